# Optimizing an MI355X kernel written in HIP

```python
import jax, jax.numpy as jnp
from jax import lax
import numpy as np

D_MODEL = 1024
BATCH = 8
SEQ = 4096
DEPTH = 2

HEAD_DIM = 64
BLOCK = 128
SWA_Q_HEADS = 8
SWA_KV_HEADS = 2
SWA_GROUP = SWA_Q_HEADS // SWA_KV_HEADS
SWA_WINDOW = 128
SB_HEADS = 8
ROPE_THETA = 10000.0
SWA_WIDTH = SWA_Q_HEADS * HEAD_DIM
SWA_KV_WIDTH = SWA_KV_HEADS * HEAD_DIM
SB_WIDTH = SB_HEADS * HEAD_DIM
N_BRANCHES = 2
OFF_K_SWA = SWA_WIDTH
OFF_V_SWA = OFF_K_SWA + SWA_KV_WIDTH
OFF_Q_SB = OFF_V_SWA + SWA_KV_WIDTH
OFF_K_SB = OFF_Q_SB + SB_WIDTH
OFF_V_SB = OFF_K_SB + SB_WIDTH
OFF_GATE_SWA = OFF_V_SB + SB_WIDTH
OFF_GATE_SB = OFF_GATE_SWA + D_MODEL
IN_COLS = OFF_GATE_SB + D_MODEL
IN_SPLITS = (OFF_K_SWA, OFF_V_SWA, OFF_Q_SB, OFF_K_SB, OFF_V_SB, OFF_GATE_SWA, OFF_GATE_SB)
PEER_HEADS = 8
PEER_NKEYS = 128
PEER_EXPERTS = PEER_NKEYS * PEER_NKEYS
PEER_TOPK = 16
PEER_QDIM = 256
PEER_HALF = PEER_QDIM // 2
PEER_CHUNK = 128
N_MOD = 6
NORM_EPS = 1e-6
NEG_INF = -1e30

kernel_name = "hybrid_swa_stickbreak_peer_adaln"


def rms_norm(x, g):
    x32 = x.astype(jnp.float32)
    y = x32 * lax.rsqrt(jnp.mean(x32 * x32, axis=-1, keepdims=True) + NORM_EPS)
    return (y * g.astype(jnp.float32)).astype(x.dtype)


def apply_rope(x, positions):
    dh = x.shape[-1]
    half = dh // 2
    inv_freq = jnp.power(ROPE_THETA, -jnp.arange(half, dtype=jnp.float32) * (2.0 / dh))
    ang = positions.astype(jnp.float32)[..., None] * inv_freq
    cos = jnp.cos(ang)[:, :, None, :]
    sin = jnp.sin(ang)[:, :, None, :]
    x32 = x.astype(jnp.float32)
    x1, x2 = x32[..., :half], x32[..., half:]
    return jnp.concatenate([x1 * cos - x2 * sin, x2 * cos + x1 * sin], axis=-1).astype(x.dtype)


def sliding_window_attention(q, k, v, sinks):
    B, S = q.shape[0], q.shape[1]
    nb = S // BLOCK
    qb = q.reshape(B, nb, BLOCK, SWA_KV_HEADS, SWA_GROUP, HEAD_DIM)

    def banded(t):
        tb = t.reshape(B, nb, BLOCK, SWA_KV_HEADS, HEAD_DIM)
        prev = jnp.pad(tb, ((0, 0), (1, 0), (0, 0), (0, 0), (0, 0)))[:, :-1]
        return jnp.concatenate([prev, tb], axis=2)

    kw, vw = banded(k), banded(v)
    scores = jnp.einsum('bnqhgd,bnkhd->bnhgqk', qb, kw).astype(jnp.float32) * (HEAD_DIM ** -0.5)
    qi = jnp.arange(BLOCK)[:, None] + BLOCK
    kj = jnp.arange(2 * BLOCK)[None, :]
    diff = qi - kj
    in_window = (diff >= 0) & (diff < SWA_WINDOW)
    key_abs = jnp.arange(nb)[:, None] * BLOCK - BLOCK + kj
    valid = in_window[None] & (key_abs >= 0)[:, None, :]
    scores = jnp.where(valid[None, :, None, None], scores, NEG_INF)
    sink = jnp.broadcast_to(
        sinks.astype(jnp.float32).reshape(1, 1, SWA_KV_HEADS, SWA_GROUP, 1, 1),
        scores.shape[:-1] + (1,))
    probs = jax.nn.softmax(jnp.concatenate([scores, sink], axis=-1), axis=-1)[..., :-1]
    out = jnp.einsum('bnhgqk,bnkhd->bnqhgd', probs.astype(v.dtype), vw)
    return out.reshape(B, S, SWA_WIDTH)


def stick_breaking_attention(q, k, v):
    B, S = q.shape[0], q.shape[1]
    nb = S // BLOCK
    qb = q.reshape(B, nb, BLOCK, SB_HEADS, HEAD_DIM).transpose(1, 0, 3, 2, 4)
    kt = k.transpose(0, 2, 1, 3)
    vt = v.transpose(0, 2, 1, 3)
    kpos = jnp.arange(S)

    def one_block(args):
        q_blk, blk = args
        z = jnp.einsum('bhqd,bhkd->bhqk', q_blk, kt).astype(jnp.float32) * (HEAD_DIM ** -0.5)
        qpos = blk * BLOCK + jnp.arange(BLOCK)
        strict = kpos[None, :] < qpos[:, None]
        log_1m = jnp.where(strict, jax.nn.log_sigmoid(-z), 0.0)
        between = lax.cumsum(log_1m, axis=3, reverse=True) - log_1m
        attn = jnp.where(strict, jnp.exp(jax.nn.log_sigmoid(z) + between), 0.0)
        return jnp.einsum('bhqk,bhkd->bhqd', attn.astype(vt.dtype), vt)

    out = lax.map(one_block, (qb, jnp.arange(nb)))
    return out.transpose(1, 0, 3, 2, 4).reshape(B, S, SB_WIDTH)


def peer_ffn(h, w_q, sub_keys, u, v):
    B, S, D = h.shape
    q = (h @ w_q).reshape(B, S, PEER_HEADS, 2, PEER_HALF)
    sk = jnp.einsum('bshpd,hpnd->bshpn', q, sub_keys).astype(jnp.float32)
    top_s, top_i = lax.top_k(sk, PEER_TOPK)
    n_cand = PEER_TOPK * PEER_TOPK
    cand_s = (top_s[..., 0, :, None] + top_s[..., 1, None, :]).reshape(B, S, PEER_HEADS, n_cand)
    cand_i = (top_i[..., 0, :, None] * PEER_NKEYS + top_i[..., 1, None, :]).reshape(B, S, PEER_HEADS, n_cand)
    best_s, best_pos = lax.top_k(cand_s, PEER_TOPK)
    expert_idx = jnp.take_along_axis(cand_i, best_pos, axis=-1)
    gates = jax.nn.softmax(best_s, axis=-1)
    n_sel = PEER_HEADS * PEER_TOPK
    nc = (B * S) // PEER_CHUNK
    h_c = h.reshape(nc, PEER_CHUNK, D)
    idx_c = expert_idx.reshape(nc, PEER_CHUNK, n_sel)
    g_c = gates.astype(h.dtype).reshape(nc, PEER_CHUNK, n_sel)

    def chunk(args):
        hc, ic, gc = args
        act = jax.nn.gelu(jnp.einsum('tkd,td->tk', jnp.take(u, ic, axis=0), hc), approximate=False)
        return jnp.einsum('tk,tkd->td', gc * act, jnp.take(v, ic, axis=0))

    return lax.map(chunk, (h_c, idx_c, g_c)).reshape(B, S, D)


def setup_inputs(seed: int = 0) -> dict:
    key = jax.random.key(seed)
    ks = jax.random.split(key, 20)
    f32 = jnp.float32
    d = D_MODEL
    x = jax.random.normal(ks[0], (BATCH, SEQ, d), f32)
    c = jax.random.normal(ks[1], (BATCH, d), f32)
    offsets = jax.random.randint(ks[2], (BATCH, 1), 0, 512, dtype=jnp.int32)
    positions = (offsets + jnp.arange(SEQ, dtype=jnp.int32)[None, :]).astype(jnp.int32)
    ada_w = jax.random.normal(ks[3], (DEPTH, d, N_MOD * d), f32) * d ** -0.5
    ada_b = jax.random.normal(ks[4], (DEPTH, N_MOD * d), f32) * 0.02
    norm1_g = 1.0 + 0.02 * jax.random.normal(ks[5], (DEPTH, d), f32)
    w_in = jax.random.normal(ks[6], (DEPTH, d, IN_COLS), f32) * d ** -0.5
    swa_sinks = jax.random.normal(ks[7], (DEPTH, SWA_Q_HEADS), f32) * 0.5
    w_branch_swa = jax.random.normal(ks[8], (DEPTH, SWA_WIDTH, d), f32) * SWA_WIDTH ** -0.5
    w_branch_sb = jax.random.normal(ks[9], (DEPTH, SB_WIDTH, d), f32) * SB_WIDTH ** -0.5
    w_out = jax.random.normal(ks[10], (DEPTH, d, d), f32) * d ** -0.5
    norm2_g = 1.0 + 0.02 * jax.random.normal(ks[11], (DEPTH, d), f32)
    peer_wq = jax.random.normal(ks[12], (DEPTH, d, PEER_HEADS * PEER_QDIM), f32) * d ** -0.5
    peer_subkeys = jax.random.normal(ks[13], (DEPTH, PEER_HEADS, 2, PEER_NKEYS, PEER_HALF), f32) * PEER_HALF ** -0.5
    peer_u = jax.random.normal(ks[14], (DEPTH, PEER_EXPERTS, d), f32) * d ** -0.5
    peer_v = jax.random.normal(ks[15], (DEPTH, PEER_EXPERTS, d), f32) * PEER_HEADS ** -0.5
    final_g = 1.0 + 0.02 * jax.random.normal(ks[16], (d,), f32)
    return {"x": x, "c": c, "positions": positions, "ada_w": ada_w, "ada_b": ada_b,
            "norm1_g": norm1_g, "w_in": w_in, "swa_sinks": swa_sinks,
            "w_branch_swa": w_branch_swa, "w_branch_sb": w_branch_sb, "w_out": w_out,
            "norm2_g": norm2_g, "peer_wq": peer_wq, "peer_subkeys": peer_subkeys,
            "peer_u": peer_u, "peer_v": peer_v, "final_g": final_g}


def reference(x, c, positions, ada_w, ada_b, norm1_g, w_in, swa_sinks, w_branch_swa, w_branch_sb,
              w_out, norm2_g, peer_wq, peer_subkeys, peer_u, peer_v, final_g):
    B, S = x.shape[0], x.shape[1]
    c_act = jax.nn.silu(c)
    for l in range(DEPTH):
        mod = c_act @ ada_w[l] + ada_b[l]
        shift1, scale1, gate1, shift2, scale2, gate2 = [m[:, None, :] for m in jnp.split(mod, N_MOD, axis=-1)]
        h = rms_norm(x, norm1_g[l]) * (1.0 + scale1) + shift1
        proj = h @ w_in[l]
        q_a, k_a, v_a, q_b, k_b, v_b, g_a, g_b = jnp.split(proj, IN_SPLITS, axis=-1)
        q_a = apply_rope(q_a.reshape(B, S, SWA_Q_HEADS, HEAD_DIM), positions)
        k_a = apply_rope(k_a.reshape(B, S, SWA_KV_HEADS, HEAD_DIM), positions)
        y_a = sliding_window_attention(q_a, k_a, v_a.reshape(B, S, SWA_KV_HEADS, HEAD_DIM), swa_sinks[l])
        y_b = stick_breaking_attention(q_b.reshape(B, S, SB_HEADS, HEAD_DIM),
                                       k_b.reshape(B, S, SB_HEADS, HEAD_DIM),
                                       v_b.reshape(B, S, SB_HEADS, HEAD_DIM))
        merged = (jax.nn.sigmoid(g_a) * (y_a @ w_branch_swa[l])
                  + jax.nn.sigmoid(g_b) * (y_b @ w_branch_sb[l]))
        x = x + gate1 * (merged @ w_out[l])
        h2 = rms_norm(x, norm2_g[l]) * (1.0 + scale2) + shift2
        x = x + gate2 * peer_ffn(h2, peer_wq[l], peer_subkeys[l], peer_u[l], peer_v[l])
    return rms_norm(x, final_g)
```

```cpp
#include <hip/hip_runtime.h>
#include <hip/hip_cooperative_groups.h>
#include <cstdio>
#include <cstdint>
namespace cg = cooperative_groups;

namespace pg8 {
#define PG8_LAS __attribute__((address_space(3)))
typedef unsigned short bf16_t;
typedef short bf16x8 __attribute__((ext_vector_type(8)));
typedef float f32x4 __attribute__((ext_vector_type(4)));
typedef unsigned u32x4 __attribute__((ext_vector_type(4)));
constexpr int BM = 256, BK = 64, HALF = 128, HTB = HALF * BK * 2  , STAGE_BYTES = 8 * HTB, NXCD = 8, WGM = 8;

__host__ __device__ __forceinline__ int lds_byte(int r, int c) { const int st = (r >> 4) * 2 + (c >> 5), rr = r & 15, cc = c & 31, ob = rr * 64 + cc * 2; return st * 1024 + (ob ^ (((ob >> 9) & 1) << 5)); }
__host__ __device__ __forceinline__ void stage_rc(int b, int& R, int& C) { const int st = b / 1024, sb = b % 1024, swz = sb ^ (((sb >> 9) & 1) << 5); R = (st >> 1) * 16 + swz / 64; C = (st & 1) * 32 + (swz % 64) / 2; }
__host__ __device__ __forceinline__ int perm32(int rho) { const int n = rho >> 4, i = rho & 15; return 8 * (i >> 2) + 4 * n + (i & 3); }

struct Unit { int pm, pn; };
struct Gemm { const bf16_t* A; const bf16_t* Bt; int M, N, K; };

struct StaticOrder {
    int nM, nN, nwg, G, c;
    __host__ __device__ void init(int M, int N, int G_, int c_) { nM = M / BM; nN = N / BM; nwg = nM * nN; G = G_; c = c_; }
    __host__ __device__ bool next(int i, Unit& u) const {
        const long L = (long)i * G + c; if (L >= nwg) return false;
        int wgid = (int)L; { const int q = nwg / NXCD, r = nwg % NXCD, xcd = wgid % NXCD, off = wgid / NXCD; wgid = (xcd < r ? xcd * (q + 1) : r * (q + 1) + (xcd - r) * q) + off; }
        const int nig = WGM * nN, gid = wgid / nig, fm = gid * WGM, gsz = (nM - fm) < WGM ? (nM - fm) : WGM;
        u.pm = fm + ((wgid % nig) % gsz); u.pn = (wgid % nig) / gsz; return true;
    }
    __device__ __forceinline__ void a_ready(const Unit&) const {}
    __device__ __forceinline__ void done(const Unit&) const {}
};


__device__ __forceinline__ unsigned cvt_pk_bf16(float lo, float hi) { unsigned r; asm volatile("v_cvt_pk_bf16_f32 %0, %1, %2" : "=v"(r) : "v"(lo), "v"(hi)); return r; }
template <class Epi, class Sched, bool ALIGN_EPI = false, bool SP2 = false>
__device__ __forceinline__ void gemm_phase(PG8_LAS unsigned char* lds, const Gemm g, const Sched& S, const Epi& E) {
    int tid_op = threadIdx.x; asm volatile("" : "+v"(tid_op));
    const int tid = tid_op, wid = __builtin_amdgcn_readfirstlane(tid >> 6), lane = tid & 63, wr = wid >> 2, wc = wid & 3, fr = lane & 15, fq = lane >> 4;
    const int K = g.K, nt = K / BK;
    unsigned voffA[2], voffB[2];
#pragma unroll
    for (int i = 0; i < 2; ++i) { int R, C; stage_rc(tid * 16 + i * 8192, R, C); const int Rb = Epi::PERM ? ((R & ~31) + perm32(R & 31)) : R;
        voffA[i] = (unsigned)(R * K + C) * 2u; voffB[i] = (unsigned)(Rb * K + C) * 2u; }
    const size_t kstep = (size_t)(BK * 2);
    const size_t hstep = (size_t)HALF * K * 2;
    const size_t tstep = 2 * hstep;
    const unsigned ldsw = (unsigned)wid * 1024u;
    const int aoff = lds_byte(wr * 64 + fr, fq * 8), boff = lds_byte(wc * 32 + fr, fq * 8);
#define PG8_SA(b, h) (((b) * 2 + (h)) * HTB)
#define PG8_SB(b, h) ((4 + (b) * 2 + (h)) * HTB)
#define PG8_STAGE(bufoff, gbase, voff) do { _Pragma("unroll") for (int _i = 0; _i < 2; ++_i) \
        __builtin_amdgcn_global_load_lds((const unsigned*)((const char*)(gbase) + (voff)[_i]), (PG8_LAS unsigned*)(lds + (bufoff) + ldsw + _i * 8192), 16, 0, 0); } while (0)
#define PG8_LDA(dst, b, h) do { _Pragma("unroll") for (int m = 0; m < 4; ++m) _Pragma("unroll") for (int k = 0; k < 2; ++k) dst[m][k] = *(const PG8_LAS bf16x8*)(lds + PG8_SA(b, h) + aoff + m * 2048 + k * 1024); } while (0)
#define PG8_LDB(dst, b, h) do { _Pragma("unroll") for (int n = 0; n < 2; ++n) _Pragma("unroll") for (int k = 0; k < 2; ++k) dst[n][k] = *(const PG8_LAS bf16x8*)(lds + PG8_SB(b, h) + boff + n * 2048 + k * 1024); } while (0)
#define PG8_MMA(ai, bj, At, Bt) do { __builtin_amdgcn_s_setprio(1); _Pragma("unroll") for (int m = 0; m < 4; ++m) _Pragma("unroll") for (int n = 0; n < 2; ++n) _Pragma("unroll") for (int k = 0; k < 2; ++k) \
        acc[ai][bj][m][n] = __builtin_amdgcn_mfma_f32_16x16x32_bf16(Bt[n][k], At[m][k], acc[ai][bj][m][n], 0, 0, 0); __builtin_amdgcn_s_setprio(0); } while (0)
#define PG8_WAIT_V(n) asm volatile("s_waitcnt vmcnt(" #n ")" ::: "memory")
#define PG8_WAIT_L(n) asm volatile("s_waitcnt lgkmcnt(" #n ")" ::: "memory")
#define PG8_BAR __builtin_amdgcn_s_barrier()
#define PG8_SCHED __builtin_amdgcn_sched_barrier(0)
    Unit cur, nxt; int ui = 0;
    if (!S.next(0, cur)) return;
    f32x4 acc[2][2][4][2];
#pragma unroll
    for (int a = 0; a < 2; ++a)
#pragma unroll
        for (int b = 0; b < 2; ++b)
#pragma unroll
            for (int m = 0; m < 4; ++m)
#pragma unroll
                for (int n = 0; n < 2; ++n) acc[a][b][m][n] = (f32x4){0.f, 0.f, 0.f, 0.f};
    bf16x8 At[4][2], B0[2][2], B1[2][2];
    const char* cA = (const char*)g.A + (size_t)cur.pm * tstep; const char* cB = (const char*)g.Bt + (size_t)cur.pn * tstep;
    S.a_ready(cur);
    if constexpr (SP2) {
        PG8_STAGE(PG8_SB(0, 0), cB, voffB); PG8_STAGE(PG8_SB(0, 1), cB + hstep, voffB); PG8_STAGE(PG8_SA(0, 0), cA, voffA); PG8_STAGE(PG8_SA(0, 1), cA + hstep, voffA);
        if (wr == 1) PG8_BAR;
        PG8_WAIT_V(2); PG8_BAR;
        PG8_STAGE(PG8_SB(1, 0), cB + kstep, voffB); PG8_STAGE(PG8_SA(1, 0), cA + kstep, voffA); PG8_STAGE(PG8_SB(1, 1), cB + hstep + kstep, voffB);
        PG8_WAIT_V(6); PG8_BAR;
    } else {
        PG8_STAGE(PG8_SB(0, 0), cB, voffB); PG8_STAGE(PG8_SA(0, 0), cA, voffA); PG8_STAGE(PG8_SB(0, 1), cB + hstep, voffB); PG8_STAGE(PG8_SA(0, 1), cA + hstep, voffA);
        if (wr == 1) PG8_BAR;
        PG8_WAIT_V(4); PG8_BAR;
        PG8_STAGE(PG8_SB(1, 0), cB + kstep, voffB); PG8_STAGE(PG8_SA(1, 0), cA + kstep, voffA); PG8_STAGE(PG8_SB(1, 1), cB + hstep + kstep, voffB);
        PG8_WAIT_V(6); PG8_BAR;
    }
    for (;;) {
        const bool has_next = S.next(ui + 1, nxt);
        const char* nA = has_next ? (const char*)g.A + (size_t)nxt.pm * tstep : cA; const char* nB = has_next ? (const char*)g.Bt + (size_t)nxt.pn * tstep : cB;
        for (int t = 0; t < nt; t += 2) {
            const bool last = (t == nt - 2);
            const char* a1 = cA + (size_t)(t + 1) * kstep;
            const char* a2 = last ? nA : cA + (size_t)(t + 2) * kstep; const char* b2 = last ? nB : cB + (size_t)(t + 2) * kstep;
            const char* a3 = a2 + kstep; const char* b3 = b2 + kstep;
            if (last && has_next) S.a_ready(nxt);
            if constexpr (SP2) {
            PG8_LDB(B0, 0, 0); PG8_LDB(B1, 0, 1); PG8_SCHED; PG8_LDA(At, 0, 0); PG8_STAGE(PG8_SA(1, 1), a1 + hstep, voffA);
            PG8_WAIT_V(8); PG8_WAIT_L(0); PG8_BAR; PG8_MMA(0, 0, At, B0); PG8_MMA(0, 1, At, B1); PG8_BAR; PG8_SCHED;
            PG8_LDA(At, 0, 1); PG8_STAGE(PG8_SB(0, 0), b2, voffB); PG8_STAGE(PG8_SB(0, 1), b2 + hstep, voffB); PG8_STAGE(PG8_SA(0, 0), a2, voffA);
            PG8_WAIT_V(8); PG8_WAIT_L(0); PG8_BAR; PG8_MMA(1, 0, At, B0); PG8_MMA(1, 1, At, B1); PG8_BAR; PG8_SCHED;
            PG8_LDB(B0, 1, 0); PG8_LDB(B1, 1, 1); PG8_SCHED; PG8_LDA(At, 1, 0); PG8_STAGE(PG8_SA(0, 1), a2 + hstep, voffA);
            PG8_WAIT_V(8); PG8_WAIT_L(0); PG8_BAR; PG8_MMA(0, 0, At, B0); PG8_MMA(0, 1, At, B1); PG8_BAR; PG8_SCHED;
            PG8_LDA(At, 1, 1); PG8_STAGE(PG8_SB(1, 0), b3, voffB); PG8_STAGE(PG8_SB(1, 1), b3 + hstep, voffB); PG8_STAGE(PG8_SA(1, 0), a3, voffA);
            PG8_WAIT_V(8); PG8_WAIT_L(0); PG8_BAR; PG8_MMA(1, 0, At, B0); PG8_MMA(1, 1, At, B1); PG8_BAR; PG8_SCHED;
            } else {
            PG8_LDB(B0, 0, 0); PG8_SCHED; PG8_LDA(At, 0, 0); PG8_STAGE(PG8_SA(1, 1), a1 + hstep, voffA);
            PG8_WAIT_L(8); PG8_BAR; PG8_WAIT_L(0); PG8_MMA(0, 0, At, B0); PG8_BAR; PG8_SCHED;
            PG8_LDB(B1, 0, 1); PG8_STAGE(PG8_SB(0, 0), b2, voffB);
            PG8_BAR; PG8_WAIT_L(0); PG8_MMA(0, 1, At, B1); PG8_BAR;
            PG8_LDA(At, 0, 1); PG8_STAGE(PG8_SA(0, 0), a2, voffA);
            PG8_BAR; PG8_WAIT_L(0); PG8_MMA(1, 0, At, B0); PG8_BAR; PG8_SCHED;
            PG8_STAGE(PG8_SB(0, 1), b2 + hstep, voffB);
            PG8_WAIT_V(6); PG8_BAR; PG8_MMA(1, 1, At, B1); PG8_BAR;
            PG8_LDB(B0, 1, 0); PG8_SCHED; PG8_LDA(At, 1, 0); PG8_STAGE(PG8_SA(0, 1), a2 + hstep, voffA);
            PG8_WAIT_L(8); PG8_BAR; PG8_WAIT_L(0); PG8_MMA(0, 0, At, B0); PG8_BAR; PG8_SCHED;
            PG8_LDB(B1, 1, 1); PG8_STAGE(PG8_SB(1, 0), b3, voffB);
            PG8_BAR; PG8_WAIT_L(0); PG8_MMA(0, 1, At, B1); PG8_BAR;
            PG8_LDA(At, 1, 1); PG8_STAGE(PG8_SA(1, 0), a3, voffA);
            PG8_BAR; PG8_WAIT_L(0); PG8_MMA(1, 0, At, B0); PG8_BAR; PG8_SCHED;
            PG8_STAGE(PG8_SB(1, 1), b3 + hstep, voffB);
            PG8_WAIT_V(6); PG8_BAR; PG8_MMA(1, 1, At, B1); PG8_BAR;
            }
        }
        if constexpr (ALIGN_EPI) { if (wr == 0) PG8_BAR; }
        if constexpr (!Epi::AFTER_DRAIN) { E(acc, cur, wr, wc, fr, fq); S.done(cur); }
        if (!has_next) break;
#pragma unroll
        for (int a = 0; a < 2; ++a)
#pragma unroll
            for (int b = 0; b < 2; ++b)
#pragma unroll
                for (int m = 0; m < 4; ++m)
#pragma unroll
                    for (int n = 0; n < 2; ++n) acc[a][b][m][n] = (f32x4){0.f, 0.f, 0.f, 0.f};
        cur = nxt; cA = nA; cB = nB; ++ui;
        if constexpr (ALIGN_EPI) { if (wr == 1) PG8_BAR; }
    }
    PG8_WAIT_V(0);
    if constexpr (!ALIGN_EPI) { if (wr == 0) PG8_BAR; }
    PG8_BAR;
    if constexpr (Epi::AFTER_DRAIN) { E.fused(acc, cur, wr, wc, fr, fq, lds, wid, lane); S.done(cur); }
#undef PG8_SA
#undef PG8_SB
#undef PG8_STAGE
#undef PG8_LDA
#undef PG8_LDB
#undef PG8_MMA
#undef PG8_WAIT_V
#undef PG8_WAIT_L
#undef PG8_BAR
#undef PG8_SCHED
}
}


#define LAS __attribute__((address_space(3)))
typedef unsigned short bf16_t;
typedef float f32x4 __attribute__((ext_vector_type(4)));
typedef unsigned u32x4 __attribute__((ext_vector_type(4)));
typedef unsigned u32x2 __attribute__((ext_vector_type(2)));

constexpr int BATCH = 8, SEQ = 4096, DM = 1024, T = BATCH * SEQ, DEPTH = 2;
constexpr int NPROJ = 4352, NMOD = 6 * DM;
constexpr int NEXP = 16384, PQ = 2048;
constexpr float NORM_EPS = 1e-6f;
constexpr float LOG2E = 1.4426950408889634f;
constexpr float QSCALE = 0.125f * LOG2E;
constexpr float SB_EXIT = 160.0f;

constexpr size_t MiB = 1u << 20;
constexpr size_t WS_CTL = 0;
constexpr size_t WS_MOD = 1 * MiB;
constexpr size_t WS_ROPE = 2 * MiB;
constexpr size_t WS_WIN = 10 * MiB;
constexpr size_t WS_WBA = 27 * MiB;
constexpr size_t WS_WBB = 29 * MiB;
constexpr size_t WS_WOUT = 31 * MiB;
constexpr size_t WS_WQ = 35 * MiB;
constexpr size_t WS_SK = 43 * MiB;
constexpr size_t WS_UQ = 44 * MiB;
constexpr size_t WS_VQ = 76 * MiB;
constexpr size_t WS_USC = 108 * MiB;
constexpr size_t WS_VSC = 108 * MiB + 256 * 1024;
constexpr size_t WS_HS = 109 * MiB;
constexpr size_t WS_H = 112 * MiB;
constexpr size_t WS_QA = 176 * MiB;
constexpr size_t WS_QB = 208 * MiB;
constexpr size_t WS_KB = 240 * MiB;
constexpr size_t WS_VB = 272 * MiB;
constexpr size_t WS_KA = 304 * MiB;
constexpr size_t WS_VA = 312 * MiB;
constexpr size_t WS_GA = 320 * MiB;
constexpr size_t WS_GB = 384 * MiB;
constexpr size_t WS_END = 448 * MiB;
constexpr size_t WS_H2Q = WS_QA, WS_IDX = WS_KB, WS_GATE = WS_VB, WS_Q2 = WS_GA;

constexpr int LDS_BYTES = 147456;
constexpr int NTHREADS = 512, NWAVES = 8;

struct KArgs {
    const float* x; const float* c; const int* pos; const float* ada_w; const float* ada_b; const float* norm1_g; const float* w_in; const float* sinks;
    const float* wbr_a; const float* wbr_b; const float* w_out; const float* norm2_g; const float* wq; const float* subkeys; const float* pu; const float* pv; const float* final_g;
    float* out; unsigned char* ws; int ph_lo, ph_hi;
};

__device__ __forceinline__ unsigned f2bf(float f) { unsigned u = __float_as_uint(f); return (u + 0x7fffu + ((u >> 16) & 1u)) >> 16; }
__device__ __forceinline__ unsigned pk2(float lo, float hi) { return f2bf(lo) | (f2bf(hi) << 16); }
__device__ __forceinline__ float bflo(unsigned w) { return __uint_as_float(w << 16); }
__device__ __forceinline__ float bfhi(unsigned w) { return __uint_as_float(w & 0xffff0000u); }
__device__ __forceinline__ float wave_sum(float v) {
#pragma unroll
    for (int o = 1; o < 64; o <<= 1) v += __shfl_xor(v, o);
    return v;
}
__device__ __forceinline__ float wave_max(float v) {
#pragma unroll
    for (int o = 1; o < 64; o <<= 1) v = fmaxf(v, __shfl_xor(v, o));
    return v;
}
__device__ __forceinline__ float dot8(u32x4 a, u32x4 b, float acc) {
    acc = fmaf(bflo(a.x), bflo(b.x), acc); acc = fmaf(bfhi(a.x), bfhi(b.x), acc);
    acc = fmaf(bflo(a.y), bflo(b.y), acc); acc = fmaf(bfhi(a.y), bfhi(b.y), acc);
    acc = fmaf(bflo(a.z), bflo(b.z), acc); acc = fmaf(bfhi(a.z), bfhi(b.z), acc);
    acc = fmaf(bflo(a.w), bflo(b.w), acc); acc = fmaf(bfhi(a.w), bfhi(b.w), acc);
    return acc;
}
__device__ __forceinline__ float softplus2(float z2) {
    return fmaxf(z2, 0.f) + __log2f(1.0f + exp2f(-fabsf(z2)));
}

__device__ __forceinline__ int win_pos(int n) {
    if (n >= 640) return n;
    const int hb = n & ~63, d = n & 63;
    return hb + (d < 32 ? 2 * d : 2 * (d - 32) + 1);
}
template <bool WIN>
__device__ __forceinline__ void transpose_item(const float* W, int K, int N, bf16_t* WT, LAS float* scr, int item, int lane) {
    const int nblk = N / 32, kb = item / nblk, nb = item % nblk, k0 = 64 * kb, n0 = 32 * nb;
#pragma unroll 8
    for (int i = 0; i < 32; ++i) { const int kk = 2 * i + (lane >> 5); scr[kk * 33 + (lane & 31)] = W[(size_t)(k0 + kk) * N + n0 + (lane & 31)]; }
    asm volatile("s_waitcnt lgkmcnt(0)" ::: "memory");
    const int c = lane & 7;
#pragma unroll
    for (int j = 0; j < 4; ++j) { const int n = (lane >> 3) + 8 * j; const LAS float* s = scr + (8 * c) * 33 + n;
        u32x4 o; o.x = pk2(s[0 * 33], s[1 * 33]); o.y = pk2(s[2 * 33], s[3 * 33]); o.z = pk2(s[4 * 33], s[5 * 33]); o.w = pk2(s[6 * 33], s[7 * 33]);
        const int row = WIN ? win_pos(n0 + n) : (n0 + n);
        *(u32x4*)(WT + (size_t)row * K + k0 + 8 * c) = o; }
    asm volatile("s_waitcnt lgkmcnt(0)" ::: "memory");
}
template <bool OFFSET128>
__device__ __forceinline__ void quant_row(const f32x4 (&v)[4], unsigned char* dst_row, float* scale_out, int lane) {
    float am = 0.f;
#pragma unroll
    for (int i = 0; i < 4; ++i) am = fmaxf(am, fmaxf(fmaxf(fabsf(v[i].x), fabsf(v[i].y)), fmaxf(fabsf(v[i].z), fabsf(v[i].w))));
    am = wave_max(am);
    const float inv = am > 0.f ? 127.0f / am : 0.f, sc = am > 0.f ? am / 127.0f : 1.0f;
    u32x4 o;
#pragma unroll
    for (int i = 0; i < 4; ++i) {
        int q0 = (int)rintf(v[i].x * inv), q1 = (int)rintf(v[i].y * inv), q2 = (int)rintf(v[i].z * inv), q3 = (int)rintf(v[i].w * inv);
        if (OFFSET128) { q0 += 128; q1 += 128; q2 += 128; q3 += 128; }
        o[i] = (unsigned)(q0 & 0xff) | ((unsigned)(q1 & 0xff) << 8) | ((unsigned)(q2 & 0xff) << 16) | ((unsigned)(q3 & 0xff) << 24);
    }
    *(u32x4*)(dst_row + 16 * lane) = o;
    if (lane == 0) *scale_out = sc;
}

__device__ __forceinline__ void ph_prologue(const KArgs& a, LAS unsigned char* lds) {
    int tid_op = threadIdx.x; asm volatile("" : "+v"(tid_op)); const int tid = tid_op, lane = tid & 63, wave = tid >> 6, G = gridDim.x;
    const int gw = blockIdx.x * NWAVES + wave, NGW = G * NWAVES;
    unsigned char* ws = a.ws;
    {
        LAS float* sc = (LAS float*)lds;
        for (int it = blockIdx.x; it < DEPTH * 12; it += G) {
            for (int idx = tid; idx < 8192; idx += NTHREADS) { const int b = idx >> 10, i = idx & 1023; const float cv = a.c[b * 1024 + i]; sc[i * 8 + b] = cv / (1.0f + __expf(-cv)); }
            __syncthreads();
            const int l = it / 12, j = (it % 12) * 512 + tid;
            const float* wp = a.ada_w + (size_t)l * 1024 * NMOD + j;
            float acc[8];
#pragma unroll
            for (int b = 0; b < 8; ++b) acc[b] = 0.f;
#pragma unroll 4
            for (int i = 0; i < 1024; ++i) {
                const float w = wp[(size_t)i * NMOD];
                const f32x4 s0 = *(const LAS f32x4*)(sc + i * 8), s1 = *(const LAS f32x4*)(sc + i * 8 + 4);
                acc[0] = fmaf(s0.x, w, acc[0]); acc[1] = fmaf(s0.y, w, acc[1]); acc[2] = fmaf(s0.z, w, acc[2]); acc[3] = fmaf(s0.w, w, acc[3]);
                acc[4] = fmaf(s1.x, w, acc[4]); acc[5] = fmaf(s1.y, w, acc[5]); acc[6] = fmaf(s1.z, w, acc[6]); acc[7] = fmaf(s1.w, w, acc[7]);
            }
            float* mod = (float*)(ws + WS_MOD);
            const float bias = a.ada_b[l * NMOD + j];
#pragma unroll
            for (int b = 0; b < 8; ++b) mod[(size_t)(l * 8 + b) * NMOD + j] = acc[b] + bias;
            __syncthreads();
        }
    }
    {
        LAS float* scr = (LAS float*)(lds + 32768 + wave * 8448);
        constexpr int I_IN = 16 * 136, I_BR = 8 * 32, I_OUT = 16 * 32, I_Q = 16 * 64, I_L = I_IN + 2 * I_BR + I_OUT + I_Q;
        for (int it = gw; it < DEPTH * I_L; it += NGW) {
            const int l = it / I_L; int r = it % I_L;
            if (r < I_IN) { transpose_item<true>(a.w_in + (size_t)l * 1024 * NPROJ, 1024, NPROJ, (bf16_t*)(ws + WS_WIN) + (size_t)l * NPROJ * 1024, scr, r, lane); continue; } r -= I_IN;
            if (r < I_BR) { transpose_item<false>(a.wbr_a + (size_t)l * 512 * 1024, 512, 1024, (bf16_t*)(ws + WS_WBA) + (size_t)l * 1024 * 512, scr, r, lane); continue; } r -= I_BR;
            if (r < I_BR) { transpose_item<false>(a.wbr_b + (size_t)l * 512 * 1024, 512, 1024, (bf16_t*)(ws + WS_WBB) + (size_t)l * 1024 * 512, scr, r, lane); continue; } r -= I_BR;
            if (r < I_OUT) { transpose_item<false>(a.w_out + (size_t)l * 1024 * 1024, 1024, 1024, (bf16_t*)(ws + WS_WOUT) + (size_t)l * 1024 * 1024, scr, r, lane); continue; } r -= I_OUT;
            transpose_item<false>(a.wq + (size_t)l * 1024 * PQ, 1024, PQ, (bf16_t*)(ws + WS_WQ) + (size_t)l * PQ * 1024, scr, r, lane);
        }
    }
    {
        const int gt = blockIdx.x * NTHREADS + tid, NGT = G * NTHREADS;
        for (int i = gt; i < DEPTH * 8 * 2 * 128 * 128 / 8; i += NGT) {
            const f32x4 v0 = *(const f32x4*)(a.subkeys + (size_t)i * 8), v1 = *(const f32x4*)(a.subkeys + (size_t)i * 8 + 4);
            u32x4 o; o.x = pk2(v0.x, v0.y); o.y = pk2(v0.z, v0.w); o.z = pk2(v1.x, v1.y); o.w = pk2(v1.z, v1.w);
            *(u32x4*)((bf16_t*)(ws + WS_SK) + (size_t)i * 8) = o;
        }
        for (int i = gt; i < T * 32; i += NGT) {
            const int t = i >> 5, f = i & 31;
            double inv = 1.0;
            for (int k = 0; k < f; ++k) inv *= 0.7498942093324559;
            const double ang = (double)a.pos[t] * inv;
            const double kq = rint(ang * 0.63661977236758134308);
            const double r = fma(-kq, 6.123233995736766036e-17, fma(-kq, 1.57079632679489655800, ang));
            const int quad = (int)((long long)kq & 3);
            const double r2 = r * r;
            double sp = -1.0 / 1307674368000.0; sp = fma(sp, r2, 1.0 / 6227020800.0); sp = fma(sp, r2, -1.0 / 39916800.0); sp = fma(sp, r2, 1.0 / 362880.0);
            sp = fma(sp, r2, -1.0 / 5040.0); sp = fma(sp, r2, 1.0 / 120.0); sp = fma(sp, r2, -1.0 / 6.0); sp = fma(sp * r2, r, r);
            double cp = 1.0 / 20922789888000.0; cp = fma(cp, r2, -1.0 / 87178291200.0); cp = fma(cp, r2, 1.0 / 479001600.0); cp = fma(cp, r2, -1.0 / 3628800.0);
            cp = fma(cp, r2, 1.0 / 40320.0); cp = fma(cp, r2, -1.0 / 720.0); cp = fma(cp, r2, 1.0 / 24.0); cp = fma(cp, r2, -0.5); cp = fma(cp, r2, 1.0);
            const double sn = (quad == 0) ? sp : (quad == 1) ? cp : (quad == 2) ? -sp : -cp;
            const double cs = (quad == 0) ? cp : (quad == 1) ? -sp : (quad == 2) ? -cp : sp;
            float* rp = (float*)(ws + WS_ROPE) + (size_t)i * 2; rp[0] = (float)cs; rp[1] = (float)sn;
        }
    }
    for (int r = gw; r < DEPTH * 2 * NEXP; r += NGW) {
        const int tbl = r / (DEPTH * NEXP), lr = r % (DEPTH * NEXP);
        const float* src = (tbl == 0 ? a.pu : a.pv) + (size_t)lr * 1024;
        f32x4 v[4];
#pragma unroll
        for (int i = 0; i < 4; ++i) v[i] = ((const f32x4*)src)[64 * i + lane];
        if (tbl == 0) quant_row<false>(v, ws + WS_UQ + (size_t)lr * 1024, (float*)(ws + WS_USC) + lr, lane);
        else quant_row<true>(v, ws + WS_VQ + (size_t)lr * 1024, (float*)(ws + WS_VSC) + lr, lane);
    }
}

template <bool WITH_Q8>
__device__ __forceinline__ void ph_norm(const KArgs& a, const float* xin, const float* g, const float* mod_l, int shift_idx, int scale_idx) {
    int tid_op = threadIdx.x; asm volatile("" : "+v"(tid_op)); const int tid = tid_op, lane = tid & 63, wave = tid >> 6;
    const int gw = blockIdx.x * NWAVES + wave, NGW = gridDim.x * NWAVES;
    bf16_t* H = (bf16_t*)(a.ws + WS_H);
    for (int row = gw; row < T; row += NGW) {
        const int b = row >> 12;
        f32x4 v[4]; float ss = 0.f;
#pragma unroll
        for (int i = 0; i < 4; ++i) { v[i] = ((const f32x4*)(xin + (size_t)row * DM))[64 * i + lane]; ss += (v[i].x * v[i].x + v[i].y * v[i].y) + (v[i].z * v[i].z + v[i].w * v[i].w); }
        ss = wave_sum(ss);
        const float r = 1.0f / sqrtf(ss * (1.0f / DM) + NORM_EPS);
#pragma unroll
        for (int i = 0; i < 4; ++i) {
            const int col = 256 * i + 4 * lane;
            const f32x4 gg = *(const f32x4*)(g + col), sc = *(const f32x4*)(mod_l + (size_t)b * NMOD + scale_idx * DM + col), sh = *(const f32x4*)(mod_l + (size_t)b * NMOD + shift_idx * DM + col);
            v[i] = (v[i] * r) * gg * (sc + 1.0f) + sh;
            u32x2 o; o.x = pk2(v[i].x, v[i].y); o.y = pk2(v[i].z, v[i].w);
            *(u32x2*)(H + (size_t)row * DM + col) = o;
        }
        if (WITH_Q8) quant_row<false>(v, a.ws + WS_H2Q + (size_t)row * 1024, (float*)(a.ws + WS_HS) + row, lane);
    }
}
__device__ __forceinline__ void ph_final_norm(const KArgs& a) {
    int tid_op = threadIdx.x; asm volatile("" : "+v"(tid_op)); const int tid = tid_op, lane = tid & 63, wave = tid >> 6;
    const int gw = blockIdx.x * NWAVES + wave, NGW = gridDim.x * NWAVES;
    for (int row = gw; row < T; row += NGW) {
        f32x4 v[4]; float ss = 0.f;
#pragma unroll
        for (int i = 0; i < 4; ++i) { v[i] = ((const f32x4*)(a.out + (size_t)row * DM))[64 * i + lane]; ss += (v[i].x * v[i].x + v[i].y * v[i].y) + (v[i].z * v[i].z + v[i].w * v[i].w); }
        ss = wave_sum(ss);
        const float r = 1.0f / sqrtf(ss * (1.0f / DM) + NORM_EPS);
#pragma unroll
        for (int i = 0; i < 4; ++i) { const f32x4 gg = *(const f32x4*)(a.final_g + 256 * i + 4 * lane); ((f32x4*)(a.out + (size_t)row * DM))[64 * i + lane] = (v[i] * r) * gg; }
    }
}

struct EpiProj {
    static constexpr bool PERM = true, AFTER_DRAIN = false;
    unsigned char* ws;
    __device__ __forceinline__ void operator()(const pg8::f32x4 (&acc)[2][2][4][2], const pg8::Unit& u, int wr, int wc, int fr, int fq) const {
        const int row0 = u.pm * 256 + wr * 64 + fr;
        const float* rope = (const float*)(ws + WS_ROPE);
#pragma unroll
        for (int bj = 0; bj < 2; ++bj) {
            const int cgb = u.pn * 256 + bj * 128;
            bf16_t* base; int pitch, cl, mode;
            if (cgb < 512) { base = (bf16_t*)(ws + WS_QA); pitch = 512; cl = cgb; mode = 1; }
            else if (cgb < 640) { base = (bf16_t*)(ws + WS_KA); pitch = 128; cl = cgb - 512; mode = 2; }
            else if (cgb < 768) { base = (bf16_t*)(ws + WS_VA); pitch = 128; cl = cgb - 640; mode = 0; }
            else if (cgb < 1280) { base = (bf16_t*)(ws + WS_QB); pitch = 512; cl = cgb - 768; mode = 3; }
            else if (cgb < 1792) { base = (bf16_t*)(ws + WS_KB); pitch = 512; cl = cgb - 1280; mode = 0; }
            else if (cgb < 2304) { base = (bf16_t*)(ws + WS_VB); pitch = 512; cl = cgb - 1792; mode = 0; }
            else if (cgb < 3328) { base = (bf16_t*)(ws + WS_GA); pitch = 1024; cl = cgb - 2304; mode = 4; }
            else { base = (bf16_t*)(ws + WS_GB); pitch = 1024; cl = cgb - 3328; mode = 4; }
            const int col = cl + wc * 32 + 8 * fq;
#pragma unroll
            for (int ai = 0; ai < 2; ++ai)
#pragma unroll
                for (int m = 0; m < 4; ++m) {
                    const int row = row0 + ai * 128 + m * 16;
                    pg8::f32x4 v0 = acc[ai][bj][m][0], v1 = acc[ai][bj][m][1];
                    if (mode == 1 || mode == 2) {
                        const int i0 = (col & 63) >> 1;
                        const f32x4 c01 = *(const f32x4*)(rope + ((size_t)row * 32 + i0) * 2), c23 = *(const f32x4*)(rope + ((size_t)row * 32 + i0 + 2) * 2);
                        pg8::f32x4 w0, w1;
                        w0[0] = v0[0] * c01.x - v0[1] * c01.y; w0[1] = v0[1] * c01.x + v0[0] * c01.y;
                        w0[2] = v0[2] * c01.z - v0[3] * c01.w; w0[3] = v0[3] * c01.z + v0[2] * c01.w;
                        w1[0] = v1[0] * c23.x - v1[1] * c23.y; w1[1] = v1[1] * c23.x + v1[0] * c23.y;
                        w1[2] = v1[2] * c23.z - v1[3] * c23.w; w1[3] = v1[3] * c23.z + v1[2] * c23.w;
                        v0 = w0; v1 = w1;
                    }
                    if (mode == 1 || mode == 3) { v0 = v0 * QSCALE; v1 = v1 * QSCALE; }
                    if (mode == 4) {
#pragma unroll
                        for (int e = 0; e < 4; ++e) { v0[e] = 1.0f / (1.0f + __expf(-v0[e])); v1[e] = 1.0f / (1.0f + __expf(-v1[e])); }
                    }
                    u32x4 w; w.x = pk2(v0[0], v0[1]); w.y = pk2(v0[2], v0[3]); w.z = pk2(v1[0], v1[1]); w.w = pk2(v1[2], v1[3]);
                    *(u32x4*)(base + (size_t)row * pitch + col) = w;
                }
        }
    }
};
template <bool ADD> struct EpiBranch {
    static constexpr bool PERM = true, AFTER_DRAIN = false;
    const bf16_t* Gt; bf16_t* O;
    __device__ __forceinline__ void operator()(const pg8::f32x4 (&acc)[2][2][4][2], const pg8::Unit& u, int wr, int wc, int fr, int fq) const {
        const int row0 = u.pm * 256 + wr * 64 + fr, col0 = u.pn * 256 + wc * 32 + 8 * fq;
#pragma unroll
        for (int ai = 0; ai < 2; ++ai)
#pragma unroll
            for (int m = 0; m < 4; ++m)
#pragma unroll
                for (int bj = 0; bj < 2; ++bj) {
                    const size_t off = (size_t)(row0 + ai * 128 + m * 16) * DM + col0 + bj * 128;
                    const u32x4 gv = *(const u32x4*)(Gt + off);
                    const pg8::f32x4 v0 = acc[ai][bj][m][0], v1 = acc[ai][bj][m][1];
                    float r[8];
                    r[0] = bflo(gv.x) * v0[0]; r[1] = bfhi(gv.x) * v0[1]; r[2] = bflo(gv.y) * v0[2]; r[3] = bfhi(gv.y) * v0[3];
                    r[4] = bflo(gv.z) * v1[0]; r[5] = bfhi(gv.z) * v1[1]; r[6] = bflo(gv.w) * v1[2]; r[7] = bfhi(gv.w) * v1[3];
                    if (ADD) { const u32x4 ov = *(const u32x4*)(O + off);
                        r[0] += bflo(ov.x); r[1] += bfhi(ov.x); r[2] += bflo(ov.y); r[3] += bfhi(ov.y); r[4] += bflo(ov.z); r[5] += bfhi(ov.z); r[6] += bflo(ov.w); r[7] += bfhi(ov.w); }
                    u32x4 w; w.x = pk2(r[0], r[1]); w.y = pk2(r[2], r[3]); w.z = pk2(r[4], r[5]); w.w = pk2(r[6], r[7]);
                    *(u32x4*)(O + off) = w;
                }
    }
};
struct EpiWout {
    static constexpr bool PERM = false, AFTER_DRAIN = false;
    const float* xold; float* xnew; const float* gate;
    __device__ __forceinline__ void operator()(const pg8::f32x4 (&acc)[2][2][4][2], const pg8::Unit& u, int wr, int wc, int fr, int fq) const {
        const int row0 = u.pm * 256 + wr * 64 + fr, col0 = u.pn * 256 + wc * 32 + 4 * fq, b = u.pm >> 4;
#pragma unroll
        for (int bj = 0; bj < 2; ++bj)
#pragma unroll
            for (int n = 0; n < 2; ++n) {
                const pg8::f32x4 gv = *(const pg8::f32x4*)(gate + (size_t)b * NMOD + col0 + bj * 128 + n * 16);
#pragma unroll
                for (int ai = 0; ai < 2; ++ai)
#pragma unroll
                    for (int m = 0; m < 4; ++m) { const size_t off = (size_t)(row0 + ai * 128 + m * 16) * DM + col0 + bj * 128 + n * 16;
                        const pg8::f32x4 xo = *(const pg8::f32x4*)(xold + off);
                        *(pg8::f32x4*)(xnew + off) = xo + gv * acc[ai][bj][m][n]; }
            }
    }
};
struct EpiPlainBf16 {
    static constexpr bool PERM = true, AFTER_DRAIN = false;
    bf16_t* O; int ldc;
    __device__ __forceinline__ void operator()(const pg8::f32x4 (&acc)[2][2][4][2], const pg8::Unit& u, int wr, int wc, int fr, int fq) const {
        const int row0 = u.pm * 256 + wr * 64 + fr, col0 = u.pn * 256 + wc * 32 + 8 * fq;
#pragma unroll
        for (int ai = 0; ai < 2; ++ai)
#pragma unroll
            for (int m = 0; m < 4; ++m)
#pragma unroll
                for (int bj = 0; bj < 2; ++bj) {
                    const pg8::f32x4 v0 = acc[ai][bj][m][0], v1 = acc[ai][bj][m][1];
                    u32x4 w; w.x = pk2(v0[0], v0[1]); w.y = pk2(v0[2], v0[3]); w.z = pk2(v1[0], v1[1]); w.w = pk2(v1[2], v1[3]);
                    *(u32x4*)(O + (size_t)(row0 + ai * 128 + m * 16) * ldc + col0 + bj * 128) = w;
                }
    }
};

__device__ __forceinline__ void load_row64(const bf16_t* p, float (&q)[64]) {
#pragma unroll
    for (int i = 0; i < 8; ++i) { const u32x4 w = *(const u32x4*)(p + 8 * i);
        q[8 * i + 0] = bflo(w.x); q[8 * i + 1] = bfhi(w.x); q[8 * i + 2] = bflo(w.y); q[8 * i + 3] = bfhi(w.y);
        q[8 * i + 4] = bflo(w.z); q[8 * i + 5] = bfhi(w.z); q[8 * i + 6] = bflo(w.w); q[8 * i + 7] = bfhi(w.w); }
}
__device__ __forceinline__ float dot_row64(const bf16_t* p, const float (&q)[64]) {
    float acc = 0.f;
#pragma unroll
    for (int i = 0; i < 8; ++i) { const u32x4 w = *(const u32x4*)(p + 8 * i);
        acc = fmaf(q[8 * i + 0], bflo(w.x), acc); acc = fmaf(q[8 * i + 1], bfhi(w.x), acc); acc = fmaf(q[8 * i + 2], bflo(w.y), acc); acc = fmaf(q[8 * i + 3], bfhi(w.y), acc);
        acc = fmaf(q[8 * i + 4], bflo(w.z), acc); acc = fmaf(q[8 * i + 5], bfhi(w.z), acc); acc = fmaf(q[8 * i + 6], bflo(w.w), acc); acc = fmaf(q[8 * i + 7], bfhi(w.w), acc); }
    return acc;
}
template <bool EARLY_EXIT>
__device__ __forceinline__ void ph_attn_sb(const KArgs& a) {
    int tid_op = threadIdx.x; asm volatile("" : "+v"(tid_op)); const int tid = tid_op, lane = tid & 63, wave = tid >> 6;
    const int gw = blockIdx.x * NWAVES + wave, NGW = gridDim.x * NWAVES;
    const bf16_t* QB = (const bf16_t*)(a.ws + WS_QB); const bf16_t* KB = (const bf16_t*)(a.ws + WS_KB); const bf16_t* VB = (const bf16_t*)(a.ws + WS_VB);
    bf16_t* YB = (bf16_t*)(a.ws + WS_QB);
    for (int it = gw; it < T * 8; it += NGW) {
        const int s = it & 4095, h = (it >> 12) & 7, b = it >> 15;
        const size_t t = (size_t)b * SEQ + s;
        float q[64]; load_row64(QB + t * 512 + h * 64, q);
        float o = 0.f, carry = 0.f;
        for (int c = (s - 1) >> 6; c >= 0; --c) {
            const int key = 64 * c + lane; const bool valid = key < s;
            const float z2 = dot_row64(KB + ((size_t)b * SEQ + key) * 512 + h * 64, q);
            const float l2 = valid ? -softplus2(z2) : 0.f;
            float sfx = l2;
#pragma unroll
            for (int off = 1; off < 64; off <<= 1) { const float tt = __shfl_down(sfx, off); if (lane + off < 64) sfx += tt; }
            const float total = __shfl(sfx, 0);
            const float A = valid ? exp2f(z2 + sfx + carry) : 0.f;
            carry += total;
            const bf16_t* vp = VB + ((size_t)b * SEQ + 64 * c) * 512 + h * 64 + lane;
#pragma unroll 16
            for (int j = 0; j < 64; ++j) { const float aj = __shfl(A, j); o = fmaf(aj, __uint_as_float((unsigned)vp[(size_t)j * 512] << 16), o); }
            if (EARLY_EXIT && carry < -SB_EXIT) break;
        }
        YB[t * 512 + h * 64 + lane] = (bf16_t)f2bf(o);
    }
}
__device__ __forceinline__ void ph_attn_swa(const KArgs& a, int l) {
    int tid_op = threadIdx.x; asm volatile("" : "+v"(tid_op)); const int tid = tid_op, lane = tid & 63, wave = tid >> 6;
    const int gw = blockIdx.x * NWAVES + wave, NGW = gridDim.x * NWAVES;
    const bf16_t* QA = (const bf16_t*)(a.ws + WS_QA); const bf16_t* KA = (const bf16_t*)(a.ws + WS_KA); const bf16_t* VA = (const bf16_t*)(a.ws + WS_VA);
    bf16_t* YA = (bf16_t*)(a.ws + WS_QA);
    for (int it = gw; it < T * 8; it += NGW) {
        const int s = it & 4095, hq = (it >> 12) & 7, b = it >> 15, kvh = hq >> 2;
        const size_t t = (size_t)b * SEQ + s;
        float q[64]; load_row64(QA + t * 512 + hq * 64, q);
        const int lo = s - 127 > 0 ? s - 127 : 0, c_lo = lo >> 6, c_hi = s >> 6;
        float sc[3];
#pragma unroll
        for (int ci = 0; ci < 3; ++ci) {
            const int c = c_lo + ci; sc[ci] = -INFINITY;
            if (c <= c_hi) { const int key = 64 * c + lane; const float z2 = dot_row64(KA + ((size_t)b * SEQ + key) * 128 + kvh * 64, q); if (key >= lo && key <= s) sc[ci] = z2; }
        }
        const float sink2 = a.sinks[l * 8 + hq] * LOG2E;
        const float m = fmaxf(wave_max(fmaxf(fmaxf(sc[0], sc[1]), sc[2])), sink2);
        float p[3], ps = 0.f;
#pragma unroll
        for (int ci = 0; ci < 3; ++ci) { p[ci] = exp2f(sc[ci] - m); ps += p[ci]; }
        const float denom = wave_sum(ps) + exp2f(sink2 - m);
        float o = 0.f;
#pragma unroll
        for (int ci = 0; ci < 3; ++ci) {
            const int c = c_lo + ci;
            if (c <= c_hi) { const bf16_t* vp = VA + ((size_t)b * SEQ + 64 * c) * 128 + kvh * 64 + lane;
#pragma unroll 16
                for (int j = 0; j < 64; ++j) { const float pj = __shfl(p[ci], j); o = fmaf(pj, __uint_as_float((unsigned)vp[(size_t)j * 128] << 16), o); } }
        }
        YA[t * 512 + hq * 64 + lane] = (bf16_t)f2bf(o / denom);
    }
}

__device__ __forceinline__ void ph_topk(const KArgs& a, int l, LAS unsigned char* lds) {
    int tid_op = threadIdx.x; asm volatile("" : "+v"(tid_op)); const int tid = tid_op, lane = tid & 63, wave = tid >> 6;
    const int gw = blockIdx.x * NWAVES + wave, NGW = gridDim.x * NWAVES;
    const bf16_t* Q2 = (const bf16_t*)(a.ws + WS_Q2);
    const bf16_t* SK = (const bf16_t*)(a.ws + WS_SK) + (size_t)l * 8 * 2 * 128 * 128;
    int* IDX = (int*)(a.ws + WS_IDX); float* GATE = (float*)(a.ws + WS_GATE);
    LAS float* ls_s = (LAS float*)(lds + wave * 256);
    LAS int* ls_i = (LAS int*)(lds + wave * 256 + 128);
    for (int it = gw; it < T * 8; it += NGW) {
        const int h = it & 7; const size_t t = (size_t)(it >> 3);
#pragma unroll 1
        for (int p = 0; p < 2; ++p) {
            const bf16_t* qp = Q2 + t * PQ + h * 256 + p * 128;
            const bf16_t* k0 = SK + ((size_t)(h * 2 + p) * 128 + lane) * 128;
            const bf16_t* k1 = k0 + 64 * 128;
            float s0 = 0.f, s1 = 0.f;
#pragma unroll
            for (int i = 0; i < 16; ++i) { const u32x4 qv = *(const u32x4*)(qp + 8 * i); s0 = dot8(qv, *(const u32x4*)(k0 + 8 * i), s0); s1 = dot8(qv, *(const u32x4*)(k1 + 8 * i), s1); }
#pragma unroll 1
            for (int r = 0; r < 16; ++r) {
                const float wm = wave_max(fmaxf(s0, s1));
                const unsigned long long b0 = __ballot(s0 == wm), b1 = __ballot(s1 == wm);
                const int n = b0 ? (__ffsll((long long)b0) - 1) : (64 + __ffsll((long long)b1) - 1);
                if (lane == 0) { ls_s[p * 16 + r] = wm; ls_i[p * 16 + r] = n; }
                if (n == lane) s0 = -INFINITY;
                if (n == lane + 64) s1 = -INFINITY;
            }
        }
        asm volatile("s_waitcnt lgkmcnt(0)" ::: "memory");
        const int ci = lane >> 2, cj = (lane & 3) * 4;
        const float av = ls_s[ci];
        float cand[4];
#pragma unroll
        for (int k = 0; k < 4; ++k) cand[k] = av + ls_s[16 + cj + k];
        float my_s = 0.f; int my_flat = 0; float smax = 0.f;
#pragma unroll 1
        for (int r = 0; r < 16; ++r) {
            const float best = fmaxf(fmaxf(cand[0], cand[1]), fmaxf(cand[2], cand[3]));
            const float wm = wave_max(best);
            const unsigned long long bal = __ballot(best == wm);
            const int wl = __ffsll((long long)bal) - 1;
            const int kk = (cand[0] == wm) ? 0 : (cand[1] == wm) ? 1 : (cand[2] == wm) ? 2 : 3;
            const int flat_w = __shfl(lane * 4 + kk, wl);
            if (lane == wl) {
#pragma unroll
                for (int k = 0; k < 4; ++k) if (kk == k) cand[k] = -INFINITY;
            }
            if (lane == r) { my_s = wm; my_flat = flat_w; }
            if (r == 0) smax = wm;
        }
        const float e = lane < 16 ? __expf(my_s - smax) : 0.f;
        const float den = wave_sum(e);
        if (lane < 16) {
            const int ia = ls_i[my_flat >> 4], ib = ls_i[16 + (my_flat & 15)];
            IDX[t * 128 + h * 16 + lane] = ia * 128 + ib;
            GATE[t * 128 + h * 16 + lane] = e / den;
        }
        asm volatile("s_waitcnt lgkmcnt(0)" ::: "memory");
    }
}

__device__ __forceinline__ void ph_peer(const KArgs& a, int l, const float* mod_l) {
    int tid_op = threadIdx.x; asm volatile("" : "+v"(tid_op)); const int tid = tid_op, lane = tid & 63, wave = tid >> 6;
    const int gw = blockIdx.x * NWAVES + wave, NGW = gridDim.x * NWAVES;
    const unsigned char* UQ = a.ws + WS_UQ + (size_t)l * NEXP * 1024; const unsigned char* VQ = a.ws + WS_VQ + (size_t)l * NEXP * 1024;
    const float* USC = (const float*)(a.ws + WS_USC) + l * NEXP; const float* VSC = (const float*)(a.ws + WS_VSC) + l * NEXP;
    const int* IDX = (const int*)(a.ws + WS_IDX); const float* GATE = (const float*)(a.ws + WS_GATE);
    const unsigned char* HQ = a.ws + WS_H2Q; const float* HS = (const float*)(a.ws + WS_HS);
    for (int t = gw; t < T; t += NGW) {
        const int b = t >> 12;
        const u32x4 hv = *(const u32x4*)(HQ + (size_t)t * 1024 + 16 * lane);
        const float sh = HS[t];
        const int idx0 = IDX[(size_t)t * 128 + lane], idx1 = IDX[(size_t)t * 128 + 64 + lane];
        float coef0 = 0.f, coef1 = 0.f;
#pragma unroll 1
        for (int kb = 0; kb < 8; ++kb) {
            u32x4 uv[16]; int ee[16];
#pragma unroll
            for (int kk = 0; kk < 16; ++kk) { const int k = kb * 16 + kk; ee[kk] = __shfl(k < 64 ? idx0 : idx1, k & 63); uv[kk] = *(const u32x4*)(UQ + (size_t)ee[kk] * 1024 + 16 * lane); }
#pragma unroll
            for (int kk = 0; kk < 16; ++kk) {
                const int k = kb * 16 + kk;
                int is = __builtin_amdgcn_sdot4((int)uv[kk].x, (int)hv.x, 0, false);
                is = __builtin_amdgcn_sdot4((int)uv[kk].y, (int)hv.y, is, false);
                is = __builtin_amdgcn_sdot4((int)uv[kk].z, (int)hv.z, is, false);
                is = __builtin_amdgcn_sdot4((int)uv[kk].w, (int)hv.w, is, false);
                const float d = wave_sum((float)is) * USC[ee[kk]] * sh;
                const float act = 0.5f * d * (1.0f + erff(d * 0.70710678118654752f));
                if ((k & 63) == lane) { if (k < 64) coef0 = act; else coef1 = act; }
            }
        }
        coef0 *= GATE[(size_t)t * 128 + lane] * VSC[idx0];
        coef1 *= GATE[(size_t)t * 128 + 64 + lane] * VSC[idx1];
        float acc[16], csum = 0.f;
#pragma unroll
        for (int i = 0; i < 16; ++i) acc[i] = 0.f;
#pragma unroll 1
        for (int kb = 0; kb < 16; ++kb) {
            u32x4 vv[8]; float cc[8];
#pragma unroll
            for (int kk = 0; kk < 8; ++kk) { const int k = kb * 8 + kk; const int e = __shfl(k < 64 ? idx0 : idx1, k & 63); cc[kk] = __shfl(k < 64 ? coef0 : coef1, k & 63); vv[kk] = *(const u32x4*)(VQ + (size_t)e * 1024 + 16 * lane); }
#pragma unroll
            for (int kk = 0; kk < 8; ++kk) {
                csum += cc[kk];
#pragma unroll
                for (int i = 0; i < 4; ++i) { const unsigned w = vv[kk][i];
                    acc[4 * i + 0] = fmaf(cc[kk], (float)(w & 0xffu), acc[4 * i + 0]); acc[4 * i + 1] = fmaf(cc[kk], (float)((w >> 8) & 0xffu), acc[4 * i + 1]);
                    acc[4 * i + 2] = fmaf(cc[kk], (float)((w >> 16) & 0xffu), acc[4 * i + 2]); acc[4 * i + 3] = fmaf(cc[kk], (float)(w >> 24), acc[4 * i + 3]); }
            }
        }
        const float off = 128.0f * csum;
#pragma unroll
        for (int i = 0; i < 4; ++i) {
            const int col = 256 * i + 4 * lane;
            const f32x4 g = *(const f32x4*)(mod_l + (size_t)b * NMOD + 5 * DM + col);
            f32x4 xv = *(const f32x4*)(a.out + (size_t)t * DM + col);
            xv.x += g.x * (acc[4 * i + 0] - off); xv.y += g.y * (acc[4 * i + 1] - off); xv.z += g.z * (acc[4 * i + 2] - off); xv.w += g.w * (acc[4 * i + 3] - off);
            *(f32x4*)(a.out + (size_t)t * DM + col) = xv;
        }
    }
}

constexpr int PH_PER_LAYER = 9, NPHASES = 1 + DEPTH * PH_PER_LAYER + 1;
#ifndef PHASE_MASK
#define PHASE_MASK 0xFFFF
#endif
#define HASP(k) (((PHASE_MASK) >> (k)) & 1)
#ifndef SB_EARLY_EXIT
#define SB_EARLY_EXIT 0
#endif

__global__ void __launch_bounds__(NTHREADS, 2) fwd_kernel(KArgs a) {
    extern __shared__ __attribute__((aligned(16))) unsigned char lds_raw[];
    LAS unsigned char* lds = (LAS unsigned char*)lds_raw;
    cg::grid_group grid = cg::this_grid();
    unsigned char* ws = a.ws;
    const int G = gridDim.x;
#define IN(k) (a.ph_lo <= (k) && (k) < a.ph_hi)
#define SEAM(k) do { if (IN(k) && IN((k) + 1)) grid.sync(); } while (0)
    if (IN(0)) { if (HASP(0)) ph_prologue(a, lds); }
    SEAM(0);
#pragma unroll 1
    for (int l = 0; l < DEPTH; ++l) {
        const int p0 = 1 + l * PH_PER_LAYER;
        const float* mod_l = (const float*)(ws + WS_MOD) + (size_t)l * 8 * NMOD;
        const float* xcur = (l == 0) ? a.x : a.out;
        if (IN(p0 + 0)) { if (HASP(1)) ph_norm<false>(a, xcur, a.norm1_g + l * DM, mod_l, 0, 1); }
        SEAM(p0 + 0);
        if (IN(p0 + 1)) { if (HASP(2)) { pg8::Gemm g{(const bf16_t*)(ws + WS_H), (const bf16_t*)(ws + WS_WIN) + (size_t)l * NPROJ * 1024, T, NPROJ, 1024};
                  pg8::StaticOrder S; S.init(T, NPROJ, G, (int)blockIdx.x); EpiProj E{ws};
                  pg8::gemm_phase<EpiProj, pg8::StaticOrder, true, true>(lds, g, S, E); } }
        SEAM(p0 + 1);
        if (IN(p0 + 2)) { if (HASP(3)) { ph_attn_swa(a, l); ph_attn_sb<SB_EARLY_EXIT != 0>(a); } }
        SEAM(p0 + 2);
        if (IN(p0 + 3)) { if (HASP(4)) { pg8::StaticOrder S; S.init(T, DM, G, (int)blockIdx.x);
                  { pg8::Gemm g{(const bf16_t*)(ws + WS_QA), (const bf16_t*)(ws + WS_WBA) + (size_t)l * 1024 * 512, T, DM, 512};
                    EpiBranch<false> E{(const bf16_t*)(ws + WS_GA), (bf16_t*)(ws + WS_H)};
                    pg8::gemm_phase<EpiBranch<false>, pg8::StaticOrder, true, true>(lds, g, S, E); }
                  __syncthreads();
                  { pg8::Gemm g{(const bf16_t*)(ws + WS_QB), (const bf16_t*)(ws + WS_WBB) + (size_t)l * 1024 * 512, T, DM, 512};
                    EpiBranch<true> E{(const bf16_t*)(ws + WS_GB), (bf16_t*)(ws + WS_H)};
                    pg8::gemm_phase<EpiBranch<true>, pg8::StaticOrder, true, true>(lds, g, S, E); } } }
        SEAM(p0 + 3);
        if (IN(p0 + 4)) { if (HASP(5)) { pg8::Gemm g{(const bf16_t*)(ws + WS_H), (const bf16_t*)(ws + WS_WOUT) + (size_t)l * 1024 * 1024, T, DM, 1024};
                  pg8::StaticOrder S; S.init(T, DM, G, (int)blockIdx.x); EpiWout E{xcur, a.out, mod_l + 2 * DM};
                  pg8::gemm_phase<EpiWout, pg8::StaticOrder, true, true>(lds, g, S, E); } }
        SEAM(p0 + 4);
        if (IN(p0 + 5)) { if (HASP(6)) ph_norm<true>(a, a.out, a.norm2_g + l * DM, mod_l, 3, 4); }
        SEAM(p0 + 5);
        if (IN(p0 + 6)) { if (HASP(7)) { pg8::Gemm g{(const bf16_t*)(ws + WS_H), (const bf16_t*)(ws + WS_WQ) + (size_t)l * PQ * 1024, T, PQ, 1024};
                  pg8::StaticOrder S; S.init(T, PQ, G, (int)blockIdx.x); EpiPlainBf16 E{(bf16_t*)(ws + WS_Q2), PQ};
                  pg8::gemm_phase<EpiPlainBf16, pg8::StaticOrder, true, true>(lds, g, S, E); } }
        SEAM(p0 + 6);
        if (IN(p0 + 7)) { if (HASP(8)) ph_topk(a, l, lds); }
        SEAM(p0 + 7);
        if (IN(p0 + 8)) { if (HASP(9)) ph_peer(a, l, mod_l); }
        SEAM(p0 + 8);
    }
    if (IN(NPHASES - 1)) { if (HASP(10)) ph_final_norm(a); }
#undef IN
#undef SEAM
}

#ifndef N_LAUNCH_SPLIT
#define N_LAUNCH_SPLIT 1
#endif
extern "C" void kernel_launch(void* const* d_in, const int* in_sizes, int n_in, void* d_out, int out_size, void* d_ws, size_t ws_size, hipStream_t stream) {
    static int grid = 0;
    if (grid == 0) {
        if (n_in != 17 || out_size != T * DM || ws_size < WS_END) { fprintf(stderr, "kernel_launch: unexpected problem (n_in %d out %d ws %zu)\n", n_in, out_size, ws_size); grid = -1; return; }
        int dev = 0, cus = 0, per_cu = 0;
        (void)hipGetDevice(&dev);
        (void)hipDeviceGetAttribute(&cus, hipDeviceAttributeMultiprocessorCount, dev);
        (void)hipFuncSetAttribute((const void*)fwd_kernel, hipFuncAttributeMaxDynamicSharedMemorySize, LDS_BYTES);
        (void)hipOccupancyMaxActiveBlocksPerMultiprocessor(&per_cu, (const void*)fwd_kernel, NTHREADS, LDS_BYTES);
        if (per_cu < 1) { fprintf(stderr, "kernel_launch: occupancy query says %d\n", per_cu); per_cu = 1; }
        grid = cus;
        fprintf(stderr, "kernel_launch: cus %d per_cu %d grid %d ws %zu\n", cus, per_cu, grid, ws_size);
    }
    if (grid < 0) return;
    KArgs a{};
    a.x = (const float*)d_in[0]; a.c = (const float*)d_in[1]; a.pos = (const int*)d_in[2]; a.ada_w = (const float*)d_in[3]; a.ada_b = (const float*)d_in[4];
    a.norm1_g = (const float*)d_in[5]; a.w_in = (const float*)d_in[6]; a.sinks = (const float*)d_in[7]; a.wbr_a = (const float*)d_in[8]; a.wbr_b = (const float*)d_in[9];
    a.w_out = (const float*)d_in[10]; a.norm2_g = (const float*)d_in[11]; a.wq = (const float*)d_in[12]; a.subkeys = (const float*)d_in[13]; a.pu = (const float*)d_in[14];
    a.pv = (const float*)d_in[15]; a.final_g = (const float*)d_in[16]; a.out = (float*)d_out; a.ws = (unsigned char*)d_ws;
#if N_LAUNCH_SPLIT
    a.ph_lo = 0; a.ph_hi = NPHASES;
    { void* args[] = {&a};
      hipError_t e = hipLaunchCooperativeKernel((void*)fwd_kernel, dim3(grid), dim3(NTHREADS), args, LDS_BYTES, stream);
      if (e != hipSuccess) fprintf(stderr, "cooperative launch failed: %s (grid %d)\n", hipGetErrorString(e), grid); }
#else
    for (int ph = 0; ph < NPHASES; ++ph) {
        a.ph_lo = ph; a.ph_hi = ph + 1;
        void* args[] = {&a};
        hipError_t e = hipLaunchCooperativeKernel((void*)fwd_kernel, dim3(grid), dim3(NTHREADS), args, LDS_BYTES, stream);
        if (e != hipSuccess) { fprintf(stderr, "cooperative launch %d failed: %s (grid %d)\n", ph, hipGetErrorString(e), grid); break; }
    }
#endif
}
```

```cpp
#include <hip/hip_runtime.h>
#include <hip/hip_cooperative_groups.h>
#include <cstdio>
#include <cstdint>
namespace cg = cooperative_groups;

namespace pg8 {
#define PG8_LAS __attribute__((address_space(3)))
typedef unsigned short bf16_t;
typedef short bf16x8 __attribute__((ext_vector_type(8)));
typedef float f32x4 __attribute__((ext_vector_type(4)));
typedef unsigned u32x4 __attribute__((ext_vector_type(4)));
constexpr int BM = 256, BK = 64, HALF = 128, HTB = HALF * BK * 2  , STAGE_BYTES = 8 * HTB, NXCD = 8, WGM = 8;

__host__ __device__ __forceinline__ int lds_byte(int r, int c) { const int st = (r >> 4) * 2 + (c >> 5), rr = r & 15, cc = c & 31, ob = rr * 64 + cc * 2; return st * 1024 + (ob ^ (((ob >> 9) & 1) << 5)); }
__host__ __device__ __forceinline__ void stage_rc(int b, int& R, int& C) { const int st = b / 1024, sb = b % 1024, swz = sb ^ (((sb >> 9) & 1) << 5); R = (st >> 1) * 16 + swz / 64; C = (st & 1) * 32 + (swz % 64) / 2; }
__host__ __device__ __forceinline__ int perm32(int rho) { const int n = rho >> 4, i = rho & 15; return 8 * (i >> 2) + 4 * n + (i & 3); }

struct Unit { int pm, pn; };
struct Gemm { const bf16_t* A; const bf16_t* Bt; int M, N, K; };

struct StaticOrder {
    int nM, nN, nwg, G, c;
    __host__ __device__ void init(int M, int N, int G_, int c_) { nM = M / BM; nN = N / BM; nwg = nM * nN; G = G_; c = c_; }
    __host__ __device__ bool next(int i, Unit& u) const {
        const long L = (long)i * G + c; if (L >= nwg) return false;
        int wgid = (int)L; { const int q = nwg / NXCD, r = nwg % NXCD, xcd = wgid % NXCD, off = wgid / NXCD; wgid = (xcd < r ? xcd * (q + 1) : r * (q + 1) + (xcd - r) * q) + off; }
        const int nig = WGM * nN, gid = wgid / nig, fm = gid * WGM, gsz = (nM - fm) < WGM ? (nM - fm) : WGM;
        u.pm = fm + ((wgid % nig) % gsz); u.pn = (wgid % nig) / gsz; return true;
    }
    __device__ __forceinline__ void a_ready(const Unit&) const {}
    __device__ __forceinline__ void done(const Unit&) const {}
};


__device__ __forceinline__ unsigned cvt_pk_bf16(float lo, float hi) { unsigned r; asm volatile("v_cvt_pk_bf16_f32 %0, %1, %2" : "=v"(r) : "v"(lo), "v"(hi)); return r; }
template <class Epi, class Sched, bool ALIGN_EPI = false, bool SP2 = false>
__device__ __forceinline__ void gemm_phase(PG8_LAS unsigned char* lds, const Gemm g, const Sched& S, const Epi& E) {
    int tid_op = threadIdx.x; asm volatile("" : "+v"(tid_op));
    const int tid = tid_op, wid = __builtin_amdgcn_readfirstlane(tid >> 6), lane = tid & 63, wr = wid >> 2, wc = wid & 3, fr = lane & 15, fq = lane >> 4;
    const int K = g.K, nt = K / BK;
    unsigned voffA[2], voffB[2];
#pragma unroll
    for (int i = 0; i < 2; ++i) { int R, C; stage_rc(tid * 16 + i * 8192, R, C); const int Rb = Epi::PERM ? ((R & ~31) + perm32(R & 31)) : R;
        voffA[i] = (unsigned)(R * K + C) * 2u; voffB[i] = (unsigned)(Rb * K + C) * 2u; }
    const size_t kstep = (size_t)(BK * 2);
    const size_t hstep = (size_t)HALF * K * 2;
    const size_t tstep = 2 * hstep;
    const unsigned ldsw = (unsigned)wid * 1024u;
    const int aoff = lds_byte(wr * 64 + fr, fq * 8), boff = lds_byte(wc * 32 + fr, fq * 8);
#define PG8_SA(b, h) (((b) * 2 + (h)) * HTB)
#define PG8_SB(b, h) ((4 + (b) * 2 + (h)) * HTB)
#define PG8_STAGE(bufoff, gbase, voff) do { _Pragma("unroll") for (int _i = 0; _i < 2; ++_i) \
        __builtin_amdgcn_global_load_lds((const unsigned*)((const char*)(gbase) + (voff)[_i]), (PG8_LAS unsigned*)(lds + (bufoff) + ldsw + _i * 8192), 16, 0, 0); } while (0)
#define PG8_LDA(dst, b, h) do { _Pragma("unroll") for (int m = 0; m < 4; ++m) _Pragma("unroll") for (int k = 0; k < 2; ++k) dst[m][k] = *(const PG8_LAS bf16x8*)(lds + PG8_SA(b, h) + aoff + m * 2048 + k * 1024); } while (0)
#define PG8_LDB(dst, b, h) do { _Pragma("unroll") for (int n = 0; n < 2; ++n) _Pragma("unroll") for (int k = 0; k < 2; ++k) dst[n][k] = *(const PG8_LAS bf16x8*)(lds + PG8_SB(b, h) + boff + n * 2048 + k * 1024); } while (0)
#define PG8_MMA(ai, bj, At, Bt) do { __builtin_amdgcn_s_setprio(1); _Pragma("unroll") for (int m = 0; m < 4; ++m) _Pragma("unroll") for (int n = 0; n < 2; ++n) _Pragma("unroll") for (int k = 0; k < 2; ++k) \
        acc[ai][bj][m][n] = __builtin_amdgcn_mfma_f32_16x16x32_bf16(Bt[n][k], At[m][k], acc[ai][bj][m][n], 0, 0, 0); __builtin_amdgcn_s_setprio(0); } while (0)
#define PG8_WAIT_V(n) asm volatile("s_waitcnt vmcnt(" #n ")" ::: "memory")
#define PG8_WAIT_L(n) asm volatile("s_waitcnt lgkmcnt(" #n ")" ::: "memory")
#define PG8_BAR __builtin_amdgcn_s_barrier()
#define PG8_SCHED __builtin_amdgcn_sched_barrier(0)
    Unit cur, nxt; int ui = 0;
    if (!S.next(0, cur)) return;
    f32x4 acc[2][2][4][2];
#pragma unroll
    for (int a = 0; a < 2; ++a)
#pragma unroll
        for (int b = 0; b < 2; ++b)
#pragma unroll
            for (int m = 0; m < 4; ++m)
#pragma unroll
                for (int n = 0; n < 2; ++n) acc[a][b][m][n] = (f32x4){0.f, 0.f, 0.f, 0.f};
    bf16x8 At[4][2], B0[2][2], B1[2][2];
    const char* cA = (const char*)g.A + (size_t)cur.pm * tstep; const char* cB = (const char*)g.Bt + (size_t)cur.pn * tstep;
    S.a_ready(cur);
    if constexpr (SP2) {
        PG8_STAGE(PG8_SB(0, 0), cB, voffB); PG8_STAGE(PG8_SB(0, 1), cB + hstep, voffB); PG8_STAGE(PG8_SA(0, 0), cA, voffA); PG8_STAGE(PG8_SA(0, 1), cA + hstep, voffA);
        if (wr == 1) PG8_BAR;
        PG8_WAIT_V(2); PG8_BAR;
        PG8_STAGE(PG8_SB(1, 0), cB + kstep, voffB); PG8_STAGE(PG8_SA(1, 0), cA + kstep, voffA); PG8_STAGE(PG8_SB(1, 1), cB + hstep + kstep, voffB);
        PG8_WAIT_V(6); PG8_BAR;
    } else {
        PG8_STAGE(PG8_SB(0, 0), cB, voffB); PG8_STAGE(PG8_SA(0, 0), cA, voffA); PG8_STAGE(PG8_SB(0, 1), cB + hstep, voffB); PG8_STAGE(PG8_SA(0, 1), cA + hstep, voffA);
        if (wr == 1) PG8_BAR;
        PG8_WAIT_V(4); PG8_BAR;
        PG8_STAGE(PG8_SB(1, 0), cB + kstep, voffB); PG8_STAGE(PG8_SA(1, 0), cA + kstep, voffA); PG8_STAGE(PG8_SB(1, 1), cB + hstep + kstep, voffB);
        PG8_WAIT_V(6); PG8_BAR;
    }
    for (;;) {
        const bool has_next = S.next(ui + 1, nxt);
        const char* nA = has_next ? (const char*)g.A + (size_t)nxt.pm * tstep : cA; const char* nB = has_next ? (const char*)g.Bt + (size_t)nxt.pn * tstep : cB;
        for (int t = 0; t < nt; t += 2) {
            const bool last = (t == nt - 2);
            const char* a1 = cA + (size_t)(t + 1) * kstep;
            const char* a2 = last ? nA : cA + (size_t)(t + 2) * kstep; const char* b2 = last ? nB : cB + (size_t)(t + 2) * kstep;
            const char* a3 = a2 + kstep; const char* b3 = b2 + kstep;
            if (last && has_next) S.a_ready(nxt);
            if constexpr (SP2) {
            PG8_LDB(B0, 0, 0); PG8_LDB(B1, 0, 1); PG8_SCHED; PG8_LDA(At, 0, 0); PG8_STAGE(PG8_SA(1, 1), a1 + hstep, voffA);
            PG8_WAIT_V(8); PG8_WAIT_L(0); PG8_BAR; PG8_MMA(0, 0, At, B0); PG8_MMA(0, 1, At, B1); PG8_BAR; PG8_SCHED;
            PG8_LDA(At, 0, 1); PG8_STAGE(PG8_SB(0, 0), b2, voffB); PG8_STAGE(PG8_SB(0, 1), b2 + hstep, voffB); PG8_STAGE(PG8_SA(0, 0), a2, voffA);
            PG8_WAIT_V(8); PG8_WAIT_L(0); PG8_BAR; PG8_MMA(1, 0, At, B0); PG8_MMA(1, 1, At, B1); PG8_BAR; PG8_SCHED;
            PG8_LDB(B0, 1, 0); PG8_LDB(B1, 1, 1); PG8_SCHED; PG8_LDA(At, 1, 0); PG8_STAGE(PG8_SA(0, 1), a2 + hstep, voffA);
            PG8_WAIT_V(8); PG8_WAIT_L(0); PG8_BAR; PG8_MMA(0, 0, At, B0); PG8_MMA(0, 1, At, B1); PG8_BAR; PG8_SCHED;
            PG8_LDA(At, 1, 1); PG8_STAGE(PG8_SB(1, 0), b3, voffB); PG8_STAGE(PG8_SB(1, 1), b3 + hstep, voffB); PG8_STAGE(PG8_SA(1, 0), a3, voffA);
            PG8_WAIT_V(8); PG8_WAIT_L(0); PG8_BAR; PG8_MMA(1, 0, At, B0); PG8_MMA(1, 1, At, B1); PG8_BAR; PG8_SCHED;
            } else {
            PG8_LDB(B0, 0, 0); PG8_SCHED; PG8_LDA(At, 0, 0); PG8_STAGE(PG8_SA(1, 1), a1 + hstep, voffA);
            PG8_WAIT_L(8); PG8_BAR; PG8_WAIT_L(0); PG8_MMA(0, 0, At, B0); PG8_BAR; PG8_SCHED;
            PG8_LDB(B1, 0, 1); PG8_STAGE(PG8_SB(0, 0), b2, voffB);
            PG8_BAR; PG8_WAIT_L(0); PG8_MMA(0, 1, At, B1); PG8_BAR;
            PG8_LDA(At, 0, 1); PG8_STAGE(PG8_SA(0, 0), a2, voffA);
            PG8_BAR; PG8_WAIT_L(0); PG8_MMA(1, 0, At, B0); PG8_BAR; PG8_SCHED;
            PG8_STAGE(PG8_SB(0, 1), b2 + hstep, voffB);
            PG8_WAIT_V(6); PG8_BAR; PG8_MMA(1, 1, At, B1); PG8_BAR;
            PG8_LDB(B0, 1, 0); PG8_SCHED; PG8_LDA(At, 1, 0); PG8_STAGE(PG8_SA(0, 1), a2 + hstep, voffA);
            PG8_WAIT_L(8); PG8_BAR; PG8_WAIT_L(0); PG8_MMA(0, 0, At, B0); PG8_BAR; PG8_SCHED;
            PG8_LDB(B1, 1, 1); PG8_STAGE(PG8_SB(1, 0), b3, voffB);
            PG8_BAR; PG8_WAIT_L(0); PG8_MMA(0, 1, At, B1); PG8_BAR;
            PG8_LDA(At, 1, 1); PG8_STAGE(PG8_SA(1, 0), a3, voffA);
            PG8_BAR; PG8_WAIT_L(0); PG8_MMA(1, 0, At, B0); PG8_BAR; PG8_SCHED;
            PG8_STAGE(PG8_SB(1, 1), b3 + hstep, voffB);
            PG8_WAIT_V(6); PG8_BAR; PG8_MMA(1, 1, At, B1); PG8_BAR;
            }
        }
        if constexpr (ALIGN_EPI) { if (wr == 0) PG8_BAR; }
        if constexpr (!Epi::AFTER_DRAIN) { E(acc, cur, wr, wc, fr, fq); S.done(cur); }
        if (!has_next) break;
#pragma unroll
        for (int a = 0; a < 2; ++a)
#pragma unroll
            for (int b = 0; b < 2; ++b)
#pragma unroll
                for (int m = 0; m < 4; ++m)
#pragma unroll
                    for (int n = 0; n < 2; ++n) acc[a][b][m][n] = (f32x4){0.f, 0.f, 0.f, 0.f};
        cur = nxt; cA = nA; cB = nB; ++ui;
        if constexpr (ALIGN_EPI) { if (wr == 1) PG8_BAR; }
    }
    PG8_WAIT_V(0);
    if constexpr (!ALIGN_EPI) { if (wr == 0) PG8_BAR; }
    PG8_BAR;
    if constexpr (Epi::AFTER_DRAIN) { E.fused(acc, cur, wr, wc, fr, fq, lds, wid, lane); S.done(cur); }
#undef PG8_SA
#undef PG8_SB
#undef PG8_STAGE
#undef PG8_LDA
#undef PG8_LDB
#undef PG8_MMA
#undef PG8_WAIT_V
#undef PG8_WAIT_L
#undef PG8_BAR
#undef PG8_SCHED
}
}


#define LAS __attribute__((address_space(3)))
typedef unsigned short bf16_t;
typedef float f32x4 __attribute__((ext_vector_type(4)));
typedef unsigned u32x4 __attribute__((ext_vector_type(4)));
typedef unsigned u32x2 __attribute__((ext_vector_type(2)));

constexpr int BATCH = 8, SEQ = 4096, DM = 1024, T = BATCH * SEQ, DEPTH = 2;
constexpr int NPROJ = 4352, NMOD = 6 * DM;
constexpr int NEXP = 16384, PQ = 2048;
constexpr float NORM_EPS = 1e-6f;
constexpr float LOG2E = 1.4426950408889634f;
constexpr float QSCALE = 0.125f * LOG2E;
constexpr float SB_EXIT = 160.0f;

constexpr size_t MiB = 1u << 20;
constexpr size_t WS_CTL = 0;
constexpr size_t WS_MOD = 1 * MiB;
constexpr size_t WS_ROPE = 2 * MiB;
constexpr size_t WS_WIN = 10 * MiB;
constexpr size_t WS_WBA = 27 * MiB;
constexpr size_t WS_WBB = 29 * MiB;
constexpr size_t WS_WOUT = 31 * MiB;
constexpr size_t WS_WQ = 35 * MiB;
constexpr size_t WS_SK = 43 * MiB;
constexpr size_t WS_UQ = 44 * MiB;
constexpr size_t WS_VQ = 76 * MiB;
constexpr size_t WS_USC = 108 * MiB;
constexpr size_t WS_VSC = 108 * MiB + 256 * 1024;
constexpr size_t WS_HS = 109 * MiB;
constexpr size_t WS_H = 112 * MiB;
constexpr size_t WS_QA = 176 * MiB;
constexpr size_t WS_QB = 208 * MiB;
constexpr size_t WS_KB = 240 * MiB;
constexpr size_t WS_VB = 272 * MiB;
constexpr size_t WS_KA = 304 * MiB;
constexpr size_t WS_VA = 312 * MiB;
constexpr size_t WS_GA = 320 * MiB;
constexpr size_t WS_GB = 384 * MiB;
constexpr size_t WS_END = 448 * MiB;
constexpr size_t WS_H2Q = WS_QA, WS_IDX = WS_KB, WS_GATE = WS_VB, WS_Q2 = WS_GA;

constexpr int LDS_BYTES = 147456;
constexpr int NTHREADS = 512, NWAVES = 8;

struct KArgs {
    const float* x; const float* c; const int* pos; const float* ada_w; const float* ada_b; const float* norm1_g; const float* w_in; const float* sinks;
    const float* wbr_a; const float* wbr_b; const float* w_out; const float* norm2_g; const float* wq; const float* subkeys; const float* pu; const float* pv; const float* final_g;
    float* out; unsigned char* ws; int ph_lo, ph_hi;
};

__device__ __forceinline__ unsigned f2bf(float f) { unsigned u = __float_as_uint(f); return (u + 0x7fffu + ((u >> 16) & 1u)) >> 16; }
__device__ __forceinline__ unsigned pk2(float lo, float hi) { return f2bf(lo) | (f2bf(hi) << 16); }
__device__ __forceinline__ float bflo(unsigned w) { return __uint_as_float(w << 16); }
__device__ __forceinline__ float bfhi(unsigned w) { return __uint_as_float(w & 0xffff0000u); }
__device__ __forceinline__ float wave_sum(float v) {
#pragma unroll
    for (int o = 1; o < 64; o <<= 1) v += __shfl_xor(v, o);
    return v;
}
__device__ __forceinline__ float wave_max(float v) {
#pragma unroll
    for (int o = 1; o < 64; o <<= 1) v = fmaxf(v, __shfl_xor(v, o));
    return v;
}
__device__ __forceinline__ float dot8(u32x4 a, u32x4 b, float acc) {
    acc = fmaf(bflo(a.x), bflo(b.x), acc); acc = fmaf(bfhi(a.x), bfhi(b.x), acc);
    acc = fmaf(bflo(a.y), bflo(b.y), acc); acc = fmaf(bfhi(a.y), bfhi(b.y), acc);
    acc = fmaf(bflo(a.z), bflo(b.z), acc); acc = fmaf(bfhi(a.z), bfhi(b.z), acc);
    acc = fmaf(bflo(a.w), bflo(b.w), acc); acc = fmaf(bfhi(a.w), bfhi(b.w), acc);
    return acc;
}
__device__ __forceinline__ float softplus2(float z2) {
    return fmaxf(z2, 0.f) + __log2f(1.0f + exp2f(-fabsf(z2)));
}

__device__ __forceinline__ int win_pos(int n) {
    if (n >= 640) return n;
    const int hb = n & ~63, d = n & 63;
    return hb + (d < 32 ? 2 * d : 2 * (d - 32) + 1);
}
template <bool WIN>
__device__ __forceinline__ void transpose_item(const float* W, int K, int N, bf16_t* WT, LAS float* scr, int item, int lane) {
    const int nblk = N / 32, kb = item / nblk, nb = item % nblk, k0 = 64 * kb, n0 = 32 * nb;
#pragma unroll 8
    for (int i = 0; i < 32; ++i) { const int kk = 2 * i + (lane >> 5); scr[kk * 33 + (lane & 31)] = W[(size_t)(k0 + kk) * N + n0 + (lane & 31)]; }
    asm volatile("s_waitcnt lgkmcnt(0)" ::: "memory");
    const int c = lane & 7;
#pragma unroll
    for (int j = 0; j < 4; ++j) { const int n = (lane >> 3) + 8 * j; const LAS float* s = scr + (8 * c) * 33 + n;
        u32x4 o; o.x = pk2(s[0 * 33], s[1 * 33]); o.y = pk2(s[2 * 33], s[3 * 33]); o.z = pk2(s[4 * 33], s[5 * 33]); o.w = pk2(s[6 * 33], s[7 * 33]);
        const int row = WIN ? win_pos(n0 + n) : (n0 + n);
        *(u32x4*)(WT + (size_t)row * K + k0 + 8 * c) = o; }
    asm volatile("s_waitcnt lgkmcnt(0)" ::: "memory");
}
template <bool OFFSET128>
__device__ __forceinline__ void quant_row(const f32x4 (&v)[4], unsigned char* dst_row, float* scale_out, int lane) {
    float am = 0.f;
#pragma unroll
    for (int i = 0; i < 4; ++i) am = fmaxf(am, fmaxf(fmaxf(fabsf(v[i].x), fabsf(v[i].y)), fmaxf(fabsf(v[i].z), fabsf(v[i].w))));
    am = wave_max(am);
    const float inv = am > 0.f ? 127.0f / am : 0.f, sc = am > 0.f ? am / 127.0f : 1.0f;
    u32x4 o;
#pragma unroll
    for (int i = 0; i < 4; ++i) {
        int q0 = (int)rintf(v[i].x * inv), q1 = (int)rintf(v[i].y * inv), q2 = (int)rintf(v[i].z * inv), q3 = (int)rintf(v[i].w * inv);
        if (OFFSET128) { q0 += 128; q1 += 128; q2 += 128; q3 += 128; }
        o[i] = (unsigned)(q0 & 0xff) | ((unsigned)(q1 & 0xff) << 8) | ((unsigned)(q2 & 0xff) << 16) | ((unsigned)(q3 & 0xff) << 24);
    }
    *(u32x4*)(dst_row + 16 * lane) = o;
    if (lane == 0) *scale_out = sc;
}

__device__ __forceinline__ void ph_prologue(const KArgs& a, LAS unsigned char* lds) {
    int tid_op = threadIdx.x; asm volatile("" : "+v"(tid_op)); const int tid = tid_op, lane = tid & 63, wave = tid >> 6, G = gridDim.x;
    const int gw = blockIdx.x * NWAVES + wave, NGW = G * NWAVES;
    unsigned char* ws = a.ws;
    {
        LAS float* sc = (LAS float*)lds;
        for (int it = blockIdx.x; it < DEPTH * 12; it += G) {
            for (int idx = tid; idx < 8192; idx += NTHREADS) { const int b = idx >> 10, i = idx & 1023; const float cv = a.c[b * 1024 + i]; sc[i * 8 + b] = cv / (1.0f + __expf(-cv)); }
            __syncthreads();
            const int l = it / 12, j = (it % 12) * 512 + tid;
            const float* wp = a.ada_w + (size_t)l * 1024 * NMOD + j;
            float acc[8];
#pragma unroll
            for (int b = 0; b < 8; ++b) acc[b] = 0.f;
#pragma unroll 4
            for (int i = 0; i < 1024; ++i) {
                const float w = wp[(size_t)i * NMOD];
                const f32x4 s0 = *(const LAS f32x4*)(sc + i * 8), s1 = *(const LAS f32x4*)(sc + i * 8 + 4);
                acc[0] = fmaf(s0.x, w, acc[0]); acc[1] = fmaf(s0.y, w, acc[1]); acc[2] = fmaf(s0.z, w, acc[2]); acc[3] = fmaf(s0.w, w, acc[3]);
                acc[4] = fmaf(s1.x, w, acc[4]); acc[5] = fmaf(s1.y, w, acc[5]); acc[6] = fmaf(s1.z, w, acc[6]); acc[7] = fmaf(s1.w, w, acc[7]);
            }
            float* mod = (float*)(ws + WS_MOD);
            const float bias = a.ada_b[l * NMOD + j];
#pragma unroll
            for (int b = 0; b < 8; ++b) mod[(size_t)(l * 8 + b) * NMOD + j] = acc[b] + bias;
            __syncthreads();
        }
    }
    {
        LAS float* scr = (LAS float*)(lds + 32768 + wave * 8448);
        constexpr int I_IN = 16 * 136, I_BR = 8 * 32, I_OUT = 16 * 32, I_Q = 16 * 64, I_L = I_IN + 2 * I_BR + I_OUT + I_Q;
        for (int it = gw; it < DEPTH * I_L; it += NGW) {
            const int l = it / I_L; int r = it % I_L;
            if (r < I_IN) { transpose_item<true>(a.w_in + (size_t)l * 1024 * NPROJ, 1024, NPROJ, (bf16_t*)(ws + WS_WIN) + (size_t)l * NPROJ * 1024, scr, r, lane); continue; } r -= I_IN;
            if (r < I_BR) { transpose_item<false>(a.wbr_a + (size_t)l * 512 * 1024, 512, 1024, (bf16_t*)(ws + WS_WBA) + (size_t)l * 1024 * 512, scr, r, lane); continue; } r -= I_BR;
            if (r < I_BR) { transpose_item<false>(a.wbr_b + (size_t)l * 512 * 1024, 512, 1024, (bf16_t*)(ws + WS_WBB) + (size_t)l * 1024 * 512, scr, r, lane); continue; } r -= I_BR;
            if (r < I_OUT) { transpose_item<false>(a.w_out + (size_t)l * 1024 * 1024, 1024, 1024, (bf16_t*)(ws + WS_WOUT) + (size_t)l * 1024 * 1024, scr, r, lane); continue; } r -= I_OUT;
            transpose_item<false>(a.wq + (size_t)l * 1024 * PQ, 1024, PQ, (bf16_t*)(ws + WS_WQ) + (size_t)l * PQ * 1024, scr, r, lane);
        }
    }
    {
        const int gt = blockIdx.x * NTHREADS + tid, NGT = G * NTHREADS;
        for (int i = gt; i < DEPTH * 8 * 2 * 128 * 128 / 8; i += NGT) {
            const f32x4 v0 = *(const f32x4*)(a.subkeys + (size_t)i * 8), v1 = *(const f32x4*)(a.subkeys + (size_t)i * 8 + 4);
            u32x4 o; o.x = pk2(v0.x, v0.y); o.y = pk2(v0.z, v0.w); o.z = pk2(v1.x, v1.y); o.w = pk2(v1.z, v1.w);
            *(u32x4*)((bf16_t*)(ws + WS_SK) + (size_t)i * 8) = o;
        }
        for (int i = gt; i < T * 32; i += NGT) {
            const int t = i >> 5, f = i & 31;
            double inv = 1.0;
            for (int k = 0; k < f; ++k) inv *= 0.7498942093324559;
            const double ang = (double)a.pos[t] * inv;
            const double kq = rint(ang * 0.63661977236758134308);
            const double r = fma(-kq, 6.123233995736766036e-17, fma(-kq, 1.57079632679489655800, ang));
            const int quad = (int)((long long)kq & 3);
            const double r2 = r * r;
            double sp = -1.0 / 1307674368000.0; sp = fma(sp, r2, 1.0 / 6227020800.0); sp = fma(sp, r2, -1.0 / 39916800.0); sp = fma(sp, r2, 1.0 / 362880.0);
            sp = fma(sp, r2, -1.0 / 5040.0); sp = fma(sp, r2, 1.0 / 120.0); sp = fma(sp, r2, -1.0 / 6.0); sp = fma(sp * r2, r, r);
            double cp = 1.0 / 20922789888000.0; cp = fma(cp, r2, -1.0 / 87178291200.0); cp = fma(cp, r2, 1.0 / 479001600.0); cp = fma(cp, r2, -1.0 / 3628800.0);
            cp = fma(cp, r2, 1.0 / 40320.0); cp = fma(cp, r2, -1.0 / 720.0); cp = fma(cp, r2, 1.0 / 24.0); cp = fma(cp, r2, -0.5); cp = fma(cp, r2, 1.0);
            const double sn = (quad == 0) ? sp : (quad == 1) ? cp : (quad == 2) ? -sp : -cp;
            const double cs = (quad == 0) ? cp : (quad == 1) ? -sp : (quad == 2) ? -cp : sp;
            float* rp = (float*)(ws + WS_ROPE) + (size_t)i * 2; rp[0] = (float)cs; rp[1] = (float)sn;
        }
    }
    for (int r = gw; r < DEPTH * 2 * NEXP; r += NGW) {
        const int tbl = r / (DEPTH * NEXP), lr = r % (DEPTH * NEXP);
        const float* src = (tbl == 0 ? a.pu : a.pv) + (size_t)lr * 1024;
        f32x4 v[4];
#pragma unroll
        for (int i = 0; i < 4; ++i) v[i] = ((const f32x4*)src)[64 * i + lane];
        if (tbl == 0) quant_row<false>(v, ws + WS_UQ + (size_t)lr * 1024, (float*)(ws + WS_USC) + lr, lane);
        else quant_row<true>(v, ws + WS_VQ + (size_t)lr * 1024, (float*)(ws + WS_VSC) + lr, lane);
    }
}

template <bool WITH_Q8>
__device__ __forceinline__ void ph_norm(const KArgs& a, const float* xin, const float* g, const float* mod_l, int shift_idx, int scale_idx) {
    int tid_op = threadIdx.x; asm volatile("" : "+v"(tid_op)); const int tid = tid_op, lane = tid & 63, wave = tid >> 6;
    const int gw = blockIdx.x * NWAVES + wave, NGW = gridDim.x * NWAVES;
    bf16_t* H = (bf16_t*)(a.ws + WS_H);
    for (int row = gw; row < T; row += NGW) {
        const int b = row >> 12;
        f32x4 v[4]; float ss = 0.f;
#pragma unroll
        for (int i = 0; i < 4; ++i) { v[i] = ((const f32x4*)(xin + (size_t)row * DM))[64 * i + lane]; ss += (v[i].x * v[i].x + v[i].y * v[i].y) + (v[i].z * v[i].z + v[i].w * v[i].w); }
        ss = wave_sum(ss);
        const float r = 1.0f / sqrtf(ss * (1.0f / DM) + NORM_EPS);
#pragma unroll
        for (int i = 0; i < 4; ++i) {
            const int col = 256 * i + 4 * lane;
            const f32x4 gg = *(const f32x4*)(g + col), sc = *(const f32x4*)(mod_l + (size_t)b * NMOD + scale_idx * DM + col), sh = *(const f32x4*)(mod_l + (size_t)b * NMOD + shift_idx * DM + col);
            v[i] = (v[i] * r) * gg * (sc + 1.0f) + sh;
            u32x2 o; o.x = pk2(v[i].x, v[i].y); o.y = pk2(v[i].z, v[i].w);
            *(u32x2*)(H + (size_t)row * DM + col) = o;
        }
        if (WITH_Q8) quant_row<false>(v, a.ws + WS_H2Q + (size_t)row * 1024, (float*)(a.ws + WS_HS) + row, lane);
    }
}
__device__ __forceinline__ void ph_final_norm(const KArgs& a) {
    int tid_op = threadIdx.x; asm volatile("" : "+v"(tid_op)); const int tid = tid_op, lane = tid & 63, wave = tid >> 6;
    const int gw = blockIdx.x * NWAVES + wave, NGW = gridDim.x * NWAVES;
    for (int row = gw; row < T; row += NGW) {
        f32x4 v[4]; float ss = 0.f;
#pragma unroll
        for (int i = 0; i < 4; ++i) { v[i] = ((const f32x4*)(a.out + (size_t)row * DM))[64 * i + lane]; ss += (v[i].x * v[i].x + v[i].y * v[i].y) + (v[i].z * v[i].z + v[i].w * v[i].w); }
        ss = wave_sum(ss);
        const float r = 1.0f / sqrtf(ss * (1.0f / DM) + NORM_EPS);
#pragma unroll
        for (int i = 0; i < 4; ++i) { const f32x4 gg = *(const f32x4*)(a.final_g + 256 * i + 4 * lane); ((f32x4*)(a.out + (size_t)row * DM))[64 * i + lane] = (v[i] * r) * gg; }
    }
}

struct EpiProj {
    static constexpr bool PERM = true, AFTER_DRAIN = false;
    unsigned char* ws;
    __device__ __forceinline__ void operator()(const pg8::f32x4 (&acc)[2][2][4][2], const pg8::Unit& u, int wr, int wc, int fr, int fq) const {
        const int row0 = u.pm * 256 + wr * 64 + fr;
        const float* rope = (const float*)(ws + WS_ROPE);
#pragma unroll
        for (int bj = 0; bj < 2; ++bj) {
            const int cgb = u.pn * 256 + bj * 128;
            bf16_t* base; int pitch, cl, mode;
            if (cgb < 512) { base = (bf16_t*)(ws + WS_QA); pitch = 512; cl = cgb; mode = 1; }
            else if (cgb < 640) { base = (bf16_t*)(ws + WS_KA); pitch = 128; cl = cgb - 512; mode = 2; }
            else if (cgb < 768) { base = (bf16_t*)(ws + WS_VA); pitch = 128; cl = cgb - 640; mode = 0; }
            else if (cgb < 1280) { base = (bf16_t*)(ws + WS_QB); pitch = 512; cl = cgb - 768; mode = 3; }
            else if (cgb < 1792) { base = (bf16_t*)(ws + WS_KB); pitch = 512; cl = cgb - 1280; mode = 0; }
            else if (cgb < 2304) { base = (bf16_t*)(ws + WS_VB); pitch = 512; cl = cgb - 1792; mode = 0; }
            else if (cgb < 3328) { base = (bf16_t*)(ws + WS_GA); pitch = 1024; cl = cgb - 2304; mode = 4; }
            else { base = (bf16_t*)(ws + WS_GB); pitch = 1024; cl = cgb - 3328; mode = 4; }
            const int col = cl + wc * 32 + 8 * fq;
#pragma unroll
            for (int ai = 0; ai < 2; ++ai)
#pragma unroll
                for (int m = 0; m < 4; ++m) {
                    const int row = row0 + ai * 128 + m * 16;
                    pg8::f32x4 v0 = acc[ai][bj][m][0], v1 = acc[ai][bj][m][1];
                    if (mode == 1 || mode == 2) {
                        const int i0 = (col & 63) >> 1;
                        const f32x4 c01 = *(const f32x4*)(rope + ((size_t)row * 32 + i0) * 2), c23 = *(const f32x4*)(rope + ((size_t)row * 32 + i0 + 2) * 2);
                        pg8::f32x4 w0, w1;
                        w0[0] = v0[0] * c01.x - v0[1] * c01.y; w0[1] = v0[1] * c01.x + v0[0] * c01.y;
                        w0[2] = v0[2] * c01.z - v0[3] * c01.w; w0[3] = v0[3] * c01.z + v0[2] * c01.w;
                        w1[0] = v1[0] * c23.x - v1[1] * c23.y; w1[1] = v1[1] * c23.x + v1[0] * c23.y;
                        w1[2] = v1[2] * c23.z - v1[3] * c23.w; w1[3] = v1[3] * c23.z + v1[2] * c23.w;
                        v0 = w0; v1 = w1;
                    }
                    if (mode == 1 || mode == 3) { v0 = v0 * QSCALE; v1 = v1 * QSCALE; }
                    if (mode == 4) {
#pragma unroll
                        for (int e = 0; e < 4; ++e) { v0[e] = 1.0f / (1.0f + __expf(-v0[e])); v1[e] = 1.0f / (1.0f + __expf(-v1[e])); }
                    }
                    u32x4 w; w.x = pk2(v0[0], v0[1]); w.y = pk2(v0[2], v0[3]); w.z = pk2(v1[0], v1[1]); w.w = pk2(v1[2], v1[3]);
                    *(u32x4*)(base + (size_t)row * pitch + col) = w;
                }
        }
    }
};
template <bool ADD> struct EpiBranch {
    static constexpr bool PERM = true, AFTER_DRAIN = false;
    const bf16_t* Gt; bf16_t* O;
    __device__ __forceinline__ void operator()(const pg8::f32x4 (&acc)[2][2][4][2], const pg8::Unit& u, int wr, int wc, int fr, int fq) const {
        const int row0 = u.pm * 256 + wr * 64 + fr, col0 = u.pn * 256 + wc * 32 + 8 * fq;
#pragma unroll
        for (int ai = 0; ai < 2; ++ai)
#pragma unroll
            for (int m = 0; m < 4; ++m)
#pragma unroll
                for (int bj = 0; bj < 2; ++bj) {
                    const size_t off = (size_t)(row0 + ai * 128 + m * 16) * DM + col0 + bj * 128;
                    const u32x4 gv = *(const u32x4*)(Gt + off);
                    const pg8::f32x4 v0 = acc[ai][bj][m][0], v1 = acc[ai][bj][m][1];
                    float r[8];
                    r[0] = bflo(gv.x) * v0[0]; r[1] = bfhi(gv.x) * v0[1]; r[2] = bflo(gv.y) * v0[2]; r[3] = bfhi(gv.y) * v0[3];
                    r[4] = bflo(gv.z) * v1[0]; r[5] = bfhi(gv.z) * v1[1]; r[6] = bflo(gv.w) * v1[2]; r[7] = bfhi(gv.w) * v1[3];
                    if (ADD) { const u32x4 ov = *(const u32x4*)(O + off);
                        r[0] += bflo(ov.x); r[1] += bfhi(ov.x); r[2] += bflo(ov.y); r[3] += bfhi(ov.y); r[4] += bflo(ov.z); r[5] += bfhi(ov.z); r[6] += bflo(ov.w); r[7] += bfhi(ov.w); }
                    u32x4 w; w.x = pk2(r[0], r[1]); w.y = pk2(r[2], r[3]); w.z = pk2(r[4], r[5]); w.w = pk2(r[6], r[7]);
                    *(u32x4*)(O + off) = w;
                }
    }
};
struct EpiWout {
    static constexpr bool PERM = false, AFTER_DRAIN = false;
    const float* xold; float* xnew; const float* gate;
    __device__ __forceinline__ void operator()(const pg8::f32x4 (&acc)[2][2][4][2], const pg8::Unit& u, int wr, int wc, int fr, int fq) const {
        const int row0 = u.pm * 256 + wr * 64 + fr, col0 = u.pn * 256 + wc * 32 + 4 * fq, b = u.pm >> 4;
#pragma unroll
        for (int bj = 0; bj < 2; ++bj)
#pragma unroll
            for (int n = 0; n < 2; ++n) {
                const pg8::f32x4 gv = *(const pg8::f32x4*)(gate + (size_t)b * NMOD + col0 + bj * 128 + n * 16);
#pragma unroll
                for (int ai = 0; ai < 2; ++ai)
#pragma unroll
                    for (int m = 0; m < 4; ++m) { const size_t off = (size_t)(row0 + ai * 128 + m * 16) * DM + col0 + bj * 128 + n * 16;
                        const pg8::f32x4 xo = *(const pg8::f32x4*)(xold + off);
                        *(pg8::f32x4*)(xnew + off) = xo + gv * acc[ai][bj][m][n]; }
            }
    }
};
struct EpiPlainBf16 {
    static constexpr bool PERM = true, AFTER_DRAIN = false;
    bf16_t* O; int ldc;
    __device__ __forceinline__ void operator()(const pg8::f32x4 (&acc)[2][2][4][2], const pg8::Unit& u, int wr, int wc, int fr, int fq) const {
        const int row0 = u.pm * 256 + wr * 64 + fr, col0 = u.pn * 256 + wc * 32 + 8 * fq;
#pragma unroll
        for (int ai = 0; ai < 2; ++ai)
#pragma unroll
            for (int m = 0; m < 4; ++m)
#pragma unroll
                for (int bj = 0; bj < 2; ++bj) {
                    const pg8::f32x4 v0 = acc[ai][bj][m][0], v1 = acc[ai][bj][m][1];
                    u32x4 w; w.x = pk2(v0[0], v0[1]); w.y = pk2(v0[2], v0[3]); w.z = pk2(v1[0], v1[1]); w.w = pk2(v1[2], v1[3]);
                    *(u32x4*)(O + (size_t)(row0 + ai * 128 + m * 16) * ldc + col0 + bj * 128) = w;
                }
    }
};

__device__ __forceinline__ void load_row64(const bf16_t* p, float (&q)[64]) {
#pragma unroll
    for (int i = 0; i < 8; ++i) { const u32x4 w = *(const u32x4*)(p + 8 * i);
        q[8 * i + 0] = bflo(w.x); q[8 * i + 1] = bfhi(w.x); q[8 * i + 2] = bflo(w.y); q[8 * i + 3] = bfhi(w.y);
        q[8 * i + 4] = bflo(w.z); q[8 * i + 5] = bfhi(w.z); q[8 * i + 6] = bflo(w.w); q[8 * i + 7] = bfhi(w.w); }
}
__device__ __forceinline__ float dot_row64(const bf16_t* p, const float (&q)[64]) {
    float acc = 0.f;
#pragma unroll
    for (int i = 0; i < 8; ++i) { const u32x4 w = *(const u32x4*)(p + 8 * i);
        acc = fmaf(q[8 * i + 0], bflo(w.x), acc); acc = fmaf(q[8 * i + 1], bfhi(w.x), acc); acc = fmaf(q[8 * i + 2], bflo(w.y), acc); acc = fmaf(q[8 * i + 3], bfhi(w.y), acc);
        acc = fmaf(q[8 * i + 4], bflo(w.z), acc); acc = fmaf(q[8 * i + 5], bfhi(w.z), acc); acc = fmaf(q[8 * i + 6], bflo(w.w), acc); acc = fmaf(q[8 * i + 7], bfhi(w.w), acc); }
    return acc;
}
template <bool EARLY_EXIT>
__device__ __forceinline__ void ph_attn_sb(const KArgs& a) {
    int tid_op = threadIdx.x; asm volatile("" : "+v"(tid_op)); const int tid = tid_op, lane = tid & 63, wave = tid >> 6;
    const int gw = blockIdx.x * NWAVES + wave, NGW = gridDim.x * NWAVES;
    const bf16_t* QB = (const bf16_t*)(a.ws + WS_QB); const bf16_t* KB = (const bf16_t*)(a.ws + WS_KB); const bf16_t* VB = (const bf16_t*)(a.ws + WS_VB);
    bf16_t* YB = (bf16_t*)(a.ws + WS_QB);
    for (int it = gw; it < T * 8; it += NGW) {
        const int s = it & 4095, h = (it >> 12) & 7, b = it >> 15;
        const size_t t = (size_t)b * SEQ + s;
        float q[64]; load_row64(QB + t * 512 + h * 64, q);
        float o = 0.f, carry = 0.f;
        for (int c = (s - 1) >> 6; c >= 0; --c) {
            const int key = 64 * c + lane; const bool valid = key < s;
            const float z2 = dot_row64(KB + ((size_t)b * SEQ + key) * 512 + h * 64, q);
            const float l2 = valid ? -softplus2(z2) : 0.f;
            float sfx = l2;
#pragma unroll
            for (int off = 1; off < 64; off <<= 1) { const float tt = __shfl_down(sfx, off); if (lane + off < 64) sfx += tt; }
            const float total = __shfl(sfx, 0);
            const float A = valid ? exp2f(z2 + sfx + carry) : 0.f;
            carry += total;
            const bf16_t* vp = VB + ((size_t)b * SEQ + 64 * c) * 512 + h * 64 + lane;
#pragma unroll 16
            for (int j = 0; j < 64; ++j) { const float aj = __shfl(A, j); o = fmaf(aj, __uint_as_float((unsigned)vp[(size_t)j * 512] << 16), o); }
            if (EARLY_EXIT && carry < -SB_EXIT) break;
        }
        YB[t * 512 + h * 64 + lane] = (bf16_t)f2bf(o);
    }
}
__device__ __forceinline__ void ph_attn_swa(const KArgs& a, int l) {
    int tid_op = threadIdx.x; asm volatile("" : "+v"(tid_op)); const int tid = tid_op, lane = tid & 63, wave = tid >> 6;
    const int gw = blockIdx.x * NWAVES + wave, NGW = gridDim.x * NWAVES;
    const bf16_t* QA = (const bf16_t*)(a.ws + WS_QA); const bf16_t* KA = (const bf16_t*)(a.ws + WS_KA); const bf16_t* VA = (const bf16_t*)(a.ws + WS_VA);
    bf16_t* YA = (bf16_t*)(a.ws + WS_QA);
    for (int it = gw; it < T * 8; it += NGW) {
        const int s = it & 4095, hq = (it >> 12) & 7, b = it >> 15, kvh = hq >> 2;
        const size_t t = (size_t)b * SEQ + s;
        float q[64]; load_row64(QA + t * 512 + hq * 64, q);
        const int lo = s - 127 > 0 ? s - 127 : 0, c_lo = lo >> 6, c_hi = s >> 6;
        float sc[3];
#pragma unroll
        for (int ci = 0; ci < 3; ++ci) {
            const int c = c_lo + ci; sc[ci] = -INFINITY;
            if (c <= c_hi) { const int key = 64 * c + lane; const float z2 = dot_row64(KA + ((size_t)b * SEQ + key) * 128 + kvh * 64, q); if (key >= lo && key <= s) sc[ci] = z2; }
        }
        const float sink2 = a.sinks[l * 8 + hq] * LOG2E;
        const float m = fmaxf(wave_max(fmaxf(fmaxf(sc[0], sc[1]), sc[2])), sink2);
        float p[3], ps = 0.f;
#pragma unroll
        for (int ci = 0; ci < 3; ++ci) { p[ci] = exp2f(sc[ci] - m); ps += p[ci]; }
        const float denom = wave_sum(ps) + exp2f(sink2 - m);
        float o = 0.f;
#pragma unroll
        for (int ci = 0; ci < 3; ++ci) {
            const int c = c_lo + ci;
            if (c <= c_hi) { const bf16_t* vp = VA + ((size_t)b * SEQ + 64 * c) * 128 + kvh * 64 + lane;
#pragma unroll 16
                for (int j = 0; j < 64; ++j) { const float pj = __shfl(p[ci], j); o = fmaf(pj, __uint_as_float((unsigned)vp[(size_t)j * 128] << 16), o); } }
        }
        YA[t * 512 + hq * 64 + lane] = (bf16_t)f2bf(o / denom);
    }
}

__device__ __forceinline__ void ph_topk(const KArgs& a, int l, LAS unsigned char* lds) {
    int tid_op = threadIdx.x; asm volatile("" : "+v"(tid_op)); const int tid = tid_op, lane = tid & 63, wave = tid >> 6;
    const int gw = blockIdx.x * NWAVES + wave, NGW = gridDim.x * NWAVES;
    const bf16_t* Q2 = (const bf16_t*)(a.ws + WS_Q2);
    const bf16_t* SK = (const bf16_t*)(a.ws + WS_SK) + (size_t)l * 8 * 2 * 128 * 128;
    int* IDX = (int*)(a.ws + WS_IDX); float* GATE = (float*)(a.ws + WS_GATE);
    LAS float* ls_s = (LAS float*)(lds + wave * 256);
    LAS int* ls_i = (LAS int*)(lds + wave * 256 + 128);
    for (int it = gw; it < T * 8; it += NGW) {
        const int h = it & 7; const size_t t = (size_t)(it >> 3);
#pragma unroll 1
        for (int p = 0; p < 2; ++p) {
            const bf16_t* qp = Q2 + t * PQ + h * 256 + p * 128;
            const bf16_t* k0 = SK + ((size_t)(h * 2 + p) * 128 + lane) * 128;
            const bf16_t* k1 = k0 + 64 * 128;
            float s0 = 0.f, s1 = 0.f;
#pragma unroll
            for (int i = 0; i < 16; ++i) { const u32x4 qv = *(const u32x4*)(qp + 8 * i); s0 = dot8(qv, *(const u32x4*)(k0 + 8 * i), s0); s1 = dot8(qv, *(const u32x4*)(k1 + 8 * i), s1); }
#pragma unroll 1
            for (int r = 0; r < 16; ++r) {
                const float wm = wave_max(fmaxf(s0, s1));
                const unsigned long long b0 = __ballot(s0 == wm), b1 = __ballot(s1 == wm);
                const int n = b0 ? (__ffsll((long long)b0) - 1) : (64 + __ffsll((long long)b1) - 1);
                if (lane == 0) { ls_s[p * 16 + r] = wm; ls_i[p * 16 + r] = n; }
                if (n == lane) s0 = -INFINITY;
                if (n == lane + 64) s1 = -INFINITY;
            }
        }
        asm volatile("s_waitcnt lgkmcnt(0)" ::: "memory");
        const int ci = lane >> 2, cj = (lane & 3) * 4;
        const float av = ls_s[ci];
        float cand[4];
#pragma unroll
        for (int k = 0; k < 4; ++k) cand[k] = av + ls_s[16 + cj + k];
        float my_s = 0.f; int my_flat = 0; float smax = 0.f;
#pragma unroll 1
        for (int r = 0; r < 16; ++r) {
            const float best = fmaxf(fmaxf(cand[0], cand[1]), fmaxf(cand[2], cand[3]));
            const float wm = wave_max(best);
            const unsigned long long bal = __ballot(best == wm);
            const int wl = __ffsll((long long)bal) - 1;
            const int kk = (cand[0] == wm) ? 0 : (cand[1] == wm) ? 1 : (cand[2] == wm) ? 2 : 3;
            const int flat_w = __shfl(lane * 4 + kk, wl);
            if (lane == wl) {
#pragma unroll
                for (int k = 0; k < 4; ++k) if (kk == k) cand[k] = -INFINITY;
            }
            if (lane == r) { my_s = wm; my_flat = flat_w; }
            if (r == 0) smax = wm;
        }
        const float e = lane < 16 ? __expf(my_s - smax) : 0.f;
        const float den = wave_sum(e);
        if (lane < 16) {
            const int ia = ls_i[my_flat >> 4], ib = ls_i[16 + (my_flat & 15)];
            IDX[t * 128 + h * 16 + lane] = ia * 128 + ib;
            GATE[t * 128 + h * 16 + lane] = e / den;
        }
        asm volatile("s_waitcnt lgkmcnt(0)" ::: "memory");
    }
}

__device__ __forceinline__ void ph_peer(const KArgs& a, int l, const float* mod_l) {
    int tid_op = threadIdx.x; asm volatile("" : "+v"(tid_op)); const int tid = tid_op, lane = tid & 63, wave = tid >> 6;
    const int gw = blockIdx.x * NWAVES + wave, NGW = gridDim.x * NWAVES;
    const unsigned char* UQ = a.ws + WS_UQ + (size_t)l * NEXP * 1024; const unsigned char* VQ = a.ws + WS_VQ + (size_t)l * NEXP * 1024;
    const float* USC = (const float*)(a.ws + WS_USC) + l * NEXP; const float* VSC = (const float*)(a.ws + WS_VSC) + l * NEXP;
    const int* IDX = (const int*)(a.ws + WS_IDX); const float* GATE = (const float*)(a.ws + WS_GATE);
    const unsigned char* HQ = a.ws + WS_H2Q; const float* HS = (const float*)(a.ws + WS_HS);
    for (int t = gw; t < T; t += NGW) {
        const int b = t >> 12;
        const u32x4 hv = *(const u32x4*)(HQ + (size_t)t * 1024 + 16 * lane);
        const float sh = HS[t];
        const int idx0 = IDX[(size_t)t * 128 + lane], idx1 = IDX[(size_t)t * 128 + 64 + lane];
        float coef0 = 0.f, coef1 = 0.f;
#pragma unroll 1
        for (int kb = 0; kb < 8; ++kb) {
            u32x4 uv[16]; int ee[16];
#pragma unroll
            for (int kk = 0; kk < 16; ++kk) { const int k = kb * 16 + kk; ee[kk] = __shfl(k < 64 ? idx0 : idx1, k & 63); uv[kk] = *(const u32x4*)(UQ + (size_t)ee[kk] * 1024 + 16 * lane); }
#pragma unroll
            for (int kk = 0; kk < 16; ++kk) {
                const int k = kb * 16 + kk;
                int is = __builtin_amdgcn_sdot4((int)uv[kk].x, (int)hv.x, 0, false);
                is = __builtin_amdgcn_sdot4((int)uv[kk].y, (int)hv.y, is, false);
                is = __builtin_amdgcn_sdot4((int)uv[kk].z, (int)hv.z, is, false);
                is = __builtin_amdgcn_sdot4((int)uv[kk].w, (int)hv.w, is, false);
                const float d = wave_sum((float)is) * USC[ee[kk]] * sh;
                const float act = 0.5f * d * (1.0f + erff(d * 0.70710678118654752f));
                if ((k & 63) == lane) { if (k < 64) coef0 = act; else coef1 = act; }
            }
        }
        coef0 *= GATE[(size_t)t * 128 + lane] * VSC[idx0];
        coef1 *= GATE[(size_t)t * 128 + 64 + lane] * VSC[idx1];
        float acc[16], csum = 0.f;
#pragma unroll
        for (int i = 0; i < 16; ++i) acc[i] = 0.f;
#pragma unroll 1
        for (int kb = 0; kb < 16; ++kb) {
            u32x4 vv[8]; float cc[8];
#pragma unroll
            for (int kk = 0; kk < 8; ++kk) { const int k = kb * 8 + kk; const int e = __shfl(k < 64 ? idx0 : idx1, k & 63); cc[kk] = __shfl(k < 64 ? coef0 : coef1, k & 63); vv[kk] = *(const u32x4*)(VQ + (size_t)e * 1024 + 16 * lane); }
#pragma unroll
            for (int kk = 0; kk < 8; ++kk) {
                csum += cc[kk];
#pragma unroll
                for (int i = 0; i < 4; ++i) { const unsigned w = vv[kk][i];
                    acc[4 * i + 0] = fmaf(cc[kk], (float)(w & 0xffu), acc[4 * i + 0]); acc[4 * i + 1] = fmaf(cc[kk], (float)((w >> 8) & 0xffu), acc[4 * i + 1]);
                    acc[4 * i + 2] = fmaf(cc[kk], (float)((w >> 16) & 0xffu), acc[4 * i + 2]); acc[4 * i + 3] = fmaf(cc[kk], (float)(w >> 24), acc[4 * i + 3]); }
            }
        }
        const float off = 128.0f * csum;
#pragma unroll
        for (int i = 0; i < 4; ++i) {
            const int col = 256 * i + 4 * lane;
            const f32x4 g = *(const f32x4*)(mod_l + (size_t)b * NMOD + 5 * DM + col);
            f32x4 xv = *(const f32x4*)(a.out + (size_t)t * DM + col);
            xv.x += g.x * (acc[4 * i + 0] - off); xv.y += g.y * (acc[4 * i + 1] - off); xv.z += g.z * (acc[4 * i + 2] - off); xv.w += g.w * (acc[4 * i + 3] - off);
            *(f32x4*)(a.out + (size_t)t * DM + col) = xv;
        }
    }
}

constexpr int PH_PER_LAYER = 9, NPHASES = 1 + DEPTH * PH_PER_LAYER + 1;
#ifndef PHASE_MASK
#define PHASE_MASK 0xFFFF
#endif
#define HASP(k) (((PHASE_MASK) >> (k)) & 1)
#ifndef SB_EARLY_EXIT
#define SB_EARLY_EXIT 1
#endif

__global__ void __launch_bounds__(NTHREADS, 2) fwd_kernel(KArgs a) {
    extern __shared__ __attribute__((aligned(16))) unsigned char lds_raw[];
    LAS unsigned char* lds = (LAS unsigned char*)lds_raw;
    cg::grid_group grid = cg::this_grid();
    unsigned char* ws = a.ws;
    const int G = gridDim.x;
#define IN(k) (a.ph_lo <= (k) && (k) < a.ph_hi)
#define SEAM(k) do { if (IN(k) && IN((k) + 1)) grid.sync(); } while (0)
    if (IN(0)) { if (HASP(0)) ph_prologue(a, lds); }
    SEAM(0);
#pragma unroll 1
    for (int l = 0; l < DEPTH; ++l) {
        const int p0 = 1 + l * PH_PER_LAYER;
        const float* mod_l = (const float*)(ws + WS_MOD) + (size_t)l * 8 * NMOD;
        const float* xcur = (l == 0) ? a.x : a.out;
        if (IN(p0 + 0)) { if (HASP(1)) ph_norm<false>(a, xcur, a.norm1_g + l * DM, mod_l, 0, 1); }
        SEAM(p0 + 0);
        if (IN(p0 + 1)) { if (HASP(2)) { pg8::Gemm g{(const bf16_t*)(ws + WS_H), (const bf16_t*)(ws + WS_WIN) + (size_t)l * NPROJ * 1024, T, NPROJ, 1024};
                  pg8::StaticOrder S; S.init(T, NPROJ, G, (int)blockIdx.x); EpiProj E{ws};
                  pg8::gemm_phase<EpiProj, pg8::StaticOrder, true, true>(lds, g, S, E); } }
        SEAM(p0 + 1);
        if (IN(p0 + 2)) { if (HASP(3)) { ph_attn_swa(a, l); ph_attn_sb<SB_EARLY_EXIT != 0>(a); } }
        SEAM(p0 + 2);
        if (IN(p0 + 3)) { if (HASP(4)) { pg8::StaticOrder S; S.init(T, DM, G, (int)blockIdx.x);
                  { pg8::Gemm g{(const bf16_t*)(ws + WS_QA), (const bf16_t*)(ws + WS_WBA) + (size_t)l * 1024 * 512, T, DM, 512};
                    EpiBranch<false> E{(const bf16_t*)(ws + WS_GA), (bf16_t*)(ws + WS_H)};
                    pg8::gemm_phase<EpiBranch<false>, pg8::StaticOrder, true, true>(lds, g, S, E); }
                  __syncthreads();
                  { pg8::Gemm g{(const bf16_t*)(ws + WS_QB), (const bf16_t*)(ws + WS_WBB) + (size_t)l * 1024 * 512, T, DM, 512};
                    EpiBranch<true> E{(const bf16_t*)(ws + WS_GB), (bf16_t*)(ws + WS_H)};
                    pg8::gemm_phase<EpiBranch<true>, pg8::StaticOrder, true, true>(lds, g, S, E); } } }
        SEAM(p0 + 3);
        if (IN(p0 + 4)) { if (HASP(5)) { pg8::Gemm g{(const bf16_t*)(ws + WS_H), (const bf16_t*)(ws + WS_WOUT) + (size_t)l * 1024 * 1024, T, DM, 1024};
                  pg8::StaticOrder S; S.init(T, DM, G, (int)blockIdx.x); EpiWout E{xcur, a.out, mod_l + 2 * DM};
                  pg8::gemm_phase<EpiWout, pg8::StaticOrder, true, true>(lds, g, S, E); } }
        SEAM(p0 + 4);
        if (IN(p0 + 5)) { if (HASP(6)) ph_norm<true>(a, a.out, a.norm2_g + l * DM, mod_l, 3, 4); }
        SEAM(p0 + 5);
        if (IN(p0 + 6)) { if (HASP(7)) { pg8::Gemm g{(const bf16_t*)(ws + WS_H), (const bf16_t*)(ws + WS_WQ) + (size_t)l * PQ * 1024, T, PQ, 1024};
                  pg8::StaticOrder S; S.init(T, PQ, G, (int)blockIdx.x); EpiPlainBf16 E{(bf16_t*)(ws + WS_Q2), PQ};
                  pg8::gemm_phase<EpiPlainBf16, pg8::StaticOrder, true, true>(lds, g, S, E); } }
        SEAM(p0 + 6);
        if (IN(p0 + 7)) { if (HASP(8)) ph_topk(a, l, lds); }
        SEAM(p0 + 7);
        if (IN(p0 + 8)) { if (HASP(9)) ph_peer(a, l, mod_l); }
        SEAM(p0 + 8);
    }
    if (IN(NPHASES - 1)) { if (HASP(10)) ph_final_norm(a); }
#undef IN
#undef SEAM
}

#ifndef N_LAUNCH_SPLIT
#define N_LAUNCH_SPLIT 1
#endif
extern "C" void kernel_launch(void* const* d_in, const int* in_sizes, int n_in, void* d_out, int out_size, void* d_ws, size_t ws_size, hipStream_t stream) {
    static int grid = 0;
    if (grid == 0) {
        if (n_in != 17 || out_size != T * DM || ws_size < WS_END) { fprintf(stderr, "kernel_launch: unexpected problem (n_in %d out %d ws %zu)\n", n_in, out_size, ws_size); grid = -1; return; }
        int dev = 0, cus = 0, per_cu = 0;
        (void)hipGetDevice(&dev);
        (void)hipDeviceGetAttribute(&cus, hipDeviceAttributeMultiprocessorCount, dev);
        (void)hipFuncSetAttribute((const void*)fwd_kernel, hipFuncAttributeMaxDynamicSharedMemorySize, LDS_BYTES);
        (void)hipOccupancyMaxActiveBlocksPerMultiprocessor(&per_cu, (const void*)fwd_kernel, NTHREADS, LDS_BYTES);
        if (per_cu < 1) { fprintf(stderr, "kernel_launch: occupancy query says %d\n", per_cu); per_cu = 1; }
        grid = cus;
        fprintf(stderr, "kernel_launch: cus %d per_cu %d grid %d ws %zu\n", cus, per_cu, grid, ws_size);
    }
    if (grid < 0) return;
    KArgs a{};
    a.x = (const float*)d_in[0]; a.c = (const float*)d_in[1]; a.pos = (const int*)d_in[2]; a.ada_w = (const float*)d_in[3]; a.ada_b = (const float*)d_in[4];
    a.norm1_g = (const float*)d_in[5]; a.w_in = (const float*)d_in[6]; a.sinks = (const float*)d_in[7]; a.wbr_a = (const float*)d_in[8]; a.wbr_b = (const float*)d_in[9];
    a.w_out = (const float*)d_in[10]; a.norm2_g = (const float*)d_in[11]; a.wq = (const float*)d_in[12]; a.subkeys = (const float*)d_in[13]; a.pu = (const float*)d_in[14];
    a.pv = (const float*)d_in[15]; a.final_g = (const float*)d_in[16]; a.out = (float*)d_out; a.ws = (unsigned char*)d_ws;
#if N_LAUNCH_SPLIT
    a.ph_lo = 0; a.ph_hi = NPHASES;
    { void* args[] = {&a};
      hipError_t e = hipLaunchCooperativeKernel((void*)fwd_kernel, dim3(grid), dim3(NTHREADS), args, LDS_BYTES, stream);
      if (e != hipSuccess) fprintf(stderr, "cooperative launch failed: %s (grid %d)\n", hipGetErrorString(e), grid); }
#else
    for (int ph = 0; ph < NPHASES; ++ph) {
        a.ph_lo = ph; a.ph_hi = ph + 1;
        void* args[] = {&a};
        hipError_t e = hipLaunchCooperativeKernel((void*)fwd_kernel, dim3(grid), dim3(NTHREADS), args, LDS_BYTES, stream);
        if (e != hipSuccess) { fprintf(stderr, "cooperative launch %d failed: %s (grid %d)\n", ph, hipGetErrorString(e), grid); break; }
    }
#endif
}
```

```cpp
#include <hip/hip_runtime.h>
#include <hip/hip_cooperative_groups.h>
#include <cstdio>
#include <cstdint>
namespace cg = cooperative_groups;

namespace pg8 {
#define PG8_LAS __attribute__((address_space(3)))
typedef unsigned short bf16_t;
typedef short bf16x8 __attribute__((ext_vector_type(8)));
typedef float f32x4 __attribute__((ext_vector_type(4)));
typedef unsigned u32x4 __attribute__((ext_vector_type(4)));
constexpr int BM = 256, BK = 64, HALF = 128, HTB = HALF * BK * 2  , STAGE_BYTES = 8 * HTB, NXCD = 8, WGM = 8;

__host__ __device__ __forceinline__ int lds_byte(int r, int c) { const int st = (r >> 4) * 2 + (c >> 5), rr = r & 15, cc = c & 31, ob = rr * 64 + cc * 2; return st * 1024 + (ob ^ (((ob >> 9) & 1) << 5)); }
__host__ __device__ __forceinline__ void stage_rc(int b, int& R, int& C) { const int st = b / 1024, sb = b % 1024, swz = sb ^ (((sb >> 9) & 1) << 5); R = (st >> 1) * 16 + swz / 64; C = (st & 1) * 32 + (swz % 64) / 2; }
__host__ __device__ __forceinline__ int perm32(int rho) { const int n = rho >> 4, i = rho & 15; return 8 * (i >> 2) + 4 * n + (i & 3); }

struct Unit { int pm, pn; };
struct Gemm { const bf16_t* A; const bf16_t* Bt; int M, N, K; };

struct StaticOrder {
    int nM, nN, nwg, G, c;
    __host__ __device__ void init(int M, int N, int G_, int c_) { nM = M / BM; nN = N / BM; nwg = nM * nN; G = G_; c = c_; }
    __host__ __device__ bool next(int i, Unit& u) const {
        const long L = (long)i * G + c; if (L >= nwg) return false;
        int wgid = (int)L; { const int q = nwg / NXCD, r = nwg % NXCD, xcd = wgid % NXCD, off = wgid / NXCD; wgid = (xcd < r ? xcd * (q + 1) : r * (q + 1) + (xcd - r) * q) + off; }
        const int nig = WGM * nN, gid = wgid / nig, fm = gid * WGM, gsz = (nM - fm) < WGM ? (nM - fm) : WGM;
        u.pm = fm + ((wgid % nig) % gsz); u.pn = (wgid % nig) / gsz; return true;
    }
    __device__ __forceinline__ void a_ready(const Unit&) const {}
    __device__ __forceinline__ void done(const Unit&) const {}
};


__device__ __forceinline__ unsigned cvt_pk_bf16(float lo, float hi) { unsigned r; asm volatile("v_cvt_pk_bf16_f32 %0, %1, %2" : "=v"(r) : "v"(lo), "v"(hi)); return r; }
template <class Epi, class Sched, bool ALIGN_EPI = false, bool SP2 = false>
__device__ __forceinline__ void gemm_phase(PG8_LAS unsigned char* lds, const Gemm g, const Sched& S, const Epi& E) {
    int tid_op = threadIdx.x; asm volatile("" : "+v"(tid_op));
    const int tid = tid_op, wid = __builtin_amdgcn_readfirstlane(tid >> 6), lane = tid & 63, wr = wid >> 2, wc = wid & 3, fr = lane & 15, fq = lane >> 4;
    const int K = g.K, nt = K / BK;
    unsigned voffA[2], voffB[2];
#pragma unroll
    for (int i = 0; i < 2; ++i) { int R, C; stage_rc(tid * 16 + i * 8192, R, C); const int Rb = Epi::PERM ? ((R & ~31) + perm32(R & 31)) : R;
        voffA[i] = (unsigned)(R * K + C) * 2u; voffB[i] = (unsigned)(Rb * K + C) * 2u; }
    const size_t kstep = (size_t)(BK * 2);
    const size_t hstep = (size_t)HALF * K * 2;
    const size_t tstep = 2 * hstep;
    const unsigned ldsw = (unsigned)wid * 1024u;
    const int aoff = lds_byte(wr * 64 + fr, fq * 8), boff = lds_byte(wc * 32 + fr, fq * 8);
#define PG8_SA(b, h) (((b) * 2 + (h)) * HTB)
#define PG8_SB(b, h) ((4 + (b) * 2 + (h)) * HTB)
#define PG8_STAGE(bufoff, gbase, voff) do { _Pragma("unroll") for (int _i = 0; _i < 2; ++_i) \
        __builtin_amdgcn_global_load_lds((const unsigned*)((const char*)(gbase) + (voff)[_i]), (PG8_LAS unsigned*)(lds + (bufoff) + ldsw + _i * 8192), 16, 0, 0); } while (0)
#define PG8_LDA(dst, b, h) do { _Pragma("unroll") for (int m = 0; m < 4; ++m) _Pragma("unroll") for (int k = 0; k < 2; ++k) dst[m][k] = *(const PG8_LAS bf16x8*)(lds + PG8_SA(b, h) + aoff + m * 2048 + k * 1024); } while (0)
#define PG8_LDB(dst, b, h) do { _Pragma("unroll") for (int n = 0; n < 2; ++n) _Pragma("unroll") for (int k = 0; k < 2; ++k) dst[n][k] = *(const PG8_LAS bf16x8*)(lds + PG8_SB(b, h) + boff + n * 2048 + k * 1024); } while (0)
#define PG8_MMA(ai, bj, At, Bt) do { __builtin_amdgcn_s_setprio(1); _Pragma("unroll") for (int m = 0; m < 4; ++m) _Pragma("unroll") for (int n = 0; n < 2; ++n) _Pragma("unroll") for (int k = 0; k < 2; ++k) \
        acc[ai][bj][m][n] = __builtin_amdgcn_mfma_f32_16x16x32_bf16(Bt[n][k], At[m][k], acc[ai][bj][m][n], 0, 0, 0); __builtin_amdgcn_s_setprio(0); } while (0)
#define PG8_WAIT_V(n) asm volatile("s_waitcnt vmcnt(" #n ")" ::: "memory")
#define PG8_WAIT_L(n) asm volatile("s_waitcnt lgkmcnt(" #n ")" ::: "memory")
#define PG8_BAR __builtin_amdgcn_s_barrier()
#define PG8_SCHED __builtin_amdgcn_sched_barrier(0)
    Unit cur, nxt; int ui = 0;
    if (!S.next(0, cur)) return;
    f32x4 acc[2][2][4][2];
#pragma unroll
    for (int a = 0; a < 2; ++a)
#pragma unroll
        for (int b = 0; b < 2; ++b)
#pragma unroll
            for (int m = 0; m < 4; ++m)
#pragma unroll
                for (int n = 0; n < 2; ++n) acc[a][b][m][n] = (f32x4){0.f, 0.f, 0.f, 0.f};
    bf16x8 At[4][2], B0[2][2], B1[2][2];
    const char* cA = (const char*)g.A + (size_t)cur.pm * tstep; const char* cB = (const char*)g.Bt + (size_t)cur.pn * tstep;
    S.a_ready(cur);
    if constexpr (SP2) {
        PG8_STAGE(PG8_SB(0, 0), cB, voffB); PG8_STAGE(PG8_SB(0, 1), cB + hstep, voffB); PG8_STAGE(PG8_SA(0, 0), cA, voffA); PG8_STAGE(PG8_SA(0, 1), cA + hstep, voffA);
        if (wr == 1) PG8_BAR;
        PG8_WAIT_V(2); PG8_BAR;
        PG8_STAGE(PG8_SB(1, 0), cB + kstep, voffB); PG8_STAGE(PG8_SA(1, 0), cA + kstep, voffA); PG8_STAGE(PG8_SB(1, 1), cB + hstep + kstep, voffB);
        PG8_WAIT_V(6); PG8_BAR;
    } else {
        PG8_STAGE(PG8_SB(0, 0), cB, voffB); PG8_STAGE(PG8_SA(0, 0), cA, voffA); PG8_STAGE(PG8_SB(0, 1), cB + hstep, voffB); PG8_STAGE(PG8_SA(0, 1), cA + hstep, voffA);
        if (wr == 1) PG8_BAR;
        PG8_WAIT_V(4); PG8_BAR;
        PG8_STAGE(PG8_SB(1, 0), cB + kstep, voffB); PG8_STAGE(PG8_SA(1, 0), cA + kstep, voffA); PG8_STAGE(PG8_SB(1, 1), cB + hstep + kstep, voffB);
        PG8_WAIT_V(6); PG8_BAR;
    }
    for (;;) {
        const bool has_next = S.next(ui + 1, nxt);
        const char* nA = has_next ? (const char*)g.A + (size_t)nxt.pm * tstep : cA; const char* nB = has_next ? (const char*)g.Bt + (size_t)nxt.pn * tstep : cB;
        for (int t = 0; t < nt; t += 2) {
            const bool last = (t == nt - 2);
            const char* a1 = cA + (size_t)(t + 1) * kstep;
            const char* a2 = last ? nA : cA + (size_t)(t + 2) * kstep; const char* b2 = last ? nB : cB + (size_t)(t + 2) * kstep;
            const char* a3 = a2 + kstep; const char* b3 = b2 + kstep;
            if (last && has_next) S.a_ready(nxt);
            if constexpr (SP2) {
            PG8_LDB(B0, 0, 0); PG8_LDB(B1, 0, 1); PG8_SCHED; PG8_LDA(At, 0, 0); PG8_STAGE(PG8_SA(1, 1), a1 + hstep, voffA);
            PG8_WAIT_V(8); PG8_WAIT_L(0); PG8_BAR; PG8_MMA(0, 0, At, B0); PG8_MMA(0, 1, At, B1); PG8_BAR; PG8_SCHED;
            PG8_LDA(At, 0, 1); PG8_STAGE(PG8_SB(0, 0), b2, voffB); PG8_STAGE(PG8_SB(0, 1), b2 + hstep, voffB); PG8_STAGE(PG8_SA(0, 0), a2, voffA);
            PG8_WAIT_V(8); PG8_WAIT_L(0); PG8_BAR; PG8_MMA(1, 0, At, B0); PG8_MMA(1, 1, At, B1); PG8_BAR; PG8_SCHED;
            PG8_LDB(B0, 1, 0); PG8_LDB(B1, 1, 1); PG8_SCHED; PG8_LDA(At, 1, 0); PG8_STAGE(PG8_SA(0, 1), a2 + hstep, voffA);
            PG8_WAIT_V(8); PG8_WAIT_L(0); PG8_BAR; PG8_MMA(0, 0, At, B0); PG8_MMA(0, 1, At, B1); PG8_BAR; PG8_SCHED;
            PG8_LDA(At, 1, 1); PG8_STAGE(PG8_SB(1, 0), b3, voffB); PG8_STAGE(PG8_SB(1, 1), b3 + hstep, voffB); PG8_STAGE(PG8_SA(1, 0), a3, voffA);
            PG8_WAIT_V(8); PG8_WAIT_L(0); PG8_BAR; PG8_MMA(1, 0, At, B0); PG8_MMA(1, 1, At, B1); PG8_BAR; PG8_SCHED;
            } else {
            PG8_LDB(B0, 0, 0); PG8_SCHED; PG8_LDA(At, 0, 0); PG8_STAGE(PG8_SA(1, 1), a1 + hstep, voffA);
            PG8_WAIT_L(8); PG8_BAR; PG8_WAIT_L(0); PG8_MMA(0, 0, At, B0); PG8_BAR; PG8_SCHED;
            PG8_LDB(B1, 0, 1); PG8_STAGE(PG8_SB(0, 0), b2, voffB);
            PG8_BAR; PG8_WAIT_L(0); PG8_MMA(0, 1, At, B1); PG8_BAR;
            PG8_LDA(At, 0, 1); PG8_STAGE(PG8_SA(0, 0), a2, voffA);
            PG8_BAR; PG8_WAIT_L(0); PG8_MMA(1, 0, At, B0); PG8_BAR; PG8_SCHED;
            PG8_STAGE(PG8_SB(0, 1), b2 + hstep, voffB);
            PG8_WAIT_V(6); PG8_BAR; PG8_MMA(1, 1, At, B1); PG8_BAR;
            PG8_LDB(B0, 1, 0); PG8_SCHED; PG8_LDA(At, 1, 0); PG8_STAGE(PG8_SA(0, 1), a2 + hstep, voffA);
            PG8_WAIT_L(8); PG8_BAR; PG8_WAIT_L(0); PG8_MMA(0, 0, At, B0); PG8_BAR; PG8_SCHED;
            PG8_LDB(B1, 1, 1); PG8_STAGE(PG8_SB(1, 0), b3, voffB);
            PG8_BAR; PG8_WAIT_L(0); PG8_MMA(0, 1, At, B1); PG8_BAR;
            PG8_LDA(At, 1, 1); PG8_STAGE(PG8_SA(1, 0), a3, voffA);
            PG8_BAR; PG8_WAIT_L(0); PG8_MMA(1, 0, At, B0); PG8_BAR; PG8_SCHED;
            PG8_STAGE(PG8_SB(1, 1), b3 + hstep, voffB);
            PG8_WAIT_V(6); PG8_BAR; PG8_MMA(1, 1, At, B1); PG8_BAR;
            }
        }
        if constexpr (ALIGN_EPI) { if (wr == 0) PG8_BAR; }
        if constexpr (!Epi::AFTER_DRAIN) { E(acc, cur, wr, wc, fr, fq); S.done(cur); }
        if (!has_next) break;
#pragma unroll
        for (int a = 0; a < 2; ++a)
#pragma unroll
            for (int b = 0; b < 2; ++b)
#pragma unroll
                for (int m = 0; m < 4; ++m)
#pragma unroll
                    for (int n = 0; n < 2; ++n) acc[a][b][m][n] = (f32x4){0.f, 0.f, 0.f, 0.f};
        cur = nxt; cA = nA; cB = nB; ++ui;
        if constexpr (ALIGN_EPI) { if (wr == 1) PG8_BAR; }
    }
    PG8_WAIT_V(0);
    if constexpr (!ALIGN_EPI) { if (wr == 0) PG8_BAR; }
    PG8_BAR;
    if constexpr (Epi::AFTER_DRAIN) { E.fused(acc, cur, wr, wc, fr, fq, lds, wid, lane); S.done(cur); }
#undef PG8_SA
#undef PG8_SB
#undef PG8_STAGE
#undef PG8_LDA
#undef PG8_LDB
#undef PG8_MMA
#undef PG8_WAIT_V
#undef PG8_WAIT_L
#undef PG8_BAR
#undef PG8_SCHED
}
}


#define LAS __attribute__((address_space(3)))
typedef unsigned short bf16_t;
typedef float f32x4 __attribute__((ext_vector_type(4)));
typedef unsigned u32x4 __attribute__((ext_vector_type(4)));
typedef unsigned u32x2 __attribute__((ext_vector_type(2)));

constexpr int BATCH = 8, SEQ = 4096, DM = 1024, T = BATCH * SEQ, DEPTH = 2;
constexpr int NPROJ = 4352, NMOD = 6 * DM;
constexpr int NEXP = 16384, PQ = 2048;
constexpr float NORM_EPS = 1e-6f;
constexpr float LOG2E = 1.4426950408889634f;
constexpr float QSCALE = 0.125f * LOG2E;
constexpr float SB_EXIT = 160.0f;

constexpr size_t MiB = 1u << 20;
constexpr size_t WS_CTL = 0;
constexpr size_t WS_MOD = 1 * MiB;
constexpr size_t WS_ROPE = 2 * MiB;
constexpr size_t WS_WIN = 10 * MiB;
constexpr size_t WS_WBA = 27 * MiB;
constexpr size_t WS_WBB = 29 * MiB;
constexpr size_t WS_WOUT = 31 * MiB;
constexpr size_t WS_WQ = 35 * MiB;
constexpr size_t WS_SK = 43 * MiB;
constexpr size_t WS_UQ = 44 * MiB;
constexpr size_t WS_VQ = 76 * MiB;
constexpr size_t WS_USC = 108 * MiB;
constexpr size_t WS_VSC = 108 * MiB + 256 * 1024;
constexpr size_t WS_HS = 109 * MiB;
constexpr size_t WS_H = 112 * MiB;
constexpr size_t WS_QA = 176 * MiB;
constexpr size_t WS_QB = 208 * MiB;
constexpr size_t WS_KB = 240 * MiB;
constexpr size_t WS_VB = 272 * MiB;
constexpr size_t WS_KA = 304 * MiB;
constexpr size_t WS_VA = 312 * MiB;
constexpr size_t WS_GA = 320 * MiB;
constexpr size_t WS_GB = 384 * MiB;
constexpr size_t WS_END = 448 * MiB;
constexpr size_t WS_H2Q = WS_QA, WS_IDX = WS_KB, WS_GATE = WS_VB, WS_Q2 = WS_GA;

constexpr int LDS_BYTES = 147456;
constexpr int NTHREADS = 512, NWAVES = 8;

struct KArgs {
    const float* x; const float* c; const int* pos; const float* ada_w; const float* ada_b; const float* norm1_g; const float* w_in; const float* sinks;
    const float* wbr_a; const float* wbr_b; const float* w_out; const float* norm2_g; const float* wq; const float* subkeys; const float* pu; const float* pv; const float* final_g;
    float* out; unsigned char* ws; int ph_lo, ph_hi;
};

__device__ __forceinline__ unsigned f2bf(float f) { unsigned u = __float_as_uint(f); return (u + 0x7fffu + ((u >> 16) & 1u)) >> 16; }
__device__ __forceinline__ unsigned pk2(float lo, float hi) { return f2bf(lo) | (f2bf(hi) << 16); }
__device__ __forceinline__ float bflo(unsigned w) { return __uint_as_float(w << 16); }
__device__ __forceinline__ float bfhi(unsigned w) { return __uint_as_float(w & 0xffff0000u); }
template <int M> __device__ __forceinline__ float swz_xor(float v) { return __int_as_float(__builtin_amdgcn_ds_swizzle(__float_as_int(v), (M << 10) | 0x1f)); }
__device__ __forceinline__ float wave_sum(float v) {
    v += swz_xor<1>(v); v += swz_xor<2>(v); v += swz_xor<4>(v); v += swz_xor<8>(v); v += swz_xor<16>(v);
    auto rr = __builtin_amdgcn_permlane32_swap(__float_as_uint(v), __float_as_uint(v), false, false);
    return __uint_as_float(rr[0]) + __uint_as_float(rr[1]);
}
__device__ __forceinline__ float wave_max(float v) {
    v = fmaxf(v, swz_xor<1>(v)); v = fmaxf(v, swz_xor<2>(v)); v = fmaxf(v, swz_xor<4>(v)); v = fmaxf(v, swz_xor<8>(v)); v = fmaxf(v, swz_xor<16>(v));
    auto rr = __builtin_amdgcn_permlane32_swap(__float_as_uint(v), __float_as_uint(v), false, false);
    return fmaxf(__uint_as_float(rr[0]), __uint_as_float(rr[1]));
}
__device__ __forceinline__ int rdlane_i(int v, int l) { return __builtin_amdgcn_readlane(v, __builtin_amdgcn_readfirstlane(l)); }
__device__ __forceinline__ float rdlane_f(float v, int l) { return __int_as_float(__builtin_amdgcn_readlane(__float_as_int(v), __builtin_amdgcn_readfirstlane(l))); }
__device__ __forceinline__ float dot8(u32x4 a, u32x4 b, float acc) {
    acc = fmaf(bflo(a.x), bflo(b.x), acc); acc = fmaf(bfhi(a.x), bfhi(b.x), acc);
    acc = fmaf(bflo(a.y), bflo(b.y), acc); acc = fmaf(bfhi(a.y), bfhi(b.y), acc);
    acc = fmaf(bflo(a.z), bflo(b.z), acc); acc = fmaf(bfhi(a.z), bfhi(b.z), acc);
    acc = fmaf(bflo(a.w), bflo(b.w), acc); acc = fmaf(bfhi(a.w), bfhi(b.w), acc);
    return acc;
}
__device__ __forceinline__ float softplus2(float z2) {
    return fmaxf(z2, 0.f) + __log2f(1.0f + exp2f(-fabsf(z2)));
}

__device__ __forceinline__ int win_pos(int n) {
    if (n >= 640) return n;
    const int hb = n & ~63, d = n & 63;
    return hb + (d < 32 ? 2 * d : 2 * (d - 32) + 1);
}
template <bool WIN>
__device__ __forceinline__ void transpose_item(const float* W, int K, int N, bf16_t* WT, LAS float* scr, int item, int lane) {
    const int nblk = N / 32, kb = item / nblk, nb = item % nblk, k0 = 64 * kb, n0 = 32 * nb;
#pragma unroll 8
    for (int i = 0; i < 32; ++i) { const int kk = 2 * i + (lane >> 5); scr[kk * 33 + (lane & 31)] = W[(size_t)(k0 + kk) * N + n0 + (lane & 31)]; }
    asm volatile("s_waitcnt lgkmcnt(0)" ::: "memory");
    const int c = lane & 7;
#pragma unroll
    for (int j = 0; j < 4; ++j) { const int n = (lane >> 3) + 8 * j; const LAS float* s = scr + (8 * c) * 33 + n;
        u32x4 o; o.x = pk2(s[0 * 33], s[1 * 33]); o.y = pk2(s[2 * 33], s[3 * 33]); o.z = pk2(s[4 * 33], s[5 * 33]); o.w = pk2(s[6 * 33], s[7 * 33]);
        const int row = WIN ? win_pos(n0 + n) : (n0 + n);
        *(u32x4*)(WT + (size_t)row * K + k0 + 8 * c) = o; }
    asm volatile("s_waitcnt lgkmcnt(0)" ::: "memory");
}
template <bool OFFSET128>
__device__ __forceinline__ void quant_row(const f32x4 (&v)[4], unsigned char* dst_row, float* scale_out, int lane) {
    float am = 0.f;
#pragma unroll
    for (int i = 0; i < 4; ++i) am = fmaxf(am, fmaxf(fmaxf(fabsf(v[i].x), fabsf(v[i].y)), fmaxf(fabsf(v[i].z), fabsf(v[i].w))));
    am = wave_max(am);
    const float inv = am > 0.f ? 127.0f / am : 0.f, sc = am > 0.f ? am / 127.0f : 1.0f;
    u32x4 o;
#pragma unroll
    for (int i = 0; i < 4; ++i) {
        int q0 = (int)rintf(v[i].x * inv), q1 = (int)rintf(v[i].y * inv), q2 = (int)rintf(v[i].z * inv), q3 = (int)rintf(v[i].w * inv);
        if (OFFSET128) { q0 += 128; q1 += 128; q2 += 128; q3 += 128; }
        o[i] = (unsigned)(q0 & 0xff) | ((unsigned)(q1 & 0xff) << 8) | ((unsigned)(q2 & 0xff) << 16) | ((unsigned)(q3 & 0xff) << 24);
    }
    *(u32x4*)(dst_row + 16 * lane) = o;
    if (lane == 0) *scale_out = sc;
}

__device__ __forceinline__ void ph_prologue(const KArgs& a, LAS unsigned char* lds) {
    int tid_op = threadIdx.x; asm volatile("" : "+v"(tid_op)); const int tid = tid_op, lane = tid & 63, wave = tid >> 6, G = gridDim.x;
    const int gw = blockIdx.x * NWAVES + wave, NGW = G * NWAVES;
    unsigned char* ws = a.ws;
    {
        LAS float* sc = (LAS float*)lds;
        for (int it = blockIdx.x; it < DEPTH * 12; it += G) {
            for (int idx = tid; idx < 8192; idx += NTHREADS) { const int b = idx >> 10, i = idx & 1023; const float cv = a.c[b * 1024 + i]; sc[i * 8 + b] = cv / (1.0f + __expf(-cv)); }
            __syncthreads();
            const int l = it / 12, j = (it % 12) * 512 + tid;
            const float* wp = a.ada_w + (size_t)l * 1024 * NMOD + j;
            float acc[8];
#pragma unroll
            for (int b = 0; b < 8; ++b) acc[b] = 0.f;
#pragma unroll 4
            for (int i = 0; i < 1024; ++i) {
                const float w = wp[(size_t)i * NMOD];
                const f32x4 s0 = *(const LAS f32x4*)(sc + i * 8), s1 = *(const LAS f32x4*)(sc + i * 8 + 4);
                acc[0] = fmaf(s0.x, w, acc[0]); acc[1] = fmaf(s0.y, w, acc[1]); acc[2] = fmaf(s0.z, w, acc[2]); acc[3] = fmaf(s0.w, w, acc[3]);
                acc[4] = fmaf(s1.x, w, acc[4]); acc[5] = fmaf(s1.y, w, acc[5]); acc[6] = fmaf(s1.z, w, acc[6]); acc[7] = fmaf(s1.w, w, acc[7]);
            }
            float* mod = (float*)(ws + WS_MOD);
            const float bias = a.ada_b[l * NMOD + j];
#pragma unroll
            for (int b = 0; b < 8; ++b) mod[(size_t)(l * 8 + b) * NMOD + j] = acc[b] + bias;
            __syncthreads();
        }
    }
    {
        LAS float* scr = (LAS float*)(lds + 32768 + wave * 8448);
        constexpr int I_IN = 16 * 136, I_BR = 8 * 32, I_OUT = 16 * 32, I_Q = 16 * 64, I_L = I_IN + 2 * I_BR + I_OUT + I_Q;
        for (int it = gw; it < DEPTH * I_L; it += NGW) {
            const int l = it / I_L; int r = it % I_L;
            if (r < I_IN) { transpose_item<true>(a.w_in + (size_t)l * 1024 * NPROJ, 1024, NPROJ, (bf16_t*)(ws + WS_WIN) + (size_t)l * NPROJ * 1024, scr, r, lane); continue; } r -= I_IN;
            if (r < I_BR) { transpose_item<false>(a.wbr_a + (size_t)l * 512 * 1024, 512, 1024, (bf16_t*)(ws + WS_WBA) + (size_t)l * 1024 * 512, scr, r, lane); continue; } r -= I_BR;
            if (r < I_BR) { transpose_item<false>(a.wbr_b + (size_t)l * 512 * 1024, 512, 1024, (bf16_t*)(ws + WS_WBB) + (size_t)l * 1024 * 512, scr, r, lane); continue; } r -= I_BR;
            if (r < I_OUT) { transpose_item<false>(a.w_out + (size_t)l * 1024 * 1024, 1024, 1024, (bf16_t*)(ws + WS_WOUT) + (size_t)l * 1024 * 1024, scr, r, lane); continue; } r -= I_OUT;
            transpose_item<false>(a.wq + (size_t)l * 1024 * PQ, 1024, PQ, (bf16_t*)(ws + WS_WQ) + (size_t)l * PQ * 1024, scr, r, lane);
        }
    }
    {
        const int gt = blockIdx.x * NTHREADS + tid, NGT = G * NTHREADS;
        for (int i = gt; i < DEPTH * 8 * 2 * 128 * 128 / 8; i += NGT) {
            const f32x4 v0 = *(const f32x4*)(a.subkeys + (size_t)i * 8), v1 = *(const f32x4*)(a.subkeys + (size_t)i * 8 + 4);
            u32x4 o; o.x = pk2(v0.x, v0.y); o.y = pk2(v0.z, v0.w); o.z = pk2(v1.x, v1.y); o.w = pk2(v1.z, v1.w);
            *(u32x4*)((bf16_t*)(ws + WS_SK) + (size_t)i * 8) = o;
        }
        for (int i = gt; i < T * 32; i += NGT) {
            const int t = i >> 5, f = i & 31;
            double inv = 1.0;
            for (int k = 0; k < f; ++k) inv *= 0.7498942093324559;
            const double ang = (double)a.pos[t] * inv;
            const double kq = rint(ang * 0.63661977236758134308);
            const double r = fma(-kq, 6.123233995736766036e-17, fma(-kq, 1.57079632679489655800, ang));
            const int quad = (int)((long long)kq & 3);
            const double r2 = r * r;
            double sp = -1.0 / 1307674368000.0; sp = fma(sp, r2, 1.0 / 6227020800.0); sp = fma(sp, r2, -1.0 / 39916800.0); sp = fma(sp, r2, 1.0 / 362880.0);
            sp = fma(sp, r2, -1.0 / 5040.0); sp = fma(sp, r2, 1.0 / 120.0); sp = fma(sp, r2, -1.0 / 6.0); sp = fma(sp * r2, r, r);
            double cp = 1.0 / 20922789888000.0; cp = fma(cp, r2, -1.0 / 87178291200.0); cp = fma(cp, r2, 1.0 / 479001600.0); cp = fma(cp, r2, -1.0 / 3628800.0);
            cp = fma(cp, r2, 1.0 / 40320.0); cp = fma(cp, r2, -1.0 / 720.0); cp = fma(cp, r2, 1.0 / 24.0); cp = fma(cp, r2, -0.5); cp = fma(cp, r2, 1.0);
            const double sn = (quad == 0) ? sp : (quad == 1) ? cp : (quad == 2) ? -sp : -cp;
            const double cs = (quad == 0) ? cp : (quad == 1) ? -sp : (quad == 2) ? -cp : sp;
            float* rp = (float*)(ws + WS_ROPE) + (size_t)i * 2; rp[0] = (float)cs; rp[1] = (float)sn;
        }
    }
    for (int r = gw; r < DEPTH * 2 * NEXP; r += NGW) {
        const int tbl = r / (DEPTH * NEXP), lr = r % (DEPTH * NEXP);
        const float* src = (tbl == 0 ? a.pu : a.pv) + (size_t)lr * 1024;
        f32x4 v[4];
#pragma unroll
        for (int i = 0; i < 4; ++i) v[i] = ((const f32x4*)src)[64 * i + lane];
        if (tbl == 0) quant_row<false>(v, ws + WS_UQ + (size_t)lr * 1024, (float*)(ws + WS_USC) + lr, lane);
        else quant_row<true>(v, ws + WS_VQ + (size_t)lr * 1024, (float*)(ws + WS_VSC) + lr, lane);
    }
}

template <bool WITH_Q8>
__device__ __forceinline__ void ph_norm(const KArgs& a, const float* xin, const float* g, const float* mod_l, int shift_idx, int scale_idx) {
    int tid_op = threadIdx.x; asm volatile("" : "+v"(tid_op)); const int tid = tid_op, lane = tid & 63, wave = tid >> 6;
    const int gw = blockIdx.x * NWAVES + wave, NGW = gridDim.x * NWAVES;
    bf16_t* H = (bf16_t*)(a.ws + WS_H);
    for (int row = gw; row < T; row += NGW) {
        const int b = row >> 12;
        f32x4 v[4]; float ss = 0.f;
#pragma unroll
        for (int i = 0; i < 4; ++i) { v[i] = ((const f32x4*)(xin + (size_t)row * DM))[64 * i + lane]; ss += (v[i].x * v[i].x + v[i].y * v[i].y) + (v[i].z * v[i].z + v[i].w * v[i].w); }
        ss = wave_sum(ss);
        const float r = 1.0f / sqrtf(ss * (1.0f / DM) + NORM_EPS);
#pragma unroll
        for (int i = 0; i < 4; ++i) {
            const int col = 256 * i + 4 * lane;
            const f32x4 gg = *(const f32x4*)(g + col), sc = *(const f32x4*)(mod_l + (size_t)b * NMOD + scale_idx * DM + col), sh = *(const f32x4*)(mod_l + (size_t)b * NMOD + shift_idx * DM + col);
            v[i] = (v[i] * r) * gg * (sc + 1.0f) + sh;
            u32x2 o; o.x = pk2(v[i].x, v[i].y); o.y = pk2(v[i].z, v[i].w);
            *(u32x2*)(H + (size_t)row * DM + col) = o;
        }
        if (WITH_Q8) quant_row<false>(v, a.ws + WS_H2Q + (size_t)row * 1024, (float*)(a.ws + WS_HS) + row, lane);
    }
}
__device__ __forceinline__ void ph_final_norm(const KArgs& a) {
    int tid_op = threadIdx.x; asm volatile("" : "+v"(tid_op)); const int tid = tid_op, lane = tid & 63, wave = tid >> 6;
    const int gw = blockIdx.x * NWAVES + wave, NGW = gridDim.x * NWAVES;
    for (int row = gw; row < T; row += NGW) {
        f32x4 v[4]; float ss = 0.f;
#pragma unroll
        for (int i = 0; i < 4; ++i) { v[i] = ((const f32x4*)(a.out + (size_t)row * DM))[64 * i + lane]; ss += (v[i].x * v[i].x + v[i].y * v[i].y) + (v[i].z * v[i].z + v[i].w * v[i].w); }
        ss = wave_sum(ss);
        const float r = 1.0f / sqrtf(ss * (1.0f / DM) + NORM_EPS);
#pragma unroll
        for (int i = 0; i < 4; ++i) { const f32x4 gg = *(const f32x4*)(a.final_g + 256 * i + 4 * lane); ((f32x4*)(a.out + (size_t)row * DM))[64 * i + lane] = (v[i] * r) * gg; }
    }
}

struct EpiProj {
    static constexpr bool PERM = true, AFTER_DRAIN = false;
    unsigned char* ws;
    __device__ __forceinline__ void operator()(const pg8::f32x4 (&acc)[2][2][4][2], const pg8::Unit& u, int wr, int wc, int fr, int fq) const {
        const int row0 = u.pm * 256 + wr * 64 + fr;
        const float* rope = (const float*)(ws + WS_ROPE);
#pragma unroll
        for (int bj = 0; bj < 2; ++bj) {
            const int cgb = u.pn * 256 + bj * 128;
            bf16_t* base; int pitch, cl, mode;
            if (cgb < 512) { base = (bf16_t*)(ws + WS_QA); pitch = 512; cl = cgb; mode = 1; }
            else if (cgb < 640) { base = (bf16_t*)(ws + WS_KA); pitch = 128; cl = cgb - 512; mode = 2; }
            else if (cgb < 768) { base = (bf16_t*)(ws + WS_VA); pitch = 128; cl = cgb - 640; mode = 0; }
            else if (cgb < 1280) { base = (bf16_t*)(ws + WS_QB); pitch = 512; cl = cgb - 768; mode = 3; }
            else if (cgb < 1792) { base = (bf16_t*)(ws + WS_KB); pitch = 512; cl = cgb - 1280; mode = 0; }
            else if (cgb < 2304) { base = (bf16_t*)(ws + WS_VB); pitch = 512; cl = cgb - 1792; mode = 0; }
            else if (cgb < 3328) { base = (bf16_t*)(ws + WS_GA); pitch = 1024; cl = cgb - 2304; mode = 4; }
            else { base = (bf16_t*)(ws + WS_GB); pitch = 1024; cl = cgb - 3328; mode = 4; }
            const int col = cl + wc * 32 + 8 * fq;
#pragma unroll
            for (int ai = 0; ai < 2; ++ai)
#pragma unroll
                for (int m = 0; m < 4; ++m) {
                    const int row = row0 + ai * 128 + m * 16;
                    pg8::f32x4 v0 = acc[ai][bj][m][0], v1 = acc[ai][bj][m][1];
                    if (mode == 1 || mode == 2) {
                        const int i0 = (col & 63) >> 1;
                        const f32x4 c01 = *(const f32x4*)(rope + ((size_t)row * 32 + i0) * 2), c23 = *(const f32x4*)(rope + ((size_t)row * 32 + i0 + 2) * 2);
                        pg8::f32x4 w0, w1;
                        w0[0] = v0[0] * c01.x - v0[1] * c01.y; w0[1] = v0[1] * c01.x + v0[0] * c01.y;
                        w0[2] = v0[2] * c01.z - v0[3] * c01.w; w0[3] = v0[3] * c01.z + v0[2] * c01.w;
                        w1[0] = v1[0] * c23.x - v1[1] * c23.y; w1[1] = v1[1] * c23.x + v1[0] * c23.y;
                        w1[2] = v1[2] * c23.z - v1[3] * c23.w; w1[3] = v1[3] * c23.z + v1[2] * c23.w;
                        v0 = w0; v1 = w1;
                    }
                    if (mode == 1 || mode == 3) { v0 = v0 * QSCALE; v1 = v1 * QSCALE; }
                    if (mode == 4) {
#pragma unroll
                        for (int e = 0; e < 4; ++e) { v0[e] = 1.0f / (1.0f + __expf(-v0[e])); v1[e] = 1.0f / (1.0f + __expf(-v1[e])); }
                    }
                    u32x4 w; w.x = pk2(v0[0], v0[1]); w.y = pk2(v0[2], v0[3]); w.z = pk2(v1[0], v1[1]); w.w = pk2(v1[2], v1[3]);
                    *(u32x4*)(base + (size_t)row * pitch + col) = w;
                }
        }
    }
};
template <bool ADD> struct EpiBranch {
    static constexpr bool PERM = true, AFTER_DRAIN = false;
    const bf16_t* Gt; bf16_t* O;
    __device__ __forceinline__ void operator()(const pg8::f32x4 (&acc)[2][2][4][2], const pg8::Unit& u, int wr, int wc, int fr, int fq) const {
        const int row0 = u.pm * 256 + wr * 64 + fr, col0 = u.pn * 256 + wc * 32 + 8 * fq;
#pragma unroll
        for (int ai = 0; ai < 2; ++ai)
#pragma unroll
            for (int m = 0; m < 4; ++m)
#pragma unroll
                for (int bj = 0; bj < 2; ++bj) {
                    const size_t off = (size_t)(row0 + ai * 128 + m * 16) * DM + col0 + bj * 128;
                    const u32x4 gv = *(const u32x4*)(Gt + off);
                    const pg8::f32x4 v0 = acc[ai][bj][m][0], v1 = acc[ai][bj][m][1];
                    float r[8];
                    r[0] = bflo(gv.x) * v0[0]; r[1] = bfhi(gv.x) * v0[1]; r[2] = bflo(gv.y) * v0[2]; r[3] = bfhi(gv.y) * v0[3];
                    r[4] = bflo(gv.z) * v1[0]; r[5] = bfhi(gv.z) * v1[1]; r[6] = bflo(gv.w) * v1[2]; r[7] = bfhi(gv.w) * v1[3];
                    if (ADD) { const u32x4 ov = *(const u32x4*)(O + off);
                        r[0] += bflo(ov.x); r[1] += bfhi(ov.x); r[2] += bflo(ov.y); r[3] += bfhi(ov.y); r[4] += bflo(ov.z); r[5] += bfhi(ov.z); r[6] += bflo(ov.w); r[7] += bfhi(ov.w); }
                    u32x4 w; w.x = pk2(r[0], r[1]); w.y = pk2(r[2], r[3]); w.z = pk2(r[4], r[5]); w.w = pk2(r[6], r[7]);
                    *(u32x4*)(O + off) = w;
                }
    }
};
struct EpiWout {
    static constexpr bool PERM = false, AFTER_DRAIN = false;
    const float* xold; float* xnew; const float* gate;
    __device__ __forceinline__ void operator()(const pg8::f32x4 (&acc)[2][2][4][2], const pg8::Unit& u, int wr, int wc, int fr, int fq) const {
        const int row0 = u.pm * 256 + wr * 64 + fr, col0 = u.pn * 256 + wc * 32 + 4 * fq, b = u.pm >> 4;
#pragma unroll
        for (int bj = 0; bj < 2; ++bj)
#pragma unroll
            for (int n = 0; n < 2; ++n) {
                const pg8::f32x4 gv = *(const pg8::f32x4*)(gate + (size_t)b * NMOD + col0 + bj * 128 + n * 16);
#pragma unroll
                for (int ai = 0; ai < 2; ++ai)
#pragma unroll
                    for (int m = 0; m < 4; ++m) { const size_t off = (size_t)(row0 + ai * 128 + m * 16) * DM + col0 + bj * 128 + n * 16;
                        const pg8::f32x4 xo = *(const pg8::f32x4*)(xold + off);
                        *(pg8::f32x4*)(xnew + off) = xo + gv * acc[ai][bj][m][n]; }
            }
    }
};
struct EpiPlainBf16 {
    static constexpr bool PERM = true, AFTER_DRAIN = false;
    bf16_t* O; int ldc;
    __device__ __forceinline__ void operator()(const pg8::f32x4 (&acc)[2][2][4][2], const pg8::Unit& u, int wr, int wc, int fr, int fq) const {
        const int row0 = u.pm * 256 + wr * 64 + fr, col0 = u.pn * 256 + wc * 32 + 8 * fq;
#pragma unroll
        for (int ai = 0; ai < 2; ++ai)
#pragma unroll
            for (int m = 0; m < 4; ++m)
#pragma unroll
                for (int bj = 0; bj < 2; ++bj) {
                    const pg8::f32x4 v0 = acc[ai][bj][m][0], v1 = acc[ai][bj][m][1];
                    u32x4 w; w.x = pk2(v0[0], v0[1]); w.y = pk2(v0[2], v0[3]); w.z = pk2(v1[0], v1[1]); w.w = pk2(v1[2], v1[3]);
                    *(u32x4*)(O + (size_t)(row0 + ai * 128 + m * 16) * ldc + col0 + bj * 128) = w;
                }
    }
};

namespace att {
typedef short bf16x8 __attribute__((ext_vector_type(8)));
typedef short s16x4 __attribute__((ext_vector_type(4)));
typedef float f32x16 __attribute__((ext_vector_type(16)));
__device__ __forceinline__ int crow(int r, int hi) { return (r & 3) + 8 * (r >> 2) + 4 * hi; }
typedef float f32x2_t __attribute__((ext_vector_type(2))); typedef __bf16 bf16x2_t __attribute__((ext_vector_type(2)));
__device__ __forceinline__ unsigned cvtpk(float lo, float hi) { f32x2_t v = {lo, hi}; bf16x2_t b = __builtin_convertvector(v, bf16x2_t); return __builtin_bit_cast(unsigned, b); }
#define ATT_SBAR() __builtin_amdgcn_sched_barrier(0)

__device__ __forceinline__ void qkt(f32x16& p0, f32x16& p1, const LAS unsigned char* kslot, const bf16x8 (&qr)[4], int r32, int hi) {
    const LAS unsigned char* kb = kslot + hi * 1024 + r32 * 16;
    p0 = f32x16{}; p1 = f32x16{};
#pragma unroll
    for (int d0 = 0; d0 < 4; ++d0) {
        const bf16x8 b0 = *(const LAS bf16x8*)(kb + d0 * 2048);
        const bf16x8 b1 = *(const LAS bf16x8*)(kb + d0 * 2048 + 512);
        p0 = __builtin_amdgcn_mfma_f32_32x32x16_bf16(b0, qr[d0], p0, 0, 0, 0);
        p1 = __builtin_amdgcn_mfma_f32_32x32x16_bf16(b1, qr[d0], p1, 0, 0, 0);
    }
}
__device__ __forceinline__ void pv(f32x16 (&o)[2], int vb, bf16x8 pa0, bf16x8 pa1, bf16x8 pa2, bf16x8 pa3) {
#pragma unroll
    for (int d0 = 0; d0 < 2; ++d0) {
        s16x4 lo[4], hh[4];
#pragma unroll
        for (int ks = 0; ks < 4; ++ks) {
            asm volatile("ds_read_b64_tr_b16 %0,%1 offset:%c2" : "=&v"(lo[ks]) : "v"(vb), "i"(d0 * 4096 + ks * 1024) : "memory");
            asm volatile("ds_read_b64_tr_b16 %0,%1 offset:%c2" : "=&v"(hh[ks]) : "v"(vb), "i"(d0 * 4096 + ks * 1024 + 512) : "memory");
        }
        asm volatile("s_waitcnt lgkmcnt(0)" ::: "memory"); ATT_SBAR();
#define ATT_PK(k) (bf16x8){lo[k][0], lo[k][1], lo[k][2], lo[k][3], hh[k][0], hh[k][1], hh[k][2], hh[k][3]}
        o[d0] = __builtin_amdgcn_mfma_f32_32x32x16_bf16(pa0, ATT_PK(0), o[d0], 0, 0, 0);
        o[d0] = __builtin_amdgcn_mfma_f32_32x32x16_bf16(pa1, ATT_PK(1), o[d0], 0, 0, 0);
        o[d0] = __builtin_amdgcn_mfma_f32_32x32x16_bf16(pa2, ATT_PK(2), o[d0], 0, 0, 0);
        o[d0] = __builtin_amdgcn_mfma_f32_32x32x16_bf16(pa3, ATT_PK(3), o[d0], 0, 0, 0);
#undef ATT_PK
    }
}
__device__ __forceinline__ void pack_p(const f32x16& p0, const f32x16& p1, bf16x8& pa0, bf16x8& pa1, bf16x8& pa2, bf16x8& pa3) {
    u32x4 w0, w1, w2, w3;
    w0 = (u32x4){cvtpk(p0[0], p0[1]), cvtpk(p0[2], p0[3]), cvtpk(p0[4], p0[5]), cvtpk(p0[6], p0[7])};
    w1 = (u32x4){cvtpk(p0[8], p0[9]), cvtpk(p0[10], p0[11]), cvtpk(p0[12], p0[13]), cvtpk(p0[14], p0[15])};
    w2 = (u32x4){cvtpk(p1[0], p1[1]), cvtpk(p1[2], p1[3]), cvtpk(p1[4], p1[5]), cvtpk(p1[6], p1[7])};
    w3 = (u32x4){cvtpk(p1[8], p1[9]), cvtpk(p1[10], p1[11]), cvtpk(p1[12], p1[13]), cvtpk(p1[14], p1[15])};
    pa0 = __builtin_bit_cast(bf16x8, w0); pa1 = __builtin_bit_cast(bf16x8, w1); pa2 = __builtin_bit_cast(bf16x8, w2); pa3 = __builtin_bit_cast(bf16x8, w3);
}
__device__ __forceinline__ u32x4 tile_gload(const bf16_t* src, int pitch, int tid) { return *(const u32x4*)(src + (size_t)(tid >> 3) * pitch + (tid & 7) * 8); }
__device__ __forceinline__ void tile_kwrite(LAS unsigned char* kslot, u32x4 v, int tid) { *(LAS u32x4*)(kslot + (tid & 7) * 1024 + (tid >> 3) * 16) = v; }
__device__ __forceinline__ void tile_vwrite(LAS unsigned char* vslot, u32x4 v, int tid) { const int c = tid & 7; *(LAS u32x4*)(vslot + (c >> 2) * 4096 + (tid >> 3) * 64 + (c & 3) * 16) = v; }
__device__ __forceinline__ void store_o(const f32x16 (&o)[2], const float (&rs)[16], LAS unsigned char* stage, bf16_t* Ow, int pitch, int lane) {
    const int r32 = lane & 31, hi = lane >> 5;
    LAS bf16_t* stg = (LAS bf16_t*)stage;
#pragma unroll
    for (int r = 0; r < 16; ++r) { const int orow = crow(r, hi);
#pragma unroll
        for (int d0 = 0; d0 < 2; ++d0) stg[orow * 64 + d0 * 32 + r32] = (bf16_t)f2bf(o[d0][r] * rs[r]); }
    asm volatile("s_waitcnt lgkmcnt(0)" ::: "memory");
#pragma unroll
    for (int i = 0; i < 4; ++i) { const int row = i * 8 + (lane >> 3), ch = lane & 7; const u32x4 v = *(const LAS u32x4*)(stg + row * 64 + ch * 8); *(u32x4*)(Ow + (size_t)row * pitch + ch * 8) = v; }
    asm volatile("s_waitcnt lgkmcnt(0)" ::: "memory");
}

constexpr int SB_K0 = 0, SB_V0 = 16384, SB_STAGE = 32768, SB_FLAGS = 65536, SB_LDS_END = 65536 + 64;
template <bool EARLY_EXIT>
__device__ __forceinline__ void sb_phase(const bf16_t* Q, const bf16_t* K, const bf16_t* V, bf16_t* O, LAS unsigned char* lds) {
    int tid_op = threadIdx.x; asm volatile("" : "+v"(tid_op));
    const int tid = tid_op, lane = tid & 63, r32 = lane & 31, hi = lane >> 5, wid = __builtin_amdgcn_readfirstlane(tid >> 6);
    const int vb0 = (int)(unsigned)(uintptr_t)(lds + SB_V0) + ((lane >> 4) & 1) * 32 + (lane & 3) * 8 + (4 * hi + ((lane & 15) >> 2)) * 64;
    volatile LAS unsigned* flags = (volatile LAS unsigned*)(lds + SB_FLAGS);
    const float m0 = hi == 0 ? 1.0f : 0.0f;
    for (int unit = blockIdx.x; unit < BATCH * 8 * 16; unit += gridDim.x) {
        const int qb = unit & 15, h = (unit >> 4) & 7, b = unit >> 7;
        const int q0 = qb * 256;
        const size_t rowbase = (size_t)b * SEQ;
        const bf16_t* Kh = K + rowbase * 512 + h * 64; const bf16_t* Vh = V + rowbase * 512 + h * 64;
        const bf16_t* Qw = Q + (rowbase + q0 + wid * 32) * 512 + h * 64;
        int kt = 4 * qb + 3;
        u32x4 kreg = tile_gload(Kh + (size_t)kt * 64 * 512, 512, tid), vreg = tile_gload(Vh + (size_t)kt * 64 * 512, 512, tid);
        bf16x8 qr[4];
#pragma unroll
        for (int d0 = 0; d0 < 4; ++d0) qr[d0] = *(const bf16x8*)(Qw + (size_t)r32 * 512 + d0 * 16 + hi * 8);
        if (tid < 16) flags[tid] = 0u;
        tile_kwrite(lds + SB_K0, kreg, tid); tile_vwrite(lds + SB_V0, vreg, tid);
        f32x16 o[2]; o[0] = f32x16{}; o[1] = f32x16{};
        float carry = 0.f;
        int cur = 0, it = 0;
        for (;;) {
            __syncthreads();
            if (EARLY_EXIT && it > 0) {
                const int fs = ((it - 1) & 1) * 8;
                unsigned all = 1u;
#pragma unroll
                for (int w = 0; w < 8; ++w) all &= flags[fs + w];
                if (all) break;
            }
            const bool more = kt > 0;
            if (more) { kreg = tile_gload(Kh + (size_t)(kt - 1) * 64 * 512, 512, tid); vreg = tile_gload(Vh + (size_t)(kt - 1) * 64 * 512, 512, tid); }
            const int D = q0 + 32 * wid - 64 * kt;
            if (D + 31 > 0) {
                f32x16 p0, p1;
                qkt(p0, p1, lds + SB_K0 + cur * 8192, qr, r32, hi);
                if (D < 64) {
                    const int qrel = D + r32;
#pragma unroll
                    for (int r = 0; r < 16; ++r) { const int kv = crow(r, hi); if (kv >= qrel) p0[r] = -INFINITY; if (kv + 32 >= qrel) p1[r] = -INFINITY; }
                }
                f32x16 l0, l1;
#pragma unroll
                for (int r = 0; r < 16; ++r) { l0[r] = fmaxf(p0[r], 0.f) + __log2f(1.0f + exp2f(-fabsf(p0[r]))); l1[r] = fmaxf(p1[r], 0.f) + __log2f(1.0f + exp2f(-fabsf(p1[r]))); }
                float tt[8], uu[8];
#pragma unroll
                for (int i = 0; i < 4; ++i) { tt[i] = (l0[4 * i] + l0[4 * i + 1]) + (l0[4 * i + 2] + l0[4 * i + 3]); tt[4 + i] = (l1[4 * i] + l1[4 * i + 1]) + (l1[4 * i + 2] + l1[4 * i + 3]); }
#pragma unroll
                for (int k = 0; k < 8; ++k) { auto rr = __builtin_amdgcn_permlane32_swap(__float_as_uint(tt[k]), __float_as_uint(tt[k]), false, false); uu[k] = __uint_as_float(hi ? rr[0] : rr[1]); }
                float sw = 0.f, base[8];
#pragma unroll
                for (int k = 7; k >= 0; --k) { base[k] = carry - (sw + m0 * uu[k]); sw += tt[k] + uu[k]; }
#pragma unroll
                for (int i = 0; i < 4; ++i) {
                    float s3 = l0[4 * i + 3], s2 = s3 + l0[4 * i + 2], s1 = s2 + l0[4 * i + 1], s0 = s1 + l0[4 * i];
                    p0[4 * i + 3] = exp2f(p0[4 * i + 3] + (base[i] - s3)); p0[4 * i + 2] = exp2f(p0[4 * i + 2] + (base[i] - s2));
                    p0[4 * i + 1] = exp2f(p0[4 * i + 1] + (base[i] - s1)); p0[4 * i] = exp2f(p0[4 * i] + (base[i] - s0));
                    s3 = l1[4 * i + 3]; s2 = s3 + l1[4 * i + 2]; s1 = s2 + l1[4 * i + 1]; s0 = s1 + l1[4 * i];
                    p1[4 * i + 3] = exp2f(p1[4 * i + 3] + (base[4 + i] - s3)); p1[4 * i + 2] = exp2f(p1[4 * i + 2] + (base[4 + i] - s2));
                    p1[4 * i + 1] = exp2f(p1[4 * i + 1] + (base[4 + i] - s1)); p1[4 * i] = exp2f(p1[4 * i] + (base[4 + i] - s0));
                }
                carry -= sw;
                bf16x8 pa0, pa1, pa2, pa3; pack_p(p0, p1, pa0, pa1, pa2, pa3);
                pv(o, vb0 + cur * 8192, pa0, pa1, pa2, pa3);
            }
            if (EARLY_EXIT) { const bool done = __all(carry < -SB_EXIT); if (lane == 0) flags[(it & 1) * 8 + wid] = done ? 1u : 0u; }
            if (!more) break;
            tile_kwrite(lds + SB_K0 + (cur ^ 1) * 8192, kreg, tid); tile_vwrite(lds + SB_V0 + (cur ^ 1) * 8192, vreg, tid);
            cur ^= 1; --kt; ++it;
        }
        float ones[16];
#pragma unroll
        for (int r = 0; r < 16; ++r) ones[r] = 1.0f;
        store_o(o, ones, lds + SB_STAGE + wid * 4096, O + (rowbase + q0 + wid * 32) * 512 + h * 64, 512, lane);
        __syncthreads();
    }
}

constexpr int SW_K0 = 0, SW_V0 = 24576, SW_STAGE = 49152, SW_WSF = 81920, SW_LDS_END = 81920 + 2048;
__device__ __forceinline__ void swa_phase(const bf16_t* Q, const bf16_t* K, const bf16_t* V, bf16_t* O, const float* sinks, LAS unsigned char* lds) {
    int tid_op = threadIdx.x; asm volatile("" : "+v"(tid_op));
    const int tid = tid_op, lane = tid & 63, r32 = lane & 31, hi = lane >> 5, wid = __builtin_amdgcn_readfirstlane(tid >> 6);
    const int vb0 = (int)(unsigned)(uintptr_t)(lds + SW_V0) + ((lane >> 4) & 1) * 32 + (lane & 3) * 8 + (4 * hi + ((lane & 15) >> 2)) * 64;
    LAS float* wsf = (LAS float*)(lds + SW_WSF) + wid * 64;
    const int g = wid >> 1, j = wid & 1;
    for (int unit = blockIdx.x; unit < BATCH * 2 * 64; unit += gridDim.x) {
        const int qb = unit & 63, kvh = (unit >> 6) & 1, b = unit >> 7;
        const int q0 = qb * 64, hq = kvh * 4 + g;
        const size_t rowbase = (size_t)b * SEQ;
        const bf16_t* Kh = K + rowbase * 128 + kvh * 64; const bf16_t* Vh = V + rowbase * 128 + kvh * 64;
        const bf16_t* Qw = Q + (rowbase + q0 + j * 32) * 512 + hq * 64;
        __syncthreads();
#pragma unroll
        for (int i = 0; i < 3; ++i) { const int kt = qb - 2 + i;
            if (kt >= 0) { const u32x4 kv = tile_gload(Kh + (size_t)kt * 64 * 128, 128, tid), vv = tile_gload(Vh + (size_t)kt * 64 * 128, 128, tid);
                tile_kwrite(lds + SW_K0 + i * 8192, kv, tid); tile_vwrite(lds + SW_V0 + i * 8192, vv, tid); } }
        bf16x8 qr[4];
#pragma unroll
        for (int d0 = 0; d0 < 4; ++d0) qr[d0] = *(const bf16x8*)(Qw + (size_t)r32 * 512 + d0 * 16 + hi * 8);
        __syncthreads();
        const int qrel = 32 * j + r32;
        const float sink2 = sinks[hq] * LOG2E;
        float m = sink2;
#pragma unroll
        for (int i = 0; i < 3; ++i) {
            if (qb - 2 + i >= 0) {
                f32x16 p0, p1;
                qkt(p0, p1, lds + SW_K0 + i * 8192, qr, r32, hi);
#pragma unroll
                for (int r = 0; r < 16; ++r) { const int kv = crow(r, hi);
                    bool v0 = true, v1 = true;
                    if (i == 2) { v0 = kv <= qrel; v1 = kv + 32 <= qrel; }
                    if (i == 0) { v0 = kv > qrel; v1 = kv + 32 > qrel; }
                    m = fmaxf(m, fmaxf(v0 ? p0[r] : -INFINITY, v1 ? p1[r] : -INFINITY)); }
            }
        }
        { auto rr = __builtin_amdgcn_permlane32_swap(__float_as_uint(m), __float_as_uint(m), false, false); m = fmaxf(__uint_as_float(rr[0]), __uint_as_float(rr[1])); }
        float lsum = 0.f;
        f32x16 o[2]; o[0] = f32x16{}; o[1] = f32x16{};
#pragma unroll
        for (int i = 0; i < 3; ++i) {
            if (qb - 2 + i >= 0) {
                f32x16 p0, p1;
                qkt(p0, p1, lds + SW_K0 + i * 8192, qr, r32, hi);
#pragma unroll
                for (int r = 0; r < 16; ++r) { const int kv = crow(r, hi);
                    bool v0 = true, v1 = true;
                    if (i == 2) { v0 = kv <= qrel; v1 = kv + 32 <= qrel; }
                    if (i == 0) { v0 = kv > qrel; v1 = kv + 32 > qrel; }
                    p0[r] = v0 ? exp2f(p0[r] - m) : 0.f; p1[r] = v1 ? exp2f(p1[r] - m) : 0.f; lsum += p0[r] + p1[r]; }
                bf16x8 pa0, pa1, pa2, pa3; pack_p(p0, p1, pa0, pa1, pa2, pa3); pv(o, vb0 + i * 8192, pa0, pa1, pa2, pa3);
            }
        }
        { auto rr = __builtin_amdgcn_permlane32_swap(__float_as_uint(lsum), __float_as_uint(lsum), false, false); lsum = __uint_as_float(rr[0]) + __uint_as_float(rr[1]); }
        lsum += exp2f(sink2 - m);
        if (hi == 0) wsf[r32] = 1.0f / lsum;
        asm volatile("s_waitcnt lgkmcnt(0)" ::: "memory");
        float rs[16];
#pragma unroll
        for (int r = 0; r < 16; ++r) rs[r] = wsf[crow(r, hi)];
        asm volatile("s_waitcnt lgkmcnt(0)" ::: "memory");
        store_o(o, rs, lds + SW_STAGE + wid * 4096, O + (rowbase + q0 + j * 32) * 512 + hq * 64, 512, lane);
    }
}
#undef ATT_SBAR
}

__device__ __forceinline__ void ph_topk(const KArgs& a, int l, LAS unsigned char* lds) {
    int tid_op = threadIdx.x; asm volatile("" : "+v"(tid_op)); const int tid = tid_op, lane = tid & 63, wave = tid >> 6;
    const int gw = blockIdx.x * NWAVES + wave, NGW = gridDim.x * NWAVES;
    const bf16_t* Q2 = (const bf16_t*)(a.ws + WS_Q2);
    const bf16_t* SK = (const bf16_t*)(a.ws + WS_SK) + (size_t)l * 8 * 2 * 128 * 128;
    int* IDX = (int*)(a.ws + WS_IDX); float* GATE = (float*)(a.ws + WS_GATE);
    LAS float* ls_s = (LAS float*)(lds + wave * 256);
    LAS int* ls_i = (LAS int*)(lds + wave * 256 + 128);
    for (int it = gw; it < T * 8; it += NGW) {
        const int h = it & 7; const size_t t = (size_t)(it >> 3);
#pragma unroll 1
        for (int p = 0; p < 2; ++p) {
            const bf16_t* qp = Q2 + t * PQ + h * 256 + p * 128;
            const bf16_t* k0 = SK + ((size_t)(h * 2 + p) * 128 + lane) * 128;
            const bf16_t* k1 = k0 + 64 * 128;
            float s0 = 0.f, s1 = 0.f;
#pragma unroll
            for (int i = 0; i < 16; ++i) { const u32x4 qv = *(const u32x4*)(qp + 8 * i); s0 = dot8(qv, *(const u32x4*)(k0 + 8 * i), s0); s1 = dot8(qv, *(const u32x4*)(k1 + 8 * i), s1); }
#pragma unroll 1
            for (int r = 0; r < 16; ++r) {
                const float wm = wave_max(fmaxf(s0, s1));
                const unsigned long long b0 = __ballot(s0 == wm), b1 = __ballot(s1 == wm);
                const int n = b0 ? (__ffsll((long long)b0) - 1) : (64 + __ffsll((long long)b1) - 1);
                if (lane == 0) { ls_s[p * 16 + r] = wm; ls_i[p * 16 + r] = n; }
                if (n == lane) s0 = -INFINITY;
                if (n == lane + 64) s1 = -INFINITY;
            }
        }
        asm volatile("s_waitcnt lgkmcnt(0)" ::: "memory");
        const int ci = lane >> 2, cj = (lane & 3) * 4;
        const float av = ls_s[ci];
        float cand[4];
#pragma unroll
        for (int k = 0; k < 4; ++k) cand[k] = av + ls_s[16 + cj + k];
        float my_s = 0.f; int my_flat = 0; float smax = 0.f;
#pragma unroll 1
        for (int r = 0; r < 16; ++r) {
            const float best = fmaxf(fmaxf(cand[0], cand[1]), fmaxf(cand[2], cand[3]));
            const float wm = wave_max(best);
            const unsigned long long bal = __ballot(best == wm);
            const int wl = __ffsll((long long)bal) - 1;
            const int kk = (cand[0] == wm) ? 0 : (cand[1] == wm) ? 1 : (cand[2] == wm) ? 2 : 3;
            const int flat_w = rdlane_i(lane * 4 + kk, wl);
            if (lane == wl) {
#pragma unroll
                for (int k = 0; k < 4; ++k) if (kk == k) cand[k] = -INFINITY;
            }
            if (lane == r) { my_s = wm; my_flat = flat_w; }
            if (r == 0) smax = wm;
        }
        const float e = lane < 16 ? __expf(my_s - smax) : 0.f;
        const float den = wave_sum(e);
        if (lane < 16) {
            const int ia = ls_i[my_flat >> 4], ib = ls_i[16 + (my_flat & 15)];
            IDX[t * 128 + h * 16 + lane] = ia * 128 + ib;
            GATE[t * 128 + h * 16 + lane] = e / den;
        }
        asm volatile("s_waitcnt lgkmcnt(0)" ::: "memory");
    }
}

__device__ __forceinline__ void ph_peer(const KArgs& a, int l, const float* mod_l) {
    int tid_op = threadIdx.x; asm volatile("" : "+v"(tid_op)); const int tid = tid_op, lane = tid & 63, wave = tid >> 6;
    const int gw = blockIdx.x * NWAVES + wave, NGW = gridDim.x * NWAVES;
    const unsigned char* UQ = a.ws + WS_UQ + (size_t)l * NEXP * 1024; const unsigned char* VQ = a.ws + WS_VQ + (size_t)l * NEXP * 1024;
    const float* USC = (const float*)(a.ws + WS_USC) + l * NEXP; const float* VSC = (const float*)(a.ws + WS_VSC) + l * NEXP;
    const int* IDX = (const int*)(a.ws + WS_IDX); const float* GATE = (const float*)(a.ws + WS_GATE);
    const unsigned char* HQ = a.ws + WS_H2Q; const float* HS = (const float*)(a.ws + WS_HS);
    for (int t = gw; t < T; t += NGW) {
        const int b = t >> 12;
        const u32x4 hv = *(const u32x4*)(HQ + (size_t)t * 1024 + 16 * lane);
        const float sh = HS[t];
        const int idx0 = IDX[(size_t)t * 128 + lane], idx1 = IDX[(size_t)t * 128 + 64 + lane];
        float coef0 = 0.f, coef1 = 0.f;
#pragma unroll 1
        for (int kb = 0; kb < 8; ++kb) {
            u32x4 uv[16]; int ee[16];
#pragma unroll
            for (int kk = 0; kk < 16; ++kk) { const int k = kb * 16 + kk; ee[kk] = rdlane_i(k < 64 ? idx0 : idx1, k & 63); uv[kk] = *(const u32x4*)(UQ + (size_t)ee[kk] * 1024 + 16 * lane); }
#pragma unroll
            for (int kk = 0; kk < 16; ++kk) {
                const int k = kb * 16 + kk;
                int is = __builtin_amdgcn_sdot4((int)uv[kk].x, (int)hv.x, 0, false);
                is = __builtin_amdgcn_sdot4((int)uv[kk].y, (int)hv.y, is, false);
                is = __builtin_amdgcn_sdot4((int)uv[kk].z, (int)hv.z, is, false);
                is = __builtin_amdgcn_sdot4((int)uv[kk].w, (int)hv.w, is, false);
                const float d = wave_sum((float)is) * USC[ee[kk]] * sh;
                const float act = 0.5f * d * (1.0f + erff(d * 0.70710678118654752f));
                if ((k & 63) == lane) { if (k < 64) coef0 = act; else coef1 = act; }
            }
        }
        coef0 *= GATE[(size_t)t * 128 + lane] * VSC[idx0];
        coef1 *= GATE[(size_t)t * 128 + 64 + lane] * VSC[idx1];
        float acc[16], csum = 0.f;
#pragma unroll
        for (int i = 0; i < 16; ++i) acc[i] = 0.f;
#pragma unroll 1
        for (int kb = 0; kb < 16; ++kb) {
            u32x4 vv[8]; float cc[8];
#pragma unroll
            for (int kk = 0; kk < 8; ++kk) { const int k = kb * 8 + kk; const int e = rdlane_i(k < 64 ? idx0 : idx1, k & 63); cc[kk] = rdlane_f(k < 64 ? coef0 : coef1, k & 63); vv[kk] = *(const u32x4*)(VQ + (size_t)e * 1024 + 16 * lane); }
#pragma unroll
            for (int kk = 0; kk < 8; ++kk) {
                csum += cc[kk];
#pragma unroll
                for (int i = 0; i < 4; ++i) { const unsigned w = vv[kk][i];
                    acc[4 * i + 0] = fmaf(cc[kk], (float)(w & 0xffu), acc[4 * i + 0]); acc[4 * i + 1] = fmaf(cc[kk], (float)((w >> 8) & 0xffu), acc[4 * i + 1]);
                    acc[4 * i + 2] = fmaf(cc[kk], (float)((w >> 16) & 0xffu), acc[4 * i + 2]); acc[4 * i + 3] = fmaf(cc[kk], (float)(w >> 24), acc[4 * i + 3]); }
            }
        }
        const float off = 128.0f * csum;
#pragma unroll
        for (int i = 0; i < 4; ++i) {
            const int col = 256 * i + 4 * lane;
            const f32x4 g = *(const f32x4*)(mod_l + (size_t)b * NMOD + 5 * DM + col);
            f32x4 xv = *(const f32x4*)(a.out + (size_t)t * DM + col);
            xv.x += g.x * (acc[4 * i + 0] - off); xv.y += g.y * (acc[4 * i + 1] - off); xv.z += g.z * (acc[4 * i + 2] - off); xv.w += g.w * (acc[4 * i + 3] - off);
            *(f32x4*)(a.out + (size_t)t * DM + col) = xv;
        }
    }
}

constexpr int PH_PER_LAYER = 9, NPHASES = 1 + DEPTH * PH_PER_LAYER + 1;
#ifndef PHASE_MASK
#define PHASE_MASK 0xFFFF
#endif
#define HASP(k) (((PHASE_MASK) >> (k)) & 1)
#ifndef SB_EARLY_EXIT
#define SB_EARLY_EXIT 1
#endif

typedef const __attribute__((address_space(4))) KArgs* KArgsP;
__device__ __forceinline__ KArgsP kargs() { KArgsP p = (KArgsP)__builtin_amdgcn_kernarg_segment_ptr(); asm volatile("" : "+s"(p)); return p; }

__device__ __forceinline__ void load_args(KArgs& a) {
#if defined(__HIP_DEVICE_COMPILE__)
    KArgsP p = kargs();
    a.x = p->x; a.c = p->c; a.pos = p->pos; a.ada_w = p->ada_w; a.ada_b = p->ada_b; a.norm1_g = p->norm1_g; a.w_in = p->w_in; a.sinks = p->sinks; a.wbr_a = p->wbr_a; a.wbr_b = p->wbr_b;
    a.w_out = p->w_out; a.norm2_g = p->norm2_g; a.wq = p->wq; a.subkeys = p->subkeys; a.pu = p->pu; a.pv = p->pv; a.final_g = p->final_g; a.out = p->out; a.ws = p->ws; a.ph_lo = p->ph_lo; a.ph_hi = p->ph_hi;
#endif
}
__global__ void __launch_bounds__(NTHREADS, 2) fwd_kernel(KArgs a_unused) {
    extern __shared__ __attribute__((aligned(16))) unsigned char lds_raw[];
    LAS unsigned char* lds = (LAS unsigned char*)lds_raw;
    cg::grid_group grid = cg::this_grid();
    const int ph_lo = kargs()->ph_lo, ph_hi = kargs()->ph_hi;
#define IN(k) (ph_lo <= (k) && (k) < ph_hi)
#define SEAM(k) do { if (IN(k) && IN((k) + 1)) grid.sync(); } while (0)
#define LOADARGS KArgs a; load_args(a); unsigned char* ws = a.ws; const int G = gridDim.x; (void)G; (void)ws
#define LAYERARGS const float* mod_l = (const float*)(ws + WS_MOD) + (size_t)l * 8 * NMOD; const float* xcur = (l == 0) ? a.x : a.out; (void)mod_l; (void)xcur
    if (IN(0)) { if (HASP(0)) { LOADARGS; ph_prologue(a, lds); } }
    SEAM(0);
#pragma unroll 1
    for (int l = 0; l < DEPTH; ++l) {
        const int p0 = 1 + l * PH_PER_LAYER;
        if (IN(p0 + 0)) { if (HASP(1)) { LOADARGS; LAYERARGS; ph_norm<false>(a, xcur, a.norm1_g + l * DM, mod_l, 0, 1); } }
        SEAM(p0 + 0);
        if (IN(p0 + 1)) { if (HASP(2)) { LOADARGS; pg8::Gemm g{(const bf16_t*)(ws + WS_H), (const bf16_t*)(ws + WS_WIN) + (size_t)l * NPROJ * 1024, T, NPROJ, 1024};
                  pg8::StaticOrder S; S.init(T, NPROJ, G, (int)blockIdx.x); EpiProj E{ws};
                  pg8::gemm_phase<EpiProj, pg8::StaticOrder, true, true>(lds, g, S, E); } }
        SEAM(p0 + 1);
        if (IN(p0 + 2)) { if (HASP(3)) { LOADARGS;
                  att::swa_phase((const bf16_t*)(ws + WS_QA), (const bf16_t*)(ws + WS_KA), (const bf16_t*)(ws + WS_VA), (bf16_t*)(ws + WS_QA), a.sinks + l * 8, lds);
                  __syncthreads();
                  att::sb_phase<SB_EARLY_EXIT != 0>((const bf16_t*)(ws + WS_QB), (const bf16_t*)(ws + WS_KB), (const bf16_t*)(ws + WS_VB), (bf16_t*)(ws + WS_QB), lds); } }
        SEAM(p0 + 2);
        if (IN(p0 + 3)) { if (HASP(4)) { LOADARGS; pg8::StaticOrder S; S.init(T, DM, G, (int)blockIdx.x);
                  { pg8::Gemm g{(const bf16_t*)(ws + WS_QA), (const bf16_t*)(ws + WS_WBA) + (size_t)l * 1024 * 512, T, DM, 512};
                    EpiBranch<false> E{(const bf16_t*)(ws + WS_GA), (bf16_t*)(ws + WS_H)};
                    pg8::gemm_phase<EpiBranch<false>, pg8::StaticOrder, true, true>(lds, g, S, E); }
                  __syncthreads();
                  { pg8::Gemm g{(const bf16_t*)(ws + WS_QB), (const bf16_t*)(ws + WS_WBB) + (size_t)l * 1024 * 512, T, DM, 512};
                    EpiBranch<true> E{(const bf16_t*)(ws + WS_GB), (bf16_t*)(ws + WS_H)};
                    pg8::gemm_phase<EpiBranch<true>, pg8::StaticOrder, true, true>(lds, g, S, E); } } }
        SEAM(p0 + 3);
        if (IN(p0 + 4)) { if (HASP(5)) { LOADARGS; LAYERARGS; pg8::Gemm g{(const bf16_t*)(ws + WS_H), (const bf16_t*)(ws + WS_WOUT) + (size_t)l * 1024 * 1024, T, DM, 1024};
                  pg8::StaticOrder S; S.init(T, DM, G, (int)blockIdx.x); EpiWout E{xcur, a.out, mod_l + 2 * DM};
                  pg8::gemm_phase<EpiWout, pg8::StaticOrder, true, true>(lds, g, S, E); } }
        SEAM(p0 + 4);
        if (IN(p0 + 5)) { if (HASP(6)) { LOADARGS; LAYERARGS; ph_norm<true>(a, a.out, a.norm2_g + l * DM, mod_l, 3, 4); } }
        SEAM(p0 + 5);
        if (IN(p0 + 6)) { if (HASP(7)) { LOADARGS; pg8::Gemm g{(const bf16_t*)(ws + WS_H), (const bf16_t*)(ws + WS_WQ) + (size_t)l * PQ * 1024, T, PQ, 1024};
                  pg8::StaticOrder S; S.init(T, PQ, G, (int)blockIdx.x); EpiPlainBf16 E{(bf16_t*)(ws + WS_Q2), PQ};
                  pg8::gemm_phase<EpiPlainBf16, pg8::StaticOrder, true, true>(lds, g, S, E); } }
        SEAM(p0 + 6);
        if (IN(p0 + 7)) { if (HASP(8)) { LOADARGS; ph_topk(a, l, lds); } }
        SEAM(p0 + 7);
        if (IN(p0 + 8)) { if (HASP(9)) { LOADARGS; LAYERARGS; ph_peer(a, l, mod_l); } }
        SEAM(p0 + 8);
    }
    if (IN(NPHASES - 1)) { if (HASP(10)) { LOADARGS; ph_final_norm(a); } }
#undef IN
#undef SEAM
}

#ifndef N_LAUNCH_SPLIT
#define N_LAUNCH_SPLIT 1
#endif
extern "C" void kernel_launch(void* const* d_in, const int* in_sizes, int n_in, void* d_out, int out_size, void* d_ws, size_t ws_size, hipStream_t stream) {
    static int grid = 0;
    if (grid == 0) {
        if (n_in != 17 || out_size != T * DM || ws_size < WS_END) { fprintf(stderr, "kernel_launch: unexpected problem (n_in %d out %d ws %zu)\n", n_in, out_size, ws_size); grid = -1; return; }
        int dev = 0, cus = 0, per_cu = 0;
        (void)hipGetDevice(&dev);
        (void)hipDeviceGetAttribute(&cus, hipDeviceAttributeMultiprocessorCount, dev);
        (void)hipFuncSetAttribute((const void*)fwd_kernel, hipFuncAttributeMaxDynamicSharedMemorySize, LDS_BYTES);
        (void)hipOccupancyMaxActiveBlocksPerMultiprocessor(&per_cu, (const void*)fwd_kernel, NTHREADS, LDS_BYTES);
        if (per_cu < 1) { fprintf(stderr, "kernel_launch: occupancy query says %d\n", per_cu); per_cu = 1; }
        grid = cus;
        fprintf(stderr, "kernel_launch: cus %d per_cu %d grid %d ws %zu\n", cus, per_cu, grid, ws_size);
    }
    if (grid < 0) return;
    KArgs a{};
    a.x = (const float*)d_in[0]; a.c = (const float*)d_in[1]; a.pos = (const int*)d_in[2]; a.ada_w = (const float*)d_in[3]; a.ada_b = (const float*)d_in[4];
    a.norm1_g = (const float*)d_in[5]; a.w_in = (const float*)d_in[6]; a.sinks = (const float*)d_in[7]; a.wbr_a = (const float*)d_in[8]; a.wbr_b = (const float*)d_in[9];
    a.w_out = (const float*)d_in[10]; a.norm2_g = (const float*)d_in[11]; a.wq = (const float*)d_in[12]; a.subkeys = (const float*)d_in[13]; a.pu = (const float*)d_in[14];
    a.pv = (const float*)d_in[15]; a.final_g = (const float*)d_in[16]; a.out = (float*)d_out; a.ws = (unsigned char*)d_ws;
#if N_LAUNCH_SPLIT
    a.ph_lo = 0; a.ph_hi = NPHASES;
    { void* args[] = {&a};
      hipError_t e = hipLaunchCooperativeKernel((void*)fwd_kernel, dim3(grid), dim3(NTHREADS), args, LDS_BYTES, stream);
      if (e != hipSuccess) fprintf(stderr, "cooperative launch failed: %s (grid %d)\n", hipGetErrorString(e), grid); }
#else
    for (int ph = 0; ph < NPHASES; ++ph) {
        a.ph_lo = ph; a.ph_hi = ph + 1;
        void* args[] = {&a};
        hipError_t e = hipLaunchCooperativeKernel((void*)fwd_kernel, dim3(grid), dim3(NTHREADS), args, LDS_BYTES, stream);
        if (e != hipSuccess) { fprintf(stderr, "cooperative launch %d failed: %s (grid %d)\n", ph, hipGetErrorString(e), grid); break; }
    }
#endif
}
```

```cpp
#include <hip/hip_runtime.h>
#include <hip/hip_cooperative_groups.h>
#include <cstdio>
#include <cstdint>
namespace cg = cooperative_groups;

namespace pg8 {
#define PG8_LAS __attribute__((address_space(3)))
typedef unsigned short bf16_t;
typedef short bf16x8 __attribute__((ext_vector_type(8)));
typedef float f32x4 __attribute__((ext_vector_type(4)));
typedef unsigned u32x4 __attribute__((ext_vector_type(4)));
constexpr int BM = 256, BK = 64, HALF = 128, HTB = HALF * BK * 2  , STAGE_BYTES = 8 * HTB, NXCD = 8, WGM = 8;

__host__ __device__ __forceinline__ int lds_byte(int r, int c) { const int st = (r >> 4) * 2 + (c >> 5), rr = r & 15, cc = c & 31, ob = rr * 64 + cc * 2; return st * 1024 + (ob ^ (((ob >> 9) & 1) << 5)); }
__host__ __device__ __forceinline__ void stage_rc(int b, int& R, int& C) { const int st = b / 1024, sb = b % 1024, swz = sb ^ (((sb >> 9) & 1) << 5); R = (st >> 1) * 16 + swz / 64; C = (st & 1) * 32 + (swz % 64) / 2; }
__host__ __device__ __forceinline__ int perm32(int rho) { const int n = rho >> 4, i = rho & 15; return 8 * (i >> 2) + 4 * n + (i & 3); }

struct Unit { int pm, pn; };
struct Gemm { const bf16_t* A; const bf16_t* Bt; int M, N, K; };

struct StaticOrder {
    int nM, nN, nwg, G, c;
    __host__ __device__ void init(int M, int N, int G_, int c_) { nM = M / BM; nN = N / BM; nwg = nM * nN; G = G_; c = c_; }
    __host__ __device__ bool next(int i, Unit& u) const {
        const long L = (long)i * G + c; if (L >= nwg) return false;
        int wgid = (int)L; { const int q = nwg / NXCD, r = nwg % NXCD, xcd = wgid % NXCD, off = wgid / NXCD; wgid = (xcd < r ? xcd * (q + 1) : r * (q + 1) + (xcd - r) * q) + off; }
        const int nig = WGM * nN, gid = wgid / nig, fm = gid * WGM, gsz = (nM - fm) < WGM ? (nM - fm) : WGM;
        u.pm = fm + ((wgid % nig) % gsz); u.pn = (wgid % nig) / gsz; return true;
    }
    __device__ __forceinline__ void a_ready(const Unit&) const {}
    __device__ __forceinline__ void done(const Unit&) const {}
};


__device__ __forceinline__ unsigned cvt_pk_bf16(float lo, float hi) { unsigned r; asm volatile("v_cvt_pk_bf16_f32 %0, %1, %2" : "=v"(r) : "v"(lo), "v"(hi)); return r; }
template <class Epi, class Sched, bool ALIGN_EPI = false, bool SP2 = false>
__device__ __forceinline__ void gemm_phase(PG8_LAS unsigned char* lds, const Gemm g, const Sched& S, const Epi& E) {
    int tid_op = threadIdx.x; asm volatile("" : "+v"(tid_op));
    const int tid = tid_op, wid = __builtin_amdgcn_readfirstlane(tid >> 6), lane = tid & 63, wr = wid >> 2, wc = wid & 3, fr = lane & 15, fq = lane >> 4;
    const int K = g.K, nt = K / BK;
    unsigned voffA[2], voffB[2];
#pragma unroll
    for (int i = 0; i < 2; ++i) { int R, C; stage_rc(tid * 16 + i * 8192, R, C); const int Rb = Epi::PERM ? ((R & ~31) + perm32(R & 31)) : R;
        voffA[i] = (unsigned)(R * K + C) * 2u; voffB[i] = (unsigned)(Rb * K + C) * 2u; }
    const size_t kstep = (size_t)(BK * 2);
    const size_t hstep = (size_t)HALF * K * 2;
    const size_t tstep = 2 * hstep;
    const unsigned ldsw = (unsigned)wid * 1024u;
    const int aoff = lds_byte(wr * 64 + fr, fq * 8), boff = lds_byte(wc * 32 + fr, fq * 8);
#define PG8_SA(b, h) (((b) * 2 + (h)) * HTB)
#define PG8_SB(b, h) ((4 + (b) * 2 + (h)) * HTB)
#define PG8_STAGE(bufoff, gbase, voff) do { _Pragma("unroll") for (int _i = 0; _i < 2; ++_i) \
        __builtin_amdgcn_global_load_lds((const unsigned*)((const char*)(gbase) + (voff)[_i]), (PG8_LAS unsigned*)(lds + (bufoff) + ldsw + _i * 8192), 16, 0, 0); } while (0)
#define PG8_LDA(dst, b, h) do { _Pragma("unroll") for (int m = 0; m < 4; ++m) _Pragma("unroll") for (int k = 0; k < 2; ++k) dst[m][k] = *(const PG8_LAS bf16x8*)(lds + PG8_SA(b, h) + aoff + m * 2048 + k * 1024); } while (0)
#define PG8_LDB(dst, b, h) do { _Pragma("unroll") for (int n = 0; n < 2; ++n) _Pragma("unroll") for (int k = 0; k < 2; ++k) dst[n][k] = *(const PG8_LAS bf16x8*)(lds + PG8_SB(b, h) + boff + n * 2048 + k * 1024); } while (0)
#define PG8_MMA(ai, bj, At, Bt) do { __builtin_amdgcn_s_setprio(1); _Pragma("unroll") for (int m = 0; m < 4; ++m) _Pragma("unroll") for (int n = 0; n < 2; ++n) _Pragma("unroll") for (int k = 0; k < 2; ++k) \
        acc[ai][bj][m][n] = __builtin_amdgcn_mfma_f32_16x16x32_bf16(Bt[n][k], At[m][k], acc[ai][bj][m][n], 0, 0, 0); __builtin_amdgcn_s_setprio(0); } while (0)
#define PG8_WAIT_V(n) asm volatile("s_waitcnt vmcnt(" #n ")" ::: "memory")
#define PG8_WAIT_L(n) asm volatile("s_waitcnt lgkmcnt(" #n ")" ::: "memory")
#define PG8_BAR __builtin_amdgcn_s_barrier()
#define PG8_SCHED __builtin_amdgcn_sched_barrier(0)
    Unit cur, nxt; int ui = 0;
    if (!S.next(0, cur)) return;
    f32x4 acc[2][2][4][2];
#pragma unroll
    for (int a = 0; a < 2; ++a)
#pragma unroll
        for (int b = 0; b < 2; ++b)
#pragma unroll
            for (int m = 0; m < 4; ++m)
#pragma unroll
                for (int n = 0; n < 2; ++n) acc[a][b][m][n] = (f32x4){0.f, 0.f, 0.f, 0.f};
    bf16x8 At[4][2], B0[2][2], B1[2][2];
    const char* cA = (const char*)g.A + (size_t)cur.pm * tstep; const char* cB = (const char*)g.Bt + (size_t)cur.pn * tstep;
    S.a_ready(cur);
    if constexpr (SP2) {
        PG8_STAGE(PG8_SB(0, 0), cB, voffB); PG8_STAGE(PG8_SB(0, 1), cB + hstep, voffB); PG8_STAGE(PG8_SA(0, 0), cA, voffA); PG8_STAGE(PG8_SA(0, 1), cA + hstep, voffA);
        if (wr == 1) PG8_BAR;
        PG8_WAIT_V(2); PG8_BAR;
        PG8_STAGE(PG8_SB(1, 0), cB + kstep, voffB); PG8_STAGE(PG8_SA(1, 0), cA + kstep, voffA); PG8_STAGE(PG8_SB(1, 1), cB + hstep + kstep, voffB);
        PG8_WAIT_V(6); PG8_BAR;
    } else {
        PG8_STAGE(PG8_SB(0, 0), cB, voffB); PG8_STAGE(PG8_SA(0, 0), cA, voffA); PG8_STAGE(PG8_SB(0, 1), cB + hstep, voffB); PG8_STAGE(PG8_SA(0, 1), cA + hstep, voffA);
        if (wr == 1) PG8_BAR;
        PG8_WAIT_V(4); PG8_BAR;
        PG8_STAGE(PG8_SB(1, 0), cB + kstep, voffB); PG8_STAGE(PG8_SA(1, 0), cA + kstep, voffA); PG8_STAGE(PG8_SB(1, 1), cB + hstep + kstep, voffB);
        PG8_WAIT_V(6); PG8_BAR;
    }
    for (;;) {
        const bool has_next = S.next(ui + 1, nxt);
        const char* nA = has_next ? (const char*)g.A + (size_t)nxt.pm * tstep : cA; const char* nB = has_next ? (const char*)g.Bt + (size_t)nxt.pn * tstep : cB;
        for (int t = 0; t < nt; t += 2) {
            const bool last = (t == nt - 2);
            const char* a1 = cA + (size_t)(t + 1) * kstep;
            const char* a2 = last ? nA : cA + (size_t)(t + 2) * kstep; const char* b2 = last ? nB : cB + (size_t)(t + 2) * kstep;
            const char* a3 = a2 + kstep; const char* b3 = b2 + kstep;
            if (last && has_next) S.a_ready(nxt);
            if constexpr (SP2) {
            PG8_LDB(B0, 0, 0); PG8_LDB(B1, 0, 1); PG8_SCHED; PG8_LDA(At, 0, 0); PG8_STAGE(PG8_SA(1, 1), a1 + hstep, voffA);
            PG8_WAIT_V(8); PG8_WAIT_L(0); PG8_BAR; PG8_MMA(0, 0, At, B0); PG8_MMA(0, 1, At, B1); PG8_BAR; PG8_SCHED;
            PG8_LDA(At, 0, 1); PG8_STAGE(PG8_SB(0, 0), b2, voffB); PG8_STAGE(PG8_SB(0, 1), b2 + hstep, voffB); PG8_STAGE(PG8_SA(0, 0), a2, voffA);
            PG8_WAIT_V(8); PG8_WAIT_L(0); PG8_BAR; PG8_MMA(1, 0, At, B0); PG8_MMA(1, 1, At, B1); PG8_BAR; PG8_SCHED;
            PG8_LDB(B0, 1, 0); PG8_LDB(B1, 1, 1); PG8_SCHED; PG8_LDA(At, 1, 0); PG8_STAGE(PG8_SA(0, 1), a2 + hstep, voffA);
            PG8_WAIT_V(8); PG8_WAIT_L(0); PG8_BAR; PG8_MMA(0, 0, At, B0); PG8_MMA(0, 1, At, B1); PG8_BAR; PG8_SCHED;
            PG8_LDA(At, 1, 1); PG8_STAGE(PG8_SB(1, 0), b3, voffB); PG8_STAGE(PG8_SB(1, 1), b3 + hstep, voffB); PG8_STAGE(PG8_SA(1, 0), a3, voffA);
            PG8_WAIT_V(8); PG8_WAIT_L(0); PG8_BAR; PG8_MMA(1, 0, At, B0); PG8_MMA(1, 1, At, B1); PG8_BAR; PG8_SCHED;
            } else {
            PG8_LDB(B0, 0, 0); PG8_SCHED; PG8_LDA(At, 0, 0); PG8_STAGE(PG8_SA(1, 1), a1 + hstep, voffA);
            PG8_WAIT_L(8); PG8_BAR; PG8_WAIT_L(0); PG8_MMA(0, 0, At, B0); PG8_BAR; PG8_SCHED;
            PG8_LDB(B1, 0, 1); PG8_STAGE(PG8_SB(0, 0), b2, voffB);
            PG8_BAR; PG8_WAIT_L(0); PG8_MMA(0, 1, At, B1); PG8_BAR;
            PG8_LDA(At, 0, 1); PG8_STAGE(PG8_SA(0, 0), a2, voffA);
            PG8_BAR; PG8_WAIT_L(0); PG8_MMA(1, 0, At, B0); PG8_BAR; PG8_SCHED;
            PG8_STAGE(PG8_SB(0, 1), b2 + hstep, voffB);
            PG8_WAIT_V(6); PG8_BAR; PG8_MMA(1, 1, At, B1); PG8_BAR;
            PG8_LDB(B0, 1, 0); PG8_SCHED; PG8_LDA(At, 1, 0); PG8_STAGE(PG8_SA(0, 1), a2 + hstep, voffA);
            PG8_WAIT_L(8); PG8_BAR; PG8_WAIT_L(0); PG8_MMA(0, 0, At, B0); PG8_BAR; PG8_SCHED;
            PG8_LDB(B1, 1, 1); PG8_STAGE(PG8_SB(1, 0), b3, voffB);
            PG8_BAR; PG8_WAIT_L(0); PG8_MMA(0, 1, At, B1); PG8_BAR;
            PG8_LDA(At, 1, 1); PG8_STAGE(PG8_SA(1, 0), a3, voffA);
            PG8_BAR; PG8_WAIT_L(0); PG8_MMA(1, 0, At, B0); PG8_BAR; PG8_SCHED;
            PG8_STAGE(PG8_SB(1, 1), b3 + hstep, voffB);
            PG8_WAIT_V(6); PG8_BAR; PG8_MMA(1, 1, At, B1); PG8_BAR;
            }
        }
        if constexpr (ALIGN_EPI) { if (wr == 0) PG8_BAR; }
        if constexpr (!Epi::AFTER_DRAIN) { E(acc, cur, wr, wc, fr, fq); S.done(cur); }
        if (!has_next) break;
#pragma unroll
        for (int a = 0; a < 2; ++a)
#pragma unroll
            for (int b = 0; b < 2; ++b)
#pragma unroll
                for (int m = 0; m < 4; ++m)
#pragma unroll
                    for (int n = 0; n < 2; ++n) acc[a][b][m][n] = (f32x4){0.f, 0.f, 0.f, 0.f};
        cur = nxt; cA = nA; cB = nB; ++ui;
        if constexpr (ALIGN_EPI) { if (wr == 1) PG8_BAR; }
    }
    PG8_WAIT_V(0);
    if constexpr (!ALIGN_EPI) { if (wr == 0) PG8_BAR; }
    PG8_BAR;
    if constexpr (Epi::AFTER_DRAIN) { E.fused(acc, cur, wr, wc, fr, fq, lds, wid, lane); S.done(cur); }
#undef PG8_SA
#undef PG8_SB
#undef PG8_STAGE
#undef PG8_LDA
#undef PG8_LDB
#undef PG8_MMA
#undef PG8_WAIT_V
#undef PG8_WAIT_L
#undef PG8_BAR
#undef PG8_SCHED
}
}


#define LAS __attribute__((address_space(3)))
typedef unsigned short bf16_t;
typedef float f32x4 __attribute__((ext_vector_type(4)));
typedef unsigned u32x4 __attribute__((ext_vector_type(4)));
typedef unsigned u32x2 __attribute__((ext_vector_type(2)));

constexpr int BATCH = 8, SEQ = 4096, DM = 1024, T = BATCH * SEQ, DEPTH = 2;
constexpr int NPROJ = 4352, NMOD = 6 * DM;
constexpr int NEXP = 16384, PQ = 2048;
constexpr float NORM_EPS = 1e-6f;
constexpr float LOG2E = 1.4426950408889634f;
constexpr float QSCALE = 0.125f * LOG2E;
constexpr float SB_EXIT = 160.0f;

constexpr size_t MiB = 1u << 20;
constexpr size_t WS_CTL = 0;
constexpr size_t WS_MOD = 1 * MiB;
constexpr size_t WS_ROPE = 2 * MiB;
constexpr size_t WS_WIN = 10 * MiB;
constexpr size_t WS_WBA = 27 * MiB;
constexpr size_t WS_WBB = 29 * MiB;
constexpr size_t WS_WOUT = 31 * MiB;
constexpr size_t WS_WQ = 35 * MiB;
constexpr size_t WS_SK = 43 * MiB;
constexpr size_t WS_UQ = 44 * MiB;
constexpr size_t WS_VQ = 76 * MiB;
constexpr size_t WS_USC = 108 * MiB;
constexpr size_t WS_VSC = 108 * MiB + 256 * 1024;
constexpr size_t WS_HS = 109 * MiB;
constexpr size_t WS_H = 112 * MiB;
constexpr size_t WS_QA = 176 * MiB;
constexpr size_t WS_QB = 208 * MiB;
constexpr size_t WS_KB = 240 * MiB;
constexpr size_t WS_VB = 272 * MiB;
constexpr size_t WS_KA = 304 * MiB;
constexpr size_t WS_VA = 312 * MiB;
constexpr size_t WS_GA = 320 * MiB;
constexpr size_t WS_GB = 384 * MiB;
constexpr size_t WS_END = 448 * MiB;
constexpr size_t WS_H2Q = WS_QA, WS_IDX = WS_KB, WS_GATE = WS_VB, WS_Q2 = WS_GA;

constexpr int LDS_BYTES = 147456;
constexpr int NTHREADS = 512, NWAVES = 8;

struct KArgs {
    const float* x; const float* c; const int* pos; const float* ada_w; const float* ada_b; const float* norm1_g; const float* w_in; const float* sinks;
    const float* wbr_a; const float* wbr_b; const float* w_out; const float* norm2_g; const float* wq; const float* subkeys; const float* pu; const float* pv; const float* final_g;
    float* out; unsigned char* ws; int ph_lo, ph_hi;
};

__device__ __forceinline__ unsigned f2bf(float f) { unsigned u = __float_as_uint(f); return (u + 0x7fffu + ((u >> 16) & 1u)) >> 16; }
__device__ __forceinline__ unsigned pk2(float lo, float hi) { return f2bf(lo) | (f2bf(hi) << 16); }
__device__ __forceinline__ float bflo(unsigned w) { return __uint_as_float(w << 16); }
__device__ __forceinline__ float bfhi(unsigned w) { return __uint_as_float(w & 0xffff0000u); }
template <int M> __device__ __forceinline__ float swz_xor(float v) { return __int_as_float(__builtin_amdgcn_ds_swizzle(__float_as_int(v), (M << 10) | 0x1f)); }
__device__ __forceinline__ float wave_sum(float v) {
    v += swz_xor<1>(v); v += swz_xor<2>(v); v += swz_xor<4>(v); v += swz_xor<8>(v); v += swz_xor<16>(v);
    auto rr = __builtin_amdgcn_permlane32_swap(__float_as_uint(v), __float_as_uint(v), false, false);
    return __uint_as_float(rr[0]) + __uint_as_float(rr[1]);
}
__device__ __forceinline__ float wave_max(float v) {
    v = fmaxf(v, swz_xor<1>(v)); v = fmaxf(v, swz_xor<2>(v)); v = fmaxf(v, swz_xor<4>(v)); v = fmaxf(v, swz_xor<8>(v)); v = fmaxf(v, swz_xor<16>(v));
    auto rr = __builtin_amdgcn_permlane32_swap(__float_as_uint(v), __float_as_uint(v), false, false);
    return fmaxf(__uint_as_float(rr[0]), __uint_as_float(rr[1]));
}
__device__ __forceinline__ int rdlane_i(int v, int l) { return __builtin_amdgcn_readlane(v, __builtin_amdgcn_readfirstlane(l)); }
__device__ __forceinline__ float rdlane_f(float v, int l) { return __int_as_float(__builtin_amdgcn_readlane(__float_as_int(v), __builtin_amdgcn_readfirstlane(l))); }
__device__ __forceinline__ float dot8(u32x4 a, u32x4 b, float acc) {
    acc = fmaf(bflo(a.x), bflo(b.x), acc); acc = fmaf(bfhi(a.x), bfhi(b.x), acc);
    acc = fmaf(bflo(a.y), bflo(b.y), acc); acc = fmaf(bfhi(a.y), bfhi(b.y), acc);
    acc = fmaf(bflo(a.z), bflo(b.z), acc); acc = fmaf(bfhi(a.z), bfhi(b.z), acc);
    acc = fmaf(bflo(a.w), bflo(b.w), acc); acc = fmaf(bfhi(a.w), bfhi(b.w), acc);
    return acc;
}
__device__ __forceinline__ float softplus2(float z2) {
    return fmaxf(z2, 0.f) + __log2f(1.0f + exp2f(-fabsf(z2)));
}

__device__ __forceinline__ int win_pos(int n) {
    if (n >= 640) return n;
    const int hb = n & ~63, d = n & 63;
    return hb + (d < 32 ? 2 * d : 2 * (d - 32) + 1);
}
template <bool WIN>
__device__ __forceinline__ void transpose_item(const float* W, int K, int N, bf16_t* WT, LAS float* scr, int item, int lane) {
    const int nblk = N / 32, kb = item / nblk, nb = item % nblk, k0 = 64 * kb, n0 = 32 * nb;
#pragma unroll 8
    for (int i = 0; i < 32; ++i) { const int kk = 2 * i + (lane >> 5); scr[kk * 33 + (lane & 31)] = W[(size_t)(k0 + kk) * N + n0 + (lane & 31)]; }
    asm volatile("s_waitcnt lgkmcnt(0)" ::: "memory");
    const int c = lane & 7;
#pragma unroll
    for (int j = 0; j < 4; ++j) { const int n = (lane >> 3) + 8 * j; const LAS float* s = scr + (8 * c) * 33 + n;
        u32x4 o; o.x = pk2(s[0 * 33], s[1 * 33]); o.y = pk2(s[2 * 33], s[3 * 33]); o.z = pk2(s[4 * 33], s[5 * 33]); o.w = pk2(s[6 * 33], s[7 * 33]);
        const int row = WIN ? win_pos(n0 + n) : (n0 + n);
        *(u32x4*)(WT + (size_t)row * K + k0 + 8 * c) = o; }
    asm volatile("s_waitcnt lgkmcnt(0)" ::: "memory");
}
template <bool OFFSET128>
__device__ __forceinline__ void quant_row(const f32x4 (&v)[4], unsigned char* dst_row, float* scale_out, int lane) {
    float am = 0.f;
#pragma unroll
    for (int i = 0; i < 4; ++i) am = fmaxf(am, fmaxf(fmaxf(fabsf(v[i].x), fabsf(v[i].y)), fmaxf(fabsf(v[i].z), fabsf(v[i].w))));
    am = wave_max(am);
    const float inv = am > 0.f ? 127.0f / am : 0.f, sc = am > 0.f ? am / 127.0f : 1.0f;
    u32x4 o;
#pragma unroll
    for (int i = 0; i < 4; ++i) {
        int q0 = (int)rintf(v[i].x * inv), q1 = (int)rintf(v[i].y * inv), q2 = (int)rintf(v[i].z * inv), q3 = (int)rintf(v[i].w * inv);
        if (OFFSET128) { q0 += 128; q1 += 128; q2 += 128; q3 += 128; }
        o[i] = (unsigned)(q0 & 0xff) | ((unsigned)(q1 & 0xff) << 8) | ((unsigned)(q2 & 0xff) << 16) | ((unsigned)(q3 & 0xff) << 24);
    }
    *(u32x4*)(dst_row + 16 * lane) = o;
    if (lane == 0) *scale_out = sc;
}

__device__ __forceinline__ void ph_prologue(const KArgs& a, LAS unsigned char* lds) {
    int tid_op = threadIdx.x; asm volatile("" : "+v"(tid_op)); const int tid = tid_op, lane = tid & 63, wave = tid >> 6, G = gridDim.x;
    const int gw = blockIdx.x * NWAVES + wave, NGW = G * NWAVES;
    unsigned char* ws = a.ws;
    {
        LAS float* sc = (LAS float*)lds;
        for (int it = blockIdx.x; it < DEPTH * 12; it += G) {
            for (int idx = tid; idx < 8192; idx += NTHREADS) { const int b = idx >> 10, i = idx & 1023; const float cv = a.c[b * 1024 + i]; sc[i * 8 + b] = cv / (1.0f + __expf(-cv)); }
            __syncthreads();
            const int l = it / 12, j = (it % 12) * 512 + tid;
            const float* wp = a.ada_w + (size_t)l * 1024 * NMOD + j;
            float acc[8];
#pragma unroll
            for (int b = 0; b < 8; ++b) acc[b] = 0.f;
#pragma unroll 4
            for (int i = 0; i < 1024; ++i) {
                const float w = wp[(size_t)i * NMOD];
                const f32x4 s0 = *(const LAS f32x4*)(sc + i * 8), s1 = *(const LAS f32x4*)(sc + i * 8 + 4);
                acc[0] = fmaf(s0.x, w, acc[0]); acc[1] = fmaf(s0.y, w, acc[1]); acc[2] = fmaf(s0.z, w, acc[2]); acc[3] = fmaf(s0.w, w, acc[3]);
                acc[4] = fmaf(s1.x, w, acc[4]); acc[5] = fmaf(s1.y, w, acc[5]); acc[6] = fmaf(s1.z, w, acc[6]); acc[7] = fmaf(s1.w, w, acc[7]);
            }
            float* mod = (float*)(ws + WS_MOD);
            const float bias = a.ada_b[l * NMOD + j];
#pragma unroll
            for (int b = 0; b < 8; ++b) mod[(size_t)(l * 8 + b) * NMOD + j] = acc[b] + bias;
            __syncthreads();
        }
    }
    {
        LAS float* scr = (LAS float*)(lds + 32768 + wave * 8448);
        constexpr int I_IN = 16 * 136, I_BR = 8 * 32, I_OUT = 16 * 32, I_Q = 16 * 64, I_L = I_IN + 2 * I_BR + I_OUT + I_Q;
        for (int it = gw; it < DEPTH * I_L; it += NGW) {
            const int l = it / I_L; int r = it % I_L;
            if (r < I_IN) { transpose_item<true>(a.w_in + (size_t)l * 1024 * NPROJ, 1024, NPROJ, (bf16_t*)(ws + WS_WIN) + (size_t)l * NPROJ * 1024, scr, r, lane); continue; } r -= I_IN;
            if (r < I_BR) { transpose_item<false>(a.wbr_a + (size_t)l * 512 * 1024, 512, 1024, (bf16_t*)(ws + WS_WBA) + (size_t)l * 1024 * 512, scr, r, lane); continue; } r -= I_BR;
            if (r < I_BR) { transpose_item<false>(a.wbr_b + (size_t)l * 512 * 1024, 512, 1024, (bf16_t*)(ws + WS_WBB) + (size_t)l * 1024 * 512, scr, r, lane); continue; } r -= I_BR;
            if (r < I_OUT) { transpose_item<false>(a.w_out + (size_t)l * 1024 * 1024, 1024, 1024, (bf16_t*)(ws + WS_WOUT) + (size_t)l * 1024 * 1024, scr, r, lane); continue; } r -= I_OUT;
            transpose_item<false>(a.wq + (size_t)l * 1024 * PQ, 1024, PQ, (bf16_t*)(ws + WS_WQ) + (size_t)l * PQ * 1024, scr, r, lane);
        }
    }
    {
        const int gt = blockIdx.x * NTHREADS + tid, NGT = G * NTHREADS;
        for (int i = gt; i < DEPTH * 8 * 2 * 128 * 128 / 8; i += NGT) {
            const f32x4 v0 = *(const f32x4*)(a.subkeys + (size_t)i * 8), v1 = *(const f32x4*)(a.subkeys + (size_t)i * 8 + 4);
            u32x4 o; o.x = pk2(v0.x, v0.y); o.y = pk2(v0.z, v0.w); o.z = pk2(v1.x, v1.y); o.w = pk2(v1.z, v1.w);
            *(u32x4*)((bf16_t*)(ws + WS_SK) + (size_t)i * 8) = o;
        }
        for (int i = gt; i < T * 32; i += NGT) {
            const int t = i >> 5, f = i & 31;
            double inv = 1.0;
            for (int k = 0; k < f; ++k) inv *= 0.7498942093324559;
            const double ang = (double)a.pos[t] * inv;
            const double kq = rint(ang * 0.63661977236758134308);
            const double r = fma(-kq, 6.123233995736766036e-17, fma(-kq, 1.57079632679489655800, ang));
            const int quad = (int)((long long)kq & 3);
            const double r2 = r * r;
            double sp = -1.0 / 1307674368000.0; sp = fma(sp, r2, 1.0 / 6227020800.0); sp = fma(sp, r2, -1.0 / 39916800.0); sp = fma(sp, r2, 1.0 / 362880.0);
            sp = fma(sp, r2, -1.0 / 5040.0); sp = fma(sp, r2, 1.0 / 120.0); sp = fma(sp, r2, -1.0 / 6.0); sp = fma(sp * r2, r, r);
            double cp = 1.0 / 20922789888000.0; cp = fma(cp, r2, -1.0 / 87178291200.0); cp = fma(cp, r2, 1.0 / 479001600.0); cp = fma(cp, r2, -1.0 / 3628800.0);
            cp = fma(cp, r2, 1.0 / 40320.0); cp = fma(cp, r2, -1.0 / 720.0); cp = fma(cp, r2, 1.0 / 24.0); cp = fma(cp, r2, -0.5); cp = fma(cp, r2, 1.0);
            const double sn = (quad == 0) ? sp : (quad == 1) ? cp : (quad == 2) ? -sp : -cp;
            const double cs = (quad == 0) ? cp : (quad == 1) ? -sp : (quad == 2) ? -cp : sp;
            float* rp = (float*)(ws + WS_ROPE) + (size_t)i * 2; rp[0] = (float)cs; rp[1] = (float)sn;
        }
    }
    for (int r = gw; r < DEPTH * 2 * NEXP; r += NGW) {
        const int tbl = r / (DEPTH * NEXP), lr = r % (DEPTH * NEXP);
        const float* src = (tbl == 0 ? a.pu : a.pv) + (size_t)lr * 1024;
        f32x4 v[4];
#pragma unroll
        for (int i = 0; i < 4; ++i) v[i] = ((const f32x4*)src)[64 * i + lane];
        if (tbl == 0) quant_row<false>(v, ws + WS_UQ + (size_t)lr * 1024, (float*)(ws + WS_USC) + lr, lane);
        else quant_row<true>(v, ws + WS_VQ + (size_t)lr * 1024, (float*)(ws + WS_VSC) + lr, lane);
    }
}

template <bool WITH_Q8>
__device__ __forceinline__ void ph_norm(const KArgs& a, const float* xin, const float* g, const float* mod_l, int shift_idx, int scale_idx) {
    int tid_op = threadIdx.x; asm volatile("" : "+v"(tid_op)); const int tid = tid_op, lane = tid & 63, wave = tid >> 6;
    const int gw = blockIdx.x * NWAVES + wave, NGW = gridDim.x * NWAVES;
    bf16_t* H = (bf16_t*)(a.ws + WS_H);
    for (int row = gw; row < T; row += NGW) {
        const int b = row >> 12;
        f32x4 v[4]; float ss = 0.f;
#pragma unroll
        for (int i = 0; i < 4; ++i) { v[i] = ((const f32x4*)(xin + (size_t)row * DM))[64 * i + lane]; ss += (v[i].x * v[i].x + v[i].y * v[i].y) + (v[i].z * v[i].z + v[i].w * v[i].w); }
        ss = wave_sum(ss);
        const float r = 1.0f / sqrtf(ss * (1.0f / DM) + NORM_EPS);
#pragma unroll
        for (int i = 0; i < 4; ++i) {
            const int col = 256 * i + 4 * lane;
            const f32x4 gg = *(const f32x4*)(g + col), sc = *(const f32x4*)(mod_l + (size_t)b * NMOD + scale_idx * DM + col), sh = *(const f32x4*)(mod_l + (size_t)b * NMOD + shift_idx * DM + col);
            v[i] = (v[i] * r) * gg * (sc + 1.0f) + sh;
            u32x2 o; o.x = pk2(v[i].x, v[i].y); o.y = pk2(v[i].z, v[i].w);
            *(u32x2*)(H + (size_t)row * DM + col) = o;
        }
        if (WITH_Q8) quant_row<false>(v, a.ws + WS_H2Q + (size_t)row * 1024, (float*)(a.ws + WS_HS) + row, lane);
    }
}
__device__ __forceinline__ void ph_final_norm(const KArgs& a) {
    int tid_op = threadIdx.x; asm volatile("" : "+v"(tid_op)); const int tid = tid_op, lane = tid & 63, wave = tid >> 6;
    const int gw = blockIdx.x * NWAVES + wave, NGW = gridDim.x * NWAVES;
    for (int row = gw; row < T; row += NGW) {
        f32x4 v[4]; float ss = 0.f;
#pragma unroll
        for (int i = 0; i < 4; ++i) { v[i] = ((const f32x4*)(a.out + (size_t)row * DM))[64 * i + lane]; ss += (v[i].x * v[i].x + v[i].y * v[i].y) + (v[i].z * v[i].z + v[i].w * v[i].w); }
        ss = wave_sum(ss);
        const float r = 1.0f / sqrtf(ss * (1.0f / DM) + NORM_EPS);
#pragma unroll
        for (int i = 0; i < 4; ++i) { const f32x4 gg = *(const f32x4*)(a.final_g + 256 * i + 4 * lane); ((f32x4*)(a.out + (size_t)row * DM))[64 * i + lane] = (v[i] * r) * gg; }
    }
}

struct EpiProj {
    static constexpr bool PERM = true, AFTER_DRAIN = false;
    unsigned char* ws;
    __device__ __forceinline__ void operator()(const pg8::f32x4 (&acc)[2][2][4][2], const pg8::Unit& u, int wr, int wc, int fr, int fq) const {
        const int row0 = u.pm * 256 + wr * 64 + fr;
        const float* rope = (const float*)(ws + WS_ROPE);
#pragma unroll
        for (int bj = 0; bj < 2; ++bj) {
            const int cgb = u.pn * 256 + bj * 128;
            bf16_t* base; int pitch, cl, mode;
            if (cgb < 512) { base = (bf16_t*)(ws + WS_QA); pitch = 512; cl = cgb; mode = 1; }
            else if (cgb < 640) { base = (bf16_t*)(ws + WS_KA); pitch = 128; cl = cgb - 512; mode = 2; }
            else if (cgb < 768) { base = (bf16_t*)(ws + WS_VA); pitch = 128; cl = cgb - 640; mode = 0; }
            else if (cgb < 1280) { base = (bf16_t*)(ws + WS_QB); pitch = 512; cl = cgb - 768; mode = 3; }
            else if (cgb < 1792) { base = (bf16_t*)(ws + WS_KB); pitch = 512; cl = cgb - 1280; mode = 0; }
            else if (cgb < 2304) { base = (bf16_t*)(ws + WS_VB); pitch = 512; cl = cgb - 1792; mode = 0; }
            else if (cgb < 3328) { base = (bf16_t*)(ws + WS_GA); pitch = 1024; cl = cgb - 2304; mode = 4; }
            else { base = (bf16_t*)(ws + WS_GB); pitch = 1024; cl = cgb - 3328; mode = 4; }
            const int col = cl + wc * 32 + 8 * fq;
#pragma unroll
            for (int ai = 0; ai < 2; ++ai)
#pragma unroll
                for (int m = 0; m < 4; ++m) {
                    const int row = row0 + ai * 128 + m * 16;
                    pg8::f32x4 v0 = acc[ai][bj][m][0], v1 = acc[ai][bj][m][1];
                    if (mode == 1 || mode == 2) {
                        const int i0 = (col & 63) >> 1;
                        const f32x4 c01 = *(const f32x4*)(rope + ((size_t)row * 32 + i0) * 2), c23 = *(const f32x4*)(rope + ((size_t)row * 32 + i0 + 2) * 2);
                        pg8::f32x4 w0, w1;
                        w0[0] = v0[0] * c01.x - v0[1] * c01.y; w0[1] = v0[1] * c01.x + v0[0] * c01.y;
                        w0[2] = v0[2] * c01.z - v0[3] * c01.w; w0[3] = v0[3] * c01.z + v0[2] * c01.w;
                        w1[0] = v1[0] * c23.x - v1[1] * c23.y; w1[1] = v1[1] * c23.x + v1[0] * c23.y;
                        w1[2] = v1[2] * c23.z - v1[3] * c23.w; w1[3] = v1[3] * c23.z + v1[2] * c23.w;
                        v0 = w0; v1 = w1;
                    }
                    if (mode == 1 || mode == 3) { v0 = v0 * QSCALE; v1 = v1 * QSCALE; }
                    if (mode == 4) {
#pragma unroll
                        for (int e = 0; e < 4; ++e) { v0[e] = 1.0f / (1.0f + __expf(-v0[e])); v1[e] = 1.0f / (1.0f + __expf(-v1[e])); }
                    }
                    u32x4 w; w.x = pk2(v0[0], v0[1]); w.y = pk2(v0[2], v0[3]); w.z = pk2(v1[0], v1[1]); w.w = pk2(v1[2], v1[3]);
                    *(u32x4*)(base + (size_t)row * pitch + col) = w;
                }
        }
    }
};
template <bool ADD> struct EpiBranch {
    static constexpr bool PERM = true, AFTER_DRAIN = false;
    const bf16_t* Gt; bf16_t* O;
    __device__ __forceinline__ void operator()(const pg8::f32x4 (&acc)[2][2][4][2], const pg8::Unit& u, int wr, int wc, int fr, int fq) const {
        const int row0 = u.pm * 256 + wr * 64 + fr, col0 = u.pn * 256 + wc * 32 + 8 * fq;
#pragma unroll
        for (int ai = 0; ai < 2; ++ai)
#pragma unroll
            for (int m = 0; m < 4; ++m)
#pragma unroll
                for (int bj = 0; bj < 2; ++bj) {
                    const size_t off = (size_t)(row0 + ai * 128 + m * 16) * DM + col0 + bj * 128;
                    const u32x4 gv = *(const u32x4*)(Gt + off);
                    const pg8::f32x4 v0 = acc[ai][bj][m][0], v1 = acc[ai][bj][m][1];
                    float r[8];
                    r[0] = bflo(gv.x) * v0[0]; r[1] = bfhi(gv.x) * v0[1]; r[2] = bflo(gv.y) * v0[2]; r[3] = bfhi(gv.y) * v0[3];
                    r[4] = bflo(gv.z) * v1[0]; r[5] = bfhi(gv.z) * v1[1]; r[6] = bflo(gv.w) * v1[2]; r[7] = bfhi(gv.w) * v1[3];
                    if (ADD) { const u32x4 ov = *(const u32x4*)(O + off);
                        r[0] += bflo(ov.x); r[1] += bfhi(ov.x); r[2] += bflo(ov.y); r[3] += bfhi(ov.y); r[4] += bflo(ov.z); r[5] += bfhi(ov.z); r[6] += bflo(ov.w); r[7] += bfhi(ov.w); }
                    u32x4 w; w.x = pk2(r[0], r[1]); w.y = pk2(r[2], r[3]); w.z = pk2(r[4], r[5]); w.w = pk2(r[6], r[7]);
                    *(u32x4*)(O + off) = w;
                }
    }
};
struct EpiWout {
    static constexpr bool PERM = false, AFTER_DRAIN = false;
    const float* xold; float* xnew; const float* gate;
    __device__ __forceinline__ void operator()(const pg8::f32x4 (&acc)[2][2][4][2], const pg8::Unit& u, int wr, int wc, int fr, int fq) const {
        const int row0 = u.pm * 256 + wr * 64 + fr, col0 = u.pn * 256 + wc * 32 + 4 * fq, b = u.pm >> 4;
#pragma unroll
        for (int bj = 0; bj < 2; ++bj)
#pragma unroll
            for (int n = 0; n < 2; ++n) {
                const pg8::f32x4 gv = *(const pg8::f32x4*)(gate + (size_t)b * NMOD + col0 + bj * 128 + n * 16);
#pragma unroll
                for (int ai = 0; ai < 2; ++ai)
#pragma unroll
                    for (int m = 0; m < 4; ++m) { const size_t off = (size_t)(row0 + ai * 128 + m * 16) * DM + col0 + bj * 128 + n * 16;
                        const pg8::f32x4 xo = *(const pg8::f32x4*)(xold + off);
                        *(pg8::f32x4*)(xnew + off) = xo + gv * acc[ai][bj][m][n]; }
            }
    }
};
struct EpiPlainBf16 {
    static constexpr bool PERM = true, AFTER_DRAIN = false;
    bf16_t* O; int ldc;
    __device__ __forceinline__ void operator()(const pg8::f32x4 (&acc)[2][2][4][2], const pg8::Unit& u, int wr, int wc, int fr, int fq) const {
        const int row0 = u.pm * 256 + wr * 64 + fr, col0 = u.pn * 256 + wc * 32 + 8 * fq;
#pragma unroll
        for (int ai = 0; ai < 2; ++ai)
#pragma unroll
            for (int m = 0; m < 4; ++m)
#pragma unroll
                for (int bj = 0; bj < 2; ++bj) {
                    const pg8::f32x4 v0 = acc[ai][bj][m][0], v1 = acc[ai][bj][m][1];
                    u32x4 w; w.x = pk2(v0[0], v0[1]); w.y = pk2(v0[2], v0[3]); w.z = pk2(v1[0], v1[1]); w.w = pk2(v1[2], v1[3]);
                    *(u32x4*)(O + (size_t)(row0 + ai * 128 + m * 16) * ldc + col0 + bj * 128) = w;
                }
    }
};

namespace att {
typedef short bf16x8 __attribute__((ext_vector_type(8)));
typedef short s16x4 __attribute__((ext_vector_type(4)));
typedef float f32x16 __attribute__((ext_vector_type(16)));
__device__ __forceinline__ int crow(int r, int hi) { return (r & 3) + 8 * (r >> 2) + 4 * hi; }
typedef float f32x2_t __attribute__((ext_vector_type(2))); typedef __bf16 bf16x2_t __attribute__((ext_vector_type(2)));
__device__ __forceinline__ unsigned cvtpk(float lo, float hi) { f32x2_t v = {lo, hi}; bf16x2_t b = __builtin_convertvector(v, bf16x2_t); return __builtin_bit_cast(unsigned, b); }
#define ATT_SBAR() __builtin_amdgcn_sched_barrier(0)

__device__ __forceinline__ void qkt(f32x16& p0, f32x16& p1, const LAS unsigned char* kslot, const bf16x8 (&qr)[4], int r32, int hi) {
    const LAS unsigned char* kb = kslot + hi * 1024 + r32 * 16;
    p0 = f32x16{}; p1 = f32x16{};
#pragma unroll
    for (int d0 = 0; d0 < 4; ++d0) {
        const bf16x8 b0 = *(const LAS bf16x8*)(kb + d0 * 2048);
        const bf16x8 b1 = *(const LAS bf16x8*)(kb + d0 * 2048 + 512);
        p0 = __builtin_amdgcn_mfma_f32_32x32x16_bf16(b0, qr[d0], p0, 0, 0, 0);
        p1 = __builtin_amdgcn_mfma_f32_32x32x16_bf16(b1, qr[d0], p1, 0, 0, 0);
    }
}
__device__ __forceinline__ void pv(f32x16 (&o)[2], int vb, bf16x8 pa0, bf16x8 pa1, bf16x8 pa2, bf16x8 pa3) {
#pragma unroll
    for (int d0 = 0; d0 < 2; ++d0) {
        s16x4 lo[4], hh[4];
#pragma unroll
        for (int ks = 0; ks < 4; ++ks) {
            asm volatile("ds_read_b64_tr_b16 %0,%1 offset:%c2" : "=&v"(lo[ks]) : "v"(vb), "i"(d0 * 4096 + ks * 1024) : "memory");
            asm volatile("ds_read_b64_tr_b16 %0,%1 offset:%c2" : "=&v"(hh[ks]) : "v"(vb), "i"(d0 * 4096 + ks * 1024 + 512) : "memory");
        }
        asm volatile("s_waitcnt lgkmcnt(0)" ::: "memory"); ATT_SBAR();
#define ATT_PK(k) (bf16x8){lo[k][0], lo[k][1], lo[k][2], lo[k][3], hh[k][0], hh[k][1], hh[k][2], hh[k][3]}
        o[d0] = __builtin_amdgcn_mfma_f32_32x32x16_bf16(pa0, ATT_PK(0), o[d0], 0, 0, 0);
        o[d0] = __builtin_amdgcn_mfma_f32_32x32x16_bf16(pa1, ATT_PK(1), o[d0], 0, 0, 0);
        o[d0] = __builtin_amdgcn_mfma_f32_32x32x16_bf16(pa2, ATT_PK(2), o[d0], 0, 0, 0);
        o[d0] = __builtin_amdgcn_mfma_f32_32x32x16_bf16(pa3, ATT_PK(3), o[d0], 0, 0, 0);
#undef ATT_PK
    }
}
__device__ __forceinline__ void pack_p(const f32x16& p0, const f32x16& p1, bf16x8& pa0, bf16x8& pa1, bf16x8& pa2, bf16x8& pa3) {
    u32x4 w0, w1, w2, w3;
    w0 = (u32x4){cvtpk(p0[0], p0[1]), cvtpk(p0[2], p0[3]), cvtpk(p0[4], p0[5]), cvtpk(p0[6], p0[7])};
    w1 = (u32x4){cvtpk(p0[8], p0[9]), cvtpk(p0[10], p0[11]), cvtpk(p0[12], p0[13]), cvtpk(p0[14], p0[15])};
    w2 = (u32x4){cvtpk(p1[0], p1[1]), cvtpk(p1[2], p1[3]), cvtpk(p1[4], p1[5]), cvtpk(p1[6], p1[7])};
    w3 = (u32x4){cvtpk(p1[8], p1[9]), cvtpk(p1[10], p1[11]), cvtpk(p1[12], p1[13]), cvtpk(p1[14], p1[15])};
    pa0 = __builtin_bit_cast(bf16x8, w0); pa1 = __builtin_bit_cast(bf16x8, w1); pa2 = __builtin_bit_cast(bf16x8, w2); pa3 = __builtin_bit_cast(bf16x8, w3);
}
__device__ __forceinline__ u32x4 tile_gload(const bf16_t* src, int pitch, int tid) { return *(const u32x4*)(src + (size_t)(tid >> 3) * pitch + (tid & 7) * 8); }
__device__ __forceinline__ void tile_kwrite(LAS unsigned char* kslot, u32x4 v, int tid) { *(LAS u32x4*)(kslot + (tid & 7) * 1024 + (tid >> 3) * 16) = v; }
__device__ __forceinline__ void tile_vwrite(LAS unsigned char* vslot, u32x4 v, int tid) { const int c = tid & 7; *(LAS u32x4*)(vslot + (c >> 2) * 4096 + (tid >> 3) * 64 + (c & 3) * 16) = v; }
__device__ __forceinline__ void store_o(const f32x16 (&o)[2], const float (&rs)[16], LAS unsigned char* stage, bf16_t* Ow, int pitch, int lane) {
    const int r32 = lane & 31, hi = lane >> 5;
    LAS bf16_t* stg = (LAS bf16_t*)stage;
#pragma unroll
    for (int r = 0; r < 16; ++r) { const int orow = crow(r, hi);
#pragma unroll
        for (int d0 = 0; d0 < 2; ++d0) stg[orow * 64 + d0 * 32 + r32] = (bf16_t)f2bf(o[d0][r] * rs[r]); }
    asm volatile("s_waitcnt lgkmcnt(0)" ::: "memory");
#pragma unroll
    for (int i = 0; i < 4; ++i) { const int row = i * 8 + (lane >> 3), ch = lane & 7; const u32x4 v = *(const LAS u32x4*)(stg + row * 64 + ch * 8); *(u32x4*)(Ow + (size_t)row * pitch + ch * 8) = v; }
    asm volatile("s_waitcnt lgkmcnt(0)" ::: "memory");
}

constexpr int SB_K0 = 0, SB_V0 = 16384, SB_STAGE = 32768, SB_FLAGS = 65536, SB_LDS_END = 65536 + 64;
template <bool EARLY_EXIT>
__device__ __forceinline__ void sb_phase(const bf16_t* Q, const bf16_t* K, const bf16_t* V, bf16_t* O, LAS unsigned char* lds) {
    int tid_op = threadIdx.x; asm volatile("" : "+v"(tid_op));
    const int tid = tid_op, lane = tid & 63, r32 = lane & 31, hi = lane >> 5, wid = __builtin_amdgcn_readfirstlane(tid >> 6);
    const int vb0 = (int)(unsigned)(uintptr_t)(lds + SB_V0) + ((lane >> 4) & 1) * 32 + (lane & 3) * 8 + (4 * hi + ((lane & 15) >> 2)) * 64;
    volatile LAS unsigned* flags = (volatile LAS unsigned*)(lds + SB_FLAGS);
    const float m0 = hi == 0 ? 1.0f : 0.0f;
    for (int unit = blockIdx.x; unit < BATCH * 8 * 16; unit += gridDim.x) {
        const int qb = unit & 15, h = (unit >> 4) & 7, b = unit >> 7;
        const int q0 = qb * 256;
        const size_t rowbase = (size_t)b * SEQ;
        const bf16_t* Kh = K + rowbase * 512 + h * 64; const bf16_t* Vh = V + rowbase * 512 + h * 64;
        const bf16_t* Qw = Q + (rowbase + q0 + wid * 32) * 512 + h * 64;
        int kt = 4 * qb + 3;
        u32x4 kreg = tile_gload(Kh + (size_t)kt * 64 * 512, 512, tid), vreg = tile_gload(Vh + (size_t)kt * 64 * 512, 512, tid);
        bf16x8 qr[4];
#pragma unroll
        for (int d0 = 0; d0 < 4; ++d0) qr[d0] = *(const bf16x8*)(Qw + (size_t)r32 * 512 + d0 * 16 + hi * 8);
        if (tid < 16) flags[tid] = 0u;
        tile_kwrite(lds + SB_K0, kreg, tid); tile_vwrite(lds + SB_V0, vreg, tid);
        f32x16 o[2]; o[0] = f32x16{}; o[1] = f32x16{};
        float carry = 0.f;
        int cur = 0, it = 0;
        for (;;) {
            __syncthreads();
            if (EARLY_EXIT && it > 0) {
                const int fs = ((it - 1) & 1) * 8;
                unsigned all = 1u;
#pragma unroll
                for (int w = 0; w < 8; ++w) all &= flags[fs + w];
                if (all) break;
            }
            const bool more = kt > 0;
            if (more) { kreg = tile_gload(Kh + (size_t)(kt - 1) * 64 * 512, 512, tid); vreg = tile_gload(Vh + (size_t)(kt - 1) * 64 * 512, 512, tid); }
            const int D = q0 + 32 * wid - 64 * kt;
            if (D + 31 > 0) {
                f32x16 p0, p1;
                qkt(p0, p1, lds + SB_K0 + cur * 8192, qr, r32, hi);
                if (D < 64) {
                    const int qrel = D + r32;
#pragma unroll
                    for (int r = 0; r < 16; ++r) { const int kv = crow(r, hi); if (kv >= qrel) p0[r] = -INFINITY; if (kv + 32 >= qrel) p1[r] = -INFINITY; }
                }
                f32x16 l0, l1;
#pragma unroll
                for (int r = 0; r < 16; ++r) { l0[r] = fmaxf(p0[r], 0.f) + __log2f(1.0f + exp2f(-fabsf(p0[r]))); l1[r] = fmaxf(p1[r], 0.f) + __log2f(1.0f + exp2f(-fabsf(p1[r]))); }
                float tt[8], uu[8];
#pragma unroll
                for (int i = 0; i < 4; ++i) { tt[i] = (l0[4 * i] + l0[4 * i + 1]) + (l0[4 * i + 2] + l0[4 * i + 3]); tt[4 + i] = (l1[4 * i] + l1[4 * i + 1]) + (l1[4 * i + 2] + l1[4 * i + 3]); }
#pragma unroll
                for (int k = 0; k < 8; ++k) { auto rr = __builtin_amdgcn_permlane32_swap(__float_as_uint(tt[k]), __float_as_uint(tt[k]), false, false); uu[k] = __uint_as_float(hi ? rr[0] : rr[1]); }
                float sw = 0.f, base[8];
#pragma unroll
                for (int k = 7; k >= 0; --k) { base[k] = carry - (sw + m0 * uu[k]); sw += tt[k] + uu[k]; }
#pragma unroll
                for (int i = 0; i < 4; ++i) {
                    float s3 = l0[4 * i + 3], s2 = s3 + l0[4 * i + 2], s1 = s2 + l0[4 * i + 1], s0 = s1 + l0[4 * i];
                    p0[4 * i + 3] = exp2f(p0[4 * i + 3] + (base[i] - s3)); p0[4 * i + 2] = exp2f(p0[4 * i + 2] + (base[i] - s2));
                    p0[4 * i + 1] = exp2f(p0[4 * i + 1] + (base[i] - s1)); p0[4 * i] = exp2f(p0[4 * i] + (base[i] - s0));
                    s3 = l1[4 * i + 3]; s2 = s3 + l1[4 * i + 2]; s1 = s2 + l1[4 * i + 1]; s0 = s1 + l1[4 * i];
                    p1[4 * i + 3] = exp2f(p1[4 * i + 3] + (base[4 + i] - s3)); p1[4 * i + 2] = exp2f(p1[4 * i + 2] + (base[4 + i] - s2));
                    p1[4 * i + 1] = exp2f(p1[4 * i + 1] + (base[4 + i] - s1)); p1[4 * i] = exp2f(p1[4 * i] + (base[4 + i] - s0));
                }
                carry -= sw;
                bf16x8 pa0, pa1, pa2, pa3; pack_p(p0, p1, pa0, pa1, pa2, pa3);
                pv(o, vb0 + cur * 8192, pa0, pa1, pa2, pa3);
            }
            if (EARLY_EXIT) { const bool done = __all(carry < -SB_EXIT); if (lane == 0) flags[(it & 1) * 8 + wid] = done ? 1u : 0u; }
            if (!more) break;
            tile_kwrite(lds + SB_K0 + (cur ^ 1) * 8192, kreg, tid); tile_vwrite(lds + SB_V0 + (cur ^ 1) * 8192, vreg, tid);
            cur ^= 1; --kt; ++it;
        }
        float ones[16];
#pragma unroll
        for (int r = 0; r < 16; ++r) ones[r] = 1.0f;
        store_o(o, ones, lds + SB_STAGE + wid * 4096, O + (rowbase + q0 + wid * 32) * 512 + h * 64, 512, lane);
        __syncthreads();
    }
}

constexpr int SW_K0 = 0, SW_V0 = 24576, SW_STAGE = 49152, SW_WSF = 81920, SW_LDS_END = 81920 + 2048;
__device__ __forceinline__ void swa_phase(const bf16_t* Q, const bf16_t* K, const bf16_t* V, bf16_t* O, const float* sinks, LAS unsigned char* lds) {
    int tid_op = threadIdx.x; asm volatile("" : "+v"(tid_op));
    const int tid = tid_op, lane = tid & 63, r32 = lane & 31, hi = lane >> 5, wid = __builtin_amdgcn_readfirstlane(tid >> 6);
    const int vb0 = (int)(unsigned)(uintptr_t)(lds + SW_V0) + ((lane >> 4) & 1) * 32 + (lane & 3) * 8 + (4 * hi + ((lane & 15) >> 2)) * 64;
    LAS float* wsf = (LAS float*)(lds + SW_WSF) + wid * 64;
    const int g = wid >> 1, j = wid & 1;
    for (int unit = blockIdx.x; unit < BATCH * 2 * 64; unit += gridDim.x) {
        const int qb = unit & 63, kvh = (unit >> 6) & 1, b = unit >> 7;
        const int q0 = qb * 64, hq = kvh * 4 + g;
        const size_t rowbase = (size_t)b * SEQ;
        const bf16_t* Kh = K + rowbase * 128 + kvh * 64; const bf16_t* Vh = V + rowbase * 128 + kvh * 64;
        const bf16_t* Qw = Q + (rowbase + q0 + j * 32) * 512 + hq * 64;
        __syncthreads();
#pragma unroll
        for (int i = 0; i < 3; ++i) { const int kt = qb - 2 + i;
            if (kt >= 0) { const u32x4 kv = tile_gload(Kh + (size_t)kt * 64 * 128, 128, tid), vv = tile_gload(Vh + (size_t)kt * 64 * 128, 128, tid);
                tile_kwrite(lds + SW_K0 + i * 8192, kv, tid); tile_vwrite(lds + SW_V0 + i * 8192, vv, tid); } }
        bf16x8 qr[4];
#pragma unroll
        for (int d0 = 0; d0 < 4; ++d0) qr[d0] = *(const bf16x8*)(Qw + (size_t)r32 * 512 + d0 * 16 + hi * 8);
        __syncthreads();
        const int qrel = 32 * j + r32;
        const float sink2 = sinks[hq] * LOG2E;
        float m = sink2;
#pragma unroll
        for (int i = 0; i < 3; ++i) {
            if (qb - 2 + i >= 0) {
                f32x16 p0, p1;
                qkt(p0, p1, lds + SW_K0 + i * 8192, qr, r32, hi);
#pragma unroll
                for (int r = 0; r < 16; ++r) { const int kv = crow(r, hi);
                    bool v0 = true, v1 = true;
                    if (i == 2) { v0 = kv <= qrel; v1 = kv + 32 <= qrel; }
                    if (i == 0) { v0 = kv > qrel; v1 = kv + 32 > qrel; }
                    m = fmaxf(m, fmaxf(v0 ? p0[r] : -INFINITY, v1 ? p1[r] : -INFINITY)); }
            }
        }
        { auto rr = __builtin_amdgcn_permlane32_swap(__float_as_uint(m), __float_as_uint(m), false, false); m = fmaxf(__uint_as_float(rr[0]), __uint_as_float(rr[1])); }
        float lsum = 0.f;
        f32x16 o[2]; o[0] = f32x16{}; o[1] = f32x16{};
#pragma unroll
        for (int i = 0; i < 3; ++i) {
            if (qb - 2 + i >= 0) {
                f32x16 p0, p1;
                qkt(p0, p1, lds + SW_K0 + i * 8192, qr, r32, hi);
#pragma unroll
                for (int r = 0; r < 16; ++r) { const int kv = crow(r, hi);
                    bool v0 = true, v1 = true;
                    if (i == 2) { v0 = kv <= qrel; v1 = kv + 32 <= qrel; }
                    if (i == 0) { v0 = kv > qrel; v1 = kv + 32 > qrel; }
                    p0[r] = v0 ? exp2f(p0[r] - m) : 0.f; p1[r] = v1 ? exp2f(p1[r] - m) : 0.f; lsum += p0[r] + p1[r]; }
                bf16x8 pa0, pa1, pa2, pa3; pack_p(p0, p1, pa0, pa1, pa2, pa3); pv(o, vb0 + i * 8192, pa0, pa1, pa2, pa3);
            }
        }
        { auto rr = __builtin_amdgcn_permlane32_swap(__float_as_uint(lsum), __float_as_uint(lsum), false, false); lsum = __uint_as_float(rr[0]) + __uint_as_float(rr[1]); }
        lsum += exp2f(sink2 - m);
        if (hi == 0) wsf[r32] = 1.0f / lsum;
        asm volatile("s_waitcnt lgkmcnt(0)" ::: "memory");
        float rs[16];
#pragma unroll
        for (int r = 0; r < 16; ++r) rs[r] = wsf[crow(r, hi)];
        asm volatile("s_waitcnt lgkmcnt(0)" ::: "memory");
        store_o(o, rs, lds + SW_STAGE + wid * 4096, O + (rowbase + q0 + j * 32) * 512 + hq * 64, 512, lane);
    }
}
#undef ATT_SBAR
}

namespace tk {
typedef short bf16x8 __attribute__((ext_vector_type(8)));
typedef float f32x16 __attribute__((ext_vector_type(16)));
__device__ __forceinline__ float vmax(float a, float b) { float r; asm("v_max_f32 %0, %1, %2" : "=v"(r) : "v"(a), "v"(b)); return r; }
__device__ __forceinline__ float vmin(float a, float b) { float r; asm("v_min_f32 %0, %1, %2" : "=v"(r) : "v"(a), "v"(b)); return r; }
#define TK_CE(a, b) { const float t_ = vmax(a, b); b = vmin(a, b); a = t_; }
__device__ __forceinline__ void sort16(float (&v)[16]) {
    TK_CE(v[0], v[1]) TK_CE(v[2], v[3]) TK_CE(v[0], v[2]) TK_CE(v[1], v[3]) TK_CE(v[1], v[2]) TK_CE(v[4], v[5]) TK_CE(v[6], v[7]) TK_CE(v[4], v[6])
    TK_CE(v[5], v[7]) TK_CE(v[5], v[6]) TK_CE(v[0], v[4]) TK_CE(v[2], v[6]) TK_CE(v[2], v[4]) TK_CE(v[1], v[5]) TK_CE(v[3], v[7]) TK_CE(v[3], v[5])
    TK_CE(v[1], v[2]) TK_CE(v[3], v[4]) TK_CE(v[5], v[6]) TK_CE(v[8], v[9]) TK_CE(v[10], v[11]) TK_CE(v[8], v[10]) TK_CE(v[9], v[11]) TK_CE(v[9], v[10])
    TK_CE(v[12], v[13]) TK_CE(v[14], v[15]) TK_CE(v[12], v[14]) TK_CE(v[13], v[15]) TK_CE(v[13], v[14]) TK_CE(v[8], v[12]) TK_CE(v[10], v[14]) TK_CE(v[10], v[12])
    TK_CE(v[9], v[13]) TK_CE(v[11], v[15]) TK_CE(v[11], v[13]) TK_CE(v[9], v[10]) TK_CE(v[11], v[12]) TK_CE(v[13], v[14]) TK_CE(v[0], v[8]) TK_CE(v[4], v[12])
    TK_CE(v[4], v[8]) TK_CE(v[2], v[10]) TK_CE(v[6], v[14]) TK_CE(v[6], v[10]) TK_CE(v[2], v[4]) TK_CE(v[6], v[8]) TK_CE(v[10], v[12]) TK_CE(v[1], v[9])
    TK_CE(v[5], v[13]) TK_CE(v[5], v[9]) TK_CE(v[3], v[11]) TK_CE(v[7], v[15]) TK_CE(v[7], v[11]) TK_CE(v[3], v[5]) TK_CE(v[7], v[9]) TK_CE(v[11], v[13])
    TK_CE(v[1], v[2]) TK_CE(v[3], v[4]) TK_CE(v[5], v[6]) TK_CE(v[7], v[8]) TK_CE(v[9], v[10]) TK_CE(v[11], v[12]) TK_CE(v[13], v[14])
}
__device__ __forceinline__ void bmerge16(float (&v)[16]) {
    TK_CE(v[0], v[8]) TK_CE(v[1], v[9]) TK_CE(v[2], v[10]) TK_CE(v[3], v[11]) TK_CE(v[4], v[12]) TK_CE(v[5], v[13]) TK_CE(v[6], v[14]) TK_CE(v[7], v[15])
    TK_CE(v[0], v[4]) TK_CE(v[1], v[5]) TK_CE(v[2], v[6]) TK_CE(v[3], v[7]) TK_CE(v[8], v[12]) TK_CE(v[9], v[13]) TK_CE(v[10], v[14]) TK_CE(v[11], v[15])
    TK_CE(v[0], v[2]) TK_CE(v[1], v[3]) TK_CE(v[4], v[6]) TK_CE(v[5], v[7]) TK_CE(v[8], v[10]) TK_CE(v[9], v[11]) TK_CE(v[12], v[14]) TK_CE(v[13], v[15])
    TK_CE(v[0], v[1]) TK_CE(v[2], v[3]) TK_CE(v[4], v[5]) TK_CE(v[6], v[7]) TK_CE(v[8], v[9]) TK_CE(v[10], v[11]) TK_CE(v[12], v[13]) TK_CE(v[14], v[15])
}

__device__ __forceinline__ void merge_top16(float (&a)[16], const float (&b)[16]) {
#pragma unroll
    for (int i = 0; i < 16; ++i) a[i] = vmax(a[i], b[15 - i]);
    bmerge16(a);
}
__device__ __forceinline__ float partner_f(float v, int hi) { auto rr = __builtin_amdgcn_permlane32_swap(__float_as_uint(v), __float_as_uint(v), false, false); return __uint_as_float(hi ? rr[0] : rr[1]); }
__device__ __forceinline__ void merge_partner(float (&a)[16], int hi) {
    float pp[16];
#pragma unroll
    for (int i = 0; i < 16; ++i) pp[i] = partner_f(a[i], hi);
    merge_top16(a, pp);
}
__device__ __forceinline__ void take_block(float (&v)[16], const f32x16& acc, int blk, unsigned hi4) {
#pragma unroll
    for (int r = 0; r < 16; ++r) { const unsigned code = 127u - (unsigned)(32 * blk + (r & 3) + 8 * (r >> 2)); v[r] = __uint_as_float(((__float_as_uint(acc[r]) & 0xFFFFFF80u) | code) ^ hi4); }
    sort16(v);
}
constexpr int TK_SK = 0, TK_IDX = 65536, TK_LDS_END = 65536 + 8192;
constexpr float TK_NEG = -3.4028234663852886e38f;
template <int P>
__device__ __forceinline__ void half_top16(float (&L)[16], const bf16_t* qrow, LAS unsigned char* lds, LAS unsigned char* idxslot, int r32, int hi) {
    bf16x8 qf[8];
#pragma unroll
    for (int ks = 0; ks < 8; ++ks) qf[ks] = *(const bf16x8*)(qrow + P * 128 + 16 * ks + 8 * hi);
    f32x16 acc[4];
#pragma unroll
    for (int blk = 0; blk < 4; ++blk) acc[blk] = f32x16{};
    const LAS unsigned char* ab = lds + TK_SK + P * 32768 + hi * 2048 + r32 * 16;
#pragma unroll
    for (int ks = 0; ks < 8; ++ks)
#pragma unroll
        for (int blk = 0; blk < 4; ++blk) {
            const bf16x8 af = *(const LAS bf16x8*)(ab + ks * 4096 + blk * 512);
            acc[blk] = __builtin_amdgcn_mfma_f32_32x32x16_bf16(af, qf[ks], acc[blk], 0, 0, 0);
        }
    const unsigned hi4 = (unsigned)hi << 2;
    float M[16];
    take_block(L, acc[0], 0, hi4); take_block(M, acc[1], 1, hi4); merge_top16(L, M);
    { float N[16]; take_block(M, acc[2], 2, hi4); take_block(N, acc[3], 3, hi4); merge_top16(M, N); }
    merge_top16(L, M);
    merge_partner(L, hi);
    if (hi == 0) {
        u32x4 w;
#pragma unroll
        for (int q = 0; q < 4; ++q) w[q] = (__float_as_uint(L[4 * q]) & 127u) | ((__float_as_uint(L[4 * q + 1]) & 127u) << 8) | ((__float_as_uint(L[4 * q + 2]) & 127u) << 16) | ((__float_as_uint(L[4 * q + 3]) & 127u) << 24);
        *(LAS u32x4*)(idxslot + P * 16) = w;
    }
}
__device__ __forceinline__ float cand(float x, float y, unsigned code, unsigned hi8) { return __uint_as_float((__float_as_uint(x + y) & 0xFFFFFE00u) | code | hi8); }

__device__ __forceinline__ void topk_phase(const bf16_t* Q2, const bf16_t* SKl, int* IDX, float* GATE, LAS unsigned char* lds) {
    int tid_op = threadIdx.x; asm volatile("" : "+v"(tid_op));
    const int tid = tid_op, lane = tid & 63, r32 = lane & 31, hi = lane >> 5, wid = __builtin_amdgcn_readfirstlane(tid >> 6);
    LAS unsigned char* idxslot = lds + TK_IDX + wid * 1024 + r32 * 32;
    int cur_h = -1;
    for (int unit = blockIdx.x; unit < 8 * (T / 256); unit += gridDim.x) {
        const int h = unit & 7, tb = unit >> 3;
        if (h != cur_h) {
            __syncthreads();
#pragma unroll
            for (int i = 0; i < 8; ++i) { const int id = tid + 512 * i, c = id & 15, n = (id >> 4) & 127, p = id >> 11;
                const u32x4 v = *(const u32x4*)(SKl + ((size_t)(h * 2 + p) * 128 + n) * 128 + c * 8);
                *(LAS u32x4*)(lds + TK_SK + p * 32768 + c * 2048 + n * 16) = v; }
            __syncthreads();
            cur_h = h;
        }
        const size_t token = (size_t)tb * 256 + wid * 32 + r32;
        const bf16_t* qrow = Q2 + token * PQ + h * 256;
        float a[16], b[16];
        half_top16<0>(a, qrow, lds, idxslot, r32, hi);
        half_top16<1>(b, qrow, lds, idxslot, r32, hi);
        float x[16], y[16];
#pragma unroll
        for (int i = 0; i < 16; ++i) { float av = a[i], bv = b[i]; asm volatile("" : "+v"(av), "+v"(bv)); x[i] = hi ? bv : av; y[i] = hi ? av : bv; }
        const unsigned hi8 = (unsigned)hi << 8;
        float A[16], B[16];
#pragma unroll
        for (int j = 1; j < 16; ++j) A[j - 1] = cand(x[0], y[j], (unsigned)j, hi8);
        A[15] = TK_NEG;
#pragma unroll
        for (int j = 2; j < 8; ++j) B[j - 2] = cand(x[1], y[j], (unsigned)(16 + j), hi8);
        B[6] = cand(x[2], y[3], 2u * 16u + 3u, hi8); B[7] = cand(x[2], y[4], 2u * 16u + 4u, hi8);
#pragma unroll
        for (int i = 0; i < 4; ++i) { const float d = cand(x[i], y[i], (unsigned)(17 * i), hi8); B[8 + i] = hi ? TK_NEG : d; }
        B[12] = TK_NEG; B[13] = TK_NEG; B[14] = TK_NEG; B[15] = TK_NEG;
        sort16(B);
        merge_top16(A, B);
        merge_partner(A, hi);
        const float smax = A[0];
        float ex[8]; int eidx[8]; float lsum = 0.f;
        asm volatile("s_waitcnt lgkmcnt(0)" ::: "memory");
#pragma unroll
        for (int k = 0; k < 8; ++k) {
            float s_lo = A[k], s_hi = A[8 + k]; asm volatile("" : "+v"(s_lo), "+v"(s_hi)); const float s = hi ? s_hi : s_lo;
            ex[k] = __expf(s - smax); lsum += ex[k];
            const unsigned code = __float_as_uint(s) & 0x1FFu, src = code >> 8, ci = (code >> 4) & 15u, cj = code & 15u;
            const unsigned ai = src ? cj : ci, bi = src ? ci : cj;
            const unsigned ca = idxslot[ai], cb = idxslot[16 + bi];
            eidx[k] = (int)(((ca ^ 127u) << 7) | (cb ^ 127u));
        }
        const float tot = lsum + partner_f(lsum, hi);
        const float inv = 1.0f / tot;
        int* ip = IDX + token * 128 + h * 16 + 8 * hi; float* gp = GATE + token * 128 + h * 16 + 8 * hi;
        *(u32x4*)ip = (u32x4){(unsigned)eidx[0], (unsigned)eidx[1], (unsigned)eidx[2], (unsigned)eidx[3]};
        *(u32x4*)(ip + 4) = (u32x4){(unsigned)eidx[4], (unsigned)eidx[5], (unsigned)eidx[6], (unsigned)eidx[7]};
        *(f32x4*)gp = (f32x4){ex[0] * inv, ex[1] * inv, ex[2] * inv, ex[3] * inv};
        *(f32x4*)(gp + 4) = (f32x4){ex[4] * inv, ex[5] * inv, ex[6] * inv, ex[7] * inv};
        asm volatile("s_waitcnt lgkmcnt(0)" ::: "memory");
    }
}
}

__device__ __forceinline__ void ph_peer(const KArgs& a, int l, const float* mod_l) {
    int tid_op = threadIdx.x; asm volatile("" : "+v"(tid_op)); const int tid = tid_op, lane = tid & 63, wave = tid >> 6;
    const int gw = blockIdx.x * NWAVES + wave, NGW = gridDim.x * NWAVES;
    const unsigned char* UQ = a.ws + WS_UQ + (size_t)l * NEXP * 1024; const unsigned char* VQ = a.ws + WS_VQ + (size_t)l * NEXP * 1024;
    const float* USC = (const float*)(a.ws + WS_USC) + l * NEXP; const float* VSC = (const float*)(a.ws + WS_VSC) + l * NEXP;
    const int* IDX = (const int*)(a.ws + WS_IDX); const float* GATE = (const float*)(a.ws + WS_GATE);
    const unsigned char* HQ = a.ws + WS_H2Q; const float* HS = (const float*)(a.ws + WS_HS);
    for (int t = gw; t < T; t += NGW) {
        const int b = t >> 12;
        const u32x4 hv = *(const u32x4*)(HQ + (size_t)t * 1024 + 16 * lane);
        const float sh = HS[t];
        const int idx0 = IDX[(size_t)t * 128 + lane], idx1 = IDX[(size_t)t * 128 + 64 + lane];
        float coef0 = 0.f, coef1 = 0.f;
#pragma unroll 1
        for (int kb = 0; kb < 8; ++kb) {
            u32x4 uv[16]; int ee[16];
#pragma unroll
            for (int kk = 0; kk < 16; ++kk) { const int k = kb * 16 + kk; ee[kk] = rdlane_i(k < 64 ? idx0 : idx1, k & 63); uv[kk] = *(const u32x4*)(UQ + (size_t)ee[kk] * 1024 + 16 * lane); }
#pragma unroll
            for (int kk = 0; kk < 16; ++kk) {
                const int k = kb * 16 + kk;
                int is = __builtin_amdgcn_sdot4((int)uv[kk].x, (int)hv.x, 0, false);
                is = __builtin_amdgcn_sdot4((int)uv[kk].y, (int)hv.y, is, false);
                is = __builtin_amdgcn_sdot4((int)uv[kk].z, (int)hv.z, is, false);
                is = __builtin_amdgcn_sdot4((int)uv[kk].w, (int)hv.w, is, false);
                const float d = wave_sum((float)is) * USC[ee[kk]] * sh;
                const float act = 0.5f * d * (1.0f + erff(d * 0.70710678118654752f));
                if ((k & 63) == lane) { if (k < 64) coef0 = act; else coef1 = act; }
            }
        }
        coef0 *= GATE[(size_t)t * 128 + lane] * VSC[idx0];
        coef1 *= GATE[(size_t)t * 128 + 64 + lane] * VSC[idx1];
        float acc[16], csum = 0.f;
#pragma unroll
        for (int i = 0; i < 16; ++i) acc[i] = 0.f;
#pragma unroll 1
        for (int kb = 0; kb < 16; ++kb) {
            u32x4 vv[8]; float cc[8];
#pragma unroll
            for (int kk = 0; kk < 8; ++kk) { const int k = kb * 8 + kk; const int e = rdlane_i(k < 64 ? idx0 : idx1, k & 63); cc[kk] = rdlane_f(k < 64 ? coef0 : coef1, k & 63); vv[kk] = *(const u32x4*)(VQ + (size_t)e * 1024 + 16 * lane); }
#pragma unroll
            for (int kk = 0; kk < 8; ++kk) {
                csum += cc[kk];
#pragma unroll
                for (int i = 0; i < 4; ++i) { const unsigned w = vv[kk][i];
                    acc[4 * i + 0] = fmaf(cc[kk], (float)(w & 0xffu), acc[4 * i + 0]); acc[4 * i + 1] = fmaf(cc[kk], (float)((w >> 8) & 0xffu), acc[4 * i + 1]);
                    acc[4 * i + 2] = fmaf(cc[kk], (float)((w >> 16) & 0xffu), acc[4 * i + 2]); acc[4 * i + 3] = fmaf(cc[kk], (float)(w >> 24), acc[4 * i + 3]); }
            }
        }
        const float off = 128.0f * csum;
#pragma unroll
        for (int i = 0; i < 4; ++i) {
            const int col = 256 * i + 4 * lane;
            const f32x4 g = *(const f32x4*)(mod_l + (size_t)b * NMOD + 5 * DM + col);
            f32x4 xv = *(const f32x4*)(a.out + (size_t)t * DM + col);
            xv.x += g.x * (acc[4 * i + 0] - off); xv.y += g.y * (acc[4 * i + 1] - off); xv.z += g.z * (acc[4 * i + 2] - off); xv.w += g.w * (acc[4 * i + 3] - off);
            *(f32x4*)(a.out + (size_t)t * DM + col) = xv;
        }
    }
}

constexpr int PH_PER_LAYER = 9, NPHASES = 1 + DEPTH * PH_PER_LAYER + 1;
#ifndef PHASE_MASK
#define PHASE_MASK 0xFFFF
#endif
#define HASP(k) (((PHASE_MASK) >> (k)) & 1)
#ifndef SB_EARLY_EXIT
#define SB_EARLY_EXIT 1
#endif

typedef const __attribute__((address_space(4))) KArgs* KArgsP;
__device__ __forceinline__ KArgsP kargs() { KArgsP p = (KArgsP)__builtin_amdgcn_kernarg_segment_ptr(); asm volatile("" : "+s"(p)); return p; }

__device__ __forceinline__ void load_args(KArgs& a) {
#if defined(__HIP_DEVICE_COMPILE__)
    KArgsP p = kargs();
    a.x = p->x; a.c = p->c; a.pos = p->pos; a.ada_w = p->ada_w; a.ada_b = p->ada_b; a.norm1_g = p->norm1_g; a.w_in = p->w_in; a.sinks = p->sinks; a.wbr_a = p->wbr_a; a.wbr_b = p->wbr_b;
    a.w_out = p->w_out; a.norm2_g = p->norm2_g; a.wq = p->wq; a.subkeys = p->subkeys; a.pu = p->pu; a.pv = p->pv; a.final_g = p->final_g; a.out = p->out; a.ws = p->ws; a.ph_lo = p->ph_lo; a.ph_hi = p->ph_hi;
#endif
}
__global__ void __launch_bounds__(NTHREADS, 2) fwd_kernel(KArgs a_unused) {
    extern __shared__ __attribute__((aligned(16))) unsigned char lds_raw[];
    LAS unsigned char* lds = (LAS unsigned char*)lds_raw;
    cg::grid_group grid = cg::this_grid();
    const int ph_lo = kargs()->ph_lo, ph_hi = kargs()->ph_hi;
#define IN(k) (ph_lo <= (k) && (k) < ph_hi)
#ifdef PROBE_PH
    unsigned long long pr_prev = __builtin_amdgcn_s_memrealtime(), pr_acc = 0;
#define PROBE_MATCH(k) ((PROBE_PH) >= 100 ? ((k) >= 1 && (k) < NPHASES - 1 && (((k) - 1) % PH_PER_LAYER) == (PROBE_PH) - 100) : (k) == (PROBE_PH))
#define SEAM(k) do { if (IN(k) && IN((k) + 1)) grid.sync(); { const unsigned long long now_ = __builtin_amdgcn_s_memrealtime(); if (PROBE_MATCH(k)) pr_acc += now_ - pr_prev; pr_prev = now_; } } while (0)
#else
#define SEAM(k) do { if (IN(k) && IN((k) + 1)) grid.sync(); } while (0)
#endif
#define LOADARGS KArgs a; load_args(a); unsigned char* ws = a.ws; const int G = gridDim.x; (void)G; (void)ws
#define LAYERARGS const float* mod_l = (const float*)(ws + WS_MOD) + (size_t)l * 8 * NMOD; const float* xcur = (l == 0) ? a.x : a.out; (void)mod_l; (void)xcur
    if (IN(0)) { if (HASP(0)) { LOADARGS; ph_prologue(a, lds); } }
    SEAM(0);
#pragma unroll 1
    for (int l = 0; l < DEPTH; ++l) {
        const int p0 = 1 + l * PH_PER_LAYER;
        if (IN(p0 + 0)) { if (HASP(1)) { LOADARGS; LAYERARGS; ph_norm<false>(a, xcur, a.norm1_g + l * DM, mod_l, 0, 1); } }
        SEAM(p0 + 0);
        if (IN(p0 + 1)) { if (HASP(2)) { LOADARGS; pg8::Gemm g{(const bf16_t*)(ws + WS_H), (const bf16_t*)(ws + WS_WIN) + (size_t)l * NPROJ * 1024, T, NPROJ, 1024};
                  pg8::StaticOrder S; S.init(T, NPROJ, G, (int)blockIdx.x); EpiProj E{ws};
                  pg8::gemm_phase<EpiProj, pg8::StaticOrder, true, true>(lds, g, S, E); } }
        SEAM(p0 + 1);
        if (IN(p0 + 2)) { if (HASP(3)) { LOADARGS;
                  att::swa_phase((const bf16_t*)(ws + WS_QA), (const bf16_t*)(ws + WS_KA), (const bf16_t*)(ws + WS_VA), (bf16_t*)(ws + WS_QA), a.sinks + l * 8, lds);
                  __syncthreads();
                  att::sb_phase<SB_EARLY_EXIT != 0>((const bf16_t*)(ws + WS_QB), (const bf16_t*)(ws + WS_KB), (const bf16_t*)(ws + WS_VB), (bf16_t*)(ws + WS_QB), lds); } }
        SEAM(p0 + 2);
        if (IN(p0 + 3)) { if (HASP(4)) { LOADARGS; pg8::StaticOrder S; S.init(T, DM, G, (int)blockIdx.x);
                  { pg8::Gemm g{(const bf16_t*)(ws + WS_QA), (const bf16_t*)(ws + WS_WBA) + (size_t)l * 1024 * 512, T, DM, 512};
                    EpiBranch<false> E{(const bf16_t*)(ws + WS_GA), (bf16_t*)(ws + WS_H)};
                    pg8::gemm_phase<EpiBranch<false>, pg8::StaticOrder, true, true>(lds, g, S, E); }
                  __syncthreads();
                  { pg8::Gemm g{(const bf16_t*)(ws + WS_QB), (const bf16_t*)(ws + WS_WBB) + (size_t)l * 1024 * 512, T, DM, 512};
                    EpiBranch<true> E{(const bf16_t*)(ws + WS_GB), (bf16_t*)(ws + WS_H)};
                    pg8::gemm_phase<EpiBranch<true>, pg8::StaticOrder, true, true>(lds, g, S, E); } } }
        SEAM(p0 + 3);
        if (IN(p0 + 4)) { if (HASP(5)) { LOADARGS; LAYERARGS; pg8::Gemm g{(const bf16_t*)(ws + WS_H), (const bf16_t*)(ws + WS_WOUT) + (size_t)l * 1024 * 1024, T, DM, 1024};
                  pg8::StaticOrder S; S.init(T, DM, G, (int)blockIdx.x); EpiWout E{xcur, a.out, mod_l + 2 * DM};
                  pg8::gemm_phase<EpiWout, pg8::StaticOrder, true, true>(lds, g, S, E); } }
        SEAM(p0 + 4);
        if (IN(p0 + 5)) { if (HASP(6)) { LOADARGS; LAYERARGS; ph_norm<true>(a, a.out, a.norm2_g + l * DM, mod_l, 3, 4); } }
        SEAM(p0 + 5);
        if (IN(p0 + 6)) { if (HASP(7)) { LOADARGS; pg8::Gemm g{(const bf16_t*)(ws + WS_H), (const bf16_t*)(ws + WS_WQ) + (size_t)l * PQ * 1024, T, PQ, 1024};
                  pg8::StaticOrder S; S.init(T, PQ, G, (int)blockIdx.x); EpiPlainBf16 E{(bf16_t*)(ws + WS_Q2), PQ};
                  pg8::gemm_phase<EpiPlainBf16, pg8::StaticOrder, true, true>(lds, g, S, E); } }
        SEAM(p0 + 6);
        if (IN(p0 + 7)) { if (HASP(8)) { LOADARGS; tk::topk_phase((const bf16_t*)(ws + WS_Q2), (const bf16_t*)(ws + WS_SK) + (size_t)l * 8 * 2 * 128 * 128, (int*)(ws + WS_IDX), (float*)(ws + WS_GATE), lds); } }
        SEAM(p0 + 7);
        if (IN(p0 + 8)) { if (HASP(9)) { LOADARGS; LAYERARGS; ph_peer(a, l, mod_l); } }
        SEAM(p0 + 8);
    }
    if (IN(NPHASES - 1)) { if (HASP(10)) { LOADARGS; ph_final_norm(a); } }
#ifdef PROBE_PH
    { const unsigned long long now_ = __builtin_amdgcn_s_memrealtime(); if (PROBE_MATCH(NPHASES - 1)) pr_acc += now_ - pr_prev;
      if (blockIdx.x == 0 && threadIdx.x == 0) { const unsigned long long t0_ = __builtin_amdgcn_s_memrealtime(); while (__builtin_amdgcn_s_memrealtime() - t0_ < pr_acc * (PROBE_K)) __builtin_amdgcn_s_sleep(16); } }
#endif
#undef IN
#undef SEAM
}

#ifndef N_LAUNCH_SPLIT
#define N_LAUNCH_SPLIT 1
#endif
extern "C" void kernel_launch(void* const* d_in, const int* in_sizes, int n_in, void* d_out, int out_size, void* d_ws, size_t ws_size, hipStream_t stream) {
    static int grid = 0;
    if (grid == 0) {
        if (n_in != 17 || out_size != T * DM || ws_size < WS_END) { fprintf(stderr, "kernel_launch: unexpected problem (n_in %d out %d ws %zu)\n", n_in, out_size, ws_size); grid = -1; return; }
        int dev = 0, cus = 0, per_cu = 0;
        (void)hipGetDevice(&dev);
        (void)hipDeviceGetAttribute(&cus, hipDeviceAttributeMultiprocessorCount, dev);
        (void)hipFuncSetAttribute((const void*)fwd_kernel, hipFuncAttributeMaxDynamicSharedMemorySize, LDS_BYTES);
        (void)hipOccupancyMaxActiveBlocksPerMultiprocessor(&per_cu, (const void*)fwd_kernel, NTHREADS, LDS_BYTES);
        if (per_cu < 1) { fprintf(stderr, "kernel_launch: occupancy query says %d\n", per_cu); per_cu = 1; }
        grid = cus;
        fprintf(stderr, "kernel_launch: cus %d per_cu %d grid %d ws %zu\n", cus, per_cu, grid, ws_size);
    }
    if (grid < 0) return;
    KArgs a{};
    a.x = (const float*)d_in[0]; a.c = (const float*)d_in[1]; a.pos = (const int*)d_in[2]; a.ada_w = (const float*)d_in[3]; a.ada_b = (const float*)d_in[4];
    a.norm1_g = (const float*)d_in[5]; a.w_in = (const float*)d_in[6]; a.sinks = (const float*)d_in[7]; a.wbr_a = (const float*)d_in[8]; a.wbr_b = (const float*)d_in[9];
    a.w_out = (const float*)d_in[10]; a.norm2_g = (const float*)d_in[11]; a.wq = (const float*)d_in[12]; a.subkeys = (const float*)d_in[13]; a.pu = (const float*)d_in[14];
    a.pv = (const float*)d_in[15]; a.final_g = (const float*)d_in[16]; a.out = (float*)d_out; a.ws = (unsigned char*)d_ws;
#if N_LAUNCH_SPLIT
    a.ph_lo = 0; a.ph_hi = NPHASES;
    { void* args[] = {&a};
      hipError_t e = hipLaunchCooperativeKernel((void*)fwd_kernel, dim3(grid), dim3(NTHREADS), args, LDS_BYTES, stream);
      if (e != hipSuccess) fprintf(stderr, "cooperative launch failed: %s (grid %d)\n", hipGetErrorString(e), grid); }
#else
    for (int ph = 0; ph < NPHASES; ++ph) {
        a.ph_lo = ph; a.ph_hi = ph + 1;
        void* args[] = {&a};
        hipError_t e = hipLaunchCooperativeKernel((void*)fwd_kernel, dim3(grid), dim3(NTHREADS), args, LDS_BYTES, stream);
        if (e != hipSuccess) { fprintf(stderr, "cooperative launch %d failed: %s (grid %d)\n", ph, hipGetErrorString(e), grid); break; }
    }
#endif
}
```

```cpp
#include <hip/hip_runtime.h>
#include <hip/hip_cooperative_groups.h>
#include <cstdio>
#include <cstdint>
namespace cg = cooperative_groups;

namespace pg8 {
#define PG8_LAS __attribute__((address_space(3)))
typedef unsigned short bf16_t;
typedef short bf16x8 __attribute__((ext_vector_type(8)));
typedef float f32x4 __attribute__((ext_vector_type(4)));
typedef unsigned u32x4 __attribute__((ext_vector_type(4)));
constexpr int BM = 256, BK = 64, HALF = 128, HTB = HALF * BK * 2  , STAGE_BYTES = 8 * HTB, NXCD = 8, WGM = 8;

__host__ __device__ __forceinline__ int lds_byte(int r, int c) { const int st = (r >> 4) * 2 + (c >> 5), rr = r & 15, cc = c & 31, ob = rr * 64 + cc * 2; return st * 1024 + (ob ^ (((ob >> 9) & 1) << 5)); }
__host__ __device__ __forceinline__ void stage_rc(int b, int& R, int& C) { const int st = b / 1024, sb = b % 1024, swz = sb ^ (((sb >> 9) & 1) << 5); R = (st >> 1) * 16 + swz / 64; C = (st & 1) * 32 + (swz % 64) / 2; }
__host__ __device__ __forceinline__ int perm32(int rho) { const int n = rho >> 4, i = rho & 15; return 8 * (i >> 2) + 4 * n + (i & 3); }

struct Unit { int pm, pn; };
struct Gemm { const bf16_t* A; const bf16_t* Bt; int M, N, K; };

struct StaticOrder {
    int nM, nN, nwg, G, c;
    __host__ __device__ void init(int M, int N, int G_, int c_) { nM = M / BM; nN = N / BM; nwg = nM * nN; G = G_; c = c_; }
    __host__ __device__ bool next(int i, Unit& u) const {
        const long L = (long)i * G + c; if (L >= nwg) return false;
        int wgid = (int)L; { const int q = nwg / NXCD, r = nwg % NXCD, xcd = wgid % NXCD, off = wgid / NXCD; wgid = (xcd < r ? xcd * (q + 1) : r * (q + 1) + (xcd - r) * q) + off; }
        const int nig = WGM * nN, gid = wgid / nig, fm = gid * WGM, gsz = (nM - fm) < WGM ? (nM - fm) : WGM;
        u.pm = fm + ((wgid % nig) % gsz); u.pn = (wgid % nig) / gsz; return true;
    }
    __device__ __forceinline__ void a_ready(const Unit&) const {}
    __device__ __forceinline__ void done(const Unit&) const {}
};


__device__ __forceinline__ unsigned cvt_pk_bf16(float lo, float hi) { unsigned r; asm volatile("v_cvt_pk_bf16_f32 %0, %1, %2" : "=v"(r) : "v"(lo), "v"(hi)); return r; }
template <class Epi, class Sched, bool ALIGN_EPI = false, bool SP2 = false>
__device__ __forceinline__ void gemm_phase(PG8_LAS unsigned char* lds, const Gemm g, const Sched& S, const Epi& E) {
    int tid_op = threadIdx.x; asm volatile("" : "+v"(tid_op));
    const int tid = tid_op, wid = __builtin_amdgcn_readfirstlane(tid >> 6), lane = tid & 63, wr = wid >> 2, wc = wid & 3, fr = lane & 15, fq = lane >> 4;
    const int K = g.K, nt = K / BK;
    unsigned voffA[2], voffB[2];
#pragma unroll
    for (int i = 0; i < 2; ++i) { int R, C; stage_rc(tid * 16 + i * 8192, R, C); const int Rb = Epi::PERM ? ((R & ~31) + perm32(R & 31)) : R;
        voffA[i] = (unsigned)(R * K + C) * 2u; voffB[i] = (unsigned)(Rb * K + C) * 2u; }
    const size_t kstep = (size_t)(BK * 2);
    const size_t hstep = (size_t)HALF * K * 2;
    const size_t tstep = 2 * hstep;
    const unsigned ldsw = (unsigned)wid * 1024u;
    const int aoff = lds_byte(wr * 64 + fr, fq * 8), boff = lds_byte(wc * 32 + fr, fq * 8);
#define PG8_SA(b, h) (((b) * 2 + (h)) * HTB)
#define PG8_SB(b, h) ((4 + (b) * 2 + (h)) * HTB)
#define PG8_STAGE(bufoff, gbase, voff) do { _Pragma("unroll") for (int _i = 0; _i < 2; ++_i) \
        __builtin_amdgcn_global_load_lds((const unsigned*)((const char*)(gbase) + (voff)[_i]), (PG8_LAS unsigned*)(lds + (bufoff) + ldsw + _i * 8192), 16, 0, 0); } while (0)
#define PG8_LDA(dst, b, h) do { _Pragma("unroll") for (int m = 0; m < 4; ++m) _Pragma("unroll") for (int k = 0; k < 2; ++k) dst[m][k] = *(const PG8_LAS bf16x8*)(lds + PG8_SA(b, h) + aoff + m * 2048 + k * 1024); } while (0)
#define PG8_LDB(dst, b, h) do { _Pragma("unroll") for (int n = 0; n < 2; ++n) _Pragma("unroll") for (int k = 0; k < 2; ++k) dst[n][k] = *(const PG8_LAS bf16x8*)(lds + PG8_SB(b, h) + boff + n * 2048 + k * 1024); } while (0)
#define PG8_MMA(ai, bj, At, Bt) do { __builtin_amdgcn_s_setprio(1); _Pragma("unroll") for (int m = 0; m < 4; ++m) _Pragma("unroll") for (int n = 0; n < 2; ++n) _Pragma("unroll") for (int k = 0; k < 2; ++k) \
        acc[ai][bj][m][n] = __builtin_amdgcn_mfma_f32_16x16x32_bf16(Bt[n][k], At[m][k], acc[ai][bj][m][n], 0, 0, 0); __builtin_amdgcn_s_setprio(0); } while (0)
#define PG8_WAIT_V(n) asm volatile("s_waitcnt vmcnt(" #n ")" ::: "memory")
#define PG8_WAIT_L(n) asm volatile("s_waitcnt lgkmcnt(" #n ")" ::: "memory")
#define PG8_BAR __builtin_amdgcn_s_barrier()
#define PG8_SCHED __builtin_amdgcn_sched_barrier(0)
    Unit cur, nxt; int ui = 0;
    if (!S.next(0, cur)) return;
    f32x4 acc[2][2][4][2];
#pragma unroll
    for (int a = 0; a < 2; ++a)
#pragma unroll
        for (int b = 0; b < 2; ++b)
#pragma unroll
            for (int m = 0; m < 4; ++m)
#pragma unroll
                for (int n = 0; n < 2; ++n) acc[a][b][m][n] = (f32x4){0.f, 0.f, 0.f, 0.f};
    bf16x8 At[4][2], B0[2][2], B1[2][2];
    const char* cA = (const char*)g.A + (size_t)cur.pm * tstep; const char* cB = (const char*)g.Bt + (size_t)cur.pn * tstep;
    S.a_ready(cur);
    if constexpr (SP2) {
        PG8_STAGE(PG8_SB(0, 0), cB, voffB); PG8_STAGE(PG8_SB(0, 1), cB + hstep, voffB); PG8_STAGE(PG8_SA(0, 0), cA, voffA); PG8_STAGE(PG8_SA(0, 1), cA + hstep, voffA);
        if (wr == 1) PG8_BAR;
        PG8_WAIT_V(2); PG8_BAR;
        PG8_STAGE(PG8_SB(1, 0), cB + kstep, voffB); PG8_STAGE(PG8_SA(1, 0), cA + kstep, voffA); PG8_STAGE(PG8_SB(1, 1), cB + hstep + kstep, voffB);
        PG8_WAIT_V(6); PG8_BAR;
    } else {
        PG8_STAGE(PG8_SB(0, 0), cB, voffB); PG8_STAGE(PG8_SA(0, 0), cA, voffA); PG8_STAGE(PG8_SB(0, 1), cB + hstep, voffB); PG8_STAGE(PG8_SA(0, 1), cA + hstep, voffA);
        if (wr == 1) PG8_BAR;
        PG8_WAIT_V(4); PG8_BAR;
        PG8_STAGE(PG8_SB(1, 0), cB + kstep, voffB); PG8_STAGE(PG8_SA(1, 0), cA + kstep, voffA); PG8_STAGE(PG8_SB(1, 1), cB + hstep + kstep, voffB);
        PG8_WAIT_V(6); PG8_BAR;
    }
    for (;;) {
        const bool has_next = S.next(ui + 1, nxt);
        const char* nA = has_next ? (const char*)g.A + (size_t)nxt.pm * tstep : cA; const char* nB = has_next ? (const char*)g.Bt + (size_t)nxt.pn * tstep : cB;
        for (int t = 0; t < nt; t += 2) {
            const bool last = (t == nt - 2);
            const char* a1 = cA + (size_t)(t + 1) * kstep;
            const char* a2 = last ? nA : cA + (size_t)(t + 2) * kstep; const char* b2 = last ? nB : cB + (size_t)(t + 2) * kstep;
            const char* a3 = a2 + kstep; const char* b3 = b2 + kstep;
            if (last && has_next) S.a_ready(nxt);
            if constexpr (SP2) {
            PG8_LDB(B0, 0, 0); PG8_LDB(B1, 0, 1); PG8_SCHED; PG8_LDA(At, 0, 0); PG8_STAGE(PG8_SA(1, 1), a1 + hstep, voffA);
            PG8_WAIT_V(8); PG8_WAIT_L(0); PG8_BAR; PG8_MMA(0, 0, At, B0); PG8_MMA(0, 1, At, B1); PG8_BAR; PG8_SCHED;
            PG8_LDA(At, 0, 1); PG8_STAGE(PG8_SB(0, 0), b2, voffB); PG8_STAGE(PG8_SB(0, 1), b2 + hstep, voffB); PG8_STAGE(PG8_SA(0, 0), a2, voffA);
            PG8_WAIT_V(8); PG8_WAIT_L(0); PG8_BAR; PG8_MMA(1, 0, At, B0); PG8_MMA(1, 1, At, B1); PG8_BAR; PG8_SCHED;
            PG8_LDB(B0, 1, 0); PG8_LDB(B1, 1, 1); PG8_SCHED; PG8_LDA(At, 1, 0); PG8_STAGE(PG8_SA(0, 1), a2 + hstep, voffA);
            PG8_WAIT_V(8); PG8_WAIT_L(0); PG8_BAR; PG8_MMA(0, 0, At, B0); PG8_MMA(0, 1, At, B1); PG8_BAR; PG8_SCHED;
            PG8_LDA(At, 1, 1); PG8_STAGE(PG8_SB(1, 0), b3, voffB); PG8_STAGE(PG8_SB(1, 1), b3 + hstep, voffB); PG8_STAGE(PG8_SA(1, 0), a3, voffA);
            PG8_WAIT_V(8); PG8_WAIT_L(0); PG8_BAR; PG8_MMA(1, 0, At, B0); PG8_MMA(1, 1, At, B1); PG8_BAR; PG8_SCHED;
            } else {
            PG8_LDB(B0, 0, 0); PG8_SCHED; PG8_LDA(At, 0, 0); PG8_STAGE(PG8_SA(1, 1), a1 + hstep, voffA);
            PG8_WAIT_L(8); PG8_BAR; PG8_WAIT_L(0); PG8_MMA(0, 0, At, B0); PG8_BAR; PG8_SCHED;
            PG8_LDB(B1, 0, 1); PG8_STAGE(PG8_SB(0, 0), b2, voffB);
            PG8_BAR; PG8_WAIT_L(0); PG8_MMA(0, 1, At, B1); PG8_BAR;
            PG8_LDA(At, 0, 1); PG8_STAGE(PG8_SA(0, 0), a2, voffA);
            PG8_BAR; PG8_WAIT_L(0); PG8_MMA(1, 0, At, B0); PG8_BAR; PG8_SCHED;
            PG8_STAGE(PG8_SB(0, 1), b2 + hstep, voffB);
            PG8_WAIT_V(6); PG8_BAR; PG8_MMA(1, 1, At, B1); PG8_BAR;
            PG8_LDB(B0, 1, 0); PG8_SCHED; PG8_LDA(At, 1, 0); PG8_STAGE(PG8_SA(0, 1), a2 + hstep, voffA);
            PG8_WAIT_L(8); PG8_BAR; PG8_WAIT_L(0); PG8_MMA(0, 0, At, B0); PG8_BAR; PG8_SCHED;
            PG8_LDB(B1, 1, 1); PG8_STAGE(PG8_SB(1, 0), b3, voffB);
            PG8_BAR; PG8_WAIT_L(0); PG8_MMA(0, 1, At, B1); PG8_BAR;
            PG8_LDA(At, 1, 1); PG8_STAGE(PG8_SA(1, 0), a3, voffA);
            PG8_BAR; PG8_WAIT_L(0); PG8_MMA(1, 0, At, B0); PG8_BAR; PG8_SCHED;
            PG8_STAGE(PG8_SB(1, 1), b3 + hstep, voffB);
            PG8_WAIT_V(6); PG8_BAR; PG8_MMA(1, 1, At, B1); PG8_BAR;
            }
        }
        if constexpr (ALIGN_EPI) { if (wr == 0) PG8_BAR; }
        if constexpr (!Epi::AFTER_DRAIN) { E(acc, cur, wr, wc, fr, fq); S.done(cur); }
        if (!has_next) break;
#pragma unroll
        for (int a = 0; a < 2; ++a)
#pragma unroll
            for (int b = 0; b < 2; ++b)
#pragma unroll
                for (int m = 0; m < 4; ++m)
#pragma unroll
                    for (int n = 0; n < 2; ++n) acc[a][b][m][n] = (f32x4){0.f, 0.f, 0.f, 0.f};
        cur = nxt; cA = nA; cB = nB; ++ui;
        if constexpr (ALIGN_EPI) { if (wr == 1) PG8_BAR; }
    }
    PG8_WAIT_V(0);
    if constexpr (!ALIGN_EPI) { if (wr == 0) PG8_BAR; }
    PG8_BAR;
    if constexpr (Epi::AFTER_DRAIN) { E.fused(acc, cur, wr, wc, fr, fq, lds, wid, lane); S.done(cur); }
#undef PG8_SA
#undef PG8_SB
#undef PG8_STAGE
#undef PG8_LDA
#undef PG8_LDB
#undef PG8_MMA
#undef PG8_WAIT_V
#undef PG8_WAIT_L
#undef PG8_BAR
#undef PG8_SCHED
}
}


#define LAS __attribute__((address_space(3)))
typedef unsigned short bf16_t;
typedef float f32x4 __attribute__((ext_vector_type(4)));
typedef unsigned u32x4 __attribute__((ext_vector_type(4)));
typedef unsigned u32x2 __attribute__((ext_vector_type(2)));

constexpr int BATCH = 8, SEQ = 4096, DM = 1024, T = BATCH * SEQ, DEPTH = 2;
constexpr int NPROJ = 4352, NMOD = 6 * DM;
constexpr int NEXP = 16384, PQ = 2048;
constexpr float NORM_EPS = 1e-6f;
constexpr float LOG2E = 1.4426950408889634f;
constexpr float QSCALE = 0.125f * LOG2E;
constexpr float SB_EXIT = 160.0f;

constexpr size_t MiB = 1u << 20;
constexpr size_t WS_CTL = 0;
constexpr size_t WS_MOD = 1 * MiB;
constexpr size_t WS_ROPE = 2 * MiB;
constexpr size_t WS_WIN = 10 * MiB;
constexpr size_t WS_WBA = 27 * MiB;
constexpr size_t WS_WBB = 29 * MiB;
constexpr size_t WS_WOUT = 31 * MiB;
constexpr size_t WS_WQ = 35 * MiB;
constexpr size_t WS_SK = 43 * MiB;
constexpr size_t WS_UQ = 44 * MiB;
constexpr size_t WS_VQ = 76 * MiB;
constexpr size_t WS_USC = 108 * MiB;
constexpr size_t WS_VSC = 108 * MiB + 256 * 1024;
constexpr size_t WS_HS = 109 * MiB;
constexpr size_t WS_H = 112 * MiB;
constexpr size_t WS_QA = 176 * MiB;
constexpr size_t WS_QB = 208 * MiB;
constexpr size_t WS_KB = 240 * MiB;
constexpr size_t WS_VB = 272 * MiB;
constexpr size_t WS_KA = 304 * MiB;
constexpr size_t WS_VA = 312 * MiB;
constexpr size_t WS_GA = 320 * MiB;
constexpr size_t WS_GB = 384 * MiB;
constexpr size_t WS_END = 448 * MiB;
constexpr size_t WS_H2Q = WS_QA, WS_IDX = WS_KB, WS_GATE = WS_VB, WS_Q2 = WS_GA, WS_COEF = WS_GA;
constexpr int CTL_QUEUE = 1024;

constexpr int LDS_BYTES = 147456;
constexpr int NTHREADS = 512, NWAVES = 8;

struct KArgs {
    const float* x; const float* c; const int* pos; const float* ada_w; const float* ada_b; const float* norm1_g; const float* w_in; const float* sinks;
    const float* wbr_a; const float* wbr_b; const float* w_out; const float* norm2_g; const float* wq; const float* subkeys; const float* pu; const float* pv; const float* final_g;
    float* out; unsigned char* ws; int ph_lo, ph_hi;
};

__device__ __forceinline__ unsigned f2bf(float f) { unsigned u = __float_as_uint(f); return (u + 0x7fffu + ((u >> 16) & 1u)) >> 16; }
__device__ __forceinline__ unsigned pk2(float lo, float hi) { return f2bf(lo) | (f2bf(hi) << 16); }
__device__ __forceinline__ float bflo(unsigned w) { return __uint_as_float(w << 16); }
__device__ __forceinline__ float bfhi(unsigned w) { return __uint_as_float(w & 0xffff0000u); }
template <int M> __device__ __forceinline__ float swz_xor(float v) { return __int_as_float(__builtin_amdgcn_ds_swizzle(__float_as_int(v), (M << 10) | 0x1f)); }
__device__ __forceinline__ float wave_sum(float v) {
    v += swz_xor<1>(v); v += swz_xor<2>(v); v += swz_xor<4>(v); v += swz_xor<8>(v); v += swz_xor<16>(v);
    auto rr = __builtin_amdgcn_permlane32_swap(__float_as_uint(v), __float_as_uint(v), false, false);
    return __uint_as_float(rr[0]) + __uint_as_float(rr[1]);
}
__device__ __forceinline__ float wave_max(float v) {
    v = fmaxf(v, swz_xor<1>(v)); v = fmaxf(v, swz_xor<2>(v)); v = fmaxf(v, swz_xor<4>(v)); v = fmaxf(v, swz_xor<8>(v)); v = fmaxf(v, swz_xor<16>(v));
    auto rr = __builtin_amdgcn_permlane32_swap(__float_as_uint(v), __float_as_uint(v), false, false);
    return fmaxf(__uint_as_float(rr[0]), __uint_as_float(rr[1]));
}
__device__ __forceinline__ int rdlane_i(int v, int l) { return __builtin_amdgcn_readlane(v, __builtin_amdgcn_readfirstlane(l)); }
__device__ __forceinline__ float rdlane_f(float v, int l) { return __int_as_float(__builtin_amdgcn_readlane(__float_as_int(v), __builtin_amdgcn_readfirstlane(l))); }
__device__ __forceinline__ float dot8(u32x4 a, u32x4 b, float acc) {
    acc = fmaf(bflo(a.x), bflo(b.x), acc); acc = fmaf(bfhi(a.x), bfhi(b.x), acc);
    acc = fmaf(bflo(a.y), bflo(b.y), acc); acc = fmaf(bfhi(a.y), bfhi(b.y), acc);
    acc = fmaf(bflo(a.z), bflo(b.z), acc); acc = fmaf(bfhi(a.z), bfhi(b.z), acc);
    acc = fmaf(bflo(a.w), bflo(b.w), acc); acc = fmaf(bfhi(a.w), bfhi(b.w), acc);
    return acc;
}
__device__ __forceinline__ float softplus2(float z2) {
    return fmaxf(z2, 0.f) + __log2f(1.0f + exp2f(-fabsf(z2)));
}

__device__ __forceinline__ int win_pos(int n) {
    if (n >= 640) return n;
    const int hb = n & ~63, d = n & 63;
    return hb + (d < 32 ? 2 * d : 2 * (d - 32) + 1);
}
template <bool WIN>
__device__ __forceinline__ void transpose_item(const float* W, int K, int N, bf16_t* WT, LAS float* scr, int item, int lane) {
    const int nblk = N / 32, kb = item / nblk, nb = item % nblk, k0 = 64 * kb, n0 = 32 * nb;
#pragma unroll 8
    for (int i = 0; i < 32; ++i) { const int kk = 2 * i + (lane >> 5); scr[kk * 33 + (lane & 31)] = W[(size_t)(k0 + kk) * N + n0 + (lane & 31)]; }
    asm volatile("s_waitcnt lgkmcnt(0)" ::: "memory");
    const int c = lane & 7;
#pragma unroll
    for (int j = 0; j < 4; ++j) { const int n = (lane >> 3) + 8 * j; const LAS float* s = scr + (8 * c) * 33 + n;
        u32x4 o; o.x = pk2(s[0 * 33], s[1 * 33]); o.y = pk2(s[2 * 33], s[3 * 33]); o.z = pk2(s[4 * 33], s[5 * 33]); o.w = pk2(s[6 * 33], s[7 * 33]);
        const int row = WIN ? win_pos(n0 + n) : (n0 + n);
        *(u32x4*)(WT + (size_t)row * K + k0 + 8 * c) = o; }
    asm volatile("s_waitcnt lgkmcnt(0)" ::: "memory");
}
template <bool OFFSET128>
__device__ __forceinline__ void quant_row(const f32x4 (&v)[4], unsigned char* dst_row, float* scale_out, int lane) {
    float am = 0.f;
#pragma unroll
    for (int i = 0; i < 4; ++i) am = fmaxf(am, fmaxf(fmaxf(fabsf(v[i].x), fabsf(v[i].y)), fmaxf(fabsf(v[i].z), fabsf(v[i].w))));
    am = wave_max(am);
    const float inv = am > 0.f ? 127.0f / am : 0.f, sc = am > 0.f ? am / 127.0f : 1.0f;
    u32x4 o;
#pragma unroll
    for (int i = 0; i < 4; ++i) {
        int q0 = (int)rintf(v[i].x * inv), q1 = (int)rintf(v[i].y * inv), q2 = (int)rintf(v[i].z * inv), q3 = (int)rintf(v[i].w * inv);
        if (OFFSET128) { q0 += 128; q1 += 128; q2 += 128; q3 += 128; }
        o[i] = (unsigned)(q0 & 0xff) | ((unsigned)(q1 & 0xff) << 8) | ((unsigned)(q2 & 0xff) << 16) | ((unsigned)(q3 & 0xff) << 24);
    }
    *(u32x4*)(dst_row + 16 * lane) = o;
    if (lane == 0) *scale_out = sc;
}

__device__ __forceinline__ void ph_prologue(const KArgs& a, LAS unsigned char* lds) {
    int tid_op = threadIdx.x; asm volatile("" : "+v"(tid_op)); const int tid = tid_op, lane = tid & 63, wave = tid >> 6, G = gridDim.x;
    const int gw = blockIdx.x * NWAVES + wave, NGW = G * NWAVES;
    unsigned char* ws = a.ws;
    {
        LAS float* sc = (LAS float*)lds;
        for (int it = blockIdx.x; it < DEPTH * 12; it += G) {
            for (int idx = tid; idx < 8192; idx += NTHREADS) { const int b = idx >> 10, i = idx & 1023; const float cv = a.c[b * 1024 + i]; sc[i * 8 + b] = cv / (1.0f + __expf(-cv)); }
            __syncthreads();
            const int l = it / 12, j = (it % 12) * 512 + tid;
            const float* wp = a.ada_w + (size_t)l * 1024 * NMOD + j;
            float acc[8];
#pragma unroll
            for (int b = 0; b < 8; ++b) acc[b] = 0.f;
#pragma unroll 4
            for (int i = 0; i < 1024; ++i) {
                const float w = wp[(size_t)i * NMOD];
                const f32x4 s0 = *(const LAS f32x4*)(sc + i * 8), s1 = *(const LAS f32x4*)(sc + i * 8 + 4);
                acc[0] = fmaf(s0.x, w, acc[0]); acc[1] = fmaf(s0.y, w, acc[1]); acc[2] = fmaf(s0.z, w, acc[2]); acc[3] = fmaf(s0.w, w, acc[3]);
                acc[4] = fmaf(s1.x, w, acc[4]); acc[5] = fmaf(s1.y, w, acc[5]); acc[6] = fmaf(s1.z, w, acc[6]); acc[7] = fmaf(s1.w, w, acc[7]);
            }
            float* mod = (float*)(ws + WS_MOD);
            const float bias = a.ada_b[l * NMOD + j];
#pragma unroll
            for (int b = 0; b < 8; ++b) mod[(size_t)(l * 8 + b) * NMOD + j] = acc[b] + bias;
            __syncthreads();
        }
    }
    {
        LAS float* scr = (LAS float*)(lds + 32768 + wave * 8448);
        constexpr int I_IN = 16 * 136, I_BR = 8 * 32, I_OUT = 16 * 32, I_Q = 16 * 64, I_L = I_IN + 2 * I_BR + I_OUT + I_Q;
        for (int it = gw; it < DEPTH * I_L; it += NGW) {
            const int l = it / I_L; int r = it % I_L;
            if (r < I_IN) { transpose_item<true>(a.w_in + (size_t)l * 1024 * NPROJ, 1024, NPROJ, (bf16_t*)(ws + WS_WIN) + (size_t)l * NPROJ * 1024, scr, r, lane); continue; } r -= I_IN;
            if (r < I_BR) { transpose_item<false>(a.wbr_a + (size_t)l * 512 * 1024, 512, 1024, (bf16_t*)(ws + WS_WBA) + (size_t)l * 1024 * 512, scr, r, lane); continue; } r -= I_BR;
            if (r < I_BR) { transpose_item<false>(a.wbr_b + (size_t)l * 512 * 1024, 512, 1024, (bf16_t*)(ws + WS_WBB) + (size_t)l * 1024 * 512, scr, r, lane); continue; } r -= I_BR;
            if (r < I_OUT) { transpose_item<false>(a.w_out + (size_t)l * 1024 * 1024, 1024, 1024, (bf16_t*)(ws + WS_WOUT) + (size_t)l * 1024 * 1024, scr, r, lane); continue; } r -= I_OUT;
            transpose_item<false>(a.wq + (size_t)l * 1024 * PQ, 1024, PQ, (bf16_t*)(ws + WS_WQ) + (size_t)l * PQ * 1024, scr, r, lane);
        }
    }
    {
        const int gt = blockIdx.x * NTHREADS + tid, NGT = G * NTHREADS;
        for (int i = gt; i < DEPTH * 8 * 2 * 128 * 128 / 8; i += NGT) {
            const f32x4 v0 = *(const f32x4*)(a.subkeys + (size_t)i * 8), v1 = *(const f32x4*)(a.subkeys + (size_t)i * 8 + 4);
            u32x4 o; o.x = pk2(v0.x, v0.y); o.y = pk2(v0.z, v0.w); o.z = pk2(v1.x, v1.y); o.w = pk2(v1.z, v1.w);
            *(u32x4*)((bf16_t*)(ws + WS_SK) + (size_t)i * 8) = o;
        }
        for (int i = gt; i < T * 32; i += NGT) {
            const int t = i >> 5, f = i & 31;
            double inv = 1.0;
            for (int k = 0; k < f; ++k) inv *= 0.7498942093324559;
            const double ang = (double)a.pos[t] * inv;
            const double kq = rint(ang * 0.63661977236758134308);
            const double r = fma(-kq, 6.123233995736766036e-17, fma(-kq, 1.57079632679489655800, ang));
            const int quad = (int)((long long)kq & 3);
            const double r2 = r * r;
            double sp = -1.0 / 1307674368000.0; sp = fma(sp, r2, 1.0 / 6227020800.0); sp = fma(sp, r2, -1.0 / 39916800.0); sp = fma(sp, r2, 1.0 / 362880.0);
            sp = fma(sp, r2, -1.0 / 5040.0); sp = fma(sp, r2, 1.0 / 120.0); sp = fma(sp, r2, -1.0 / 6.0); sp = fma(sp * r2, r, r);
            double cp = 1.0 / 20922789888000.0; cp = fma(cp, r2, -1.0 / 87178291200.0); cp = fma(cp, r2, 1.0 / 479001600.0); cp = fma(cp, r2, -1.0 / 3628800.0);
            cp = fma(cp, r2, 1.0 / 40320.0); cp = fma(cp, r2, -1.0 / 720.0); cp = fma(cp, r2, 1.0 / 24.0); cp = fma(cp, r2, -0.5); cp = fma(cp, r2, 1.0);
            const double sn = (quad == 0) ? sp : (quad == 1) ? cp : (quad == 2) ? -sp : -cp;
            const double cs = (quad == 0) ? cp : (quad == 1) ? -sp : (quad == 2) ? -cp : sp;
            float* rp = (float*)(ws + WS_ROPE) + (size_t)i * 2; rp[0] = (float)cs; rp[1] = (float)sn;
        }
    }
    for (int r = gw; r < DEPTH * 2 * NEXP; r += NGW) {
        const int tbl = r / (DEPTH * NEXP), lr = r % (DEPTH * NEXP);
        const float* src = (tbl == 0 ? a.pu : a.pv) + (size_t)lr * 1024;
        f32x4 v[4];
        if (tbl == 0) {
#pragma unroll
            for (int i = 0; i < 4; ++i) v[i] = ((const f32x4*)src)[64 * i + lane];
            quant_row<false>(v, ws + WS_UQ + (size_t)lr * 1024, (float*)(ws + WS_USC) + lr, lane);
        } else {
#pragma unroll
            for (int i = 0; i < 4; ++i) v[i] = ((const f32x4*)src)[4 * lane + i];
            const int l = lr / NEXP, e = lr % NEXP;
            quant_row<true>(v, ws + WS_VQ + (size_t)l * NEXP * 1024 + ((size_t)(lane >> 3) * NEXP + e) * 128 + 16 * (lane & 7) - 16 * lane, (float*)(ws + WS_VSC) + lr, lane);
        }
    }
    if (blockIdx.x == 0) for (int i = tid; i < DEPTH * 2 * 8 * 64; i += NTHREADS) ((unsigned*)(ws + WS_CTL))[CTL_QUEUE + i] = 0u;
}

template <bool WITH_Q8>
__device__ __forceinline__ void ph_norm(const KArgs& a, const float* xin, const float* g, const float* mod_l, int shift_idx, int scale_idx) {
    int tid_op = threadIdx.x; asm volatile("" : "+v"(tid_op)); const int tid = tid_op, lane = tid & 63, wave = tid >> 6;
    const int gw = blockIdx.x * NWAVES + wave, NGW = gridDim.x * NWAVES;
    bf16_t* H = (bf16_t*)(a.ws + WS_H);
    for (int row = gw; row < T; row += NGW) {
        const int b = row >> 12;
        f32x4 v[4]; float ss = 0.f;
#pragma unroll
        for (int i = 0; i < 4; ++i) { v[i] = ((const f32x4*)(xin + (size_t)row * DM))[64 * i + lane]; ss += (v[i].x * v[i].x + v[i].y * v[i].y) + (v[i].z * v[i].z + v[i].w * v[i].w); }
        ss = wave_sum(ss);
        const float r = 1.0f / sqrtf(ss * (1.0f / DM) + NORM_EPS);
#pragma unroll
        for (int i = 0; i < 4; ++i) {
            const int col = 256 * i + 4 * lane;
            const f32x4 gg = *(const f32x4*)(g + col), sc = *(const f32x4*)(mod_l + (size_t)b * NMOD + scale_idx * DM + col), sh = *(const f32x4*)(mod_l + (size_t)b * NMOD + shift_idx * DM + col);
            v[i] = (v[i] * r) * gg * (sc + 1.0f) + sh;
            u32x2 o; o.x = pk2(v[i].x, v[i].y); o.y = pk2(v[i].z, v[i].w);
            *(u32x2*)(H + (size_t)row * DM + col) = o;
        }
        if (WITH_Q8) quant_row<false>(v, a.ws + WS_H2Q + (size_t)row * 1024, (float*)(a.ws + WS_HS) + row, lane);
    }
}
__device__ __forceinline__ void ph_final_norm(const KArgs& a) {
    int tid_op = threadIdx.x; asm volatile("" : "+v"(tid_op)); const int tid = tid_op, lane = tid & 63, wave = tid >> 6;
    const int gw = blockIdx.x * NWAVES + wave, NGW = gridDim.x * NWAVES;
    for (int row = gw; row < T; row += NGW) {
        f32x4 v[4]; float ss = 0.f;
#pragma unroll
        for (int i = 0; i < 4; ++i) { v[i] = ((const f32x4*)(a.out + (size_t)row * DM))[64 * i + lane]; ss += (v[i].x * v[i].x + v[i].y * v[i].y) + (v[i].z * v[i].z + v[i].w * v[i].w); }
        ss = wave_sum(ss);
        const float r = 1.0f / sqrtf(ss * (1.0f / DM) + NORM_EPS);
#pragma unroll
        for (int i = 0; i < 4; ++i) { const f32x4 gg = *(const f32x4*)(a.final_g + 256 * i + 4 * lane); ((f32x4*)(a.out + (size_t)row * DM))[64 * i + lane] = (v[i] * r) * gg; }
    }
}

struct EpiProj {
    static constexpr bool PERM = true, AFTER_DRAIN = false;
    unsigned char* ws;
    __device__ __forceinline__ void operator()(const pg8::f32x4 (&acc)[2][2][4][2], const pg8::Unit& u, int wr, int wc, int fr, int fq) const {
        const int row0 = u.pm * 256 + wr * 64 + fr;
        const float* rope = (const float*)(ws + WS_ROPE);
#pragma unroll
        for (int bj = 0; bj < 2; ++bj) {
            const int cgb = u.pn * 256 + bj * 128;
            bf16_t* base; int pitch, cl, mode;
            if (cgb < 512) { base = (bf16_t*)(ws + WS_QA); pitch = 512; cl = cgb; mode = 1; }
            else if (cgb < 640) { base = (bf16_t*)(ws + WS_KA); pitch = 128; cl = cgb - 512; mode = 2; }
            else if (cgb < 768) { base = (bf16_t*)(ws + WS_VA); pitch = 128; cl = cgb - 640; mode = 0; }
            else if (cgb < 1280) { base = (bf16_t*)(ws + WS_QB); pitch = 512; cl = cgb - 768; mode = 3; }
            else if (cgb < 1792) { base = (bf16_t*)(ws + WS_KB); pitch = 512; cl = cgb - 1280; mode = 0; }
            else if (cgb < 2304) { base = (bf16_t*)(ws + WS_VB); pitch = 512; cl = cgb - 1792; mode = 0; }
            else if (cgb < 3328) { base = (bf16_t*)(ws + WS_GA); pitch = 1024; cl = cgb - 2304; mode = 4; }
            else { base = (bf16_t*)(ws + WS_GB); pitch = 1024; cl = cgb - 3328; mode = 4; }
            const int col = cl + wc * 32 + 8 * fq;
#pragma unroll
            for (int ai = 0; ai < 2; ++ai)
#pragma unroll
                for (int m = 0; m < 4; ++m) {
                    const int row = row0 + ai * 128 + m * 16;
                    pg8::f32x4 v0 = acc[ai][bj][m][0], v1 = acc[ai][bj][m][1];
                    if (mode == 1 || mode == 2) {
                        const int i0 = (col & 63) >> 1;
                        const f32x4 c01 = *(const f32x4*)(rope + ((size_t)row * 32 + i0) * 2), c23 = *(const f32x4*)(rope + ((size_t)row * 32 + i0 + 2) * 2);
                        pg8::f32x4 w0, w1;
                        w0[0] = v0[0] * c01.x - v0[1] * c01.y; w0[1] = v0[1] * c01.x + v0[0] * c01.y;
                        w0[2] = v0[2] * c01.z - v0[3] * c01.w; w0[3] = v0[3] * c01.z + v0[2] * c01.w;
                        w1[0] = v1[0] * c23.x - v1[1] * c23.y; w1[1] = v1[1] * c23.x + v1[0] * c23.y;
                        w1[2] = v1[2] * c23.z - v1[3] * c23.w; w1[3] = v1[3] * c23.z + v1[2] * c23.w;
                        v0 = w0; v1 = w1;
                    }
                    if (mode == 1 || mode == 3) { v0 = v0 * QSCALE; v1 = v1 * QSCALE; }
                    if (mode == 4) {
#pragma unroll
                        for (int e = 0; e < 4; ++e) { v0[e] = 1.0f / (1.0f + __expf(-v0[e])); v1[e] = 1.0f / (1.0f + __expf(-v1[e])); }
                    }
                    u32x4 w; w.x = pk2(v0[0], v0[1]); w.y = pk2(v0[2], v0[3]); w.z = pk2(v1[0], v1[1]); w.w = pk2(v1[2], v1[3]);
                    *(u32x4*)(base + (size_t)row * pitch + col) = w;
                }
        }
    }
};
template <bool ADD> struct EpiBranch {
    static constexpr bool PERM = true, AFTER_DRAIN = false;
    const bf16_t* Gt; bf16_t* O;
    __device__ __forceinline__ void operator()(const pg8::f32x4 (&acc)[2][2][4][2], const pg8::Unit& u, int wr, int wc, int fr, int fq) const {
        const int row0 = u.pm * 256 + wr * 64 + fr, col0 = u.pn * 256 + wc * 32 + 8 * fq;
#pragma unroll
        for (int ai = 0; ai < 2; ++ai)
#pragma unroll
            for (int m = 0; m < 4; ++m)
#pragma unroll
                for (int bj = 0; bj < 2; ++bj) {
                    const size_t off = (size_t)(row0 + ai * 128 + m * 16) * DM + col0 + bj * 128;
                    const u32x4 gv = *(const u32x4*)(Gt + off);
                    const pg8::f32x4 v0 = acc[ai][bj][m][0], v1 = acc[ai][bj][m][1];
                    float r[8];
                    r[0] = bflo(gv.x) * v0[0]; r[1] = bfhi(gv.x) * v0[1]; r[2] = bflo(gv.y) * v0[2]; r[3] = bfhi(gv.y) * v0[3];
                    r[4] = bflo(gv.z) * v1[0]; r[5] = bfhi(gv.z) * v1[1]; r[6] = bflo(gv.w) * v1[2]; r[7] = bfhi(gv.w) * v1[3];
                    if (ADD) { const u32x4 ov = *(const u32x4*)(O + off);
                        r[0] += bflo(ov.x); r[1] += bfhi(ov.x); r[2] += bflo(ov.y); r[3] += bfhi(ov.y); r[4] += bflo(ov.z); r[5] += bfhi(ov.z); r[6] += bflo(ov.w); r[7] += bfhi(ov.w); }
                    u32x4 w; w.x = pk2(r[0], r[1]); w.y = pk2(r[2], r[3]); w.z = pk2(r[4], r[5]); w.w = pk2(r[6], r[7]);
                    *(u32x4*)(O + off) = w;
                }
    }
};
struct EpiWout {
    static constexpr bool PERM = false, AFTER_DRAIN = false;
    const float* xold; float* xnew; const float* gate;
    __device__ __forceinline__ void operator()(const pg8::f32x4 (&acc)[2][2][4][2], const pg8::Unit& u, int wr, int wc, int fr, int fq) const {
        const int row0 = u.pm * 256 + wr * 64 + fr, col0 = u.pn * 256 + wc * 32 + 4 * fq, b = u.pm >> 4;
#pragma unroll
        for (int bj = 0; bj < 2; ++bj)
#pragma unroll
            for (int n = 0; n < 2; ++n) {
                const pg8::f32x4 gv = *(const pg8::f32x4*)(gate + (size_t)b * NMOD + col0 + bj * 128 + n * 16);
#pragma unroll
                for (int ai = 0; ai < 2; ++ai)
#pragma unroll
                    for (int m = 0; m < 4; ++m) { const size_t off = (size_t)(row0 + ai * 128 + m * 16) * DM + col0 + bj * 128 + n * 16;
                        const pg8::f32x4 xo = *(const pg8::f32x4*)(xold + off);
                        *(pg8::f32x4*)(xnew + off) = xo + gv * acc[ai][bj][m][n]; }
            }
    }
};
struct EpiPlainBf16 {
    static constexpr bool PERM = true, AFTER_DRAIN = false;
    bf16_t* O; int ldc;
    __device__ __forceinline__ void operator()(const pg8::f32x4 (&acc)[2][2][4][2], const pg8::Unit& u, int wr, int wc, int fr, int fq) const {
        const int row0 = u.pm * 256 + wr * 64 + fr, col0 = u.pn * 256 + wc * 32 + 8 * fq;
#pragma unroll
        for (int ai = 0; ai < 2; ++ai)
#pragma unroll
            for (int m = 0; m < 4; ++m)
#pragma unroll
                for (int bj = 0; bj < 2; ++bj) {
                    const pg8::f32x4 v0 = acc[ai][bj][m][0], v1 = acc[ai][bj][m][1];
                    u32x4 w; w.x = pk2(v0[0], v0[1]); w.y = pk2(v0[2], v0[3]); w.z = pk2(v1[0], v1[1]); w.w = pk2(v1[2], v1[3]);
                    *(u32x4*)(O + (size_t)(row0 + ai * 128 + m * 16) * ldc + col0 + bj * 128) = w;
                }
    }
};

namespace att {
typedef short bf16x8 __attribute__((ext_vector_type(8)));
typedef short s16x4 __attribute__((ext_vector_type(4)));
typedef float f32x16 __attribute__((ext_vector_type(16)));
__device__ __forceinline__ int crow(int r, int hi) { return (r & 3) + 8 * (r >> 2) + 4 * hi; }
typedef float f32x2_t __attribute__((ext_vector_type(2))); typedef __bf16 bf16x2_t __attribute__((ext_vector_type(2)));
__device__ __forceinline__ unsigned cvtpk(float lo, float hi) { f32x2_t v = {lo, hi}; bf16x2_t b = __builtin_convertvector(v, bf16x2_t); return __builtin_bit_cast(unsigned, b); }
#define ATT_SBAR() __builtin_amdgcn_sched_barrier(0)

__device__ __forceinline__ void qkt(f32x16& p0, f32x16& p1, const LAS unsigned char* kslot, const bf16x8 (&qr)[4], int r32, int hi) {
    const LAS unsigned char* kb = kslot + hi * 1024 + r32 * 16;
    p0 = f32x16{}; p1 = f32x16{};
#pragma unroll
    for (int d0 = 0; d0 < 4; ++d0) {
        const bf16x8 b0 = *(const LAS bf16x8*)(kb + d0 * 2048);
        const bf16x8 b1 = *(const LAS bf16x8*)(kb + d0 * 2048 + 512);
        p0 = __builtin_amdgcn_mfma_f32_32x32x16_bf16(b0, qr[d0], p0, 0, 0, 0);
        p1 = __builtin_amdgcn_mfma_f32_32x32x16_bf16(b1, qr[d0], p1, 0, 0, 0);
    }
}
__device__ __forceinline__ void pv(f32x16 (&o)[2], int vb, bf16x8 pa0, bf16x8 pa1, bf16x8 pa2, bf16x8 pa3) {
#pragma unroll
    for (int d0 = 0; d0 < 2; ++d0) {
        s16x4 lo[4], hh[4];
#pragma unroll
        for (int ks = 0; ks < 4; ++ks) {
            asm volatile("ds_read_b64_tr_b16 %0,%1 offset:%c2" : "=&v"(lo[ks]) : "v"(vb), "i"(d0 * 4096 + ks * 1024) : "memory");
            asm volatile("ds_read_b64_tr_b16 %0,%1 offset:%c2" : "=&v"(hh[ks]) : "v"(vb), "i"(d0 * 4096 + ks * 1024 + 512) : "memory");
        }
        asm volatile("s_waitcnt lgkmcnt(0)" ::: "memory"); ATT_SBAR();
#define ATT_PK(k) (bf16x8){lo[k][0], lo[k][1], lo[k][2], lo[k][3], hh[k][0], hh[k][1], hh[k][2], hh[k][3]}
        o[d0] = __builtin_amdgcn_mfma_f32_32x32x16_bf16(pa0, ATT_PK(0), o[d0], 0, 0, 0);
        o[d0] = __builtin_amdgcn_mfma_f32_32x32x16_bf16(pa1, ATT_PK(1), o[d0], 0, 0, 0);
        o[d0] = __builtin_amdgcn_mfma_f32_32x32x16_bf16(pa2, ATT_PK(2), o[d0], 0, 0, 0);
        o[d0] = __builtin_amdgcn_mfma_f32_32x32x16_bf16(pa3, ATT_PK(3), o[d0], 0, 0, 0);
#undef ATT_PK
    }
}
__device__ __forceinline__ void pack_p(const f32x16& p0, const f32x16& p1, bf16x8& pa0, bf16x8& pa1, bf16x8& pa2, bf16x8& pa3) {
    u32x4 w0, w1, w2, w3;
    w0 = (u32x4){cvtpk(p0[0], p0[1]), cvtpk(p0[2], p0[3]), cvtpk(p0[4], p0[5]), cvtpk(p0[6], p0[7])};
    w1 = (u32x4){cvtpk(p0[8], p0[9]), cvtpk(p0[10], p0[11]), cvtpk(p0[12], p0[13]), cvtpk(p0[14], p0[15])};
    w2 = (u32x4){cvtpk(p1[0], p1[1]), cvtpk(p1[2], p1[3]), cvtpk(p1[4], p1[5]), cvtpk(p1[6], p1[7])};
    w3 = (u32x4){cvtpk(p1[8], p1[9]), cvtpk(p1[10], p1[11]), cvtpk(p1[12], p1[13]), cvtpk(p1[14], p1[15])};
    pa0 = __builtin_bit_cast(bf16x8, w0); pa1 = __builtin_bit_cast(bf16x8, w1); pa2 = __builtin_bit_cast(bf16x8, w2); pa3 = __builtin_bit_cast(bf16x8, w3);
}
__device__ __forceinline__ u32x4 tile_gload(const bf16_t* src, int pitch, int tid) { return *(const u32x4*)(src + (size_t)(tid >> 3) * pitch + (tid & 7) * 8); }
__device__ __forceinline__ void tile_kwrite(LAS unsigned char* kslot, u32x4 v, int tid) { *(LAS u32x4*)(kslot + (tid & 7) * 1024 + (tid >> 3) * 16) = v; }
__device__ __forceinline__ void tile_vwrite(LAS unsigned char* vslot, u32x4 v, int tid) { const int c = tid & 7; *(LAS u32x4*)(vslot + (c >> 2) * 4096 + (tid >> 3) * 64 + (c & 3) * 16) = v; }
__device__ __forceinline__ void store_o(const f32x16 (&o)[2], const float (&rs)[16], LAS unsigned char* stage, bf16_t* Ow, int pitch, int lane) {
    const int r32 = lane & 31, hi = lane >> 5;
    LAS bf16_t* stg = (LAS bf16_t*)stage;
#pragma unroll
    for (int r = 0; r < 16; ++r) { const int orow = crow(r, hi);
#pragma unroll
        for (int d0 = 0; d0 < 2; ++d0) stg[orow * 64 + d0 * 32 + r32] = (bf16_t)f2bf(o[d0][r] * rs[r]); }
    asm volatile("s_waitcnt lgkmcnt(0)" ::: "memory");
#pragma unroll
    for (int i = 0; i < 4; ++i) { const int row = i * 8 + (lane >> 3), ch = lane & 7; const u32x4 v = *(const LAS u32x4*)(stg + row * 64 + ch * 8); *(u32x4*)(Ow + (size_t)row * pitch + ch * 8) = v; }
    asm volatile("s_waitcnt lgkmcnt(0)" ::: "memory");
}

constexpr int SB_K0 = 0, SB_V0 = 16384, SB_STAGE = 32768, SB_FLAGS = 65536, SB_LDS_END = 65536 + 64;
template <bool EARLY_EXIT>
__device__ __forceinline__ void sb_phase(const bf16_t* Q, const bf16_t* K, const bf16_t* V, bf16_t* O, LAS unsigned char* lds) {
    int tid_op = threadIdx.x; asm volatile("" : "+v"(tid_op));
    const int tid = tid_op, lane = tid & 63, r32 = lane & 31, hi = lane >> 5, wid = __builtin_amdgcn_readfirstlane(tid >> 6);
    const int vb0 = (int)(unsigned)(uintptr_t)(lds + SB_V0) + ((lane >> 4) & 1) * 32 + (lane & 3) * 8 + (4 * hi + ((lane & 15) >> 2)) * 64;
    volatile LAS unsigned* flags = (volatile LAS unsigned*)(lds + SB_FLAGS);
    const float m0 = hi == 0 ? 1.0f : 0.0f;
    for (int unit = blockIdx.x; unit < BATCH * 8 * 16; unit += gridDim.x) {
        const int qb = unit & 15, h = (unit >> 4) & 7, b = unit >> 7;
        const int q0 = qb * 256;
        const size_t rowbase = (size_t)b * SEQ;
        const bf16_t* Kh = K + rowbase * 512 + h * 64; const bf16_t* Vh = V + rowbase * 512 + h * 64;
        const bf16_t* Qw = Q + (rowbase + q0 + wid * 32) * 512 + h * 64;
        int kt = 4 * qb + 3;
        u32x4 kreg = tile_gload(Kh + (size_t)kt * 64 * 512, 512, tid), vreg = tile_gload(Vh + (size_t)kt * 64 * 512, 512, tid);
        bf16x8 qr[4];
#pragma unroll
        for (int d0 = 0; d0 < 4; ++d0) qr[d0] = *(const bf16x8*)(Qw + (size_t)r32 * 512 + d0 * 16 + hi * 8);
        if (tid < 16) flags[tid] = 0u;
        tile_kwrite(lds + SB_K0, kreg, tid); tile_vwrite(lds + SB_V0, vreg, tid);
        f32x16 o[2]; o[0] = f32x16{}; o[1] = f32x16{};
        float carry = 0.f;
        int cur = 0, it = 0;
        for (;;) {
            __syncthreads();
            if (EARLY_EXIT && it > 0) {
                const int fs = ((it - 1) & 1) * 8;
                unsigned all = 1u;
#pragma unroll
                for (int w = 0; w < 8; ++w) all &= flags[fs + w];
                if (all) break;
            }
            const bool more = kt > 0;
            if (more) { kreg = tile_gload(Kh + (size_t)(kt - 1) * 64 * 512, 512, tid); vreg = tile_gload(Vh + (size_t)(kt - 1) * 64 * 512, 512, tid); }
            const int D = q0 + 32 * wid - 64 * kt;
            if (D + 31 > 0) {
                f32x16 p0, p1;
                qkt(p0, p1, lds + SB_K0 + cur * 8192, qr, r32, hi);
                if (D < 64) {
                    const int qrel = D + r32;
#pragma unroll
                    for (int r = 0; r < 16; ++r) { const int kv = crow(r, hi); if (kv >= qrel) p0[r] = -INFINITY; if (kv + 32 >= qrel) p1[r] = -INFINITY; }
                }
                f32x16 l0, l1;
#pragma unroll
                for (int r = 0; r < 16; ++r) { l0[r] = fmaxf(p0[r], 0.f) + __log2f(1.0f + exp2f(-fabsf(p0[r]))); l1[r] = fmaxf(p1[r], 0.f) + __log2f(1.0f + exp2f(-fabsf(p1[r]))); }
                float tt[8], uu[8];
#pragma unroll
                for (int i = 0; i < 4; ++i) { tt[i] = (l0[4 * i] + l0[4 * i + 1]) + (l0[4 * i + 2] + l0[4 * i + 3]); tt[4 + i] = (l1[4 * i] + l1[4 * i + 1]) + (l1[4 * i + 2] + l1[4 * i + 3]); }
#pragma unroll
                for (int k = 0; k < 8; ++k) { auto rr = __builtin_amdgcn_permlane32_swap(__float_as_uint(tt[k]), __float_as_uint(tt[k]), false, false); uu[k] = __uint_as_float(hi ? rr[0] : rr[1]); }
                float sw = 0.f, base[8];
#pragma unroll
                for (int k = 7; k >= 0; --k) { base[k] = carry - (sw + m0 * uu[k]); sw += tt[k] + uu[k]; }
#pragma unroll
                for (int i = 0; i < 4; ++i) {
                    float s3 = l0[4 * i + 3], s2 = s3 + l0[4 * i + 2], s1 = s2 + l0[4 * i + 1], s0 = s1 + l0[4 * i];
                    p0[4 * i + 3] = exp2f(p0[4 * i + 3] + (base[i] - s3)); p0[4 * i + 2] = exp2f(p0[4 * i + 2] + (base[i] - s2));
                    p0[4 * i + 1] = exp2f(p0[4 * i + 1] + (base[i] - s1)); p0[4 * i] = exp2f(p0[4 * i] + (base[i] - s0));
                    s3 = l1[4 * i + 3]; s2 = s3 + l1[4 * i + 2]; s1 = s2 + l1[4 * i + 1]; s0 = s1 + l1[4 * i];
                    p1[4 * i + 3] = exp2f(p1[4 * i + 3] + (base[4 + i] - s3)); p1[4 * i + 2] = exp2f(p1[4 * i + 2] + (base[4 + i] - s2));
                    p1[4 * i + 1] = exp2f(p1[4 * i + 1] + (base[4 + i] - s1)); p1[4 * i] = exp2f(p1[4 * i] + (base[4 + i] - s0));
                }
                carry -= sw;
                bf16x8 pa0, pa1, pa2, pa3; pack_p(p0, p1, pa0, pa1, pa2, pa3);
                pv(o, vb0 + cur * 8192, pa0, pa1, pa2, pa3);
            }
            if (EARLY_EXIT) { const bool done = __all(carry < -SB_EXIT); if (lane == 0) flags[(it & 1) * 8 + wid] = done ? 1u : 0u; }
            if (!more) break;
            tile_kwrite(lds + SB_K0 + (cur ^ 1) * 8192, kreg, tid); tile_vwrite(lds + SB_V0 + (cur ^ 1) * 8192, vreg, tid);
            cur ^= 1; --kt; ++it;
        }
        float ones[16];
#pragma unroll
        for (int r = 0; r < 16; ++r) ones[r] = 1.0f;
        store_o(o, ones, lds + SB_STAGE + wid * 4096, O + (rowbase + q0 + wid * 32) * 512 + h * 64, 512, lane);
        __syncthreads();
    }
}

constexpr int SW_K0 = 0, SW_V0 = 24576, SW_STAGE = 49152, SW_WSF = 81920, SW_LDS_END = 81920 + 2048;
__device__ __forceinline__ void swa_phase(const bf16_t* Q, const bf16_t* K, const bf16_t* V, bf16_t* O, const float* sinks, LAS unsigned char* lds) {
    int tid_op = threadIdx.x; asm volatile("" : "+v"(tid_op));
    const int tid = tid_op, lane = tid & 63, r32 = lane & 31, hi = lane >> 5, wid = __builtin_amdgcn_readfirstlane(tid >> 6);
    const int vb0 = (int)(unsigned)(uintptr_t)(lds + SW_V0) + ((lane >> 4) & 1) * 32 + (lane & 3) * 8 + (4 * hi + ((lane & 15) >> 2)) * 64;
    LAS float* wsf = (LAS float*)(lds + SW_WSF) + wid * 64;
    const int g = wid >> 1, j = wid & 1;
    for (int unit = blockIdx.x; unit < BATCH * 2 * 64; unit += gridDim.x) {
        const int qb = unit & 63, kvh = (unit >> 6) & 1, b = unit >> 7;
        const int q0 = qb * 64, hq = kvh * 4 + g;
        const size_t rowbase = (size_t)b * SEQ;
        const bf16_t* Kh = K + rowbase * 128 + kvh * 64; const bf16_t* Vh = V + rowbase * 128 + kvh * 64;
        const bf16_t* Qw = Q + (rowbase + q0 + j * 32) * 512 + hq * 64;
        __syncthreads();
#pragma unroll
        for (int i = 0; i < 3; ++i) { const int kt = qb - 2 + i;
            if (kt >= 0) { const u32x4 kv = tile_gload(Kh + (size_t)kt * 64 * 128, 128, tid), vv = tile_gload(Vh + (size_t)kt * 64 * 128, 128, tid);
                tile_kwrite(lds + SW_K0 + i * 8192, kv, tid); tile_vwrite(lds + SW_V0 + i * 8192, vv, tid); } }
        bf16x8 qr[4];
#pragma unroll
        for (int d0 = 0; d0 < 4; ++d0) qr[d0] = *(const bf16x8*)(Qw + (size_t)r32 * 512 + d0 * 16 + hi * 8);
        __syncthreads();
        const int qrel = 32 * j + r32;
        const float sink2 = sinks[hq] * LOG2E;
        float m = sink2;
#pragma unroll
        for (int i = 0; i < 3; ++i) {
            if (qb - 2 + i >= 0) {
                f32x16 p0, p1;
                qkt(p0, p1, lds + SW_K0 + i * 8192, qr, r32, hi);
#pragma unroll
                for (int r = 0; r < 16; ++r) { const int kv = crow(r, hi);
                    bool v0 = true, v1 = true;
                    if (i == 2) { v0 = kv <= qrel; v1 = kv + 32 <= qrel; }
                    if (i == 0) { v0 = kv > qrel; v1 = kv + 32 > qrel; }
                    m = fmaxf(m, fmaxf(v0 ? p0[r] : -INFINITY, v1 ? p1[r] : -INFINITY)); }
            }
        }
        { auto rr = __builtin_amdgcn_permlane32_swap(__float_as_uint(m), __float_as_uint(m), false, false); m = fmaxf(__uint_as_float(rr[0]), __uint_as_float(rr[1])); }
        float lsum = 0.f;
        f32x16 o[2]; o[0] = f32x16{}; o[1] = f32x16{};
#pragma unroll
        for (int i = 0; i < 3; ++i) {
            if (qb - 2 + i >= 0) {
                f32x16 p0, p1;
                qkt(p0, p1, lds + SW_K0 + i * 8192, qr, r32, hi);
#pragma unroll
                for (int r = 0; r < 16; ++r) { const int kv = crow(r, hi);
                    bool v0 = true, v1 = true;
                    if (i == 2) { v0 = kv <= qrel; v1 = kv + 32 <= qrel; }
                    if (i == 0) { v0 = kv > qrel; v1 = kv + 32 > qrel; }
                    p0[r] = v0 ? exp2f(p0[r] - m) : 0.f; p1[r] = v1 ? exp2f(p1[r] - m) : 0.f; lsum += p0[r] + p1[r]; }
                bf16x8 pa0, pa1, pa2, pa3; pack_p(p0, p1, pa0, pa1, pa2, pa3); pv(o, vb0 + i * 8192, pa0, pa1, pa2, pa3);
            }
        }
        { auto rr = __builtin_amdgcn_permlane32_swap(__float_as_uint(lsum), __float_as_uint(lsum), false, false); lsum = __uint_as_float(rr[0]) + __uint_as_float(rr[1]); }
        lsum += exp2f(sink2 - m);
        if (hi == 0) wsf[r32] = 1.0f / lsum;
        asm volatile("s_waitcnt lgkmcnt(0)" ::: "memory");
        float rs[16];
#pragma unroll
        for (int r = 0; r < 16; ++r) rs[r] = wsf[crow(r, hi)];
        asm volatile("s_waitcnt lgkmcnt(0)" ::: "memory");
        store_o(o, rs, lds + SW_STAGE + wid * 4096, O + (rowbase + q0 + j * 32) * 512 + hq * 64, 512, lane);
    }
}
#undef ATT_SBAR
}

namespace tk {
typedef short bf16x8 __attribute__((ext_vector_type(8)));
typedef float f32x16 __attribute__((ext_vector_type(16)));
__device__ __forceinline__ float vmax(float a, float b) { float r; asm("v_max_f32 %0, %1, %2" : "=v"(r) : "v"(a), "v"(b)); return r; }
__device__ __forceinline__ float vmin(float a, float b) { float r; asm("v_min_f32 %0, %1, %2" : "=v"(r) : "v"(a), "v"(b)); return r; }
#define TK_CE(a, b) { const float t_ = vmax(a, b); b = vmin(a, b); a = t_; }
__device__ __forceinline__ void sort16(float (&v)[16]) {
    TK_CE(v[0], v[1]) TK_CE(v[2], v[3]) TK_CE(v[0], v[2]) TK_CE(v[1], v[3]) TK_CE(v[1], v[2]) TK_CE(v[4], v[5]) TK_CE(v[6], v[7]) TK_CE(v[4], v[6])
    TK_CE(v[5], v[7]) TK_CE(v[5], v[6]) TK_CE(v[0], v[4]) TK_CE(v[2], v[6]) TK_CE(v[2], v[4]) TK_CE(v[1], v[5]) TK_CE(v[3], v[7]) TK_CE(v[3], v[5])
    TK_CE(v[1], v[2]) TK_CE(v[3], v[4]) TK_CE(v[5], v[6]) TK_CE(v[8], v[9]) TK_CE(v[10], v[11]) TK_CE(v[8], v[10]) TK_CE(v[9], v[11]) TK_CE(v[9], v[10])
    TK_CE(v[12], v[13]) TK_CE(v[14], v[15]) TK_CE(v[12], v[14]) TK_CE(v[13], v[15]) TK_CE(v[13], v[14]) TK_CE(v[8], v[12]) TK_CE(v[10], v[14]) TK_CE(v[10], v[12])
    TK_CE(v[9], v[13]) TK_CE(v[11], v[15]) TK_CE(v[11], v[13]) TK_CE(v[9], v[10]) TK_CE(v[11], v[12]) TK_CE(v[13], v[14]) TK_CE(v[0], v[8]) TK_CE(v[4], v[12])
    TK_CE(v[4], v[8]) TK_CE(v[2], v[10]) TK_CE(v[6], v[14]) TK_CE(v[6], v[10]) TK_CE(v[2], v[4]) TK_CE(v[6], v[8]) TK_CE(v[10], v[12]) TK_CE(v[1], v[9])
    TK_CE(v[5], v[13]) TK_CE(v[5], v[9]) TK_CE(v[3], v[11]) TK_CE(v[7], v[15]) TK_CE(v[7], v[11]) TK_CE(v[3], v[5]) TK_CE(v[7], v[9]) TK_CE(v[11], v[13])
    TK_CE(v[1], v[2]) TK_CE(v[3], v[4]) TK_CE(v[5], v[6]) TK_CE(v[7], v[8]) TK_CE(v[9], v[10]) TK_CE(v[11], v[12]) TK_CE(v[13], v[14])
}
__device__ __forceinline__ void bmerge16(float (&v)[16]) {
    TK_CE(v[0], v[8]) TK_CE(v[1], v[9]) TK_CE(v[2], v[10]) TK_CE(v[3], v[11]) TK_CE(v[4], v[12]) TK_CE(v[5], v[13]) TK_CE(v[6], v[14]) TK_CE(v[7], v[15])
    TK_CE(v[0], v[4]) TK_CE(v[1], v[5]) TK_CE(v[2], v[6]) TK_CE(v[3], v[7]) TK_CE(v[8], v[12]) TK_CE(v[9], v[13]) TK_CE(v[10], v[14]) TK_CE(v[11], v[15])
    TK_CE(v[0], v[2]) TK_CE(v[1], v[3]) TK_CE(v[4], v[6]) TK_CE(v[5], v[7]) TK_CE(v[8], v[10]) TK_CE(v[9], v[11]) TK_CE(v[12], v[14]) TK_CE(v[13], v[15])
    TK_CE(v[0], v[1]) TK_CE(v[2], v[3]) TK_CE(v[4], v[5]) TK_CE(v[6], v[7]) TK_CE(v[8], v[9]) TK_CE(v[10], v[11]) TK_CE(v[12], v[13]) TK_CE(v[14], v[15])
}

__device__ __forceinline__ void merge_top16(float (&a)[16], const float (&b)[16]) {
#pragma unroll
    for (int i = 0; i < 16; ++i) a[i] = vmax(a[i], b[15 - i]);
    bmerge16(a);
}
__device__ __forceinline__ float partner_f(float v, int hi) { auto rr = __builtin_amdgcn_permlane32_swap(__float_as_uint(v), __float_as_uint(v), false, false); return __uint_as_float(hi ? rr[0] : rr[1]); }
__device__ __forceinline__ void merge_partner(float (&a)[16], int hi) {
    float pp[16];
#pragma unroll
    for (int i = 0; i < 16; ++i) pp[i] = partner_f(a[i], hi);
    merge_top16(a, pp);
}
__device__ __forceinline__ void take_block(float (&v)[16], const f32x16& acc, int blk, unsigned hi4) {
#pragma unroll
    for (int r = 0; r < 16; ++r) { const unsigned code = 127u - (unsigned)(32 * blk + (r & 3) + 8 * (r >> 2)); v[r] = __uint_as_float(((__float_as_uint(acc[r]) & 0xFFFFFF80u) | code) ^ hi4); }
    sort16(v);
}
constexpr int TK_SK = 0, TK_IDX = 65536, TK_LDS_END = 65536 + 8192;
constexpr float TK_NEG = -3.4028234663852886e38f;
template <int P>
__device__ __forceinline__ void half_top16(float (&L)[16], const bf16_t* qrow, LAS unsigned char* lds, LAS unsigned char* idxslot, int r32, int hi) {
    bf16x8 qf[8];
#pragma unroll
    for (int ks = 0; ks < 8; ++ks) qf[ks] = *(const bf16x8*)(qrow + P * 128 + 16 * ks + 8 * hi);
    f32x16 acc[4];
#pragma unroll
    for (int blk = 0; blk < 4; ++blk) acc[blk] = f32x16{};
    const LAS unsigned char* ab = lds + TK_SK + P * 32768 + hi * 2048 + r32 * 16;
#pragma unroll
    for (int ks = 0; ks < 8; ++ks)
#pragma unroll
        for (int blk = 0; blk < 4; ++blk) {
            const bf16x8 af = *(const LAS bf16x8*)(ab + ks * 4096 + blk * 512);
            acc[blk] = __builtin_amdgcn_mfma_f32_32x32x16_bf16(af, qf[ks], acc[blk], 0, 0, 0);
        }
    const unsigned hi4 = (unsigned)hi << 2;
    float M[16];
    take_block(L, acc[0], 0, hi4); take_block(M, acc[1], 1, hi4); merge_top16(L, M);
    { float N[16]; take_block(M, acc[2], 2, hi4); take_block(N, acc[3], 3, hi4); merge_top16(M, N); }
    merge_top16(L, M);
    merge_partner(L, hi);
    if (hi == 0) {
        u32x4 w;
#pragma unroll
        for (int q = 0; q < 4; ++q) w[q] = (__float_as_uint(L[4 * q]) & 127u) | ((__float_as_uint(L[4 * q + 1]) & 127u) << 8) | ((__float_as_uint(L[4 * q + 2]) & 127u) << 16) | ((__float_as_uint(L[4 * q + 3]) & 127u) << 24);
        *(LAS u32x4*)(idxslot + P * 16) = w;
    }
}
__device__ __forceinline__ float cand(float x, float y, unsigned code, unsigned hi8) { return __uint_as_float((__float_as_uint(x + y) & 0xFFFFFE00u) | code | hi8); }

__device__ __forceinline__ void topk_phase(const bf16_t* Q2, const bf16_t* SKl, int* IDX, float* GATE, LAS unsigned char* lds) {
    int tid_op = threadIdx.x; asm volatile("" : "+v"(tid_op));
    const int tid = tid_op, lane = tid & 63, r32 = lane & 31, hi = lane >> 5, wid = __builtin_amdgcn_readfirstlane(tid >> 6);
    LAS unsigned char* idxslot = lds + TK_IDX + wid * 1024 + r32 * 32;
    int cur_h = -1;
    for (int unit = blockIdx.x; unit < 8 * (T / 256); unit += gridDim.x) {
        const int h = unit & 7, tb = unit >> 3;
        if (h != cur_h) {
            __syncthreads();
#pragma unroll
            for (int i = 0; i < 8; ++i) { const int id = tid + 512 * i, c = id & 15, n = (id >> 4) & 127, p = id >> 11;
                const u32x4 v = *(const u32x4*)(SKl + ((size_t)(h * 2 + p) * 128 + n) * 128 + c * 8);
                *(LAS u32x4*)(lds + TK_SK + p * 32768 + c * 2048 + n * 16) = v; }
            __syncthreads();
            cur_h = h;
        }
        const size_t token = (size_t)tb * 256 + wid * 32 + r32;
        const bf16_t* qrow = Q2 + token * PQ + h * 256;
        float a[16], b[16];
        half_top16<0>(a, qrow, lds, idxslot, r32, hi);
        half_top16<1>(b, qrow, lds, idxslot, r32, hi);
        float x[16], y[16];
#pragma unroll
        for (int i = 0; i < 16; ++i) { float av = a[i], bv = b[i]; asm volatile("" : "+v"(av), "+v"(bv)); x[i] = hi ? bv : av; y[i] = hi ? av : bv; }
        const unsigned hi8 = (unsigned)hi << 8;
        float A[16], B[16];
#pragma unroll
        for (int j = 1; j < 16; ++j) A[j - 1] = cand(x[0], y[j], (unsigned)j, hi8);
        A[15] = TK_NEG;
#pragma unroll
        for (int j = 2; j < 8; ++j) B[j - 2] = cand(x[1], y[j], (unsigned)(16 + j), hi8);
        B[6] = cand(x[2], y[3], 2u * 16u + 3u, hi8); B[7] = cand(x[2], y[4], 2u * 16u + 4u, hi8);
#pragma unroll
        for (int i = 0; i < 4; ++i) { const float d = cand(x[i], y[i], (unsigned)(17 * i), hi8); B[8 + i] = hi ? TK_NEG : d; }
        B[12] = TK_NEG; B[13] = TK_NEG; B[14] = TK_NEG; B[15] = TK_NEG;
        sort16(B);
        merge_top16(A, B);
        merge_partner(A, hi);
        const float smax = A[0];
        float ex[8]; int eidx[8]; float lsum = 0.f;
        asm volatile("s_waitcnt lgkmcnt(0)" ::: "memory");
#pragma unroll
        for (int k = 0; k < 8; ++k) {
            float s_lo = A[k], s_hi = A[8 + k]; asm volatile("" : "+v"(s_lo), "+v"(s_hi)); const float s = hi ? s_hi : s_lo;
            ex[k] = __expf(s - smax); lsum += ex[k];
            const unsigned code = __float_as_uint(s) & 0x1FFu, src = code >> 8, ci = (code >> 4) & 15u, cj = code & 15u;
            const unsigned ai = src ? cj : ci, bi = src ? ci : cj;
            const unsigned ca = idxslot[ai], cb = idxslot[16 + bi];
            eidx[k] = (int)(((ca ^ 127u) << 7) | (cb ^ 127u));
        }
        const float tot = lsum + partner_f(lsum, hi);
        const float inv = 1.0f / tot;
        int* ip = IDX + token * 128 + h * 16 + 8 * hi; float* gp = GATE + token * 128 + h * 16 + 8 * hi;
        *(u32x4*)ip = (u32x4){(unsigned)eidx[0], (unsigned)eidx[1], (unsigned)eidx[2], (unsigned)eidx[3]};
        *(u32x4*)(ip + 4) = (u32x4){(unsigned)eidx[4], (unsigned)eidx[5], (unsigned)eidx[6], (unsigned)eidx[7]};
        *(f32x4*)gp = (f32x4){ex[0] * inv, ex[1] * inv, ex[2] * inv, ex[3] * inv};
        *(f32x4*)(gp + 4) = (f32x4){ex[4] * inv, ex[5] * inv, ex[6] * inv, ex[7] * inv};
        asm volatile("s_waitcnt lgkmcnt(0)" ::: "memory");
    }
}
}

namespace peer2 {
__device__ __forceinline__ unsigned xcc_id() { return (unsigned)__builtin_amdgcn_s_getreg((3 << 11) | 20) & 7u; }
constexpr int CHUNK = 128, NCHUNK = T / CHUNK;
__device__ __forceinline__ float wsum(float v) {
    v += swz_xor<1>(v); v += swz_xor<2>(v); v += swz_xor<4>(v); v += swz_xor<8>(v); v += swz_xor<16>(v);
    auto rr = __builtin_amdgcn_permlane32_swap(__float_as_uint(v), __float_as_uint(v), false, false);
    return __uint_as_float(rr[0]) + __uint_as_float(rr[1]);
}
__device__ __forceinline__ float gelu_erf(float d) { return 0.5f * d * (1.0f + erff(d * 0.70710678118654752f)); }

__device__ __forceinline__ void u_half(unsigned long long m, int idx, float& d, const unsigned char* UQ, const u32x4& hv, int lane) {
    while (m) {
        const int n = __builtin_popcountll(m);
        int kk[16]; u32x4 uv[16];
#pragma unroll
        for (int j = 0; j < 16; ++j) {
            if (j < n) { kk[j] = __builtin_ctzll(m); m &= m - 1; const int e = __builtin_amdgcn_readlane(idx, kk[j]); uv[j] = *(const u32x4*)(UQ + (size_t)e * 1024 + 16 * lane); }
        }
#pragma unroll
        for (int j = 0; j < 16; ++j) {
            if (j < n) {
                int is = __builtin_amdgcn_sdot4((int)uv[j].x, (int)hv.x, 0, false);
                is = __builtin_amdgcn_sdot4((int)uv[j].y, (int)hv.y, is, false);
                is = __builtin_amdgcn_sdot4((int)uv[j].z, (int)hv.z, is, false);
                is = __builtin_amdgcn_sdot4((int)uv[j].w, (int)hv.w, is, false);
                const float f = wsum((float)is);
                if (lane == kk[j]) d = f;
            }
        }
    }
}
__device__ __forceinline__ void u_phase(const KArgs& a, int l, unsigned* cnt, LAS unsigned char* lds) {
    int tid_op = threadIdx.x; asm volatile("" : "+v"(tid_op));
    const int tid = tid_op, lane = tid & 63, wid = __builtin_amdgcn_readfirstlane(tid >> 6);
    const unsigned char* UQ = a.ws + WS_UQ + (size_t)l * NEXP * 1024;
    const float* USC = (const float*)(a.ws + WS_USC) + l * NEXP; const float* VSC = (const float*)(a.ws + WS_VSC) + l * NEXP;
    const int* IDX = (const int*)(a.ws + WS_IDX); const float* GATE = (const float*)(a.ws + WS_GATE);
    const unsigned char* HQ = a.ws + WS_H2Q; const float* HS = (const float*)(a.ws + WS_HS);
    float* COEF = (float*)(a.ws + WS_COEF);
    volatile LAS unsigned* bc = (volatile LAS unsigned*)lds;
    const unsigned home = xcc_id();
    for (unsigned ss = 0; ss < 8; ++ss) {
        const unsigned s = (home + ss) & 7u;
        for (;;) {
            __syncthreads();
            if (tid == 0) bc[0] = __hip_atomic_fetch_add(cnt + 64 * s, 1u, __ATOMIC_RELAXED, __HIP_MEMORY_SCOPE_AGENT);
            __syncthreads();
            const unsigned chunk = bc[0];
            if (chunk >= (unsigned)NCHUNK) break;
#pragma unroll 1
            for (int i = 0; i < CHUNK / NWAVES; ++i) {
                const size_t t = (size_t)chunk * CHUNK + wid * (CHUNK / NWAVES) + i;
                const int idx0 = IDX[t * 128 + lane], idx1 = IDX[t * 128 + 64 + lane];
                const bool in0 = (unsigned)(idx0 >> 11) == s, in1 = (unsigned)(idx1 >> 11) == s;
                const unsigned long long m0 = __ballot(in0), m1 = __ballot(in1);
                const u32x4 hv = *(const u32x4*)(HQ + t * 1024 + 16 * lane);
                const float sh = HS[t];
                float d0 = 0.f, d1 = 0.f;
                u_half(m0, idx0, d0, UQ, hv, lane);
                u_half(m1, idx1, d1, UQ, hv, lane);
                if (in0) COEF[t * 128 + lane] = gelu_erf(d0 * USC[idx0] * sh) * GATE[t * 128 + lane] * VSC[idx0];
                if (in1) COEF[t * 128 + 64 + lane] = gelu_erf(d1 * USC[idx1] * sh) * GATE[t * 128 + 64 + lane] * VSC[idx1];
            }
        }
    }
}
__device__ __forceinline__ void v_phase(const KArgs& a, int l, const float* mod_l, unsigned* cnt, LAS unsigned char* lds) {
    int tid_op = threadIdx.x; asm volatile("" : "+v"(tid_op));
    const int tid = tid_op, lane = tid & 63, wid = __builtin_amdgcn_readfirstlane(tid >> 6);
    const int g = lane >> 3, p = lane & 7;
    const unsigned char* VQ = a.ws + WS_VQ + (size_t)l * NEXP * 1024;
    const int* IDX = (const int*)(a.ws + WS_IDX); const float* COEF = (const float*)(a.ws + WS_COEF);
    volatile LAS unsigned* bc = (volatile LAS unsigned*)lds;
    const unsigned home = xcc_id();
    const bool b4 = (lane >> 4) & 1, b3 = (lane >> 3) & 1;
    for (unsigned ss = 0; ss < 8; ++ss) {
        const unsigned s = (home + ss) & 7u;
        const unsigned char* VS = VQ + (size_t)s * NEXP * 128 + 16 * p;
        for (;;) {
            __syncthreads();
            if (tid == 0) bc[0] = __hip_atomic_fetch_add(cnt + 64 * s, 1u, __ATOMIC_RELAXED, __HIP_MEMORY_SCOPE_AGENT);
            __syncthreads();
            const unsigned chunk = bc[0];
            if (chunk >= (unsigned)NCHUNK) break;
#pragma unroll 1
            for (int i = 0; i < CHUNK / NWAVES; ++i) {
                const size_t t = (size_t)chunk * CHUNK + wid * (CHUNK / NWAVES) + i;
                const int b = (int)(t >> 12);
                u32x4 iv[4]; f32x4 cv[4];
#pragma unroll
                for (int q = 0; q < 4; ++q) { iv[q] = *(const u32x4*)(IDX + t * 128 + 16 * g + 4 * q); cv[q] = *(const f32x4*)(COEF + t * 128 + 16 * g + 4 * q); }
                u32x4 pc[16];
#pragma unroll
                for (int j = 0; j < 16; ++j) pc[j] = *(const u32x4*)(VS + (size_t)iv[j >> 2][j & 3] * 128);
                float acc[16], csum = 0.f;
#pragma unroll
                for (int k = 0; k < 16; ++k) acc[k] = 0.f;
#pragma unroll
                for (int j = 0; j < 16; ++j) {
                    const float c = cv[j >> 2][j & 3]; csum += c;
#pragma unroll
                    for (int w = 0; w < 4; ++w) { const unsigned x = pc[j][w];
                        acc[4 * w + 0] = fmaf(c, (float)(x & 0xffu), acc[4 * w + 0]); acc[4 * w + 1] = fmaf(c, (float)((x >> 8) & 0xffu), acc[4 * w + 1]);
                        acc[4 * w + 2] = fmaf(c, (float)((x >> 16) & 0xffu), acc[4 * w + 2]); acc[4 * w + 3] = fmaf(c, (float)(x >> 24), acc[4 * w + 3]); }
                }
                float r8[8], r4[4], r2[2];
#pragma unroll
                for (int q = 0; q < 8; ++q) { auto rr = __builtin_amdgcn_permlane32_swap(__float_as_uint(acc[q]), __float_as_uint(acc[8 + q]), false, false); r8[q] = __uint_as_float(rr[0]) + __uint_as_float(rr[1]); }
#pragma unroll
                for (int q = 0; q < 4; ++q) { float lo = r8[q], hi = r8[4 + q]; asm volatile("" : "+v"(lo), "+v"(hi)); const float keep = b4 ? hi : lo, send = b4 ? lo : hi; r4[q] = keep + swz_xor<16>(send); }
#pragma unroll
                for (int q = 0; q < 2; ++q) { float lo = r4[q], hi = r4[2 + q]; asm volatile("" : "+v"(lo), "+v"(hi)); const float keep = b3 ? hi : lo, send = b3 ? lo : hi; r2[q] = keep + swz_xor<8>(send); }
                csum += swz_xor<8>(csum); csum += swz_xor<16>(csum);
                { auto rr = __builtin_amdgcn_permlane32_swap(__float_as_uint(csum), __float_as_uint(csum), false, false); csum = __uint_as_float(rr[0]) + __uint_as_float(rr[1]); }
                const float off = 128.0f * csum;
                const int col = (int)s * 128 + 16 * p + 2 * g;
                const float g0 = mod_l[(size_t)b * NMOD + 5 * DM + col], g1 = mod_l[(size_t)b * NMOD + 5 * DM + col + 1];
                float* xp = a.out + t * DM + col;
                typedef float f32x2 __attribute__((ext_vector_type(2)));
                f32x2 xv = *(const f32x2*)xp;
                xv.x += g0 * (r2[0] - off); xv.y += g1 * (r2[1] - off);
                *(f32x2*)xp = xv;
            }
        }
    }
}
}

constexpr int PH_PER_LAYER = 10, NPHASES = 1 + DEPTH * PH_PER_LAYER + 1;
#ifndef PHASE_MASK
#define PHASE_MASK 0xFFFF
#endif
#define HASP(k) (((PHASE_MASK) >> (k)) & 1)
#ifndef SB_EARLY_EXIT
#define SB_EARLY_EXIT 1
#endif

typedef const __attribute__((address_space(4))) KArgs* KArgsP;
__device__ __forceinline__ KArgsP kargs() { KArgsP p = (KArgsP)__builtin_amdgcn_kernarg_segment_ptr(); asm volatile("" : "+s"(p)); return p; }

__device__ __forceinline__ void load_args(KArgs& a) {
#if defined(__HIP_DEVICE_COMPILE__)
    KArgsP p = kargs();
    a.x = p->x; a.c = p->c; a.pos = p->pos; a.ada_w = p->ada_w; a.ada_b = p->ada_b; a.norm1_g = p->norm1_g; a.w_in = p->w_in; a.sinks = p->sinks; a.wbr_a = p->wbr_a; a.wbr_b = p->wbr_b;
    a.w_out = p->w_out; a.norm2_g = p->norm2_g; a.wq = p->wq; a.subkeys = p->subkeys; a.pu = p->pu; a.pv = p->pv; a.final_g = p->final_g; a.out = p->out; a.ws = p->ws; a.ph_lo = p->ph_lo; a.ph_hi = p->ph_hi;
#endif
}
__global__ void __launch_bounds__(NTHREADS, 2) fwd_kernel(KArgs a_unused) {
    extern __shared__ __attribute__((aligned(16))) unsigned char lds_raw[];
    LAS unsigned char* lds = (LAS unsigned char*)lds_raw;
    cg::grid_group grid = cg::this_grid();
    const int ph_lo = kargs()->ph_lo, ph_hi = kargs()->ph_hi;
#define IN(k) (ph_lo <= (k) && (k) < ph_hi)
#ifdef PROBE_PH
    unsigned long long pr_prev = __builtin_amdgcn_s_memrealtime(), pr_acc = 0;
#define PROBE_MATCH(k) ((PROBE_PH) >= 100 ? ((k) >= 1 && (k) < NPHASES - 1 && (((k) - 1) % PH_PER_LAYER) == (PROBE_PH) - 100) : (k) == (PROBE_PH))
#define SEAM(k) do { if (IN(k) && IN((k) + 1)) grid.sync(); { const unsigned long long now_ = __builtin_amdgcn_s_memrealtime(); if (PROBE_MATCH(k)) pr_acc += now_ - pr_prev; pr_prev = now_; } } while (0)
#else
#define SEAM(k) do { if (IN(k) && IN((k) + 1)) grid.sync(); } while (0)
#endif
#define LOADARGS KArgs a; load_args(a); unsigned char* ws = a.ws; const int G = gridDim.x; (void)G; (void)ws
#define LAYERARGS const float* mod_l = (const float*)(ws + WS_MOD) + (size_t)l * 8 * NMOD; const float* xcur = (l == 0) ? a.x : a.out; (void)mod_l; (void)xcur
    if (IN(0)) { if (HASP(0)) { LOADARGS; ph_prologue(a, lds); } }
    SEAM(0);
#pragma unroll 1
    for (int l = 0; l < DEPTH; ++l) {
        const int p0 = 1 + l * PH_PER_LAYER;
        if (IN(p0 + 0)) { if (HASP(1)) { LOADARGS; LAYERARGS; ph_norm<false>(a, xcur, a.norm1_g + l * DM, mod_l, 0, 1); } }
        SEAM(p0 + 0);
        if (IN(p0 + 1)) { if (HASP(2)) { LOADARGS; pg8::Gemm g{(const bf16_t*)(ws + WS_H), (const bf16_t*)(ws + WS_WIN) + (size_t)l * NPROJ * 1024, T, NPROJ, 1024};
                  pg8::StaticOrder S; S.init(T, NPROJ, G, (int)blockIdx.x); EpiProj E{ws};
                  pg8::gemm_phase<EpiProj, pg8::StaticOrder, true, true>(lds, g, S, E); } }
        SEAM(p0 + 1);
        if (IN(p0 + 2)) { if (HASP(3)) { LOADARGS;
                  att::swa_phase((const bf16_t*)(ws + WS_QA), (const bf16_t*)(ws + WS_KA), (const bf16_t*)(ws + WS_VA), (bf16_t*)(ws + WS_QA), a.sinks + l * 8, lds);
                  __syncthreads();
                  att::sb_phase<SB_EARLY_EXIT != 0>((const bf16_t*)(ws + WS_QB), (const bf16_t*)(ws + WS_KB), (const bf16_t*)(ws + WS_VB), (bf16_t*)(ws + WS_QB), lds); } }
        SEAM(p0 + 2);
        if (IN(p0 + 3)) { if (HASP(4)) { LOADARGS; pg8::StaticOrder S; S.init(T, DM, G, (int)blockIdx.x);
                  { pg8::Gemm g{(const bf16_t*)(ws + WS_QA), (const bf16_t*)(ws + WS_WBA) + (size_t)l * 1024 * 512, T, DM, 512};
                    EpiBranch<false> E{(const bf16_t*)(ws + WS_GA), (bf16_t*)(ws + WS_H)};
                    pg8::gemm_phase<EpiBranch<false>, pg8::StaticOrder, true, true>(lds, g, S, E); }
                  __syncthreads();
                  { pg8::Gemm g{(const bf16_t*)(ws + WS_QB), (const bf16_t*)(ws + WS_WBB) + (size_t)l * 1024 * 512, T, DM, 512};
                    EpiBranch<true> E{(const bf16_t*)(ws + WS_GB), (bf16_t*)(ws + WS_H)};
                    pg8::gemm_phase<EpiBranch<true>, pg8::StaticOrder, true, true>(lds, g, S, E); } } }
        SEAM(p0 + 3);
        if (IN(p0 + 4)) { if (HASP(5)) { LOADARGS; LAYERARGS; pg8::Gemm g{(const bf16_t*)(ws + WS_H), (const bf16_t*)(ws + WS_WOUT) + (size_t)l * 1024 * 1024, T, DM, 1024};
                  pg8::StaticOrder S; S.init(T, DM, G, (int)blockIdx.x); EpiWout E{xcur, a.out, mod_l + 2 * DM};
                  pg8::gemm_phase<EpiWout, pg8::StaticOrder, true, true>(lds, g, S, E); } }
        SEAM(p0 + 4);
        if (IN(p0 + 5)) { if (HASP(6)) { LOADARGS; LAYERARGS; ph_norm<true>(a, a.out, a.norm2_g + l * DM, mod_l, 3, 4); } }
        SEAM(p0 + 5);
        if (IN(p0 + 6)) { if (HASP(7)) { LOADARGS; pg8::Gemm g{(const bf16_t*)(ws + WS_H), (const bf16_t*)(ws + WS_WQ) + (size_t)l * PQ * 1024, T, PQ, 1024};
                  pg8::StaticOrder S; S.init(T, PQ, G, (int)blockIdx.x); EpiPlainBf16 E{(bf16_t*)(ws + WS_Q2), PQ};
                  pg8::gemm_phase<EpiPlainBf16, pg8::StaticOrder, true, true>(lds, g, S, E); } }
        SEAM(p0 + 6);
        if (IN(p0 + 7)) { if (HASP(8)) { LOADARGS; tk::topk_phase((const bf16_t*)(ws + WS_Q2), (const bf16_t*)(ws + WS_SK) + (size_t)l * 8 * 2 * 128 * 128, (int*)(ws + WS_IDX), (float*)(ws + WS_GATE), lds); } }
        SEAM(p0 + 7);
        if (IN(p0 + 8)) { if (HASP(9)) { LOADARGS; peer2::u_phase(a, l, (unsigned*)(ws + WS_CTL) + CTL_QUEUE + (l * 2 + 0) * 8 * 64, lds); } }
        SEAM(p0 + 8);
        if (IN(p0 + 9)) { if (HASP(10)) { LOADARGS; LAYERARGS; peer2::v_phase(a, l, mod_l, (unsigned*)(ws + WS_CTL) + CTL_QUEUE + (l * 2 + 1) * 8 * 64, lds); } }
        SEAM(p0 + 9);
    }
    if (IN(NPHASES - 1)) { if (HASP(11)) { LOADARGS; ph_final_norm(a); } }
#ifdef PROBE_PH
    { const unsigned long long now_ = __builtin_amdgcn_s_memrealtime(); if (PROBE_MATCH(NPHASES - 1)) pr_acc += now_ - pr_prev;
      if (blockIdx.x == 0 && threadIdx.x == 0) { const unsigned long long t0_ = __builtin_amdgcn_s_memrealtime(); while (__builtin_amdgcn_s_memrealtime() - t0_ < pr_acc * (PROBE_K)) __builtin_amdgcn_s_sleep(16); } }
#endif
#undef IN
#undef SEAM
}

#ifndef N_LAUNCH_SPLIT
#define N_LAUNCH_SPLIT 1
#endif
extern "C" void kernel_launch(void* const* d_in, const int* in_sizes, int n_in, void* d_out, int out_size, void* d_ws, size_t ws_size, hipStream_t stream) {
    static int grid = 0;
    if (grid == 0) {
        if (n_in != 17 || out_size != T * DM || ws_size < WS_END) { fprintf(stderr, "kernel_launch: unexpected problem (n_in %d out %d ws %zu)\n", n_in, out_size, ws_size); grid = -1; return; }
        int dev = 0, cus = 0, per_cu = 0;
        (void)hipGetDevice(&dev);
        (void)hipDeviceGetAttribute(&cus, hipDeviceAttributeMultiprocessorCount, dev);
        (void)hipFuncSetAttribute((const void*)fwd_kernel, hipFuncAttributeMaxDynamicSharedMemorySize, LDS_BYTES);
        (void)hipOccupancyMaxActiveBlocksPerMultiprocessor(&per_cu, (const void*)fwd_kernel, NTHREADS, LDS_BYTES);
        if (per_cu < 1) { fprintf(stderr, "kernel_launch: occupancy query says %d\n", per_cu); per_cu = 1; }
        grid = cus;
        fprintf(stderr, "kernel_launch: cus %d per_cu %d grid %d ws %zu\n", cus, per_cu, grid, ws_size);
    }
    if (grid < 0) return;
    KArgs a{};
    a.x = (const float*)d_in[0]; a.c = (const float*)d_in[1]; a.pos = (const int*)d_in[2]; a.ada_w = (const float*)d_in[3]; a.ada_b = (const float*)d_in[4];
    a.norm1_g = (const float*)d_in[5]; a.w_in = (const float*)d_in[6]; a.sinks = (const float*)d_in[7]; a.wbr_a = (const float*)d_in[8]; a.wbr_b = (const float*)d_in[9];
    a.w_out = (const float*)d_in[10]; a.norm2_g = (const float*)d_in[11]; a.wq = (const float*)d_in[12]; a.subkeys = (const float*)d_in[13]; a.pu = (const float*)d_in[14];
    a.pv = (const float*)d_in[15]; a.final_g = (const float*)d_in[16]; a.out = (float*)d_out; a.ws = (unsigned char*)d_ws;
#if N_LAUNCH_SPLIT
    a.ph_lo = 0; a.ph_hi = NPHASES;
    { void* args[] = {&a};
      hipError_t e = hipLaunchCooperativeKernel((void*)fwd_kernel, dim3(grid), dim3(NTHREADS), args, LDS_BYTES, stream);
      if (e != hipSuccess) fprintf(stderr, "cooperative launch failed: %s (grid %d)\n", hipGetErrorString(e), grid); }
#else
    for (int ph = 0; ph < NPHASES; ++ph) {
        a.ph_lo = ph; a.ph_hi = ph + 1;
        void* args[] = {&a};
        hipError_t e = hipLaunchCooperativeKernel((void*)fwd_kernel, dim3(grid), dim3(NTHREADS), args, LDS_BYTES, stream);
        if (e != hipSuccess) { fprintf(stderr, "cooperative launch %d failed: %s (grid %d)\n", ph, hipGetErrorString(e), grid); break; }
    }
#endif
}
```

```cpp
#include <hip/hip_runtime.h>
#include <hip/hip_cooperative_groups.h>
#include <cstdio>
#include <cstdint>
namespace cg = cooperative_groups;

namespace pg8 {
#define PG8_LAS __attribute__((address_space(3)))
typedef unsigned short bf16_t;
typedef short bf16x8 __attribute__((ext_vector_type(8)));
typedef float f32x4 __attribute__((ext_vector_type(4)));
typedef unsigned u32x4 __attribute__((ext_vector_type(4)));
constexpr int BM = 256, BK = 64, HALF = 128, HTB = HALF * BK * 2  , STAGE_BYTES = 8 * HTB, NXCD = 8, WGM = 8;

__host__ __device__ __forceinline__ int lds_byte(int r, int c) { const int st = (r >> 4) * 2 + (c >> 5), rr = r & 15, cc = c & 31, ob = rr * 64 + cc * 2; return st * 1024 + (ob ^ (((ob >> 9) & 1) << 5)); }
__host__ __device__ __forceinline__ void stage_rc(int b, int& R, int& C) { const int st = b / 1024, sb = b % 1024, swz = sb ^ (((sb >> 9) & 1) << 5); R = (st >> 1) * 16 + swz / 64; C = (st & 1) * 32 + (swz % 64) / 2; }
__host__ __device__ __forceinline__ int perm32(int rho) { const int n = rho >> 4, i = rho & 15; return 8 * (i >> 2) + 4 * n + (i & 3); }

struct Unit { int pm, pn; };
struct Gemm { const bf16_t* A; const bf16_t* Bt; int M, N, K; };

struct StaticOrder {
    int nM, nN, nwg, G, c;
    __host__ __device__ void init(int M, int N, int G_, int c_) { nM = M / BM; nN = N / BM; nwg = nM * nN; G = G_; c = c_; }
    __host__ __device__ bool next(int i, Unit& u) const {
        const long L = (long)i * G + c; if (L >= nwg) return false;
        int wgid = (int)L; { const int q = nwg / NXCD, r = nwg % NXCD, xcd = wgid % NXCD, off = wgid / NXCD; wgid = (xcd < r ? xcd * (q + 1) : r * (q + 1) + (xcd - r) * q) + off; }
        const int nig = WGM * nN, gid = wgid / nig, fm = gid * WGM, gsz = (nM - fm) < WGM ? (nM - fm) : WGM;
        u.pm = fm + ((wgid % nig) % gsz); u.pn = (wgid % nig) / gsz; return true;
    }
    __device__ __forceinline__ void a_ready(const Unit&) const {}
    __device__ __forceinline__ void done(const Unit&) const {}
};


__device__ __forceinline__ unsigned cvt_pk_bf16(float lo, float hi) { unsigned r; asm volatile("v_cvt_pk_bf16_f32 %0, %1, %2" : "=v"(r) : "v"(lo), "v"(hi)); return r; }
template <class Epi, class Sched, bool ALIGN_EPI = false, bool SP2 = false>
__device__ __forceinline__ void gemm_phase(PG8_LAS unsigned char* lds, const Gemm g, const Sched& S, const Epi& E) {
    int tid_op = threadIdx.x; asm volatile("" : "+v"(tid_op));
    const int tid = tid_op, wid = __builtin_amdgcn_readfirstlane(tid >> 6), lane = tid & 63, wr = wid >> 2, wc = wid & 3, fr = lane & 15, fq = lane >> 4;
    const int K = g.K, nt = K / BK;
    unsigned voffA[2], voffB[2];
#pragma unroll
    for (int i = 0; i < 2; ++i) { int R, C; stage_rc(tid * 16 + i * 8192, R, C); const int Rb = Epi::PERM ? ((R & ~31) + perm32(R & 31)) : R;
        voffA[i] = (unsigned)(R * K + C) * 2u; voffB[i] = (unsigned)(Rb * K + C) * 2u; }
    const size_t kstep = (size_t)(BK * 2);
    const size_t hstep = (size_t)HALF * K * 2;
    const size_t tstep = 2 * hstep;
    const unsigned ldsw = (unsigned)wid * 1024u;
    const int aoff = lds_byte(wr * 64 + fr, fq * 8), boff = lds_byte(wc * 32 + fr, fq * 8);
#define PG8_SA(b, h) (((b) * 2 + (h)) * HTB)
#define PG8_SB(b, h) ((4 + (b) * 2 + (h)) * HTB)
#define PG8_STAGE(bufoff, gbase, voff) do { _Pragma("unroll") for (int _i = 0; _i < 2; ++_i) \
        __builtin_amdgcn_global_load_lds((const unsigned*)((const char*)(gbase) + (voff)[_i]), (PG8_LAS unsigned*)(lds + (bufoff) + ldsw + _i * 8192), 16, 0, 0); } while (0)
#define PG8_LDA(dst, b, h) do { _Pragma("unroll") for (int m = 0; m < 4; ++m) _Pragma("unroll") for (int k = 0; k < 2; ++k) dst[m][k] = *(const PG8_LAS bf16x8*)(lds + PG8_SA(b, h) + aoff + m * 2048 + k * 1024); } while (0)
#define PG8_LDB(dst, b, h) do { _Pragma("unroll") for (int n = 0; n < 2; ++n) _Pragma("unroll") for (int k = 0; k < 2; ++k) dst[n][k] = *(const PG8_LAS bf16x8*)(lds + PG8_SB(b, h) + boff + n * 2048 + k * 1024); } while (0)
#define PG8_MMA(ai, bj, At, Bt) do { __builtin_amdgcn_s_setprio(1); _Pragma("unroll") for (int m = 0; m < 4; ++m) _Pragma("unroll") for (int n = 0; n < 2; ++n) _Pragma("unroll") for (int k = 0; k < 2; ++k) \
        acc[ai][bj][m][n] = __builtin_amdgcn_mfma_f32_16x16x32_bf16(Bt[n][k], At[m][k], acc[ai][bj][m][n], 0, 0, 0); __builtin_amdgcn_s_setprio(0); } while (0)
#define PG8_WAIT_V(n) asm volatile("s_waitcnt vmcnt(" #n ")" ::: "memory")
#define PG8_WAIT_L(n) asm volatile("s_waitcnt lgkmcnt(" #n ")" ::: "memory")
#define PG8_BAR __builtin_amdgcn_s_barrier()
#define PG8_SCHED __builtin_amdgcn_sched_barrier(0)
    Unit cur, nxt; int ui = 0;
    if (!S.next(0, cur)) return;
    f32x4 acc[2][2][4][2];
#pragma unroll
    for (int a = 0; a < 2; ++a)
#pragma unroll
        for (int b = 0; b < 2; ++b)
#pragma unroll
            for (int m = 0; m < 4; ++m)
#pragma unroll
                for (int n = 0; n < 2; ++n) acc[a][b][m][n] = (f32x4){0.f, 0.f, 0.f, 0.f};
    bf16x8 At[4][2], B0[2][2], B1[2][2];
    const char* cA = (const char*)g.A + (size_t)cur.pm * tstep; const char* cB = (const char*)g.Bt + (size_t)cur.pn * tstep;
    S.a_ready(cur);
    if constexpr (SP2) {
        PG8_STAGE(PG8_SB(0, 0), cB, voffB); PG8_STAGE(PG8_SB(0, 1), cB + hstep, voffB); PG8_STAGE(PG8_SA(0, 0), cA, voffA); PG8_STAGE(PG8_SA(0, 1), cA + hstep, voffA);
        if (wr == 1) PG8_BAR;
        PG8_WAIT_V(2); PG8_BAR;
        PG8_STAGE(PG8_SB(1, 0), cB + kstep, voffB); PG8_STAGE(PG8_SA(1, 0), cA + kstep, voffA); PG8_STAGE(PG8_SB(1, 1), cB + hstep + kstep, voffB);
        PG8_WAIT_V(6); PG8_BAR;
    } else {
        PG8_STAGE(PG8_SB(0, 0), cB, voffB); PG8_STAGE(PG8_SA(0, 0), cA, voffA); PG8_STAGE(PG8_SB(0, 1), cB + hstep, voffB); PG8_STAGE(PG8_SA(0, 1), cA + hstep, voffA);
        if (wr == 1) PG8_BAR;
        PG8_WAIT_V(4); PG8_BAR;
        PG8_STAGE(PG8_SB(1, 0), cB + kstep, voffB); PG8_STAGE(PG8_SA(1, 0), cA + kstep, voffA); PG8_STAGE(PG8_SB(1, 1), cB + hstep + kstep, voffB);
        PG8_WAIT_V(6); PG8_BAR;
    }
    for (;;) {
        const bool has_next = S.next(ui + 1, nxt);
        const char* nA = has_next ? (const char*)g.A + (size_t)nxt.pm * tstep : cA; const char* nB = has_next ? (const char*)g.Bt + (size_t)nxt.pn * tstep : cB;
        for (int t = 0; t < nt; t += 2) {
            const bool last = (t == nt - 2);
            const char* a1 = cA + (size_t)(t + 1) * kstep;
            const char* a2 = last ? nA : cA + (size_t)(t + 2) * kstep; const char* b2 = last ? nB : cB + (size_t)(t + 2) * kstep;
            const char* a3 = a2 + kstep; const char* b3 = b2 + kstep;
            if (last && has_next) S.a_ready(nxt);
            if constexpr (SP2) {
            PG8_LDB(B0, 0, 0); PG8_LDB(B1, 0, 1); PG8_SCHED; PG8_LDA(At, 0, 0); PG8_STAGE(PG8_SA(1, 1), a1 + hstep, voffA);
            PG8_WAIT_V(8); PG8_WAIT_L(0); PG8_BAR; PG8_MMA(0, 0, At, B0); PG8_MMA(0, 1, At, B1); PG8_BAR; PG8_SCHED;
            PG8_LDA(At, 0, 1); PG8_STAGE(PG8_SB(0, 0), b2, voffB); PG8_STAGE(PG8_SB(0, 1), b2 + hstep, voffB); PG8_STAGE(PG8_SA(0, 0), a2, voffA);
            PG8_WAIT_V(8); PG8_WAIT_L(0); PG8_BAR; PG8_MMA(1, 0, At, B0); PG8_MMA(1, 1, At, B1); PG8_BAR; PG8_SCHED;
            PG8_LDB(B0, 1, 0); PG8_LDB(B1, 1, 1); PG8_SCHED; PG8_LDA(At, 1, 0); PG8_STAGE(PG8_SA(0, 1), a2 + hstep, voffA);
            PG8_WAIT_V(8); PG8_WAIT_L(0); PG8_BAR; PG8_MMA(0, 0, At, B0); PG8_MMA(0, 1, At, B1); PG8_BAR; PG8_SCHED;
            PG8_LDA(At, 1, 1); PG8_STAGE(PG8_SB(1, 0), b3, voffB); PG8_STAGE(PG8_SB(1, 1), b3 + hstep, voffB); PG8_STAGE(PG8_SA(1, 0), a3, voffA);
            PG8_WAIT_V(8); PG8_WAIT_L(0); PG8_BAR; PG8_MMA(1, 0, At, B0); PG8_MMA(1, 1, At, B1); PG8_BAR; PG8_SCHED;
            } else {
            PG8_LDB(B0, 0, 0); PG8_SCHED; PG8_LDA(At, 0, 0); PG8_STAGE(PG8_SA(1, 1), a1 + hstep, voffA);
            PG8_WAIT_L(8); PG8_BAR; PG8_WAIT_L(0); PG8_MMA(0, 0, At, B0); PG8_BAR; PG8_SCHED;
            PG8_LDB(B1, 0, 1); PG8_STAGE(PG8_SB(0, 0), b2, voffB);
            PG8_BAR; PG8_WAIT_L(0); PG8_MMA(0, 1, At, B1); PG8_BAR;
            PG8_LDA(At, 0, 1); PG8_STAGE(PG8_SA(0, 0), a2, voffA);
            PG8_BAR; PG8_WAIT_L(0); PG8_MMA(1, 0, At, B0); PG8_BAR; PG8_SCHED;
            PG8_STAGE(PG8_SB(0, 1), b2 + hstep, voffB);
            PG8_WAIT_V(6); PG8_BAR; PG8_MMA(1, 1, At, B1); PG8_BAR;
            PG8_LDB(B0, 1, 0); PG8_SCHED; PG8_LDA(At, 1, 0); PG8_STAGE(PG8_SA(0, 1), a2 + hstep, voffA);
            PG8_WAIT_L(8); PG8_BAR; PG8_WAIT_L(0); PG8_MMA(0, 0, At, B0); PG8_BAR; PG8_SCHED;
            PG8_LDB(B1, 1, 1); PG8_STAGE(PG8_SB(1, 0), b3, voffB);
            PG8_BAR; PG8_WAIT_L(0); PG8_MMA(0, 1, At, B1); PG8_BAR;
            PG8_LDA(At, 1, 1); PG8_STAGE(PG8_SA(1, 0), a3, voffA);
            PG8_BAR; PG8_WAIT_L(0); PG8_MMA(1, 0, At, B0); PG8_BAR; PG8_SCHED;
            PG8_STAGE(PG8_SB(1, 1), b3 + hstep, voffB);
            PG8_WAIT_V(6); PG8_BAR; PG8_MMA(1, 1, At, B1); PG8_BAR;
            }
        }
        if constexpr (ALIGN_EPI) { if (wr == 0) PG8_BAR; }
        if constexpr (!Epi::AFTER_DRAIN) { E(acc, cur, wr, wc, fr, fq); S.done(cur); }
        if (!has_next) break;
#pragma unroll
        for (int a = 0; a < 2; ++a)
#pragma unroll
            for (int b = 0; b < 2; ++b)
#pragma unroll
                for (int m = 0; m < 4; ++m)
#pragma unroll
                    for (int n = 0; n < 2; ++n) acc[a][b][m][n] = (f32x4){0.f, 0.f, 0.f, 0.f};
        cur = nxt; cA = nA; cB = nB; ++ui;
        if constexpr (ALIGN_EPI) { if (wr == 1) PG8_BAR; }
    }
    PG8_WAIT_V(0);
    if constexpr (!ALIGN_EPI) { if (wr == 0) PG8_BAR; }
    PG8_BAR;
    if constexpr (Epi::AFTER_DRAIN) { E.fused(acc, cur, wr, wc, fr, fq, lds, wid, lane); S.done(cur); }
#undef PG8_SA
#undef PG8_SB
#undef PG8_STAGE
#undef PG8_LDA
#undef PG8_LDB
#undef PG8_MMA
#undef PG8_WAIT_V
#undef PG8_WAIT_L
#undef PG8_BAR
#undef PG8_SCHED
}
}


#define LAS __attribute__((address_space(3)))
typedef unsigned short bf16_t;
typedef float f32x4 __attribute__((ext_vector_type(4)));
typedef unsigned u32x4 __attribute__((ext_vector_type(4)));
typedef unsigned u32x2 __attribute__((ext_vector_type(2)));

constexpr int BATCH = 8, SEQ = 4096, DM = 1024, T = BATCH * SEQ, DEPTH = 2;
constexpr int NPROJ = 4352, NMOD = 6 * DM;
constexpr int NEXP = 16384, PQ = 2048;
constexpr float NORM_EPS = 1e-6f;
constexpr float LOG2E = 1.4426950408889634f;
constexpr float QSCALE = 0.125f * LOG2E;
constexpr float SB_EXIT = 160.0f;

constexpr size_t MiB = 1u << 20;
constexpr size_t WS_CTL = 0;
constexpr size_t WS_MOD = 1 * MiB;
constexpr size_t WS_ROPE = 2 * MiB;
constexpr size_t WS_WIN = 10 * MiB;
constexpr size_t WS_WBA = 27 * MiB;
constexpr size_t WS_WBB = 29 * MiB;
constexpr size_t WS_WOUT = 31 * MiB;
constexpr size_t WS_WQ = 35 * MiB;
constexpr size_t WS_SK = 43 * MiB;
constexpr size_t WS_UQ = 44 * MiB;
constexpr size_t WS_VQ = 76 * MiB;
constexpr size_t WS_USC = 108 * MiB;
constexpr size_t WS_VSC = 108 * MiB + 256 * 1024;
constexpr size_t WS_HS = 109 * MiB;
constexpr size_t WS_H = 112 * MiB;
constexpr size_t WS_QA = 176 * MiB;
constexpr size_t WS_QB = 208 * MiB;
constexpr size_t WS_KB = 240 * MiB;
constexpr size_t WS_VB = 272 * MiB;
constexpr size_t WS_KA = 304 * MiB;
constexpr size_t WS_VA = 312 * MiB;
constexpr size_t WS_GA = 320 * MiB;
constexpr size_t WS_GB = 384 * MiB;
constexpr size_t WS_END = 448 * MiB;
constexpr size_t WS_H2Q = WS_QA, WS_IDX = WS_KB, WS_GATE = WS_VB, WS_Q2 = WS_GA, WS_COEF = WS_GA;
constexpr int CTL_QUEUE = 1024;

constexpr int LDS_BYTES = 147456;
constexpr int NTHREADS = 512, NWAVES = 8;

struct KArgs {
    const float* x; const float* c; const int* pos; const float* ada_w; const float* ada_b; const float* norm1_g; const float* w_in; const float* sinks;
    const float* wbr_a; const float* wbr_b; const float* w_out; const float* norm2_g; const float* wq; const float* subkeys; const float* pu; const float* pv; const float* final_g;
    float* out; unsigned char* ws; int ph_lo, ph_hi;
};

__device__ __forceinline__ unsigned f2bf(float f) { unsigned u = __float_as_uint(f); return (u + 0x7fffu + ((u >> 16) & 1u)) >> 16; }
__device__ __forceinline__ unsigned pk2(float lo, float hi) { return f2bf(lo) | (f2bf(hi) << 16); }
__device__ __forceinline__ float bflo(unsigned w) { return __uint_as_float(w << 16); }
__device__ __forceinline__ float bfhi(unsigned w) { return __uint_as_float(w & 0xffff0000u); }
template <int M> __device__ __forceinline__ float swz_xor(float v) { return __int_as_float(__builtin_amdgcn_ds_swizzle(__float_as_int(v), (M << 10) | 0x1f)); }
__device__ __forceinline__ float wave_sum(float v) {
    v += swz_xor<1>(v); v += swz_xor<2>(v); v += swz_xor<4>(v); v += swz_xor<8>(v); v += swz_xor<16>(v);
    auto rr = __builtin_amdgcn_permlane32_swap(__float_as_uint(v), __float_as_uint(v), false, false);
    return __uint_as_float(rr[0]) + __uint_as_float(rr[1]);
}
__device__ __forceinline__ float wave_max(float v) {
    v = fmaxf(v, swz_xor<1>(v)); v = fmaxf(v, swz_xor<2>(v)); v = fmaxf(v, swz_xor<4>(v)); v = fmaxf(v, swz_xor<8>(v)); v = fmaxf(v, swz_xor<16>(v));
    auto rr = __builtin_amdgcn_permlane32_swap(__float_as_uint(v), __float_as_uint(v), false, false);
    return fmaxf(__uint_as_float(rr[0]), __uint_as_float(rr[1]));
}
__device__ __forceinline__ int rdlane_i(int v, int l) { return __builtin_amdgcn_readlane(v, __builtin_amdgcn_readfirstlane(l)); }
__device__ __forceinline__ float rdlane_f(float v, int l) { return __int_as_float(__builtin_amdgcn_readlane(__float_as_int(v), __builtin_amdgcn_readfirstlane(l))); }
__device__ __forceinline__ float dot8(u32x4 a, u32x4 b, float acc) {
    acc = fmaf(bflo(a.x), bflo(b.x), acc); acc = fmaf(bfhi(a.x), bfhi(b.x), acc);
    acc = fmaf(bflo(a.y), bflo(b.y), acc); acc = fmaf(bfhi(a.y), bfhi(b.y), acc);
    acc = fmaf(bflo(a.z), bflo(b.z), acc); acc = fmaf(bfhi(a.z), bfhi(b.z), acc);
    acc = fmaf(bflo(a.w), bflo(b.w), acc); acc = fmaf(bfhi(a.w), bfhi(b.w), acc);
    return acc;
}
__device__ __forceinline__ float softplus2(float z2) {
    return fmaxf(z2, 0.f) + __log2f(1.0f + exp2f(-fabsf(z2)));
}

__device__ __forceinline__ int win_pos(int n) {
    if (n >= 640) return n;
    const int hb = n & ~63, d = n & 63;
    return hb + (d < 32 ? 2 * d : 2 * (d - 32) + 1);
}
template <bool WIN>
__device__ __forceinline__ void transpose_item(const float* W, int K, int N, bf16_t* WT, LAS float* scr, int item, int lane) {
    const int nblk = N / 32, kb = item / nblk, nb = item % nblk, k0 = 64 * kb, n0 = 32 * nb;
#pragma unroll 8
    for (int i = 0; i < 32; ++i) { const int kk = 2 * i + (lane >> 5); scr[kk * 33 + (lane & 31)] = W[(size_t)(k0 + kk) * N + n0 + (lane & 31)]; }
    asm volatile("s_waitcnt lgkmcnt(0)" ::: "memory");
    const int c = lane & 7;
#pragma unroll
    for (int j = 0; j < 4; ++j) { const int n = (lane >> 3) + 8 * j; const LAS float* s = scr + (8 * c) * 33 + n;
        u32x4 o; o.x = pk2(s[0 * 33], s[1 * 33]); o.y = pk2(s[2 * 33], s[3 * 33]); o.z = pk2(s[4 * 33], s[5 * 33]); o.w = pk2(s[6 * 33], s[7 * 33]);
        const int row = WIN ? win_pos(n0 + n) : (n0 + n);
        *(u32x4*)(WT + (size_t)row * K + k0 + 8 * c) = o; }
    asm volatile("s_waitcnt lgkmcnt(0)" ::: "memory");
}
template <bool OFFSET128>
__device__ __forceinline__ void quant_row(const f32x4 (&v)[4], unsigned char* dst_row, float* scale_out, int lane) {
    float am = 0.f;
#pragma unroll
    for (int i = 0; i < 4; ++i) am = fmaxf(am, fmaxf(fmaxf(fabsf(v[i].x), fabsf(v[i].y)), fmaxf(fabsf(v[i].z), fabsf(v[i].w))));
    am = wave_max(am);
    const float inv = am > 0.f ? 127.0f / am : 0.f, sc = am > 0.f ? am / 127.0f : 1.0f;
    u32x4 o;
#pragma unroll
    for (int i = 0; i < 4; ++i) {
        int q0 = (int)rintf(v[i].x * inv), q1 = (int)rintf(v[i].y * inv), q2 = (int)rintf(v[i].z * inv), q3 = (int)rintf(v[i].w * inv);
        if (OFFSET128) { q0 += 128; q1 += 128; q2 += 128; q3 += 128; }
        o[i] = (unsigned)(q0 & 0xff) | ((unsigned)(q1 & 0xff) << 8) | ((unsigned)(q2 & 0xff) << 16) | ((unsigned)(q3 & 0xff) << 24);
    }
    *(u32x4*)(dst_row + 16 * lane) = o;
    if (lane == 0) *scale_out = sc;
}

__device__ __forceinline__ void ph_prologue(const KArgs& a, LAS unsigned char* lds) {
    int tid_op = threadIdx.x; asm volatile("" : "+v"(tid_op)); const int tid = tid_op, lane = tid & 63, wave = tid >> 6, G = gridDim.x;
    const int gw = blockIdx.x * NWAVES + wave, NGW = G * NWAVES;
    unsigned char* ws = a.ws;
    {
        LAS float* sc = (LAS float*)lds;
        for (int it = blockIdx.x; it < DEPTH * 12; it += G) {
            for (int idx = tid; idx < 8192; idx += NTHREADS) { const int b = idx >> 10, i = idx & 1023; const float cv = a.c[b * 1024 + i]; sc[i * 8 + b] = cv / (1.0f + __expf(-cv)); }
            __syncthreads();
            const int l = it / 12, j = (it % 12) * 512 + tid;
            const float* wp = a.ada_w + (size_t)l * 1024 * NMOD + j;
            float acc[8];
#pragma unroll
            for (int b = 0; b < 8; ++b) acc[b] = 0.f;
#pragma unroll 4
            for (int i = 0; i < 1024; ++i) {
                const float w = wp[(size_t)i * NMOD];
                const f32x4 s0 = *(const LAS f32x4*)(sc + i * 8), s1 = *(const LAS f32x4*)(sc + i * 8 + 4);
                acc[0] = fmaf(s0.x, w, acc[0]); acc[1] = fmaf(s0.y, w, acc[1]); acc[2] = fmaf(s0.z, w, acc[2]); acc[3] = fmaf(s0.w, w, acc[3]);
                acc[4] = fmaf(s1.x, w, acc[4]); acc[5] = fmaf(s1.y, w, acc[5]); acc[6] = fmaf(s1.z, w, acc[6]); acc[7] = fmaf(s1.w, w, acc[7]);
            }
            float* mod = (float*)(ws + WS_MOD);
            const float bias = a.ada_b[l * NMOD + j];
#pragma unroll
            for (int b = 0; b < 8; ++b) mod[(size_t)(l * 8 + b) * NMOD + j] = acc[b] + bias;
            __syncthreads();
        }
    }
    {
        LAS float* scr = (LAS float*)(lds + 32768 + wave * 8448);
        constexpr int I_IN = 16 * 136, I_BR = 8 * 32, I_OUT = 16 * 32, I_Q = 16 * 64, I_L = I_IN + 2 * I_BR + I_OUT + I_Q;
        for (int it = gw; it < DEPTH * I_L; it += NGW) {
            const int l = it / I_L; int r = it % I_L;
            if (r < I_IN) { transpose_item<true>(a.w_in + (size_t)l * 1024 * NPROJ, 1024, NPROJ, (bf16_t*)(ws + WS_WIN) + (size_t)l * NPROJ * 1024, scr, r, lane); continue; } r -= I_IN;
            if (r < I_BR) { transpose_item<false>(a.wbr_a + (size_t)l * 512 * 1024, 512, 1024, (bf16_t*)(ws + WS_WBA) + (size_t)l * 1024 * 512, scr, r, lane); continue; } r -= I_BR;
            if (r < I_BR) { transpose_item<false>(a.wbr_b + (size_t)l * 512 * 1024, 512, 1024, (bf16_t*)(ws + WS_WBB) + (size_t)l * 1024 * 512, scr, r, lane); continue; } r -= I_BR;
            if (r < I_OUT) { transpose_item<false>(a.w_out + (size_t)l * 1024 * 1024, 1024, 1024, (bf16_t*)(ws + WS_WOUT) + (size_t)l * 1024 * 1024, scr, r, lane); continue; } r -= I_OUT;
            transpose_item<false>(a.wq + (size_t)l * 1024 * PQ, 1024, PQ, (bf16_t*)(ws + WS_WQ) + (size_t)l * PQ * 1024, scr, r, lane);
        }
    }
    {
        const int gt = blockIdx.x * NTHREADS + tid, NGT = G * NTHREADS;
        for (int i = gt; i < DEPTH * 8 * 2 * 128 * 128 / 8; i += NGT) {
            const f32x4 v0 = *(const f32x4*)(a.subkeys + (size_t)i * 8), v1 = *(const f32x4*)(a.subkeys + (size_t)i * 8 + 4);
            u32x4 o; o.x = pk2(v0.x, v0.y); o.y = pk2(v0.z, v0.w); o.z = pk2(v1.x, v1.y); o.w = pk2(v1.z, v1.w);
            *(u32x4*)((bf16_t*)(ws + WS_SK) + (size_t)i * 8) = o;
        }
        for (int i = gt; i < T * 32; i += NGT) {
            const int t = i >> 5, f = i & 31;
            double inv = 1.0;
            for (int k = 0; k < f; ++k) inv *= 0.7498942093324559;
            const double ang = (double)a.pos[t] * inv;
            const double kq = rint(ang * 0.63661977236758134308);
            const double r = fma(-kq, 6.123233995736766036e-17, fma(-kq, 1.57079632679489655800, ang));
            const int quad = (int)((long long)kq & 3);
            const double r2 = r * r;
            double sp = -1.0 / 1307674368000.0; sp = fma(sp, r2, 1.0 / 6227020800.0); sp = fma(sp, r2, -1.0 / 39916800.0); sp = fma(sp, r2, 1.0 / 362880.0);
            sp = fma(sp, r2, -1.0 / 5040.0); sp = fma(sp, r2, 1.0 / 120.0); sp = fma(sp, r2, -1.0 / 6.0); sp = fma(sp * r2, r, r);
            double cp = 1.0 / 20922789888000.0; cp = fma(cp, r2, -1.0 / 87178291200.0); cp = fma(cp, r2, 1.0 / 479001600.0); cp = fma(cp, r2, -1.0 / 3628800.0);
            cp = fma(cp, r2, 1.0 / 40320.0); cp = fma(cp, r2, -1.0 / 720.0); cp = fma(cp, r2, 1.0 / 24.0); cp = fma(cp, r2, -0.5); cp = fma(cp, r2, 1.0);
            const double sn = (quad == 0) ? sp : (quad == 1) ? cp : (quad == 2) ? -sp : -cp;
            const double cs = (quad == 0) ? cp : (quad == 1) ? -sp : (quad == 2) ? -cp : sp;
            float* rp = (float*)(ws + WS_ROPE) + (size_t)i * 2; rp[0] = (float)cs; rp[1] = (float)sn;
        }
    }
    for (int r = gw; r < DEPTH * 2 * NEXP; r += NGW) {
        const int tbl = r / (DEPTH * NEXP), lr = r % (DEPTH * NEXP);
        const float* src = (tbl == 0 ? a.pu : a.pv) + (size_t)lr * 1024;
        f32x4 v[4];
        if (tbl == 0) {
#pragma unroll
            for (int i = 0; i < 4; ++i) v[i] = ((const f32x4*)src)[64 * i + lane];
            quant_row<false>(v, ws + WS_UQ + (size_t)lr * 1024, (float*)(ws + WS_USC) + lr, lane);
        } else {
#pragma unroll
            for (int i = 0; i < 4; ++i) v[i] = ((const f32x4*)src)[4 * lane + i];
            const int l = lr / NEXP, e = lr % NEXP;
            quant_row<true>(v, ws + WS_VQ + (size_t)l * NEXP * 1024 + ((size_t)(lane >> 3) * NEXP + e) * 128 + 16 * (lane & 7) - 16 * lane, (float*)(ws + WS_VSC) + lr, lane);
        }
    }
    if (blockIdx.x == 0) for (int i = tid; i < DEPTH * 2 * 8 * 64; i += NTHREADS) ((unsigned*)(ws + WS_CTL))[CTL_QUEUE + i] = 0u;
}

template <bool WITH_Q8>
__device__ __forceinline__ void ph_norm(const KArgs& a, const float* xin, const float* g, const float* mod_l, int shift_idx, int scale_idx) {
    int tid_op = threadIdx.x; asm volatile("" : "+v"(tid_op)); const int tid = tid_op, lane = tid & 63, wave = tid >> 6;
    const int gw = blockIdx.x * NWAVES + wave, NGW = gridDim.x * NWAVES;
    bf16_t* H = (bf16_t*)(a.ws + WS_H);
    for (int row = gw; row < T; row += NGW) {
        const int b = row >> 12;
        f32x4 v[4]; float ss = 0.f;
#pragma unroll
        for (int i = 0; i < 4; ++i) { v[i] = ((const f32x4*)(xin + (size_t)row * DM))[64 * i + lane]; ss += (v[i].x * v[i].x + v[i].y * v[i].y) + (v[i].z * v[i].z + v[i].w * v[i].w); }
        ss = wave_sum(ss);
        const float r = 1.0f / sqrtf(ss * (1.0f / DM) + NORM_EPS);
#pragma unroll
        for (int i = 0; i < 4; ++i) {
            const int col = 256 * i + 4 * lane;
            const f32x4 gg = *(const f32x4*)(g + col), sc = *(const f32x4*)(mod_l + (size_t)b * NMOD + scale_idx * DM + col), sh = *(const f32x4*)(mod_l + (size_t)b * NMOD + shift_idx * DM + col);
            v[i] = (v[i] * r) * gg * (sc + 1.0f) + sh;
            u32x2 o; o.x = pk2(v[i].x, v[i].y); o.y = pk2(v[i].z, v[i].w);
            *(u32x2*)(H + (size_t)row * DM + col) = o;
        }
        if (WITH_Q8) quant_row<false>(v, a.ws + WS_H2Q + (size_t)row * 1024, (float*)(a.ws + WS_HS) + row, lane);
    }
}
__device__ __forceinline__ void ph_final_norm(const KArgs& a) {
    int tid_op = threadIdx.x; asm volatile("" : "+v"(tid_op)); const int tid = tid_op, lane = tid & 63, wave = tid >> 6;
    const int gw = blockIdx.x * NWAVES + wave, NGW = gridDim.x * NWAVES;
    for (int row = gw; row < T; row += NGW) {
        f32x4 v[4]; float ss = 0.f;
#pragma unroll
        for (int i = 0; i < 4; ++i) { v[i] = ((const f32x4*)(a.out + (size_t)row * DM))[64 * i + lane]; ss += (v[i].x * v[i].x + v[i].y * v[i].y) + (v[i].z * v[i].z + v[i].w * v[i].w); }
        ss = wave_sum(ss);
        const float r = 1.0f / sqrtf(ss * (1.0f / DM) + NORM_EPS);
#pragma unroll
        for (int i = 0; i < 4; ++i) { const f32x4 gg = *(const f32x4*)(a.final_g + 256 * i + 4 * lane); ((f32x4*)(a.out + (size_t)row * DM))[64 * i + lane] = (v[i] * r) * gg; }
    }
}

struct EpiProj {
    static constexpr bool PERM = true, AFTER_DRAIN = false;
    unsigned char* ws;
    __device__ __forceinline__ void operator()(const pg8::f32x4 (&acc)[2][2][4][2], const pg8::Unit& u, int wr, int wc, int fr, int fq) const {
        const int row0 = u.pm * 256 + wr * 64 + fr;
        const float* rope = (const float*)(ws + WS_ROPE);
#pragma unroll
        for (int bj = 0; bj < 2; ++bj) {
            const int cgb = u.pn * 256 + bj * 128;
            bf16_t* base; int pitch, cl, mode;
            if (cgb < 512) { base = (bf16_t*)(ws + WS_QA); pitch = 512; cl = cgb; mode = 1; }
            else if (cgb < 640) { base = (bf16_t*)(ws + WS_KA); pitch = 128; cl = cgb - 512; mode = 2; }
            else if (cgb < 768) { base = (bf16_t*)(ws + WS_VA); pitch = 128; cl = cgb - 640; mode = 0; }
            else if (cgb < 1280) { base = (bf16_t*)(ws + WS_QB); pitch = 512; cl = cgb - 768; mode = 3; }
            else if (cgb < 1792) { base = (bf16_t*)(ws + WS_KB); pitch = 512; cl = cgb - 1280; mode = 0; }
            else if (cgb < 2304) { base = (bf16_t*)(ws + WS_VB); pitch = 512; cl = cgb - 1792; mode = 0; }
            else if (cgb < 3328) { base = (bf16_t*)(ws + WS_GA); pitch = 1024; cl = cgb - 2304; mode = 4; }
            else { base = (bf16_t*)(ws + WS_GB); pitch = 1024; cl = cgb - 3328; mode = 4; }
            const int col = cl + wc * 32 + 8 * fq;
#pragma unroll
            for (int ai = 0; ai < 2; ++ai)
#pragma unroll
                for (int m = 0; m < 4; ++m) {
                    const int row = row0 + ai * 128 + m * 16;
                    pg8::f32x4 v0 = acc[ai][bj][m][0], v1 = acc[ai][bj][m][1];
                    if (mode == 1 || mode == 2) {
                        const int i0 = (col & 63) >> 1;
                        const f32x4 c01 = *(const f32x4*)(rope + ((size_t)row * 32 + i0) * 2), c23 = *(const f32x4*)(rope + ((size_t)row * 32 + i0 + 2) * 2);
                        pg8::f32x4 w0, w1;
                        w0[0] = v0[0] * c01.x - v0[1] * c01.y; w0[1] = v0[1] * c01.x + v0[0] * c01.y;
                        w0[2] = v0[2] * c01.z - v0[3] * c01.w; w0[3] = v0[3] * c01.z + v0[2] * c01.w;
                        w1[0] = v1[0] * c23.x - v1[1] * c23.y; w1[1] = v1[1] * c23.x + v1[0] * c23.y;
                        w1[2] = v1[2] * c23.z - v1[3] * c23.w; w1[3] = v1[3] * c23.z + v1[2] * c23.w;
                        v0 = w0; v1 = w1;
                    }
                    if (mode == 1 || mode == 3) { v0 = v0 * QSCALE; v1 = v1 * QSCALE; }
                    if (mode == 4) {
#pragma unroll
                        for (int e = 0; e < 4; ++e) { v0[e] = 1.0f / (1.0f + __expf(-v0[e])); v1[e] = 1.0f / (1.0f + __expf(-v1[e])); }
                    }
                    u32x4 w; w.x = pk2(v0[0], v0[1]); w.y = pk2(v0[2], v0[3]); w.z = pk2(v1[0], v1[1]); w.w = pk2(v1[2], v1[3]);
                    *(u32x4*)(base + (size_t)row * pitch + col) = w;
                }
        }
    }
};
template <bool ADD> struct EpiBranch {
    static constexpr bool PERM = true, AFTER_DRAIN = false;
    const bf16_t* Gt; bf16_t* O;
    __device__ __forceinline__ void operator()(const pg8::f32x4 (&acc)[2][2][4][2], const pg8::Unit& u, int wr, int wc, int fr, int fq) const {
        const int row0 = u.pm * 256 + wr * 64 + fr, col0 = u.pn * 256 + wc * 32 + 8 * fq;
#pragma unroll
        for (int ai = 0; ai < 2; ++ai)
#pragma unroll
            for (int m = 0; m < 4; ++m)
#pragma unroll
                for (int bj = 0; bj < 2; ++bj) {
                    const size_t off = (size_t)(row0 + ai * 128 + m * 16) * DM + col0 + bj * 128;
                    const u32x4 gv = *(const u32x4*)(Gt + off);
                    const pg8::f32x4 v0 = acc[ai][bj][m][0], v1 = acc[ai][bj][m][1];
                    float r[8];
                    r[0] = bflo(gv.x) * v0[0]; r[1] = bfhi(gv.x) * v0[1]; r[2] = bflo(gv.y) * v0[2]; r[3] = bfhi(gv.y) * v0[3];
                    r[4] = bflo(gv.z) * v1[0]; r[5] = bfhi(gv.z) * v1[1]; r[6] = bflo(gv.w) * v1[2]; r[7] = bfhi(gv.w) * v1[3];
                    if (ADD) { const u32x4 ov = *(const u32x4*)(O + off);
                        r[0] += bflo(ov.x); r[1] += bfhi(ov.x); r[2] += bflo(ov.y); r[3] += bfhi(ov.y); r[4] += bflo(ov.z); r[5] += bfhi(ov.z); r[6] += bflo(ov.w); r[7] += bfhi(ov.w); }
                    u32x4 w; w.x = pk2(r[0], r[1]); w.y = pk2(r[2], r[3]); w.z = pk2(r[4], r[5]); w.w = pk2(r[6], r[7]);
                    *(u32x4*)(O + off) = w;
                }
    }
};
struct EpiWout {
    static constexpr bool PERM = false, AFTER_DRAIN = false;
    const float* xold; float* xnew; const float* gate;
    __device__ __forceinline__ void operator()(const pg8::f32x4 (&acc)[2][2][4][2], const pg8::Unit& u, int wr, int wc, int fr, int fq) const {
        const int row0 = u.pm * 256 + wr * 64 + fr, col0 = u.pn * 256 + wc * 32 + 4 * fq, b = u.pm >> 4;
#pragma unroll
        for (int bj = 0; bj < 2; ++bj)
#pragma unroll
            for (int n = 0; n < 2; ++n) {
                const pg8::f32x4 gv = *(const pg8::f32x4*)(gate + (size_t)b * NMOD + col0 + bj * 128 + n * 16);
#pragma unroll
                for (int ai = 0; ai < 2; ++ai)
#pragma unroll
                    for (int m = 0; m < 4; ++m) { const size_t off = (size_t)(row0 + ai * 128 + m * 16) * DM + col0 + bj * 128 + n * 16;
                        const pg8::f32x4 xo = *(const pg8::f32x4*)(xold + off);
                        *(pg8::f32x4*)(xnew + off) = xo + gv * acc[ai][bj][m][n]; }
            }
    }
};
struct EpiPlainBf16 {
    static constexpr bool PERM = true, AFTER_DRAIN = false;
    bf16_t* O; int ldc;
    __device__ __forceinline__ void operator()(const pg8::f32x4 (&acc)[2][2][4][2], const pg8::Unit& u, int wr, int wc, int fr, int fq) const {
        const int row0 = u.pm * 256 + wr * 64 + fr, col0 = u.pn * 256 + wc * 32 + 8 * fq;
#pragma unroll
        for (int ai = 0; ai < 2; ++ai)
#pragma unroll
            for (int m = 0; m < 4; ++m)
#pragma unroll
                for (int bj = 0; bj < 2; ++bj) {
                    const pg8::f32x4 v0 = acc[ai][bj][m][0], v1 = acc[ai][bj][m][1];
                    u32x4 w; w.x = pk2(v0[0], v0[1]); w.y = pk2(v0[2], v0[3]); w.z = pk2(v1[0], v1[1]); w.w = pk2(v1[2], v1[3]);
                    *(u32x4*)(O + (size_t)(row0 + ai * 128 + m * 16) * ldc + col0 + bj * 128) = w;
                }
    }
};

namespace att {
typedef short bf16x8 __attribute__((ext_vector_type(8)));
typedef short s16x4 __attribute__((ext_vector_type(4)));
typedef float f32x16 __attribute__((ext_vector_type(16)));
__device__ __forceinline__ int crow(int r, int hi) { return (r & 3) + 8 * (r >> 2) + 4 * hi; }
typedef float f32x2_t __attribute__((ext_vector_type(2))); typedef __bf16 bf16x2_t __attribute__((ext_vector_type(2)));
__device__ __forceinline__ unsigned cvtpk(float lo, float hi) { f32x2_t v = {lo, hi}; bf16x2_t b = __builtin_convertvector(v, bf16x2_t); return __builtin_bit_cast(unsigned, b); }
#define ATT_SBAR() __builtin_amdgcn_sched_barrier(0)

__device__ __forceinline__ void qkt(f32x16& p0, f32x16& p1, const LAS unsigned char* kslot, const bf16x8 (&qr)[4], int r32, int hi) {
    const LAS unsigned char* kb = kslot + hi * 1024 + r32 * 16;
    p0 = f32x16{}; p1 = f32x16{};
#pragma unroll
    for (int d0 = 0; d0 < 4; ++d0) {
        const bf16x8 b0 = *(const LAS bf16x8*)(kb + d0 * 2048);
        const bf16x8 b1 = *(const LAS bf16x8*)(kb + d0 * 2048 + 512);
        p0 = __builtin_amdgcn_mfma_f32_32x32x16_bf16(b0, qr[d0], p0, 0, 0, 0);
        p1 = __builtin_amdgcn_mfma_f32_32x32x16_bf16(b1, qr[d0], p1, 0, 0, 0);
    }
}
__device__ __forceinline__ void pv(f32x16 (&o)[2], int vb, bf16x8 pa0, bf16x8 pa1, bf16x8 pa2, bf16x8 pa3) {
#pragma unroll
    for (int d0 = 0; d0 < 2; ++d0) {
        s16x4 lo[4], hh[4];
#pragma unroll
        for (int ks = 0; ks < 4; ++ks) {
            asm volatile("ds_read_b64_tr_b16 %0,%1 offset:%c2" : "=&v"(lo[ks]) : "v"(vb), "i"(d0 * 4096 + ks * 1024) : "memory");
            asm volatile("ds_read_b64_tr_b16 %0,%1 offset:%c2" : "=&v"(hh[ks]) : "v"(vb), "i"(d0 * 4096 + ks * 1024 + 512) : "memory");
        }
        asm volatile("s_waitcnt lgkmcnt(0)" ::: "memory"); ATT_SBAR();
#define ATT_PK(k) (bf16x8){lo[k][0], lo[k][1], lo[k][2], lo[k][3], hh[k][0], hh[k][1], hh[k][2], hh[k][3]}
        o[d0] = __builtin_amdgcn_mfma_f32_32x32x16_bf16(pa0, ATT_PK(0), o[d0], 0, 0, 0);
        o[d0] = __builtin_amdgcn_mfma_f32_32x32x16_bf16(pa1, ATT_PK(1), o[d0], 0, 0, 0);
        o[d0] = __builtin_amdgcn_mfma_f32_32x32x16_bf16(pa2, ATT_PK(2), o[d0], 0, 0, 0);
        o[d0] = __builtin_amdgcn_mfma_f32_32x32x16_bf16(pa3, ATT_PK(3), o[d0], 0, 0, 0);
#undef ATT_PK
    }
}
__device__ __forceinline__ void pack_p(const f32x16& p0, const f32x16& p1, bf16x8& pa0, bf16x8& pa1, bf16x8& pa2, bf16x8& pa3) {
    u32x4 w0, w1, w2, w3;
    w0 = (u32x4){cvtpk(p0[0], p0[1]), cvtpk(p0[2], p0[3]), cvtpk(p0[4], p0[5]), cvtpk(p0[6], p0[7])};
    w1 = (u32x4){cvtpk(p0[8], p0[9]), cvtpk(p0[10], p0[11]), cvtpk(p0[12], p0[13]), cvtpk(p0[14], p0[15])};
    w2 = (u32x4){cvtpk(p1[0], p1[1]), cvtpk(p1[2], p1[3]), cvtpk(p1[4], p1[5]), cvtpk(p1[6], p1[7])};
    w3 = (u32x4){cvtpk(p1[8], p1[9]), cvtpk(p1[10], p1[11]), cvtpk(p1[12], p1[13]), cvtpk(p1[14], p1[15])};
    pa0 = __builtin_bit_cast(bf16x8, w0); pa1 = __builtin_bit_cast(bf16x8, w1); pa2 = __builtin_bit_cast(bf16x8, w2); pa3 = __builtin_bit_cast(bf16x8, w3);
}
__device__ __forceinline__ u32x4 tile_gload(const bf16_t* src, int pitch, int tid) { return *(const u32x4*)(src + (size_t)(tid >> 3) * pitch + (tid & 7) * 8); }
__device__ __forceinline__ void tile_kwrite(LAS unsigned char* kslot, u32x4 v, int tid) { *(LAS u32x4*)(kslot + (tid & 7) * 1024 + (tid >> 3) * 16) = v; }
__device__ __forceinline__ void tile_vwrite(LAS unsigned char* vslot, u32x4 v, int tid) { const int c = tid & 7; *(LAS u32x4*)(vslot + (c >> 2) * 4096 + (tid >> 3) * 64 + (c & 3) * 16) = v; }
__device__ __forceinline__ void store_o(const f32x16 (&o)[2], const float (&rs)[16], LAS unsigned char* stage, bf16_t* Ow, int pitch, int lane) {
    const int r32 = lane & 31, hi = lane >> 5;
    LAS bf16_t* stg = (LAS bf16_t*)stage;
#pragma unroll
    for (int r = 0; r < 16; ++r) { const int orow = crow(r, hi);
#pragma unroll
        for (int d0 = 0; d0 < 2; ++d0) stg[orow * 64 + d0 * 32 + r32] = (bf16_t)f2bf(o[d0][r] * rs[r]); }
    asm volatile("s_waitcnt lgkmcnt(0)" ::: "memory");
#pragma unroll
    for (int i = 0; i < 4; ++i) { const int row = i * 8 + (lane >> 3), ch = lane & 7; const u32x4 v = *(const LAS u32x4*)(stg + row * 64 + ch * 8); *(u32x4*)(Ow + (size_t)row * pitch + ch * 8) = v; }
    asm volatile("s_waitcnt lgkmcnt(0)" ::: "memory");
}

constexpr int SB_K0 = 0, SB_V0 = 16384, SB_STAGE = 32768, SB_FLAGS = 65536, SB_LDS_END = 65536 + 64;
template <bool EARLY_EXIT>
__device__ __forceinline__ void sb_phase(const bf16_t* Q, const bf16_t* K, const bf16_t* V, bf16_t* O, LAS unsigned char* lds) {
    int tid_op = threadIdx.x; asm volatile("" : "+v"(tid_op));
    const int tid = tid_op, lane = tid & 63, r32 = lane & 31, hi = lane >> 5, wid = __builtin_amdgcn_readfirstlane(tid >> 6);
    const int vb0 = (int)(unsigned)(uintptr_t)(lds + SB_V0) + ((lane >> 4) & 1) * 32 + (lane & 3) * 8 + (4 * hi + ((lane & 15) >> 2)) * 64;
    volatile LAS unsigned* flags = (volatile LAS unsigned*)(lds + SB_FLAGS);
    const float m0 = hi == 0 ? 1.0f : 0.0f;
    for (int unit = blockIdx.x; unit < BATCH * 8 * 16; unit += gridDim.x) {
        const int qb = unit & 15, h = (unit >> 4) & 7, b = unit >> 7;
        const int q0 = qb * 256;
        const size_t rowbase = (size_t)b * SEQ;
        const bf16_t* Kh = K + rowbase * 512 + h * 64; const bf16_t* Vh = V + rowbase * 512 + h * 64;
        const bf16_t* Qw = Q + (rowbase + q0 + wid * 32) * 512 + h * 64;
        int kt = 4 * qb + 3;
        u32x4 kreg = tile_gload(Kh + (size_t)kt * 64 * 512, 512, tid), vreg = tile_gload(Vh + (size_t)kt * 64 * 512, 512, tid);
        bf16x8 qr[4];
#pragma unroll
        for (int d0 = 0; d0 < 4; ++d0) qr[d0] = *(const bf16x8*)(Qw + (size_t)r32 * 512 + d0 * 16 + hi * 8);
        if (tid < 16) flags[tid] = 0u;
        tile_kwrite(lds + SB_K0, kreg, tid); tile_vwrite(lds + SB_V0, vreg, tid);
        f32x16 o[2]; o[0] = f32x16{}; o[1] = f32x16{};
        float carry = 0.f;
        int cur = 0, it = 0;
        for (;;) {
            __syncthreads();
            if (EARLY_EXIT && it > 0) {
                const int fs = ((it - 1) & 1) * 8;
                unsigned all = 1u;
#pragma unroll
                for (int w = 0; w < 8; ++w) all &= flags[fs + w];
                if (all) break;
            }
            const bool more = kt > 0;
            if (more) { kreg = tile_gload(Kh + (size_t)(kt - 1) * 64 * 512, 512, tid); vreg = tile_gload(Vh + (size_t)(kt - 1) * 64 * 512, 512, tid); }
            const int D = q0 + 32 * wid - 64 * kt;
            if (D + 31 > 0) {
                f32x16 p0, p1;
                qkt(p0, p1, lds + SB_K0 + cur * 8192, qr, r32, hi);
                if (D < 64) {
                    const int qrel = D + r32;
#pragma unroll
                    for (int r = 0; r < 16; ++r) { const int kv = crow(r, hi); if (kv >= qrel) p0[r] = -INFINITY; if (kv + 32 >= qrel) p1[r] = -INFINITY; }
                }
                f32x16 l0, l1;
#pragma unroll
                for (int r = 0; r < 16; ++r) { l0[r] = fmaxf(p0[r], 0.f) + __log2f(1.0f + exp2f(-fabsf(p0[r]))); l1[r] = fmaxf(p1[r], 0.f) + __log2f(1.0f + exp2f(-fabsf(p1[r]))); }
                float tt[8], uu[8];
#pragma unroll
                for (int i = 0; i < 4; ++i) { tt[i] = (l0[4 * i] + l0[4 * i + 1]) + (l0[4 * i + 2] + l0[4 * i + 3]); tt[4 + i] = (l1[4 * i] + l1[4 * i + 1]) + (l1[4 * i + 2] + l1[4 * i + 3]); }
#pragma unroll
                for (int k = 0; k < 8; ++k) { auto rr = __builtin_amdgcn_permlane32_swap(__float_as_uint(tt[k]), __float_as_uint(tt[k]), false, false); uu[k] = __uint_as_float(hi ? rr[0] : rr[1]); }
                float sw = 0.f, base[8];
#pragma unroll
                for (int k = 7; k >= 0; --k) { base[k] = carry - (sw + m0 * uu[k]); sw += tt[k] + uu[k]; }
#pragma unroll
                for (int i = 0; i < 4; ++i) {
                    float s3 = l0[4 * i + 3], s2 = s3 + l0[4 * i + 2], s1 = s2 + l0[4 * i + 1], s0 = s1 + l0[4 * i];
                    p0[4 * i + 3] = exp2f(p0[4 * i + 3] + (base[i] - s3)); p0[4 * i + 2] = exp2f(p0[4 * i + 2] + (base[i] - s2));
                    p0[4 * i + 1] = exp2f(p0[4 * i + 1] + (base[i] - s1)); p0[4 * i] = exp2f(p0[4 * i] + (base[i] - s0));
                    s3 = l1[4 * i + 3]; s2 = s3 + l1[4 * i + 2]; s1 = s2 + l1[4 * i + 1]; s0 = s1 + l1[4 * i];
                    p1[4 * i + 3] = exp2f(p1[4 * i + 3] + (base[4 + i] - s3)); p1[4 * i + 2] = exp2f(p1[4 * i + 2] + (base[4 + i] - s2));
                    p1[4 * i + 1] = exp2f(p1[4 * i + 1] + (base[4 + i] - s1)); p1[4 * i] = exp2f(p1[4 * i] + (base[4 + i] - s0));
                }
                carry -= sw;
                bf16x8 pa0, pa1, pa2, pa3; pack_p(p0, p1, pa0, pa1, pa2, pa3);
                pv(o, vb0 + cur * 8192, pa0, pa1, pa2, pa3);
            }
            if (EARLY_EXIT) { const bool done = __all(carry < -SB_EXIT); if (lane == 0) flags[(it & 1) * 8 + wid] = done ? 1u : 0u; }
            if (!more) break;
            tile_kwrite(lds + SB_K0 + (cur ^ 1) * 8192, kreg, tid); tile_vwrite(lds + SB_V0 + (cur ^ 1) * 8192, vreg, tid);
            cur ^= 1; --kt; ++it;
        }
        float ones[16];
#pragma unroll
        for (int r = 0; r < 16; ++r) ones[r] = 1.0f;
        store_o(o, ones, lds + SB_STAGE + wid * 4096, O + (rowbase + q0 + wid * 32) * 512 + h * 64, 512, lane);
        __syncthreads();
    }
}

constexpr int SW_K0 = 0, SW_V0 = 24576, SW_STAGE = 49152, SW_WSF = 81920, SW_LDS_END = 81920 + 2048;
__device__ __forceinline__ void swa_phase(const bf16_t* Q, const bf16_t* K, const bf16_t* V, bf16_t* O, const float* sinks, LAS unsigned char* lds) {
    int tid_op = threadIdx.x; asm volatile("" : "+v"(tid_op));
    const int tid = tid_op, lane = tid & 63, r32 = lane & 31, hi = lane >> 5, wid = __builtin_amdgcn_readfirstlane(tid >> 6);
    const int vb0 = (int)(unsigned)(uintptr_t)(lds + SW_V0) + ((lane >> 4) & 1) * 32 + (lane & 3) * 8 + (4 * hi + ((lane & 15) >> 2)) * 64;
    LAS float* wsf = (LAS float*)(lds + SW_WSF) + wid * 64;
    const int g = wid >> 1, j = wid & 1;
    for (int unit = blockIdx.x; unit < BATCH * 2 * 64; unit += gridDim.x) {
        const int qb = unit & 63, kvh = (unit >> 6) & 1, b = unit >> 7;
        const int q0 = qb * 64, hq = kvh * 4 + g;
        const size_t rowbase = (size_t)b * SEQ;
        const bf16_t* Kh = K + rowbase * 128 + kvh * 64; const bf16_t* Vh = V + rowbase * 128 + kvh * 64;
        const bf16_t* Qw = Q + (rowbase + q0 + j * 32) * 512 + hq * 64;
        __syncthreads();
#pragma unroll
        for (int i = 0; i < 3; ++i) { const int kt = qb - 2 + i;
            if (kt >= 0) { const u32x4 kv = tile_gload(Kh + (size_t)kt * 64 * 128, 128, tid), vv = tile_gload(Vh + (size_t)kt * 64 * 128, 128, tid);
                tile_kwrite(lds + SW_K0 + i * 8192, kv, tid); tile_vwrite(lds + SW_V0 + i * 8192, vv, tid); } }
        bf16x8 qr[4];
#pragma unroll
        for (int d0 = 0; d0 < 4; ++d0) qr[d0] = *(const bf16x8*)(Qw + (size_t)r32 * 512 + d0 * 16 + hi * 8);
        __syncthreads();
        const int qrel = 32 * j + r32;
        const float sink2 = sinks[hq] * LOG2E;
        float m = sink2;
#pragma unroll
        for (int i = 0; i < 3; ++i) {
            if (qb - 2 + i >= 0) {
                f32x16 p0, p1;
                qkt(p0, p1, lds + SW_K0 + i * 8192, qr, r32, hi);
#pragma unroll
                for (int r = 0; r < 16; ++r) { const int kv = crow(r, hi);
                    bool v0 = true, v1 = true;
                    if (i == 2) { v0 = kv <= qrel; v1 = kv + 32 <= qrel; }
                    if (i == 0) { v0 = kv > qrel; v1 = kv + 32 > qrel; }
                    m = fmaxf(m, fmaxf(v0 ? p0[r] : -INFINITY, v1 ? p1[r] : -INFINITY)); }
            }
        }
        { auto rr = __builtin_amdgcn_permlane32_swap(__float_as_uint(m), __float_as_uint(m), false, false); m = fmaxf(__uint_as_float(rr[0]), __uint_as_float(rr[1])); }
        float lsum = 0.f;
        f32x16 o[2]; o[0] = f32x16{}; o[1] = f32x16{};
#pragma unroll
        for (int i = 0; i < 3; ++i) {
            if (qb - 2 + i >= 0) {
                f32x16 p0, p1;
                qkt(p0, p1, lds + SW_K0 + i * 8192, qr, r32, hi);
#pragma unroll
                for (int r = 0; r < 16; ++r) { const int kv = crow(r, hi);
                    bool v0 = true, v1 = true;
                    if (i == 2) { v0 = kv <= qrel; v1 = kv + 32 <= qrel; }
                    if (i == 0) { v0 = kv > qrel; v1 = kv + 32 > qrel; }
                    p0[r] = v0 ? exp2f(p0[r] - m) : 0.f; p1[r] = v1 ? exp2f(p1[r] - m) : 0.f; lsum += p0[r] + p1[r]; }
                bf16x8 pa0, pa1, pa2, pa3; pack_p(p0, p1, pa0, pa1, pa2, pa3); pv(o, vb0 + i * 8192, pa0, pa1, pa2, pa3);
            }
        }
        { auto rr = __builtin_amdgcn_permlane32_swap(__float_as_uint(lsum), __float_as_uint(lsum), false, false); lsum = __uint_as_float(rr[0]) + __uint_as_float(rr[1]); }
        lsum += exp2f(sink2 - m);
        if (hi == 0) wsf[r32] = 1.0f / lsum;
        asm volatile("s_waitcnt lgkmcnt(0)" ::: "memory");
        float rs[16];
#pragma unroll
        for (int r = 0; r < 16; ++r) rs[r] = wsf[crow(r, hi)];
        asm volatile("s_waitcnt lgkmcnt(0)" ::: "memory");
        store_o(o, rs, lds + SW_STAGE + wid * 4096, O + (rowbase + q0 + j * 32) * 512 + hq * 64, 512, lane);
    }
}
#undef ATT_SBAR
}

namespace tk {
typedef short bf16x8 __attribute__((ext_vector_type(8)));
typedef float f32x16 __attribute__((ext_vector_type(16)));
__device__ __forceinline__ float vmax(float a, float b) { float r; asm("v_max_f32 %0, %1, %2" : "=v"(r) : "v"(a), "v"(b)); return r; }
__device__ __forceinline__ float vmin(float a, float b) { float r; asm("v_min_f32 %0, %1, %2" : "=v"(r) : "v"(a), "v"(b)); return r; }
#define TK_CE(a, b) { const float t_ = vmax(a, b); b = vmin(a, b); a = t_; }
__device__ __forceinline__ void sort16(float (&v)[16]) {
    TK_CE(v[0], v[1]) TK_CE(v[2], v[3]) TK_CE(v[0], v[2]) TK_CE(v[1], v[3]) TK_CE(v[1], v[2]) TK_CE(v[4], v[5]) TK_CE(v[6], v[7]) TK_CE(v[4], v[6])
    TK_CE(v[5], v[7]) TK_CE(v[5], v[6]) TK_CE(v[0], v[4]) TK_CE(v[2], v[6]) TK_CE(v[2], v[4]) TK_CE(v[1], v[5]) TK_CE(v[3], v[7]) TK_CE(v[3], v[5])
    TK_CE(v[1], v[2]) TK_CE(v[3], v[4]) TK_CE(v[5], v[6]) TK_CE(v[8], v[9]) TK_CE(v[10], v[11]) TK_CE(v[8], v[10]) TK_CE(v[9], v[11]) TK_CE(v[9], v[10])
    TK_CE(v[12], v[13]) TK_CE(v[14], v[15]) TK_CE(v[12], v[14]) TK_CE(v[13], v[15]) TK_CE(v[13], v[14]) TK_CE(v[8], v[12]) TK_CE(v[10], v[14]) TK_CE(v[10], v[12])
    TK_CE(v[9], v[13]) TK_CE(v[11], v[15]) TK_CE(v[11], v[13]) TK_CE(v[9], v[10]) TK_CE(v[11], v[12]) TK_CE(v[13], v[14]) TK_CE(v[0], v[8]) TK_CE(v[4], v[12])
    TK_CE(v[4], v[8]) TK_CE(v[2], v[10]) TK_CE(v[6], v[14]) TK_CE(v[6], v[10]) TK_CE(v[2], v[4]) TK_CE(v[6], v[8]) TK_CE(v[10], v[12]) TK_CE(v[1], v[9])
    TK_CE(v[5], v[13]) TK_CE(v[5], v[9]) TK_CE(v[3], v[11]) TK_CE(v[7], v[15]) TK_CE(v[7], v[11]) TK_CE(v[3], v[5]) TK_CE(v[7], v[9]) TK_CE(v[11], v[13])
    TK_CE(v[1], v[2]) TK_CE(v[3], v[4]) TK_CE(v[5], v[6]) TK_CE(v[7], v[8]) TK_CE(v[9], v[10]) TK_CE(v[11], v[12]) TK_CE(v[13], v[14])
}
__device__ __forceinline__ void bmerge16(float (&v)[16]) {
    TK_CE(v[0], v[8]) TK_CE(v[1], v[9]) TK_CE(v[2], v[10]) TK_CE(v[3], v[11]) TK_CE(v[4], v[12]) TK_CE(v[5], v[13]) TK_CE(v[6], v[14]) TK_CE(v[7], v[15])
    TK_CE(v[0], v[4]) TK_CE(v[1], v[5]) TK_CE(v[2], v[6]) TK_CE(v[3], v[7]) TK_CE(v[8], v[12]) TK_CE(v[9], v[13]) TK_CE(v[10], v[14]) TK_CE(v[11], v[15])
    TK_CE(v[0], v[2]) TK_CE(v[1], v[3]) TK_CE(v[4], v[6]) TK_CE(v[5], v[7]) TK_CE(v[8], v[10]) TK_CE(v[9], v[11]) TK_CE(v[12], v[14]) TK_CE(v[13], v[15])
    TK_CE(v[0], v[1]) TK_CE(v[2], v[3]) TK_CE(v[4], v[5]) TK_CE(v[6], v[7]) TK_CE(v[8], v[9]) TK_CE(v[10], v[11]) TK_CE(v[12], v[13]) TK_CE(v[14], v[15])
}

__device__ __forceinline__ void merge_top16(float (&a)[16], const float (&b)[16]) {
#pragma unroll
    for (int i = 0; i < 16; ++i) a[i] = vmax(a[i], b[15 - i]);
    bmerge16(a);
}
__device__ __forceinline__ float partner_f(float v, int hi) { auto rr = __builtin_amdgcn_permlane32_swap(__float_as_uint(v), __float_as_uint(v), false, false); return __uint_as_float(hi ? rr[0] : rr[1]); }
__device__ __forceinline__ void merge_partner(float (&a)[16], int hi) {
    float pp[16];
#pragma unroll
    for (int i = 0; i < 16; ++i) pp[i] = partner_f(a[i], hi);
    merge_top16(a, pp);
}
__device__ __forceinline__ void take_block(float (&v)[16], const f32x16& acc, int blk, unsigned hi4) {
#pragma unroll
    for (int r = 0; r < 16; ++r) { const unsigned code = 127u - (unsigned)(32 * blk + (r & 3) + 8 * (r >> 2)); v[r] = __uint_as_float(((__float_as_uint(acc[r]) & 0xFFFFFF80u) | code) ^ hi4); }
    sort16(v);
}
constexpr int TK_SK = 0, TK_IDX = 65536, TK_LDS_END = 65536 + 8192;
constexpr float TK_NEG = -3.4028234663852886e38f;
template <int P>
__device__ __forceinline__ void half_top16(float (&L)[16], const bf16_t* qrow, LAS unsigned char* lds, LAS unsigned char* idxslot, int r32, int hi) {
    bf16x8 qf[8];
#pragma unroll
    for (int ks = 0; ks < 8; ++ks) qf[ks] = *(const bf16x8*)(qrow + P * 128 + 16 * ks + 8 * hi);
    f32x16 acc[4];
#pragma unroll
    for (int blk = 0; blk < 4; ++blk) acc[blk] = f32x16{};
    const LAS unsigned char* ab = lds + TK_SK + P * 32768 + hi * 2048 + r32 * 16;
#pragma unroll
    for (int ks = 0; ks < 8; ++ks)
#pragma unroll
        for (int blk = 0; blk < 4; ++blk) {
            const bf16x8 af = *(const LAS bf16x8*)(ab + ks * 4096 + blk * 512);
            acc[blk] = __builtin_amdgcn_mfma_f32_32x32x16_bf16(af, qf[ks], acc[blk], 0, 0, 0);
        }
    const unsigned hi4 = (unsigned)hi << 2;
    float M[16];
    take_block(L, acc[0], 0, hi4); take_block(M, acc[1], 1, hi4); merge_top16(L, M);
    { float N[16]; take_block(M, acc[2], 2, hi4); take_block(N, acc[3], 3, hi4); merge_top16(M, N); }
    merge_top16(L, M);
    merge_partner(L, hi);
    if (hi == 0) {
        u32x4 w;
#pragma unroll
        for (int q = 0; q < 4; ++q) w[q] = (__float_as_uint(L[4 * q]) & 127u) | ((__float_as_uint(L[4 * q + 1]) & 127u) << 8) | ((__float_as_uint(L[4 * q + 2]) & 127u) << 16) | ((__float_as_uint(L[4 * q + 3]) & 127u) << 24);
        *(LAS u32x4*)(idxslot + P * 16) = w;
    }
}
__device__ __forceinline__ float cand(float x, float y, unsigned code, unsigned hi8) { return __uint_as_float((__float_as_uint(x + y) & 0xFFFFFE00u) | code | hi8); }

__device__ __forceinline__ void topk_phase(const bf16_t* Q2, const bf16_t* SKl, int* IDX, float* GATE, LAS unsigned char* lds) {
    int tid_op = threadIdx.x; asm volatile("" : "+v"(tid_op));
    const int tid = tid_op, lane = tid & 63, r32 = lane & 31, hi = lane >> 5, wid = __builtin_amdgcn_readfirstlane(tid >> 6);
    LAS unsigned char* idxslot = lds + TK_IDX + wid * 1024 + r32 * 32;
    int cur_h = -1;
    for (int unit = blockIdx.x; unit < 8 * (T / 256); unit += gridDim.x) {
        const int h = unit & 7, tb = unit >> 3;
        if (h != cur_h) {
            __syncthreads();
#pragma unroll
            for (int i = 0; i < 8; ++i) { const int id = tid + 512 * i, c = id & 15, n = (id >> 4) & 127, p = id >> 11;
                const u32x4 v = *(const u32x4*)(SKl + ((size_t)(h * 2 + p) * 128 + n) * 128 + c * 8);
                *(LAS u32x4*)(lds + TK_SK + p * 32768 + c * 2048 + n * 16) = v; }
            __syncthreads();
            cur_h = h;
        }
        const size_t token = (size_t)tb * 256 + wid * 32 + r32;
        const bf16_t* qrow = Q2 + token * PQ + h * 256;
        float a[16], b[16];
        half_top16<0>(a, qrow, lds, idxslot, r32, hi);
        half_top16<1>(b, qrow, lds, idxslot, r32, hi);
        float x[16], y[16];
#pragma unroll
        for (int i = 0; i < 16; ++i) { float av = a[i], bv = b[i]; asm volatile("" : "+v"(av), "+v"(bv)); x[i] = hi ? bv : av; y[i] = hi ? av : bv; }
        const unsigned hi8 = (unsigned)hi << 8;
        float A[16], B[16];
#pragma unroll
        for (int j = 1; j < 16; ++j) A[j - 1] = cand(x[0], y[j], (unsigned)j, hi8);
        A[15] = TK_NEG;
#pragma unroll
        for (int j = 2; j < 8; ++j) B[j - 2] = cand(x[1], y[j], (unsigned)(16 + j), hi8);
        B[6] = cand(x[2], y[3], 2u * 16u + 3u, hi8); B[7] = cand(x[2], y[4], 2u * 16u + 4u, hi8);
#pragma unroll
        for (int i = 0; i < 4; ++i) { const float d = cand(x[i], y[i], (unsigned)(17 * i), hi8); B[8 + i] = hi ? TK_NEG : d; }
        B[12] = TK_NEG; B[13] = TK_NEG; B[14] = TK_NEG; B[15] = TK_NEG;
        sort16(B);
        merge_top16(A, B);
        merge_partner(A, hi);
        const float smax = A[0];
        float ex[8]; int eidx[8]; float lsum = 0.f;
        asm volatile("s_waitcnt lgkmcnt(0)" ::: "memory");
#pragma unroll
        for (int k = 0; k < 8; ++k) {
            float s_lo = A[k], s_hi = A[8 + k]; asm volatile("" : "+v"(s_lo), "+v"(s_hi)); const float s = hi ? s_hi : s_lo;
            ex[k] = __expf(s - smax); lsum += ex[k];
            const unsigned code = __float_as_uint(s) & 0x1FFu, src = code >> 8, ci = (code >> 4) & 15u, cj = code & 15u;
            const unsigned ai = src ? cj : ci, bi = src ? ci : cj;
            const unsigned ca = idxslot[ai], cb = idxslot[16 + bi];
            eidx[k] = (int)(((ca ^ 127u) << 7) | (cb ^ 127u));
        }
        const float tot = lsum + partner_f(lsum, hi);
        const float inv = 1.0f / tot;
        int* ip = IDX + token * 128 + h * 16 + 8 * hi; float* gp = GATE + token * 128 + h * 16 + 8 * hi;
        *(u32x4*)ip = (u32x4){(unsigned)eidx[0], (unsigned)eidx[1], (unsigned)eidx[2], (unsigned)eidx[3]};
        *(u32x4*)(ip + 4) = (u32x4){(unsigned)eidx[4], (unsigned)eidx[5], (unsigned)eidx[6], (unsigned)eidx[7]};
        *(f32x4*)gp = (f32x4){ex[0] * inv, ex[1] * inv, ex[2] * inv, ex[3] * inv};
        *(f32x4*)(gp + 4) = (f32x4){ex[4] * inv, ex[5] * inv, ex[6] * inv, ex[7] * inv};
        asm volatile("s_waitcnt lgkmcnt(0)" ::: "memory");
    }
}
}

namespace peer2 {
__device__ __forceinline__ unsigned xcc_id() { return (unsigned)__builtin_amdgcn_s_getreg((3 << 11) | 20) & 7u; }
constexpr int CHUNK = 128, NCHUNK = T / CHUNK;
template <int CTRL> __device__ __forceinline__ float dpp_mov(float v) { return __int_as_float(__builtin_amdgcn_update_dpp(0, __float_as_int(v), CTRL, 0xF, 0xF, true)); }
__device__ __forceinline__ float wsum(float v) {
    v += dpp_mov<0xB1>(v);
    v += dpp_mov<0x4E>(v);
    v += dpp_mov<0x141>(v);
    v += dpp_mov<0x140>(v);
    { auto rr = __builtin_amdgcn_permlane16_swap(__float_as_uint(v), __float_as_uint(v), false, false); v = __uint_as_float(rr[0]) + __uint_as_float(rr[1]); }
    { auto rr = __builtin_amdgcn_permlane32_swap(__float_as_uint(v), __float_as_uint(v), false, false); v = __uint_as_float(rr[0]) + __uint_as_float(rr[1]); }
    return v;
}
__device__ __forceinline__ float gelu_erf(float d) { return 0.5f * d * (1.0f + erff(d * 0.70710678118654752f)); }

constexpr int UB = 24;
__device__ __forceinline__ void u_token(unsigned long long m0, unsigned long long m1, int idx0, int idx1, bool in0, bool in1, float& d0, float& d1, const unsigned char* UQ, const u32x4& hv, int lane) {
    const int c0 = __builtin_popcountll(m0);
    const int rank0 = in0 ? (int)__builtin_amdgcn_mbcnt_hi((unsigned)(m0 >> 32), __builtin_amdgcn_mbcnt_lo((unsigned)m0, 0u)) : -1;
    const int rank1 = in1 ? c0 + (int)__builtin_amdgcn_mbcnt_hi((unsigned)(m1 >> 32), __builtin_amdgcn_mbcnt_lo((unsigned)m1, 0u)) : -1;
    int n = c0 + __builtin_popcountll(m1), base = 0;
    while (n > 0) {
        u32x4 uv[UB];
#pragma unroll
        for (int j = 0; j < UB; ++j) {
            uv[j] = (u32x4){0u, 0u, 0u, 0u};
            if (j < n) {
                int e;
                if (m0) { const int k = __builtin_ctzll(m0); m0 &= m0 - 1; e = __builtin_amdgcn_readlane(idx0, k); }
                else { const int k = __builtin_ctzll(m1); m1 &= m1 - 1; e = __builtin_amdgcn_readlane(idx1, k); }
                uv[j] = *(const u32x4*)(UQ + (size_t)e * 1024 + 16 * lane);
            }
        }
        float f[UB];
#pragma unroll
        for (int j = 0; j < UB; ++j) {
            int is = __builtin_amdgcn_sdot4((int)uv[j].x, (int)hv.x, 0, false);
            is = __builtin_amdgcn_sdot4((int)uv[j].y, (int)hv.y, is, false);
            is = __builtin_amdgcn_sdot4((int)uv[j].z, (int)hv.z, is, false);
            is = __builtin_amdgcn_sdot4((int)uv[j].w, (int)hv.w, is, false);
            f[j] = wsum((float)is);
        }
#pragma unroll
        for (int j = 0; j < UB; ++j) { if (rank0 == base + j) d0 = f[j]; if (rank1 == base + j) d1 = f[j]; }
        n -= UB; base += UB;
    }
}
__device__ __forceinline__ void u_phase(const KArgs& a, int l, unsigned* cnt, LAS unsigned char* lds) {
    int tid_op = threadIdx.x; asm volatile("" : "+v"(tid_op));
    const int tid = tid_op, lane = tid & 63, wid = __builtin_amdgcn_readfirstlane(tid >> 6);
    const unsigned char* UQ = a.ws + WS_UQ + (size_t)l * NEXP * 1024;
    const float* USC = (const float*)(a.ws + WS_USC) + l * NEXP; const float* VSC = (const float*)(a.ws + WS_VSC) + l * NEXP;
    const int* IDX = (const int*)(a.ws + WS_IDX); const float* GATE = (const float*)(a.ws + WS_GATE);
    const unsigned char* HQ = a.ws + WS_H2Q; const float* HS = (const float*)(a.ws + WS_HS);
    float* COEF = (float*)(a.ws + WS_COEF);
    volatile LAS unsigned* bc = (volatile LAS unsigned*)lds;
    const unsigned home = xcc_id();
    constexpr int TPW = CHUNK / NWAVES;
    for (unsigned ss = 0; ss < 8; ++ss) {
        const unsigned s = (home + ss) & 7u;
        for (;;) {
            __syncthreads();
            if (tid == 0) bc[0] = __hip_atomic_fetch_add(cnt + 64 * s, 1u, __ATOMIC_RELAXED, __HIP_MEMORY_SCOPE_AGENT);
            __syncthreads();
            const unsigned chunk = bc[0];
            if (chunk >= (unsigned)NCHUNK) break;
            const size_t t0 = (size_t)chunk * CHUNK + wid * TPW;
            int idx0 = IDX[t0 * 128 + lane], idx1 = IDX[t0 * 128 + 64 + lane];
            u32x4 hv = *(const u32x4*)(HQ + t0 * 1024 + 16 * lane);
            float g0 = GATE[t0 * 128 + lane], g1 = GATE[t0 * 128 + 64 + lane], sh = HS[t0];
#pragma unroll 1
            for (int i = 0; i < TPW; ++i) {
                const size_t t = t0 + i, tn = t0 + (i + 1 < TPW ? i + 1 : i);
                const float us0 = USC[idx0], us1 = USC[idx1], vs0 = VSC[idx0], vs1 = VSC[idx1];
                const int nidx0 = IDX[tn * 128 + lane], nidx1 = IDX[tn * 128 + 64 + lane];
                const u32x4 nhv = *(const u32x4*)(HQ + tn * 1024 + 16 * lane);
                const float ng0 = GATE[tn * 128 + lane], ng1 = GATE[tn * 128 + 64 + lane], nsh = HS[tn];
                const bool in0 = (unsigned)(idx0 >> 11) == s, in1 = (unsigned)(idx1 >> 11) == s;
                const unsigned long long m0 = __ballot(in0), m1 = __ballot(in1);
                float d0 = 0.f, d1 = 0.f;
                u_token(m0, m1, idx0, idx1, in0, in1, d0, d1, UQ, hv, lane);
                const float c0 = gelu_erf(d0 * us0 * sh) * g0 * vs0, c1 = gelu_erf(d1 * us1 * sh) * g1 * vs1;
                if (in0) COEF[t * 128 + lane] = c0;
                if (in1) COEF[t * 128 + 64 + lane] = c1;
                idx0 = nidx0; idx1 = nidx1; hv = nhv; g0 = ng0; g1 = ng1; sh = nsh;
            }
        }
    }
}
struct VMeta { u32x4 iv[4]; f32x4 cv[4]; };
__device__ __forceinline__ void v_meta(VMeta& m, const int* IDX, const float* COEF, size_t t, int g) {
#pragma unroll
    for (int q = 0; q < 4; ++q) { m.iv[q] = *(const u32x4*)(IDX + t * 128 + 16 * g + 4 * q); m.cv[q] = *(const f32x4*)(COEF + t * 128 + 16 * g + 4 * q); }
}
__device__ __forceinline__ void v_issue(u32x4 (&pc)[16], const VMeta& m, const unsigned char* VS) {
#pragma unroll
    for (int j = 0; j < 16; ++j) pc[j] = *(const u32x4*)(VS + (size_t)m.iv[j >> 2][j & 3] * 128);
}
__device__ __forceinline__ void v_finish(const u32x4 (&pc)[16], const VMeta& m, float* xout, const float* mod_l, size_t t, unsigned s, int lane) {
    const int g = lane >> 3, p = lane & 7; const bool b4 = (lane >> 4) & 1, b3 = (lane >> 3) & 1;
    typedef float f32x2 __attribute__((ext_vector_type(2)));
    const int col = (int)s * 128 + 16 * p + 2 * g, b = (int)(t >> 12);
    float* xp = xout + t * DM + col;
    f32x2 xv = *(const f32x2*)xp;
    const f32x2 gt = *(const f32x2*)(mod_l + (size_t)b * NMOD + 5 * DM + col);
    float acc[16], csum = 0.f;
#pragma unroll
    for (int k = 0; k < 16; ++k) acc[k] = 0.f;
#pragma unroll
    for (int j = 0; j < 16; ++j) {
        const float c = m.cv[j >> 2][j & 3]; csum += c;
#pragma unroll
        for (int w = 0; w < 4; ++w) { const unsigned x = pc[j][w];
            acc[4 * w + 0] = fmaf(c, (float)(x & 0xffu), acc[4 * w + 0]); acc[4 * w + 1] = fmaf(c, (float)((x >> 8) & 0xffu), acc[4 * w + 1]);
            acc[4 * w + 2] = fmaf(c, (float)((x >> 16) & 0xffu), acc[4 * w + 2]); acc[4 * w + 3] = fmaf(c, (float)(x >> 24), acc[4 * w + 3]); }
    }
    float r8[8], r4[4], r2[2];
#pragma unroll
    for (int q = 0; q < 8; ++q) { auto rr = __builtin_amdgcn_permlane32_swap(__float_as_uint(acc[q]), __float_as_uint(acc[8 + q]), false, false); r8[q] = __uint_as_float(rr[0]) + __uint_as_float(rr[1]); }
#pragma unroll
    for (int q = 0; q < 4; ++q) { float lo = r8[q], hi = r8[4 + q]; asm volatile("" : "+v"(lo), "+v"(hi)); const float keep = b4 ? hi : lo, send = b4 ? lo : hi; r4[q] = keep + swz_xor<16>(send); }
#pragma unroll
    for (int q = 0; q < 2; ++q) { float lo = r4[q], hi = r4[2 + q]; asm volatile("" : "+v"(lo), "+v"(hi)); const float keep = b3 ? hi : lo, send = b3 ? lo : hi; r2[q] = keep + swz_xor<8>(send); }
    csum += swz_xor<8>(csum); csum += swz_xor<16>(csum);
    { auto rr = __builtin_amdgcn_permlane32_swap(__float_as_uint(csum), __float_as_uint(csum), false, false); csum = __uint_as_float(rr[0]) + __uint_as_float(rr[1]); }
    const float off = 128.0f * csum;
    xv.x += gt.x * (r2[0] - off); xv.y += gt.y * (r2[1] - off);
    *(f32x2*)xp = xv;
}
__device__ __forceinline__ void v_phase(const KArgs& a, int l, const float* mod_l, unsigned* cnt, LAS unsigned char* lds) {
    int tid_op = threadIdx.x; asm volatile("" : "+v"(tid_op));
    const int tid = tid_op, lane = tid & 63, wid = __builtin_amdgcn_readfirstlane(tid >> 6);
    const int g = lane >> 3, p = lane & 7;
    const unsigned char* VQ = a.ws + WS_VQ + (size_t)l * NEXP * 1024;
    const int* IDX = (const int*)(a.ws + WS_IDX); const float* COEF = (const float*)(a.ws + WS_COEF);
    volatile LAS unsigned* bc = (volatile LAS unsigned*)lds;
    const unsigned home = xcc_id();
    constexpr int TPW = CHUNK / NWAVES;
    for (unsigned ss = 0; ss < 8; ++ss) {
        const unsigned s = (home + ss) & 7u;
        const unsigned char* VS = VQ + (size_t)s * NEXP * 128 + 16 * p;
        for (;;) {
            __syncthreads();
            if (tid == 0) bc[0] = __hip_atomic_fetch_add(cnt + 64 * s, 1u, __ATOMIC_RELAXED, __HIP_MEMORY_SCOPE_AGENT);
            __syncthreads();
            const unsigned chunk = bc[0];
            if (chunk >= (unsigned)NCHUNK) break;
            const size_t t0 = (size_t)chunk * CHUNK + wid * TPW;
            VMeta mA; v_meta(mA, IDX, COEF, t0, g);
#pragma unroll 1
            for (int i = 0; i < TPW; ++i) {
                const size_t t = t0 + i, tn = t0 + (i + 1 < TPW ? i + 1 : i);
                u32x4 pA[16];
                v_issue(pA, mA, VS);
                VMeta nA; v_meta(nA, IDX, COEF, tn, g);
                v_finish(pA, mA, a.out, mod_l, t, s, lane);
                mA = nA;
            }
        }
    }
}
}

constexpr int PH_PER_LAYER = 10, NPHASES = 1 + DEPTH * PH_PER_LAYER + 1;
#ifndef PHASE_MASK
#define PHASE_MASK 0xFFFF
#endif
#define HASP(k) (((PHASE_MASK) >> (k)) & 1)
#ifndef SB_EARLY_EXIT
#define SB_EARLY_EXIT 1
#endif

typedef const __attribute__((address_space(4))) KArgs* KArgsP;
__device__ __forceinline__ KArgsP kargs() { KArgsP p = (KArgsP)__builtin_amdgcn_kernarg_segment_ptr(); asm volatile("" : "+s"(p)); return p; }

__device__ __forceinline__ void load_args(KArgs& a) {
#if defined(__HIP_DEVICE_COMPILE__)
    KArgsP p = kargs();
    a.x = p->x; a.c = p->c; a.pos = p->pos; a.ada_w = p->ada_w; a.ada_b = p->ada_b; a.norm1_g = p->norm1_g; a.w_in = p->w_in; a.sinks = p->sinks; a.wbr_a = p->wbr_a; a.wbr_b = p->wbr_b;
    a.w_out = p->w_out; a.norm2_g = p->norm2_g; a.wq = p->wq; a.subkeys = p->subkeys; a.pu = p->pu; a.pv = p->pv; a.final_g = p->final_g; a.out = p->out; a.ws = p->ws; a.ph_lo = p->ph_lo; a.ph_hi = p->ph_hi;
#endif
}
__global__ void __launch_bounds__(NTHREADS, 2) fwd_kernel(KArgs a_unused) {
    extern __shared__ __attribute__((aligned(16))) unsigned char lds_raw[];
    LAS unsigned char* lds = (LAS unsigned char*)lds_raw;
    cg::grid_group grid = cg::this_grid();
    const int ph_lo = kargs()->ph_lo, ph_hi = kargs()->ph_hi;
#define IN(k) (ph_lo <= (k) && (k) < ph_hi)
#ifdef PROBE_PH
    unsigned long long pr_prev = __builtin_amdgcn_s_memrealtime(), pr_acc = 0;
#define PROBE_MATCH(k) ((PROBE_PH) >= 100 ? ((k) >= 1 && (k) < NPHASES - 1 && (((k) - 1) % PH_PER_LAYER) == (PROBE_PH) - 100) : (k) == (PROBE_PH))
#define SEAM(k) do { if (IN(k) && IN((k) + 1)) grid.sync(); { const unsigned long long now_ = __builtin_amdgcn_s_memrealtime(); if (PROBE_MATCH(k)) pr_acc += now_ - pr_prev; pr_prev = now_; } } while (0)
#else
#define SEAM(k) do { if (IN(k) && IN((k) + 1)) grid.sync(); } while (0)
#endif
#define LOADARGS KArgs a; load_args(a); unsigned char* ws = a.ws; const int G = gridDim.x; (void)G; (void)ws
#define LAYERARGS const float* mod_l = (const float*)(ws + WS_MOD) + (size_t)l * 8 * NMOD; const float* xcur = (l == 0) ? a.x : a.out; (void)mod_l; (void)xcur
    if (IN(0)) { if (HASP(0)) { LOADARGS; ph_prologue(a, lds); } }
    SEAM(0);
#pragma unroll 1
    for (int l = 0; l < DEPTH; ++l) {
        const int p0 = 1 + l * PH_PER_LAYER;
        if (IN(p0 + 0)) { if (HASP(1)) { LOADARGS; LAYERARGS; ph_norm<false>(a, xcur, a.norm1_g + l * DM, mod_l, 0, 1); } }
        SEAM(p0 + 0);
        if (IN(p0 + 1)) { if (HASP(2)) { LOADARGS; pg8::Gemm g{(const bf16_t*)(ws + WS_H), (const bf16_t*)(ws + WS_WIN) + (size_t)l * NPROJ * 1024, T, NPROJ, 1024};
                  pg8::StaticOrder S; S.init(T, NPROJ, G, (int)blockIdx.x); EpiProj E{ws};
                  pg8::gemm_phase<EpiProj, pg8::StaticOrder, true, true>(lds, g, S, E); } }
        SEAM(p0 + 1);
        if (IN(p0 + 2)) { if (HASP(3)) { LOADARGS;
                  att::swa_phase((const bf16_t*)(ws + WS_QA), (const bf16_t*)(ws + WS_KA), (const bf16_t*)(ws + WS_VA), (bf16_t*)(ws + WS_QA), a.sinks + l * 8, lds);
                  __syncthreads();
                  att::sb_phase<SB_EARLY_EXIT != 0>((const bf16_t*)(ws + WS_QB), (const bf16_t*)(ws + WS_KB), (const bf16_t*)(ws + WS_VB), (bf16_t*)(ws + WS_QB), lds); } }
        SEAM(p0 + 2);
        if (IN(p0 + 3)) { if (HASP(4)) { LOADARGS; pg8::StaticOrder S; S.init(T, DM, G, (int)blockIdx.x);
                  { pg8::Gemm g{(const bf16_t*)(ws + WS_QA), (const bf16_t*)(ws + WS_WBA) + (size_t)l * 1024 * 512, T, DM, 512};
                    EpiBranch<false> E{(const bf16_t*)(ws + WS_GA), (bf16_t*)(ws + WS_H)};
                    pg8::gemm_phase<EpiBranch<false>, pg8::StaticOrder, true, true>(lds, g, S, E); }
                  __syncthreads();
                  { pg8::Gemm g{(const bf16_t*)(ws + WS_QB), (const bf16_t*)(ws + WS_WBB) + (size_t)l * 1024 * 512, T, DM, 512};
                    EpiBranch<true> E{(const bf16_t*)(ws + WS_GB), (bf16_t*)(ws + WS_H)};
                    pg8::gemm_phase<EpiBranch<true>, pg8::StaticOrder, true, true>(lds, g, S, E); } } }
        SEAM(p0 + 3);
        if (IN(p0 + 4)) { if (HASP(5)) { LOADARGS; LAYERARGS; pg8::Gemm g{(const bf16_t*)(ws + WS_H), (const bf16_t*)(ws + WS_WOUT) + (size_t)l * 1024 * 1024, T, DM, 1024};
                  pg8::StaticOrder S; S.init(T, DM, G, (int)blockIdx.x); EpiWout E{xcur, a.out, mod_l + 2 * DM};
                  pg8::gemm_phase<EpiWout, pg8::StaticOrder, true, true>(lds, g, S, E); } }
        SEAM(p0 + 4);
        if (IN(p0 + 5)) { if (HASP(6)) { LOADARGS; LAYERARGS; ph_norm<true>(a, a.out, a.norm2_g + l * DM, mod_l, 3, 4); } }
        SEAM(p0 + 5);
        if (IN(p0 + 6)) { if (HASP(7)) { LOADARGS; pg8::Gemm g{(const bf16_t*)(ws + WS_H), (const bf16_t*)(ws + WS_WQ) + (size_t)l * PQ * 1024, T, PQ, 1024};
                  pg8::StaticOrder S; S.init(T, PQ, G, (int)blockIdx.x); EpiPlainBf16 E{(bf16_t*)(ws + WS_Q2), PQ};
                  pg8::gemm_phase<EpiPlainBf16, pg8::StaticOrder, true, true>(lds, g, S, E); } }
        SEAM(p0 + 6);
        if (IN(p0 + 7)) { if (HASP(8)) { LOADARGS; tk::topk_phase((const bf16_t*)(ws + WS_Q2), (const bf16_t*)(ws + WS_SK) + (size_t)l * 8 * 2 * 128 * 128, (int*)(ws + WS_IDX), (float*)(ws + WS_GATE), lds); } }
        SEAM(p0 + 7);
        if (IN(p0 + 8)) { if (HASP(9)) { LOADARGS; peer2::u_phase(a, l, (unsigned*)(ws + WS_CTL) + CTL_QUEUE + (l * 2 + 0) * 8 * 64, lds); } }
        SEAM(p0 + 8);
        if (IN(p0 + 9)) { if (HASP(10)) { LOADARGS; LAYERARGS; peer2::v_phase(a, l, mod_l, (unsigned*)(ws + WS_CTL) + CTL_QUEUE + (l * 2 + 1) * 8 * 64, lds); } }
        SEAM(p0 + 9);
    }
    if (IN(NPHASES - 1)) { if (HASP(11)) { LOADARGS; ph_final_norm(a); } }
#ifdef PROBE_PH
    { const unsigned long long now_ = __builtin_amdgcn_s_memrealtime(); if (PROBE_MATCH(NPHASES - 1)) pr_acc += now_ - pr_prev;
      if (blockIdx.x == 0 && threadIdx.x == 0) { const unsigned long long t0_ = __builtin_amdgcn_s_memrealtime(); while (__builtin_amdgcn_s_memrealtime() - t0_ < pr_acc * (PROBE_K)) __builtin_amdgcn_s_sleep(16); } }
#endif
#undef IN
#undef SEAM
}

#ifndef N_LAUNCH_SPLIT
#define N_LAUNCH_SPLIT 1
#endif
extern "C" void kernel_launch(void* const* d_in, const int* in_sizes, int n_in, void* d_out, int out_size, void* d_ws, size_t ws_size, hipStream_t stream) {
    static int grid = 0;
    if (grid == 0) {
        if (n_in != 17 || out_size != T * DM || ws_size < WS_END) { fprintf(stderr, "kernel_launch: unexpected problem (n_in %d out %d ws %zu)\n", n_in, out_size, ws_size); grid = -1; return; }
        int dev = 0, cus = 0, per_cu = 0;
        (void)hipGetDevice(&dev);
        (void)hipDeviceGetAttribute(&cus, hipDeviceAttributeMultiprocessorCount, dev);
        (void)hipFuncSetAttribute((const void*)fwd_kernel, hipFuncAttributeMaxDynamicSharedMemorySize, LDS_BYTES);
        (void)hipOccupancyMaxActiveBlocksPerMultiprocessor(&per_cu, (const void*)fwd_kernel, NTHREADS, LDS_BYTES);
        if (per_cu < 1) { fprintf(stderr, "kernel_launch: occupancy query says %d\n", per_cu); per_cu = 1; }
        grid = cus;
        fprintf(stderr, "kernel_launch: cus %d per_cu %d grid %d ws %zu\n", cus, per_cu, grid, ws_size);
    }
    if (grid < 0) return;
    KArgs a{};
    a.x = (const float*)d_in[0]; a.c = (const float*)d_in[1]; a.pos = (const int*)d_in[2]; a.ada_w = (const float*)d_in[3]; a.ada_b = (const float*)d_in[4];
    a.norm1_g = (const float*)d_in[5]; a.w_in = (const float*)d_in[6]; a.sinks = (const float*)d_in[7]; a.wbr_a = (const float*)d_in[8]; a.wbr_b = (const float*)d_in[9];
    a.w_out = (const float*)d_in[10]; a.norm2_g = (const float*)d_in[11]; a.wq = (const float*)d_in[12]; a.subkeys = (const float*)d_in[13]; a.pu = (const float*)d_in[14];
    a.pv = (const float*)d_in[15]; a.final_g = (const float*)d_in[16]; a.out = (float*)d_out; a.ws = (unsigned char*)d_ws;
#if N_LAUNCH_SPLIT
    a.ph_lo = 0; a.ph_hi = NPHASES;
    { void* args[] = {&a};
      hipError_t e = hipLaunchCooperativeKernel((void*)fwd_kernel, dim3(grid), dim3(NTHREADS), args, LDS_BYTES, stream);
      if (e != hipSuccess) fprintf(stderr, "cooperative launch failed: %s (grid %d)\n", hipGetErrorString(e), grid); }
#else
    for (int ph = 0; ph < NPHASES; ++ph) {
        a.ph_lo = ph; a.ph_hi = ph + 1;
        void* args[] = {&a};
        hipError_t e = hipLaunchCooperativeKernel((void*)fwd_kernel, dim3(grid), dim3(NTHREADS), args, LDS_BYTES, stream);
        if (e != hipSuccess) { fprintf(stderr, "cooperative launch %d failed: %s (grid %d)\n", ph, hipGetErrorString(e), grid); break; }
    }
#endif
}
```

```cpp
#include <hip/hip_runtime.h>
#include <hip/hip_cooperative_groups.h>
#include <cstdio>
#include <cstdint>
namespace cg = cooperative_groups;

namespace pg8 {
#define PG8_LAS __attribute__((address_space(3)))
typedef unsigned short bf16_t;
typedef short bf16x8 __attribute__((ext_vector_type(8)));
typedef float f32x4 __attribute__((ext_vector_type(4)));
typedef unsigned u32x4 __attribute__((ext_vector_type(4)));
constexpr int BM = 256, BK = 64, HALF = 128, HTB = HALF * BK * 2  , STAGE_BYTES = 8 * HTB, NXCD = 8, WGM = 8;

__host__ __device__ __forceinline__ int lds_byte(int r, int c) { const int st = (r >> 4) * 2 + (c >> 5), rr = r & 15, cc = c & 31, ob = rr * 64 + cc * 2; return st * 1024 + (ob ^ (((ob >> 9) & 1) << 5)); }
__host__ __device__ __forceinline__ void stage_rc(int b, int& R, int& C) { const int st = b / 1024, sb = b % 1024, swz = sb ^ (((sb >> 9) & 1) << 5); R = (st >> 1) * 16 + swz / 64; C = (st & 1) * 32 + (swz % 64) / 2; }
__host__ __device__ __forceinline__ int perm32(int rho) { const int n = rho >> 4, i = rho & 15; return 8 * (i >> 2) + 4 * n + (i & 3); }

struct Unit { int pm, pn; };
struct Gemm { const bf16_t* A; const bf16_t* Bt; int M, N, K; };

struct StaticOrder {
    int nM, nN, nwg, G, c;
    __host__ __device__ void init(int M, int N, int G_, int c_) { nM = M / BM; nN = N / BM; nwg = nM * nN; G = G_; c = c_; }
    __host__ __device__ bool next(int i, Unit& u) const {
        const long L = (long)i * G + c; if (L >= nwg) return false;
        int wgid = (int)L; { const int q = nwg / NXCD, r = nwg % NXCD, xcd = wgid % NXCD, off = wgid / NXCD; wgid = (xcd < r ? xcd * (q + 1) : r * (q + 1) + (xcd - r) * q) + off; }
        const int nig = WGM * nN, gid = wgid / nig, fm = gid * WGM, gsz = (nM - fm) < WGM ? (nM - fm) : WGM;
        u.pm = fm + ((wgid % nig) % gsz); u.pn = (wgid % nig) / gsz; return true;
    }
    __device__ __forceinline__ void a_ready(const Unit&) const {}
    __device__ __forceinline__ void done(const Unit&) const {}
};


__device__ __forceinline__ unsigned cvt_pk_bf16(float lo, float hi) { unsigned r; asm volatile("v_cvt_pk_bf16_f32 %0, %1, %2" : "=v"(r) : "v"(lo), "v"(hi)); return r; }
template <class Epi, class Sched, bool ALIGN_EPI = false, bool SP2 = false>
__device__ __forceinline__ void gemm_phase(PG8_LAS unsigned char* lds, const Gemm g, const Sched& S, const Epi& E, int wv) {
    unsigned m_op = ~0u; asm volatile("" : "+s"(m_op));
    const int tid = wv * 64 + (int)__builtin_amdgcn_mbcnt_hi(m_op, __builtin_amdgcn_mbcnt_lo(m_op, 0u)), wid = wv, lane = tid & 63, wr = wid >> 2, wc = wid & 3, fr = lane & 15, fq = lane >> 4;
    const int K = g.K, nt = K / BK;
    unsigned voffA[2], voffB[2];
#pragma unroll
    for (int i = 0; i < 2; ++i) { int R, C; stage_rc(tid * 16 + i * 8192, R, C); const int Rb = Epi::PERM ? ((R & ~31) + perm32(R & 31)) : R;
        voffA[i] = (unsigned)(R * K + C) * 2u; voffB[i] = (unsigned)(Rb * K + C) * 2u; }
    const size_t kstep = (size_t)(BK * 2);
    const size_t hstep = (size_t)HALF * K * 2;
    const size_t tstep = 2 * hstep;
    const unsigned ldsw = (unsigned)wid * 1024u;
    const int aoff = lds_byte(wr * 64 + fr, fq * 8), boff = lds_byte(wc * 32 + fr, fq * 8);
#define PG8_SA(b, h) (((b) * 2 + (h)) * HTB)
#define PG8_SB(b, h) ((4 + (b) * 2 + (h)) * HTB)
#define PG8_STAGE(bufoff, gbase, voff) do { _Pragma("unroll") for (int _i = 0; _i < 2; ++_i) \
        __builtin_amdgcn_global_load_lds((const unsigned*)((const char*)(gbase) + (voff)[_i]), (PG8_LAS unsigned*)(lds + (bufoff) + ldsw + _i * 8192), 16, 0, 0); } while (0)
#define PG8_LDA(dst, b, h) do { _Pragma("unroll") for (int m = 0; m < 4; ++m) _Pragma("unroll") for (int k = 0; k < 2; ++k) dst[m][k] = *(const PG8_LAS bf16x8*)(lds + PG8_SA(b, h) + aoff + m * 2048 + k * 1024); } while (0)
#define PG8_LDB(dst, b, h) do { _Pragma("unroll") for (int n = 0; n < 2; ++n) _Pragma("unroll") for (int k = 0; k < 2; ++k) dst[n][k] = *(const PG8_LAS bf16x8*)(lds + PG8_SB(b, h) + boff + n * 2048 + k * 1024); } while (0)
#define PG8_MMA(ai, bj, At, Bt) do { __builtin_amdgcn_s_setprio(1); _Pragma("unroll") for (int m = 0; m < 4; ++m) _Pragma("unroll") for (int n = 0; n < 2; ++n) _Pragma("unroll") for (int k = 0; k < 2; ++k) \
        acc[ai][bj][m][n] = __builtin_amdgcn_mfma_f32_16x16x32_bf16(Bt[n][k], At[m][k], acc[ai][bj][m][n], 0, 0, 0); __builtin_amdgcn_s_setprio(0); } while (0)
#define PG8_WAIT_V(n) asm volatile("s_waitcnt vmcnt(" #n ")" ::: "memory")
#define PG8_WAIT_L(n) asm volatile("s_waitcnt lgkmcnt(" #n ")" ::: "memory")
#define PG8_BAR __builtin_amdgcn_s_barrier()
#define PG8_SCHED __builtin_amdgcn_sched_barrier(0)
    Unit cur, nxt; int ui = 0;
    if (!S.next(0, cur)) return;
    f32x4 acc[2][2][4][2];
#pragma unroll
    for (int a = 0; a < 2; ++a)
#pragma unroll
        for (int b = 0; b < 2; ++b)
#pragma unroll
            for (int m = 0; m < 4; ++m)
#pragma unroll
                for (int n = 0; n < 2; ++n) acc[a][b][m][n] = (f32x4){0.f, 0.f, 0.f, 0.f};
    bf16x8 At[4][2], B0[2][2], B1[2][2];
    const char* cA = (const char*)g.A + (size_t)cur.pm * tstep; const char* cB = (const char*)g.Bt + (size_t)cur.pn * tstep;
    S.a_ready(cur);
    if constexpr (SP2) {
        PG8_STAGE(PG8_SB(0, 0), cB, voffB); PG8_STAGE(PG8_SB(0, 1), cB + hstep, voffB); PG8_STAGE(PG8_SA(0, 0), cA, voffA); PG8_STAGE(PG8_SA(0, 1), cA + hstep, voffA);
        if (wr == 1) PG8_BAR;
        PG8_WAIT_V(2); PG8_BAR;
        PG8_STAGE(PG8_SB(1, 0), cB + kstep, voffB); PG8_STAGE(PG8_SA(1, 0), cA + kstep, voffA); PG8_STAGE(PG8_SB(1, 1), cB + hstep + kstep, voffB);
        PG8_WAIT_V(6); PG8_BAR;
    } else {
        PG8_STAGE(PG8_SB(0, 0), cB, voffB); PG8_STAGE(PG8_SA(0, 0), cA, voffA); PG8_STAGE(PG8_SB(0, 1), cB + hstep, voffB); PG8_STAGE(PG8_SA(0, 1), cA + hstep, voffA);
        if (wr == 1) PG8_BAR;
        PG8_WAIT_V(4); PG8_BAR;
        PG8_STAGE(PG8_SB(1, 0), cB + kstep, voffB); PG8_STAGE(PG8_SA(1, 0), cA + kstep, voffA); PG8_STAGE(PG8_SB(1, 1), cB + hstep + kstep, voffB);
        PG8_WAIT_V(6); PG8_BAR;
    }
    for (;;) {
        const bool has_next = S.next(ui + 1, nxt);
        const char* nA = has_next ? (const char*)g.A + (size_t)nxt.pm * tstep : cA; const char* nB = has_next ? (const char*)g.Bt + (size_t)nxt.pn * tstep : cB;
        for (int t = 0; t < nt; t += 2) {
            const bool last = (t == nt - 2);
            const char* a1 = cA + (size_t)(t + 1) * kstep;
            const char* a2 = last ? nA : cA + (size_t)(t + 2) * kstep; const char* b2 = last ? nB : cB + (size_t)(t + 2) * kstep;
            const char* a3 = a2 + kstep; const char* b3 = b2 + kstep;
            if (last && has_next) S.a_ready(nxt);
            if constexpr (SP2) {
            PG8_LDB(B0, 0, 0); PG8_LDB(B1, 0, 1); PG8_SCHED; PG8_LDA(At, 0, 0); PG8_STAGE(PG8_SA(1, 1), a1 + hstep, voffA);
            PG8_WAIT_V(8); PG8_WAIT_L(0); PG8_BAR; PG8_MMA(0, 0, At, B0); PG8_MMA(0, 1, At, B1); PG8_BAR; PG8_SCHED;
            PG8_LDA(At, 0, 1); PG8_STAGE(PG8_SB(0, 0), b2, voffB); PG8_STAGE(PG8_SB(0, 1), b2 + hstep, voffB); PG8_STAGE(PG8_SA(0, 0), a2, voffA);
            PG8_WAIT_V(8); PG8_WAIT_L(0); PG8_BAR; PG8_MMA(1, 0, At, B0); PG8_MMA(1, 1, At, B1); PG8_BAR; PG8_SCHED;
            PG8_LDB(B0, 1, 0); PG8_LDB(B1, 1, 1); PG8_SCHED; PG8_LDA(At, 1, 0); PG8_STAGE(PG8_SA(0, 1), a2 + hstep, voffA);
            PG8_WAIT_V(8); PG8_WAIT_L(0); PG8_BAR; PG8_MMA(0, 0, At, B0); PG8_MMA(0, 1, At, B1); PG8_BAR; PG8_SCHED;
            PG8_LDA(At, 1, 1); PG8_STAGE(PG8_SB(1, 0), b3, voffB); PG8_STAGE(PG8_SB(1, 1), b3 + hstep, voffB); PG8_STAGE(PG8_SA(1, 0), a3, voffA);
            PG8_WAIT_V(8); PG8_WAIT_L(0); PG8_BAR; PG8_MMA(1, 0, At, B0); PG8_MMA(1, 1, At, B1); PG8_BAR; PG8_SCHED;
            } else {
            PG8_LDB(B0, 0, 0); PG8_SCHED; PG8_LDA(At, 0, 0); PG8_STAGE(PG8_SA(1, 1), a1 + hstep, voffA);
            PG8_WAIT_L(8); PG8_BAR; PG8_WAIT_L(0); PG8_MMA(0, 0, At, B0); PG8_BAR; PG8_SCHED;
            PG8_LDB(B1, 0, 1); PG8_STAGE(PG8_SB(0, 0), b2, voffB);
            PG8_BAR; PG8_WAIT_L(0); PG8_MMA(0, 1, At, B1); PG8_BAR;
            PG8_LDA(At, 0, 1); PG8_STAGE(PG8_SA(0, 0), a2, voffA);
            PG8_BAR; PG8_WAIT_L(0); PG8_MMA(1, 0, At, B0); PG8_BAR; PG8_SCHED;
            PG8_STAGE(PG8_SB(0, 1), b2 + hstep, voffB);
            PG8_WAIT_V(6); PG8_BAR; PG8_MMA(1, 1, At, B1); PG8_BAR;
            PG8_LDB(B0, 1, 0); PG8_SCHED; PG8_LDA(At, 1, 0); PG8_STAGE(PG8_SA(0, 1), a2 + hstep, voffA);
            PG8_WAIT_L(8); PG8_BAR; PG8_WAIT_L(0); PG8_MMA(0, 0, At, B0); PG8_BAR; PG8_SCHED;
            PG8_LDB(B1, 1, 1); PG8_STAGE(PG8_SB(1, 0), b3, voffB);
            PG8_BAR; PG8_WAIT_L(0); PG8_MMA(0, 1, At, B1); PG8_BAR;
            PG8_LDA(At, 1, 1); PG8_STAGE(PG8_SA(1, 0), a3, voffA);
            PG8_BAR; PG8_WAIT_L(0); PG8_MMA(1, 0, At, B0); PG8_BAR; PG8_SCHED;
            PG8_STAGE(PG8_SB(1, 1), b3 + hstep, voffB);
            PG8_WAIT_V(6); PG8_BAR; PG8_MMA(1, 1, At, B1); PG8_BAR;
            }
        }
        if constexpr (ALIGN_EPI) { if (wr == 0) PG8_BAR; }
        if constexpr (!Epi::AFTER_DRAIN) { E(acc, cur, wr, wc, fr, fq); S.done(cur); }
        if (!has_next) break;
#pragma unroll
        for (int a = 0; a < 2; ++a)
#pragma unroll
            for (int b = 0; b < 2; ++b)
#pragma unroll
                for (int m = 0; m < 4; ++m)
#pragma unroll
                    for (int n = 0; n < 2; ++n) acc[a][b][m][n] = (f32x4){0.f, 0.f, 0.f, 0.f};
        cur = nxt; cA = nA; cB = nB; ++ui;
        if constexpr (ALIGN_EPI) { if (wr == 1) PG8_BAR; }
    }
    PG8_WAIT_V(0);
    if constexpr (!ALIGN_EPI) { if (wr == 0) PG8_BAR; }
    PG8_BAR;
    if constexpr (Epi::AFTER_DRAIN) { E.fused(acc, cur, wr, wc, fr, fq, lds, wid, lane); S.done(cur); }
#undef PG8_SA
#undef PG8_SB
#undef PG8_STAGE
#undef PG8_LDA
#undef PG8_LDB
#undef PG8_MMA
#undef PG8_WAIT_V
#undef PG8_WAIT_L
#undef PG8_BAR
#undef PG8_SCHED
}
}


#define LAS __attribute__((address_space(3)))

__device__ __forceinline__ int op_bid() { int b = (int)blockIdx.x; asm volatile("" : "+s"(b)); return b; }
__device__ __forceinline__ int op_grid() { int g = (int)gridDim.x; asm volatile("" : "+s"(g)); return g; }
__device__ __forceinline__ int phase_tid(int wv) { unsigned m = ~0u; asm volatile("" : "+s"(m)); return wv * 64 + (int)__builtin_amdgcn_mbcnt_hi(m, __builtin_amdgcn_mbcnt_lo(m, 0u)); }
typedef unsigned short bf16_t;
typedef float f32x4 __attribute__((ext_vector_type(4)));
typedef unsigned u32x4 __attribute__((ext_vector_type(4)));
typedef unsigned u32x2 __attribute__((ext_vector_type(2)));

constexpr int BATCH = 8, SEQ = 4096, DM = 1024, T = BATCH * SEQ, DEPTH = 2;
constexpr int NPROJ = 4352, NMOD = 6 * DM;
constexpr int NEXP = 16384, PQ = 2048;
constexpr float NORM_EPS = 1e-6f;
constexpr float LOG2E = 1.4426950408889634f;
constexpr float QSCALE = 0.125f * LOG2E;
constexpr float SB_EXIT = 160.0f;

constexpr size_t MiB = 1u << 20;
constexpr size_t WS_CTL = 0;
constexpr size_t WS_MOD = 1 * MiB;
constexpr size_t WS_ROPE = 2 * MiB;
constexpr size_t WS_WIN = 10 * MiB;
constexpr size_t WS_WBA = 27 * MiB;
constexpr size_t WS_WBB = 29 * MiB;
constexpr size_t WS_WOUT = 31 * MiB;
constexpr size_t WS_WQ = 35 * MiB;
constexpr size_t WS_SK = 43 * MiB;
constexpr size_t WS_UQ = 44 * MiB;
constexpr size_t WS_VQ = 76 * MiB;
constexpr size_t WS_USC = 108 * MiB;
constexpr size_t WS_VSC = 108 * MiB + 256 * 1024;
constexpr size_t WS_HS = 109 * MiB;
constexpr size_t WS_H = 112 * MiB;
constexpr size_t WS_QA = 176 * MiB;
constexpr size_t WS_QB = 208 * MiB;
constexpr size_t WS_KB = 240 * MiB;
constexpr size_t WS_VB = 272 * MiB;
constexpr size_t WS_KA = 304 * MiB;
constexpr size_t WS_VA = 312 * MiB;
constexpr size_t WS_GA = 320 * MiB;
constexpr size_t WS_GB = 384 * MiB;
constexpr size_t WS_END = 448 * MiB;
constexpr size_t WS_H2Q = WS_QA, WS_IDX = WS_KB, WS_GATE = WS_VB, WS_Q2 = WS_GA, WS_COEF = WS_GA;
constexpr int CTL_QUEUE = 1024;

constexpr int LDS_BYTES = 147456;
constexpr int NTHREADS = 512, NWAVES = 8;

struct KArgs {
    const float* x; const float* c; const int* pos; const float* ada_w; const float* ada_b; const float* norm1_g; const float* w_in; const float* sinks;
    const float* wbr_a; const float* wbr_b; const float* w_out; const float* norm2_g; const float* wq; const float* subkeys; const float* pu; const float* pv; const float* final_g;
    float* out; unsigned char* ws; int ph_lo, ph_hi;
};

__device__ __forceinline__ unsigned f2bf(float f) { unsigned u = __float_as_uint(f); return (u + 0x7fffu + ((u >> 16) & 1u)) >> 16; }
__device__ __forceinline__ unsigned pk2(float lo, float hi) { return f2bf(lo) | (f2bf(hi) << 16); }
__device__ __forceinline__ float bflo(unsigned w) { return __uint_as_float(w << 16); }
__device__ __forceinline__ float bfhi(unsigned w) { return __uint_as_float(w & 0xffff0000u); }
template <int M> __device__ __forceinline__ float swz_xor(float v) { return __int_as_float(__builtin_amdgcn_ds_swizzle(__float_as_int(v), (M << 10) | 0x1f)); }
__device__ __forceinline__ float wave_sum(float v) {
    v += swz_xor<1>(v); v += swz_xor<2>(v); v += swz_xor<4>(v); v += swz_xor<8>(v); v += swz_xor<16>(v);
    auto rr = __builtin_amdgcn_permlane32_swap(__float_as_uint(v), __float_as_uint(v), false, false);
    return __uint_as_float(rr[0]) + __uint_as_float(rr[1]);
}
__device__ __forceinline__ float wave_max(float v) {
    v = fmaxf(v, swz_xor<1>(v)); v = fmaxf(v, swz_xor<2>(v)); v = fmaxf(v, swz_xor<4>(v)); v = fmaxf(v, swz_xor<8>(v)); v = fmaxf(v, swz_xor<16>(v));
    auto rr = __builtin_amdgcn_permlane32_swap(__float_as_uint(v), __float_as_uint(v), false, false);
    return fmaxf(__uint_as_float(rr[0]), __uint_as_float(rr[1]));
}
__device__ __forceinline__ int rdlane_i(int v, int l) { return __builtin_amdgcn_readlane(v, __builtin_amdgcn_readfirstlane(l)); }
__device__ __forceinline__ float rdlane_f(float v, int l) { return __int_as_float(__builtin_amdgcn_readlane(__float_as_int(v), __builtin_amdgcn_readfirstlane(l))); }
__device__ __forceinline__ float dot8(u32x4 a, u32x4 b, float acc) {
    acc = fmaf(bflo(a.x), bflo(b.x), acc); acc = fmaf(bfhi(a.x), bfhi(b.x), acc);
    acc = fmaf(bflo(a.y), bflo(b.y), acc); acc = fmaf(bfhi(a.y), bfhi(b.y), acc);
    acc = fmaf(bflo(a.z), bflo(b.z), acc); acc = fmaf(bfhi(a.z), bfhi(b.z), acc);
    acc = fmaf(bflo(a.w), bflo(b.w), acc); acc = fmaf(bfhi(a.w), bfhi(b.w), acc);
    return acc;
}
__device__ __forceinline__ float softplus2(float z2) {
    return fmaxf(z2, 0.f) + __log2f(1.0f + exp2f(-fabsf(z2)));
}

__device__ __forceinline__ int win_pos(int n) {
    if (n >= 640) return n;
    const int hb = n & ~63, d = n & 63;
    return hb + (d < 32 ? 2 * d : 2 * (d - 32) + 1);
}
template <bool WIN>
__device__ __forceinline__ void transpose_item(const float* W, int K, int N, bf16_t* WT, LAS float* scr, int item, int lane) {
    const int nblk = N / 32, kb = item / nblk, nb = item % nblk, k0 = 64 * kb, n0 = 32 * nb;
#pragma unroll 8
    for (int i = 0; i < 32; ++i) { const int kk = 2 * i + (lane >> 5); scr[kk * 33 + (lane & 31)] = W[(size_t)(k0 + kk) * N + n0 + (lane & 31)]; }
    asm volatile("s_waitcnt lgkmcnt(0)" ::: "memory");
    const int c = lane & 7;
#pragma unroll
    for (int j = 0; j < 4; ++j) { const int n = (lane >> 3) + 8 * j; const LAS float* s = scr + (8 * c) * 33 + n;
        u32x4 o; o.x = pk2(s[0 * 33], s[1 * 33]); o.y = pk2(s[2 * 33], s[3 * 33]); o.z = pk2(s[4 * 33], s[5 * 33]); o.w = pk2(s[6 * 33], s[7 * 33]);
        const int row = WIN ? win_pos(n0 + n) : (n0 + n);
        *(u32x4*)(WT + (size_t)row * K + k0 + 8 * c) = o; }
    asm volatile("s_waitcnt lgkmcnt(0)" ::: "memory");
}
template <bool OFFSET128>
__device__ __forceinline__ void quant_row(const f32x4 (&v)[4], unsigned char* dst_row, float* scale_out, int lane) {
    float am = 0.f;
#pragma unroll
    for (int i = 0; i < 4; ++i) am = fmaxf(am, fmaxf(fmaxf(fabsf(v[i].x), fabsf(v[i].y)), fmaxf(fabsf(v[i].z), fabsf(v[i].w))));
    am = wave_max(am);
    const float inv = am > 0.f ? 127.0f / am : 0.f, sc = am > 0.f ? am / 127.0f : 1.0f;
    u32x4 o;
#pragma unroll
    for (int i = 0; i < 4; ++i) {
        int q0 = (int)rintf(v[i].x * inv), q1 = (int)rintf(v[i].y * inv), q2 = (int)rintf(v[i].z * inv), q3 = (int)rintf(v[i].w * inv);
        if (OFFSET128) { q0 += 128; q1 += 128; q2 += 128; q3 += 128; }
        o[i] = (unsigned)(q0 & 0xff) | ((unsigned)(q1 & 0xff) << 8) | ((unsigned)(q2 & 0xff) << 16) | ((unsigned)(q3 & 0xff) << 24);
    }
    *(u32x4*)(dst_row + 16 * lane) = o;
    if (lane == 0) *scale_out = sc;
}

__device__ __forceinline__ void ph_prologue(const KArgs& a, LAS unsigned char* lds, int wv) {
    const int tid = phase_tid(wv), lane = tid & 63, wave = wv, G = op_grid();
    const int gw = op_bid() * NWAVES + wave, NGW = G * NWAVES;
    unsigned char* ws = a.ws;
    {
        LAS float* sc = (LAS float*)lds;
        for (int it = op_bid(); it < DEPTH * 12; it += G) {
            for (int idx = tid; idx < 8192; idx += NTHREADS) { const int b = idx >> 10, i = idx & 1023; const float cv = a.c[b * 1024 + i]; sc[i * 8 + b] = cv / (1.0f + __expf(-cv)); }
            __syncthreads();
            const int l = it / 12, j = (it % 12) * 512 + tid;
            const float* wp = a.ada_w + (size_t)l * 1024 * NMOD + j;
            float acc[8];
#pragma unroll
            for (int b = 0; b < 8; ++b) acc[b] = 0.f;
#pragma unroll 4
            for (int i = 0; i < 1024; ++i) {
                const float w = wp[(size_t)i * NMOD];
                const f32x4 s0 = *(const LAS f32x4*)(sc + i * 8), s1 = *(const LAS f32x4*)(sc + i * 8 + 4);
                acc[0] = fmaf(s0.x, w, acc[0]); acc[1] = fmaf(s0.y, w, acc[1]); acc[2] = fmaf(s0.z, w, acc[2]); acc[3] = fmaf(s0.w, w, acc[3]);
                acc[4] = fmaf(s1.x, w, acc[4]); acc[5] = fmaf(s1.y, w, acc[5]); acc[6] = fmaf(s1.z, w, acc[6]); acc[7] = fmaf(s1.w, w, acc[7]);
            }
            float* mod = (float*)(ws + WS_MOD);
            const float bias = a.ada_b[l * NMOD + j];
#pragma unroll
            for (int b = 0; b < 8; ++b) mod[(size_t)(l * 8 + b) * NMOD + j] = acc[b] + bias;
            __syncthreads();
        }
    }
    {
        LAS float* scr = (LAS float*)(lds + 32768 + wave * 8448);
        constexpr int I_IN = 16 * 136, I_BR = 8 * 32, I_OUT = 16 * 32, I_Q = 16 * 64, I_L = I_IN + 2 * I_BR + I_OUT + I_Q;
        for (int it = gw; it < DEPTH * I_L; it += NGW) {
            const int l = it / I_L; int r = it % I_L;
            if (r < I_IN) { transpose_item<true>(a.w_in + (size_t)l * 1024 * NPROJ, 1024, NPROJ, (bf16_t*)(ws + WS_WIN) + (size_t)l * NPROJ * 1024, scr, r, lane); continue; } r -= I_IN;
            if (r < I_BR) { transpose_item<false>(a.wbr_a + (size_t)l * 512 * 1024, 512, 1024, (bf16_t*)(ws + WS_WBA) + (size_t)l * 1024 * 512, scr, r, lane); continue; } r -= I_BR;
            if (r < I_BR) { transpose_item<false>(a.wbr_b + (size_t)l * 512 * 1024, 512, 1024, (bf16_t*)(ws + WS_WBB) + (size_t)l * 1024 * 512, scr, r, lane); continue; } r -= I_BR;
            if (r < I_OUT) { transpose_item<false>(a.w_out + (size_t)l * 1024 * 1024, 1024, 1024, (bf16_t*)(ws + WS_WOUT) + (size_t)l * 1024 * 1024, scr, r, lane); continue; } r -= I_OUT;
            transpose_item<false>(a.wq + (size_t)l * 1024 * PQ, 1024, PQ, (bf16_t*)(ws + WS_WQ) + (size_t)l * PQ * 1024, scr, r, lane);
        }
    }
    {
        const int gt = op_bid() * NTHREADS + tid, NGT = G * NTHREADS;
        for (int i = gt; i < DEPTH * 8 * 2 * 128 * 128 / 8; i += NGT) {
            const f32x4 v0 = *(const f32x4*)(a.subkeys + (size_t)i * 8), v1 = *(const f32x4*)(a.subkeys + (size_t)i * 8 + 4);
            u32x4 o; o.x = pk2(v0.x, v0.y); o.y = pk2(v0.z, v0.w); o.z = pk2(v1.x, v1.y); o.w = pk2(v1.z, v1.w);
            *(u32x4*)((bf16_t*)(ws + WS_SK) + (size_t)i * 8) = o;
        }
        for (int i = gt; i < T * 32; i += NGT) {
            const int t = i >> 5, f = i & 31;
            double inv = 1.0;
            for (int k = 0; k < f; ++k) inv *= 0.7498942093324559;
            const double ang = (double)a.pos[t] * inv;
            const double kq = rint(ang * 0.63661977236758134308);
            const double r = fma(-kq, 6.123233995736766036e-17, fma(-kq, 1.57079632679489655800, ang));
            const int quad = (int)((long long)kq & 3);
            const double r2 = r * r;
            double sp = -1.0 / 1307674368000.0; sp = fma(sp, r2, 1.0 / 6227020800.0); sp = fma(sp, r2, -1.0 / 39916800.0); sp = fma(sp, r2, 1.0 / 362880.0);
            sp = fma(sp, r2, -1.0 / 5040.0); sp = fma(sp, r2, 1.0 / 120.0); sp = fma(sp, r2, -1.0 / 6.0); sp = fma(sp * r2, r, r);
            double cp = 1.0 / 20922789888000.0; cp = fma(cp, r2, -1.0 / 87178291200.0); cp = fma(cp, r2, 1.0 / 479001600.0); cp = fma(cp, r2, -1.0 / 3628800.0);
            cp = fma(cp, r2, 1.0 / 40320.0); cp = fma(cp, r2, -1.0 / 720.0); cp = fma(cp, r2, 1.0 / 24.0); cp = fma(cp, r2, -0.5); cp = fma(cp, r2, 1.0);
            const double sn = (quad == 0) ? sp : (quad == 1) ? cp : (quad == 2) ? -sp : -cp;
            const double cs = (quad == 0) ? cp : (quad == 1) ? -sp : (quad == 2) ? -cp : sp;
            float* rp = (float*)(ws + WS_ROPE) + (size_t)i * 2; rp[0] = (float)cs; rp[1] = (float)sn;
        }
    }
    for (int r = gw; r < DEPTH * 2 * NEXP; r += NGW) {
        const int tbl = r / (DEPTH * NEXP), lr = r % (DEPTH * NEXP);
        const float* src = (tbl == 0 ? a.pu : a.pv) + (size_t)lr * 1024;
        f32x4 v[4];
        if (tbl == 0) {
#pragma unroll
            for (int i = 0; i < 4; ++i) v[i] = ((const f32x4*)src)[64 * i + lane];
            quant_row<false>(v, ws + WS_UQ + (size_t)lr * 1024, (float*)(ws + WS_USC) + lr, lane);
        } else {
#pragma unroll
            for (int i = 0; i < 4; ++i) v[i] = ((const f32x4*)src)[4 * lane + i];
            const int l = lr / NEXP, e = lr % NEXP;
            quant_row<false>(v, ws + WS_VQ + (size_t)l * NEXP * 1024 + ((size_t)(lane >> 3) * NEXP + e) * 128 + 16 * (lane & 7) - 16 * lane, (float*)(ws + WS_VSC) + lr, lane);
        }
    }
    if (op_bid() == 0) for (int i = tid; i < DEPTH * 2 * 8 * 64; i += NTHREADS) ((unsigned*)(ws + WS_CTL))[CTL_QUEUE + i] = 0u;
}

template <bool WITH_Q8>
__device__ __forceinline__ void ph_norm(const KArgs& a, const float* xin, const float* g, const float* mod_l, int shift_idx, int scale_idx, int wv) {
    const int tid = phase_tid(wv), lane = tid & 63, wave = wv;
    const int gw = op_bid() * NWAVES + wave, NGW = op_grid() * NWAVES;
    bf16_t* H = (bf16_t*)(a.ws + WS_H);
    for (int row = gw; row < T; row += NGW) {
        const int b = row >> 12;
        f32x4 v[4]; float ss = 0.f;
#pragma unroll
        for (int i = 0; i < 4; ++i) { v[i] = ((const f32x4*)(xin + (size_t)row * DM))[64 * i + lane]; ss += (v[i].x * v[i].x + v[i].y * v[i].y) + (v[i].z * v[i].z + v[i].w * v[i].w); }
        ss = wave_sum(ss);
        const float r = 1.0f / sqrtf(ss * (1.0f / DM) + NORM_EPS);
#pragma unroll
        for (int i = 0; i < 4; ++i) {
            const int col = 256 * i + 4 * lane;
            const f32x4 gg = *(const f32x4*)(g + col), sc = *(const f32x4*)(mod_l + (size_t)b * NMOD + scale_idx * DM + col), sh = *(const f32x4*)(mod_l + (size_t)b * NMOD + shift_idx * DM + col);
            v[i] = (v[i] * r) * gg * (sc + 1.0f) + sh;
            u32x2 o; o.x = pk2(v[i].x, v[i].y); o.y = pk2(v[i].z, v[i].w);
            *(u32x2*)(H + (size_t)row * DM + col) = o;
        }
        if (WITH_Q8) quant_row<false>(v, a.ws + WS_H2Q + (size_t)row * 1024, (float*)(a.ws + WS_HS) + row, lane);
    }
}
__device__ __forceinline__ void ph_final_norm(const KArgs& a, int wv) {
    const int tid = phase_tid(wv), lane = tid & 63, wave = wv;
    const int gw = op_bid() * NWAVES + wave, NGW = op_grid() * NWAVES;
    for (int row = gw; row < T; row += NGW) {
        f32x4 v[4]; float ss = 0.f;
#pragma unroll
        for (int i = 0; i < 4; ++i) { v[i] = ((const f32x4*)(a.out + (size_t)row * DM))[64 * i + lane]; ss += (v[i].x * v[i].x + v[i].y * v[i].y) + (v[i].z * v[i].z + v[i].w * v[i].w); }
        ss = wave_sum(ss);
        const float r = 1.0f / sqrtf(ss * (1.0f / DM) + NORM_EPS);
#pragma unroll
        for (int i = 0; i < 4; ++i) { const f32x4 gg = *(const f32x4*)(a.final_g + 256 * i + 4 * lane); ((f32x4*)(a.out + (size_t)row * DM))[64 * i + lane] = (v[i] * r) * gg; }
    }
}

struct EpiProj {
    static constexpr bool PERM = true, AFTER_DRAIN = false;
    unsigned char* ws;
    __device__ __forceinline__ void operator()(const pg8::f32x4 (&acc)[2][2][4][2], const pg8::Unit& u, int wr, int wc, int fr, int fq) const {
        const int row0 = u.pm * 256 + wr * 64 + fr;
        const float* rope = (const float*)(ws + WS_ROPE);
#pragma unroll
        for (int bj = 0; bj < 2; ++bj) {
            const int cgb = u.pn * 256 + bj * 128;
            bf16_t* base; int pitch, cl, mode;
            if (cgb < 512) { base = (bf16_t*)(ws + WS_QA); pitch = 512; cl = cgb; mode = 1; }
            else if (cgb < 640) { base = (bf16_t*)(ws + WS_KA); pitch = 128; cl = cgb - 512; mode = 2; }
            else if (cgb < 768) { base = (bf16_t*)(ws + WS_VA); pitch = 128; cl = cgb - 640; mode = 0; }
            else if (cgb < 1280) { base = (bf16_t*)(ws + WS_QB); pitch = 512; cl = cgb - 768; mode = 3; }
            else if (cgb < 1792) { base = (bf16_t*)(ws + WS_KB); pitch = 512; cl = cgb - 1280; mode = 0; }
            else if (cgb < 2304) { base = (bf16_t*)(ws + WS_VB); pitch = 512; cl = cgb - 1792; mode = 0; }
            else if (cgb < 3328) { base = (bf16_t*)(ws + WS_GA); pitch = 1024; cl = cgb - 2304; mode = 4; }
            else { base = (bf16_t*)(ws + WS_GB); pitch = 1024; cl = cgb - 3328; mode = 4; }
            const int col = cl + wc * 32 + 8 * fq;
#pragma unroll
            for (int ai = 0; ai < 2; ++ai)
#pragma unroll
                for (int m = 0; m < 4; ++m) {
                    const int row = row0 + ai * 128 + m * 16;
                    pg8::f32x4 v0 = acc[ai][bj][m][0], v1 = acc[ai][bj][m][1];
                    if (mode == 1 || mode == 2) {
                        const int i0 = (col & 63) >> 1;
                        const f32x4 c01 = *(const f32x4*)(rope + ((size_t)row * 32 + i0) * 2), c23 = *(const f32x4*)(rope + ((size_t)row * 32 + i0 + 2) * 2);
                        pg8::f32x4 w0, w1;
                        w0[0] = v0[0] * c01.x - v0[1] * c01.y; w0[1] = v0[1] * c01.x + v0[0] * c01.y;
                        w0[2] = v0[2] * c01.z - v0[3] * c01.w; w0[3] = v0[3] * c01.z + v0[2] * c01.w;
                        w1[0] = v1[0] * c23.x - v1[1] * c23.y; w1[1] = v1[1] * c23.x + v1[0] * c23.y;
                        w1[2] = v1[2] * c23.z - v1[3] * c23.w; w1[3] = v1[3] * c23.z + v1[2] * c23.w;
                        v0 = w0; v1 = w1;
                    }
                    if (mode == 1 || mode == 3) { v0 = v0 * QSCALE; v1 = v1 * QSCALE; }
                    if (mode == 4) {
#pragma unroll
                        for (int e = 0; e < 4; ++e) { v0[e] = 1.0f / (1.0f + __expf(-v0[e])); v1[e] = 1.0f / (1.0f + __expf(-v1[e])); }
                    }
                    u32x4 w; w.x = pk2(v0[0], v0[1]); w.y = pk2(v0[2], v0[3]); w.z = pk2(v1[0], v1[1]); w.w = pk2(v1[2], v1[3]);
                    *(u32x4*)(base + (size_t)row * pitch + col) = w;
                }
        }
    }
};
template <bool ADD> struct EpiBranch {
    static constexpr bool PERM = true, AFTER_DRAIN = false;
    const bf16_t* Gt; bf16_t* O;
    __device__ __forceinline__ void operator()(const pg8::f32x4 (&acc)[2][2][4][2], const pg8::Unit& u, int wr, int wc, int fr, int fq) const {
        const int row0 = u.pm * 256 + wr * 64 + fr, col0 = u.pn * 256 + wc * 32 + 8 * fq;
#pragma unroll
        for (int ai = 0; ai < 2; ++ai)
#pragma unroll
            for (int m = 0; m < 4; ++m)
#pragma unroll
                for (int bj = 0; bj < 2; ++bj) {
                    const size_t off = (size_t)(row0 + ai * 128 + m * 16) * DM + col0 + bj * 128;
                    const u32x4 gv = *(const u32x4*)(Gt + off);
                    const pg8::f32x4 v0 = acc[ai][bj][m][0], v1 = acc[ai][bj][m][1];
                    float r[8];
                    r[0] = bflo(gv.x) * v0[0]; r[1] = bfhi(gv.x) * v0[1]; r[2] = bflo(gv.y) * v0[2]; r[3] = bfhi(gv.y) * v0[3];
                    r[4] = bflo(gv.z) * v1[0]; r[5] = bfhi(gv.z) * v1[1]; r[6] = bflo(gv.w) * v1[2]; r[7] = bfhi(gv.w) * v1[3];
                    if (ADD) { const u32x4 ov = *(const u32x4*)(O + off);
                        r[0] += bflo(ov.x); r[1] += bfhi(ov.x); r[2] += bflo(ov.y); r[3] += bfhi(ov.y); r[4] += bflo(ov.z); r[5] += bfhi(ov.z); r[6] += bflo(ov.w); r[7] += bfhi(ov.w); }
                    u32x4 w; w.x = pk2(r[0], r[1]); w.y = pk2(r[2], r[3]); w.z = pk2(r[4], r[5]); w.w = pk2(r[6], r[7]);
                    *(u32x4*)(O + off) = w;
                }
    }
};
struct EpiWout {
    static constexpr bool PERM = false, AFTER_DRAIN = false;
    const float* xold; float* xnew; const float* gate;
    __device__ __forceinline__ void operator()(const pg8::f32x4 (&acc)[2][2][4][2], const pg8::Unit& u, int wr, int wc, int fr, int fq) const {
        const int row0 = u.pm * 256 + wr * 64 + fr, col0 = u.pn * 256 + wc * 32 + 4 * fq, b = u.pm >> 4;
#pragma unroll
        for (int bj = 0; bj < 2; ++bj)
#pragma unroll
            for (int n = 0; n < 2; ++n) {
                const pg8::f32x4 gv = *(const pg8::f32x4*)(gate + (size_t)b * NMOD + col0 + bj * 128 + n * 16);
#pragma unroll
                for (int ai = 0; ai < 2; ++ai)
#pragma unroll
                    for (int m = 0; m < 4; ++m) { const size_t off = (size_t)(row0 + ai * 128 + m * 16) * DM + col0 + bj * 128 + n * 16;
                        const pg8::f32x4 xo = *(const pg8::f32x4*)(xold + off);
                        *(pg8::f32x4*)(xnew + off) = xo + gv * acc[ai][bj][m][n]; }
            }
    }
};
struct EpiPlainBf16 {
    static constexpr bool PERM = true, AFTER_DRAIN = false;
    bf16_t* O; int ldc;
    __device__ __forceinline__ void operator()(const pg8::f32x4 (&acc)[2][2][4][2], const pg8::Unit& u, int wr, int wc, int fr, int fq) const {
        const int row0 = u.pm * 256 + wr * 64 + fr, col0 = u.pn * 256 + wc * 32 + 8 * fq;
#pragma unroll
        for (int ai = 0; ai < 2; ++ai)
#pragma unroll
            for (int m = 0; m < 4; ++m)
#pragma unroll
                for (int bj = 0; bj < 2; ++bj) {
                    const pg8::f32x4 v0 = acc[ai][bj][m][0], v1 = acc[ai][bj][m][1];
                    u32x4 w; w.x = pk2(v0[0], v0[1]); w.y = pk2(v0[2], v0[3]); w.z = pk2(v1[0], v1[1]); w.w = pk2(v1[2], v1[3]);
                    *(u32x4*)(O + (size_t)(row0 + ai * 128 + m * 16) * ldc + col0 + bj * 128) = w;
                }
    }
};

namespace att {
typedef short bf16x8 __attribute__((ext_vector_type(8)));
typedef short s16x4 __attribute__((ext_vector_type(4)));
typedef float f32x16 __attribute__((ext_vector_type(16)));
__device__ __forceinline__ int crow(int r, int hi) { return (r & 3) + 8 * (r >> 2) + 4 * hi; }
typedef float f32x2_t __attribute__((ext_vector_type(2))); typedef __bf16 bf16x2_t __attribute__((ext_vector_type(2)));
__device__ __forceinline__ unsigned cvtpk(float lo, float hi) { f32x2_t v = {lo, hi}; bf16x2_t b = __builtin_convertvector(v, bf16x2_t); return __builtin_bit_cast(unsigned, b); }
#define ATT_SBAR() __builtin_amdgcn_sched_barrier(0)

__device__ __forceinline__ void qkt(f32x16& p0, f32x16& p1, const LAS unsigned char* kslot, const bf16x8 (&qr)[4], int r32, int hi) {
    const LAS unsigned char* kb = kslot + hi * 1024 + r32 * 16;
    p0 = f32x16{}; p1 = f32x16{};
#pragma unroll
    for (int d0 = 0; d0 < 4; ++d0) {
        const bf16x8 b0 = *(const LAS bf16x8*)(kb + d0 * 2048);
        const bf16x8 b1 = *(const LAS bf16x8*)(kb + d0 * 2048 + 512);
        p0 = __builtin_amdgcn_mfma_f32_32x32x16_bf16(b0, qr[d0], p0, 0, 0, 0);
        p1 = __builtin_amdgcn_mfma_f32_32x32x16_bf16(b1, qr[d0], p1, 0, 0, 0);
    }
}
__device__ __forceinline__ void pv(f32x16 (&o)[2], int vb, bf16x8 pa0, bf16x8 pa1, bf16x8 pa2, bf16x8 pa3) {
#pragma unroll
    for (int d0 = 0; d0 < 2; ++d0) {
        s16x4 lo[4], hh[4];
#pragma unroll
        for (int ks = 0; ks < 4; ++ks) {
            asm volatile("ds_read_b64_tr_b16 %0,%1 offset:%c2" : "=&v"(lo[ks]) : "v"(vb), "i"(d0 * 4096 + ks * 1024) : "memory");
            asm volatile("ds_read_b64_tr_b16 %0,%1 offset:%c2" : "=&v"(hh[ks]) : "v"(vb), "i"(d0 * 4096 + ks * 1024 + 512) : "memory");
        }
        asm volatile("s_waitcnt lgkmcnt(0)" ::: "memory"); ATT_SBAR();
#define ATT_PK(k) (bf16x8){lo[k][0], lo[k][1], lo[k][2], lo[k][3], hh[k][0], hh[k][1], hh[k][2], hh[k][3]}
        o[d0] = __builtin_amdgcn_mfma_f32_32x32x16_bf16(pa0, ATT_PK(0), o[d0], 0, 0, 0);
        o[d0] = __builtin_amdgcn_mfma_f32_32x32x16_bf16(pa1, ATT_PK(1), o[d0], 0, 0, 0);
        o[d0] = __builtin_amdgcn_mfma_f32_32x32x16_bf16(pa2, ATT_PK(2), o[d0], 0, 0, 0);
        o[d0] = __builtin_amdgcn_mfma_f32_32x32x16_bf16(pa3, ATT_PK(3), o[d0], 0, 0, 0);
#undef ATT_PK
    }
}
__device__ __forceinline__ void pack_p(const f32x16& p0, const f32x16& p1, bf16x8& pa0, bf16x8& pa1, bf16x8& pa2, bf16x8& pa3) {
    u32x4 w0, w1, w2, w3;
    w0 = (u32x4){cvtpk(p0[0], p0[1]), cvtpk(p0[2], p0[3]), cvtpk(p0[4], p0[5]), cvtpk(p0[6], p0[7])};
    w1 = (u32x4){cvtpk(p0[8], p0[9]), cvtpk(p0[10], p0[11]), cvtpk(p0[12], p0[13]), cvtpk(p0[14], p0[15])};
    w2 = (u32x4){cvtpk(p1[0], p1[1]), cvtpk(p1[2], p1[3]), cvtpk(p1[4], p1[5]), cvtpk(p1[6], p1[7])};
    w3 = (u32x4){cvtpk(p1[8], p1[9]), cvtpk(p1[10], p1[11]), cvtpk(p1[12], p1[13]), cvtpk(p1[14], p1[15])};
    pa0 = __builtin_bit_cast(bf16x8, w0); pa1 = __builtin_bit_cast(bf16x8, w1); pa2 = __builtin_bit_cast(bf16x8, w2); pa3 = __builtin_bit_cast(bf16x8, w3);
}
__device__ __forceinline__ u32x4 tile_gload(const bf16_t* src, int pitch, int tid) { return *(const u32x4*)(src + (size_t)(tid >> 3) * pitch + (tid & 7) * 8); }
__device__ __forceinline__ void tile_kwrite(LAS unsigned char* kslot, u32x4 v, int tid) { *(LAS u32x4*)(kslot + (tid & 7) * 1024 + (tid >> 3) * 16) = v; }
__device__ __forceinline__ void tile_vwrite(LAS unsigned char* vslot, u32x4 v, int tid) { const int c = tid & 7; *(LAS u32x4*)(vslot + (c >> 2) * 4096 + (tid >> 3) * 64 + (c & 3) * 16) = v; }
__device__ __forceinline__ void store_o(const f32x16 (&o)[2], const float (&rs)[16], LAS unsigned char* stage, bf16_t* Ow, int pitch, int lane) {
    const int r32 = lane & 31, hi = lane >> 5;
    LAS bf16_t* stg = (LAS bf16_t*)stage;
#pragma unroll
    for (int r = 0; r < 16; ++r) { const int orow = crow(r, hi);
#pragma unroll
        for (int d0 = 0; d0 < 2; ++d0) stg[orow * 64 + d0 * 32 + r32] = (bf16_t)f2bf(o[d0][r] * rs[r]); }
    asm volatile("s_waitcnt lgkmcnt(0)" ::: "memory");
#pragma unroll
    for (int i = 0; i < 4; ++i) { const int row = i * 8 + (lane >> 3), ch = lane & 7; const u32x4 v = *(const LAS u32x4*)(stg + row * 64 + ch * 8); *(u32x4*)(Ow + (size_t)row * pitch + ch * 8) = v; }
    asm volatile("s_waitcnt lgkmcnt(0)" ::: "memory");
}

constexpr int SB_K0 = 0, SB_V0 = 16384, SB_STAGE = 32768, SB_FLAGS = 65536, SB_LDS_END = 65536 + 64;
template <bool EARLY_EXIT>
__device__ __forceinline__ void sb_phase(const bf16_t* Q, const bf16_t* K, const bf16_t* V, bf16_t* O, LAS unsigned char* lds, int wv) {
        const int tid = phase_tid(wv), lane = tid & 63, r32 = lane & 31, hi = lane >> 5, wid = wv;
    const int vb0 = (int)(unsigned)(uintptr_t)(lds + SB_V0) + ((lane >> 4) & 1) * 32 + (lane & 3) * 8 + (4 * hi + ((lane & 15) >> 2)) * 64;
    volatile LAS unsigned* flags = (volatile LAS unsigned*)(lds + SB_FLAGS);
    const float m0 = hi == 0 ? 1.0f : 0.0f;
    for (int unit = op_bid(); unit < BATCH * 8 * 16; unit += op_grid()) {
        const int qb = unit & 15, h = (unit >> 4) & 7, b = unit >> 7;
        const int q0 = qb * 256;
        const size_t rowbase = (size_t)b * SEQ;
        const bf16_t* Kh = K + rowbase * 512 + h * 64; const bf16_t* Vh = V + rowbase * 512 + h * 64;
        const bf16_t* Qw = Q + (rowbase + q0 + wid * 32) * 512 + h * 64;
        int kt = 4 * qb + 3;
        u32x4 kreg = tile_gload(Kh + (size_t)kt * 64 * 512, 512, tid), vreg = tile_gload(Vh + (size_t)kt * 64 * 512, 512, tid);
        bf16x8 qr[4];
#pragma unroll
        for (int d0 = 0; d0 < 4; ++d0) qr[d0] = *(const bf16x8*)(Qw + (size_t)r32 * 512 + d0 * 16 + hi * 8);
        if (tid < 16) flags[tid] = 0u;
        tile_kwrite(lds + SB_K0, kreg, tid); tile_vwrite(lds + SB_V0, vreg, tid);
        f32x16 o[2]; o[0] = f32x16{}; o[1] = f32x16{};
        float carry = 0.f;
        int cur = 0, it = 0;
        for (;;) {
            __syncthreads();
            if (EARLY_EXIT && it > 0) {
                const int fs = ((it - 1) & 1) * 8;
                unsigned all = 1u;
#pragma unroll
                for (int w = 0; w < 8; ++w) all &= flags[fs + w];
                if (all) break;
            }
            const bool more = kt > 0;
            if (more) { kreg = tile_gload(Kh + (size_t)(kt - 1) * 64 * 512, 512, tid); vreg = tile_gload(Vh + (size_t)(kt - 1) * 64 * 512, 512, tid); }
            const int D = q0 + 32 * wid - 64 * kt;
            if (D + 31 > 0) {
                f32x16 p0, p1;
                qkt(p0, p1, lds + SB_K0 + cur * 8192, qr, r32, hi);
                if (D < 64) {
                    const int qrel = D + r32;
#pragma unroll
                    for (int r = 0; r < 16; ++r) { const int kv = crow(r, hi); if (kv >= qrel) p0[r] = -INFINITY; if (kv + 32 >= qrel) p1[r] = -INFINITY; }
                }
                f32x16 l0, l1;
#pragma unroll
                for (int r = 0; r < 16; ++r) { l0[r] = fmaxf(p0[r], 0.f) + __log2f(1.0f + exp2f(-fabsf(p0[r]))); l1[r] = fmaxf(p1[r], 0.f) + __log2f(1.0f + exp2f(-fabsf(p1[r]))); }
                float tt[8], uu[8];
#pragma unroll
                for (int i = 0; i < 4; ++i) { tt[i] = (l0[4 * i] + l0[4 * i + 1]) + (l0[4 * i + 2] + l0[4 * i + 3]); tt[4 + i] = (l1[4 * i] + l1[4 * i + 1]) + (l1[4 * i + 2] + l1[4 * i + 3]); }
#pragma unroll
                for (int k = 0; k < 8; ++k) { auto rr = __builtin_amdgcn_permlane32_swap(__float_as_uint(tt[k]), __float_as_uint(tt[k]), false, false); uu[k] = __uint_as_float(hi ? rr[0] : rr[1]); }
                float sw = 0.f, base[8];
#pragma unroll
                for (int k = 7; k >= 0; --k) { base[k] = carry - (sw + m0 * uu[k]); sw += tt[k] + uu[k]; }
#pragma unroll
                for (int i = 0; i < 4; ++i) {
                    float s3 = l0[4 * i + 3], s2 = s3 + l0[4 * i + 2], s1 = s2 + l0[4 * i + 1], s0 = s1 + l0[4 * i];
                    p0[4 * i + 3] = exp2f(p0[4 * i + 3] + (base[i] - s3)); p0[4 * i + 2] = exp2f(p0[4 * i + 2] + (base[i] - s2));
                    p0[4 * i + 1] = exp2f(p0[4 * i + 1] + (base[i] - s1)); p0[4 * i] = exp2f(p0[4 * i] + (base[i] - s0));
                    s3 = l1[4 * i + 3]; s2 = s3 + l1[4 * i + 2]; s1 = s2 + l1[4 * i + 1]; s0 = s1 + l1[4 * i];
                    p1[4 * i + 3] = exp2f(p1[4 * i + 3] + (base[4 + i] - s3)); p1[4 * i + 2] = exp2f(p1[4 * i + 2] + (base[4 + i] - s2));
                    p1[4 * i + 1] = exp2f(p1[4 * i + 1] + (base[4 + i] - s1)); p1[4 * i] = exp2f(p1[4 * i] + (base[4 + i] - s0));
                }
                carry -= sw;
                bf16x8 pa0, pa1, pa2, pa3; pack_p(p0, p1, pa0, pa1, pa2, pa3);
                pv(o, vb0 + cur * 8192, pa0, pa1, pa2, pa3);
            }
            if (EARLY_EXIT) { const bool done = __all(carry < -SB_EXIT); if (lane == 0) flags[(it & 1) * 8 + wid] = done ? 1u : 0u; }
            if (!more) break;
            tile_kwrite(lds + SB_K0 + (cur ^ 1) * 8192, kreg, tid); tile_vwrite(lds + SB_V0 + (cur ^ 1) * 8192, vreg, tid);
            cur ^= 1; --kt; ++it;
        }
        float ones[16];
#pragma unroll
        for (int r = 0; r < 16; ++r) ones[r] = 1.0f;
        store_o(o, ones, lds + SB_STAGE + wid * 4096, O + (rowbase + q0 + wid * 32) * 512 + h * 64, 512, lane);
        __syncthreads();
    }
}

constexpr int SW_K0 = 0, SW_V0 = 24576, SW_STAGE = 49152, SW_WSF = 81920, SW_LDS_END = 81920 + 2048;
__device__ __forceinline__ void swa_phase(const bf16_t* Q, const bf16_t* K, const bf16_t* V, bf16_t* O, const float* sinks, LAS unsigned char* lds, int wv) {
        const int tid = phase_tid(wv), lane = tid & 63, r32 = lane & 31, hi = lane >> 5, wid = wv;
    const int vb0 = (int)(unsigned)(uintptr_t)(lds + SW_V0) + ((lane >> 4) & 1) * 32 + (lane & 3) * 8 + (4 * hi + ((lane & 15) >> 2)) * 64;
    LAS float* wsf = (LAS float*)(lds + SW_WSF) + wid * 64;
    const int g = wid >> 1, j = wid & 1;
    for (int unit = op_bid(); unit < BATCH * 2 * 64; unit += op_grid()) {
        const int qb = unit & 63, kvh = (unit >> 6) & 1, b = unit >> 7;
        const int q0 = qb * 64, hq = kvh * 4 + g;
        const size_t rowbase = (size_t)b * SEQ;
        const bf16_t* Kh = K + rowbase * 128 + kvh * 64; const bf16_t* Vh = V + rowbase * 128 + kvh * 64;
        const bf16_t* Qw = Q + (rowbase + q0 + j * 32) * 512 + hq * 64;
        __syncthreads();
#pragma unroll
        for (int i = 0; i < 3; ++i) { const int kt = qb - 2 + i;
            if (kt >= 0) { const u32x4 kv = tile_gload(Kh + (size_t)kt * 64 * 128, 128, tid), vv = tile_gload(Vh + (size_t)kt * 64 * 128, 128, tid);
                tile_kwrite(lds + SW_K0 + i * 8192, kv, tid); tile_vwrite(lds + SW_V0 + i * 8192, vv, tid); } }
        bf16x8 qr[4];
#pragma unroll
        for (int d0 = 0; d0 < 4; ++d0) qr[d0] = *(const bf16x8*)(Qw + (size_t)r32 * 512 + d0 * 16 + hi * 8);
        __syncthreads();
        const int qrel = 32 * j + r32;
        const float sink2 = sinks[hq] * LOG2E;
        float m = sink2;
#pragma unroll
        for (int i = 0; i < 3; ++i) {
            if (qb - 2 + i >= 0) {
                f32x16 p0, p1;
                qkt(p0, p1, lds + SW_K0 + i * 8192, qr, r32, hi);
#pragma unroll
                for (int r = 0; r < 16; ++r) { const int kv = crow(r, hi);
                    bool v0 = true, v1 = true;
                    if (i == 2) { v0 = kv <= qrel; v1 = kv + 32 <= qrel; }
                    if (i == 0) { v0 = kv > qrel; v1 = kv + 32 > qrel; }
                    m = fmaxf(m, fmaxf(v0 ? p0[r] : -INFINITY, v1 ? p1[r] : -INFINITY)); }
            }
        }
        { auto rr = __builtin_amdgcn_permlane32_swap(__float_as_uint(m), __float_as_uint(m), false, false); m = fmaxf(__uint_as_float(rr[0]), __uint_as_float(rr[1])); }
        float lsum = 0.f;
        f32x16 o[2]; o[0] = f32x16{}; o[1] = f32x16{};
#pragma unroll
        for (int i = 0; i < 3; ++i) {
            if (qb - 2 + i >= 0) {
                f32x16 p0, p1;
                qkt(p0, p1, lds + SW_K0 + i * 8192, qr, r32, hi);
#pragma unroll
                for (int r = 0; r < 16; ++r) { const int kv = crow(r, hi);
                    bool v0 = true, v1 = true;
                    if (i == 2) { v0 = kv <= qrel; v1 = kv + 32 <= qrel; }
                    if (i == 0) { v0 = kv > qrel; v1 = kv + 32 > qrel; }
                    p0[r] = v0 ? exp2f(p0[r] - m) : 0.f; p1[r] = v1 ? exp2f(p1[r] - m) : 0.f; lsum += p0[r] + p1[r]; }
                bf16x8 pa0, pa1, pa2, pa3; pack_p(p0, p1, pa0, pa1, pa2, pa3); pv(o, vb0 + i * 8192, pa0, pa1, pa2, pa3);
            }
        }
        { auto rr = __builtin_amdgcn_permlane32_swap(__float_as_uint(lsum), __float_as_uint(lsum), false, false); lsum = __uint_as_float(rr[0]) + __uint_as_float(rr[1]); }
        lsum += exp2f(sink2 - m);
        if (hi == 0) wsf[r32] = 1.0f / lsum;
        asm volatile("s_waitcnt lgkmcnt(0)" ::: "memory");
        float rs[16];
#pragma unroll
        for (int r = 0; r < 16; ++r) rs[r] = wsf[crow(r, hi)];
        asm volatile("s_waitcnt lgkmcnt(0)" ::: "memory");
        store_o(o, rs, lds + SW_STAGE + wid * 4096, O + (rowbase + q0 + j * 32) * 512 + hq * 64, 512, lane);
    }
}
#undef ATT_SBAR
}

namespace tk {
typedef short bf16x8 __attribute__((ext_vector_type(8)));
typedef float f32x16 __attribute__((ext_vector_type(16)));
__device__ __forceinline__ float vmax(float a, float b) { float r; asm("v_max_f32 %0, %1, %2" : "=v"(r) : "v"(a), "v"(b)); return r; }
__device__ __forceinline__ float vmin(float a, float b) { float r; asm("v_min_f32 %0, %1, %2" : "=v"(r) : "v"(a), "v"(b)); return r; }
#define TK_CE(a, b) { const float t_ = vmax(a, b); b = vmin(a, b); a = t_; }
__device__ __forceinline__ void sort16(float (&v)[16]) {
    TK_CE(v[0], v[1]) TK_CE(v[2], v[3]) TK_CE(v[0], v[2]) TK_CE(v[1], v[3]) TK_CE(v[1], v[2]) TK_CE(v[4], v[5]) TK_CE(v[6], v[7]) TK_CE(v[4], v[6])
    TK_CE(v[5], v[7]) TK_CE(v[5], v[6]) TK_CE(v[0], v[4]) TK_CE(v[2], v[6]) TK_CE(v[2], v[4]) TK_CE(v[1], v[5]) TK_CE(v[3], v[7]) TK_CE(v[3], v[5])
    TK_CE(v[1], v[2]) TK_CE(v[3], v[4]) TK_CE(v[5], v[6]) TK_CE(v[8], v[9]) TK_CE(v[10], v[11]) TK_CE(v[8], v[10]) TK_CE(v[9], v[11]) TK_CE(v[9], v[10])
    TK_CE(v[12], v[13]) TK_CE(v[14], v[15]) TK_CE(v[12], v[14]) TK_CE(v[13], v[15]) TK_CE(v[13], v[14]) TK_CE(v[8], v[12]) TK_CE(v[10], v[14]) TK_CE(v[10], v[12])
    TK_CE(v[9], v[13]) TK_CE(v[11], v[15]) TK_CE(v[11], v[13]) TK_CE(v[9], v[10]) TK_CE(v[11], v[12]) TK_CE(v[13], v[14]) TK_CE(v[0], v[8]) TK_CE(v[4], v[12])
    TK_CE(v[4], v[8]) TK_CE(v[2], v[10]) TK_CE(v[6], v[14]) TK_CE(v[6], v[10]) TK_CE(v[2], v[4]) TK_CE(v[6], v[8]) TK_CE(v[10], v[12]) TK_CE(v[1], v[9])
    TK_CE(v[5], v[13]) TK_CE(v[5], v[9]) TK_CE(v[3], v[11]) TK_CE(v[7], v[15]) TK_CE(v[7], v[11]) TK_CE(v[3], v[5]) TK_CE(v[7], v[9]) TK_CE(v[11], v[13])
    TK_CE(v[1], v[2]) TK_CE(v[3], v[4]) TK_CE(v[5], v[6]) TK_CE(v[7], v[8]) TK_CE(v[9], v[10]) TK_CE(v[11], v[12]) TK_CE(v[13], v[14])
}
__device__ __forceinline__ void bmerge16(float (&v)[16]) {
    TK_CE(v[0], v[8]) TK_CE(v[1], v[9]) TK_CE(v[2], v[10]) TK_CE(v[3], v[11]) TK_CE(v[4], v[12]) TK_CE(v[5], v[13]) TK_CE(v[6], v[14]) TK_CE(v[7], v[15])
    TK_CE(v[0], v[4]) TK_CE(v[1], v[5]) TK_CE(v[2], v[6]) TK_CE(v[3], v[7]) TK_CE(v[8], v[12]) TK_CE(v[9], v[13]) TK_CE(v[10], v[14]) TK_CE(v[11], v[15])
    TK_CE(v[0], v[2]) TK_CE(v[1], v[3]) TK_CE(v[4], v[6]) TK_CE(v[5], v[7]) TK_CE(v[8], v[10]) TK_CE(v[9], v[11]) TK_CE(v[12], v[14]) TK_CE(v[13], v[15])
    TK_CE(v[0], v[1]) TK_CE(v[2], v[3]) TK_CE(v[4], v[5]) TK_CE(v[6], v[7]) TK_CE(v[8], v[9]) TK_CE(v[10], v[11]) TK_CE(v[12], v[13]) TK_CE(v[14], v[15])
}

__device__ __forceinline__ void merge_top16(float (&a)[16], const float (&b)[16]) {
#pragma unroll
    for (int i = 0; i < 16; ++i) a[i] = vmax(a[i], b[15 - i]);
    bmerge16(a);
}
__device__ __forceinline__ float partner_f(float v, int hi) { auto rr = __builtin_amdgcn_permlane32_swap(__float_as_uint(v), __float_as_uint(v), false, false); return __uint_as_float(hi ? rr[0] : rr[1]); }
__device__ __forceinline__ void merge_partner(float (&a)[16], int hi) {
    float pp[16];
#pragma unroll
    for (int i = 0; i < 16; ++i) pp[i] = partner_f(a[i], hi);
    merge_top16(a, pp);
}
__device__ __forceinline__ void take_block(float (&v)[16], const f32x16& acc, int blk, unsigned hi4) {
#pragma unroll
    for (int r = 0; r < 16; ++r) { const unsigned code = 127u - (unsigned)(32 * blk + (r & 3) + 8 * (r >> 2)); v[r] = __uint_as_float(((__float_as_uint(acc[r]) & 0xFFFFFF80u) | code) ^ hi4); }
    sort16(v);
}
constexpr int TK_SK = 0, TK_IDX = 65536, TK_LDS_END = 65536 + 8192;
constexpr float TK_NEG = -3.4028234663852886e38f;
template <int P>
__device__ __forceinline__ void half_top16(float (&L)[16], const bf16_t* qrow, LAS unsigned char* lds, LAS unsigned char* idxslot, int r32, int hi) {
    bf16x8 qf[8];
#pragma unroll
    for (int ks = 0; ks < 8; ++ks) qf[ks] = *(const bf16x8*)(qrow + P * 128 + 16 * ks + 8 * hi);
    f32x16 acc[4];
#pragma unroll
    for (int blk = 0; blk < 4; ++blk) acc[blk] = f32x16{};
    const LAS unsigned char* ab = lds + TK_SK + P * 32768 + hi * 2048 + r32 * 16;
#pragma unroll
    for (int ks = 0; ks < 8; ++ks)
#pragma unroll
        for (int blk = 0; blk < 4; ++blk) {
            const bf16x8 af = *(const LAS bf16x8*)(ab + ks * 4096 + blk * 512);
            acc[blk] = __builtin_amdgcn_mfma_f32_32x32x16_bf16(af, qf[ks], acc[blk], 0, 0, 0);
        }
    const unsigned hi4 = (unsigned)hi << 2;
    float M[16];
    take_block(L, acc[0], 0, hi4); take_block(M, acc[1], 1, hi4); merge_top16(L, M);
    { float N[16]; take_block(M, acc[2], 2, hi4); take_block(N, acc[3], 3, hi4); merge_top16(M, N); }
    merge_top16(L, M);
    merge_partner(L, hi);
    if (hi == 0) {
        u32x4 w;
#pragma unroll
        for (int q = 0; q < 4; ++q) w[q] = (__float_as_uint(L[4 * q]) & 127u) | ((__float_as_uint(L[4 * q + 1]) & 127u) << 8) | ((__float_as_uint(L[4 * q + 2]) & 127u) << 16) | ((__float_as_uint(L[4 * q + 3]) & 127u) << 24);
        *(LAS u32x4*)(idxslot + P * 16) = w;
    }
}
__device__ __forceinline__ float cand(float x, float y, unsigned code, unsigned hi8) { return __uint_as_float((__float_as_uint(x + y) & 0xFFFFFE00u) | code | hi8); }

__device__ __forceinline__ void topk_phase(const bf16_t* Q2, const bf16_t* SKl, int* IDX, float* GATE, LAS unsigned char* lds, int wv) {
        const int tid = phase_tid(wv), lane = tid & 63, r32 = lane & 31, hi = lane >> 5, wid = wv;
    LAS unsigned char* idxslot = lds + TK_IDX + wid * 1024 + r32 * 32;
    int cur_h = -1;
    for (int unit = op_bid(); unit < 8 * (T / 256); unit += op_grid()) {
        const int h = unit & 7, tb = unit >> 3;
        if (h != cur_h) {
            __syncthreads();
#pragma unroll
            for (int i = 0; i < 8; ++i) { const int id = tid + 512 * i, c = id & 15, n = (id >> 4) & 127, p = id >> 11;
                const u32x4 v = *(const u32x4*)(SKl + ((size_t)(h * 2 + p) * 128 + n) * 128 + c * 8);
                *(LAS u32x4*)(lds + TK_SK + p * 32768 + c * 2048 + n * 16) = v; }
            __syncthreads();
            cur_h = h;
        }
        const size_t token = (size_t)tb * 256 + wid * 32 + r32;
        const bf16_t* qrow = Q2 + token * PQ + h * 256;
        float a[16], b[16];
        half_top16<0>(a, qrow, lds, idxslot, r32, hi);
        half_top16<1>(b, qrow, lds, idxslot, r32, hi);
        float x[16], y[16];
#pragma unroll
        for (int i = 0; i < 16; ++i) { float av = a[i], bv = b[i]; asm volatile("" : "+v"(av), "+v"(bv)); x[i] = hi ? bv : av; y[i] = hi ? av : bv; }
        const unsigned hi8 = (unsigned)hi << 8;
        float A[16], B[16];
#pragma unroll
        for (int j = 1; j < 16; ++j) A[j - 1] = cand(x[0], y[j], (unsigned)j, hi8);
        A[15] = TK_NEG;
#pragma unroll
        for (int j = 2; j < 8; ++j) B[j - 2] = cand(x[1], y[j], (unsigned)(16 + j), hi8);
        B[6] = cand(x[2], y[3], 2u * 16u + 3u, hi8); B[7] = cand(x[2], y[4], 2u * 16u + 4u, hi8);
#pragma unroll
        for (int i = 0; i < 4; ++i) { const float d = cand(x[i], y[i], (unsigned)(17 * i), hi8); B[8 + i] = hi ? TK_NEG : d; }
        B[12] = TK_NEG; B[13] = TK_NEG; B[14] = TK_NEG; B[15] = TK_NEG;
        sort16(B);
        merge_top16(A, B);
        merge_partner(A, hi);
        const float smax = A[0];
        float ex[8]; int eidx[8]; float lsum = 0.f;
        asm volatile("s_waitcnt lgkmcnt(0)" ::: "memory");
#pragma unroll
        for (int k = 0; k < 8; ++k) {
            float s_lo = A[k], s_hi = A[8 + k]; asm volatile("" : "+v"(s_lo), "+v"(s_hi)); const float s = hi ? s_hi : s_lo;
            ex[k] = __expf(s - smax); lsum += ex[k];
            const unsigned code = __float_as_uint(s) & 0x1FFu, src = code >> 8, ci = (code >> 4) & 15u, cj = code & 15u;
            const unsigned ai = src ? cj : ci, bi = src ? ci : cj;
            const unsigned ca = idxslot[ai], cb = idxslot[16 + bi];
            eidx[k] = (int)(((ca ^ 127u) << 7) | (cb ^ 127u));
        }
        const float tot = lsum + partner_f(lsum, hi);
        const float inv = 1.0f / tot;
        int* ip = IDX + token * 128 + h * 16 + 8 * hi; float* gp = GATE + token * 128 + h * 16 + 8 * hi;
        *(u32x4*)ip = (u32x4){(unsigned)eidx[0], (unsigned)eidx[1], (unsigned)eidx[2], (unsigned)eidx[3]};
        *(u32x4*)(ip + 4) = (u32x4){(unsigned)eidx[4], (unsigned)eidx[5], (unsigned)eidx[6], (unsigned)eidx[7]};
        *(f32x4*)gp = (f32x4){ex[0] * inv, ex[1] * inv, ex[2] * inv, ex[3] * inv};
        *(f32x4*)(gp + 4) = (f32x4){ex[4] * inv, ex[5] * inv, ex[6] * inv, ex[7] * inv};
        asm volatile("s_waitcnt lgkmcnt(0)" ::: "memory");
    }
}
}

namespace peer3 {
__device__ __forceinline__ unsigned xcc_id() { return (unsigned)__builtin_amdgcn_s_getreg((3 << 11) | 20) & 7u; }
constexpr int UNIT = 16, NUNIT = T / UNIT;
template <int CTRL> __device__ __forceinline__ int dpp_i(int v) { return __builtin_amdgcn_update_dpp(0, v, CTRL, 0xF, 0xF, true); }
__device__ __forceinline__ int rowsum16(int v) { v += dpp_i<0xB1>(v); v += dpp_i<0x4E>(v); v += dpp_i<0x141>(v); v += dpp_i<0x140>(v); return v; }
__device__ __forceinline__ float gelu_as(float v) {
    const float av = fabsf(v), t = __builtin_amdgcn_rcpf(fmaf(av, 0.2316418882f, 1.0f));
    float q = fmaf(t, 0.5307027145f, -0.7265760135f); q = fmaf(q, t, 0.7107068705f); q = fmaf(q, t, -0.142248368f); q = fmaf(q, t, 0.127414796f); q = q * t;
    const float e = __builtin_amdgcn_exp2f(v * v * -0.72134752044f), m = v * (q * e);
    return v < 0.f ? m : v - m;
}
__device__ __forceinline__ unsigned take_async(unsigned* p, int lane) { unsigned v = 0u; if (lane == 0) v = __hip_atomic_fetch_add(p, 1u, __ATOMIC_RELAXED, __HIP_MEMORY_SCOPE_AGENT); return v; }

constexpr int UST = 6;
__device__ __forceinline__ void u_unit(const KArgs& a, int l, unsigned s, unsigned unit, LAS unsigned char* wlds, int lane) {
    const unsigned char* UQ = a.ws + WS_UQ + (size_t)l * NEXP * 1024;
    const float* USC = (const float*)(a.ws + WS_USC) + l * NEXP; const float* VSC = (const float*)(a.ws + WS_VSC) + l * NEXP;
    const int* IDX = (const int*)(a.ws + WS_IDX); const float* GATE = (const float*)(a.ws + WS_GATE);
    const unsigned char* HQ = a.ws + WS_H2Q; const float* HS = (const float*)(a.ws + WS_HS);
    float* COEF = (float*)(a.ws + WS_COEF);
    LAS int* lst = (LAS int*)wlds; LAS float* res = (LAS float*)(wlds + 512);
    const int q = lane >> 4, r = lane & 15;
    const size_t t0 = (size_t)unit * UNIT;
    int idx0 = IDX[t0 * 128 + lane], idx1 = IDX[t0 * 128 + 64 + lane];
    float g0 = GATE[t0 * 128 + lane], g1 = GATE[t0 * 128 + 64 + lane], sh = HS[t0];
    u32x4 hv[4];
#pragma unroll
    for (int k = 0; k < 4; ++k) hv[k] = *(const u32x4*)(HQ + t0 * 1024 + 256 * k + 16 * r);
#pragma unroll 1
    for (int i = 0; i < UNIT; ++i) {
        const size_t t = t0 + i, tn = t0 + (i + 1 < UNIT ? i + 1 : i);
        const float us0 = USC[idx0], us1 = USC[idx1], vs0 = VSC[idx0], vs1 = VSC[idx1];
        const int nidx0 = IDX[tn * 128 + lane], nidx1 = IDX[tn * 128 + 64 + lane];
        const float ng0 = GATE[tn * 128 + lane], ng1 = GATE[tn * 128 + 64 + lane], nsh = HS[tn];
        const bool in0 = (unsigned)(idx0 >> 11) == s, in1 = (unsigned)(idx1 >> 11) == s;
        const unsigned long long m0 = __ballot(in0), m1 = __ballot(in1);
        const int c0 = __builtin_popcountll(m0), n = c0 + __builtin_popcountll(m1);
        const int rank0 = (int)__builtin_amdgcn_mbcnt_hi((unsigned)(m0 >> 32), __builtin_amdgcn_mbcnt_lo((unsigned)m0, 0u));
        const int rank1 = c0 + (int)__builtin_amdgcn_mbcnt_hi((unsigned)(m1 >> 32), __builtin_amdgcn_mbcnt_lo((unsigned)m1, 0u));
        if (in0) lst[rank0] = idx0;
        if (in1) lst[rank1] = idx1;
#pragma unroll 1
        for (int base = 0; base < n; base += 4 * UST) {
            const int nst = (n - base + 3) >> 2;
            u32x4 uv[UST][4];
#pragma unroll
            for (int st = 0; st < UST; ++st) {
                if (st < nst) {
                    int slot = base + 4 * st + q; slot = slot < n ? slot : n - 1;
                    const unsigned char* rp = UQ + (size_t)lst[slot] * 1024 + 16 * r;
#pragma unroll
                    for (int k = 0; k < 4; ++k) uv[st][k] = *(const u32x4*)(rp + 256 * k);
                }
            }
#pragma unroll
            for (int st = 0; st < UST; ++st) {
                if (st < nst) {
                    int s0_ = 0, s1_ = 0, s2_ = 0, s3_ = 0;
#pragma unroll
                    for (int k = 0; k < 4; ++k) {
                        s0_ = __builtin_amdgcn_sdot4((int)uv[st][k].x, (int)hv[k].x, s0_, false); s1_ = __builtin_amdgcn_sdot4((int)uv[st][k].y, (int)hv[k].y, s1_, false);
                        s2_ = __builtin_amdgcn_sdot4((int)uv[st][k].z, (int)hv[k].z, s2_, false); s3_ = __builtin_amdgcn_sdot4((int)uv[st][k].w, (int)hv[k].w, s3_, false);
                    }
                    const int tot = rowsum16((s0_ + s1_) + (s2_ + s3_));
                    if (r == 0) res[base + 4 * st + q] = (float)tot;
                }
            }
        }
        const float d0 = in0 ? res[rank0] : 0.f, d1 = in1 ? res[rank1] : 0.f;
        u32x4 nhv[4];
#pragma unroll
        for (int k = 0; k < 4; ++k) nhv[k] = *(const u32x4*)(HQ + tn * 1024 + 256 * k + 16 * r);
        if (in0) COEF[t * 128 + lane] = gelu_as(d0 * us0 * sh) * g0 * vs0;
        if (in1) COEF[t * 128 + 64 + lane] = gelu_as(d1 * us1 * sh) * g1 * vs1;
        idx0 = nidx0; idx1 = nidx1; g0 = ng0; g1 = ng1; sh = nsh;
#pragma unroll
        for (int k = 0; k < 4; ++k) hv[k] = nhv[k];
    }
}
struct VMeta { u32x4 iv[4]; f32x4 cv[4]; };
__device__ __forceinline__ void v_meta(VMeta& m, const int* IDX, const float* COEF, size_t t, int g) {
#pragma unroll
    for (int q = 0; q < 4; ++q) { m.iv[q] = *(const u32x4*)(IDX + t * 128 + 16 * g + 4 * q); m.cv[q] = *(const f32x4*)(COEF + t * 128 + 16 * g + 4 * q); }
}
__device__ __forceinline__ void v_stage(u32x4 (&P)[16], u32x4& CQ, float& cs, const VMeta& m, const unsigned char* VS) {
    float cm = 0.f;
#pragma unroll
    for (int j = 0; j < 16; ++j) cm = fmaxf(cm, fabsf(m.cv[j >> 2][j & 3]));
    cm = fmaxf(cm, swz_xor<8>(cm)); cm = fmaxf(cm, swz_xor<16>(cm));
    { auto rr = __builtin_amdgcn_permlane32_swap(__float_as_uint(cm), __float_as_uint(cm), false, false); cm = fmaxf(__uint_as_float(rr[0]), __uint_as_float(rr[1])); }
    const float inv = cm > 0.f ? 127.0f / cm : 0.f; cs = cm * (1.0f / 127.0f);
#pragma unroll
    for (int qd = 0; qd < 4; ++qd) {
        const int c0 = (int)rintf(m.cv[qd][0] * inv), c1 = (int)rintf(m.cv[qd][1] * inv), c2 = (int)rintf(m.cv[qd][2] * inv), c3 = (int)rintf(m.cv[qd][3] * inv);
        CQ[qd] = (unsigned)(c0 & 0xff) | ((unsigned)(c1 & 0xff) << 8) | ((unsigned)(c2 & 0xff) << 16) | ((unsigned)(c3 & 0xff) << 24);
    }
#pragma unroll
    for (int j = 0; j < 16; ++j) P[j] = *(const u32x4*)(VS + (size_t)m.iv[j >> 2][j & 3] * 128);
}
__device__ __forceinline__ void v_compute(const u32x4 (&P)[16], const u32x4& CQ, float cs, float* xout, const float* mod_l, size_t t, unsigned s, int lane) {
    const int g = lane >> 3, p = lane & 7; const bool b4 = (lane >> 4) & 1, b3 = (lane >> 3) & 1;
    typedef float f32x2 __attribute__((ext_vector_type(2)));
    const int col = (int)s * 128 + 16 * p + 2 * g, b = (int)(t >> 12);
    float* xp = xout + t * DM + col;
    f32x2 xv = *(const f32x2*)xp;
    const f32x2 gt = *(const f32x2*)(mod_l + (size_t)b * NMOD + 5 * DM + col);
    int acc[16];
#pragma unroll
    for (int k = 0; k < 16; ++k) acc[k] = 0;
#pragma unroll
    for (int qd = 0; qd < 4; ++qd)
#pragma unroll
        for (int w = 0; w < 4; ++w) {
            const unsigned A = P[4 * qd][w], B = P[4 * qd + 1][w], C = P[4 * qd + 2][w], D = P[4 * qd + 3][w];
            const unsigned X = __builtin_amdgcn_perm(B, A, 0x05010400u), Y = __builtin_amdgcn_perm(B, A, 0x07030602u);
            const unsigned Z = __builtin_amdgcn_perm(D, C, 0x05010400u), W = __builtin_amdgcn_perm(D, C, 0x07030602u);
            const unsigned T0 = __builtin_amdgcn_perm(Z, X, 0x05040100u), T1 = __builtin_amdgcn_perm(Z, X, 0x07060302u);
            const unsigned T2 = __builtin_amdgcn_perm(W, Y, 0x05040100u), T3 = __builtin_amdgcn_perm(W, Y, 0x07060302u);
            acc[4 * w + 0] = __builtin_amdgcn_sdot4((int)T0, (int)CQ[qd], acc[4 * w + 0], false); acc[4 * w + 1] = __builtin_amdgcn_sdot4((int)T1, (int)CQ[qd], acc[4 * w + 1], false);
            acc[4 * w + 2] = __builtin_amdgcn_sdot4((int)T2, (int)CQ[qd], acc[4 * w + 2], false); acc[4 * w + 3] = __builtin_amdgcn_sdot4((int)T3, (int)CQ[qd], acc[4 * w + 3], false);
        }
    int r8[8], r4[4], r2[2];
#pragma unroll
    for (int q = 0; q < 8; ++q) { auto rr = __builtin_amdgcn_permlane32_swap((unsigned)acc[q], (unsigned)acc[8 + q], false, false); r8[q] = (int)rr[0] + (int)rr[1]; }
#pragma unroll
    for (int q = 0; q < 4; ++q) { int lo = r8[q], hi = r8[4 + q]; asm volatile("" : "+v"(lo), "+v"(hi)); const int keep = b4 ? hi : lo, send = b4 ? lo : hi; r4[q] = keep + __builtin_amdgcn_ds_swizzle(send, (16 << 10) | 0x1f); }
#pragma unroll
    for (int q = 0; q < 2; ++q) { int lo = r4[q], hi = r4[2 + q]; asm volatile("" : "+v"(lo), "+v"(hi)); const int keep = b3 ? hi : lo, send = b3 ? lo : hi; r2[q] = keep + __builtin_amdgcn_ds_swizzle(send, (8 << 10) | 0x1f); }
    xv.x += gt.x * ((float)r2[0] * cs); xv.y += gt.y * ((float)r2[1] * cs);
    *(f32x2*)xp = xv;
}
__device__ __forceinline__ void v_unit(const KArgs& a, int l, const float* mod_l, unsigned s, unsigned unit, int lane) {
    const int g = lane >> 3, p = lane & 7;
    const unsigned char* VS = a.ws + WS_VQ + (size_t)l * NEXP * 1024 + (size_t)s * NEXP * 128 + 16 * p;
    const int* IDX = (const int*)(a.ws + WS_IDX); const float* COEF = (const float*)(a.ws + WS_COEF);
    const size_t t0 = (size_t)unit * UNIT;
    VMeta m; v_meta(m, IDX, COEF, t0, g);
    u32x4 PA[16], PB[16], CQA, CQB; float csA, csB;
    v_stage(PA, CQA, csA, m, VS);
    v_meta(m, IDX, COEF, t0 + 1, g);
#pragma unroll 1
    for (int i = 0; i < UNIT; i += 2) {
        v_stage(PB, CQB, csB, m, VS);
        v_meta(m, IDX, COEF, t0 + (i + 2 < UNIT ? i + 2 : i), g);
        v_compute(PA, CQA, csA, a.out, mod_l, t0 + i, s, lane);
        if (i + 2 < UNIT) { v_stage(PA, CQA, csA, m, VS); v_meta(m, IDX, COEF, t0 + (i + 3 < UNIT ? i + 3 : i), g); }
        v_compute(PB, CQB, csB, a.out, mod_l, t0 + i + 1, s, lane);
    }
}
template <bool VSTEP>
__device__ __forceinline__ void peer_phase(const KArgs& a, int l, const float* mod_l, unsigned* cnt, LAS unsigned char* lds, int wv) {
        const int tid = phase_tid(wv), lane = tid & 63, wid = wv;
    LAS unsigned char* wlds = lds + wid * 1024;
    const unsigned home = xcc_id();
    unsigned ss = 0, s = home;
    unsigned nxt = take_async(cnt + 64 * s, lane);
    for (;;) {
        const unsigned cur = (unsigned)__builtin_amdgcn_readfirstlane((int)nxt);
        if (cur >= (unsigned)NUNIT) { if (++ss == 8u) break; s = (home + ss) & 7u; nxt = take_async(cnt + 64 * s, lane); continue; }
        nxt = take_async(cnt + 64 * s, lane);
        if (VSTEP) v_unit(a, l, mod_l, s, cur, lane); else u_unit(a, l, s, cur, wlds, lane);
    }
}
}

constexpr int PH_PER_LAYER = 10, NPHASES = 1 + DEPTH * PH_PER_LAYER + 1;
#ifndef PHASE_MASK
#define PHASE_MASK 0xFFFF
#endif
#define HASP(k) (((PHASE_MASK) >> (k)) & 1)
#ifndef SB_EARLY_EXIT
#define SB_EARLY_EXIT 1
#endif

typedef const __attribute__((address_space(4))) KArgs* KArgsP;
__device__ __forceinline__ KArgsP kargs() { KArgsP p = (KArgsP)__builtin_amdgcn_kernarg_segment_ptr(); asm volatile("" : "+s"(p)); return p; }

__device__ __forceinline__ void load_args(KArgs& a) {
#if defined(__HIP_DEVICE_COMPILE__)
    KArgsP p = kargs();
    a.x = p->x; a.c = p->c; a.pos = p->pos; a.ada_w = p->ada_w; a.ada_b = p->ada_b; a.norm1_g = p->norm1_g; a.w_in = p->w_in; a.sinks = p->sinks; a.wbr_a = p->wbr_a; a.wbr_b = p->wbr_b;
    a.w_out = p->w_out; a.norm2_g = p->norm2_g; a.wq = p->wq; a.subkeys = p->subkeys; a.pu = p->pu; a.pv = p->pv; a.final_g = p->final_g; a.out = p->out; a.ws = p->ws; a.ph_lo = p->ph_lo; a.ph_hi = p->ph_hi;
#endif
}
__global__ void __launch_bounds__(NTHREADS, 2) fwd_kernel(KArgs a_unused) {
    extern __shared__ __attribute__((aligned(16))) unsigned char lds_raw[];
    LAS unsigned char* lds = (LAS unsigned char*)lds_raw;
    cg::grid_group grid = cg::this_grid();
    const int ph_lo = kargs()->ph_lo, ph_hi = kargs()->ph_hi;
    const int wv = __builtin_amdgcn_readfirstlane((int)threadIdx.x >> 6);
#define IN(k) (ph_lo <= (k) && (k) < ph_hi)
#ifdef PROBE_PH
    unsigned long long pr_prev = __builtin_amdgcn_s_memrealtime(), pr_acc = 0;
#define PROBE_MATCH(k) ((PROBE_PH) >= 100 ? ((k) >= 1 && (k) < NPHASES - 1 && (((k) - 1) % PH_PER_LAYER) == (PROBE_PH) - 100) : (k) == (PROBE_PH))
#define SEAM(k) do { if (IN(k) && IN((k) + 1)) grid.sync(); { const unsigned long long now_ = __builtin_amdgcn_s_memrealtime(); if (PROBE_MATCH(k)) pr_acc += now_ - pr_prev; pr_prev = now_; } } while (0)
#else
#define SEAM(k) do { if (IN(k) && IN((k) + 1)) grid.sync(); } while (0)
#endif
#define LOADARGS KArgs a; load_args(a); unsigned char* ws = a.ws; const int G = op_grid(); (void)G; (void)ws
#define LAYERARGS const float* mod_l = (const float*)(ws + WS_MOD) + (size_t)l * 8 * NMOD; const float* xcur = (l == 0) ? a.x : a.out; (void)mod_l; (void)xcur
    if (IN(0)) { if (HASP(0)) { LOADARGS; ph_prologue(a, lds, wv); } }
    SEAM(0);
#pragma unroll 1
    for (int l = 0; l < DEPTH; ++l) {
        const int p0 = 1 + l * PH_PER_LAYER;
        if (IN(p0 + 0)) { if (HASP(1)) { LOADARGS; LAYERARGS; ph_norm<false>(a, xcur, a.norm1_g + l * DM, mod_l, 0, 1, wv); } }
        SEAM(p0 + 0);
        if (IN(p0 + 1)) { if (HASP(2)) { LOADARGS; pg8::Gemm g{(const bf16_t*)(ws + WS_H), (const bf16_t*)(ws + WS_WIN) + (size_t)l * NPROJ * 1024, T, NPROJ, 1024};
                  pg8::StaticOrder S; S.init(T, NPROJ, G, op_bid()); EpiProj E{ws};
                  pg8::gemm_phase<EpiProj, pg8::StaticOrder, true, true>(lds, g, S, E, wv); } }
        SEAM(p0 + 1);
        if (IN(p0 + 2)) { if (HASP(3)) { LOADARGS;
                  att::swa_phase((const bf16_t*)(ws + WS_QA), (const bf16_t*)(ws + WS_KA), (const bf16_t*)(ws + WS_VA), (bf16_t*)(ws + WS_QA), a.sinks + l * 8, lds, wv);
                  __syncthreads();
                  att::sb_phase<SB_EARLY_EXIT != 0>((const bf16_t*)(ws + WS_QB), (const bf16_t*)(ws + WS_KB), (const bf16_t*)(ws + WS_VB), (bf16_t*)(ws + WS_QB), lds, wv); } }
        SEAM(p0 + 2);
        if (IN(p0 + 3)) { if (HASP(4)) { LOADARGS; pg8::StaticOrder S; S.init(T, DM, G, op_bid());
                  { pg8::Gemm g{(const bf16_t*)(ws + WS_QA), (const bf16_t*)(ws + WS_WBA) + (size_t)l * 1024 * 512, T, DM, 512};
                    EpiBranch<false> E{(const bf16_t*)(ws + WS_GA), (bf16_t*)(ws + WS_H)};
                    pg8::gemm_phase<EpiBranch<false>, pg8::StaticOrder, true, true>(lds, g, S, E, wv); }
                  __syncthreads();
                  { pg8::Gemm g{(const bf16_t*)(ws + WS_QB), (const bf16_t*)(ws + WS_WBB) + (size_t)l * 1024 * 512, T, DM, 512};
                    EpiBranch<true> E{(const bf16_t*)(ws + WS_GB), (bf16_t*)(ws + WS_H)};
                    pg8::gemm_phase<EpiBranch<true>, pg8::StaticOrder, true, true>(lds, g, S, E, wv); } } }
        SEAM(p0 + 3);
        if (IN(p0 + 4)) { if (HASP(5)) { LOADARGS; LAYERARGS; pg8::Gemm g{(const bf16_t*)(ws + WS_H), (const bf16_t*)(ws + WS_WOUT) + (size_t)l * 1024 * 1024, T, DM, 1024};
                  pg8::StaticOrder S; S.init(T, DM, G, op_bid()); EpiWout E{xcur, a.out, mod_l + 2 * DM};
                  pg8::gemm_phase<EpiWout, pg8::StaticOrder, true, true>(lds, g, S, E, wv); } }
        SEAM(p0 + 4);
        if (IN(p0 + 5)) { if (HASP(6)) { LOADARGS; LAYERARGS; ph_norm<true>(a, a.out, a.norm2_g + l * DM, mod_l, 3, 4, wv); } }
        SEAM(p0 + 5);
        if (IN(p0 + 6)) { if (HASP(7)) { LOADARGS; pg8::Gemm g{(const bf16_t*)(ws + WS_H), (const bf16_t*)(ws + WS_WQ) + (size_t)l * PQ * 1024, T, PQ, 1024};
                  pg8::StaticOrder S; S.init(T, PQ, G, op_bid()); EpiPlainBf16 E{(bf16_t*)(ws + WS_Q2), PQ};
                  pg8::gemm_phase<EpiPlainBf16, pg8::StaticOrder, true, true>(lds, g, S, E, wv); } }
        SEAM(p0 + 6);
        if (IN(p0 + 7)) { if (HASP(8)) { LOADARGS; tk::topk_phase((const bf16_t*)(ws + WS_Q2), (const bf16_t*)(ws + WS_SK) + (size_t)l * 8 * 2 * 128 * 128, (int*)(ws + WS_IDX), (float*)(ws + WS_GATE), lds, wv); } }
        SEAM(p0 + 7);
        if (IN(p0 + 8)) { if (HASP(9)) { LOADARGS; peer3::peer_phase<false>(a, l, nullptr, (unsigned*)(ws + WS_CTL) + CTL_QUEUE + (l * 2 + 0) * 8 * 64, lds, wv); } }
        SEAM(p0 + 8);
        if (IN(p0 + 9)) { if (HASP(10)) { LOADARGS; LAYERARGS; peer3::peer_phase<true>(a, l, mod_l, (unsigned*)(ws + WS_CTL) + CTL_QUEUE + (l * 2 + 1) * 8 * 64, lds, wv); } }
        SEAM(p0 + 9);
    }
    if (IN(NPHASES - 1)) { if (HASP(11)) { LOADARGS; ph_final_norm(a, wv); } }
#ifdef PROBE_PH
    { const unsigned long long now_ = __builtin_amdgcn_s_memrealtime(); if (PROBE_MATCH(NPHASES - 1)) pr_acc += now_ - pr_prev;
      if (blockIdx.x == 0 && threadIdx.x == 0) { const unsigned long long t0_ = __builtin_amdgcn_s_memrealtime(); while (__builtin_amdgcn_s_memrealtime() - t0_ < pr_acc * (PROBE_K)) __builtin_amdgcn_s_sleep(16); } }
#endif
#undef IN
#undef SEAM
}

#ifndef N_LAUNCH_SPLIT
#define N_LAUNCH_SPLIT 1
#endif
extern "C" void kernel_launch(void* const* d_in, const int* in_sizes, int n_in, void* d_out, int out_size, void* d_ws, size_t ws_size, hipStream_t stream) {
    static int grid = 0;
    if (grid == 0) {
        if (n_in != 17 || out_size != T * DM || ws_size < WS_END) { fprintf(stderr, "kernel_launch: unexpected problem (n_in %d out %d ws %zu)\n", n_in, out_size, ws_size); grid = -1; return; }
        int dev = 0, cus = 0, per_cu = 0;
        (void)hipGetDevice(&dev);
        (void)hipDeviceGetAttribute(&cus, hipDeviceAttributeMultiprocessorCount, dev);
        (void)hipFuncSetAttribute((const void*)fwd_kernel, hipFuncAttributeMaxDynamicSharedMemorySize, LDS_BYTES);
        (void)hipOccupancyMaxActiveBlocksPerMultiprocessor(&per_cu, (const void*)fwd_kernel, NTHREADS, LDS_BYTES);
        if (per_cu < 1) { fprintf(stderr, "kernel_launch: occupancy query says %d\n", per_cu); per_cu = 1; }
        grid = cus;
        fprintf(stderr, "kernel_launch: cus %d per_cu %d grid %d ws %zu\n", cus, per_cu, grid, ws_size);
    }
    if (grid < 0) return;
    KArgs a{};
    a.x = (const float*)d_in[0]; a.c = (const float*)d_in[1]; a.pos = (const int*)d_in[2]; a.ada_w = (const float*)d_in[3]; a.ada_b = (const float*)d_in[4];
    a.norm1_g = (const float*)d_in[5]; a.w_in = (const float*)d_in[6]; a.sinks = (const float*)d_in[7]; a.wbr_a = (const float*)d_in[8]; a.wbr_b = (const float*)d_in[9];
    a.w_out = (const float*)d_in[10]; a.norm2_g = (const float*)d_in[11]; a.wq = (const float*)d_in[12]; a.subkeys = (const float*)d_in[13]; a.pu = (const float*)d_in[14];
    a.pv = (const float*)d_in[15]; a.final_g = (const float*)d_in[16]; a.out = (float*)d_out; a.ws = (unsigned char*)d_ws;
#if N_LAUNCH_SPLIT
    a.ph_lo = 0; a.ph_hi = NPHASES;
    { void* args[] = {&a};
      hipError_t e = hipLaunchCooperativeKernel((void*)fwd_kernel, dim3(grid), dim3(NTHREADS), args, LDS_BYTES, stream);
      if (e != hipSuccess) fprintf(stderr, "cooperative launch failed: %s (grid %d)\n", hipGetErrorString(e), grid); }
#else
    for (int ph = 0; ph < NPHASES; ++ph) {
        a.ph_lo = ph; a.ph_hi = ph + 1;
        void* args[] = {&a};
        hipError_t e = hipLaunchCooperativeKernel((void*)fwd_kernel, dim3(grid), dim3(NTHREADS), args, LDS_BYTES, stream);
        if (e != hipSuccess) { fprintf(stderr, "cooperative launch %d failed: %s (grid %d)\n", ph, hipGetErrorString(e), grid); break; }
    }
#endif
}
```

```cpp
#include <hip/hip_runtime.h>
#include <hip/hip_cooperative_groups.h>
#include <cstdio>
#include <cstdint>
namespace cg = cooperative_groups;

namespace pg8 {
#define PG8_LAS __attribute__((address_space(3)))
typedef unsigned short bf16_t;
typedef short bf16x8 __attribute__((ext_vector_type(8)));
typedef float f32x4 __attribute__((ext_vector_type(4)));
typedef unsigned u32x4 __attribute__((ext_vector_type(4)));
constexpr int BM = 256, BK = 64, HALF = 128, HTB = HALF * BK * 2  , STAGE_BYTES = 8 * HTB, NXCD = 8, WGM = 8;

__host__ __device__ __forceinline__ int lds_byte(int r, int c) { const int st = (r >> 4) * 2 + (c >> 5), rr = r & 15, cc = c & 31, ob = rr * 64 + cc * 2; return st * 1024 + (ob ^ (((ob >> 9) & 1) << 5)); }
__host__ __device__ __forceinline__ void stage_rc(int b, int& R, int& C) { const int st = b / 1024, sb = b % 1024, swz = sb ^ (((sb >> 9) & 1) << 5); R = (st >> 1) * 16 + swz / 64; C = (st & 1) * 32 + (swz % 64) / 2; }
__host__ __device__ __forceinline__ int perm32(int rho) { const int n = rho >> 4, i = rho & 15; return 8 * (i >> 2) + 4 * n + (i & 3); }

struct Unit { int pm, pn; };
struct Gemm { const bf16_t* A; const bf16_t* Bt; int M, N, K; };

struct StaticOrder {
    int nM, nN, nwg, G, c;
    __host__ __device__ void init(int M, int N, int G_, int c_) { nM = M / BM; nN = N / BM; nwg = nM * nN; G = G_; c = c_; }
    __host__ __device__ bool next(int i, Unit& u) const {
        const long L = (long)i * G + c; if (L >= nwg) return false;
        int wgid = (int)L; { const int q = nwg / NXCD, r = nwg % NXCD, xcd = wgid % NXCD, off = wgid / NXCD; wgid = (xcd < r ? xcd * (q + 1) : r * (q + 1) + (xcd - r) * q) + off; }
        const int nig = WGM * nN, gid = wgid / nig, fm = gid * WGM, gsz = (nM - fm) < WGM ? (nM - fm) : WGM;
        u.pm = fm + ((wgid % nig) % gsz); u.pn = (wgid % nig) / gsz; return true;
    }
    __device__ __forceinline__ void a_ready(const Unit&) const {}
    __device__ __forceinline__ void done(const Unit&) const {}
};


__device__ __forceinline__ unsigned cvt_pk_bf16(float lo, float hi) { unsigned r; asm volatile("v_cvt_pk_bf16_f32 %0, %1, %2" : "=v"(r) : "v"(lo), "v"(hi)); return r; }
template <class Epi, class Sched, bool ALIGN_EPI = false, bool SP2 = false>
__device__ __forceinline__ void gemm_phase(PG8_LAS unsigned char* lds, const Gemm g, const Sched& S, const Epi& E, int wv) {
    unsigned m_op = ~0u; asm volatile("" : "+s"(m_op));
    const int tid = wv * 64 + (int)__builtin_amdgcn_mbcnt_hi(m_op, __builtin_amdgcn_mbcnt_lo(m_op, 0u)), wid = wv, lane = tid & 63, wr = wid >> 2, wc = wid & 3, fr = lane & 15, fq = lane >> 4;
    const int K = g.K, nt = K / BK;
    unsigned voffA[2], voffB[2];
#pragma unroll
    for (int i = 0; i < 2; ++i) { int R, C; stage_rc(tid * 16 + i * 8192, R, C); const int Rb = Epi::PERM ? ((R & ~31) + perm32(R & 31)) : R;
        voffA[i] = (unsigned)(R * K + C) * 2u; voffB[i] = (unsigned)(Rb * K + C) * 2u; }
    const size_t kstep = (size_t)(BK * 2);
    const size_t hstep = (size_t)HALF * K * 2;
    const size_t tstep = 2 * hstep;
    const unsigned ldsw = (unsigned)wid * 1024u;
    const int aoff = lds_byte(wr * 64 + fr, fq * 8), boff = lds_byte(wc * 32 + fr, fq * 8);
#define PG8_SA(b, h) (((b) * 2 + (h)) * HTB)
#define PG8_SB(b, h) ((4 + (b) * 2 + (h)) * HTB)
#define PG8_STAGE(bufoff, gbase, voff) do { _Pragma("unroll") for (int _i = 0; _i < 2; ++_i) \
        __builtin_amdgcn_global_load_lds((const unsigned*)((const char*)(gbase) + (voff)[_i]), (PG8_LAS unsigned*)(lds + (bufoff) + ldsw + _i * 8192), 16, 0, 0); } while (0)
#define PG8_LDA(dst, b, h) do { _Pragma("unroll") for (int m = 0; m < 4; ++m) _Pragma("unroll") for (int k = 0; k < 2; ++k) dst[m][k] = *(const PG8_LAS bf16x8*)(lds + PG8_SA(b, h) + aoff + m * 2048 + k * 1024); } while (0)
#define PG8_LDB(dst, b, h) do { _Pragma("unroll") for (int n = 0; n < 2; ++n) _Pragma("unroll") for (int k = 0; k < 2; ++k) dst[n][k] = *(const PG8_LAS bf16x8*)(lds + PG8_SB(b, h) + boff + n * 2048 + k * 1024); } while (0)
#define PG8_MMA(ai, bj, At, Bt) do { __builtin_amdgcn_s_setprio(1); _Pragma("unroll") for (int m = 0; m < 4; ++m) _Pragma("unroll") for (int n = 0; n < 2; ++n) _Pragma("unroll") for (int k = 0; k < 2; ++k) \
        acc[ai][bj][m][n] = __builtin_amdgcn_mfma_f32_16x16x32_bf16(Bt[n][k], At[m][k], acc[ai][bj][m][n], 0, 0, 0); __builtin_amdgcn_s_setprio(0); } while (0)
#define PG8_WAIT_V(n) asm volatile("s_waitcnt vmcnt(" #n ")" ::: "memory")
#define PG8_WAIT_L(n) asm volatile("s_waitcnt lgkmcnt(" #n ")" ::: "memory")
#define PG8_BAR __builtin_amdgcn_s_barrier()
#define PG8_SCHED __builtin_amdgcn_sched_barrier(0)
    Unit cur, nxt; int ui = 0;
    if (!S.next(0, cur)) return;
    f32x4 acc[2][2][4][2];
#pragma unroll
    for (int a = 0; a < 2; ++a)
#pragma unroll
        for (int b = 0; b < 2; ++b)
#pragma unroll
            for (int m = 0; m < 4; ++m)
#pragma unroll
                for (int n = 0; n < 2; ++n) acc[a][b][m][n] = (f32x4){0.f, 0.f, 0.f, 0.f};
    bf16x8 At[4][2], B0[2][2], B1[2][2];
    const char* cA = (const char*)g.A + (size_t)cur.pm * tstep; const char* cB = (const char*)g.Bt + (size_t)cur.pn * tstep;
    S.a_ready(cur);
    if constexpr (SP2) {
        PG8_STAGE(PG8_SB(0, 0), cB, voffB); PG8_STAGE(PG8_SB(0, 1), cB + hstep, voffB); PG8_STAGE(PG8_SA(0, 0), cA, voffA); PG8_STAGE(PG8_SA(0, 1), cA + hstep, voffA);
        if (wr == 1) PG8_BAR;
        PG8_WAIT_V(2); PG8_BAR;
        PG8_STAGE(PG8_SB(1, 0), cB + kstep, voffB); PG8_STAGE(PG8_SA(1, 0), cA + kstep, voffA); PG8_STAGE(PG8_SB(1, 1), cB + hstep + kstep, voffB);
        PG8_WAIT_V(6); PG8_BAR;
    } else {
        PG8_STAGE(PG8_SB(0, 0), cB, voffB); PG8_STAGE(PG8_SA(0, 0), cA, voffA); PG8_STAGE(PG8_SB(0, 1), cB + hstep, voffB); PG8_STAGE(PG8_SA(0, 1), cA + hstep, voffA);
        if (wr == 1) PG8_BAR;
        PG8_WAIT_V(4); PG8_BAR;
        PG8_STAGE(PG8_SB(1, 0), cB + kstep, voffB); PG8_STAGE(PG8_SA(1, 0), cA + kstep, voffA); PG8_STAGE(PG8_SB(1, 1), cB + hstep + kstep, voffB);
        PG8_WAIT_V(6); PG8_BAR;
    }
    for (;;) {
        const bool has_next = S.next(ui + 1, nxt);
        const char* nA = has_next ? (const char*)g.A + (size_t)nxt.pm * tstep : cA; const char* nB = has_next ? (const char*)g.Bt + (size_t)nxt.pn * tstep : cB;
        for (int t = 0; t < nt; t += 2) {
            const bool last = (t == nt - 2);
            const char* a1 = cA + (size_t)(t + 1) * kstep;
            const char* a2 = last ? nA : cA + (size_t)(t + 2) * kstep; const char* b2 = last ? nB : cB + (size_t)(t + 2) * kstep;
            const char* a3 = a2 + kstep; const char* b3 = b2 + kstep;
            if (last && has_next) S.a_ready(nxt);
            if constexpr (SP2) {
            PG8_LDB(B0, 0, 0); PG8_LDB(B1, 0, 1); PG8_SCHED; PG8_LDA(At, 0, 0); PG8_STAGE(PG8_SA(1, 1), a1 + hstep, voffA);
            PG8_WAIT_V(8); PG8_WAIT_L(0); PG8_BAR; PG8_MMA(0, 0, At, B0); PG8_MMA(0, 1, At, B1); PG8_BAR; PG8_SCHED;
            PG8_LDA(At, 0, 1); PG8_STAGE(PG8_SB(0, 0), b2, voffB); PG8_STAGE(PG8_SB(0, 1), b2 + hstep, voffB); PG8_STAGE(PG8_SA(0, 0), a2, voffA);
            PG8_WAIT_V(8); PG8_WAIT_L(0); PG8_BAR; PG8_MMA(1, 0, At, B0); PG8_MMA(1, 1, At, B1); PG8_BAR; PG8_SCHED;
            PG8_LDB(B0, 1, 0); PG8_LDB(B1, 1, 1); PG8_SCHED; PG8_LDA(At, 1, 0); PG8_STAGE(PG8_SA(0, 1), a2 + hstep, voffA);
            PG8_WAIT_V(8); PG8_WAIT_L(0); PG8_BAR; PG8_MMA(0, 0, At, B0); PG8_MMA(0, 1, At, B1); PG8_BAR; PG8_SCHED;
            PG8_LDA(At, 1, 1); PG8_STAGE(PG8_SB(1, 0), b3, voffB); PG8_STAGE(PG8_SB(1, 1), b3 + hstep, voffB); PG8_STAGE(PG8_SA(1, 0), a3, voffA);
            PG8_WAIT_V(8); PG8_WAIT_L(0); PG8_BAR; PG8_MMA(1, 0, At, B0); PG8_MMA(1, 1, At, B1); PG8_BAR; PG8_SCHED;
            } else {
            PG8_LDB(B0, 0, 0); PG8_SCHED; PG8_LDA(At, 0, 0); PG8_STAGE(PG8_SA(1, 1), a1 + hstep, voffA);
            PG8_WAIT_L(8); PG8_BAR; PG8_WAIT_L(0); PG8_MMA(0, 0, At, B0); PG8_BAR; PG8_SCHED;
            PG8_LDB(B1, 0, 1); PG8_STAGE(PG8_SB(0, 0), b2, voffB);
            PG8_BAR; PG8_WAIT_L(0); PG8_MMA(0, 1, At, B1); PG8_BAR;
            PG8_LDA(At, 0, 1); PG8_STAGE(PG8_SA(0, 0), a2, voffA);
            PG8_BAR; PG8_WAIT_L(0); PG8_MMA(1, 0, At, B0); PG8_BAR; PG8_SCHED;
            PG8_STAGE(PG8_SB(0, 1), b2 + hstep, voffB);
            PG8_WAIT_V(6); PG8_BAR; PG8_MMA(1, 1, At, B1); PG8_BAR;
            PG8_LDB(B0, 1, 0); PG8_SCHED; PG8_LDA(At, 1, 0); PG8_STAGE(PG8_SA(0, 1), a2 + hstep, voffA);
            PG8_WAIT_L(8); PG8_BAR; PG8_WAIT_L(0); PG8_MMA(0, 0, At, B0); PG8_BAR; PG8_SCHED;
            PG8_LDB(B1, 1, 1); PG8_STAGE(PG8_SB(1, 0), b3, voffB);
            PG8_BAR; PG8_WAIT_L(0); PG8_MMA(0, 1, At, B1); PG8_BAR;
            PG8_LDA(At, 1, 1); PG8_STAGE(PG8_SA(1, 0), a3, voffA);
            PG8_BAR; PG8_WAIT_L(0); PG8_MMA(1, 0, At, B0); PG8_BAR; PG8_SCHED;
            PG8_STAGE(PG8_SB(1, 1), b3 + hstep, voffB);
            PG8_WAIT_V(6); PG8_BAR; PG8_MMA(1, 1, At, B1); PG8_BAR;
            }
        }
        if constexpr (ALIGN_EPI) { if (wr == 0) PG8_BAR; }
        if constexpr (!Epi::AFTER_DRAIN) { E(acc, cur, wr, wc, fr, fq); S.done(cur); }
        if (!has_next) break;
#pragma unroll
        for (int a = 0; a < 2; ++a)
#pragma unroll
            for (int b = 0; b < 2; ++b)
#pragma unroll
                for (int m = 0; m < 4; ++m)
#pragma unroll
                    for (int n = 0; n < 2; ++n) acc[a][b][m][n] = (f32x4){0.f, 0.f, 0.f, 0.f};
        cur = nxt; cA = nA; cB = nB; ++ui;
        if constexpr (ALIGN_EPI) { if (wr == 1) PG8_BAR; }
    }
    PG8_WAIT_V(0);
    if constexpr (!ALIGN_EPI) { if (wr == 0) PG8_BAR; }
    PG8_BAR;
    if constexpr (Epi::AFTER_DRAIN) { E.fused(acc, cur, wr, wc, fr, fq, lds, wid, lane); S.done(cur); }
#undef PG8_SA
#undef PG8_SB
#undef PG8_STAGE
#undef PG8_LDA
#undef PG8_LDB
#undef PG8_MMA
#undef PG8_WAIT_V
#undef PG8_WAIT_L
#undef PG8_BAR
#undef PG8_SCHED
}
}


#define LAS __attribute__((address_space(3)))

__device__ __forceinline__ int op_bid() { int b = (int)blockIdx.x; asm volatile("" : "+s"(b)); return b; }
__device__ __forceinline__ int op_grid() { int g = (int)gridDim.x; asm volatile("" : "+s"(g)); return g; }
__device__ __forceinline__ int phase_tid(int wv) { unsigned m = ~0u; asm volatile("" : "+s"(m)); return wv * 64 + (int)__builtin_amdgcn_mbcnt_hi(m, __builtin_amdgcn_mbcnt_lo(m, 0u)); }
typedef unsigned short bf16_t;
typedef float f32x4 __attribute__((ext_vector_type(4)));
typedef unsigned u32x4 __attribute__((ext_vector_type(4)));
typedef unsigned u32x2 __attribute__((ext_vector_type(2)));

constexpr int BATCH = 8, SEQ = 4096, DM = 1024, T = BATCH * SEQ, DEPTH = 2;
constexpr int NPROJ = 4352, NMOD = 6 * DM;
constexpr int NEXP = 16384, PQ = 2048;
constexpr float NORM_EPS = 1e-6f;
constexpr float LOG2E = 1.4426950408889634f;
constexpr float QSCALE = 0.125f * LOG2E;
constexpr float SB_EXIT = 160.0f;

constexpr size_t MiB = 1u << 20;
constexpr size_t WS_CTL = 0;
constexpr size_t WS_MOD = 1 * MiB;
constexpr size_t WS_ROPE = 2 * MiB;
constexpr size_t WS_WIN = 10 * MiB;
constexpr size_t WS_WBA = 27 * MiB;
constexpr size_t WS_WBB = 29 * MiB;
constexpr size_t WS_WOUT = 31 * MiB;
constexpr size_t WS_WQ = 35 * MiB;
constexpr size_t WS_SK = 43 * MiB;
constexpr size_t WS_UQ = 44 * MiB;
constexpr size_t WS_VQ = 76 * MiB;
constexpr size_t WS_USC = 108 * MiB;
constexpr size_t WS_VSC = 108 * MiB + 256 * 1024;
constexpr size_t WS_HS = 109 * MiB;
constexpr size_t WS_H = 112 * MiB;
constexpr size_t WS_QA = 176 * MiB;
constexpr size_t WS_QB = 208 * MiB;
constexpr size_t WS_KB = 240 * MiB;
constexpr size_t WS_VB = 272 * MiB;
constexpr size_t WS_KA = 304 * MiB;
constexpr size_t WS_VA = 312 * MiB;
constexpr size_t WS_GA = 320 * MiB;
constexpr size_t WS_GB = 384 * MiB;
constexpr size_t WS_END = 448 * MiB;
constexpr size_t WS_H2Q = WS_QA, WS_IDX = WS_KB, WS_GATE = WS_VB, WS_Q2 = WS_GA, WS_COEF = WS_GA;
constexpr int CTL_BAR = 4096;
constexpr int CTL_QUEUE = 1024;

constexpr int LDS_BYTES = 147456;
constexpr int NTHREADS = 512, NWAVES = 8;

struct KArgs {
    const float* x; const float* c; const int* pos; const float* ada_w; const float* ada_b; const float* norm1_g; const float* w_in; const float* sinks;
    const float* wbr_a; const float* wbr_b; const float* w_out; const float* norm2_g; const float* wq; const float* subkeys; const float* pu; const float* pv; const float* final_g;
    float* out; unsigned char* ws; int ph_lo, ph_hi;
};

__device__ __forceinline__ unsigned f2bf(float f) { unsigned u = __float_as_uint(f); return (u + 0x7fffu + ((u >> 16) & 1u)) >> 16; }
__device__ __forceinline__ unsigned pk2(float lo, float hi) { return f2bf(lo) | (f2bf(hi) << 16); }
__device__ __forceinline__ float bflo(unsigned w) { return __uint_as_float(w << 16); }
__device__ __forceinline__ float bfhi(unsigned w) { return __uint_as_float(w & 0xffff0000u); }
template <int M> __device__ __forceinline__ float swz_xor(float v) { return __int_as_float(__builtin_amdgcn_ds_swizzle(__float_as_int(v), (M << 10) | 0x1f)); }
__device__ __forceinline__ float wave_sum(float v) {
    v += swz_xor<1>(v); v += swz_xor<2>(v); v += swz_xor<4>(v); v += swz_xor<8>(v); v += swz_xor<16>(v);
    auto rr = __builtin_amdgcn_permlane32_swap(__float_as_uint(v), __float_as_uint(v), false, false);
    return __uint_as_float(rr[0]) + __uint_as_float(rr[1]);
}
__device__ __forceinline__ float wave_max(float v) {
    v = fmaxf(v, swz_xor<1>(v)); v = fmaxf(v, swz_xor<2>(v)); v = fmaxf(v, swz_xor<4>(v)); v = fmaxf(v, swz_xor<8>(v)); v = fmaxf(v, swz_xor<16>(v));
    auto rr = __builtin_amdgcn_permlane32_swap(__float_as_uint(v), __float_as_uint(v), false, false);
    return fmaxf(__uint_as_float(rr[0]), __uint_as_float(rr[1]));
}
__device__ __forceinline__ int rdlane_i(int v, int l) { return __builtin_amdgcn_readlane(v, __builtin_amdgcn_readfirstlane(l)); }
__device__ __forceinline__ float rdlane_f(float v, int l) { return __int_as_float(__builtin_amdgcn_readlane(__float_as_int(v), __builtin_amdgcn_readfirstlane(l))); }
__device__ __forceinline__ float dot8(u32x4 a, u32x4 b, float acc) {
    acc = fmaf(bflo(a.x), bflo(b.x), acc); acc = fmaf(bfhi(a.x), bfhi(b.x), acc);
    acc = fmaf(bflo(a.y), bflo(b.y), acc); acc = fmaf(bfhi(a.y), bfhi(b.y), acc);
    acc = fmaf(bflo(a.z), bflo(b.z), acc); acc = fmaf(bfhi(a.z), bfhi(b.z), acc);
    acc = fmaf(bflo(a.w), bflo(b.w), acc); acc = fmaf(bfhi(a.w), bfhi(b.w), acc);
    return acc;
}
__device__ __forceinline__ float softplus2(float z2) {
    return fmaxf(z2, 0.f) + __log2f(1.0f + exp2f(-fabsf(z2)));
}

__device__ __forceinline__ int win_pos(int n) {
    if (n >= 640) return n;
    const int hb = n & ~63, d = n & 63;
    return hb + (d < 32 ? 2 * d : 2 * (d - 32) + 1);
}
template <bool WIN>
__device__ __forceinline__ void transpose_item(const float* W, int K, int N, bf16_t* WT, LAS float* scr, int item, int lane) {
    const int nblk = N / 32, kb = item / nblk, nb = item % nblk, k0 = 64 * kb, n0 = 32 * nb;
#pragma unroll 8
    for (int i = 0; i < 32; ++i) { const int kk = 2 * i + (lane >> 5); scr[kk * 33 + (lane & 31)] = W[(size_t)(k0 + kk) * N + n0 + (lane & 31)]; }
    asm volatile("s_waitcnt lgkmcnt(0)" ::: "memory");
    const int c = lane & 7;
#pragma unroll
    for (int j = 0; j < 4; ++j) { const int n = (lane >> 3) + 8 * j; const LAS float* s = scr + (8 * c) * 33 + n;
        u32x4 o; o.x = pk2(s[0 * 33], s[1 * 33]); o.y = pk2(s[2 * 33], s[3 * 33]); o.z = pk2(s[4 * 33], s[5 * 33]); o.w = pk2(s[6 * 33], s[7 * 33]);
        const int row = WIN ? win_pos(n0 + n) : (n0 + n);
        *(u32x4*)(WT + (size_t)row * K + k0 + 8 * c) = o; }
    asm volatile("s_waitcnt lgkmcnt(0)" ::: "memory");
}
template <bool OFFSET128>
__device__ __forceinline__ void quant_row(const f32x4 (&v)[4], unsigned char* dst_row, float* scale_out, int lane) {
    float am = 0.f;
#pragma unroll
    for (int i = 0; i < 4; ++i) am = fmaxf(am, fmaxf(fmaxf(fabsf(v[i].x), fabsf(v[i].y)), fmaxf(fabsf(v[i].z), fabsf(v[i].w))));
    am = wave_max(am);
    const float inv = am > 0.f ? 127.0f / am : 0.f, sc = am > 0.f ? am / 127.0f : 1.0f;
    u32x4 o;
#pragma unroll
    for (int i = 0; i < 4; ++i) {
        int q0 = (int)rintf(v[i].x * inv), q1 = (int)rintf(v[i].y * inv), q2 = (int)rintf(v[i].z * inv), q3 = (int)rintf(v[i].w * inv);
        if (OFFSET128) { q0 += 128; q1 += 128; q2 += 128; q3 += 128; }
        o[i] = (unsigned)(q0 & 0xff) | ((unsigned)(q1 & 0xff) << 8) | ((unsigned)(q2 & 0xff) << 16) | ((unsigned)(q3 & 0xff) << 24);
    }
    *(u32x4*)(dst_row + 16 * lane) = o;
    if (lane == 0) *scale_out = sc;
}

__device__ __forceinline__ void ph_prologue(const KArgs& a, LAS unsigned char* lds, int wv) {
    const int tid = phase_tid(wv), lane = tid & 63, wave = wv, G = op_grid();
    const int gw = op_bid() * NWAVES + wave, NGW = G * NWAVES;
    unsigned char* ws = a.ws;
    {
        LAS float* sc = (LAS float*)lds;
        for (int it = op_bid(); it < DEPTH * 12; it += G) {
            for (int idx = tid; idx < 8192; idx += NTHREADS) { const int b = idx >> 10, i = idx & 1023; const float cv = a.c[b * 1024 + i]; sc[i * 8 + b] = cv / (1.0f + __expf(-cv)); }
            __syncthreads();
            const int l = it / 12, j = (it % 12) * 512 + tid;
            const float* wp = a.ada_w + (size_t)l * 1024 * NMOD + j;
            float acc[8];
#pragma unroll
            for (int b = 0; b < 8; ++b) acc[b] = 0.f;
#pragma unroll 4
            for (int i = 0; i < 1024; ++i) {
                const float w = wp[(size_t)i * NMOD];
                const f32x4 s0 = *(const LAS f32x4*)(sc + i * 8), s1 = *(const LAS f32x4*)(sc + i * 8 + 4);
                acc[0] = fmaf(s0.x, w, acc[0]); acc[1] = fmaf(s0.y, w, acc[1]); acc[2] = fmaf(s0.z, w, acc[2]); acc[3] = fmaf(s0.w, w, acc[3]);
                acc[4] = fmaf(s1.x, w, acc[4]); acc[5] = fmaf(s1.y, w, acc[5]); acc[6] = fmaf(s1.z, w, acc[6]); acc[7] = fmaf(s1.w, w, acc[7]);
            }
            float* mod = (float*)(ws + WS_MOD);
            const float bias = a.ada_b[l * NMOD + j];
#pragma unroll
            for (int b = 0; b < 8; ++b) mod[(size_t)(l * 8 + b) * NMOD + j] = acc[b] + bias;
            __syncthreads();
        }
    }
    {
        LAS float* scr = (LAS float*)(lds + 32768 + wave * 8448);
        constexpr int I_IN = 16 * 136, I_BR = 8 * 32, I_OUT = 16 * 32, I_Q = 16 * 64, I_L = I_IN + 2 * I_BR + I_OUT + I_Q;
        for (int it = gw; it < DEPTH * I_L; it += NGW) {
            const int l = it / I_L; int r = it % I_L;
            if (r < I_IN) { transpose_item<true>(a.w_in + (size_t)l * 1024 * NPROJ, 1024, NPROJ, (bf16_t*)(ws + WS_WIN) + (size_t)l * NPROJ * 1024, scr, r, lane); continue; } r -= I_IN;
            if (r < I_BR) { transpose_item<false>(a.wbr_a + (size_t)l * 512 * 1024, 512, 1024, (bf16_t*)(ws + WS_WBA) + (size_t)l * 1024 * 512, scr, r, lane); continue; } r -= I_BR;
            if (r < I_BR) { transpose_item<false>(a.wbr_b + (size_t)l * 512 * 1024, 512, 1024, (bf16_t*)(ws + WS_WBB) + (size_t)l * 1024 * 512, scr, r, lane); continue; } r -= I_BR;
            if (r < I_OUT) { transpose_item<false>(a.w_out + (size_t)l * 1024 * 1024, 1024, 1024, (bf16_t*)(ws + WS_WOUT) + (size_t)l * 1024 * 1024, scr, r, lane); continue; } r -= I_OUT;
            transpose_item<false>(a.wq + (size_t)l * 1024 * PQ, 1024, PQ, (bf16_t*)(ws + WS_WQ) + (size_t)l * PQ * 1024, scr, r, lane);
        }
    }
    {
        const int gt = op_bid() * NTHREADS + tid, NGT = G * NTHREADS;
        for (int i = gt; i < DEPTH * 8 * 2 * 128 * 128 / 8; i += NGT) {
            const f32x4 v0 = *(const f32x4*)(a.subkeys + (size_t)i * 8), v1 = *(const f32x4*)(a.subkeys + (size_t)i * 8 + 4);
            u32x4 o; o.x = pk2(v0.x, v0.y); o.y = pk2(v0.z, v0.w); o.z = pk2(v1.x, v1.y); o.w = pk2(v1.z, v1.w);
            *(u32x4*)((bf16_t*)(ws + WS_SK) + (size_t)i * 8) = o;
        }
        for (int i = gt; i < T * 32; i += NGT) {
            const int t = i >> 5, f = i & 31;
            double inv = 1.0;
            for (int k = 0; k < f; ++k) inv *= 0.7498942093324559;
            const double ang = (double)a.pos[t] * inv;
            const double kq = rint(ang * 0.63661977236758134308);
            const double r = fma(-kq, 6.123233995736766036e-17, fma(-kq, 1.57079632679489655800, ang));
            const int quad = (int)((long long)kq & 3);
            const double r2 = r * r;
            double sp = -1.0 / 1307674368000.0; sp = fma(sp, r2, 1.0 / 6227020800.0); sp = fma(sp, r2, -1.0 / 39916800.0); sp = fma(sp, r2, 1.0 / 362880.0);
            sp = fma(sp, r2, -1.0 / 5040.0); sp = fma(sp, r2, 1.0 / 120.0); sp = fma(sp, r2, -1.0 / 6.0); sp = fma(sp * r2, r, r);
            double cp = 1.0 / 20922789888000.0; cp = fma(cp, r2, -1.0 / 87178291200.0); cp = fma(cp, r2, 1.0 / 479001600.0); cp = fma(cp, r2, -1.0 / 3628800.0);
            cp = fma(cp, r2, 1.0 / 40320.0); cp = fma(cp, r2, -1.0 / 720.0); cp = fma(cp, r2, 1.0 / 24.0); cp = fma(cp, r2, -0.5); cp = fma(cp, r2, 1.0);
            const double sn = (quad == 0) ? sp : (quad == 1) ? cp : (quad == 2) ? -sp : -cp;
            const double cs = (quad == 0) ? cp : (quad == 1) ? -sp : (quad == 2) ? -cp : sp;
            float* rp = (float*)(ws + WS_ROPE) + (size_t)i * 2; rp[0] = (float)cs; rp[1] = (float)sn;
        }
    }
    for (int r = gw; r < DEPTH * 2 * NEXP; r += NGW) {
        const int tbl = r / (DEPTH * NEXP), lr = r % (DEPTH * NEXP);
        const float* src = (tbl == 0 ? a.pu : a.pv) + (size_t)lr * 1024;
        f32x4 v[4];
        if (tbl == 0) {
#pragma unroll
            for (int i = 0; i < 4; ++i) v[i] = ((const f32x4*)src)[64 * i + lane];
            quant_row<false>(v, ws + WS_UQ + (size_t)lr * 1024, (float*)(ws + WS_USC) + lr, lane);
        } else {
#pragma unroll
            for (int i = 0; i < 4; ++i) v[i] = ((const f32x4*)src)[4 * lane + i];
            const int l = lr / NEXP, e = lr % NEXP;
            quant_row<false>(v, ws + WS_VQ + (size_t)l * NEXP * 1024 + ((size_t)(lane >> 3) * NEXP + e) * 128 + 16 * (lane & 7) - 16 * lane, (float*)(ws + WS_VSC) + lr, lane);
        }
    }
    if (op_bid() == 0) for (int i = tid; i < DEPTH * 2 * 8 * 64; i += NTHREADS) ((unsigned*)(ws + WS_CTL))[CTL_QUEUE + i] = 0u;
}

template <bool WITH_Q8>
__device__ __forceinline__ void ph_norm(const KArgs& a, const float* xin, const float* g, const float* mod_l, int shift_idx, int scale_idx, int wv) {
    const int tid = phase_tid(wv), lane = tid & 63, wave = wv;
    const int gw = op_bid() * NWAVES + wave, NGW = op_grid() * NWAVES;
    bf16_t* H = (bf16_t*)(a.ws + WS_H);
    for (int row = gw; row < T; row += NGW) {
        const int b = row >> 12;
        f32x4 v[4]; float ss = 0.f;
#pragma unroll
        for (int i = 0; i < 4; ++i) { v[i] = ((const f32x4*)(xin + (size_t)row * DM))[64 * i + lane]; ss += (v[i].x * v[i].x + v[i].y * v[i].y) + (v[i].z * v[i].z + v[i].w * v[i].w); }
        ss = wave_sum(ss);
        const float r = 1.0f / sqrtf(ss * (1.0f / DM) + NORM_EPS);
#pragma unroll
        for (int i = 0; i < 4; ++i) {
            const int col = 256 * i + 4 * lane;
            const f32x4 gg = *(const f32x4*)(g + col), sc = *(const f32x4*)(mod_l + (size_t)b * NMOD + scale_idx * DM + col), sh = *(const f32x4*)(mod_l + (size_t)b * NMOD + shift_idx * DM + col);
            v[i] = (v[i] * r) * gg * (sc + 1.0f) + sh;
            u32x2 o; o.x = pk2(v[i].x, v[i].y); o.y = pk2(v[i].z, v[i].w);
            *(u32x2*)(H + (size_t)row * DM + col) = o;
        }
        if (WITH_Q8) quant_row<false>(v, a.ws + WS_H2Q + (size_t)row * 1024, (float*)(a.ws + WS_HS) + row, lane);
    }
}
__device__ __forceinline__ void ph_final_norm(const KArgs& a, int wv) {
    const int tid = phase_tid(wv), lane = tid & 63, wave = wv;
    const int gw = op_bid() * NWAVES + wave, NGW = op_grid() * NWAVES;
    for (int row = gw; row < T; row += NGW) {
        f32x4 v[4]; float ss = 0.f;
#pragma unroll
        for (int i = 0; i < 4; ++i) { v[i] = ((const f32x4*)(a.out + (size_t)row * DM))[64 * i + lane]; ss += (v[i].x * v[i].x + v[i].y * v[i].y) + (v[i].z * v[i].z + v[i].w * v[i].w); }
        ss = wave_sum(ss);
        const float r = 1.0f / sqrtf(ss * (1.0f / DM) + NORM_EPS);
#pragma unroll
        for (int i = 0; i < 4; ++i) { const f32x4 gg = *(const f32x4*)(a.final_g + 256 * i + 4 * lane); ((f32x4*)(a.out + (size_t)row * DM))[64 * i + lane] = (v[i] * r) * gg; }
    }
}

struct EpiProj {
    static constexpr bool PERM = true, AFTER_DRAIN = false;
    unsigned char* ws;
    __device__ __forceinline__ void operator()(const pg8::f32x4 (&acc)[2][2][4][2], const pg8::Unit& u, int wr, int wc, int fr, int fq) const {
        const int row0 = u.pm * 256 + wr * 64 + fr;
        const float* rope = (const float*)(ws + WS_ROPE);
#pragma unroll
        for (int bj = 0; bj < 2; ++bj) {
            const int cgb = u.pn * 256 + bj * 128;
            bf16_t* base; int pitch, cl, mode;
            if (cgb < 512) { base = (bf16_t*)(ws + WS_QA); pitch = 512; cl = cgb; mode = 1; }
            else if (cgb < 640) { base = (bf16_t*)(ws + WS_KA); pitch = 128; cl = cgb - 512; mode = 2; }
            else if (cgb < 768) { base = (bf16_t*)(ws + WS_VA); pitch = 128; cl = cgb - 640; mode = 0; }
            else if (cgb < 1280) { base = (bf16_t*)(ws + WS_QB); pitch = 512; cl = cgb - 768; mode = 3; }
            else if (cgb < 1792) { base = (bf16_t*)(ws + WS_KB); pitch = 512; cl = cgb - 1280; mode = 0; }
            else if (cgb < 2304) { base = (bf16_t*)(ws + WS_VB); pitch = 512; cl = cgb - 1792; mode = 0; }
            else if (cgb < 3328) { base = (bf16_t*)(ws + WS_GA); pitch = 1024; cl = cgb - 2304; mode = 4; }
            else { base = (bf16_t*)(ws + WS_GB); pitch = 1024; cl = cgb - 3328; mode = 4; }
            const int col = cl + wc * 32 + 8 * fq;
#pragma unroll
            for (int ai = 0; ai < 2; ++ai)
#pragma unroll
                for (int m = 0; m < 4; ++m) {
                    const int row = row0 + ai * 128 + m * 16;
                    pg8::f32x4 v0 = acc[ai][bj][m][0], v1 = acc[ai][bj][m][1];
                    if (mode == 1 || mode == 2) {
                        const int i0 = (col & 63) >> 1;
                        const f32x4 c01 = *(const f32x4*)(rope + ((size_t)row * 32 + i0) * 2), c23 = *(const f32x4*)(rope + ((size_t)row * 32 + i0 + 2) * 2);
                        pg8::f32x4 w0, w1;
                        w0[0] = v0[0] * c01.x - v0[1] * c01.y; w0[1] = v0[1] * c01.x + v0[0] * c01.y;
                        w0[2] = v0[2] * c01.z - v0[3] * c01.w; w0[3] = v0[3] * c01.z + v0[2] * c01.w;
                        w1[0] = v1[0] * c23.x - v1[1] * c23.y; w1[1] = v1[1] * c23.x + v1[0] * c23.y;
                        w1[2] = v1[2] * c23.z - v1[3] * c23.w; w1[3] = v1[3] * c23.z + v1[2] * c23.w;
                        v0 = w0; v1 = w1;
                    }
                    if (mode == 1 || mode == 3) { v0 = v0 * QSCALE; v1 = v1 * QSCALE; }
                    if (mode == 4) {
#pragma unroll
                        for (int e = 0; e < 4; ++e) { v0[e] = 1.0f / (1.0f + __expf(-v0[e])); v1[e] = 1.0f / (1.0f + __expf(-v1[e])); }
                    }
                    u32x4 w; w.x = pk2(v0[0], v0[1]); w.y = pk2(v0[2], v0[3]); w.z = pk2(v1[0], v1[1]); w.w = pk2(v1[2], v1[3]);
                    *(u32x4*)(base + (size_t)row * pitch + col) = w;
                }
        }
    }
};
template <bool ADD> struct EpiBranch {
    static constexpr bool PERM = true, AFTER_DRAIN = false;
    const bf16_t* Gt; bf16_t* O;
    __device__ __forceinline__ void operator()(const pg8::f32x4 (&acc)[2][2][4][2], const pg8::Unit& u, int wr, int wc, int fr, int fq) const {
        const int row0 = u.pm * 256 + wr * 64 + fr, col0 = u.pn * 256 + wc * 32 + 8 * fq;
#pragma unroll
        for (int ai = 0; ai < 2; ++ai)
#pragma unroll
            for (int m = 0; m < 4; ++m)
#pragma unroll
                for (int bj = 0; bj < 2; ++bj) {
                    const size_t off = (size_t)(row0 + ai * 128 + m * 16) * DM + col0 + bj * 128;
                    const u32x4 gv = *(const u32x4*)(Gt + off);
                    const pg8::f32x4 v0 = acc[ai][bj][m][0], v1 = acc[ai][bj][m][1];
                    float r[8];
                    r[0] = bflo(gv.x) * v0[0]; r[1] = bfhi(gv.x) * v0[1]; r[2] = bflo(gv.y) * v0[2]; r[3] = bfhi(gv.y) * v0[3];
                    r[4] = bflo(gv.z) * v1[0]; r[5] = bfhi(gv.z) * v1[1]; r[6] = bflo(gv.w) * v1[2]; r[7] = bfhi(gv.w) * v1[3];
                    if (ADD) { const u32x4 ov = *(const u32x4*)(O + off);
                        r[0] += bflo(ov.x); r[1] += bfhi(ov.x); r[2] += bflo(ov.y); r[3] += bfhi(ov.y); r[4] += bflo(ov.z); r[5] += bfhi(ov.z); r[6] += bflo(ov.w); r[7] += bfhi(ov.w); }
                    u32x4 w; w.x = pk2(r[0], r[1]); w.y = pk2(r[2], r[3]); w.z = pk2(r[4], r[5]); w.w = pk2(r[6], r[7]);
                    *(u32x4*)(O + off) = w;
                }
    }
};
struct EpiWout {
    static constexpr bool PERM = false, AFTER_DRAIN = false;
    const float* xold; float* xnew; const float* gate;
    __device__ __forceinline__ void operator()(const pg8::f32x4 (&acc)[2][2][4][2], const pg8::Unit& u, int wr, int wc, int fr, int fq) const {
        const int row0 = u.pm * 256 + wr * 64 + fr, col0 = u.pn * 256 + wc * 32 + 4 * fq, b = u.pm >> 4;
#pragma unroll
        for (int bj = 0; bj < 2; ++bj)
#pragma unroll
            for (int n = 0; n < 2; ++n) {
                const pg8::f32x4 gv = *(const pg8::f32x4*)(gate + (size_t)b * NMOD + col0 + bj * 128 + n * 16);
#pragma unroll
                for (int ai = 0; ai < 2; ++ai)
#pragma unroll
                    for (int m = 0; m < 4; ++m) { const size_t off = (size_t)(row0 + ai * 128 + m * 16) * DM + col0 + bj * 128 + n * 16;
                        const pg8::f32x4 xo = *(const pg8::f32x4*)(xold + off);
                        *(pg8::f32x4*)(xnew + off) = xo + gv * acc[ai][bj][m][n]; }
            }
    }
};
struct EpiPlainBf16 {
    static constexpr bool PERM = true, AFTER_DRAIN = false;
    bf16_t* O; int ldc;
    __device__ __forceinline__ void operator()(const pg8::f32x4 (&acc)[2][2][4][2], const pg8::Unit& u, int wr, int wc, int fr, int fq) const {
        const int row0 = u.pm * 256 + wr * 64 + fr, col0 = u.pn * 256 + wc * 32 + 8 * fq;
#pragma unroll
        for (int ai = 0; ai < 2; ++ai)
#pragma unroll
            for (int m = 0; m < 4; ++m)
#pragma unroll
                for (int bj = 0; bj < 2; ++bj) {
                    const pg8::f32x4 v0 = acc[ai][bj][m][0], v1 = acc[ai][bj][m][1];
                    u32x4 w; w.x = pk2(v0[0], v0[1]); w.y = pk2(v0[2], v0[3]); w.z = pk2(v1[0], v1[1]); w.w = pk2(v1[2], v1[3]);
                    *(u32x4*)(O + (size_t)(row0 + ai * 128 + m * 16) * ldc + col0 + bj * 128) = w;
                }
    }
};

namespace att {
typedef short bf16x8 __attribute__((ext_vector_type(8)));
typedef short s16x4 __attribute__((ext_vector_type(4)));
typedef float f32x16 __attribute__((ext_vector_type(16)));
__device__ __forceinline__ int crow(int r, int hi) { return (r & 3) + 8 * (r >> 2) + 4 * hi; }
typedef float f32x2_t __attribute__((ext_vector_type(2))); typedef __bf16 bf16x2_t __attribute__((ext_vector_type(2)));
__device__ __forceinline__ unsigned cvtpk(float lo, float hi) { f32x2_t v = {lo, hi}; bf16x2_t b = __builtin_convertvector(v, bf16x2_t); return __builtin_bit_cast(unsigned, b); }
#define ATT_SBAR() __builtin_amdgcn_sched_barrier(0)

__device__ __forceinline__ void qkt(f32x16& p0, f32x16& p1, const LAS unsigned char* kslot, const bf16x8 (&qr)[4], int r32, int hi) {
    const LAS unsigned char* kb = kslot + hi * 1024 + r32 * 16;
    p0 = f32x16{}; p1 = f32x16{};
#pragma unroll
    for (int d0 = 0; d0 < 4; ++d0) {
        const bf16x8 b0 = *(const LAS bf16x8*)(kb + d0 * 2048);
        const bf16x8 b1 = *(const LAS bf16x8*)(kb + d0 * 2048 + 512);
        p0 = __builtin_amdgcn_mfma_f32_32x32x16_bf16(b0, qr[d0], p0, 0, 0, 0);
        p1 = __builtin_amdgcn_mfma_f32_32x32x16_bf16(b1, qr[d0], p1, 0, 0, 0);
    }
}
__device__ __forceinline__ void pv(f32x16 (&o)[2], int vb, bf16x8 pa0, bf16x8 pa1, bf16x8 pa2, bf16x8 pa3) {
#pragma unroll
    for (int d0 = 0; d0 < 2; ++d0) {
        s16x4 lo[4], hh[4];
#pragma unroll
        for (int ks = 0; ks < 4; ++ks) {
            asm volatile("ds_read_b64_tr_b16 %0,%1 offset:%c2" : "=&v"(lo[ks]) : "v"(vb), "i"(d0 * 4096 + ks * 1024) : "memory");
            asm volatile("ds_read_b64_tr_b16 %0,%1 offset:%c2" : "=&v"(hh[ks]) : "v"(vb), "i"(d0 * 4096 + ks * 1024 + 512) : "memory");
        }
        asm volatile("s_waitcnt lgkmcnt(0)" ::: "memory"); ATT_SBAR();
#define ATT_PK(k) (bf16x8){lo[k][0], lo[k][1], lo[k][2], lo[k][3], hh[k][0], hh[k][1], hh[k][2], hh[k][3]}
        o[d0] = __builtin_amdgcn_mfma_f32_32x32x16_bf16(pa0, ATT_PK(0), o[d0], 0, 0, 0);
        o[d0] = __builtin_amdgcn_mfma_f32_32x32x16_bf16(pa1, ATT_PK(1), o[d0], 0, 0, 0);
        o[d0] = __builtin_amdgcn_mfma_f32_32x32x16_bf16(pa2, ATT_PK(2), o[d0], 0, 0, 0);
        o[d0] = __builtin_amdgcn_mfma_f32_32x32x16_bf16(pa3, ATT_PK(3), o[d0], 0, 0, 0);
#undef ATT_PK
    }
}
__device__ __forceinline__ void pack_p(const f32x16& p0, const f32x16& p1, bf16x8& pa0, bf16x8& pa1, bf16x8& pa2, bf16x8& pa3) {
    u32x4 w0, w1, w2, w3;
    w0 = (u32x4){cvtpk(p0[0], p0[1]), cvtpk(p0[2], p0[3]), cvtpk(p0[4], p0[5]), cvtpk(p0[6], p0[7])};
    w1 = (u32x4){cvtpk(p0[8], p0[9]), cvtpk(p0[10], p0[11]), cvtpk(p0[12], p0[13]), cvtpk(p0[14], p0[15])};
    w2 = (u32x4){cvtpk(p1[0], p1[1]), cvtpk(p1[2], p1[3]), cvtpk(p1[4], p1[5]), cvtpk(p1[6], p1[7])};
    w3 = (u32x4){cvtpk(p1[8], p1[9]), cvtpk(p1[10], p1[11]), cvtpk(p1[12], p1[13]), cvtpk(p1[14], p1[15])};
    pa0 = __builtin_bit_cast(bf16x8, w0); pa1 = __builtin_bit_cast(bf16x8, w1); pa2 = __builtin_bit_cast(bf16x8, w2); pa3 = __builtin_bit_cast(bf16x8, w3);
}
__device__ __forceinline__ u32x4 tile_gload(const bf16_t* src, int pitch, int tid) { return *(const u32x4*)(src + (size_t)(tid >> 3) * pitch + (tid & 7) * 8); }
__device__ __forceinline__ void tile_kwrite(LAS unsigned char* kslot, u32x4 v, int tid) { *(LAS u32x4*)(kslot + (tid & 7) * 1024 + (tid >> 3) * 16) = v; }
__device__ __forceinline__ void tile_vwrite(LAS unsigned char* vslot, u32x4 v, int tid) { const int c = tid & 7; *(LAS u32x4*)(vslot + (c >> 2) * 4096 + (tid >> 3) * 64 + (c & 3) * 16) = v; }
__device__ __forceinline__ void store_o(const f32x16 (&o)[2], const float (&rs)[16], LAS unsigned char* stage, bf16_t* Ow, int pitch, int lane) {
    const int r32 = lane & 31, hi = lane >> 5;
    LAS bf16_t* stg = (LAS bf16_t*)stage;
#pragma unroll
    for (int r = 0; r < 16; ++r) { const int orow = crow(r, hi);
#pragma unroll
        for (int d0 = 0; d0 < 2; ++d0) stg[orow * 64 + d0 * 32 + r32] = (bf16_t)f2bf(o[d0][r] * rs[r]); }
    asm volatile("s_waitcnt lgkmcnt(0)" ::: "memory");
#pragma unroll
    for (int i = 0; i < 4; ++i) { const int row = i * 8 + (lane >> 3), ch = lane & 7; const u32x4 v = *(const LAS u32x4*)(stg + row * 64 + ch * 8); *(u32x4*)(Ow + (size_t)row * pitch + ch * 8) = v; }
    asm volatile("s_waitcnt lgkmcnt(0)" ::: "memory");
}

constexpr int SB_K0 = 0, SB_V0 = 16384, SB_STAGE = 32768, SB_FLAGS = 65536, SB_LDS_END = 65536 + 64;
template <bool EARLY_EXIT>
__device__ __forceinline__ void sb_phase(const bf16_t* Q, const bf16_t* K, const bf16_t* V, bf16_t* O, LAS unsigned char* lds, int wv) {
        const int tid = phase_tid(wv), lane = tid & 63, r32 = lane & 31, hi = lane >> 5, wid = wv;
    const int vb0 = (int)(unsigned)(uintptr_t)(lds + SB_V0) + ((lane >> 4) & 1) * 32 + (lane & 3) * 8 + (4 * hi + ((lane & 15) >> 2)) * 64;
    volatile LAS unsigned* flags = (volatile LAS unsigned*)(lds + SB_FLAGS);
    const float m0 = hi == 0 ? 1.0f : 0.0f;
    for (int unit = op_bid(); unit < BATCH * 8 * 16; unit += op_grid()) {
        const int qb = unit & 15, h = (unit >> 4) & 7, b = unit >> 7;
        const int q0 = qb * 256;
        const size_t rowbase = (size_t)b * SEQ;
        const bf16_t* Kh = K + rowbase * 512 + h * 64; const bf16_t* Vh = V + rowbase * 512 + h * 64;
        const bf16_t* Qw = Q + (rowbase + q0 + wid * 32) * 512 + h * 64;
        int kt = 4 * qb + 3;
        u32x4 kreg = tile_gload(Kh + (size_t)kt * 64 * 512, 512, tid), vreg = tile_gload(Vh + (size_t)kt * 64 * 512, 512, tid);
        bf16x8 qr[4];
#pragma unroll
        for (int d0 = 0; d0 < 4; ++d0) qr[d0] = *(const bf16x8*)(Qw + (size_t)r32 * 512 + d0 * 16 + hi * 8);
        if (tid < 16) flags[tid] = 0u;
        tile_kwrite(lds + SB_K0, kreg, tid); tile_vwrite(lds + SB_V0, vreg, tid);
        f32x16 o[2]; o[0] = f32x16{}; o[1] = f32x16{};
        float carry = 0.f;
        int cur = 0, it = 0;
        for (;;) {
            __syncthreads();
            if (EARLY_EXIT && it > 0) {
                const int fs = ((it - 1) & 1) * 8;
                unsigned all = 1u;
#pragma unroll
                for (int w = 0; w < 8; ++w) all &= flags[fs + w];
                if (all) break;
            }
            const bool more = kt > 0;
            if (more) { kreg = tile_gload(Kh + (size_t)(kt - 1) * 64 * 512, 512, tid); vreg = tile_gload(Vh + (size_t)(kt - 1) * 64 * 512, 512, tid); }
            const int D = q0 + 32 * wid - 64 * kt;
            if (D + 31 > 0) {
                f32x16 p0, p1;
                qkt(p0, p1, lds + SB_K0 + cur * 8192, qr, r32, hi);
                if (D < 64) {
                    const int qrel = D + r32;
#pragma unroll
                    for (int r = 0; r < 16; ++r) { const int kv = crow(r, hi); if (kv >= qrel) p0[r] = -INFINITY; if (kv + 32 >= qrel) p1[r] = -INFINITY; }
                }
                f32x16 l0, l1;
#pragma unroll
                for (int r = 0; r < 16; ++r) { l0[r] = fmaxf(p0[r], 0.f) + __log2f(1.0f + exp2f(-fabsf(p0[r]))); l1[r] = fmaxf(p1[r], 0.f) + __log2f(1.0f + exp2f(-fabsf(p1[r]))); }
                float tt[8], uu[8];
#pragma unroll
                for (int i = 0; i < 4; ++i) { tt[i] = (l0[4 * i] + l0[4 * i + 1]) + (l0[4 * i + 2] + l0[4 * i + 3]); tt[4 + i] = (l1[4 * i] + l1[4 * i + 1]) + (l1[4 * i + 2] + l1[4 * i + 3]); }
#pragma unroll
                for (int k = 0; k < 8; ++k) { auto rr = __builtin_amdgcn_permlane32_swap(__float_as_uint(tt[k]), __float_as_uint(tt[k]), false, false); uu[k] = __uint_as_float(hi ? rr[0] : rr[1]); }
                float sw = 0.f, base[8];
#pragma unroll
                for (int k = 7; k >= 0; --k) { base[k] = carry - (sw + m0 * uu[k]); sw += tt[k] + uu[k]; }
#pragma unroll
                for (int i = 0; i < 4; ++i) {
                    float s3 = l0[4 * i + 3], s2 = s3 + l0[4 * i + 2], s1 = s2 + l0[4 * i + 1], s0 = s1 + l0[4 * i];
                    p0[4 * i + 3] = exp2f(p0[4 * i + 3] + (base[i] - s3)); p0[4 * i + 2] = exp2f(p0[4 * i + 2] + (base[i] - s2));
                    p0[4 * i + 1] = exp2f(p0[4 * i + 1] + (base[i] - s1)); p0[4 * i] = exp2f(p0[4 * i] + (base[i] - s0));
                    s3 = l1[4 * i + 3]; s2 = s3 + l1[4 * i + 2]; s1 = s2 + l1[4 * i + 1]; s0 = s1 + l1[4 * i];
                    p1[4 * i + 3] = exp2f(p1[4 * i + 3] + (base[4 + i] - s3)); p1[4 * i + 2] = exp2f(p1[4 * i + 2] + (base[4 + i] - s2));
                    p1[4 * i + 1] = exp2f(p1[4 * i + 1] + (base[4 + i] - s1)); p1[4 * i] = exp2f(p1[4 * i] + (base[4 + i] - s0));
                }
                carry -= sw;
                bf16x8 pa0, pa1, pa2, pa3; pack_p(p0, p1, pa0, pa1, pa2, pa3);
                pv(o, vb0 + cur * 8192, pa0, pa1, pa2, pa3);
            }
            if (EARLY_EXIT) { const bool done = __all(carry < -SB_EXIT); if (lane == 0) flags[(it & 1) * 8 + wid] = done ? 1u : 0u; }
            if (!more) break;
            tile_kwrite(lds + SB_K0 + (cur ^ 1) * 8192, kreg, tid); tile_vwrite(lds + SB_V0 + (cur ^ 1) * 8192, vreg, tid);
            cur ^= 1; --kt; ++it;
        }
        float ones[16];
#pragma unroll
        for (int r = 0; r < 16; ++r) ones[r] = 1.0f;
        store_o(o, ones, lds + SB_STAGE + wid * 4096, O + (rowbase + q0 + wid * 32) * 512 + h * 64, 512, lane);
        __syncthreads();
    }
}

constexpr int SW_K0 = 0, SW_V0 = 24576, SW_STAGE = 49152, SW_WSF = 81920, SW_LDS_END = 81920 + 2048;
__device__ __forceinline__ void swa_phase(const bf16_t* Q, const bf16_t* K, const bf16_t* V, bf16_t* O, const float* sinks, LAS unsigned char* lds, int wv) {
        const int tid = phase_tid(wv), lane = tid & 63, r32 = lane & 31, hi = lane >> 5, wid = wv;
    const int vb0 = (int)(unsigned)(uintptr_t)(lds + SW_V0) + ((lane >> 4) & 1) * 32 + (lane & 3) * 8 + (4 * hi + ((lane & 15) >> 2)) * 64;
    LAS float* wsf = (LAS float*)(lds + SW_WSF) + wid * 64;
    const int g = wid >> 1, j = wid & 1;
    for (int unit = op_bid(); unit < BATCH * 2 * 64; unit += op_grid()) {
        const int qb = unit & 63, kvh = (unit >> 6) & 1, b = unit >> 7;
        const int q0 = qb * 64, hq = kvh * 4 + g;
        const size_t rowbase = (size_t)b * SEQ;
        const bf16_t* Kh = K + rowbase * 128 + kvh * 64; const bf16_t* Vh = V + rowbase * 128 + kvh * 64;
        const bf16_t* Qw = Q + (rowbase + q0 + j * 32) * 512 + hq * 64;
        __syncthreads();
#pragma unroll
        for (int i = 0; i < 3; ++i) { const int kt = qb - 2 + i;
            if (kt >= 0) { const u32x4 kv = tile_gload(Kh + (size_t)kt * 64 * 128, 128, tid), vv = tile_gload(Vh + (size_t)kt * 64 * 128, 128, tid);
                tile_kwrite(lds + SW_K0 + i * 8192, kv, tid); tile_vwrite(lds + SW_V0 + i * 8192, vv, tid); } }
        bf16x8 qr[4];
#pragma unroll
        for (int d0 = 0; d0 < 4; ++d0) qr[d0] = *(const bf16x8*)(Qw + (size_t)r32 * 512 + d0 * 16 + hi * 8);
        __syncthreads();
        const int qrel = 32 * j + r32;
        const float sink2 = sinks[hq] * LOG2E;
        float m = sink2;
#pragma unroll
        for (int i = 0; i < 3; ++i) {
            if (qb - 2 + i >= 0) {
                f32x16 p0, p1;
                qkt(p0, p1, lds + SW_K0 + i * 8192, qr, r32, hi);
#pragma unroll
                for (int r = 0; r < 16; ++r) { const int kv = crow(r, hi);
                    bool v0 = true, v1 = true;
                    if (i == 2) { v0 = kv <= qrel; v1 = kv + 32 <= qrel; }
                    if (i == 0) { v0 = kv > qrel; v1 = kv + 32 > qrel; }
                    m = fmaxf(m, fmaxf(v0 ? p0[r] : -INFINITY, v1 ? p1[r] : -INFINITY)); }
            }
        }
        { auto rr = __builtin_amdgcn_permlane32_swap(__float_as_uint(m), __float_as_uint(m), false, false); m = fmaxf(__uint_as_float(rr[0]), __uint_as_float(rr[1])); }
        float lsum = 0.f;
        f32x16 o[2]; o[0] = f32x16{}; o[1] = f32x16{};
#pragma unroll
        for (int i = 0; i < 3; ++i) {
            if (qb - 2 + i >= 0) {
                f32x16 p0, p1;
                qkt(p0, p1, lds + SW_K0 + i * 8192, qr, r32, hi);
#pragma unroll
                for (int r = 0; r < 16; ++r) { const int kv = crow(r, hi);
                    bool v0 = true, v1 = true;
                    if (i == 2) { v0 = kv <= qrel; v1 = kv + 32 <= qrel; }
                    if (i == 0) { v0 = kv > qrel; v1 = kv + 32 > qrel; }
                    p0[r] = v0 ? exp2f(p0[r] - m) : 0.f; p1[r] = v1 ? exp2f(p1[r] - m) : 0.f; lsum += p0[r] + p1[r]; }
                bf16x8 pa0, pa1, pa2, pa3; pack_p(p0, p1, pa0, pa1, pa2, pa3); pv(o, vb0 + i * 8192, pa0, pa1, pa2, pa3);
            }
        }
        { auto rr = __builtin_amdgcn_permlane32_swap(__float_as_uint(lsum), __float_as_uint(lsum), false, false); lsum = __uint_as_float(rr[0]) + __uint_as_float(rr[1]); }
        lsum += exp2f(sink2 - m);
        if (hi == 0) wsf[r32] = 1.0f / lsum;
        asm volatile("s_waitcnt lgkmcnt(0)" ::: "memory");
        float rs[16];
#pragma unroll
        for (int r = 0; r < 16; ++r) rs[r] = wsf[crow(r, hi)];
        asm volatile("s_waitcnt lgkmcnt(0)" ::: "memory");
        store_o(o, rs, lds + SW_STAGE + wid * 4096, O + (rowbase + q0 + j * 32) * 512 + hq * 64, 512, lane);
    }
}
#undef ATT_SBAR
}

namespace tk {
typedef short bf16x8 __attribute__((ext_vector_type(8)));
typedef float f32x16 __attribute__((ext_vector_type(16)));
__device__ __forceinline__ float vmax(float a, float b) { float r; asm("v_max_f32 %0, %1, %2" : "=v"(r) : "v"(a), "v"(b)); return r; }
__device__ __forceinline__ float vmin(float a, float b) { float r; asm("v_min_f32 %0, %1, %2" : "=v"(r) : "v"(a), "v"(b)); return r; }
#define TK_CE(a, b) { const float t_ = vmax(a, b); b = vmin(a, b); a = t_; }
__device__ __forceinline__ void sort16(float (&v)[16]) {
    TK_CE(v[0], v[1]) TK_CE(v[2], v[3]) TK_CE(v[0], v[2]) TK_CE(v[1], v[3]) TK_CE(v[1], v[2]) TK_CE(v[4], v[5]) TK_CE(v[6], v[7]) TK_CE(v[4], v[6])
    TK_CE(v[5], v[7]) TK_CE(v[5], v[6]) TK_CE(v[0], v[4]) TK_CE(v[2], v[6]) TK_CE(v[2], v[4]) TK_CE(v[1], v[5]) TK_CE(v[3], v[7]) TK_CE(v[3], v[5])
    TK_CE(v[1], v[2]) TK_CE(v[3], v[4]) TK_CE(v[5], v[6]) TK_CE(v[8], v[9]) TK_CE(v[10], v[11]) TK_CE(v[8], v[10]) TK_CE(v[9], v[11]) TK_CE(v[9], v[10])
    TK_CE(v[12], v[13]) TK_CE(v[14], v[15]) TK_CE(v[12], v[14]) TK_CE(v[13], v[15]) TK_CE(v[13], v[14]) TK_CE(v[8], v[12]) TK_CE(v[10], v[14]) TK_CE(v[10], v[12])
    TK_CE(v[9], v[13]) TK_CE(v[11], v[15]) TK_CE(v[11], v[13]) TK_CE(v[9], v[10]) TK_CE(v[11], v[12]) TK_CE(v[13], v[14]) TK_CE(v[0], v[8]) TK_CE(v[4], v[12])
    TK_CE(v[4], v[8]) TK_CE(v[2], v[10]) TK_CE(v[6], v[14]) TK_CE(v[6], v[10]) TK_CE(v[2], v[4]) TK_CE(v[6], v[8]) TK_CE(v[10], v[12]) TK_CE(v[1], v[9])
    TK_CE(v[5], v[13]) TK_CE(v[5], v[9]) TK_CE(v[3], v[11]) TK_CE(v[7], v[15]) TK_CE(v[7], v[11]) TK_CE(v[3], v[5]) TK_CE(v[7], v[9]) TK_CE(v[11], v[13])
    TK_CE(v[1], v[2]) TK_CE(v[3], v[4]) TK_CE(v[5], v[6]) TK_CE(v[7], v[8]) TK_CE(v[9], v[10]) TK_CE(v[11], v[12]) TK_CE(v[13], v[14])
}
__device__ __forceinline__ void bmerge16(float (&v)[16]) {
    TK_CE(v[0], v[8]) TK_CE(v[1], v[9]) TK_CE(v[2], v[10]) TK_CE(v[3], v[11]) TK_CE(v[4], v[12]) TK_CE(v[5], v[13]) TK_CE(v[6], v[14]) TK_CE(v[7], v[15])
    TK_CE(v[0], v[4]) TK_CE(v[1], v[5]) TK_CE(v[2], v[6]) TK_CE(v[3], v[7]) TK_CE(v[8], v[12]) TK_CE(v[9], v[13]) TK_CE(v[10], v[14]) TK_CE(v[11], v[15])
    TK_CE(v[0], v[2]) TK_CE(v[1], v[3]) TK_CE(v[4], v[6]) TK_CE(v[5], v[7]) TK_CE(v[8], v[10]) TK_CE(v[9], v[11]) TK_CE(v[12], v[14]) TK_CE(v[13], v[15])
    TK_CE(v[0], v[1]) TK_CE(v[2], v[3]) TK_CE(v[4], v[5]) TK_CE(v[6], v[7]) TK_CE(v[8], v[9]) TK_CE(v[10], v[11]) TK_CE(v[12], v[13]) TK_CE(v[14], v[15])
}

__device__ __forceinline__ void merge_top16(float (&a)[16], const float (&b)[16]) {
#pragma unroll
    for (int i = 0; i < 16; ++i) a[i] = vmax(a[i], b[15 - i]);
    bmerge16(a);
}
__device__ __forceinline__ float partner_f(float v, int hi) { auto rr = __builtin_amdgcn_permlane32_swap(__float_as_uint(v), __float_as_uint(v), false, false); return __uint_as_float(hi ? rr[0] : rr[1]); }
__device__ __forceinline__ void merge_partner(float (&a)[16], int hi) {
    float pp[16];
#pragma unroll
    for (int i = 0; i < 16; ++i) pp[i] = partner_f(a[i], hi);
    merge_top16(a, pp);
}
__device__ __forceinline__ void take_block(float (&v)[16], const f32x16& acc, int blk, unsigned hi4) {
#pragma unroll
    for (int r = 0; r < 16; ++r) { const unsigned code = 127u - (unsigned)(32 * blk + (r & 3) + 8 * (r >> 2)); v[r] = __uint_as_float(((__float_as_uint(acc[r]) & 0xFFFFFF80u) | code) ^ hi4); }
    sort16(v);
}
constexpr int TK_SK = 0, TK_IDX = 65536, TK_LDS_END = 65536 + 8192;
constexpr float TK_NEG = -3.4028234663852886e38f;
template <int P>
__device__ __forceinline__ void half_top16(float (&L)[16], const bf16_t* qrow, LAS unsigned char* lds, LAS unsigned char* idxslot, int r32, int hi) {
    bf16x8 qf[8];
#pragma unroll
    for (int ks = 0; ks < 8; ++ks) qf[ks] = *(const bf16x8*)(qrow + P * 128 + 16 * ks + 8 * hi);
    f32x16 acc[4];
#pragma unroll
    for (int blk = 0; blk < 4; ++blk) acc[blk] = f32x16{};
    const LAS unsigned char* ab = lds + TK_SK + P * 32768 + hi * 2048 + r32 * 16;
#pragma unroll
    for (int ks = 0; ks < 8; ++ks)
#pragma unroll
        for (int blk = 0; blk < 4; ++blk) {
            const bf16x8 af = *(const LAS bf16x8*)(ab + ks * 4096 + blk * 512);
            acc[blk] = __builtin_amdgcn_mfma_f32_32x32x16_bf16(af, qf[ks], acc[blk], 0, 0, 0);
        }
    const unsigned hi4 = (unsigned)hi << 2;
    float M[16];
    take_block(L, acc[0], 0, hi4); take_block(M, acc[1], 1, hi4); merge_top16(L, M);
    { float N[16]; take_block(M, acc[2], 2, hi4); take_block(N, acc[3], 3, hi4); merge_top16(M, N); }
    merge_top16(L, M);
    merge_partner(L, hi);
    if (hi == 0) {
        u32x4 w;
#pragma unroll
        for (int q = 0; q < 4; ++q) w[q] = (__float_as_uint(L[4 * q]) & 127u) | ((__float_as_uint(L[4 * q + 1]) & 127u) << 8) | ((__float_as_uint(L[4 * q + 2]) & 127u) << 16) | ((__float_as_uint(L[4 * q + 3]) & 127u) << 24);
        *(LAS u32x4*)(idxslot + P * 16) = w;
    }
}
__device__ __forceinline__ float cand(float x, float y, unsigned code, unsigned hi8) { return __uint_as_float((__float_as_uint(x + y) & 0xFFFFFE00u) | code | hi8); }

__device__ __forceinline__ void topk_phase(const bf16_t* Q2, const bf16_t* SKl, int* IDX, float* GATE, LAS unsigned char* lds, int wv) {
        const int tid = phase_tid(wv), lane = tid & 63, r32 = lane & 31, hi = lane >> 5, wid = wv;
    LAS unsigned char* idxslot = lds + TK_IDX + wid * 1024 + r32 * 32;
    int cur_h = -1;
    for (int unit = op_bid(); unit < 8 * (T / 256); unit += op_grid()) {
        const int h = unit & 7, tb = unit >> 3;
        if (h != cur_h) {
            __syncthreads();
#pragma unroll
            for (int i = 0; i < 8; ++i) { const int id = tid + 512 * i, c = id & 15, n = (id >> 4) & 127, p = id >> 11;
                const u32x4 v = *(const u32x4*)(SKl + ((size_t)(h * 2 + p) * 128 + n) * 128 + c * 8);
                *(LAS u32x4*)(lds + TK_SK + p * 32768 + c * 2048 + n * 16) = v; }
            __syncthreads();
            cur_h = h;
        }
        const size_t token = (size_t)tb * 256 + wid * 32 + r32;
        const bf16_t* qrow = Q2 + token * PQ + h * 256;
        float a[16], b[16];
        half_top16<0>(a, qrow, lds, idxslot, r32, hi);
        half_top16<1>(b, qrow, lds, idxslot, r32, hi);
        float x[16], y[16];
#pragma unroll
        for (int i = 0; i < 16; ++i) { float av = a[i], bv = b[i]; asm volatile("" : "+v"(av), "+v"(bv)); x[i] = hi ? bv : av; y[i] = hi ? av : bv; }
        const unsigned hi8 = (unsigned)hi << 8;
        float A[16], B[16];
#pragma unroll
        for (int j = 1; j < 16; ++j) A[j - 1] = cand(x[0], y[j], (unsigned)j, hi8);
        A[15] = TK_NEG;
#pragma unroll
        for (int j = 2; j < 8; ++j) B[j - 2] = cand(x[1], y[j], (unsigned)(16 + j), hi8);
        B[6] = cand(x[2], y[3], 2u * 16u + 3u, hi8); B[7] = cand(x[2], y[4], 2u * 16u + 4u, hi8);
#pragma unroll
        for (int i = 0; i < 4; ++i) { const float d = cand(x[i], y[i], (unsigned)(17 * i), hi8); B[8 + i] = hi ? TK_NEG : d; }
        B[12] = TK_NEG; B[13] = TK_NEG; B[14] = TK_NEG; B[15] = TK_NEG;
        sort16(B);
        merge_top16(A, B);
        merge_partner(A, hi);
        const float smax = A[0];
        float ex[8]; int eidx[8]; float lsum = 0.f;
        asm volatile("s_waitcnt lgkmcnt(0)" ::: "memory");
#pragma unroll
        for (int k = 0; k < 8; ++k) {
            float s_lo = A[k], s_hi = A[8 + k]; asm volatile("" : "+v"(s_lo), "+v"(s_hi)); const float s = hi ? s_hi : s_lo;
            ex[k] = __expf(s - smax); lsum += ex[k];
            const unsigned code = __float_as_uint(s) & 0x1FFu, src = code >> 8, ci = (code >> 4) & 15u, cj = code & 15u;
            const unsigned ai = src ? cj : ci, bi = src ? ci : cj;
            const unsigned ca = idxslot[ai], cb = idxslot[16 + bi];
            eidx[k] = (int)(((ca ^ 127u) << 7) | (cb ^ 127u));
        }
        const float tot = lsum + partner_f(lsum, hi);
        const float inv = 1.0f / tot;
        int* ip = IDX + token * 128 + h * 16 + 8 * hi; float* gp = GATE + token * 128 + h * 16 + 8 * hi;
        *(u32x4*)ip = (u32x4){(unsigned)eidx[0], (unsigned)eidx[1], (unsigned)eidx[2], (unsigned)eidx[3]};
        *(u32x4*)(ip + 4) = (u32x4){(unsigned)eidx[4], (unsigned)eidx[5], (unsigned)eidx[6], (unsigned)eidx[7]};
        *(f32x4*)gp = (f32x4){ex[0] * inv, ex[1] * inv, ex[2] * inv, ex[3] * inv};
        *(f32x4*)(gp + 4) = (f32x4){ex[4] * inv, ex[5] * inv, ex[6] * inv, ex[7] * inv};
        asm volatile("s_waitcnt lgkmcnt(0)" ::: "memory");
    }
}
}

namespace peer3 {
__device__ __forceinline__ unsigned xcc_id() { return (unsigned)__builtin_amdgcn_s_getreg((3 << 11) | 20) & 7u; }
constexpr int UNIT = 16, NUNIT = T / UNIT;
template <int CTRL> __device__ __forceinline__ int dpp_i(int v) { return __builtin_amdgcn_update_dpp(0, v, CTRL, 0xF, 0xF, true); }
__device__ __forceinline__ int rowsum16(int v) { v += dpp_i<0xB1>(v); v += dpp_i<0x4E>(v); v += dpp_i<0x141>(v); v += dpp_i<0x140>(v); return v; }
__device__ __forceinline__ float gelu_as(float v) {
    const float av = fabsf(v), t = __builtin_amdgcn_rcpf(fmaf(av, 0.2316418882f, 1.0f));
    float q = fmaf(t, 0.5307027145f, -0.7265760135f); q = fmaf(q, t, 0.7107068705f); q = fmaf(q, t, -0.142248368f); q = fmaf(q, t, 0.127414796f); q = q * t;
    const float e = __builtin_amdgcn_exp2f(v * v * -0.72134752044f), m = v * (q * e);
    return v < 0.f ? m : v - m;
}
__device__ __forceinline__ unsigned take_async(unsigned* p, int lane) { unsigned v = 0u; if (lane == 0) v = __hip_atomic_fetch_add(p, 1u, __ATOMIC_RELAXED, __HIP_MEMORY_SCOPE_AGENT); return v; }

constexpr int UST = 6;
__device__ __forceinline__ void u_unit(const KArgs& a, int l, unsigned s, unsigned unit, LAS unsigned char* wlds, int lane) {
    const unsigned char* UQ = a.ws + WS_UQ + (size_t)l * NEXP * 1024;
    const float* USC = (const float*)(a.ws + WS_USC) + l * NEXP; const float* VSC = (const float*)(a.ws + WS_VSC) + l * NEXP;
    const int* IDX = (const int*)(a.ws + WS_IDX); const float* GATE = (const float*)(a.ws + WS_GATE);
    const unsigned char* HQ = a.ws + WS_H2Q; const float* HS = (const float*)(a.ws + WS_HS);
    float* COEF = (float*)(a.ws + WS_COEF);
    LAS int* lst = (LAS int*)wlds; LAS float* res = (LAS float*)(wlds + 512);
    const int q = lane >> 4, r = lane & 15;
    const size_t t0 = (size_t)unit * UNIT;
    int idx0 = IDX[t0 * 128 + lane], idx1 = IDX[t0 * 128 + 64 + lane];
    float g0 = GATE[t0 * 128 + lane], g1 = GATE[t0 * 128 + 64 + lane], sh = HS[t0];
    u32x4 hv[4];
#pragma unroll
    for (int k = 0; k < 4; ++k) hv[k] = *(const u32x4*)(HQ + t0 * 1024 + 256 * k + 16 * r);
#pragma unroll 1
    for (int i = 0; i < UNIT; ++i) {
        const size_t t = t0 + i, tn = t0 + (i + 1 < UNIT ? i + 1 : i);
        const float us0 = USC[idx0], us1 = USC[idx1], vs0 = VSC[idx0], vs1 = VSC[idx1];
        const int nidx0 = IDX[tn * 128 + lane], nidx1 = IDX[tn * 128 + 64 + lane];
        const float ng0 = GATE[tn * 128 + lane], ng1 = GATE[tn * 128 + 64 + lane], nsh = HS[tn];
        const bool in0 = (unsigned)(idx0 >> 11) == s, in1 = (unsigned)(idx1 >> 11) == s;
        const unsigned long long m0 = __ballot(in0), m1 = __ballot(in1);
        const int c0 = __builtin_popcountll(m0), n = c0 + __builtin_popcountll(m1);
        const int rank0 = (int)__builtin_amdgcn_mbcnt_hi((unsigned)(m0 >> 32), __builtin_amdgcn_mbcnt_lo((unsigned)m0, 0u));
        const int rank1 = c0 + (int)__builtin_amdgcn_mbcnt_hi((unsigned)(m1 >> 32), __builtin_amdgcn_mbcnt_lo((unsigned)m1, 0u));
        if (in0) lst[rank0] = idx0;
        if (in1) lst[rank1] = idx1;
#pragma unroll 1
        for (int base = 0; base < n; base += 4 * UST) {
            const int nst = (n - base + 3) >> 2;
            u32x4 uv[UST][4];
#pragma unroll
            for (int st = 0; st < UST; ++st) {
                if (st < nst) {
                    int slot = base + 4 * st + q; slot = slot < n ? slot : n - 1;
                    const unsigned char* rp = UQ + (size_t)lst[slot] * 1024 + 16 * r;
#pragma unroll
                    for (int k = 0; k < 4; ++k) uv[st][k] = *(const u32x4*)(rp + 256 * k);
                }
            }
#pragma unroll
            for (int st = 0; st < UST; ++st) {
                if (st < nst) {
                    int s0_ = 0, s1_ = 0, s2_ = 0, s3_ = 0;
#pragma unroll
                    for (int k = 0; k < 4; ++k) {
                        s0_ = __builtin_amdgcn_sdot4((int)uv[st][k].x, (int)hv[k].x, s0_, false); s1_ = __builtin_amdgcn_sdot4((int)uv[st][k].y, (int)hv[k].y, s1_, false);
                        s2_ = __builtin_amdgcn_sdot4((int)uv[st][k].z, (int)hv[k].z, s2_, false); s3_ = __builtin_amdgcn_sdot4((int)uv[st][k].w, (int)hv[k].w, s3_, false);
                    }
                    const int tot = rowsum16((s0_ + s1_) + (s2_ + s3_));
                    if (r == 0) res[base + 4 * st + q] = (float)tot;
                }
            }
        }
        const float d0 = in0 ? res[rank0] : 0.f, d1 = in1 ? res[rank1] : 0.f;
        u32x4 nhv[4];
#pragma unroll
        for (int k = 0; k < 4; ++k) nhv[k] = *(const u32x4*)(HQ + tn * 1024 + 256 * k + 16 * r);
        if (in0) COEF[t * 128 + lane] = gelu_as(d0 * us0 * sh) * g0 * vs0;
        if (in1) COEF[t * 128 + 64 + lane] = gelu_as(d1 * us1 * sh) * g1 * vs1;
        idx0 = nidx0; idx1 = nidx1; g0 = ng0; g1 = ng1; sh = nsh;
#pragma unroll
        for (int k = 0; k < 4; ++k) hv[k] = nhv[k];
    }
}
struct VMeta { u32x4 iv[4]; f32x4 cv[4]; };
__device__ __forceinline__ void v_meta(VMeta& m, const int* IDX, const float* COEF, size_t t, int g) {
#pragma unroll
    for (int q = 0; q < 4; ++q) { m.iv[q] = *(const u32x4*)(IDX + t * 128 + 16 * g + 4 * q); m.cv[q] = *(const f32x4*)(COEF + t * 128 + 16 * g + 4 * q); }
}
__device__ __forceinline__ void v_stage(u32x4 (&P)[16], u32x4& CQ, float& cs, const VMeta& m, const unsigned char* VS) {
    float cm = 0.f;
#pragma unroll
    for (int j = 0; j < 16; ++j) cm = fmaxf(cm, fabsf(m.cv[j >> 2][j & 3]));
    cm = fmaxf(cm, swz_xor<8>(cm)); cm = fmaxf(cm, swz_xor<16>(cm));
    { auto rr = __builtin_amdgcn_permlane32_swap(__float_as_uint(cm), __float_as_uint(cm), false, false); cm = fmaxf(__uint_as_float(rr[0]), __uint_as_float(rr[1])); }
    const float inv = cm > 0.f ? 127.0f / cm : 0.f; cs = cm * (1.0f / 127.0f);
#pragma unroll
    for (int qd = 0; qd < 4; ++qd) {
        const int c0 = (int)rintf(m.cv[qd][0] * inv), c1 = (int)rintf(m.cv[qd][1] * inv), c2 = (int)rintf(m.cv[qd][2] * inv), c3 = (int)rintf(m.cv[qd][3] * inv);
        CQ[qd] = (unsigned)(c0 & 0xff) | ((unsigned)(c1 & 0xff) << 8) | ((unsigned)(c2 & 0xff) << 16) | ((unsigned)(c3 & 0xff) << 24);
    }
#pragma unroll
    for (int j = 0; j < 16; ++j) P[j] = *(const u32x4*)(VS + (size_t)m.iv[j >> 2][j & 3] * 128);
}
__device__ __forceinline__ void v_compute(const u32x4 (&P)[16], const u32x4& CQ, float cs, float* xout, const float* mod_l, size_t t, unsigned s, int lane) {
    const int g = lane >> 3, p = lane & 7; const bool b4 = (lane >> 4) & 1, b3 = (lane >> 3) & 1;
    typedef float f32x2 __attribute__((ext_vector_type(2)));
    const int col = (int)s * 128 + 16 * p + 2 * g, b = (int)(t >> 12);
    float* xp = xout + t * DM + col;
    f32x2 xv = *(const f32x2*)xp;
    const f32x2 gt = *(const f32x2*)(mod_l + (size_t)b * NMOD + 5 * DM + col);
    int acc[16];
#pragma unroll
    for (int k = 0; k < 16; ++k) acc[k] = 0;
#pragma unroll
    for (int qd = 0; qd < 4; ++qd)
#pragma unroll
        for (int w = 0; w < 4; ++w) {
            const unsigned A = P[4 * qd][w], B = P[4 * qd + 1][w], C = P[4 * qd + 2][w], D = P[4 * qd + 3][w];
            const unsigned X = __builtin_amdgcn_perm(B, A, 0x05010400u), Y = __builtin_amdgcn_perm(B, A, 0x07030602u);
            const unsigned Z = __builtin_amdgcn_perm(D, C, 0x05010400u), W = __builtin_amdgcn_perm(D, C, 0x07030602u);
            const unsigned T0 = __builtin_amdgcn_perm(Z, X, 0x05040100u), T1 = __builtin_amdgcn_perm(Z, X, 0x07060302u);
            const unsigned T2 = __builtin_amdgcn_perm(W, Y, 0x05040100u), T3 = __builtin_amdgcn_perm(W, Y, 0x07060302u);
            acc[4 * w + 0] = __builtin_amdgcn_sdot4((int)T0, (int)CQ[qd], acc[4 * w + 0], false); acc[4 * w + 1] = __builtin_amdgcn_sdot4((int)T1, (int)CQ[qd], acc[4 * w + 1], false);
            acc[4 * w + 2] = __builtin_amdgcn_sdot4((int)T2, (int)CQ[qd], acc[4 * w + 2], false); acc[4 * w + 3] = __builtin_amdgcn_sdot4((int)T3, (int)CQ[qd], acc[4 * w + 3], false);
        }
    int r8[8], r4[4], r2[2];
#pragma unroll
    for (int q = 0; q < 8; ++q) { auto rr = __builtin_amdgcn_permlane32_swap((unsigned)acc[q], (unsigned)acc[8 + q], false, false); r8[q] = (int)rr[0] + (int)rr[1]; }
#pragma unroll
    for (int q = 0; q < 4; ++q) { int lo = r8[q], hi = r8[4 + q]; asm volatile("" : "+v"(lo), "+v"(hi)); const int keep = b4 ? hi : lo, send = b4 ? lo : hi; r4[q] = keep + __builtin_amdgcn_ds_swizzle(send, (16 << 10) | 0x1f); }
#pragma unroll
    for (int q = 0; q < 2; ++q) { int lo = r4[q], hi = r4[2 + q]; asm volatile("" : "+v"(lo), "+v"(hi)); const int keep = b3 ? hi : lo, send = b3 ? lo : hi; r2[q] = keep + __builtin_amdgcn_ds_swizzle(send, (8 << 10) | 0x1f); }
    xv.x += gt.x * ((float)r2[0] * cs); xv.y += gt.y * ((float)r2[1] * cs);
    *(f32x2*)xp = xv;
}
__device__ __forceinline__ void v_unit(const KArgs& a, int l, const float* mod_l, unsigned s, unsigned unit, int lane) {
    const int g = lane >> 3, p = lane & 7;
    const unsigned char* VS = a.ws + WS_VQ + (size_t)l * NEXP * 1024 + (size_t)s * NEXP * 128 + 16 * p;
    const int* IDX = (const int*)(a.ws + WS_IDX); const float* COEF = (const float*)(a.ws + WS_COEF);
    const size_t t0 = (size_t)unit * UNIT;
    VMeta m; v_meta(m, IDX, COEF, t0, g);
    u32x4 PA[16], PB[16], CQA, CQB; float csA, csB;
    v_stage(PA, CQA, csA, m, VS);
    v_meta(m, IDX, COEF, t0 + 1, g);
#pragma unroll 1
    for (int i = 0; i < UNIT; i += 2) {
        v_stage(PB, CQB, csB, m, VS);
        v_meta(m, IDX, COEF, t0 + (i + 2 < UNIT ? i + 2 : i), g);
        v_compute(PA, CQA, csA, a.out, mod_l, t0 + i, s, lane);
        if (i + 2 < UNIT) { v_stage(PA, CQA, csA, m, VS); v_meta(m, IDX, COEF, t0 + (i + 3 < UNIT ? i + 3 : i), g); }
        v_compute(PB, CQB, csB, a.out, mod_l, t0 + i + 1, s, lane);
    }
}
template <bool VSTEP>
__device__ __forceinline__ void peer_phase(const KArgs& a, int l, const float* mod_l, unsigned* cnt, LAS unsigned char* lds, int wv) {
        const int tid = phase_tid(wv), lane = tid & 63, wid = wv;
    LAS unsigned char* wlds = lds + wid * 1024;
    const unsigned home = xcc_id();
    unsigned ss = 0, s = home;
    unsigned nxt = take_async(cnt + 64 * s, lane);
    for (;;) {
        const unsigned cur = (unsigned)__builtin_amdgcn_readfirstlane((int)nxt);
        if (cur >= (unsigned)NUNIT) { if (++ss == 8u) break; s = (home + ss) & 7u; nxt = take_async(cnt + 64 * s, lane); continue; }
        nxt = take_async(cnt + 64 * s, lane);
        if (VSTEP) v_unit(a, l, mod_l, s, cur, lane); else u_unit(a, l, s, cur, wlds, lane);
    }
}
}

constexpr int PH_PER_LAYER = 10, NPHASES = 1 + DEPTH * PH_PER_LAYER + 1;
#ifndef PHASE_MASK
#define PHASE_MASK 0xFFFF
#endif
#define HASP(k) (((PHASE_MASK) >> (k)) & 1)
#ifndef SB_EARLY_EXIT
#define SB_EARLY_EXIT 1
#endif

#define GAS __attribute__((address_space(1)))
#define RLX_AGENT __ATOMIC_RELAXED, __HIP_MEMORY_SCOPE_AGENT
#define XB_TMO      128
#define XB_XCNT(j)  (256  + 64 * (j))
#define XB_XSUB(j)  (1280 + 64 * (j))
#define XB_XGEN(j)  (2304 + 64 * (j))
#define XB_TOP      3328
#define XB_TOPGEN   3392
#define XCD_BAR_WORDS 3456
#define XB_SPIN_CAP (1u << 18)

__device__ __forceinline__ unsigned xb_ld(unsigned* p)              { return __hip_atomic_load(p, __ATOMIC_RELAXED, __HIP_MEMORY_SCOPE_AGENT); }
__device__ __forceinline__ unsigned xb_add(unsigned* p, unsigned v) { return __hip_atomic_fetch_add(p, v, __ATOMIC_RELAXED, __HIP_MEMORY_SCOPE_AGENT); }
__device__ __forceinline__ unsigned xb_xcc_id() { return (unsigned)__builtin_amdgcn_s_getreg((3 << 11) | 20) & 0xFu; }
#define XB_SPIN(cond, bar) do { unsigned _sp = 0; while (cond) { __builtin_amdgcn_s_sleep(1); \
    if ((++_sp & 255u) == 0u) { if (xb_ld(&(bar)[XB_TMO])) break; if (_sp > XB_SPIN_CAP) { atomicAdd(&(bar)[XB_TMO], 1u); break; } } } } while (0)

struct XcdBarrier {
    unsigned* bar; unsigned x;
    volatile LAS unsigned* st;
};

__device__ __forceinline__ XcdBarrier xcd_barrier_post(unsigned* bar, volatile LAS unsigned* st, bool tid0) {
    XcdBarrier b; b.bar = bar; b.x = xb_xcc_id(); b.st = st;
    if (tid0) (void)xb_add(&bar[XB_XCNT(b.x)], 1u);
    return b;
}
__device__ __forceinline__ void xcd_barrier_complete(unsigned* bar, unsigned x, unsigned& nloc, unsigned& nx) {
    const unsigned G = gridDim.x * gridDim.y * gridDim.z;
    unsigned sum, cnt, mine, sp = 0u;
    for (;;) {
        sum = 0u; cnt = 0u; mine = 0u;
#pragma unroll
        for (unsigned j = 0; j < 16; ++j) { const unsigned c = xb_ld(&bar[XB_XCNT(j)]); sum += c; cnt += (c > 0u) ? 1u : 0u; mine = (j == x) ? c : mine; }
        if (sum == G) break;
        __builtin_amdgcn_s_sleep(1);
        if ((++sp & 255u) == 0u) { if (xb_ld(&bar[XB_TMO])) break; if (sp > XB_SPIN_CAP) { atomicAdd(&bar[XB_TMO], 1u); break; } }
    }
    nloc = mine > 0u ? mine : 1u; nx = cnt > 0u ? cnt : 1u;
}

__device__ __forceinline__ void xcd_barrier(const XcdBarrier& b, bool tid0) {
    asm volatile("s_waitcnt vmcnt(0)" ::: "memory");
    __syncthreads();
    if (tid0) {
        unsigned* bar = b.bar;
        __builtin_amdgcn_s_waitcnt(0);
        unsigned nloc = b.st[0], nx = b.st[1];
        if (nloc == 0u) { xcd_barrier_complete(bar, b.x, nloc, nx); b.st[0] = nloc; b.st[1] = nx; }
        const unsigned old = xb_add(&bar[XB_XSUB(b.x)], 1u);
        const unsigned gen = old / nloc;
        if (old + 1u == (gen + 1u) * nloc) {
            __builtin_amdgcn_fence(__ATOMIC_RELEASE, "agent");
            asm volatile("s_waitcnt vmcnt(0)" ::: "memory");
            const unsigned og = xb_add(&bar[XB_TOP], 1u);
            const unsigned tg = og / nx;
            if (og + 1u == (tg + 1u) * nx) xb_add(&bar[XB_TOPGEN], 1u);
            else XB_SPIN(xb_ld(&bar[XB_TOPGEN]) == tg, bar);
            __builtin_amdgcn_fence(__ATOMIC_ACQUIRE, "agent");
            xb_add(&bar[XB_XGEN(b.x)], 1u);
            asm volatile("s_waitcnt vmcnt(0)" ::: "memory");
        } else {
            XB_SPIN(xb_ld(&bar[XB_XGEN(b.x)]) == gen, bar);
            __builtin_amdgcn_fence(__ATOMIC_ACQUIRE, "agent");
            asm volatile("s_waitcnt vmcnt(0)" ::: "memory");
        }
    }
    __syncthreads();
}

typedef const __attribute__((address_space(4))) KArgs* KArgsP;
__device__ __forceinline__ KArgsP kargs() { KArgsP p = (KArgsP)__builtin_amdgcn_kernarg_segment_ptr(); asm volatile("" : "+s"(p)); return p; }

__device__ __forceinline__ void load_args(KArgs& a) {
#if defined(__HIP_DEVICE_COMPILE__)
    KArgsP p = kargs();
    a.x = p->x; a.c = p->c; a.pos = p->pos; a.ada_w = p->ada_w; a.ada_b = p->ada_b; a.norm1_g = p->norm1_g; a.w_in = p->w_in; a.sinks = p->sinks; a.wbr_a = p->wbr_a; a.wbr_b = p->wbr_b;
    a.w_out = p->w_out; a.norm2_g = p->norm2_g; a.wq = p->wq; a.subkeys = p->subkeys; a.pu = p->pu; a.pv = p->pv; a.final_g = p->final_g; a.out = p->out; a.ws = p->ws; a.ph_lo = p->ph_lo; a.ph_hi = p->ph_hi;
#endif
}
__global__ void __launch_bounds__(NTHREADS, 2) fwd_kernel(KArgs a_unused) {
    extern __shared__ __attribute__((aligned(16))) unsigned char lds_raw[];
    LAS unsigned char* lds = (LAS unsigned char*)lds_raw;
    cg::grid_group grid = cg::this_grid();
    const int ph_lo = kargs()->ph_lo, ph_hi = kargs()->ph_hi;
    const int wv = __builtin_amdgcn_readfirstlane((int)threadIdx.x >> 6);
#define IN(k) (ph_lo <= (k) && (k) < ph_hi)
    volatile LAS unsigned* xb_st = (volatile LAS unsigned*)(lds + LDS_BYTES - 64);
    { const bool t0_ = phase_tid(wv) == 0; if (t0_) { xb_st[0] = 0u; xb_st[1] = 0u; } __syncthreads();
      (void)xcd_barrier_post((unsigned*)(kargs()->ws + WS_CTL) + CTL_BAR, xb_st, t0_); }
#define GRID_BAR() do { XcdBarrier b_; b_.bar = (unsigned*)(kargs()->ws + WS_CTL) + CTL_BAR; b_.x = xb_xcc_id(); b_.st = xb_st; xcd_barrier(b_, phase_tid(wv) == 0); } while (0)
#ifdef PROBE_PH
    unsigned long long pr_prev = __builtin_amdgcn_s_memrealtime(), pr_acc = 0;
#define PROBE_MATCH(k) ((PROBE_PH) >= 100 ? ((k) >= 1 && (k) < NPHASES - 1 && (((k) - 1) % PH_PER_LAYER) == (PROBE_PH) - 100) : (k) == (PROBE_PH))
#define SEAM(k) do { if (IN(k) && IN((k) + 1)) { if ((k) == 0) grid.sync(); else GRID_BAR(); } { const unsigned long long now_ = __builtin_amdgcn_s_memrealtime(); if (PROBE_MATCH(k)) pr_acc += now_ - pr_prev; pr_prev = now_; } } while (0)
#else
#define SEAM(k) do { if (IN(k) && IN((k) + 1)) { if ((k) == 0) grid.sync(); else GRID_BAR(); } } while (0)
#endif
#define LOADARGS KArgs a; load_args(a); unsigned char* ws = a.ws; const int G = op_grid(); (void)G; (void)ws
#define LAYERARGS const float* mod_l = (const float*)(ws + WS_MOD) + (size_t)l * 8 * NMOD; const float* xcur = (l == 0) ? a.x : a.out; (void)mod_l; (void)xcur
    if (IN(0)) { if (HASP(0)) { LOADARGS; ph_prologue(a, lds, wv); } }
    SEAM(0);
#pragma unroll 1
    for (int l = 0; l < DEPTH; ++l) {
        const int p0 = 1 + l * PH_PER_LAYER;
        if (IN(p0 + 0)) { if (HASP(1)) { LOADARGS; LAYERARGS; ph_norm<false>(a, xcur, a.norm1_g + l * DM, mod_l, 0, 1, wv); } }
        SEAM(p0 + 0);
        if (IN(p0 + 1)) { if (HASP(2)) { LOADARGS; pg8::Gemm g{(const bf16_t*)(ws + WS_H), (const bf16_t*)(ws + WS_WIN) + (size_t)l * NPROJ * 1024, T, NPROJ, 1024};
                  pg8::StaticOrder S; S.init(T, NPROJ, G, op_bid()); EpiProj E{ws};
                  pg8::gemm_phase<EpiProj, pg8::StaticOrder, true, true>(lds, g, S, E, wv); } }
        SEAM(p0 + 1);
        if (IN(p0 + 2)) { if (HASP(3)) { LOADARGS;
                  att::swa_phase((const bf16_t*)(ws + WS_QA), (const bf16_t*)(ws + WS_KA), (const bf16_t*)(ws + WS_VA), (bf16_t*)(ws + WS_QA), a.sinks + l * 8, lds, wv);
                  __syncthreads();
                  att::sb_phase<SB_EARLY_EXIT != 0>((const bf16_t*)(ws + WS_QB), (const bf16_t*)(ws + WS_KB), (const bf16_t*)(ws + WS_VB), (bf16_t*)(ws + WS_QB), lds, wv); } }
        SEAM(p0 + 2);
        if (IN(p0 + 3)) { if (HASP(4)) { LOADARGS; pg8::StaticOrder S; S.init(T, DM, G, op_bid());
                  { pg8::Gemm g{(const bf16_t*)(ws + WS_QA), (const bf16_t*)(ws + WS_WBA) + (size_t)l * 1024 * 512, T, DM, 512};
                    EpiBranch<false> E{(const bf16_t*)(ws + WS_GA), (bf16_t*)(ws + WS_H)};
                    pg8::gemm_phase<EpiBranch<false>, pg8::StaticOrder, true, true>(lds, g, S, E, wv); }
                  __syncthreads();
                  { pg8::Gemm g{(const bf16_t*)(ws + WS_QB), (const bf16_t*)(ws + WS_WBB) + (size_t)l * 1024 * 512, T, DM, 512};
                    EpiBranch<true> E{(const bf16_t*)(ws + WS_GB), (bf16_t*)(ws + WS_H)};
                    pg8::gemm_phase<EpiBranch<true>, pg8::StaticOrder, true, true>(lds, g, S, E, wv); } } }
        SEAM(p0 + 3);
        if (IN(p0 + 4)) { if (HASP(5)) { LOADARGS; LAYERARGS; pg8::Gemm g{(const bf16_t*)(ws + WS_H), (const bf16_t*)(ws + WS_WOUT) + (size_t)l * 1024 * 1024, T, DM, 1024};
                  pg8::StaticOrder S; S.init(T, DM, G, op_bid()); EpiWout E{xcur, a.out, mod_l + 2 * DM};
                  pg8::gemm_phase<EpiWout, pg8::StaticOrder, true, true>(lds, g, S, E, wv); } }
        SEAM(p0 + 4);
        if (IN(p0 + 5)) { if (HASP(6)) { LOADARGS; LAYERARGS; ph_norm<true>(a, a.out, a.norm2_g + l * DM, mod_l, 3, 4, wv); } }
        SEAM(p0 + 5);
        if (IN(p0 + 6)) { if (HASP(7)) { LOADARGS; pg8::Gemm g{(const bf16_t*)(ws + WS_H), (const bf16_t*)(ws + WS_WQ) + (size_t)l * PQ * 1024, T, PQ, 1024};
                  pg8::StaticOrder S; S.init(T, PQ, G, op_bid()); EpiPlainBf16 E{(bf16_t*)(ws + WS_Q2), PQ};
                  pg8::gemm_phase<EpiPlainBf16, pg8::StaticOrder, true, true>(lds, g, S, E, wv); } }
        SEAM(p0 + 6);
        if (IN(p0 + 7)) { if (HASP(8)) { LOADARGS; tk::topk_phase((const bf16_t*)(ws + WS_Q2), (const bf16_t*)(ws + WS_SK) + (size_t)l * 8 * 2 * 128 * 128, (int*)(ws + WS_IDX), (float*)(ws + WS_GATE), lds, wv); } }
        SEAM(p0 + 7);
        if (IN(p0 + 8)) { if (HASP(9)) { LOADARGS; peer3::peer_phase<false>(a, l, nullptr, (unsigned*)(ws + WS_CTL) + CTL_QUEUE + (l * 2 + 0) * 8 * 64, lds, wv); } }
        SEAM(p0 + 8);
        if (IN(p0 + 9)) { if (HASP(10)) { LOADARGS; LAYERARGS; peer3::peer_phase<true>(a, l, mod_l, (unsigned*)(ws + WS_CTL) + CTL_QUEUE + (l * 2 + 1) * 8 * 64, lds, wv); } }
        SEAM(p0 + 9);
    }
    if (IN(NPHASES - 1)) { if (HASP(11)) { LOADARGS; ph_final_norm(a, wv); } }
#ifdef PROBE_PH
    { const unsigned long long now_ = __builtin_amdgcn_s_memrealtime(); if (PROBE_MATCH(NPHASES - 1)) pr_acc += now_ - pr_prev;
      if (blockIdx.x == 0 && threadIdx.x == 0) { const unsigned long long t0_ = __builtin_amdgcn_s_memrealtime(); while (__builtin_amdgcn_s_memrealtime() - t0_ < pr_acc * (PROBE_K)) __builtin_amdgcn_s_sleep(16); } }
#endif
#undef IN
#undef SEAM
}

#ifndef N_LAUNCH_SPLIT
#define N_LAUNCH_SPLIT 1
#endif
extern "C" void kernel_launch(void* const* d_in, const int* in_sizes, int n_in, void* d_out, int out_size, void* d_ws, size_t ws_size, hipStream_t stream) {
    static int grid = 0;
    if (grid == 0) {
        if (n_in != 17 || out_size != T * DM || ws_size < WS_END) { fprintf(stderr, "kernel_launch: unexpected problem (n_in %d out %d ws %zu)\n", n_in, out_size, ws_size); grid = -1; return; }
        int dev = 0, cus = 0, per_cu = 0;
        (void)hipGetDevice(&dev);
        (void)hipDeviceGetAttribute(&cus, hipDeviceAttributeMultiprocessorCount, dev);
        (void)hipFuncSetAttribute((const void*)fwd_kernel, hipFuncAttributeMaxDynamicSharedMemorySize, LDS_BYTES);
        (void)hipOccupancyMaxActiveBlocksPerMultiprocessor(&per_cu, (const void*)fwd_kernel, NTHREADS, LDS_BYTES);
        if (per_cu < 1) { fprintf(stderr, "kernel_launch: occupancy query says %d\n", per_cu); per_cu = 1; }
        grid = cus;
        fprintf(stderr, "kernel_launch: cus %d per_cu %d grid %d ws %zu\n", cus, per_cu, grid, ws_size);
    }
    if (grid < 0) return;
    if (hipMemsetAsync((char*)d_ws + WS_CTL, 0, 65536, stream) != hipSuccess) { fprintf(stderr, "kernel_launch: hipMemsetAsync of the control words failed\n"); return; }
    KArgs a{};
    a.x = (const float*)d_in[0]; a.c = (const float*)d_in[1]; a.pos = (const int*)d_in[2]; a.ada_w = (const float*)d_in[3]; a.ada_b = (const float*)d_in[4];
    a.norm1_g = (const float*)d_in[5]; a.w_in = (const float*)d_in[6]; a.sinks = (const float*)d_in[7]; a.wbr_a = (const float*)d_in[8]; a.wbr_b = (const float*)d_in[9];
    a.w_out = (const float*)d_in[10]; a.norm2_g = (const float*)d_in[11]; a.wq = (const float*)d_in[12]; a.subkeys = (const float*)d_in[13]; a.pu = (const float*)d_in[14];
    a.pv = (const float*)d_in[15]; a.final_g = (const float*)d_in[16]; a.out = (float*)d_out; a.ws = (unsigned char*)d_ws;
#if N_LAUNCH_SPLIT
    a.ph_lo = 0; a.ph_hi = NPHASES;
    { void* args[] = {&a};
      hipError_t e = hipLaunchCooperativeKernel((void*)fwd_kernel, dim3(grid), dim3(NTHREADS), args, LDS_BYTES, stream);
      if (e != hipSuccess) fprintf(stderr, "cooperative launch failed: %s (grid %d)\n", hipGetErrorString(e), grid); }
#else
    for (int ph = 0; ph < NPHASES; ++ph) {
        a.ph_lo = ph; a.ph_hi = ph + 1;
        void* args[] = {&a};
        hipError_t e = hipLaunchCooperativeKernel((void*)fwd_kernel, dim3(grid), dim3(NTHREADS), args, LDS_BYTES, stream);
        if (e != hipSuccess) { fprintf(stderr, "cooperative launch %d failed: %s (grid %d)\n", ph, hipGetErrorString(e), grid); break; }
    }
#endif
}
```

```cpp
#include <hip/hip_runtime.h>
#include <hip/hip_cooperative_groups.h>
#include <cstdio>
#include <cstdint>
namespace cg = cooperative_groups;

namespace pg8 {
#define PG8_LAS __attribute__((address_space(3)))
typedef unsigned short bf16_t;
typedef short bf16x8 __attribute__((ext_vector_type(8)));
typedef float f32x4 __attribute__((ext_vector_type(4)));
typedef unsigned u32x4 __attribute__((ext_vector_type(4)));
constexpr int BM = 256, BK = 64, HALF = 128, HTB = HALF * BK * 2  , STAGE_BYTES = 8 * HTB, NXCD = 8, WGM = 8;

__host__ __device__ __forceinline__ int lds_byte(int r, int c) { const int st = (r >> 4) * 2 + (c >> 5), rr = r & 15, cc = c & 31, ob = rr * 64 + cc * 2; return st * 1024 + (ob ^ (((ob >> 9) & 1) << 5)); }
__host__ __device__ __forceinline__ void stage_rc(int b, int& R, int& C) { const int st = b / 1024, sb = b % 1024, swz = sb ^ (((sb >> 9) & 1) << 5); R = (st >> 1) * 16 + swz / 64; C = (st & 1) * 32 + (swz % 64) / 2; }
__host__ __device__ __forceinline__ int perm32(int rho) { const int n = rho >> 4, i = rho & 15; return 8 * (i >> 2) + 4 * n + (i & 3); }

struct Unit { int pm, pn; };
struct Gemm { const bf16_t* A; const bf16_t* Bt; int M, N, K; };

struct StaticOrder {
    int nM, nN, nwg, G, c;
    __host__ __device__ void init(int M, int N, int G_, int c_) { nM = M / BM; nN = N / BM; nwg = nM * nN; G = G_; c = c_; }
    __host__ __device__ bool next(int i, Unit& u) const {
        const long L = (long)i * G + c; if (L >= nwg) return false;
        int wgid = (int)L; { const int q = nwg / NXCD, r = nwg % NXCD, xcd = wgid % NXCD, off = wgid / NXCD; wgid = (xcd < r ? xcd * (q + 1) : r * (q + 1) + (xcd - r) * q) + off; }
        const int nig = WGM * nN, gid = wgid / nig, fm = gid * WGM, gsz = (nM - fm) < WGM ? (nM - fm) : WGM;
        u.pm = fm + ((wgid % nig) % gsz); u.pn = (wgid % nig) / gsz; return true;
    }
    __device__ __forceinline__ void a_ready(const Unit&) const {}
    __device__ __forceinline__ void done(const Unit&) const {}
};


__device__ __forceinline__ unsigned cvt_pk_bf16(float lo, float hi) { unsigned r; asm volatile("v_cvt_pk_bf16_f32 %0, %1, %2" : "=v"(r) : "v"(lo), "v"(hi)); return r; }
template <class Epi, class Sched, bool ALIGN_EPI = false, bool SP2 = false>
__device__ __forceinline__ void gemm_phase(PG8_LAS unsigned char* lds, const Gemm g, const Sched& S, const Epi& E, int wv) {
    unsigned m_op = ~0u; asm volatile("" : "+s"(m_op));
    const int tid = wv * 64 + (int)__builtin_amdgcn_mbcnt_hi(m_op, __builtin_amdgcn_mbcnt_lo(m_op, 0u)), wid = wv, lane = tid & 63, wr = wid >> 2, wc = wid & 3, fr = lane & 15, fq = lane >> 4;
    const int K = g.K, nt = K / BK;
    unsigned voffA[2], voffB[2];
#pragma unroll
    for (int i = 0; i < 2; ++i) { int R, C; stage_rc(tid * 16 + i * 8192, R, C); const int Rb = Epi::PERM ? ((R & ~31) + perm32(R & 31)) : R;
        voffA[i] = (unsigned)(R * K + C) * 2u; voffB[i] = (unsigned)(Rb * K + C) * 2u; }
    const size_t kstep = (size_t)(BK * 2);
    const size_t hstep = (size_t)HALF * K * 2;
    const size_t tstep = 2 * hstep;
    const unsigned ldsw = (unsigned)wid * 1024u;
    const int aoff = lds_byte(wr * 64 + fr, fq * 8), boff = lds_byte(wc * 32 + fr, fq * 8);
#define PG8_SA(b, h) (((b) * 2 + (h)) * HTB)
#define PG8_SB(b, h) ((4 + (b) * 2 + (h)) * HTB)
#define PG8_STAGE(bufoff, gbase, voff) do { _Pragma("unroll") for (int _i = 0; _i < 2; ++_i) \
        __builtin_amdgcn_global_load_lds((const unsigned*)((const char*)(gbase) + (voff)[_i]), (PG8_LAS unsigned*)(lds + (bufoff) + ldsw + _i * 8192), 16, 0, 0); } while (0)
#define PG8_LDA(dst, b, h) do { _Pragma("unroll") for (int m = 0; m < 4; ++m) _Pragma("unroll") for (int k = 0; k < 2; ++k) dst[m][k] = *(const PG8_LAS bf16x8*)(lds + PG8_SA(b, h) + aoff + m * 2048 + k * 1024); } while (0)
#define PG8_LDB(dst, b, h) do { _Pragma("unroll") for (int n = 0; n < 2; ++n) _Pragma("unroll") for (int k = 0; k < 2; ++k) dst[n][k] = *(const PG8_LAS bf16x8*)(lds + PG8_SB(b, h) + boff + n * 2048 + k * 1024); } while (0)
#define PG8_MMA(ai, bj, At, Bt) do { __builtin_amdgcn_s_setprio(1); _Pragma("unroll") for (int m = 0; m < 4; ++m) _Pragma("unroll") for (int n = 0; n < 2; ++n) _Pragma("unroll") for (int k = 0; k < 2; ++k) \
        acc[ai][bj][m][n] = __builtin_amdgcn_mfma_f32_16x16x32_bf16(Bt[n][k], At[m][k], acc[ai][bj][m][n], 0, 0, 0); __builtin_amdgcn_s_setprio(0); } while (0)
#define PG8_WAIT_V(n) asm volatile("s_waitcnt vmcnt(" #n ")" ::: "memory")
#define PG8_WAIT_L(n) asm volatile("s_waitcnt lgkmcnt(" #n ")" ::: "memory")
#define PG8_BAR __builtin_amdgcn_s_barrier()
#define PG8_SCHED __builtin_amdgcn_sched_barrier(0)
    Unit cur, nxt; int ui = 0;
    if (!S.next(0, cur)) return;
    f32x4 acc[2][2][4][2];
#pragma unroll
    for (int a = 0; a < 2; ++a)
#pragma unroll
        for (int b = 0; b < 2; ++b)
#pragma unroll
            for (int m = 0; m < 4; ++m)
#pragma unroll
                for (int n = 0; n < 2; ++n) acc[a][b][m][n] = (f32x4){0.f, 0.f, 0.f, 0.f};
    bf16x8 At[4][2], B0[2][2], B1[2][2];
    const char* cA = (const char*)g.A + (size_t)cur.pm * tstep; const char* cB = (const char*)g.Bt + (size_t)cur.pn * tstep;
    S.a_ready(cur);
    if constexpr (SP2) {
        PG8_STAGE(PG8_SB(0, 0), cB, voffB); PG8_STAGE(PG8_SB(0, 1), cB + hstep, voffB); PG8_STAGE(PG8_SA(0, 0), cA, voffA); PG8_STAGE(PG8_SA(0, 1), cA + hstep, voffA);
        if (wr == 1) PG8_BAR;
        PG8_WAIT_V(2); PG8_BAR;
        PG8_STAGE(PG8_SB(1, 0), cB + kstep, voffB); PG8_STAGE(PG8_SA(1, 0), cA + kstep, voffA); PG8_STAGE(PG8_SB(1, 1), cB + hstep + kstep, voffB);
        PG8_WAIT_V(6); PG8_BAR;
    } else {
        PG8_STAGE(PG8_SB(0, 0), cB, voffB); PG8_STAGE(PG8_SA(0, 0), cA, voffA); PG8_STAGE(PG8_SB(0, 1), cB + hstep, voffB); PG8_STAGE(PG8_SA(0, 1), cA + hstep, voffA);
        if (wr == 1) PG8_BAR;
        PG8_WAIT_V(4); PG8_BAR;
        PG8_STAGE(PG8_SB(1, 0), cB + kstep, voffB); PG8_STAGE(PG8_SA(1, 0), cA + kstep, voffA); PG8_STAGE(PG8_SB(1, 1), cB + hstep + kstep, voffB);
        PG8_WAIT_V(6); PG8_BAR;
    }
    for (;;) {
        const bool has_next = S.next(ui + 1, nxt);
        const char* nA = has_next ? (const char*)g.A + (size_t)nxt.pm * tstep : cA; const char* nB = has_next ? (const char*)g.Bt + (size_t)nxt.pn * tstep : cB;
        for (int t = 0; t < nt; t += 2) {
            const bool last = (t == nt - 2);
            const char* a1 = cA + (size_t)(t + 1) * kstep;
            const char* a2 = last ? nA : cA + (size_t)(t + 2) * kstep; const char* b2 = last ? nB : cB + (size_t)(t + 2) * kstep;
            const char* a3 = a2 + kstep; const char* b3 = b2 + kstep;
            if (last && has_next) S.a_ready(nxt);
            if constexpr (SP2) {
            PG8_LDB(B0, 0, 0); PG8_LDB(B1, 0, 1); PG8_SCHED; PG8_LDA(At, 0, 0); PG8_STAGE(PG8_SA(1, 1), a1 + hstep, voffA);
            PG8_WAIT_V(8); PG8_WAIT_L(0); PG8_BAR; PG8_MMA(0, 0, At, B0); PG8_MMA(0, 1, At, B1); PG8_BAR; PG8_SCHED;
            PG8_LDA(At, 0, 1); PG8_STAGE(PG8_SB(0, 0), b2, voffB); PG8_STAGE(PG8_SB(0, 1), b2 + hstep, voffB); PG8_STAGE(PG8_SA(0, 0), a2, voffA);
            PG8_WAIT_V(8); PG8_WAIT_L(0); PG8_BAR; PG8_MMA(1, 0, At, B0); PG8_MMA(1, 1, At, B1); PG8_BAR; PG8_SCHED;
            PG8_LDB(B0, 1, 0); PG8_LDB(B1, 1, 1); PG8_SCHED; PG8_LDA(At, 1, 0); PG8_STAGE(PG8_SA(0, 1), a2 + hstep, voffA);
            PG8_WAIT_V(8); PG8_WAIT_L(0); PG8_BAR; PG8_MMA(0, 0, At, B0); PG8_MMA(0, 1, At, B1); PG8_BAR; PG8_SCHED;
            PG8_LDA(At, 1, 1); PG8_STAGE(PG8_SB(1, 0), b3, voffB); PG8_STAGE(PG8_SB(1, 1), b3 + hstep, voffB); PG8_STAGE(PG8_SA(1, 0), a3, voffA);
            PG8_WAIT_V(8); PG8_WAIT_L(0); PG8_BAR; PG8_MMA(1, 0, At, B0); PG8_MMA(1, 1, At, B1); PG8_BAR; PG8_SCHED;
            } else {
            PG8_LDB(B0, 0, 0); PG8_SCHED; PG8_LDA(At, 0, 0); PG8_STAGE(PG8_SA(1, 1), a1 + hstep, voffA);
            PG8_WAIT_L(8); PG8_BAR; PG8_WAIT_L(0); PG8_MMA(0, 0, At, B0); PG8_BAR; PG8_SCHED;
            PG8_LDB(B1, 0, 1); PG8_STAGE(PG8_SB(0, 0), b2, voffB);
            PG8_BAR; PG8_WAIT_L(0); PG8_MMA(0, 1, At, B1); PG8_BAR;
            PG8_LDA(At, 0, 1); PG8_STAGE(PG8_SA(0, 0), a2, voffA);
            PG8_BAR; PG8_WAIT_L(0); PG8_MMA(1, 0, At, B0); PG8_BAR; PG8_SCHED;
            PG8_STAGE(PG8_SB(0, 1), b2 + hstep, voffB);
            PG8_WAIT_V(6); PG8_BAR; PG8_MMA(1, 1, At, B1); PG8_BAR;
            PG8_LDB(B0, 1, 0); PG8_SCHED; PG8_LDA(At, 1, 0); PG8_STAGE(PG8_SA(0, 1), a2 + hstep, voffA);
            PG8_WAIT_L(8); PG8_BAR; PG8_WAIT_L(0); PG8_MMA(0, 0, At, B0); PG8_BAR; PG8_SCHED;
            PG8_LDB(B1, 1, 1); PG8_STAGE(PG8_SB(1, 0), b3, voffB);
            PG8_BAR; PG8_WAIT_L(0); PG8_MMA(0, 1, At, B1); PG8_BAR;
            PG8_LDA(At, 1, 1); PG8_STAGE(PG8_SA(1, 0), a3, voffA);
            PG8_BAR; PG8_WAIT_L(0); PG8_MMA(1, 0, At, B0); PG8_BAR; PG8_SCHED;
            PG8_STAGE(PG8_SB(1, 1), b3 + hstep, voffB);
            PG8_WAIT_V(6); PG8_BAR; PG8_MMA(1, 1, At, B1); PG8_BAR;
            }
        }
        if constexpr (ALIGN_EPI) { if (wr == 0) PG8_BAR; }
        if constexpr (!Epi::AFTER_DRAIN) { E(acc, cur, wr, wc, fr, fq); S.done(cur); }
        if (!has_next) break;
#pragma unroll
        for (int a = 0; a < 2; ++a)
#pragma unroll
            for (int b = 0; b < 2; ++b)
#pragma unroll
                for (int m = 0; m < 4; ++m)
#pragma unroll
                    for (int n = 0; n < 2; ++n) acc[a][b][m][n] = (f32x4){0.f, 0.f, 0.f, 0.f};
        cur = nxt; cA = nA; cB = nB; ++ui;
        if constexpr (ALIGN_EPI) { if (wr == 1) PG8_BAR; }
    }
    PG8_WAIT_V(0);
    if constexpr (!ALIGN_EPI) { if (wr == 0) PG8_BAR; }
    PG8_BAR;
    if constexpr (Epi::AFTER_DRAIN) { E.fused(acc, cur, wr, wc, fr, fq, lds, wid, lane); S.done(cur); }
#undef PG8_SA
#undef PG8_SB
#undef PG8_STAGE
#undef PG8_LDA
#undef PG8_LDB
#undef PG8_MMA
#undef PG8_WAIT_V
#undef PG8_WAIT_L
#undef PG8_BAR
#undef PG8_SCHED
}
}


#define LAS __attribute__((address_space(3)))

__device__ __forceinline__ int op_bid() { int b = (int)blockIdx.x; asm volatile("" : "+s"(b)); return b; }
__device__ __forceinline__ int op_grid() { int g = (int)gridDim.x; asm volatile("" : "+s"(g)); return g; }
__device__ __forceinline__ int phase_tid(int wv) { unsigned m = ~0u; asm volatile("" : "+s"(m)); return wv * 64 + (int)__builtin_amdgcn_mbcnt_hi(m, __builtin_amdgcn_mbcnt_lo(m, 0u)); }
typedef unsigned short bf16_t;
typedef float f32x4 __attribute__((ext_vector_type(4)));
typedef unsigned u32x4 __attribute__((ext_vector_type(4)));
typedef unsigned u32x2 __attribute__((ext_vector_type(2)));

constexpr int BATCH = 8, SEQ = 4096, DM = 1024, T = BATCH * SEQ, DEPTH = 2;
constexpr int NPROJ = 4352, NMOD = 6 * DM;
constexpr int NEXP = 16384, PQ = 2048;
constexpr float NORM_EPS = 1e-6f;
constexpr float LOG2E = 1.4426950408889634f;
constexpr float QSCALE = 0.125f * LOG2E;
constexpr float SB_EXIT = 160.0f;

constexpr size_t MiB = 1u << 20;
constexpr size_t WS_CTL = 0;
constexpr size_t WS_MOD = 1 * MiB;
constexpr size_t WS_ROPE = 2 * MiB;
constexpr size_t WS_WIN = 10 * MiB;
constexpr size_t WS_WBA = 27 * MiB;
constexpr size_t WS_WBB = 29 * MiB;
constexpr size_t WS_WOUT = 31 * MiB;
constexpr size_t WS_WQ = 35 * MiB;
constexpr size_t WS_SK = 43 * MiB;
constexpr size_t WS_UQ = 44 * MiB;
constexpr size_t WS_VQ = 76 * MiB;
constexpr size_t WS_USC = 108 * MiB;
constexpr size_t WS_VSC = 108 * MiB + 256 * 1024;
constexpr size_t WS_HS = 109 * MiB;
constexpr size_t WS_H = 112 * MiB;
constexpr size_t WS_QA = 176 * MiB;
constexpr size_t WS_QB = 208 * MiB;
constexpr size_t WS_KB = 240 * MiB;
constexpr size_t WS_VB = 272 * MiB;
constexpr size_t WS_KA = 304 * MiB;
constexpr size_t WS_VA = 312 * MiB;
constexpr size_t WS_GA = 320 * MiB;
constexpr size_t WS_GB = 384 * MiB;
constexpr size_t WS_END = 448 * MiB;
constexpr size_t WS_H2Q = WS_QA, WS_IDX = WS_KB, WS_GATE = WS_VB, WS_Q2 = WS_GA, WS_COEF = WS_GA;
constexpr int CTL_BAR = 4096;
constexpr int CTL_QUEUE = 1024;

constexpr int LDS_BYTES = 147456;
constexpr int NTHREADS = 512, NWAVES = 8;

struct KArgs {
    const float* x; const float* c; const int* pos; const float* ada_w; const float* ada_b; const float* norm1_g; const float* w_in; const float* sinks;
    const float* wbr_a; const float* wbr_b; const float* w_out; const float* norm2_g; const float* wq; const float* subkeys; const float* pu; const float* pv; const float* final_g;
    float* out; unsigned char* ws; int ph_lo, ph_hi;
};

__device__ __forceinline__ unsigned f2bf(float f) { unsigned u = __float_as_uint(f); return (u + 0x7fffu + ((u >> 16) & 1u)) >> 16; }
__device__ __forceinline__ unsigned pk2(float lo, float hi) { return f2bf(lo) | (f2bf(hi) << 16); }
__device__ __forceinline__ float bflo(unsigned w) { return __uint_as_float(w << 16); }
__device__ __forceinline__ float bfhi(unsigned w) { return __uint_as_float(w & 0xffff0000u); }
template <int M> __device__ __forceinline__ float swz_xor(float v) { return __int_as_float(__builtin_amdgcn_ds_swizzle(__float_as_int(v), (M << 10) | 0x1f)); }
__device__ __forceinline__ float wave_sum(float v) {
    v += swz_xor<1>(v); v += swz_xor<2>(v); v += swz_xor<4>(v); v += swz_xor<8>(v); v += swz_xor<16>(v);
    auto rr = __builtin_amdgcn_permlane32_swap(__float_as_uint(v), __float_as_uint(v), false, false);
    return __uint_as_float(rr[0]) + __uint_as_float(rr[1]);
}
__device__ __forceinline__ float wave_max(float v) {
    v = fmaxf(v, swz_xor<1>(v)); v = fmaxf(v, swz_xor<2>(v)); v = fmaxf(v, swz_xor<4>(v)); v = fmaxf(v, swz_xor<8>(v)); v = fmaxf(v, swz_xor<16>(v));
    auto rr = __builtin_amdgcn_permlane32_swap(__float_as_uint(v), __float_as_uint(v), false, false);
    return fmaxf(__uint_as_float(rr[0]), __uint_as_float(rr[1]));
}
__device__ __forceinline__ int rdlane_i(int v, int l) { return __builtin_amdgcn_readlane(v, __builtin_amdgcn_readfirstlane(l)); }
__device__ __forceinline__ float rdlane_f(float v, int l) { return __int_as_float(__builtin_amdgcn_readlane(__float_as_int(v), __builtin_amdgcn_readfirstlane(l))); }
__device__ __forceinline__ float dot8(u32x4 a, u32x4 b, float acc) {
    acc = fmaf(bflo(a.x), bflo(b.x), acc); acc = fmaf(bfhi(a.x), bfhi(b.x), acc);
    acc = fmaf(bflo(a.y), bflo(b.y), acc); acc = fmaf(bfhi(a.y), bfhi(b.y), acc);
    acc = fmaf(bflo(a.z), bflo(b.z), acc); acc = fmaf(bfhi(a.z), bfhi(b.z), acc);
    acc = fmaf(bflo(a.w), bflo(b.w), acc); acc = fmaf(bfhi(a.w), bfhi(b.w), acc);
    return acc;
}
__device__ __forceinline__ float softplus2(float z2) {
    return fmaxf(z2, 0.f) + __log2f(1.0f + exp2f(-fabsf(z2)));
}

__device__ __forceinline__ int win_pos(int n) {
    if (n >= 640) return n;
    const int hb = n & ~63, d = n & 63;
    return hb + (d < 32 ? 2 * d : 2 * (d - 32) + 1);
}
template <bool WIN>
__device__ __forceinline__ void transpose_item(const float* W, int K, int N, bf16_t* WT, LAS float* scr, int item, int lane) {
    const int nblk = N / 32, kb = item / nblk, nb = item % nblk, k0 = 64 * kb, n0 = 32 * nb;
#pragma unroll 8
    for (int i = 0; i < 32; ++i) { const int kk = 2 * i + (lane >> 5); scr[kk * 33 + (lane & 31)] = W[(size_t)(k0 + kk) * N + n0 + (lane & 31)]; }
    asm volatile("s_waitcnt lgkmcnt(0)" ::: "memory");
    const int c = lane & 7;
#pragma unroll
    for (int j = 0; j < 4; ++j) { const int n = (lane >> 3) + 8 * j; const LAS float* s = scr + (8 * c) * 33 + n;
        u32x4 o; o.x = pk2(s[0 * 33], s[1 * 33]); o.y = pk2(s[2 * 33], s[3 * 33]); o.z = pk2(s[4 * 33], s[5 * 33]); o.w = pk2(s[6 * 33], s[7 * 33]);
        const int row = WIN ? win_pos(n0 + n) : (n0 + n);
        *(u32x4*)(WT + (size_t)row * K + k0 + 8 * c) = o; }
    asm volatile("s_waitcnt lgkmcnt(0)" ::: "memory");
}
template <bool OFFSET128>
__device__ __forceinline__ void quant_row(const f32x4 (&v)[4], unsigned char* dst_row, float* scale_out, int lane) {
    float am = 0.f;
#pragma unroll
    for (int i = 0; i < 4; ++i) am = fmaxf(am, fmaxf(fmaxf(fabsf(v[i].x), fabsf(v[i].y)), fmaxf(fabsf(v[i].z), fabsf(v[i].w))));
    am = wave_max(am);
    const float inv = am > 0.f ? 127.0f / am : 0.f, sc = am > 0.f ? am / 127.0f : 1.0f;
    u32x4 o;
#pragma unroll
    for (int i = 0; i < 4; ++i) {
        int q0 = (int)rintf(v[i].x * inv), q1 = (int)rintf(v[i].y * inv), q2 = (int)rintf(v[i].z * inv), q3 = (int)rintf(v[i].w * inv);
        if (OFFSET128) { q0 += 128; q1 += 128; q2 += 128; q3 += 128; }
        o[i] = (unsigned)(q0 & 0xff) | ((unsigned)(q1 & 0xff) << 8) | ((unsigned)(q2 & 0xff) << 16) | ((unsigned)(q3 & 0xff) << 24);
    }
    *(u32x4*)(dst_row + 16 * lane) = o;
    if (lane == 0) *scale_out = sc;
}

__device__ __forceinline__ void ph_prologue(const KArgs& a, LAS unsigned char* lds, int wv) {
    const int tid = phase_tid(wv), lane = tid & 63, wave = wv, G = op_grid();
    const int gw = op_bid() * NWAVES + wave, NGW = G * NWAVES;
    unsigned char* ws = a.ws;
    {
        LAS float* sc = (LAS float*)lds;
        for (int it = op_bid(); it < DEPTH * 12; it += G) {
            for (int idx = tid; idx < 8192; idx += NTHREADS) { const int b = idx >> 10, i = idx & 1023; const float cv = a.c[b * 1024 + i]; sc[i * 8 + b] = cv / (1.0f + __expf(-cv)); }
            __syncthreads();
            const int l = it / 12, j = (it % 12) * 512 + tid;
            const float* wp = a.ada_w + (size_t)l * 1024 * NMOD + j;
            float acc[8];
#pragma unroll
            for (int b = 0; b < 8; ++b) acc[b] = 0.f;
#pragma unroll 4
            for (int i = 0; i < 1024; ++i) {
                const float w = wp[(size_t)i * NMOD];
                const f32x4 s0 = *(const LAS f32x4*)(sc + i * 8), s1 = *(const LAS f32x4*)(sc + i * 8 + 4);
                acc[0] = fmaf(s0.x, w, acc[0]); acc[1] = fmaf(s0.y, w, acc[1]); acc[2] = fmaf(s0.z, w, acc[2]); acc[3] = fmaf(s0.w, w, acc[3]);
                acc[4] = fmaf(s1.x, w, acc[4]); acc[5] = fmaf(s1.y, w, acc[5]); acc[6] = fmaf(s1.z, w, acc[6]); acc[7] = fmaf(s1.w, w, acc[7]);
            }
            float* mod = (float*)(ws + WS_MOD);
            const float bias = a.ada_b[l * NMOD + j];
#pragma unroll
            for (int b = 0; b < 8; ++b) mod[(size_t)(l * 8 + b) * NMOD + j] = acc[b] + bias;
            __syncthreads();
        }
    }
    {
        LAS float* scr = (LAS float*)(lds + 32768 + wave * 8448);
        constexpr int I_IN = 16 * 136, I_BR = 8 * 32, I_OUT = 16 * 32, I_Q = 16 * 64, I_L = I_IN + 2 * I_BR + I_OUT + I_Q;
        for (int it = gw; it < DEPTH * I_L; it += NGW) {
            const int l = it / I_L; int r = it % I_L;
            if (r < I_IN) { transpose_item<true>(a.w_in + (size_t)l * 1024 * NPROJ, 1024, NPROJ, (bf16_t*)(ws + WS_WIN) + (size_t)l * NPROJ * 1024, scr, r, lane); continue; } r -= I_IN;
            if (r < I_BR) { transpose_item<false>(a.wbr_a + (size_t)l * 512 * 1024, 512, 1024, (bf16_t*)(ws + WS_WBA) + (size_t)l * 1024 * 512, scr, r, lane); continue; } r -= I_BR;
            if (r < I_BR) { transpose_item<false>(a.wbr_b + (size_t)l * 512 * 1024, 512, 1024, (bf16_t*)(ws + WS_WBB) + (size_t)l * 1024 * 512, scr, r, lane); continue; } r -= I_BR;
            if (r < I_OUT) { transpose_item<false>(a.w_out + (size_t)l * 1024 * 1024, 1024, 1024, (bf16_t*)(ws + WS_WOUT) + (size_t)l * 1024 * 1024, scr, r, lane); continue; } r -= I_OUT;
            transpose_item<false>(a.wq + (size_t)l * 1024 * PQ, 1024, PQ, (bf16_t*)(ws + WS_WQ) + (size_t)l * PQ * 1024, scr, r, lane);
        }
    }
    {
        const int gt = op_bid() * NTHREADS + tid, NGT = G * NTHREADS;
        for (int i = gt; i < DEPTH * 8 * 2 * 128 * 128 / 8; i += NGT) {
            const f32x4 v0 = *(const f32x4*)(a.subkeys + (size_t)i * 8), v1 = *(const f32x4*)(a.subkeys + (size_t)i * 8 + 4);
            u32x4 o; o.x = pk2(v0.x, v0.y); o.y = pk2(v0.z, v0.w); o.z = pk2(v1.x, v1.y); o.w = pk2(v1.z, v1.w);
            *(u32x4*)((bf16_t*)(ws + WS_SK) + (size_t)i * 8) = o;
        }
        for (int i = gt; i < T * 32; i += NGT) {
            const int t = i >> 5, f = i & 31;
            double inv = 1.0;
            for (int k = 0; k < f; ++k) inv *= 0.7498942093324559;
            const double ang = (double)a.pos[t] * inv;
            const double kq = rint(ang * 0.63661977236758134308);
            const double r = fma(-kq, 6.123233995736766036e-17, fma(-kq, 1.57079632679489655800, ang));
            const int quad = (int)((long long)kq & 3);
            const double r2 = r * r;
            double sp = -1.0 / 1307674368000.0; sp = fma(sp, r2, 1.0 / 6227020800.0); sp = fma(sp, r2, -1.0 / 39916800.0); sp = fma(sp, r2, 1.0 / 362880.0);
            sp = fma(sp, r2, -1.0 / 5040.0); sp = fma(sp, r2, 1.0 / 120.0); sp = fma(sp, r2, -1.0 / 6.0); sp = fma(sp * r2, r, r);
            double cp = 1.0 / 20922789888000.0; cp = fma(cp, r2, -1.0 / 87178291200.0); cp = fma(cp, r2, 1.0 / 479001600.0); cp = fma(cp, r2, -1.0 / 3628800.0);
            cp = fma(cp, r2, 1.0 / 40320.0); cp = fma(cp, r2, -1.0 / 720.0); cp = fma(cp, r2, 1.0 / 24.0); cp = fma(cp, r2, -0.5); cp = fma(cp, r2, 1.0);
            const double sn = (quad == 0) ? sp : (quad == 1) ? cp : (quad == 2) ? -sp : -cp;
            const double cs = (quad == 0) ? cp : (quad == 1) ? -sp : (quad == 2) ? -cp : sp;
            float* rp = (float*)(ws + WS_ROPE) + (size_t)i * 2; rp[0] = (float)cs; rp[1] = (float)sn;
        }
    }
    for (int r = gw; r < DEPTH * 2 * NEXP; r += NGW) {
        const int tbl = r / (DEPTH * NEXP), lr = r % (DEPTH * NEXP);
        const float* src = (tbl == 0 ? a.pu : a.pv) + (size_t)lr * 1024;
        f32x4 v[4];
        if (tbl == 0) {
#pragma unroll
            for (int i = 0; i < 4; ++i) v[i] = ((const f32x4*)src)[64 * i + lane];
            quant_row<false>(v, ws + WS_UQ + (size_t)lr * 1024, (float*)(ws + WS_USC) + lr, lane);
        } else {
#pragma unroll
            for (int i = 0; i < 4; ++i) v[i] = ((const f32x4*)src)[4 * lane + i];
            const int l = lr / NEXP, e = lr % NEXP;
            quant_row<false>(v, ws + WS_VQ + (size_t)l * NEXP * 1024 + ((size_t)(lane >> 3) * NEXP + e) * 128 + 16 * (lane & 7) - 16 * lane, (float*)(ws + WS_VSC) + lr, lane);
        }
    }
    if (op_bid() == 0) for (int i = tid; i < DEPTH * 2 * 8 * 64; i += NTHREADS) ((unsigned*)(ws + WS_CTL))[CTL_QUEUE + i] = 0u;
}

template <bool WITH_Q8>
__device__ __forceinline__ void ph_norm(const KArgs& a, const float* xin, const float* g, const float* mod_l, int shift_idx, int scale_idx, int wv) {
    const int tid = phase_tid(wv), lane = tid & 63, wave = wv;
    const int gw = op_bid() * NWAVES + wave, NGW = op_grid() * NWAVES;
    bf16_t* H = (bf16_t*)(a.ws + WS_H);
    for (int row = gw; row < T; row += NGW) {
        const int b = row >> 12;
        f32x4 v[4]; float ss = 0.f;
#pragma unroll
        for (int i = 0; i < 4; ++i) { v[i] = ((const f32x4*)(xin + (size_t)row * DM))[64 * i + lane]; ss += (v[i].x * v[i].x + v[i].y * v[i].y) + (v[i].z * v[i].z + v[i].w * v[i].w); }
        ss = wave_sum(ss);
        const float r = 1.0f / sqrtf(ss * (1.0f / DM) + NORM_EPS);
#pragma unroll
        for (int i = 0; i < 4; ++i) {
            const int col = 256 * i + 4 * lane;
            const f32x4 gg = *(const f32x4*)(g + col), sc = *(const f32x4*)(mod_l + (size_t)b * NMOD + scale_idx * DM + col), sh = *(const f32x4*)(mod_l + (size_t)b * NMOD + shift_idx * DM + col);
            v[i] = (v[i] * r) * gg * (sc + 1.0f) + sh;
            u32x2 o; o.x = pk2(v[i].x, v[i].y); o.y = pk2(v[i].z, v[i].w);
            *(u32x2*)(H + (size_t)row * DM + col) = o;
        }
        if (WITH_Q8) quant_row<false>(v, a.ws + WS_H2Q + (size_t)row * 1024, (float*)(a.ws + WS_HS) + row, lane);
    }
}
__device__ __forceinline__ void ph_final_norm(const KArgs& a, int wv) {
    const int tid = phase_tid(wv), lane = tid & 63, wave = wv;
    const int gw = op_bid() * NWAVES + wave, NGW = op_grid() * NWAVES;
    for (int row = gw; row < T; row += NGW) {
        f32x4 v[4]; float ss = 0.f;
#pragma unroll
        for (int i = 0; i < 4; ++i) { v[i] = ((const f32x4*)(a.out + (size_t)row * DM))[64 * i + lane]; ss += (v[i].x * v[i].x + v[i].y * v[i].y) + (v[i].z * v[i].z + v[i].w * v[i].w); }
        ss = wave_sum(ss);
        const float r = 1.0f / sqrtf(ss * (1.0f / DM) + NORM_EPS);
#pragma unroll
        for (int i = 0; i < 4; ++i) { const f32x4 gg = *(const f32x4*)(a.final_g + 256 * i + 4 * lane); ((f32x4*)(a.out + (size_t)row * DM))[64 * i + lane] = (v[i] * r) * gg; }
    }
}

struct EpiProj {
    static constexpr bool PERM = true, AFTER_DRAIN = false;
    unsigned char* ws;
    __device__ __forceinline__ void operator()(const pg8::f32x4 (&acc)[2][2][4][2], const pg8::Unit& u, int wr, int wc, int fr, int fq) const {
        const int row0 = u.pm * 256 + wr * 64 + fr;
        const float* rope = (const float*)(ws + WS_ROPE);
#pragma unroll
        for (int bj = 0; bj < 2; ++bj) {
            const int cgb = u.pn * 256 + bj * 128;
            bf16_t* base; int pitch, cl, mode;
            if (cgb < 512) { base = (bf16_t*)(ws + WS_QA); pitch = 512; cl = cgb; mode = 1; }
            else if (cgb < 640) { base = (bf16_t*)(ws + WS_KA); pitch = 128; cl = cgb - 512; mode = 2; }
            else if (cgb < 768) { base = (bf16_t*)(ws + WS_VA); pitch = 128; cl = cgb - 640; mode = 0; }
            else if (cgb < 1280) { base = (bf16_t*)(ws + WS_QB); pitch = 512; cl = cgb - 768; mode = 3; }
            else if (cgb < 1792) { base = (bf16_t*)(ws + WS_KB); pitch = 512; cl = cgb - 1280; mode = 0; }
            else if (cgb < 2304) { base = (bf16_t*)(ws + WS_VB); pitch = 512; cl = cgb - 1792; mode = 0; }
            else if (cgb < 3328) { base = (bf16_t*)(ws + WS_GA); pitch = 1024; cl = cgb - 2304; mode = 4; }
            else { base = (bf16_t*)(ws + WS_GB); pitch = 1024; cl = cgb - 3328; mode = 4; }
            const int col = cl + wc * 32 + 8 * fq;
#pragma unroll
            for (int ai = 0; ai < 2; ++ai)
#pragma unroll
                for (int m = 0; m < 4; ++m) {
                    const int row = row0 + ai * 128 + m * 16;
                    pg8::f32x4 v0 = acc[ai][bj][m][0], v1 = acc[ai][bj][m][1];
                    if (mode == 1 || mode == 2) {
                        const int i0 = (col & 63) >> 1;
                        const f32x4 c01 = *(const f32x4*)(rope + ((size_t)row * 32 + i0) * 2), c23 = *(const f32x4*)(rope + ((size_t)row * 32 + i0 + 2) * 2);
                        pg8::f32x4 w0, w1;
                        w0[0] = v0[0] * c01.x - v0[1] * c01.y; w0[1] = v0[1] * c01.x + v0[0] * c01.y;
                        w0[2] = v0[2] * c01.z - v0[3] * c01.w; w0[3] = v0[3] * c01.z + v0[2] * c01.w;
                        w1[0] = v1[0] * c23.x - v1[1] * c23.y; w1[1] = v1[1] * c23.x + v1[0] * c23.y;
                        w1[2] = v1[2] * c23.z - v1[3] * c23.w; w1[3] = v1[3] * c23.z + v1[2] * c23.w;
                        v0 = w0; v1 = w1;
                    }
                    if (mode == 1 || mode == 3) { v0 = v0 * QSCALE; v1 = v1 * QSCALE; }
                    if (mode == 4) {
#pragma unroll
                        for (int e = 0; e < 4; ++e) { v0[e] = 1.0f / (1.0f + __expf(-v0[e])); v1[e] = 1.0f / (1.0f + __expf(-v1[e])); }
                    }
                    u32x4 w; w.x = pk2(v0[0], v0[1]); w.y = pk2(v0[2], v0[3]); w.z = pk2(v1[0], v1[1]); w.w = pk2(v1[2], v1[3]);
                    *(u32x4*)(base + (size_t)row * pitch + col) = w;
                }
        }
    }
};
template <bool ADD> struct EpiBranch {
    static constexpr bool PERM = true, AFTER_DRAIN = false;
    const bf16_t* Gt; bf16_t* O;
    __device__ __forceinline__ void operator()(const pg8::f32x4 (&acc)[2][2][4][2], const pg8::Unit& u, int wr, int wc, int fr, int fq) const {
        const int row0 = u.pm * 256 + wr * 64 + fr, col0 = u.pn * 256 + wc * 32 + 8 * fq;
#pragma unroll
        for (int ai = 0; ai < 2; ++ai)
#pragma unroll
            for (int m = 0; m < 4; ++m)
#pragma unroll
                for (int bj = 0; bj < 2; ++bj) {
                    const size_t off = (size_t)(row0 + ai * 128 + m * 16) * DM + col0 + bj * 128;
                    const u32x4 gv = *(const u32x4*)(Gt + off);
                    const pg8::f32x4 v0 = acc[ai][bj][m][0], v1 = acc[ai][bj][m][1];
                    float r[8];
                    r[0] = bflo(gv.x) * v0[0]; r[1] = bfhi(gv.x) * v0[1]; r[2] = bflo(gv.y) * v0[2]; r[3] = bfhi(gv.y) * v0[3];
                    r[4] = bflo(gv.z) * v1[0]; r[5] = bfhi(gv.z) * v1[1]; r[6] = bflo(gv.w) * v1[2]; r[7] = bfhi(gv.w) * v1[3];
                    if (ADD) { const u32x4 ov = *(const u32x4*)(O + off);
                        r[0] += bflo(ov.x); r[1] += bfhi(ov.x); r[2] += bflo(ov.y); r[3] += bfhi(ov.y); r[4] += bflo(ov.z); r[5] += bfhi(ov.z); r[6] += bflo(ov.w); r[7] += bfhi(ov.w); }
                    u32x4 w; w.x = pk2(r[0], r[1]); w.y = pk2(r[2], r[3]); w.z = pk2(r[4], r[5]); w.w = pk2(r[6], r[7]);
                    *(u32x4*)(O + off) = w;
                }
    }
};
struct EpiWout {
    static constexpr bool PERM = false, AFTER_DRAIN = false;
    const float* xold; float* xnew; const float* gate;
    __device__ __forceinline__ void operator()(const pg8::f32x4 (&acc)[2][2][4][2], const pg8::Unit& u, int wr, int wc, int fr, int fq) const {
        const int row0 = u.pm * 256 + wr * 64 + fr, col0 = u.pn * 256 + wc * 32 + 4 * fq, b = u.pm >> 4;
#pragma unroll
        for (int bj = 0; bj < 2; ++bj)
#pragma unroll
            for (int n = 0; n < 2; ++n) {
                const pg8::f32x4 gv = *(const pg8::f32x4*)(gate + (size_t)b * NMOD + col0 + bj * 128 + n * 16);
#pragma unroll
                for (int ai = 0; ai < 2; ++ai)
#pragma unroll
                    for (int m = 0; m < 4; ++m) { const size_t off = (size_t)(row0 + ai * 128 + m * 16) * DM + col0 + bj * 128 + n * 16;
                        const pg8::f32x4 xo = *(const pg8::f32x4*)(xold + off);
                        *(pg8::f32x4*)(xnew + off) = xo + gv * acc[ai][bj][m][n]; }
            }
    }
};
struct EpiPlainBf16 {
    static constexpr bool PERM = true, AFTER_DRAIN = false;
    bf16_t* O; int ldc;
    __device__ __forceinline__ void operator()(const pg8::f32x4 (&acc)[2][2][4][2], const pg8::Unit& u, int wr, int wc, int fr, int fq) const {
        const int row0 = u.pm * 256 + wr * 64 + fr, col0 = u.pn * 256 + wc * 32 + 8 * fq;
#pragma unroll
        for (int ai = 0; ai < 2; ++ai)
#pragma unroll
            for (int m = 0; m < 4; ++m)
#pragma unroll
                for (int bj = 0; bj < 2; ++bj) {
                    const pg8::f32x4 v0 = acc[ai][bj][m][0], v1 = acc[ai][bj][m][1];
                    u32x4 w; w.x = pk2(v0[0], v0[1]); w.y = pk2(v0[2], v0[3]); w.z = pk2(v1[0], v1[1]); w.w = pk2(v1[2], v1[3]);
                    *(u32x4*)(O + (size_t)(row0 + ai * 128 + m * 16) * ldc + col0 + bj * 128) = w;
                }
    }
};

namespace att {
typedef short bf16x8 __attribute__((ext_vector_type(8)));
typedef short s16x4 __attribute__((ext_vector_type(4)));
typedef float f32x16 __attribute__((ext_vector_type(16)));
__device__ __forceinline__ int crow(int r, int hi) { return (r & 3) + 8 * (r >> 2) + 4 * hi; }
typedef float f32x2_t __attribute__((ext_vector_type(2))); typedef __bf16 bf16x2_t __attribute__((ext_vector_type(2)));
__device__ __forceinline__ unsigned cvtpk(float lo, float hi) { f32x2_t v = {lo, hi}; bf16x2_t b = __builtin_convertvector(v, bf16x2_t); return __builtin_bit_cast(unsigned, b); }
#define ATT_SBAR() __builtin_amdgcn_sched_barrier(0)

__device__ __forceinline__ void qkt(f32x16& p0, f32x16& p1, const LAS unsigned char* kslot, const bf16x8 (&qr)[4], int r32, int hi) {
    const LAS unsigned char* kb = kslot + hi * 1024 + r32 * 16;
    p0 = f32x16{}; p1 = f32x16{};
#pragma unroll
    for (int d0 = 0; d0 < 4; ++d0) {
        const bf16x8 b0 = *(const LAS bf16x8*)(kb + d0 * 2048);
        const bf16x8 b1 = *(const LAS bf16x8*)(kb + d0 * 2048 + 512);
        p0 = __builtin_amdgcn_mfma_f32_32x32x16_bf16(b0, qr[d0], p0, 0, 0, 0);
        p1 = __builtin_amdgcn_mfma_f32_32x32x16_bf16(b1, qr[d0], p1, 0, 0, 0);
    }
}
__device__ __forceinline__ void pv(f32x16 (&o)[2], int vb, bf16x8 pa0, bf16x8 pa1, bf16x8 pa2, bf16x8 pa3) {
#pragma unroll
    for (int d0 = 0; d0 < 2; ++d0) {
        s16x4 lo[4], hh[4];
#pragma unroll
        for (int ks = 0; ks < 4; ++ks) {
            asm volatile("ds_read_b64_tr_b16 %0,%1 offset:%c2" : "=&v"(lo[ks]) : "v"(vb), "i"(d0 * 4096 + ks * 1024) : "memory");
            asm volatile("ds_read_b64_tr_b16 %0,%1 offset:%c2" : "=&v"(hh[ks]) : "v"(vb), "i"(d0 * 4096 + ks * 1024 + 512) : "memory");
        }
        asm volatile("s_waitcnt lgkmcnt(0)" ::: "memory"); ATT_SBAR();
#define ATT_PK(k) (bf16x8){lo[k][0], lo[k][1], lo[k][2], lo[k][3], hh[k][0], hh[k][1], hh[k][2], hh[k][3]}
        o[d0] = __builtin_amdgcn_mfma_f32_32x32x16_bf16(pa0, ATT_PK(0), o[d0], 0, 0, 0);
        o[d0] = __builtin_amdgcn_mfma_f32_32x32x16_bf16(pa1, ATT_PK(1), o[d0], 0, 0, 0);
        o[d0] = __builtin_amdgcn_mfma_f32_32x32x16_bf16(pa2, ATT_PK(2), o[d0], 0, 0, 0);
        o[d0] = __builtin_amdgcn_mfma_f32_32x32x16_bf16(pa3, ATT_PK(3), o[d0], 0, 0, 0);
#undef ATT_PK
    }
}
__device__ __forceinline__ void pack_p(const f32x16& p0, const f32x16& p1, bf16x8& pa0, bf16x8& pa1, bf16x8& pa2, bf16x8& pa3) {
    u32x4 w0, w1, w2, w3;
    w0 = (u32x4){cvtpk(p0[0], p0[1]), cvtpk(p0[2], p0[3]), cvtpk(p0[4], p0[5]), cvtpk(p0[6], p0[7])};
    w1 = (u32x4){cvtpk(p0[8], p0[9]), cvtpk(p0[10], p0[11]), cvtpk(p0[12], p0[13]), cvtpk(p0[14], p0[15])};
    w2 = (u32x4){cvtpk(p1[0], p1[1]), cvtpk(p1[2], p1[3]), cvtpk(p1[4], p1[5]), cvtpk(p1[6], p1[7])};
    w3 = (u32x4){cvtpk(p1[8], p1[9]), cvtpk(p1[10], p1[11]), cvtpk(p1[12], p1[13]), cvtpk(p1[14], p1[15])};
    pa0 = __builtin_bit_cast(bf16x8, w0); pa1 = __builtin_bit_cast(bf16x8, w1); pa2 = __builtin_bit_cast(bf16x8, w2); pa3 = __builtin_bit_cast(bf16x8, w3);
}
__device__ __forceinline__ u32x4 tile_gload(const bf16_t* src, int pitch, int tid) { return *(const u32x4*)(src + (size_t)(tid >> 3) * pitch + (tid & 7) * 8); }
__device__ __forceinline__ void tile_kwrite(LAS unsigned char* kslot, u32x4 v, int tid) { *(LAS u32x4*)(kslot + (tid & 7) * 1024 + (tid >> 3) * 16) = v; }
__device__ __forceinline__ void tile_vwrite(LAS unsigned char* vslot, u32x4 v, int tid) { const int c = tid & 7; *(LAS u32x4*)(vslot + (c >> 2) * 4096 + (tid >> 3) * 64 + (c & 3) * 16) = v; }
__device__ __forceinline__ void store_o(const f32x16 (&o)[2], const float (&rs)[16], LAS unsigned char* stage, bf16_t* Ow, int pitch, int lane) {
    asm volatile("" : "+v"(lane));
    const int r32 = lane & 31, hi = lane >> 5;
    LAS bf16_t* stg = (LAS bf16_t*)stage;
#pragma unroll
    for (int r = 0; r < 16; ++r) { const int orow = crow(r, hi);
#pragma unroll
        for (int d0 = 0; d0 < 2; ++d0) stg[orow * 64 + d0 * 32 + r32] = (bf16_t)f2bf(o[d0][r] * rs[r]); }
    asm volatile("s_waitcnt lgkmcnt(0)" ::: "memory");
#pragma unroll
    for (int i = 0; i < 4; ++i) { const int row = i * 8 + (lane >> 3), ch = lane & 7; const u32x4 v = *(const LAS u32x4*)(stg + row * 64 + ch * 8); *(u32x4*)(Ow + (size_t)row * pitch + ch * 8) = v; }
    asm volatile("s_waitcnt lgkmcnt(0)" ::: "memory");
}

constexpr int SB_WLDS = 8192;
template <bool EARLY_EXIT>
__device__ __forceinline__ void sb_phase(const bf16_t* Q, const bf16_t* K, const bf16_t* V, bf16_t* O, LAS unsigned char* lds, int wv) {
    const int tid = phase_tid(wv), lane = tid & 63, r32 = lane & 31, hi = lane >> 5, wid = wv;
    LAS unsigned char* vimg = lds + wid * SB_WLDS;
    const int vb0 = (int)(unsigned)(uintptr_t)vimg + ((lane >> 4) & 1) * 32 + (lane & 3) * 8 + (4 * hi + ((lane & 15) >> 2)) * 64;
    const int vwoff = ((lane & 7) >> 2) * 4096 + (lane >> 3) * 64 + (lane & 3) * 16;
    const float m0 = hi == 0 ? 1.0f : 0.0f;
    const int gw = op_bid() * NWAVES + wid, NGW = op_grid() * NWAVES;
    for (int wu = gw; wu < BATCH * 8 * (SEQ / 32); wu += NGW) {
        const int rb = wu & 127, h = (wu >> 7) & 7, b = wu >> 10;
        const int R0 = rb * 32;
        const size_t rowbase = (size_t)b * SEQ;
        const char* Kb = (const char*)(K + rowbase * 512 + h * 64); const char* Vb = (const char*)(V + rowbase * 512 + h * 64);
        const unsigned koff = (unsigned)(r32 * 1024 + hi * 16), voff = (unsigned)((lane >> 3) * 1024 + (lane & 7) * 16);
        const bf16_t* Qw = Q + (rowbase + R0) * 512 + h * 64;
        bf16x8 qr[4];
#pragma unroll
        for (int d0 = 0; d0 < 4; ++d0) qr[d0] = *(const bf16x8*)((const char*)Qw + koff + d0 * 32);
        int kt = R0 >> 6;
        bf16x8 kf[8]; u32x4 vr[8];
#define SB_LOADK(KT) do { const char* k0_ = Kb + (size_t)(KT) * 65536; const char* k1_ = k0_ + 32768; _Pragma("unroll") for (int d0 = 0; d0 < 4; ++d0) { kf[2 * d0] = *(const bf16x8*)(k0_ + koff + d0 * 32); kf[2 * d0 + 1] = *(const bf16x8*)(k1_ + koff + d0 * 32); } } while (0)
#define SB_LOADV(KT) do { const char* v0_ = Vb + (size_t)(KT) * 65536; _Pragma("unroll") for (int i = 0; i < 8; ++i) vr[i] = *(const u32x4*)(v0_ + i * 8192 + voff); } while (0)
        SB_LOADK(kt); SB_LOADV(kt);
        f32x16 o[2]; o[0] = f32x16{}; o[1] = f32x16{};
        float carry = 0.f;
        for (;;) {
            f32x16 p0 = f32x16{}, p1 = f32x16{};
#pragma unroll
            for (int d0 = 0; d0 < 4; ++d0) { p0 = __builtin_amdgcn_mfma_f32_32x32x16_bf16(kf[2 * d0], qr[d0], p0, 0, 0, 0); p1 = __builtin_amdgcn_mfma_f32_32x32x16_bf16(kf[2 * d0 + 1], qr[d0], p1, 0, 0, 0); }
            const bool more = kt > 0;
#pragma unroll
            for (int i = 0; i < 8; ++i) *(LAS u32x4*)(vimg + vwoff + i * 512) = vr[i];
            const int D = R0 - 64 * kt;
            if (D < 64) {
                const int thr = D + r32 - 4 * hi;
#pragma unroll
                for (int r = 0; r < 16; ++r) { const int cr = (r & 3) + 8 * (r >> 2); if (cr >= thr) p0[r] = -INFINITY; if (cr + 32 >= thr) p1[r] = -INFINITY; }
            }
            float tt[8], uu[8];
#define SB_SP(x) (fmaxf(x, 0.f) + __builtin_amdgcn_logf(1.0f + __builtin_amdgcn_exp2f(-fabsf(x))))
#pragma unroll
            for (int i = 0; i < 4; ++i) {
                float s3 = SB_SP(p0[4 * i + 3]), s2 = s3 + SB_SP(p0[4 * i + 2]), s1 = s2 + SB_SP(p0[4 * i + 1]), s0 = s1 + SB_SP(p0[4 * i]);
                p0[4 * i + 3] -= s3; p0[4 * i + 2] -= s2; p0[4 * i + 1] -= s1; p0[4 * i] -= s0; tt[i] = s0;
                s3 = SB_SP(p1[4 * i + 3]); s2 = s3 + SB_SP(p1[4 * i + 2]); s1 = s2 + SB_SP(p1[4 * i + 1]); s0 = s1 + SB_SP(p1[4 * i]);
                p1[4 * i + 3] -= s3; p1[4 * i + 2] -= s2; p1[4 * i + 1] -= s1; p1[4 * i] -= s0; tt[4 + i] = s0;
                __builtin_amdgcn_sched_barrier(0);
            }
#undef SB_SP
#pragma unroll
            for (int k = 0; k < 8; ++k) { auto rr = __builtin_amdgcn_permlane32_swap(__float_as_uint(tt[k]), __float_as_uint(tt[k]), false, false); uu[k] = __uint_as_float(hi ? rr[0] : rr[1]); }
            float sw = 0.f;
#pragma unroll
            for (int k = 7; k >= 0; --k) {
                const float bs = carry - (sw + m0 * uu[k]); sw += tt[k] + uu[k];
                if (k < 4) { p0[4 * k] = __builtin_amdgcn_exp2f(p0[4 * k] + bs); p0[4 * k + 1] = __builtin_amdgcn_exp2f(p0[4 * k + 1] + bs); p0[4 * k + 2] = __builtin_amdgcn_exp2f(p0[4 * k + 2] + bs); p0[4 * k + 3] = __builtin_amdgcn_exp2f(p0[4 * k + 3] + bs); }
                else { const int i = k - 4; p1[4 * i] = __builtin_amdgcn_exp2f(p1[4 * i] + bs); p1[4 * i + 1] = __builtin_amdgcn_exp2f(p1[4 * i + 1] + bs); p1[4 * i + 2] = __builtin_amdgcn_exp2f(p1[4 * i + 2] + bs); p1[4 * i + 3] = __builtin_amdgcn_exp2f(p1[4 * i + 3] + bs); }
            }
            carry -= sw;
            bf16x8 pa0, pa1, pa2, pa3; pack_p(p0, p1, pa0, pa1, pa2, pa3);
            if (more) { SB_LOADK(kt - 1); SB_LOADV(kt - 1); }
            pv(o, vb0, pa0, pa1, pa2, pa3);
            if (!more) break;
            if (EARLY_EXIT && __all(carry < -SB_EXIT)) break;
            --kt;
        }
        float ones[16];
#pragma unroll
        for (int r = 0; r < 16; ++r) ones[r] = 1.0f;
        store_o(o, ones, vimg, O + (rowbase + R0) * 512 + h * 64, 512, phase_tid(wv) & 63);
    }
#undef SB_LOADK
#undef SB_LOADV
}

constexpr int SW_K0 = 0, SW_V0 = 24576, SW_STAGE = 49152, SW_WSF = 81920, SW_LDS_END = 81920 + 2048;
__device__ __forceinline__ void swa_phase(const bf16_t* Q, const bf16_t* K, const bf16_t* V, bf16_t* O, const float* sinks, LAS unsigned char* lds, int wv) {
        const int tid = phase_tid(wv), lane = tid & 63, r32 = lane & 31, hi = lane >> 5, wid = wv;
    const int vb0 = (int)(unsigned)(uintptr_t)(lds + SW_V0) + ((lane >> 4) & 1) * 32 + (lane & 3) * 8 + (4 * hi + ((lane & 15) >> 2)) * 64;
    LAS float* wsf = (LAS float*)(lds + SW_WSF) + wid * 64;
    const int g = wid >> 1, j = wid & 1;
    for (int unit = op_bid(); unit < BATCH * 2 * 64; unit += op_grid()) {
        const int qb = unit & 63, kvh = (unit >> 6) & 1, b = unit >> 7;
        const int q0 = qb * 64, hq = kvh * 4 + g;
        const size_t rowbase = (size_t)b * SEQ;
        const bf16_t* Kh = K + rowbase * 128 + kvh * 64; const bf16_t* Vh = V + rowbase * 128 + kvh * 64;
        const bf16_t* Qw = Q + (rowbase + q0 + j * 32) * 512 + hq * 64;
        __syncthreads();
#pragma unroll
        for (int i = 0; i < 3; ++i) { const int kt = qb - 2 + i;
            if (kt >= 0) { const u32x4 kv = tile_gload(Kh + (size_t)kt * 64 * 128, 128, tid), vv = tile_gload(Vh + (size_t)kt * 64 * 128, 128, tid);
                tile_kwrite(lds + SW_K0 + i * 8192, kv, tid); tile_vwrite(lds + SW_V0 + i * 8192, vv, tid); } }
        bf16x8 qr[4];
#pragma unroll
        for (int d0 = 0; d0 < 4; ++d0) qr[d0] = *(const bf16x8*)(Qw + (size_t)r32 * 512 + d0 * 16 + hi * 8);
        __syncthreads();
        const int qrel4 = 32 * j + r32 - 4 * hi;
        const float sink2 = sinks[hq] * LOG2E;
        float m = sink2;
#pragma unroll
        for (int i = 0; i < 3; ++i) {
            if (qb - 2 + i >= 0) {
                f32x16 p0, p1;
                qkt(p0, p1, lds + SW_K0 + i * 8192, qr, r32, hi);
#pragma unroll
                for (int r = 0; r < 16; ++r) { const int kv = (r & 3) + 8 * (r >> 2);
                    bool v0 = true, v1 = true;
                    if (i == 2) { v0 = kv <= qrel4; v1 = kv + 32 <= qrel4; }
                    if (i == 0) { v0 = kv > qrel4; v1 = kv + 32 > qrel4; }
                    m = fmaxf(m, fmaxf(v0 ? p0[r] : -INFINITY, v1 ? p1[r] : -INFINITY)); }
            }
        }
        { auto rr = __builtin_amdgcn_permlane32_swap(__float_as_uint(m), __float_as_uint(m), false, false); m = fmaxf(__uint_as_float(rr[0]), __uint_as_float(rr[1])); }
        float lsum = 0.f;
        f32x16 o[2]; o[0] = f32x16{}; o[1] = f32x16{};
#pragma unroll
        for (int i = 0; i < 3; ++i) {
            if (qb - 2 + i >= 0) {
                f32x16 p0, p1;
                qkt(p0, p1, lds + SW_K0 + i * 8192, qr, r32, hi);
#pragma unroll
                for (int r = 0; r < 16; ++r) { const int kv = (r & 3) + 8 * (r >> 2);
                    bool v0 = true, v1 = true;
                    if (i == 2) { v0 = kv <= qrel4; v1 = kv + 32 <= qrel4; }
                    if (i == 0) { v0 = kv > qrel4; v1 = kv + 32 > qrel4; }
                    p0[r] = v0 ? exp2f(p0[r] - m) : 0.f; p1[r] = v1 ? exp2f(p1[r] - m) : 0.f; lsum += p0[r] + p1[r]; }
                bf16x8 pa0, pa1, pa2, pa3; pack_p(p0, p1, pa0, pa1, pa2, pa3); pv(o, vb0 + i * 8192, pa0, pa1, pa2, pa3);
            }
        }
        { auto rr = __builtin_amdgcn_permlane32_swap(__float_as_uint(lsum), __float_as_uint(lsum), false, false); lsum = __uint_as_float(rr[0]) + __uint_as_float(rr[1]); }
        lsum += exp2f(sink2 - m);
        if (hi == 0) wsf[r32] = 1.0f / lsum;
        asm volatile("s_waitcnt lgkmcnt(0)" ::: "memory");
        float rs[16];
#pragma unroll
        for (int r = 0; r < 16; ++r) rs[r] = wsf[crow(r, hi)];
        asm volatile("s_waitcnt lgkmcnt(0)" ::: "memory");
        store_o(o, rs, lds + SW_STAGE + wid * 4096, O + (rowbase + q0 + j * 32) * 512 + hq * 64, 512, lane);
    }
}
#undef ATT_SBAR
}

namespace tk {
typedef short bf16x8 __attribute__((ext_vector_type(8)));
typedef float f32x16 __attribute__((ext_vector_type(16)));
__device__ __forceinline__ float vmax(float a, float b) { float r; asm("v_max_f32 %0, %1, %2" : "=v"(r) : "v"(a), "v"(b)); return r; }
__device__ __forceinline__ float vmin(float a, float b) { float r; asm("v_min_f32 %0, %1, %2" : "=v"(r) : "v"(a), "v"(b)); return r; }
#define TK_CE(a, b) { const float t_ = vmax(a, b); b = vmin(a, b); a = t_; }
__device__ __forceinline__ void sort16(float (&v)[16]) {
    TK_CE(v[0], v[1]) TK_CE(v[2], v[3]) TK_CE(v[0], v[2]) TK_CE(v[1], v[3]) TK_CE(v[1], v[2]) TK_CE(v[4], v[5]) TK_CE(v[6], v[7]) TK_CE(v[4], v[6])
    TK_CE(v[5], v[7]) TK_CE(v[5], v[6]) TK_CE(v[0], v[4]) TK_CE(v[2], v[6]) TK_CE(v[2], v[4]) TK_CE(v[1], v[5]) TK_CE(v[3], v[7]) TK_CE(v[3], v[5])
    TK_CE(v[1], v[2]) TK_CE(v[3], v[4]) TK_CE(v[5], v[6]) TK_CE(v[8], v[9]) TK_CE(v[10], v[11]) TK_CE(v[8], v[10]) TK_CE(v[9], v[11]) TK_CE(v[9], v[10])
    TK_CE(v[12], v[13]) TK_CE(v[14], v[15]) TK_CE(v[12], v[14]) TK_CE(v[13], v[15]) TK_CE(v[13], v[14]) TK_CE(v[8], v[12]) TK_CE(v[10], v[14]) TK_CE(v[10], v[12])
    TK_CE(v[9], v[13]) TK_CE(v[11], v[15]) TK_CE(v[11], v[13]) TK_CE(v[9], v[10]) TK_CE(v[11], v[12]) TK_CE(v[13], v[14]) TK_CE(v[0], v[8]) TK_CE(v[4], v[12])
    TK_CE(v[4], v[8]) TK_CE(v[2], v[10]) TK_CE(v[6], v[14]) TK_CE(v[6], v[10]) TK_CE(v[2], v[4]) TK_CE(v[6], v[8]) TK_CE(v[10], v[12]) TK_CE(v[1], v[9])
    TK_CE(v[5], v[13]) TK_CE(v[5], v[9]) TK_CE(v[3], v[11]) TK_CE(v[7], v[15]) TK_CE(v[7], v[11]) TK_CE(v[3], v[5]) TK_CE(v[7], v[9]) TK_CE(v[11], v[13])
    TK_CE(v[1], v[2]) TK_CE(v[3], v[4]) TK_CE(v[5], v[6]) TK_CE(v[7], v[8]) TK_CE(v[9], v[10]) TK_CE(v[11], v[12]) TK_CE(v[13], v[14])
}
__device__ __forceinline__ void bmerge16(float (&v)[16]) {
    TK_CE(v[0], v[8]) TK_CE(v[1], v[9]) TK_CE(v[2], v[10]) TK_CE(v[3], v[11]) TK_CE(v[4], v[12]) TK_CE(v[5], v[13]) TK_CE(v[6], v[14]) TK_CE(v[7], v[15])
    TK_CE(v[0], v[4]) TK_CE(v[1], v[5]) TK_CE(v[2], v[6]) TK_CE(v[3], v[7]) TK_CE(v[8], v[12]) TK_CE(v[9], v[13]) TK_CE(v[10], v[14]) TK_CE(v[11], v[15])
    TK_CE(v[0], v[2]) TK_CE(v[1], v[3]) TK_CE(v[4], v[6]) TK_CE(v[5], v[7]) TK_CE(v[8], v[10]) TK_CE(v[9], v[11]) TK_CE(v[12], v[14]) TK_CE(v[13], v[15])
    TK_CE(v[0], v[1]) TK_CE(v[2], v[3]) TK_CE(v[4], v[5]) TK_CE(v[6], v[7]) TK_CE(v[8], v[9]) TK_CE(v[10], v[11]) TK_CE(v[12], v[13]) TK_CE(v[14], v[15])
}

__device__ __forceinline__ void merge_top16(float (&a)[16], const float (&b)[16]) {
#pragma unroll
    for (int i = 0; i < 16; ++i) a[i] = vmax(a[i], b[15 - i]);
    bmerge16(a);
}
__device__ __forceinline__ float partner_f(float v, int hi) { auto rr = __builtin_amdgcn_permlane32_swap(__float_as_uint(v), __float_as_uint(v), false, false); return __uint_as_float(hi ? rr[0] : rr[1]); }
__device__ __forceinline__ void merge_partner(float (&a)[16], int hi) {
    float pp[16];
#pragma unroll
    for (int i = 0; i < 16; ++i) pp[i] = partner_f(a[i], hi);
    merge_top16(a, pp);
}
__device__ __forceinline__ void take_block(float (&v)[16], const f32x16& acc, int blk, unsigned hi4) {
#pragma unroll
    for (int r = 0; r < 16; ++r) { const unsigned code = 127u - (unsigned)(32 * blk + (r & 3) + 8 * (r >> 2)); v[r] = __uint_as_float(((__float_as_uint(acc[r]) & 0xFFFFFF80u) | code) ^ hi4); }
    sort16(v);
}
constexpr int TK_SK = 0, TK_IDX = 65536, TK_LDS_END = 65536 + 8192;
constexpr float TK_NEG = -3.4028234663852886e38f;
template <int P>
__device__ __forceinline__ void half_top16(float (&L)[16], const bf16_t* qrow, LAS unsigned char* lds, LAS unsigned char* idxslot, int r32, int hi) {
    bf16x8 qf[8];
#pragma unroll
    for (int ks = 0; ks < 8; ++ks) qf[ks] = *(const bf16x8*)(qrow + P * 128 + 16 * ks + 8 * hi);
    f32x16 acc[4];
#pragma unroll
    for (int blk = 0; blk < 4; ++blk) acc[blk] = f32x16{};
    const LAS unsigned char* ab = lds + TK_SK + P * 32768 + hi * 2048 + r32 * 16;
#pragma unroll
    for (int ks = 0; ks < 8; ++ks)
#pragma unroll
        for (int blk = 0; blk < 4; ++blk) {
            const bf16x8 af = *(const LAS bf16x8*)(ab + ks * 4096 + blk * 512);
            acc[blk] = __builtin_amdgcn_mfma_f32_32x32x16_bf16(af, qf[ks], acc[blk], 0, 0, 0);
        }
    const unsigned hi4 = (unsigned)hi << 2;
    float M[16];
    take_block(L, acc[0], 0, hi4); take_block(M, acc[1], 1, hi4); merge_top16(L, M);
    { float N[16]; take_block(M, acc[2], 2, hi4); take_block(N, acc[3], 3, hi4); merge_top16(M, N); }
    merge_top16(L, M);
    merge_partner(L, hi);
    if (hi == 0) {
        u32x4 w;
#pragma unroll
        for (int q = 0; q < 4; ++q) w[q] = (__float_as_uint(L[4 * q]) & 127u) | ((__float_as_uint(L[4 * q + 1]) & 127u) << 8) | ((__float_as_uint(L[4 * q + 2]) & 127u) << 16) | ((__float_as_uint(L[4 * q + 3]) & 127u) << 24);
        *(LAS u32x4*)(idxslot + P * 16) = w;
    }
}
__device__ __forceinline__ float cand(float x, float y, unsigned code, unsigned hi8) { return __uint_as_float((__float_as_uint(x + y) & 0xFFFFFE00u) | code | hi8); }

__device__ __forceinline__ void topk_phase(const bf16_t* Q2, const bf16_t* SKl, int* IDX, float* GATE, LAS unsigned char* lds, int wv) {
        const int tid = phase_tid(wv), lane = tid & 63, r32 = lane & 31, hi = lane >> 5, wid = wv;
    LAS unsigned char* idxslot = lds + TK_IDX + wid * 1024 + r32 * 32;
    int cur_h = -1;
    for (int unit = op_bid(); unit < 8 * (T / 256); unit += op_grid()) {
        const int h = unit & 7, tb = unit >> 3;
        if (h != cur_h) {
            __syncthreads();
#pragma unroll
            for (int i = 0; i < 8; ++i) { const int id = tid + 512 * i, c = id & 15, n = (id >> 4) & 127, p = id >> 11;
                const u32x4 v = *(const u32x4*)(SKl + ((size_t)(h * 2 + p) * 128 + n) * 128 + c * 8);
                *(LAS u32x4*)(lds + TK_SK + p * 32768 + c * 2048 + n * 16) = v; }
            __syncthreads();
            cur_h = h;
        }
        const size_t token = (size_t)tb * 256 + wid * 32 + r32;
        const bf16_t* qrow = Q2 + token * PQ + h * 256;
        float a[16], b[16];
        half_top16<0>(a, qrow, lds, idxslot, r32, hi);
        half_top16<1>(b, qrow, lds, idxslot, r32, hi);
        float x[16], y[16];
#pragma unroll
        for (int i = 0; i < 16; ++i) { float av = a[i], bv = b[i]; asm volatile("" : "+v"(av), "+v"(bv)); x[i] = hi ? bv : av; y[i] = hi ? av : bv; }
        const unsigned hi8 = (unsigned)hi << 8;
        float A[16], B[16];
#pragma unroll
        for (int j = 1; j < 16; ++j) A[j - 1] = cand(x[0], y[j], (unsigned)j, hi8);
        A[15] = TK_NEG;
#pragma unroll
        for (int j = 2; j < 8; ++j) B[j - 2] = cand(x[1], y[j], (unsigned)(16 + j), hi8);
        B[6] = cand(x[2], y[3], 2u * 16u + 3u, hi8); B[7] = cand(x[2], y[4], 2u * 16u + 4u, hi8);
#pragma unroll
        for (int i = 0; i < 4; ++i) { const float d = cand(x[i], y[i], (unsigned)(17 * i), hi8); B[8 + i] = hi ? TK_NEG : d; }
        B[12] = TK_NEG; B[13] = TK_NEG; B[14] = TK_NEG; B[15] = TK_NEG;
        sort16(B);
        merge_top16(A, B);
        merge_partner(A, hi);
        const float smax = A[0];
        float ex[8]; int eidx[8]; float lsum = 0.f;
        asm volatile("s_waitcnt lgkmcnt(0)" ::: "memory");
#pragma unroll
        for (int k = 0; k < 8; ++k) {
            float s_lo = A[k], s_hi = A[8 + k]; asm volatile("" : "+v"(s_lo), "+v"(s_hi)); const float s = hi ? s_hi : s_lo;
            ex[k] = __expf(s - smax); lsum += ex[k];
            const unsigned code = __float_as_uint(s) & 0x1FFu, src = code >> 8, ci = (code >> 4) & 15u, cj = code & 15u;
            const unsigned ai = src ? cj : ci, bi = src ? ci : cj;
            const unsigned ca = idxslot[ai], cb = idxslot[16 + bi];
            eidx[k] = (int)(((ca ^ 127u) << 7) | (cb ^ 127u));
        }
        const float tot = lsum + partner_f(lsum, hi);
        const float inv = 1.0f / tot;
        int* ip = IDX + token * 128 + h * 16 + 8 * hi; float* gp = GATE + token * 128 + h * 16 + 8 * hi;
        *(u32x4*)ip = (u32x4){(unsigned)eidx[0], (unsigned)eidx[1], (unsigned)eidx[2], (unsigned)eidx[3]};
        *(u32x4*)(ip + 4) = (u32x4){(unsigned)eidx[4], (unsigned)eidx[5], (unsigned)eidx[6], (unsigned)eidx[7]};
        *(f32x4*)gp = (f32x4){ex[0] * inv, ex[1] * inv, ex[2] * inv, ex[3] * inv};
        *(f32x4*)(gp + 4) = (f32x4){ex[4] * inv, ex[5] * inv, ex[6] * inv, ex[7] * inv};
        asm volatile("s_waitcnt lgkmcnt(0)" ::: "memory");
    }
}
}

namespace peer3 {
__device__ __forceinline__ unsigned xcc_id() { return (unsigned)__builtin_amdgcn_s_getreg((3 << 11) | 20) & 7u; }
constexpr int UNIT = 16, NUNIT = T / UNIT;
template <int CTRL> __device__ __forceinline__ int dpp_i(int v) { return __builtin_amdgcn_update_dpp(0, v, CTRL, 0xF, 0xF, true); }
__device__ __forceinline__ int rowsum16(int v) { v += dpp_i<0xB1>(v); v += dpp_i<0x4E>(v); v += dpp_i<0x141>(v); v += dpp_i<0x140>(v); return v; }
__device__ __forceinline__ float gelu_as(float v) {
    const float av = fabsf(v), t = __builtin_amdgcn_rcpf(fmaf(av, 0.2316418882f, 1.0f));
    float q = fmaf(t, 0.5307027145f, -0.7265760135f); q = fmaf(q, t, 0.7107068705f); q = fmaf(q, t, -0.142248368f); q = fmaf(q, t, 0.127414796f); q = q * t;
    const float e = __builtin_amdgcn_exp2f(v * v * -0.72134752044f), m = v * (q * e);
    return v < 0.f ? m : v - m;
}
__device__ __forceinline__ unsigned take_async(unsigned* p, int lane) { unsigned v = 0u; if (lane == 0) v = __hip_atomic_fetch_add(p, 1u, __ATOMIC_RELAXED, __HIP_MEMORY_SCOPE_AGENT); return v; }

constexpr int UST = 6;
__device__ __forceinline__ void u_unit(const KArgs& a, int l, unsigned s, unsigned unit, LAS unsigned char* wlds, int lane) {
    const unsigned char* UQ = a.ws + WS_UQ + (size_t)l * NEXP * 1024;
    const float* USC = (const float*)(a.ws + WS_USC) + l * NEXP; const float* VSC = (const float*)(a.ws + WS_VSC) + l * NEXP;
    const int* IDX = (const int*)(a.ws + WS_IDX); const float* GATE = (const float*)(a.ws + WS_GATE);
    const unsigned char* HQ = a.ws + WS_H2Q; const float* HS = (const float*)(a.ws + WS_HS);
    float* COEF = (float*)(a.ws + WS_COEF);
    LAS int* lst = (LAS int*)wlds; LAS float* res = (LAS float*)(wlds + 512);
    const int q = lane >> 4, r = lane & 15;
    const size_t t0 = (size_t)unit * UNIT;
    int idx0 = IDX[t0 * 128 + lane], idx1 = IDX[t0 * 128 + 64 + lane];
    float g0 = GATE[t0 * 128 + lane], g1 = GATE[t0 * 128 + 64 + lane], sh = HS[t0];
    u32x4 hv[4];
#pragma unroll
    for (int k = 0; k < 4; ++k) hv[k] = *(const u32x4*)(HQ + t0 * 1024 + 256 * k + 16 * r);
#pragma unroll 1
    for (int i = 0; i < UNIT; ++i) {
        const size_t t = t0 + i, tn = t0 + (i + 1 < UNIT ? i + 1 : i);
        const float us0 = USC[idx0], us1 = USC[idx1], vs0 = VSC[idx0], vs1 = VSC[idx1];
        const int nidx0 = IDX[tn * 128 + lane], nidx1 = IDX[tn * 128 + 64 + lane];
        const float ng0 = GATE[tn * 128 + lane], ng1 = GATE[tn * 128 + 64 + lane], nsh = HS[tn];
        const bool in0 = (unsigned)(idx0 >> 11) == s, in1 = (unsigned)(idx1 >> 11) == s;
        const unsigned long long m0 = __ballot(in0), m1 = __ballot(in1);
        const int c0 = __builtin_popcountll(m0), n = c0 + __builtin_popcountll(m1);
        const int rank0 = (int)__builtin_amdgcn_mbcnt_hi((unsigned)(m0 >> 32), __builtin_amdgcn_mbcnt_lo((unsigned)m0, 0u));
        const int rank1 = c0 + (int)__builtin_amdgcn_mbcnt_hi((unsigned)(m1 >> 32), __builtin_amdgcn_mbcnt_lo((unsigned)m1, 0u));
        if (in0) lst[rank0] = idx0;
        if (in1) lst[rank1] = idx1;
#pragma unroll 1
        for (int base = 0; base < n; base += 4 * UST) {
            const int nst = (n - base + 3) >> 2;
            u32x4 uv[UST][4];
#pragma unroll
            for (int st = 0; st < UST; ++st) {
                if (st < nst) {
                    int slot = base + 4 * st + q; slot = slot < n ? slot : n - 1;
                    const unsigned char* rp = UQ + (size_t)lst[slot] * 1024 + 16 * r;
#pragma unroll
                    for (int k = 0; k < 4; ++k) uv[st][k] = *(const u32x4*)(rp + 256 * k);
                }
            }
#pragma unroll
            for (int st = 0; st < UST; ++st) {
                if (st < nst) {
                    int s0_ = 0, s1_ = 0, s2_ = 0, s3_ = 0;
#pragma unroll
                    for (int k = 0; k < 4; ++k) {
                        s0_ = __builtin_amdgcn_sdot4((int)uv[st][k].x, (int)hv[k].x, s0_, false); s1_ = __builtin_amdgcn_sdot4((int)uv[st][k].y, (int)hv[k].y, s1_, false);
                        s2_ = __builtin_amdgcn_sdot4((int)uv[st][k].z, (int)hv[k].z, s2_, false); s3_ = __builtin_amdgcn_sdot4((int)uv[st][k].w, (int)hv[k].w, s3_, false);
                    }
                    const int tot = rowsum16((s0_ + s1_) + (s2_ + s3_));
                    if (r == 0) res[base + 4 * st + q] = (float)tot;
                }
            }
        }
        const float d0 = in0 ? res[rank0] : 0.f, d1 = in1 ? res[rank1] : 0.f;
        u32x4 nhv[4];
#pragma unroll
        for (int k = 0; k < 4; ++k) nhv[k] = *(const u32x4*)(HQ + tn * 1024 + 256 * k + 16 * r);
        if (in0) COEF[t * 128 + lane] = gelu_as(d0 * us0 * sh) * g0 * vs0;
        if (in1) COEF[t * 128 + 64 + lane] = gelu_as(d1 * us1 * sh) * g1 * vs1;
        idx0 = nidx0; idx1 = nidx1; g0 = ng0; g1 = ng1; sh = nsh;
#pragma unroll
        for (int k = 0; k < 4; ++k) hv[k] = nhv[k];
    }
}
struct VMeta { u32x4 iv[4]; f32x4 cv[4]; };
__device__ __forceinline__ void v_meta(VMeta& m, const int* IDX, const float* COEF, size_t t, int g) {
#pragma unroll
    for (int q = 0; q < 4; ++q) { m.iv[q] = *(const u32x4*)(IDX + t * 128 + 16 * g + 4 * q); m.cv[q] = *(const f32x4*)(COEF + t * 128 + 16 * g + 4 * q); }
}
__device__ __forceinline__ void v_stage(u32x4 (&P)[16], u32x4& CQ, float& cs, const VMeta& m, const unsigned char* VS) {
    float cm = 0.f;
#pragma unroll
    for (int j = 0; j < 16; ++j) cm = fmaxf(cm, fabsf(m.cv[j >> 2][j & 3]));
    cm = fmaxf(cm, swz_xor<8>(cm)); cm = fmaxf(cm, swz_xor<16>(cm));
    { auto rr = __builtin_amdgcn_permlane32_swap(__float_as_uint(cm), __float_as_uint(cm), false, false); cm = fmaxf(__uint_as_float(rr[0]), __uint_as_float(rr[1])); }
    const float inv = cm > 0.f ? 127.0f / cm : 0.f; cs = cm * (1.0f / 127.0f);
#pragma unroll
    for (int qd = 0; qd < 4; ++qd) {
        const int c0 = (int)rintf(m.cv[qd][0] * inv), c1 = (int)rintf(m.cv[qd][1] * inv), c2 = (int)rintf(m.cv[qd][2] * inv), c3 = (int)rintf(m.cv[qd][3] * inv);
        CQ[qd] = (unsigned)(c0 & 0xff) | ((unsigned)(c1 & 0xff) << 8) | ((unsigned)(c2 & 0xff) << 16) | ((unsigned)(c3 & 0xff) << 24);
    }
#pragma unroll
    for (int j = 0; j < 16; ++j) P[j] = *(const u32x4*)(VS + (size_t)m.iv[j >> 2][j & 3] * 128);
}
__device__ __forceinline__ void v_compute(const u32x4 (&P)[16], const u32x4& CQ, float cs, float* xout, const float* mod_l, size_t t, unsigned s, int lane) {
    const int g = lane >> 3, p = lane & 7; const bool b4 = (lane >> 4) & 1, b3 = (lane >> 3) & 1;
    typedef float f32x2 __attribute__((ext_vector_type(2)));
    const int col = (int)s * 128 + 16 * p + 2 * g, b = (int)(t >> 12);
    float* xp = xout + t * DM + col;
    f32x2 xv = *(const f32x2*)xp;
    const f32x2 gt = *(const f32x2*)(mod_l + (size_t)b * NMOD + 5 * DM + col);
    int acc[16];
#pragma unroll
    for (int k = 0; k < 16; ++k) acc[k] = 0;
#pragma unroll
    for (int qd = 0; qd < 4; ++qd)
#pragma unroll
        for (int w = 0; w < 4; ++w) {
            const unsigned A = P[4 * qd][w], B = P[4 * qd + 1][w], C = P[4 * qd + 2][w], D = P[4 * qd + 3][w];
            const unsigned X = __builtin_amdgcn_perm(B, A, 0x05010400u), Y = __builtin_amdgcn_perm(B, A, 0x07030602u);
            const unsigned Z = __builtin_amdgcn_perm(D, C, 0x05010400u), W = __builtin_amdgcn_perm(D, C, 0x07030602u);
            const unsigned T0 = __builtin_amdgcn_perm(Z, X, 0x05040100u), T1 = __builtin_amdgcn_perm(Z, X, 0x07060302u);
            const unsigned T2 = __builtin_amdgcn_perm(W, Y, 0x05040100u), T3 = __builtin_amdgcn_perm(W, Y, 0x07060302u);
            acc[4 * w + 0] = __builtin_amdgcn_sdot4((int)T0, (int)CQ[qd], acc[4 * w + 0], false); acc[4 * w + 1] = __builtin_amdgcn_sdot4((int)T1, (int)CQ[qd], acc[4 * w + 1], false);
            acc[4 * w + 2] = __builtin_amdgcn_sdot4((int)T2, (int)CQ[qd], acc[4 * w + 2], false); acc[4 * w + 3] = __builtin_amdgcn_sdot4((int)T3, (int)CQ[qd], acc[4 * w + 3], false);
        }
    int r8[8], r4[4], r2[2];
#pragma unroll
    for (int q = 0; q < 8; ++q) { auto rr = __builtin_amdgcn_permlane32_swap((unsigned)acc[q], (unsigned)acc[8 + q], false, false); r8[q] = (int)rr[0] + (int)rr[1]; }
#pragma unroll
    for (int q = 0; q < 4; ++q) { int lo = r8[q], hi = r8[4 + q]; asm volatile("" : "+v"(lo), "+v"(hi)); const int keep = b4 ? hi : lo, send = b4 ? lo : hi; r4[q] = keep + __builtin_amdgcn_ds_swizzle(send, (16 << 10) | 0x1f); }
#pragma unroll
    for (int q = 0; q < 2; ++q) { int lo = r4[q], hi = r4[2 + q]; asm volatile("" : "+v"(lo), "+v"(hi)); const int keep = b3 ? hi : lo, send = b3 ? lo : hi; r2[q] = keep + __builtin_amdgcn_ds_swizzle(send, (8 << 10) | 0x1f); }
    xv.x += gt.x * ((float)r2[0] * cs); xv.y += gt.y * ((float)r2[1] * cs);
    *(f32x2*)xp = xv;
}
__device__ __forceinline__ void v_unit(const KArgs& a, int l, const float* mod_l, unsigned s, unsigned unit, int lane) {
    const int g = lane >> 3, p = lane & 7;
    const unsigned char* VS = a.ws + WS_VQ + (size_t)l * NEXP * 1024 + (size_t)s * NEXP * 128 + 16 * p;
    const int* IDX = (const int*)(a.ws + WS_IDX); const float* COEF = (const float*)(a.ws + WS_COEF);
    const size_t t0 = (size_t)unit * UNIT;
    VMeta m; v_meta(m, IDX, COEF, t0, g);
    u32x4 PA[16], PB[16], CQA, CQB; float csA, csB;
    v_stage(PA, CQA, csA, m, VS);
    v_meta(m, IDX, COEF, t0 + 1, g);
#pragma unroll 1
    for (int i = 0; i < UNIT; i += 2) {
        v_stage(PB, CQB, csB, m, VS);
        v_meta(m, IDX, COEF, t0 + (i + 2 < UNIT ? i + 2 : i), g);
        v_compute(PA, CQA, csA, a.out, mod_l, t0 + i, s, lane);
        if (i + 2 < UNIT) { v_stage(PA, CQA, csA, m, VS); v_meta(m, IDX, COEF, t0 + (i + 3 < UNIT ? i + 3 : i), g); }
        v_compute(PB, CQB, csB, a.out, mod_l, t0 + i + 1, s, lane);
    }
}
template <bool VSTEP>
__device__ __forceinline__ void peer_phase(const KArgs& a, int l, const float* mod_l, unsigned* cnt, LAS unsigned char* lds, int wv) {
        const int tid = phase_tid(wv), lane = tid & 63, wid = wv;
    LAS unsigned char* wlds = lds + wid * 1024;
    const unsigned home = xcc_id();
    unsigned ss = 0, s = home;
    unsigned nxt = take_async(cnt + 64 * s, lane);
    for (;;) {
        const unsigned cur = (unsigned)__builtin_amdgcn_readfirstlane((int)nxt);
        if (cur >= (unsigned)NUNIT) { if (++ss == 8u) break; s = (home + ss) & 7u; nxt = take_async(cnt + 64 * s, lane); continue; }
        nxt = take_async(cnt + 64 * s, lane);
        if (VSTEP) v_unit(a, l, mod_l, s, cur, lane); else u_unit(a, l, s, cur, wlds, lane);
    }
}
}

constexpr int PH_PER_LAYER = 10, NPHASES = 1 + DEPTH * PH_PER_LAYER + 1;
#ifndef PHASE_MASK
#define PHASE_MASK 0xFFFF
#endif
#define HASP(k) (((PHASE_MASK) >> (k)) & 1)
#ifndef SB_EARLY_EXIT
#define SB_EARLY_EXIT 1
#endif

#define GAS __attribute__((address_space(1)))
#define RLX_AGENT __ATOMIC_RELAXED, __HIP_MEMORY_SCOPE_AGENT
#define XB_TMO      128
#define XB_XCNT(j)  (256  + 64 * (j))
#define XB_XSUB(j)  (1280 + 64 * (j))
#define XB_XGEN(j)  (2304 + 64 * (j))
#define XB_TOP      3328
#define XB_TOPGEN   3392
#define XCD_BAR_WORDS 3456
#define XB_SPIN_CAP (1u << 18)

__device__ __forceinline__ unsigned xb_ld(unsigned* p)              { return __hip_atomic_load(p, __ATOMIC_RELAXED, __HIP_MEMORY_SCOPE_AGENT); }
__device__ __forceinline__ unsigned xb_add(unsigned* p, unsigned v) { return __hip_atomic_fetch_add(p, v, __ATOMIC_RELAXED, __HIP_MEMORY_SCOPE_AGENT); }
__device__ __forceinline__ unsigned xb_xcc_id() { return (unsigned)__builtin_amdgcn_s_getreg((3 << 11) | 20) & 0xFu; }
#define XB_SPIN(cond, bar) do { unsigned _sp = 0; while (cond) { __builtin_amdgcn_s_sleep(1); \
    if ((++_sp & 255u) == 0u) { if (xb_ld(&(bar)[XB_TMO])) break; if (_sp > XB_SPIN_CAP) { atomicAdd(&(bar)[XB_TMO], 1u); break; } } } } while (0)

struct XcdBarrier {
    unsigned* bar; unsigned x;
    volatile LAS unsigned* st;
};

__device__ __forceinline__ XcdBarrier xcd_barrier_post(unsigned* bar, volatile LAS unsigned* st, bool tid0) {
    XcdBarrier b; b.bar = bar; b.x = xb_xcc_id(); b.st = st;
    if (tid0) (void)xb_add(&bar[XB_XCNT(b.x)], 1u);
    return b;
}
__device__ __forceinline__ void xcd_barrier_complete(unsigned* bar, unsigned x, unsigned& nloc, unsigned& nx) {
    const unsigned G = gridDim.x * gridDim.y * gridDim.z;
    unsigned sum, cnt, mine, sp = 0u;
    for (;;) {
        sum = 0u; cnt = 0u; mine = 0u;
#pragma unroll
        for (unsigned j = 0; j < 16; ++j) { const unsigned c = xb_ld(&bar[XB_XCNT(j)]); sum += c; cnt += (c > 0u) ? 1u : 0u; mine = (j == x) ? c : mine; }
        if (sum == G) break;
        __builtin_amdgcn_s_sleep(1);
        if ((++sp & 255u) == 0u) { if (xb_ld(&bar[XB_TMO])) break; if (sp > XB_SPIN_CAP) { atomicAdd(&bar[XB_TMO], 1u); break; } }
    }
    nloc = mine > 0u ? mine : 1u; nx = cnt > 0u ? cnt : 1u;
}

__device__ __forceinline__ void xcd_barrier(const XcdBarrier& b, bool tid0) {
    asm volatile("s_waitcnt vmcnt(0)" ::: "memory");
    __syncthreads();
    if (tid0) {
        unsigned* bar = b.bar;
        __builtin_amdgcn_s_waitcnt(0);
        unsigned nloc = b.st[0], nx = b.st[1];
        if (nloc == 0u) { xcd_barrier_complete(bar, b.x, nloc, nx); b.st[0] = nloc; b.st[1] = nx; }
        const unsigned old = xb_add(&bar[XB_XSUB(b.x)], 1u);
        const unsigned gen = old / nloc;
        if (old + 1u == (gen + 1u) * nloc) {
            __builtin_amdgcn_fence(__ATOMIC_RELEASE, "agent");
            asm volatile("s_waitcnt vmcnt(0)" ::: "memory");
            const unsigned og = xb_add(&bar[XB_TOP], 1u);
            const unsigned tg = og / nx;
            if (og + 1u == (tg + 1u) * nx) xb_add(&bar[XB_TOPGEN], 1u);
            else XB_SPIN(xb_ld(&bar[XB_TOPGEN]) == tg, bar);
            __builtin_amdgcn_fence(__ATOMIC_ACQUIRE, "agent");
            xb_add(&bar[XB_XGEN(b.x)], 1u);
            asm volatile("s_waitcnt vmcnt(0)" ::: "memory");
        } else {
            XB_SPIN(xb_ld(&bar[XB_XGEN(b.x)]) == gen, bar);
            __builtin_amdgcn_fence(__ATOMIC_ACQUIRE, "agent");
            asm volatile("s_waitcnt vmcnt(0)" ::: "memory");
        }
    }
    __syncthreads();
}

typedef const __attribute__((address_space(4))) KArgs* KArgsP;
__device__ __forceinline__ KArgsP kargs() { KArgsP p = (KArgsP)__builtin_amdgcn_kernarg_segment_ptr(); asm volatile("" : "+s"(p)); return p; }

__device__ __forceinline__ void load_args(KArgs& a) {
#if defined(__HIP_DEVICE_COMPILE__)
    KArgsP p = kargs();
    a.x = p->x; a.c = p->c; a.pos = p->pos; a.ada_w = p->ada_w; a.ada_b = p->ada_b; a.norm1_g = p->norm1_g; a.w_in = p->w_in; a.sinks = p->sinks; a.wbr_a = p->wbr_a; a.wbr_b = p->wbr_b;
    a.w_out = p->w_out; a.norm2_g = p->norm2_g; a.wq = p->wq; a.subkeys = p->subkeys; a.pu = p->pu; a.pv = p->pv; a.final_g = p->final_g; a.out = p->out; a.ws = p->ws; a.ph_lo = p->ph_lo; a.ph_hi = p->ph_hi;
#endif
}
__global__ void __launch_bounds__(NTHREADS, 2) fwd_kernel(KArgs a_unused) {
    extern __shared__ __attribute__((aligned(16))) unsigned char lds_raw[];
    LAS unsigned char* lds = (LAS unsigned char*)lds_raw;
    cg::grid_group grid = cg::this_grid();
    const int ph_lo = kargs()->ph_lo, ph_hi = kargs()->ph_hi;
    const int wv = __builtin_amdgcn_readfirstlane((int)threadIdx.x >> 6);
#define IN(k) (ph_lo <= (k) && (k) < ph_hi)
    volatile LAS unsigned* xb_st = (volatile LAS unsigned*)(lds + LDS_BYTES - 64);
    { const bool t0_ = phase_tid(wv) == 0; if (t0_) { xb_st[0] = 0u; xb_st[1] = 0u; } __syncthreads();
      (void)xcd_barrier_post((unsigned*)(kargs()->ws + WS_CTL) + CTL_BAR, xb_st, t0_); }
#define GRID_BAR() do { XcdBarrier b_; b_.bar = (unsigned*)(kargs()->ws + WS_CTL) + CTL_BAR; b_.x = xb_xcc_id(); b_.st = xb_st; xcd_barrier(b_, phase_tid(wv) == 0); } while (0)
#ifdef PROBE_PH
    unsigned long long pr_prev = __builtin_amdgcn_s_memrealtime(), pr_acc = 0;
#define PROBE_MATCH(k) ((PROBE_PH) >= 100 ? ((k) >= 1 && (k) < NPHASES - 1 && (((k) - 1) % PH_PER_LAYER) == (PROBE_PH) - 100) : (k) == (PROBE_PH))
#define SEAM(k) do { if (IN(k) && IN((k) + 1)) { if ((k) == 0) grid.sync(); else GRID_BAR(); } { const unsigned long long now_ = __builtin_amdgcn_s_memrealtime(); if (PROBE_MATCH(k)) pr_acc += now_ - pr_prev; pr_prev = now_; } } while (0)
#else
#define SEAM(k) do { if (IN(k) && IN((k) + 1)) { if ((k) == 0) grid.sync(); else GRID_BAR(); } } while (0)
#endif
#define LOADARGS KArgs a; load_args(a); unsigned char* ws = a.ws; const int G = op_grid(); (void)G; (void)ws
#define LAYERARGS const float* mod_l = (const float*)(ws + WS_MOD) + (size_t)l * 8 * NMOD; const float* xcur = (l == 0) ? a.x : a.out; (void)mod_l; (void)xcur
    if (IN(0)) { if (HASP(0)) { LOADARGS; ph_prologue(a, lds, wv); } }
    SEAM(0);
#pragma unroll 1
    for (int l = 0; l < DEPTH; ++l) {
        const int p0 = 1 + l * PH_PER_LAYER;
        if (IN(p0 + 0)) { if (HASP(1)) { LOADARGS; LAYERARGS; ph_norm<false>(a, xcur, a.norm1_g + l * DM, mod_l, 0, 1, wv); } }
        SEAM(p0 + 0);
        if (IN(p0 + 1)) { if (HASP(2)) { LOADARGS; pg8::Gemm g{(const bf16_t*)(ws + WS_H), (const bf16_t*)(ws + WS_WIN) + (size_t)l * NPROJ * 1024, T, NPROJ, 1024};
                  pg8::StaticOrder S; S.init(T, NPROJ, G, op_bid()); EpiProj E{ws};
                  pg8::gemm_phase<EpiProj, pg8::StaticOrder, true, true>(lds, g, S, E, wv); } }
        SEAM(p0 + 1);
        if (IN(p0 + 2)) { if (HASP(3)) { LOADARGS;
                  att::swa_phase((const bf16_t*)(ws + WS_QA), (const bf16_t*)(ws + WS_KA), (const bf16_t*)(ws + WS_VA), (bf16_t*)(ws + WS_QA), a.sinks + l * 8, lds, wv);
                  __syncthreads();
                  att::sb_phase<SB_EARLY_EXIT != 0>((const bf16_t*)(ws + WS_QB), (const bf16_t*)(ws + WS_KB), (const bf16_t*)(ws + WS_VB), (bf16_t*)(ws + WS_QB), lds, wv); } }
        SEAM(p0 + 2);
        if (IN(p0 + 3)) { if (HASP(4)) { LOADARGS; pg8::StaticOrder S; S.init(T, DM, G, op_bid());
                  { pg8::Gemm g{(const bf16_t*)(ws + WS_QA), (const bf16_t*)(ws + WS_WBA) + (size_t)l * 1024 * 512, T, DM, 512};
                    EpiBranch<false> E{(const bf16_t*)(ws + WS_GA), (bf16_t*)(ws + WS_H)};
                    pg8::gemm_phase<EpiBranch<false>, pg8::StaticOrder, true, true>(lds, g, S, E, wv); }
                  __syncthreads();
                  { pg8::Gemm g{(const bf16_t*)(ws + WS_QB), (const bf16_t*)(ws + WS_WBB) + (size_t)l * 1024 * 512, T, DM, 512};
                    EpiBranch<true> E{(const bf16_t*)(ws + WS_GB), (bf16_t*)(ws + WS_H)};
                    pg8::gemm_phase<EpiBranch<true>, pg8::StaticOrder, true, true>(lds, g, S, E, wv); } } }
        SEAM(p0 + 3);
        if (IN(p0 + 4)) { if (HASP(5)) { LOADARGS; LAYERARGS; pg8::Gemm g{(const bf16_t*)(ws + WS_H), (const bf16_t*)(ws + WS_WOUT) + (size_t)l * 1024 * 1024, T, DM, 1024};
                  pg8::StaticOrder S; S.init(T, DM, G, op_bid()); EpiWout E{xcur, a.out, mod_l + 2 * DM};
                  pg8::gemm_phase<EpiWout, pg8::StaticOrder, true, true>(lds, g, S, E, wv); } }
        SEAM(p0 + 4);
        if (IN(p0 + 5)) { if (HASP(6)) { LOADARGS; LAYERARGS; ph_norm<true>(a, a.out, a.norm2_g + l * DM, mod_l, 3, 4, wv); } }
        SEAM(p0 + 5);
        if (IN(p0 + 6)) { if (HASP(7)) { LOADARGS; pg8::Gemm g{(const bf16_t*)(ws + WS_H), (const bf16_t*)(ws + WS_WQ) + (size_t)l * PQ * 1024, T, PQ, 1024};
                  pg8::StaticOrder S; S.init(T, PQ, G, op_bid()); EpiPlainBf16 E{(bf16_t*)(ws + WS_Q2), PQ};
                  pg8::gemm_phase<EpiPlainBf16, pg8::StaticOrder, true, true>(lds, g, S, E, wv); } }
        SEAM(p0 + 6);
        if (IN(p0 + 7)) { if (HASP(8)) { LOADARGS; tk::topk_phase((const bf16_t*)(ws + WS_Q2), (const bf16_t*)(ws + WS_SK) + (size_t)l * 8 * 2 * 128 * 128, (int*)(ws + WS_IDX), (float*)(ws + WS_GATE), lds, wv); } }
        SEAM(p0 + 7);
        if (IN(p0 + 8)) { if (HASP(9)) { LOADARGS; peer3::peer_phase<false>(a, l, nullptr, (unsigned*)(ws + WS_CTL) + CTL_QUEUE + (l * 2 + 0) * 8 * 64, lds, wv); } }
        SEAM(p0 + 8);
        if (IN(p0 + 9)) { if (HASP(10)) { LOADARGS; LAYERARGS; peer3::peer_phase<true>(a, l, mod_l, (unsigned*)(ws + WS_CTL) + CTL_QUEUE + (l * 2 + 1) * 8 * 64, lds, wv); } }
        SEAM(p0 + 9);
    }
    if (IN(NPHASES - 1)) { if (HASP(11)) { LOADARGS; ph_final_norm(a, wv); } }
#ifdef PROBE_PH
    { const unsigned long long now_ = __builtin_amdgcn_s_memrealtime(); if (PROBE_MATCH(NPHASES - 1)) pr_acc += now_ - pr_prev;
      if (blockIdx.x == 0 && threadIdx.x == 0) { const unsigned long long t0_ = __builtin_amdgcn_s_memrealtime(); while (__builtin_amdgcn_s_memrealtime() - t0_ < pr_acc * (PROBE_K)) __builtin_amdgcn_s_sleep(16); } }
#endif
#undef IN
#undef SEAM
}

#ifndef N_LAUNCH_SPLIT
#define N_LAUNCH_SPLIT 1
#endif
extern "C" void kernel_launch(void* const* d_in, const int* in_sizes, int n_in, void* d_out, int out_size, void* d_ws, size_t ws_size, hipStream_t stream) {
    static int grid = 0;
    if (grid == 0) {
        if (n_in != 17 || out_size != T * DM || ws_size < WS_END) { fprintf(stderr, "kernel_launch: unexpected problem (n_in %d out %d ws %zu)\n", n_in, out_size, ws_size); grid = -1; return; }
        int dev = 0, cus = 0, per_cu = 0;
        (void)hipGetDevice(&dev);
        (void)hipDeviceGetAttribute(&cus, hipDeviceAttributeMultiprocessorCount, dev);
        (void)hipFuncSetAttribute((const void*)fwd_kernel, hipFuncAttributeMaxDynamicSharedMemorySize, LDS_BYTES);
        (void)hipOccupancyMaxActiveBlocksPerMultiprocessor(&per_cu, (const void*)fwd_kernel, NTHREADS, LDS_BYTES);
        if (per_cu < 1) { fprintf(stderr, "kernel_launch: occupancy query says %d\n", per_cu); per_cu = 1; }
        grid = cus;
        fprintf(stderr, "kernel_launch: cus %d per_cu %d grid %d ws %zu\n", cus, per_cu, grid, ws_size);
    }
    if (grid < 0) return;
    if (hipMemsetAsync((char*)d_ws + WS_CTL, 0, 65536, stream) != hipSuccess) { fprintf(stderr, "kernel_launch: hipMemsetAsync of the control words failed\n"); return; }
    KArgs a{};
    a.x = (const float*)d_in[0]; a.c = (const float*)d_in[1]; a.pos = (const int*)d_in[2]; a.ada_w = (const float*)d_in[3]; a.ada_b = (const float*)d_in[4];
    a.norm1_g = (const float*)d_in[5]; a.w_in = (const float*)d_in[6]; a.sinks = (const float*)d_in[7]; a.wbr_a = (const float*)d_in[8]; a.wbr_b = (const float*)d_in[9];
    a.w_out = (const float*)d_in[10]; a.norm2_g = (const float*)d_in[11]; a.wq = (const float*)d_in[12]; a.subkeys = (const float*)d_in[13]; a.pu = (const float*)d_in[14];
    a.pv = (const float*)d_in[15]; a.final_g = (const float*)d_in[16]; a.out = (float*)d_out; a.ws = (unsigned char*)d_ws;
#if N_LAUNCH_SPLIT
    a.ph_lo = 0; a.ph_hi = NPHASES;
    { void* args[] = {&a};
      hipError_t e = hipLaunchCooperativeKernel((void*)fwd_kernel, dim3(grid), dim3(NTHREADS), args, LDS_BYTES, stream);
      if (e != hipSuccess) fprintf(stderr, "cooperative launch failed: %s (grid %d)\n", hipGetErrorString(e), grid); }
#else
    for (int ph = 0; ph < NPHASES; ++ph) {
        a.ph_lo = ph; a.ph_hi = ph + 1;
        void* args[] = {&a};
        hipError_t e = hipLaunchCooperativeKernel((void*)fwd_kernel, dim3(grid), dim3(NTHREADS), args, LDS_BYTES, stream);
        if (e != hipSuccess) { fprintf(stderr, "cooperative launch %d failed: %s (grid %d)\n", ph, hipGetErrorString(e), grid); break; }
    }
#endif
}
```

```cpp
#include <hip/hip_runtime.h>
#include <hip/hip_cooperative_groups.h>
#include <cstdio>
#include <cstdint>
namespace cg = cooperative_groups;

namespace pg8 {
#define PG8_LAS __attribute__((address_space(3)))
typedef unsigned short bf16_t;
typedef short bf16x8 __attribute__((ext_vector_type(8)));
typedef float f32x4 __attribute__((ext_vector_type(4)));
typedef unsigned u32x4 __attribute__((ext_vector_type(4)));
constexpr int BM = 256, BK = 64, HALF = 128, HTB = HALF * BK * 2  , STAGE_BYTES = 8 * HTB, NXCD = 8, WGM = 8;

__host__ __device__ __forceinline__ int lds_byte(int r, int c) { const int st = (r >> 4) * 2 + (c >> 5), rr = r & 15, cc = c & 31, ob = rr * 64 + cc * 2; return st * 1024 + (ob ^ (((ob >> 9) & 1) << 5)); }
__host__ __device__ __forceinline__ void stage_rc(int b, int& R, int& C) { const int st = b / 1024, sb = b % 1024, swz = sb ^ (((sb >> 9) & 1) << 5); R = (st >> 1) * 16 + swz / 64; C = (st & 1) * 32 + (swz % 64) / 2; }
__host__ __device__ __forceinline__ int perm32(int rho) { const int n = rho >> 4, i = rho & 15; return 8 * (i >> 2) + 4 * n + (i & 3); }

struct Unit { int pm, pn; };
struct Gemm { const bf16_t* A; const bf16_t* Bt; int M, N, K; };

struct StaticOrder {
    int nM, nN, nwg, G, c;
    __host__ __device__ void init(int M, int N, int G_, int c_) { nM = M / BM; nN = N / BM; nwg = nM * nN; G = G_; c = c_; }
    __host__ __device__ bool next(int i, Unit& u) const {
        const long L = (long)i * G + c; if (L >= nwg) return false;
        int wgid = (int)L; { const int q = nwg / NXCD, r = nwg % NXCD, xcd = wgid % NXCD, off = wgid / NXCD; wgid = (xcd < r ? xcd * (q + 1) : r * (q + 1) + (xcd - r) * q) + off; }
        const int nig = WGM * nN, gid = wgid / nig, fm = gid * WGM, gsz = (nM - fm) < WGM ? (nM - fm) : WGM;
        u.pm = fm + ((wgid % nig) % gsz); u.pn = (wgid % nig) / gsz; return true;
    }
    __device__ __forceinline__ void a_ready(const Unit&) const {}
    __device__ __forceinline__ void done(const Unit&) const {}
};


__device__ __forceinline__ unsigned cvt_pk_bf16(float lo, float hi) { unsigned r; asm volatile("v_cvt_pk_bf16_f32 %0, %1, %2" : "=v"(r) : "v"(lo), "v"(hi)); return r; }
template <class Epi, class Sched, bool ALIGN_EPI = false, bool SP2 = false>
__device__ __forceinline__ void gemm_phase(PG8_LAS unsigned char* lds, const Gemm g, const Sched& S, const Epi& E, int wv) {
    unsigned m_op = ~0u; asm volatile("" : "+s"(m_op));
    const int tid = wv * 64 + (int)__builtin_amdgcn_mbcnt_hi(m_op, __builtin_amdgcn_mbcnt_lo(m_op, 0u)), wid = wv, lane = tid & 63, wr = wid >> 2, wc = wid & 3, fr = lane & 15, fq = lane >> 4;
    const int K = g.K, nt = K / BK;
    unsigned voffA[2], voffB[2];
#pragma unroll
    for (int i = 0; i < 2; ++i) { int R, C; stage_rc(tid * 16 + i * 8192, R, C); const int Rb = Epi::PERM ? ((R & ~31) + perm32(R & 31)) : R;
        voffA[i] = (unsigned)(R * K + C) * 2u; voffB[i] = (unsigned)(Rb * K + C) * 2u; }
    const size_t kstep = (size_t)(BK * 2);
    const size_t hstep = (size_t)HALF * K * 2;
    const size_t tstep = 2 * hstep;
    const unsigned ldsw = (unsigned)wid * 1024u;
    const int aoff = lds_byte(wr * 64 + fr, fq * 8), boff = lds_byte(wc * 32 + fr, fq * 8);
#define PG8_SA(b, h) (((b) * 2 + (h)) * HTB)
#define PG8_SB(b, h) ((4 + (b) * 2 + (h)) * HTB)
#define PG8_STAGE(bufoff, gbase, voff) do { _Pragma("unroll") for (int _i = 0; _i < 2; ++_i) \
        __builtin_amdgcn_global_load_lds((const unsigned*)((const char*)(gbase) + (voff)[_i]), (PG8_LAS unsigned*)(lds + (bufoff) + ldsw + _i * 8192), 16, 0, 0); } while (0)
#define PG8_LDA(dst, b, h) do { _Pragma("unroll") for (int m = 0; m < 4; ++m) _Pragma("unroll") for (int k = 0; k < 2; ++k) dst[m][k] = *(const PG8_LAS bf16x8*)(lds + PG8_SA(b, h) + aoff + m * 2048 + k * 1024); } while (0)
#define PG8_LDB(dst, b, h) do { _Pragma("unroll") for (int n = 0; n < 2; ++n) _Pragma("unroll") for (int k = 0; k < 2; ++k) dst[n][k] = *(const PG8_LAS bf16x8*)(lds + PG8_SB(b, h) + boff + n * 2048 + k * 1024); } while (0)
#define PG8_MMA(ai, bj, At, Bt) do { __builtin_amdgcn_s_setprio(1); _Pragma("unroll") for (int m = 0; m < 4; ++m) _Pragma("unroll") for (int n = 0; n < 2; ++n) _Pragma("unroll") for (int k = 0; k < 2; ++k) \
        acc[ai][bj][m][n] = __builtin_amdgcn_mfma_f32_16x16x32_bf16(Bt[n][k], At[m][k], acc[ai][bj][m][n], 0, 0, 0); __builtin_amdgcn_s_setprio(0); } while (0)
#define PG8_WAIT_V(n) asm volatile("s_waitcnt vmcnt(" #n ")" ::: "memory")
#define PG8_WAIT_L(n) asm volatile("s_waitcnt lgkmcnt(" #n ")" ::: "memory")
#define PG8_BAR __builtin_amdgcn_s_barrier()
#define PG8_SCHED __builtin_amdgcn_sched_barrier(0)
    Unit cur, nxt; int ui = 0;
    if (!S.next(0, cur)) return;
    f32x4 acc[2][2][4][2];
#pragma unroll
    for (int a = 0; a < 2; ++a)
#pragma unroll
        for (int b = 0; b < 2; ++b)
#pragma unroll
            for (int m = 0; m < 4; ++m)
#pragma unroll
                for (int n = 0; n < 2; ++n) acc[a][b][m][n] = (f32x4){0.f, 0.f, 0.f, 0.f};
    bf16x8 At[4][2], B0[2][2], B1[2][2];
    const char* cA = (const char*)g.A + (size_t)cur.pm * tstep; const char* cB = (const char*)g.Bt + (size_t)cur.pn * tstep;
    S.a_ready(cur);
    if constexpr (SP2) {
        PG8_STAGE(PG8_SB(0, 0), cB, voffB); PG8_STAGE(PG8_SB(0, 1), cB + hstep, voffB); PG8_STAGE(PG8_SA(0, 0), cA, voffA); PG8_STAGE(PG8_SA(0, 1), cA + hstep, voffA);
        if (wr == 1) PG8_BAR;
        PG8_WAIT_V(2); PG8_BAR;
        PG8_STAGE(PG8_SB(1, 0), cB + kstep, voffB); PG8_STAGE(PG8_SA(1, 0), cA + kstep, voffA); PG8_STAGE(PG8_SB(1, 1), cB + hstep + kstep, voffB);
        PG8_WAIT_V(6); PG8_BAR;
    } else {
        PG8_STAGE(PG8_SB(0, 0), cB, voffB); PG8_STAGE(PG8_SA(0, 0), cA, voffA); PG8_STAGE(PG8_SB(0, 1), cB + hstep, voffB); PG8_STAGE(PG8_SA(0, 1), cA + hstep, voffA);
        if (wr == 1) PG8_BAR;
        PG8_WAIT_V(4); PG8_BAR;
        PG8_STAGE(PG8_SB(1, 0), cB + kstep, voffB); PG8_STAGE(PG8_SA(1, 0), cA + kstep, voffA); PG8_STAGE(PG8_SB(1, 1), cB + hstep + kstep, voffB);
        PG8_WAIT_V(6); PG8_BAR;
    }
    for (;;) {
        const bool has_next = S.next(ui + 1, nxt);
        const char* nA = has_next ? (const char*)g.A + (size_t)nxt.pm * tstep : cA; const char* nB = has_next ? (const char*)g.Bt + (size_t)nxt.pn * tstep : cB;
        for (int t = 0; t < nt; t += 2) {
            const bool last = (t == nt - 2);
            const char* a1 = cA + (size_t)(t + 1) * kstep;
            const char* a2 = last ? nA : cA + (size_t)(t + 2) * kstep; const char* b2 = last ? nB : cB + (size_t)(t + 2) * kstep;
            const char* a3 = a2 + kstep; const char* b3 = b2 + kstep;
            if (last && has_next) S.a_ready(nxt);
            if constexpr (SP2) {
            PG8_LDB(B0, 0, 0); PG8_LDB(B1, 0, 1); PG8_SCHED; PG8_LDA(At, 0, 0); PG8_STAGE(PG8_SA(1, 1), a1 + hstep, voffA);
            PG8_WAIT_V(8); PG8_WAIT_L(0); PG8_BAR; PG8_MMA(0, 0, At, B0); PG8_MMA(0, 1, At, B1); PG8_BAR; PG8_SCHED;
            PG8_LDA(At, 0, 1); PG8_STAGE(PG8_SB(0, 0), b2, voffB); PG8_STAGE(PG8_SB(0, 1), b2 + hstep, voffB); PG8_STAGE(PG8_SA(0, 0), a2, voffA);
            PG8_WAIT_V(8); PG8_WAIT_L(0); PG8_BAR; PG8_MMA(1, 0, At, B0); PG8_MMA(1, 1, At, B1); PG8_BAR; PG8_SCHED;
            PG8_LDB(B0, 1, 0); PG8_LDB(B1, 1, 1); PG8_SCHED; PG8_LDA(At, 1, 0); PG8_STAGE(PG8_SA(0, 1), a2 + hstep, voffA);
            PG8_WAIT_V(8); PG8_WAIT_L(0); PG8_BAR; PG8_MMA(0, 0, At, B0); PG8_MMA(0, 1, At, B1); PG8_BAR; PG8_SCHED;
            PG8_LDA(At, 1, 1); PG8_STAGE(PG8_SB(1, 0), b3, voffB); PG8_STAGE(PG8_SB(1, 1), b3 + hstep, voffB); PG8_STAGE(PG8_SA(1, 0), a3, voffA);
            PG8_WAIT_V(8); PG8_WAIT_L(0); PG8_BAR; PG8_MMA(1, 0, At, B0); PG8_MMA(1, 1, At, B1); PG8_BAR; PG8_SCHED;
            } else {
            PG8_LDB(B0, 0, 0); PG8_SCHED; PG8_LDA(At, 0, 0); PG8_STAGE(PG8_SA(1, 1), a1 + hstep, voffA);
            PG8_WAIT_L(8); PG8_BAR; PG8_WAIT_L(0); PG8_MMA(0, 0, At, B0); PG8_BAR; PG8_SCHED;
            PG8_LDB(B1, 0, 1); PG8_STAGE(PG8_SB(0, 0), b2, voffB);
            PG8_BAR; PG8_WAIT_L(0); PG8_MMA(0, 1, At, B1); PG8_BAR;
            PG8_LDA(At, 0, 1); PG8_STAGE(PG8_SA(0, 0), a2, voffA);
            PG8_BAR; PG8_WAIT_L(0); PG8_MMA(1, 0, At, B0); PG8_BAR; PG8_SCHED;
            PG8_STAGE(PG8_SB(0, 1), b2 + hstep, voffB);
            PG8_WAIT_V(6); PG8_BAR; PG8_MMA(1, 1, At, B1); PG8_BAR;
            PG8_LDB(B0, 1, 0); PG8_SCHED; PG8_LDA(At, 1, 0); PG8_STAGE(PG8_SA(0, 1), a2 + hstep, voffA);
            PG8_WAIT_L(8); PG8_BAR; PG8_WAIT_L(0); PG8_MMA(0, 0, At, B0); PG8_BAR; PG8_SCHED;
            PG8_LDB(B1, 1, 1); PG8_STAGE(PG8_SB(1, 0), b3, voffB);
            PG8_BAR; PG8_WAIT_L(0); PG8_MMA(0, 1, At, B1); PG8_BAR;
            PG8_LDA(At, 1, 1); PG8_STAGE(PG8_SA(1, 0), a3, voffA);
            PG8_BAR; PG8_WAIT_L(0); PG8_MMA(1, 0, At, B0); PG8_BAR; PG8_SCHED;
            PG8_STAGE(PG8_SB(1, 1), b3 + hstep, voffB);
            PG8_WAIT_V(6); PG8_BAR; PG8_MMA(1, 1, At, B1); PG8_BAR;
            }
        }
        if constexpr (ALIGN_EPI) { if (wr == 0) PG8_BAR; }
        if constexpr (!Epi::AFTER_DRAIN) { E(acc, cur, wr, wc, fr, fq); S.done(cur); }
        if (!has_next) break;
#pragma unroll
        for (int a = 0; a < 2; ++a)
#pragma unroll
            for (int b = 0; b < 2; ++b)
#pragma unroll
                for (int m = 0; m < 4; ++m)
#pragma unroll
                    for (int n = 0; n < 2; ++n) acc[a][b][m][n] = (f32x4){0.f, 0.f, 0.f, 0.f};
        cur = nxt; cA = nA; cB = nB; ++ui;
        if constexpr (ALIGN_EPI) { if (wr == 1) PG8_BAR; }
    }
    PG8_WAIT_V(0);
    if constexpr (!ALIGN_EPI) { if (wr == 0) PG8_BAR; }
    PG8_BAR;
    if constexpr (Epi::AFTER_DRAIN) { E.fused(acc, cur, wr, wc, fr, fq, lds, wid, lane); S.done(cur); }
#undef PG8_SA
#undef PG8_SB
#undef PG8_STAGE
#undef PG8_LDA
#undef PG8_LDB
#undef PG8_MMA
#undef PG8_WAIT_V
#undef PG8_WAIT_L
#undef PG8_BAR
#undef PG8_SCHED
}
}


#define LAS __attribute__((address_space(3)))

__device__ __forceinline__ int op_bid() { int b = (int)blockIdx.x; asm volatile("" : "+s"(b)); return b; }
__device__ __forceinline__ int op_grid() { int g = (int)gridDim.x; asm volatile("" : "+s"(g)); return g; }
__device__ __forceinline__ int phase_tid(int wv) { unsigned m = ~0u; asm volatile("" : "+s"(m)); return wv * 64 + (int)__builtin_amdgcn_mbcnt_hi(m, __builtin_amdgcn_mbcnt_lo(m, 0u)); }
typedef unsigned short bf16_t;
typedef float f32x4 __attribute__((ext_vector_type(4)));
typedef unsigned u32x4 __attribute__((ext_vector_type(4)));
typedef unsigned u32x2 __attribute__((ext_vector_type(2)));

constexpr int BATCH = 8, SEQ = 4096, DM = 1024, T = BATCH * SEQ, DEPTH = 2;
constexpr int NPROJ = 4352, NMOD = 6 * DM;
constexpr int NEXP = 16384, PQ = 2048;
constexpr float NORM_EPS = 1e-6f;
constexpr float LOG2E = 1.4426950408889634f;
constexpr float QSCALE = 0.125f * LOG2E;
constexpr float SB_EXIT = 160.0f;

constexpr size_t MiB = 1u << 20;
constexpr size_t WS_CTL = 0;
constexpr size_t WS_MOD = 1 * MiB;
constexpr size_t WS_ROPE = 2 * MiB;
constexpr size_t WS_WIN = 10 * MiB;
constexpr size_t WS_WBA = 27 * MiB;
constexpr size_t WS_WBB = 29 * MiB;
constexpr size_t WS_WOUT = 31 * MiB;
constexpr size_t WS_WQ = 35 * MiB;
constexpr size_t WS_SK = 43 * MiB;
constexpr size_t WS_UQ = 44 * MiB;
constexpr size_t WS_VQ = 76 * MiB;
constexpr size_t WS_USC = 108 * MiB;
constexpr size_t WS_VSC = 108 * MiB + 256 * 1024;
constexpr size_t WS_HS = 109 * MiB;
constexpr size_t WS_H = 112 * MiB;
constexpr size_t WS_QA = 176 * MiB;
constexpr size_t WS_QB = 208 * MiB;
constexpr size_t WS_KB = 240 * MiB;
constexpr size_t WS_VB = 272 * MiB;
constexpr size_t WS_KA = 304 * MiB;
constexpr size_t WS_VA = 312 * MiB;
constexpr size_t WS_GA = 320 * MiB;
constexpr size_t WS_GB = 384 * MiB;
constexpr size_t WS_END = 448 * MiB;
constexpr size_t WS_H2Q = WS_QA, WS_IDX = WS_KB, WS_GATE = WS_VB, WS_Q2 = WS_GA, WS_COEF = WS_GA;
constexpr int CTL_BAR = 4096;
constexpr int CTL_QUEUE = 1024;

constexpr int LDS_BYTES = 147456;
constexpr int NTHREADS = 512, NWAVES = 8;

struct KArgs {
    const float* x; const float* c; const int* pos; const float* ada_w; const float* ada_b; const float* norm1_g; const float* w_in; const float* sinks;
    const float* wbr_a; const float* wbr_b; const float* w_out; const float* norm2_g; const float* wq; const float* subkeys; const float* pu; const float* pv; const float* final_g;
    float* out; unsigned char* ws; int ph_lo, ph_hi;
};

__device__ __forceinline__ unsigned f2bf(float f) { unsigned u = __float_as_uint(f); return (u + 0x7fffu + ((u >> 16) & 1u)) >> 16; }
__device__ __forceinline__ unsigned pk2(float lo, float hi) { return f2bf(lo) | (f2bf(hi) << 16); }
__device__ __forceinline__ float bflo(unsigned w) { return __uint_as_float(w << 16); }
__device__ __forceinline__ float bfhi(unsigned w) { return __uint_as_float(w & 0xffff0000u); }
template <int M> __device__ __forceinline__ float swz_xor(float v) { return __int_as_float(__builtin_amdgcn_ds_swizzle(__float_as_int(v), (M << 10) | 0x1f)); }
__device__ __forceinline__ float wave_sum(float v) {
    v += swz_xor<1>(v); v += swz_xor<2>(v); v += swz_xor<4>(v); v += swz_xor<8>(v); v += swz_xor<16>(v);
    auto rr = __builtin_amdgcn_permlane32_swap(__float_as_uint(v), __float_as_uint(v), false, false);
    return __uint_as_float(rr[0]) + __uint_as_float(rr[1]);
}
__device__ __forceinline__ float wave_max(float v) {
    v = fmaxf(v, swz_xor<1>(v)); v = fmaxf(v, swz_xor<2>(v)); v = fmaxf(v, swz_xor<4>(v)); v = fmaxf(v, swz_xor<8>(v)); v = fmaxf(v, swz_xor<16>(v));
    auto rr = __builtin_amdgcn_permlane32_swap(__float_as_uint(v), __float_as_uint(v), false, false);
    return fmaxf(__uint_as_float(rr[0]), __uint_as_float(rr[1]));
}
__device__ __forceinline__ int rdlane_i(int v, int l) { return __builtin_amdgcn_readlane(v, __builtin_amdgcn_readfirstlane(l)); }
__device__ __forceinline__ float rdlane_f(float v, int l) { return __int_as_float(__builtin_amdgcn_readlane(__float_as_int(v), __builtin_amdgcn_readfirstlane(l))); }
__device__ __forceinline__ float dot8(u32x4 a, u32x4 b, float acc) {
    acc = fmaf(bflo(a.x), bflo(b.x), acc); acc = fmaf(bfhi(a.x), bfhi(b.x), acc);
    acc = fmaf(bflo(a.y), bflo(b.y), acc); acc = fmaf(bfhi(a.y), bfhi(b.y), acc);
    acc = fmaf(bflo(a.z), bflo(b.z), acc); acc = fmaf(bfhi(a.z), bfhi(b.z), acc);
    acc = fmaf(bflo(a.w), bflo(b.w), acc); acc = fmaf(bfhi(a.w), bfhi(b.w), acc);
    return acc;
}
__device__ __forceinline__ float softplus2(float z2) {
    return fmaxf(z2, 0.f) + __log2f(1.0f + exp2f(-fabsf(z2)));
}

__device__ __forceinline__ int win_pos(int n) {
    if (n >= 640) return n;
    const int hb = n & ~63, d = n & 63;
    return hb + (d < 32 ? 2 * d : 2 * (d - 32) + 1);
}
template <bool WIN>
__device__ __forceinline__ void transpose_item(const float* W, int K, int N, bf16_t* WT, LAS float* scr, int item, int lane) {
    const int nblk = N / 32, kb = item / nblk, nb = item % nblk, k0 = 64 * kb, n0 = 32 * nb;
#pragma unroll 8
    for (int i = 0; i < 32; ++i) { const int kk = 2 * i + (lane >> 5); scr[kk * 33 + (lane & 31)] = W[(size_t)(k0 + kk) * N + n0 + (lane & 31)]; }
    asm volatile("s_waitcnt lgkmcnt(0)" ::: "memory");
    const int c = lane & 7;
#pragma unroll
    for (int j = 0; j < 4; ++j) { const int n = (lane >> 3) + 8 * j; const LAS float* s = scr + (8 * c) * 33 + n;
        u32x4 o; o.x = pk2(s[0 * 33], s[1 * 33]); o.y = pk2(s[2 * 33], s[3 * 33]); o.z = pk2(s[4 * 33], s[5 * 33]); o.w = pk2(s[6 * 33], s[7 * 33]);
        const int row = WIN ? win_pos(n0 + n) : (n0 + n);
        *(u32x4*)(WT + (size_t)row * K + k0 + 8 * c) = o; }
    asm volatile("s_waitcnt lgkmcnt(0)" ::: "memory");
}
template <bool OFFSET128>
__device__ __forceinline__ void quant_row(const f32x4 (&v)[4], unsigned char* dst_row, float* scale_out, int lane) {
    float am = 0.f;
#pragma unroll
    for (int i = 0; i < 4; ++i) am = fmaxf(am, fmaxf(fmaxf(fabsf(v[i].x), fabsf(v[i].y)), fmaxf(fabsf(v[i].z), fabsf(v[i].w))));
    am = wave_max(am);
    const float inv = am > 0.f ? 127.0f / am : 0.f, sc = am > 0.f ? am / 127.0f : 1.0f;
    u32x4 o;
#pragma unroll
    for (int i = 0; i < 4; ++i) {
        int q0 = (int)rintf(v[i].x * inv), q1 = (int)rintf(v[i].y * inv), q2 = (int)rintf(v[i].z * inv), q3 = (int)rintf(v[i].w * inv);
        if (OFFSET128) { q0 += 128; q1 += 128; q2 += 128; q3 += 128; }
        o[i] = (unsigned)(q0 & 0xff) | ((unsigned)(q1 & 0xff) << 8) | ((unsigned)(q2 & 0xff) << 16) | ((unsigned)(q3 & 0xff) << 24);
    }
    *(u32x4*)(dst_row + 16 * lane) = o;
    if (lane == 0) *scale_out = sc;
}

__device__ __forceinline__ void ph_prologue(const KArgs& a, LAS unsigned char* lds, int wv) {
    const int tid = phase_tid(wv), lane = tid & 63, wave = wv, G = op_grid();
    const int gw = op_bid() * NWAVES + wave, NGW = G * NWAVES;
    unsigned char* ws = a.ws;
    {
        LAS float* sc = (LAS float*)lds;
        for (int it = op_bid(); it < DEPTH * 12; it += G) {
            for (int idx = tid; idx < 8192; idx += NTHREADS) { const int b = idx >> 10, i = idx & 1023; const float cv = a.c[b * 1024 + i]; sc[i * 8 + b] = cv / (1.0f + __expf(-cv)); }
            __syncthreads();
            const int l = it / 12, j = (it % 12) * 512 + tid;
            const float* wp = a.ada_w + (size_t)l * 1024 * NMOD + j;
            float acc[8];
#pragma unroll
            for (int b = 0; b < 8; ++b) acc[b] = 0.f;
#pragma unroll 4
            for (int i = 0; i < 1024; ++i) {
                const float w = wp[(size_t)i * NMOD];
                const f32x4 s0 = *(const LAS f32x4*)(sc + i * 8), s1 = *(const LAS f32x4*)(sc + i * 8 + 4);
                acc[0] = fmaf(s0.x, w, acc[0]); acc[1] = fmaf(s0.y, w, acc[1]); acc[2] = fmaf(s0.z, w, acc[2]); acc[3] = fmaf(s0.w, w, acc[3]);
                acc[4] = fmaf(s1.x, w, acc[4]); acc[5] = fmaf(s1.y, w, acc[5]); acc[6] = fmaf(s1.z, w, acc[6]); acc[7] = fmaf(s1.w, w, acc[7]);
            }
            float* mod = (float*)(ws + WS_MOD);
            const float bias = a.ada_b[l * NMOD + j];
#pragma unroll
            for (int b = 0; b < 8; ++b) mod[(size_t)(l * 8 + b) * NMOD + j] = acc[b] + bias;
            __syncthreads();
        }
    }
    {
        LAS float* scr = (LAS float*)(lds + 32768 + wave * 8448);
        constexpr int I_IN = 16 * 136, I_BR = 8 * 32, I_OUT = 16 * 32, I_Q = 16 * 64, I_L = I_IN + 2 * I_BR + I_OUT + I_Q;
        for (int it = gw; it < DEPTH * I_L; it += NGW) {
            const int l = it / I_L; int r = it % I_L;
            if (r < I_IN) { transpose_item<true>(a.w_in + (size_t)l * 1024 * NPROJ, 1024, NPROJ, (bf16_t*)(ws + WS_WIN) + (size_t)l * NPROJ * 1024, scr, r, lane); continue; } r -= I_IN;
            if (r < I_BR) { transpose_item<false>(a.wbr_a + (size_t)l * 512 * 1024, 512, 1024, (bf16_t*)(ws + WS_WBA) + (size_t)l * 1024 * 512, scr, r, lane); continue; } r -= I_BR;
            if (r < I_BR) { transpose_item<false>(a.wbr_b + (size_t)l * 512 * 1024, 512, 1024, (bf16_t*)(ws + WS_WBB) + (size_t)l * 1024 * 512, scr, r, lane); continue; } r -= I_BR;
            if (r < I_OUT) { transpose_item<false>(a.w_out + (size_t)l * 1024 * 1024, 1024, 1024, (bf16_t*)(ws + WS_WOUT) + (size_t)l * 1024 * 1024, scr, r, lane); continue; } r -= I_OUT;
            transpose_item<false>(a.wq + (size_t)l * 1024 * PQ, 1024, PQ, (bf16_t*)(ws + WS_WQ) + (size_t)l * PQ * 1024, scr, r, lane);
        }
    }
    {
        const int gt = op_bid() * NTHREADS + tid, NGT = G * NTHREADS;
        for (int i = gt; i < DEPTH * 8 * 2 * 128 * 128 / 8; i += NGT) {
            const f32x4 v0 = *(const f32x4*)(a.subkeys + (size_t)i * 8), v1 = *(const f32x4*)(a.subkeys + (size_t)i * 8 + 4);
            u32x4 o; o.x = pk2(v0.x, v0.y); o.y = pk2(v0.z, v0.w); o.z = pk2(v1.x, v1.y); o.w = pk2(v1.z, v1.w);
            *(u32x4*)((bf16_t*)(ws + WS_SK) + (size_t)i * 8) = o;
        }
        for (int i = gt; i < T * 32; i += NGT) {
            const int t = i >> 5, f = i & 31;
            double inv = 1.0;
            for (int k = 0; k < f; ++k) inv *= 0.7498942093324559;
            const double ang = (double)a.pos[t] * inv;
            const double kq = rint(ang * 0.63661977236758134308);
            const double r = fma(-kq, 6.123233995736766036e-17, fma(-kq, 1.57079632679489655800, ang));
            const int quad = (int)((long long)kq & 3);
            const double r2 = r * r;
            double sp = -1.0 / 1307674368000.0; sp = fma(sp, r2, 1.0 / 6227020800.0); sp = fma(sp, r2, -1.0 / 39916800.0); sp = fma(sp, r2, 1.0 / 362880.0);
            sp = fma(sp, r2, -1.0 / 5040.0); sp = fma(sp, r2, 1.0 / 120.0); sp = fma(sp, r2, -1.0 / 6.0); sp = fma(sp * r2, r, r);
            double cp = 1.0 / 20922789888000.0; cp = fma(cp, r2, -1.0 / 87178291200.0); cp = fma(cp, r2, 1.0 / 479001600.0); cp = fma(cp, r2, -1.0 / 3628800.0);
            cp = fma(cp, r2, 1.0 / 40320.0); cp = fma(cp, r2, -1.0 / 720.0); cp = fma(cp, r2, 1.0 / 24.0); cp = fma(cp, r2, -0.5); cp = fma(cp, r2, 1.0);
            const double sn = (quad == 0) ? sp : (quad == 1) ? cp : (quad == 2) ? -sp : -cp;
            const double cs = (quad == 0) ? cp : (quad == 1) ? -sp : (quad == 2) ? -cp : sp;
            float* rp = (float*)(ws + WS_ROPE) + (size_t)i * 2; rp[0] = (float)cs; rp[1] = (float)sn;
        }
    }
    for (int r = gw; r < DEPTH * 2 * NEXP; r += NGW) {
        const int tbl = r / (DEPTH * NEXP), lr = r % (DEPTH * NEXP);
        const float* src = (tbl == 0 ? a.pu : a.pv) + (size_t)lr * 1024;
        f32x4 v[4];
        if (tbl == 0) {
#pragma unroll
            for (int i = 0; i < 4; ++i) v[i] = ((const f32x4*)src)[64 * i + lane];
            quant_row<false>(v, ws + WS_UQ + (size_t)lr * 1024, (float*)(ws + WS_USC) + lr, lane);
        } else {
#pragma unroll
            for (int i = 0; i < 4; ++i) v[i] = ((const f32x4*)src)[4 * lane + i];
            const int l = lr / NEXP, e = lr % NEXP;
            quant_row<false>(v, ws + WS_VQ + (size_t)l * NEXP * 1024 + ((size_t)(lane >> 3) * NEXP + e) * 128 + 16 * (lane & 7) - 16 * lane, (float*)(ws + WS_VSC) + lr, lane);
        }
    }
    if (op_bid() == 0) for (int i = tid; i < DEPTH * 2 * 8 * 64; i += NTHREADS) ((unsigned*)(ws + WS_CTL))[CTL_QUEUE + i] = 0u;
}

template <bool WITH_Q8>
__device__ __forceinline__ void ph_norm(const KArgs& a, const float* xin, const float* g, const float* mod_l, int shift_idx, int scale_idx, int wv) {
    const int tid = phase_tid(wv), lane = tid & 63, wave = wv;
    const int gw = op_bid() * NWAVES + wave, NGW = op_grid() * NWAVES;
    bf16_t* H = (bf16_t*)(a.ws + WS_H);
    for (int row = gw; row < T; row += NGW) {
        const int b = row >> 12;
        f32x4 v[4]; float ss = 0.f;
#pragma unroll
        for (int i = 0; i < 4; ++i) { v[i] = ((const f32x4*)(xin + (size_t)row * DM))[64 * i + lane]; ss += (v[i].x * v[i].x + v[i].y * v[i].y) + (v[i].z * v[i].z + v[i].w * v[i].w); }
        ss = wave_sum(ss);
        const float r = 1.0f / sqrtf(ss * (1.0f / DM) + NORM_EPS);
#pragma unroll
        for (int i = 0; i < 4; ++i) {
            const int col = 256 * i + 4 * lane;
            const f32x4 gg = *(const f32x4*)(g + col), sc = *(const f32x4*)(mod_l + (size_t)b * NMOD + scale_idx * DM + col), sh = *(const f32x4*)(mod_l + (size_t)b * NMOD + shift_idx * DM + col);
            v[i] = (v[i] * r) * gg * (sc + 1.0f) + sh;
            u32x2 o; o.x = pk2(v[i].x, v[i].y); o.y = pk2(v[i].z, v[i].w);
            *(u32x2*)(H + (size_t)row * DM + col) = o;
        }
        if (WITH_Q8) quant_row<false>(v, a.ws + WS_H2Q + (size_t)row * 1024, (float*)(a.ws + WS_HS) + row, lane);
    }
}
__device__ __forceinline__ void ph_final_norm(const KArgs& a, int wv) {
    const int tid = phase_tid(wv), lane = tid & 63, wave = wv;
    const int gw = op_bid() * NWAVES + wave, NGW = op_grid() * NWAVES;
    for (int row = gw; row < T; row += NGW) {
        f32x4 v[4]; float ss = 0.f;
#pragma unroll
        for (int i = 0; i < 4; ++i) { v[i] = ((const f32x4*)(a.out + (size_t)row * DM))[64 * i + lane]; ss += (v[i].x * v[i].x + v[i].y * v[i].y) + (v[i].z * v[i].z + v[i].w * v[i].w); }
        ss = wave_sum(ss);
        const float r = 1.0f / sqrtf(ss * (1.0f / DM) + NORM_EPS);
#pragma unroll
        for (int i = 0; i < 4; ++i) { const f32x4 gg = *(const f32x4*)(a.final_g + 256 * i + 4 * lane); ((f32x4*)(a.out + (size_t)row * DM))[64 * i + lane] = (v[i] * r) * gg; }
    }
}

struct EpiProj {
    static constexpr bool PERM = true, AFTER_DRAIN = false;
    unsigned char* ws;
    __device__ __forceinline__ void operator()(const pg8::f32x4 (&acc)[2][2][4][2], const pg8::Unit& u, int wr, int wc, int fr, int fq) const {
        const int row0 = u.pm * 256 + wr * 64 + fr;
        const float* rope = (const float*)(ws + WS_ROPE);
#pragma unroll
        for (int bj = 0; bj < 2; ++bj) {
            const int cgb = u.pn * 256 + bj * 128;
            bf16_t* base; int pitch, cl, mode;
            if (cgb < 512) { base = (bf16_t*)(ws + WS_QA); pitch = 512; cl = cgb; mode = 1; }
            else if (cgb < 640) { base = (bf16_t*)(ws + WS_KA); pitch = 128; cl = cgb - 512; mode = 2; }
            else if (cgb < 768) { base = (bf16_t*)(ws + WS_VA); pitch = 128; cl = cgb - 640; mode = 0; }
            else if (cgb < 1280) { base = (bf16_t*)(ws + WS_QB); pitch = 512; cl = cgb - 768; mode = 3; }
            else if (cgb < 1792) { base = (bf16_t*)(ws + WS_KB); pitch = 512; cl = cgb - 1280; mode = 0; }
            else if (cgb < 2304) { base = (bf16_t*)(ws + WS_VB); pitch = 512; cl = cgb - 1792; mode = 0; }
            else if (cgb < 3328) { base = (bf16_t*)(ws + WS_GA); pitch = 1024; cl = cgb - 2304; mode = 4; }
            else { base = (bf16_t*)(ws + WS_GB); pitch = 1024; cl = cgb - 3328; mode = 4; }
            const int col = cl + wc * 32 + 8 * fq;
#pragma unroll
            for (int ai = 0; ai < 2; ++ai)
#pragma unroll
                for (int m = 0; m < 4; ++m) {
                    const int row = row0 + ai * 128 + m * 16;
                    pg8::f32x4 v0 = acc[ai][bj][m][0], v1 = acc[ai][bj][m][1];
                    if (mode == 1 || mode == 2) {
                        const int i0 = (col & 63) >> 1;
                        const f32x4 c01 = *(const f32x4*)(rope + ((size_t)row * 32 + i0) * 2), c23 = *(const f32x4*)(rope + ((size_t)row * 32 + i0 + 2) * 2);
                        pg8::f32x4 w0, w1;
                        w0[0] = v0[0] * c01.x - v0[1] * c01.y; w0[1] = v0[1] * c01.x + v0[0] * c01.y;
                        w0[2] = v0[2] * c01.z - v0[3] * c01.w; w0[3] = v0[3] * c01.z + v0[2] * c01.w;
                        w1[0] = v1[0] * c23.x - v1[1] * c23.y; w1[1] = v1[1] * c23.x + v1[0] * c23.y;
                        w1[2] = v1[2] * c23.z - v1[3] * c23.w; w1[3] = v1[3] * c23.z + v1[2] * c23.w;
                        v0 = w0; v1 = w1;
                    }
                    if (mode == 1 || mode == 3) { v0 = v0 * QSCALE; v1 = v1 * QSCALE; }
                    if (mode == 4) {
#pragma unroll
                        for (int e = 0; e < 4; ++e) { v0[e] = 1.0f / (1.0f + __expf(-v0[e])); v1[e] = 1.0f / (1.0f + __expf(-v1[e])); }
                    }
                    u32x4 w; w.x = pk2(v0[0], v0[1]); w.y = pk2(v0[2], v0[3]); w.z = pk2(v1[0], v1[1]); w.w = pk2(v1[2], v1[3]);
                    *(u32x4*)(base + (size_t)row * pitch + col) = w;
                }
        }
    }
};
template <bool ADD> struct EpiBranch {
    static constexpr bool PERM = true, AFTER_DRAIN = false;
    const bf16_t* Gt; bf16_t* O;
    __device__ __forceinline__ void operator()(const pg8::f32x4 (&acc)[2][2][4][2], const pg8::Unit& u, int wr, int wc, int fr, int fq) const {
        const int row0 = u.pm * 256 + wr * 64 + fr, col0 = u.pn * 256 + wc * 32 + 8 * fq;
#pragma unroll
        for (int ai = 0; ai < 2; ++ai)
#pragma unroll
            for (int m = 0; m < 4; ++m)
#pragma unroll
                for (int bj = 0; bj < 2; ++bj) {
                    const size_t off = (size_t)(row0 + ai * 128 + m * 16) * DM + col0 + bj * 128;
                    const u32x4 gv = *(const u32x4*)(Gt + off);
                    const pg8::f32x4 v0 = acc[ai][bj][m][0], v1 = acc[ai][bj][m][1];
                    float r[8];
                    r[0] = bflo(gv.x) * v0[0]; r[1] = bfhi(gv.x) * v0[1]; r[2] = bflo(gv.y) * v0[2]; r[3] = bfhi(gv.y) * v0[3];
                    r[4] = bflo(gv.z) * v1[0]; r[5] = bfhi(gv.z) * v1[1]; r[6] = bflo(gv.w) * v1[2]; r[7] = bfhi(gv.w) * v1[3];
                    if (ADD) { const u32x4 ov = *(const u32x4*)(O + off);
                        r[0] += bflo(ov.x); r[1] += bfhi(ov.x); r[2] += bflo(ov.y); r[3] += bfhi(ov.y); r[4] += bflo(ov.z); r[5] += bfhi(ov.z); r[6] += bflo(ov.w); r[7] += bfhi(ov.w); }
                    u32x4 w; w.x = pk2(r[0], r[1]); w.y = pk2(r[2], r[3]); w.z = pk2(r[4], r[5]); w.w = pk2(r[6], r[7]);
                    *(u32x4*)(O + off) = w;
                }
    }
};
struct EpiWout {
    static constexpr bool PERM = false, AFTER_DRAIN = false;
    const float* xold; float* xnew; const float* gate;
    __device__ __forceinline__ void operator()(const pg8::f32x4 (&acc)[2][2][4][2], const pg8::Unit& u, int wr, int wc, int fr, int fq) const {
        const int row0 = u.pm * 256 + wr * 64 + fr, col0 = u.pn * 256 + wc * 32 + 4 * fq, b = u.pm >> 4;
#pragma unroll
        for (int bj = 0; bj < 2; ++bj)
#pragma unroll
            for (int n = 0; n < 2; ++n) {
                const pg8::f32x4 gv = *(const pg8::f32x4*)(gate + (size_t)b * NMOD + col0 + bj * 128 + n * 16);
#pragma unroll
                for (int ai = 0; ai < 2; ++ai)
#pragma unroll
                    for (int m = 0; m < 4; ++m) { const size_t off = (size_t)(row0 + ai * 128 + m * 16) * DM + col0 + bj * 128 + n * 16;
                        const pg8::f32x4 xo = *(const pg8::f32x4*)(xold + off);
                        *(pg8::f32x4*)(xnew + off) = xo + gv * acc[ai][bj][m][n]; }
            }
    }
};
struct EpiPlainBf16 {
    static constexpr bool PERM = true, AFTER_DRAIN = false;
    bf16_t* O; int ldc;
    __device__ __forceinline__ void operator()(const pg8::f32x4 (&acc)[2][2][4][2], const pg8::Unit& u, int wr, int wc, int fr, int fq) const {
        const int row0 = u.pm * 256 + wr * 64 + fr, col0 = u.pn * 256 + wc * 32 + 8 * fq;
#pragma unroll
        for (int ai = 0; ai < 2; ++ai)
#pragma unroll
            for (int m = 0; m < 4; ++m)
#pragma unroll
                for (int bj = 0; bj < 2; ++bj) {
                    const pg8::f32x4 v0 = acc[ai][bj][m][0], v1 = acc[ai][bj][m][1];
                    u32x4 w; w.x = pk2(v0[0], v0[1]); w.y = pk2(v0[2], v0[3]); w.z = pk2(v1[0], v1[1]); w.w = pk2(v1[2], v1[3]);
                    *(u32x4*)(O + (size_t)(row0 + ai * 128 + m * 16) * ldc + col0 + bj * 128) = w;
                }
    }
};

namespace att {
typedef short bf16x8 __attribute__((ext_vector_type(8)));
typedef short s16x4 __attribute__((ext_vector_type(4)));
typedef float f32x16 __attribute__((ext_vector_type(16)));
__device__ __forceinline__ int crow(int r, int hi) { return (r & 3) + 8 * (r >> 2) + 4 * hi; }
typedef float f32x2_t __attribute__((ext_vector_type(2))); typedef __bf16 bf16x2_t __attribute__((ext_vector_type(2)));
__device__ __forceinline__ unsigned cvtpk(float lo, float hi) { f32x2_t v = {lo, hi}; bf16x2_t b = __builtin_convertvector(v, bf16x2_t); return __builtin_bit_cast(unsigned, b); }
#define ATT_SBAR() __builtin_amdgcn_sched_barrier(0)

__device__ __forceinline__ void qkt(f32x16& p0, f32x16& p1, const LAS unsigned char* kslot, const bf16x8 (&qr)[4], int r32, int hi) {
    const LAS unsigned char* kb = kslot + hi * 1024 + r32 * 16;
    p0 = f32x16{}; p1 = f32x16{};
#pragma unroll
    for (int d0 = 0; d0 < 4; ++d0) {
        const bf16x8 b0 = *(const LAS bf16x8*)(kb + d0 * 2048);
        const bf16x8 b1 = *(const LAS bf16x8*)(kb + d0 * 2048 + 512);
        p0 = __builtin_amdgcn_mfma_f32_32x32x16_bf16(b0, qr[d0], p0, 0, 0, 0);
        p1 = __builtin_amdgcn_mfma_f32_32x32x16_bf16(b1, qr[d0], p1, 0, 0, 0);
    }
}
__device__ __forceinline__ void pv(f32x16 (&o)[2], int vb, bf16x8 pa0, bf16x8 pa1, bf16x8 pa2, bf16x8 pa3) {
#pragma unroll
    for (int d0 = 0; d0 < 2; ++d0) {
        s16x4 lo[4], hh[4];
#pragma unroll
        for (int ks = 0; ks < 4; ++ks) {
            asm volatile("ds_read_b64_tr_b16 %0,%1 offset:%c2" : "=&v"(lo[ks]) : "v"(vb), "i"(d0 * 4096 + ks * 1024) : "memory");
            asm volatile("ds_read_b64_tr_b16 %0,%1 offset:%c2" : "=&v"(hh[ks]) : "v"(vb), "i"(d0 * 4096 + ks * 1024 + 512) : "memory");
        }
        asm volatile("s_waitcnt lgkmcnt(0)" ::: "memory"); ATT_SBAR();
#define ATT_PK(k) (bf16x8){lo[k][0], lo[k][1], lo[k][2], lo[k][3], hh[k][0], hh[k][1], hh[k][2], hh[k][3]}
        o[d0] = __builtin_amdgcn_mfma_f32_32x32x16_bf16(pa0, ATT_PK(0), o[d0], 0, 0, 0);
        o[d0] = __builtin_amdgcn_mfma_f32_32x32x16_bf16(pa1, ATT_PK(1), o[d0], 0, 0, 0);
        o[d0] = __builtin_amdgcn_mfma_f32_32x32x16_bf16(pa2, ATT_PK(2), o[d0], 0, 0, 0);
        o[d0] = __builtin_amdgcn_mfma_f32_32x32x16_bf16(pa3, ATT_PK(3), o[d0], 0, 0, 0);
#undef ATT_PK
    }
}
__device__ __forceinline__ void pack_p(const f32x16& p0, const f32x16& p1, bf16x8& pa0, bf16x8& pa1, bf16x8& pa2, bf16x8& pa3) {
    u32x4 w0, w1, w2, w3;
    w0 = (u32x4){cvtpk(p0[0], p0[1]), cvtpk(p0[2], p0[3]), cvtpk(p0[4], p0[5]), cvtpk(p0[6], p0[7])};
    w1 = (u32x4){cvtpk(p0[8], p0[9]), cvtpk(p0[10], p0[11]), cvtpk(p0[12], p0[13]), cvtpk(p0[14], p0[15])};
    w2 = (u32x4){cvtpk(p1[0], p1[1]), cvtpk(p1[2], p1[3]), cvtpk(p1[4], p1[5]), cvtpk(p1[6], p1[7])};
    w3 = (u32x4){cvtpk(p1[8], p1[9]), cvtpk(p1[10], p1[11]), cvtpk(p1[12], p1[13]), cvtpk(p1[14], p1[15])};
    pa0 = __builtin_bit_cast(bf16x8, w0); pa1 = __builtin_bit_cast(bf16x8, w1); pa2 = __builtin_bit_cast(bf16x8, w2); pa3 = __builtin_bit_cast(bf16x8, w3);
}
__device__ __forceinline__ u32x4 tile_gload(const bf16_t* src, int pitch, int tid) { return *(const u32x4*)(src + (size_t)(tid >> 3) * pitch + (tid & 7) * 8); }
__device__ __forceinline__ void tile_kwrite(LAS unsigned char* kslot, u32x4 v, int tid) { *(LAS u32x4*)(kslot + (tid & 7) * 1024 + (tid >> 3) * 16) = v; }
__device__ __forceinline__ void tile_vwrite(LAS unsigned char* vslot, u32x4 v, int tid) { const int c = tid & 7; *(LAS u32x4*)(vslot + (c >> 2) * 4096 + (tid >> 3) * 64 + (c & 3) * 16) = v; }
__device__ __forceinline__ void store_o(const f32x16 (&o)[2], const float (&rs)[16], LAS unsigned char* stage, bf16_t* Ow, int pitch, int lane) {
    asm volatile("" : "+v"(lane));
    const int r32 = lane & 31, hi = lane >> 5;
    LAS bf16_t* stg = (LAS bf16_t*)stage;
#pragma unroll
    for (int r = 0; r < 16; ++r) { const int orow = crow(r, hi);
#pragma unroll
        for (int d0 = 0; d0 < 2; ++d0) stg[orow * 64 + d0 * 32 + r32] = (bf16_t)f2bf(o[d0][r] * rs[r]); }
    asm volatile("s_waitcnt lgkmcnt(0)" ::: "memory");
#pragma unroll
    for (int i = 0; i < 4; ++i) { const int row = i * 8 + (lane >> 3), ch = lane & 7; const u32x4 v = *(const LAS u32x4*)(stg + row * 64 + ch * 8); *(u32x4*)(Ow + (size_t)row * pitch + ch * 8) = v; }
    asm volatile("s_waitcnt lgkmcnt(0)" ::: "memory");
}

constexpr int SB_WLDS = 8192;
template <bool EARLY_EXIT>
__device__ __forceinline__ void sb_phase(const bf16_t* Q, const bf16_t* K, const bf16_t* V, bf16_t* O, LAS unsigned char* lds, int wv) {
    const int tid = phase_tid(wv), lane = tid & 63, r32 = lane & 31, hi = lane >> 5, wid = wv;
    LAS unsigned char* vimg = lds + wid * SB_WLDS;
    const int vb0 = (int)(unsigned)(uintptr_t)vimg + ((lane >> 4) & 1) * 32 + (lane & 3) * 8 + (4 * hi + ((lane & 15) >> 2)) * 64;
    const int vwoff = ((lane & 7) >> 2) * 4096 + (lane >> 3) * 64 + (lane & 3) * 16;
    const float m0 = hi == 0 ? 1.0f : 0.0f;
    const int gw = op_bid() * NWAVES + wid, NGW = op_grid() * NWAVES;
    for (int wu = gw; wu < BATCH * 8 * (SEQ / 32); wu += NGW) {
        const int rb = wu & 127, h = (wu >> 7) & 7, b = wu >> 10;
        const int R0 = rb * 32;
        const size_t rowbase = (size_t)b * SEQ;
        const char* Kb = (const char*)(K + rowbase * 512 + h * 64); const char* Vb = (const char*)(V + rowbase * 512 + h * 64);
        const unsigned koff = (unsigned)(r32 * 1024 + hi * 16), voff = (unsigned)((lane >> 3) * 1024 + (lane & 7) * 16);
        const bf16_t* Qw = Q + (rowbase + R0) * 512 + h * 64;
        bf16x8 qr[4];
#pragma unroll
        for (int d0 = 0; d0 < 4; ++d0) qr[d0] = *(const bf16x8*)((const char*)Qw + koff + d0 * 32);
        int kt = R0 >> 6;
        bf16x8 kf[8]; u32x4 vr[8];
#define SB_LOADK(KT) do { const char* k0_ = Kb + (size_t)(KT) * 65536; const char* k1_ = k0_ + 32768; _Pragma("unroll") for (int d0 = 0; d0 < 4; ++d0) { kf[2 * d0] = *(const bf16x8*)(k0_ + koff + d0 * 32); kf[2 * d0 + 1] = *(const bf16x8*)(k1_ + koff + d0 * 32); } } while (0)
#define SB_LOADV(KT) do { const char* v0_ = Vb + (size_t)(KT) * 65536; _Pragma("unroll") for (int i = 0; i < 8; ++i) vr[i] = *(const u32x4*)(v0_ + i * 8192 + voff); } while (0)
        SB_LOADK(kt); SB_LOADV(kt);
        f32x16 o[2]; o[0] = f32x16{}; o[1] = f32x16{};
        float carry = 0.f;
        for (;;) {
            f32x16 p0 = f32x16{}, p1 = f32x16{};
#pragma unroll
            for (int d0 = 0; d0 < 4; ++d0) { p0 = __builtin_amdgcn_mfma_f32_32x32x16_bf16(kf[2 * d0], qr[d0], p0, 0, 0, 0); p1 = __builtin_amdgcn_mfma_f32_32x32x16_bf16(kf[2 * d0 + 1], qr[d0], p1, 0, 0, 0); }
            const bool more = kt > 0;
#pragma unroll
            for (int i = 0; i < 8; ++i) *(LAS u32x4*)(vimg + vwoff + i * 512) = vr[i];
            const int D = R0 - 64 * kt;
            if (D < 64) {
                const int thr = D + r32 - 4 * hi;
#pragma unroll
                for (int r = 0; r < 16; ++r) { const int cr = (r & 3) + 8 * (r >> 2); if (cr >= thr) p0[r] = -INFINITY; if (cr + 32 >= thr) p1[r] = -INFINITY; }
            }
            float tt[8], uu[8];
#define SB_SP(x) (fmaxf(x, 0.f) + __builtin_amdgcn_logf(1.0f + __builtin_amdgcn_exp2f(-fabsf(x))))
#pragma unroll
            for (int i = 0; i < 4; ++i) {
                float s3 = SB_SP(p0[4 * i + 3]), s2 = s3 + SB_SP(p0[4 * i + 2]), s1 = s2 + SB_SP(p0[4 * i + 1]), s0 = s1 + SB_SP(p0[4 * i]);
                p0[4 * i + 3] -= s3; p0[4 * i + 2] -= s2; p0[4 * i + 1] -= s1; p0[4 * i] -= s0; tt[i] = s0;
                s3 = SB_SP(p1[4 * i + 3]); s2 = s3 + SB_SP(p1[4 * i + 2]); s1 = s2 + SB_SP(p1[4 * i + 1]); s0 = s1 + SB_SP(p1[4 * i]);
                p1[4 * i + 3] -= s3; p1[4 * i + 2] -= s2; p1[4 * i + 1] -= s1; p1[4 * i] -= s0; tt[4 + i] = s0;
                __builtin_amdgcn_sched_barrier(0);
            }
#undef SB_SP
#pragma unroll
            for (int k = 0; k < 8; ++k) { auto rr = __builtin_amdgcn_permlane32_swap(__float_as_uint(tt[k]), __float_as_uint(tt[k]), false, false); uu[k] = __uint_as_float(hi ? rr[0] : rr[1]); }
            float sw = 0.f;
#pragma unroll
            for (int k = 7; k >= 0; --k) {
                const float bs = carry - (sw + m0 * uu[k]); sw += tt[k] + uu[k];
                if (k < 4) { p0[4 * k] = __builtin_amdgcn_exp2f(p0[4 * k] + bs); p0[4 * k + 1] = __builtin_amdgcn_exp2f(p0[4 * k + 1] + bs); p0[4 * k + 2] = __builtin_amdgcn_exp2f(p0[4 * k + 2] + bs); p0[4 * k + 3] = __builtin_amdgcn_exp2f(p0[4 * k + 3] + bs); }
                else { const int i = k - 4; p1[4 * i] = __builtin_amdgcn_exp2f(p1[4 * i] + bs); p1[4 * i + 1] = __builtin_amdgcn_exp2f(p1[4 * i + 1] + bs); p1[4 * i + 2] = __builtin_amdgcn_exp2f(p1[4 * i + 2] + bs); p1[4 * i + 3] = __builtin_amdgcn_exp2f(p1[4 * i + 3] + bs); }
            }
            carry -= sw;
            bf16x8 pa0, pa1, pa2, pa3; pack_p(p0, p1, pa0, pa1, pa2, pa3);
            if (more) { SB_LOADK(kt - 1); SB_LOADV(kt - 1); }
            pv(o, vb0, pa0, pa1, pa2, pa3);
            if (!more) break;
            if (EARLY_EXIT && __all(carry < -SB_EXIT)) break;
            --kt;
        }
        float ones[16];
#pragma unroll
        for (int r = 0; r < 16; ++r) ones[r] = 1.0f;
        store_o(o, ones, vimg, O + (rowbase + R0) * 512 + h * 64, 512, phase_tid(wv) & 63);
    }
#undef SB_LOADK
#undef SB_LOADV
}

constexpr int SW_K0 = 0, SW_V0 = 24576, SW_STAGE = 49152, SW_WSF = 81920, SW_LDS_END = 81920 + 2048;
__device__ __forceinline__ void swa_phase(const bf16_t* Q, const bf16_t* K, const bf16_t* V, bf16_t* O, const float* sinks, LAS unsigned char* lds, int wv) {
        const int tid = phase_tid(wv), lane = tid & 63, r32 = lane & 31, hi = lane >> 5, wid = wv;
    const int vb0 = (int)(unsigned)(uintptr_t)(lds + SW_V0) + ((lane >> 4) & 1) * 32 + (lane & 3) * 8 + (4 * hi + ((lane & 15) >> 2)) * 64;
    LAS float* wsf = (LAS float*)(lds + SW_WSF) + wid * 64;
    const int g = wid >> 1, j = wid & 1;
    for (int unit = op_bid(); unit < BATCH * 2 * 64; unit += op_grid()) {
        const int qb = unit & 63, kvh = (unit >> 6) & 1, b = unit >> 7;
        const int q0 = qb * 64, hq = kvh * 4 + g;
        const size_t rowbase = (size_t)b * SEQ;
        const bf16_t* Kh = K + rowbase * 128 + kvh * 64; const bf16_t* Vh = V + rowbase * 128 + kvh * 64;
        const bf16_t* Qw = Q + (rowbase + q0 + j * 32) * 512 + hq * 64;
        __syncthreads();
#pragma unroll
        for (int i = 0; i < 3; ++i) { const int kt = qb - 2 + i;
            if (kt >= 0) { const u32x4 kv = tile_gload(Kh + (size_t)kt * 64 * 128, 128, tid), vv = tile_gload(Vh + (size_t)kt * 64 * 128, 128, tid);
                tile_kwrite(lds + SW_K0 + i * 8192, kv, tid); tile_vwrite(lds + SW_V0 + i * 8192, vv, tid); } }
        bf16x8 qr[4];
#pragma unroll
        for (int d0 = 0; d0 < 4; ++d0) qr[d0] = *(const bf16x8*)(Qw + (size_t)r32 * 512 + d0 * 16 + hi * 8);
        __syncthreads();
        const int qrel4 = 32 * j + r32 - 4 * hi;
        const float sink2 = sinks[hq] * LOG2E;
        float m = sink2;
#pragma unroll
        for (int i = 0; i < 3; ++i) {
            if (qb - 2 + i >= 0) {
                f32x16 p0, p1;
                qkt(p0, p1, lds + SW_K0 + i * 8192, qr, r32, hi);
#pragma unroll
                for (int r = 0; r < 16; ++r) { const int kv = (r & 3) + 8 * (r >> 2);
                    bool v0 = true, v1 = true;
                    if (i == 2) { v0 = kv <= qrel4; v1 = kv + 32 <= qrel4; }
                    if (i == 0) { v0 = kv > qrel4; v1 = kv + 32 > qrel4; }
                    m = fmaxf(m, fmaxf(v0 ? p0[r] : -INFINITY, v1 ? p1[r] : -INFINITY)); }
            }
        }
        { auto rr = __builtin_amdgcn_permlane32_swap(__float_as_uint(m), __float_as_uint(m), false, false); m = fmaxf(__uint_as_float(rr[0]), __uint_as_float(rr[1])); }
        float lsum = 0.f;
        f32x16 o[2]; o[0] = f32x16{}; o[1] = f32x16{};
#pragma unroll
        for (int i = 0; i < 3; ++i) {
            if (qb - 2 + i >= 0) {
                f32x16 p0, p1;
                qkt(p0, p1, lds + SW_K0 + i * 8192, qr, r32, hi);
#pragma unroll
                for (int r = 0; r < 16; ++r) { const int kv = (r & 3) + 8 * (r >> 2);
                    bool v0 = true, v1 = true;
                    if (i == 2) { v0 = kv <= qrel4; v1 = kv + 32 <= qrel4; }
                    if (i == 0) { v0 = kv > qrel4; v1 = kv + 32 > qrel4; }
                    p0[r] = v0 ? exp2f(p0[r] - m) : 0.f; p1[r] = v1 ? exp2f(p1[r] - m) : 0.f; lsum += p0[r] + p1[r]; }
                bf16x8 pa0, pa1, pa2, pa3; pack_p(p0, p1, pa0, pa1, pa2, pa3); pv(o, vb0 + i * 8192, pa0, pa1, pa2, pa3);
            }
        }
        { auto rr = __builtin_amdgcn_permlane32_swap(__float_as_uint(lsum), __float_as_uint(lsum), false, false); lsum = __uint_as_float(rr[0]) + __uint_as_float(rr[1]); }
        lsum += exp2f(sink2 - m);
        if (hi == 0) wsf[r32] = 1.0f / lsum;
        asm volatile("s_waitcnt lgkmcnt(0)" ::: "memory");
        float rs[16];
#pragma unroll
        for (int r = 0; r < 16; ++r) rs[r] = wsf[crow(r, hi)];
        asm volatile("s_waitcnt lgkmcnt(0)" ::: "memory");
        store_o(o, rs, lds + SW_STAGE + wid * 4096, O + (rowbase + q0 + j * 32) * 512 + hq * 64, 512, lane);
    }
}
#undef ATT_SBAR
}

namespace tk {
typedef short bf16x8 __attribute__((ext_vector_type(8)));
typedef float f32x16 __attribute__((ext_vector_type(16)));
__device__ __forceinline__ float vmax(float a, float b) { float r; asm("v_max_f32 %0, %1, %2" : "=v"(r) : "v"(a), "v"(b)); return r; }
__device__ __forceinline__ float vmin(float a, float b) { float r; asm("v_min_f32 %0, %1, %2" : "=v"(r) : "v"(a), "v"(b)); return r; }
#define TK_CE(a, b) { const float t_ = vmax(a, b); b = vmin(a, b); a = t_; }
__device__ __forceinline__ void sort16(float (&v)[16]) {
    TK_CE(v[0], v[1]) TK_CE(v[2], v[3]) TK_CE(v[0], v[2]) TK_CE(v[1], v[3]) TK_CE(v[1], v[2]) TK_CE(v[4], v[5]) TK_CE(v[6], v[7]) TK_CE(v[4], v[6])
    TK_CE(v[5], v[7]) TK_CE(v[5], v[6]) TK_CE(v[0], v[4]) TK_CE(v[2], v[6]) TK_CE(v[2], v[4]) TK_CE(v[1], v[5]) TK_CE(v[3], v[7]) TK_CE(v[3], v[5])
    TK_CE(v[1], v[2]) TK_CE(v[3], v[4]) TK_CE(v[5], v[6]) TK_CE(v[8], v[9]) TK_CE(v[10], v[11]) TK_CE(v[8], v[10]) TK_CE(v[9], v[11]) TK_CE(v[9], v[10])
    TK_CE(v[12], v[13]) TK_CE(v[14], v[15]) TK_CE(v[12], v[14]) TK_CE(v[13], v[15]) TK_CE(v[13], v[14]) TK_CE(v[8], v[12]) TK_CE(v[10], v[14]) TK_CE(v[10], v[12])
    TK_CE(v[9], v[13]) TK_CE(v[11], v[15]) TK_CE(v[11], v[13]) TK_CE(v[9], v[10]) TK_CE(v[11], v[12]) TK_CE(v[13], v[14]) TK_CE(v[0], v[8]) TK_CE(v[4], v[12])
    TK_CE(v[4], v[8]) TK_CE(v[2], v[10]) TK_CE(v[6], v[14]) TK_CE(v[6], v[10]) TK_CE(v[2], v[4]) TK_CE(v[6], v[8]) TK_CE(v[10], v[12]) TK_CE(v[1], v[9])
    TK_CE(v[5], v[13]) TK_CE(v[5], v[9]) TK_CE(v[3], v[11]) TK_CE(v[7], v[15]) TK_CE(v[7], v[11]) TK_CE(v[3], v[5]) TK_CE(v[7], v[9]) TK_CE(v[11], v[13])
    TK_CE(v[1], v[2]) TK_CE(v[3], v[4]) TK_CE(v[5], v[6]) TK_CE(v[7], v[8]) TK_CE(v[9], v[10]) TK_CE(v[11], v[12]) TK_CE(v[13], v[14])
}
__device__ __forceinline__ void bmerge16(float (&v)[16]) {
    TK_CE(v[0], v[8]) TK_CE(v[1], v[9]) TK_CE(v[2], v[10]) TK_CE(v[3], v[11]) TK_CE(v[4], v[12]) TK_CE(v[5], v[13]) TK_CE(v[6], v[14]) TK_CE(v[7], v[15])
    TK_CE(v[0], v[4]) TK_CE(v[1], v[5]) TK_CE(v[2], v[6]) TK_CE(v[3], v[7]) TK_CE(v[8], v[12]) TK_CE(v[9], v[13]) TK_CE(v[10], v[14]) TK_CE(v[11], v[15])
    TK_CE(v[0], v[2]) TK_CE(v[1], v[3]) TK_CE(v[4], v[6]) TK_CE(v[5], v[7]) TK_CE(v[8], v[10]) TK_CE(v[9], v[11]) TK_CE(v[12], v[14]) TK_CE(v[13], v[15])
    TK_CE(v[0], v[1]) TK_CE(v[2], v[3]) TK_CE(v[4], v[5]) TK_CE(v[6], v[7]) TK_CE(v[8], v[9]) TK_CE(v[10], v[11]) TK_CE(v[12], v[13]) TK_CE(v[14], v[15])
}

__device__ __forceinline__ void merge_top16(float (&a)[16], const float (&b)[16]) {
#pragma unroll
    for (int i = 0; i < 16; ++i) a[i] = vmax(a[i], b[15 - i]);
    bmerge16(a);
}
__device__ __forceinline__ float partner_f(float v, int hi) { auto rr = __builtin_amdgcn_permlane32_swap(__float_as_uint(v), __float_as_uint(v), false, false); return __uint_as_float(hi ? rr[0] : rr[1]); }
__device__ __forceinline__ void merge_partner(float (&a)[16], int hi) {
    float pp[16];
#pragma unroll
    for (int i = 0; i < 16; ++i) pp[i] = partner_f(a[i], hi);
    merge_top16(a, pp);
}
__device__ __forceinline__ void take_block(float (&v)[16], const f32x16& acc, int blk, unsigned hi4) {
#pragma unroll
    for (int r = 0; r < 16; ++r) { const unsigned code = 127u - (unsigned)(32 * blk + (r & 3) + 8 * (r >> 2)); v[r] = __uint_as_float(((__float_as_uint(acc[r]) & 0xFFFFFF80u) | code) ^ hi4); }
    sort16(v);
}
constexpr int TK_SK = 0, TK_IDX = 65536, TK_LDS_END = 65536 + 8192;
constexpr float TK_NEG = -3.4028234663852886e38f;
template <int P>
__device__ __forceinline__ void half_top16(float (&L)[16], const bf16_t* qrow, LAS unsigned char* lds, LAS unsigned char* idxslot, int r32, int hi) {
    bf16x8 qf[8];
#pragma unroll
    for (int ks = 0; ks < 8; ++ks) qf[ks] = *(const bf16x8*)(qrow + P * 128 + 16 * ks + 8 * hi);
    f32x16 acc[4];
#pragma unroll
    for (int blk = 0; blk < 4; ++blk) acc[blk] = f32x16{};
    const LAS unsigned char* ab = lds + TK_SK + P * 32768 + hi * 2048 + r32 * 16;
#pragma unroll
    for (int ks = 0; ks < 8; ++ks)
#pragma unroll
        for (int blk = 0; blk < 4; ++blk) {
            const bf16x8 af = *(const LAS bf16x8*)(ab + ks * 4096 + blk * 512);
            acc[blk] = __builtin_amdgcn_mfma_f32_32x32x16_bf16(af, qf[ks], acc[blk], 0, 0, 0);
        }
    const unsigned hi4 = (unsigned)hi << 2;
    float M[16];
    take_block(L, acc[0], 0, hi4); take_block(M, acc[1], 1, hi4); merge_top16(L, M);
    { float N[16]; take_block(M, acc[2], 2, hi4); take_block(N, acc[3], 3, hi4); merge_top16(M, N); }
    merge_top16(L, M);
    merge_partner(L, hi);
    if (hi == 0) {
        u32x4 w;
#pragma unroll
        for (int q = 0; q < 4; ++q) w[q] = (__float_as_uint(L[4 * q]) & 127u) | ((__float_as_uint(L[4 * q + 1]) & 127u) << 8) | ((__float_as_uint(L[4 * q + 2]) & 127u) << 16) | ((__float_as_uint(L[4 * q + 3]) & 127u) << 24);
        *(LAS u32x4*)(idxslot + P * 16) = w;
    }
}
__device__ __forceinline__ float cand(float x, float y, unsigned code, unsigned hi8) { return __uint_as_float((__float_as_uint(x + y) & 0xFFFFFE00u) | code | hi8); }

__device__ __forceinline__ void topk_phase(const bf16_t* Q2, const bf16_t* SKl, int* IDX, float* GATE, LAS unsigned char* lds, int wv) {
        const int tid = phase_tid(wv), lane = tid & 63, r32 = lane & 31, hi = lane >> 5, wid = wv;
    LAS unsigned char* idxslot = lds + TK_IDX + wid * 1024 + r32 * 32;
    int cur_h = -1;
    for (int unit = op_bid(); unit < 8 * (T / 256); unit += op_grid()) {
        const int h = unit & 7, tb = unit >> 3;
        if (h != cur_h) {
            __syncthreads();
#pragma unroll
            for (int i = 0; i < 8; ++i) { const int id = tid + 512 * i, c = id & 15, n = (id >> 4) & 127, p = id >> 11;
                const u32x4 v = *(const u32x4*)(SKl + ((size_t)(h * 2 + p) * 128 + n) * 128 + c * 8);
                *(LAS u32x4*)(lds + TK_SK + p * 32768 + c * 2048 + n * 16) = v; }
            __syncthreads();
            cur_h = h;
        }
        const size_t token = (size_t)tb * 256 + wid * 32 + r32;
        const bf16_t* qrow = Q2 + token * PQ + h * 256;
        float a[16], b[16];
        half_top16<0>(a, qrow, lds, idxslot, r32, hi);
        half_top16<1>(b, qrow, lds, idxslot, r32, hi);
        float x[16], y[16];
#pragma unroll
        for (int i = 0; i < 16; ++i) { float av = a[i], bv = b[i]; asm volatile("" : "+v"(av), "+v"(bv)); x[i] = hi ? bv : av; y[i] = hi ? av : bv; }
        const unsigned hi8 = (unsigned)hi << 8;
        float A[16], B[16];
#pragma unroll
        for (int j = 1; j < 16; ++j) A[j - 1] = cand(x[0], y[j], (unsigned)j, hi8);
        A[15] = TK_NEG;
#pragma unroll
        for (int j = 2; j < 8; ++j) B[j - 2] = cand(x[1], y[j], (unsigned)(16 + j), hi8);
        B[6] = cand(x[2], y[3], 2u * 16u + 3u, hi8); B[7] = cand(x[2], y[4], 2u * 16u + 4u, hi8);
#pragma unroll
        for (int i = 0; i < 4; ++i) { const float d = cand(x[i], y[i], (unsigned)(17 * i), hi8); B[8 + i] = hi ? TK_NEG : d; }
        B[12] = TK_NEG; B[13] = TK_NEG; B[14] = TK_NEG; B[15] = TK_NEG;
        sort16(B);
        merge_top16(A, B);
        merge_partner(A, hi);
        const float smax = A[0];
        float ex[8]; int eidx[8]; float lsum = 0.f;
        asm volatile("s_waitcnt lgkmcnt(0)" ::: "memory");
#pragma unroll
        for (int k = 0; k < 8; ++k) {
            float s_lo = A[k], s_hi = A[8 + k]; asm volatile("" : "+v"(s_lo), "+v"(s_hi)); const float s = hi ? s_hi : s_lo;
            ex[k] = __expf(s - smax); lsum += ex[k];
            const unsigned code = __float_as_uint(s) & 0x1FFu, src = code >> 8, ci = (code >> 4) & 15u, cj = code & 15u;
            const unsigned ai = src ? cj : ci, bi = src ? ci : cj;
            const unsigned ca = idxslot[ai], cb = idxslot[16 + bi];
            eidx[k] = (int)(((ca ^ 127u) << 7) | (cb ^ 127u));
        }
        const float tot = lsum + partner_f(lsum, hi);
        const float inv = 1.0f / tot;
        int* ip = IDX + token * 128 + h * 16 + 8 * hi; float* gp = GATE + token * 128 + h * 16 + 8 * hi;
        *(u32x4*)ip = (u32x4){(unsigned)eidx[0], (unsigned)eidx[1], (unsigned)eidx[2], (unsigned)eidx[3]};
        *(u32x4*)(ip + 4) = (u32x4){(unsigned)eidx[4], (unsigned)eidx[5], (unsigned)eidx[6], (unsigned)eidx[7]};
        *(f32x4*)gp = (f32x4){ex[0] * inv, ex[1] * inv, ex[2] * inv, ex[3] * inv};
        *(f32x4*)(gp + 4) = (f32x4){ex[4] * inv, ex[5] * inv, ex[6] * inv, ex[7] * inv};
        asm volatile("s_waitcnt lgkmcnt(0)" ::: "memory");
    }
}
}

namespace peer3 {
__device__ __forceinline__ unsigned xcc_id() { return (unsigned)__builtin_amdgcn_s_getreg((3 << 11) | 20) & 7u; }
constexpr int UNIT = 16, NUNIT = T / UNIT;
template <int CTRL> __device__ __forceinline__ int dpp_i(int v) { return __builtin_amdgcn_update_dpp(0, v, CTRL, 0xF, 0xF, true); }
__device__ __forceinline__ int rowsum16(int v) { v += dpp_i<0xB1>(v); v += dpp_i<0x4E>(v); v += dpp_i<0x141>(v); v += dpp_i<0x140>(v); return v; }
__device__ __forceinline__ float gelu_as(float v) {
    const float av = fabsf(v), t = __builtin_amdgcn_rcpf(fmaf(av, 0.2316418882f, 1.0f));
    float q = fmaf(t, 0.5307027145f, -0.7265760135f); q = fmaf(q, t, 0.7107068705f); q = fmaf(q, t, -0.142248368f); q = fmaf(q, t, 0.127414796f); q = q * t;
    const float e = __builtin_amdgcn_exp2f(v * v * -0.72134752044f), m = v * (q * e);
    return v < 0.f ? m : v - m;
}
__device__ __forceinline__ unsigned take_async(unsigned* p, int lane) { unsigned v = 0u; if (lane == 0) v = __hip_atomic_fetch_add(p, 1u, __ATOMIC_RELAXED, __HIP_MEMORY_SCOPE_AGENT); return v; }

constexpr int UST = 6;
__device__ __forceinline__ void u_unit(const KArgs& a, int l, unsigned s, unsigned unit, LAS unsigned char* wlds, int lane) {
    const unsigned char* UQ = a.ws + WS_UQ + (size_t)l * NEXP * 1024;
    const float* USC = (const float*)(a.ws + WS_USC) + l * NEXP; const float* VSC = (const float*)(a.ws + WS_VSC) + l * NEXP;
    const int* IDX = (const int*)(a.ws + WS_IDX); const float* GATE = (const float*)(a.ws + WS_GATE);
    const unsigned char* HQ = a.ws + WS_H2Q; const float* HS = (const float*)(a.ws + WS_HS);
    float* COEF = (float*)(a.ws + WS_COEF);
    LAS int* lst = (LAS int*)wlds; LAS float* res = (LAS float*)(wlds + 512);
    const int q = lane >> 4, r = lane & 15;
    const size_t t0 = (size_t)unit * UNIT;
    int idx0 = IDX[t0 * 128 + lane], idx1 = IDX[t0 * 128 + 64 + lane];
    float g0 = GATE[t0 * 128 + lane], g1 = GATE[t0 * 128 + 64 + lane], sh = HS[t0];
    u32x4 hv[4];
#pragma unroll
    for (int k = 0; k < 4; ++k) hv[k] = *(const u32x4*)(HQ + t0 * 1024 + 256 * k + 16 * r);
#pragma unroll 1
    for (int i = 0; i < UNIT; ++i) {
        const size_t t = t0 + i, tn = t0 + (i + 1 < UNIT ? i + 1 : i);
        const bool in0 = (unsigned)(idx0 >> 11) == s, in1 = (unsigned)(idx1 >> 11) == s;
        float us0 = 0.f, us1 = 0.f, vs0 = 0.f, vs1 = 0.f;
        if (in0) { us0 = USC[idx0]; vs0 = VSC[idx0]; }
        if (in1) { us1 = USC[idx1]; vs1 = VSC[idx1]; }
        const int nidx0 = IDX[tn * 128 + lane], nidx1 = IDX[tn * 128 + 64 + lane];
        const float ng0 = GATE[tn * 128 + lane], ng1 = GATE[tn * 128 + 64 + lane], nsh = HS[tn];
        const unsigned long long m0 = __ballot(in0), m1 = __ballot(in1);
        const int c0 = __builtin_popcountll(m0), n = c0 + __builtin_popcountll(m1);
        const int rank0 = (int)__builtin_amdgcn_mbcnt_hi((unsigned)(m0 >> 32), __builtin_amdgcn_mbcnt_lo((unsigned)m0, 0u));
        const int rank1 = c0 + (int)__builtin_amdgcn_mbcnt_hi((unsigned)(m1 >> 32), __builtin_amdgcn_mbcnt_lo((unsigned)m1, 0u));
        if (in0) lst[rank0] = idx0;
        if (in1) lst[rank1] = idx1;
#pragma unroll 1
        for (int base = 0; base < n; base += 4 * UST) {
            const int nst = (n - base + 3) >> 2;
            u32x4 uv[UST][4];
#pragma unroll
            for (int st = 0; st < UST; ++st) {
                if (st < nst) {
                    int slot = base + 4 * st + q; slot = slot < n ? slot : n - 1;
                    const unsigned char* rp = UQ + (size_t)lst[slot] * 1024 + 16 * r;
#pragma unroll
                    for (int k = 0; k < 4; ++k) uv[st][k] = *(const u32x4*)(rp + 256 * k);
                }
            }
#pragma unroll
            for (int st = 0; st < UST; ++st) {
                if (st < nst) {
                    int s0_ = 0, s1_ = 0, s2_ = 0, s3_ = 0;
#pragma unroll
                    for (int k = 0; k < 4; ++k) {
                        s0_ = __builtin_amdgcn_sdot4((int)uv[st][k].x, (int)hv[k].x, s0_, false); s1_ = __builtin_amdgcn_sdot4((int)uv[st][k].y, (int)hv[k].y, s1_, false);
                        s2_ = __builtin_amdgcn_sdot4((int)uv[st][k].z, (int)hv[k].z, s2_, false); s3_ = __builtin_amdgcn_sdot4((int)uv[st][k].w, (int)hv[k].w, s3_, false);
                    }
                    const int tot = rowsum16((s0_ + s1_) + (s2_ + s3_));
                    if (r == 0) res[base + 4 * st + q] = (float)tot;
                }
            }
        }
        const float d0 = in0 ? res[rank0] : 0.f, d1 = in1 ? res[rank1] : 0.f;
        u32x4 nhv[4];
#pragma unroll
        for (int k = 0; k < 4; ++k) nhv[k] = *(const u32x4*)(HQ + tn * 1024 + 256 * k + 16 * r);
        if (in0) COEF[t * 128 + lane] = gelu_as(d0 * us0 * sh) * g0 * vs0;
        if (in1) COEF[t * 128 + 64 + lane] = gelu_as(d1 * us1 * sh) * g1 * vs1;
        idx0 = nidx0; idx1 = nidx1; g0 = ng0; g1 = ng1; sh = nsh;
#pragma unroll
        for (int k = 0; k < 4; ++k) hv[k] = nhv[k];
    }
}
struct VMeta { u32x4 iv[4]; f32x4 cv[4]; };
__device__ __forceinline__ void v_meta(VMeta& m, const int* IDX, const float* COEF, size_t t, int g) {
#pragma unroll
    for (int q = 0; q < 4; ++q) { m.iv[q] = *(const u32x4*)(IDX + t * 128 + 16 * g + 4 * q); m.cv[q] = *(const f32x4*)(COEF + t * 128 + 16 * g + 4 * q); }
}
__device__ __forceinline__ void v_stage(u32x4 (&P)[16], u32x4& CQ, float& cs, const VMeta& m, const unsigned char* VS) {
    float cm = 0.f;
#pragma unroll
    for (int j = 0; j < 16; ++j) cm = fmaxf(cm, fabsf(m.cv[j >> 2][j & 3]));
    cm = fmaxf(cm, swz_xor<8>(cm)); cm = fmaxf(cm, swz_xor<16>(cm));
    { auto rr = __builtin_amdgcn_permlane32_swap(__float_as_uint(cm), __float_as_uint(cm), false, false); cm = fmaxf(__uint_as_float(rr[0]), __uint_as_float(rr[1])); }
    const float inv = cm > 0.f ? 127.0f / cm : 0.f; cs = cm * (1.0f / 127.0f);
#pragma unroll
    for (int qd = 0; qd < 4; ++qd) {
        const int c0 = (int)rintf(m.cv[qd][0] * inv), c1 = (int)rintf(m.cv[qd][1] * inv), c2 = (int)rintf(m.cv[qd][2] * inv), c3 = (int)rintf(m.cv[qd][3] * inv);
        CQ[qd] = (unsigned)(c0 & 0xff) | ((unsigned)(c1 & 0xff) << 8) | ((unsigned)(c2 & 0xff) << 16) | ((unsigned)(c3 & 0xff) << 24);
    }
#pragma unroll
    for (int j = 0; j < 16; ++j) P[j] = *(const u32x4*)(VS + (size_t)m.iv[j >> 2][j & 3] * 128);
}
__device__ __forceinline__ void v_compute(const u32x4 (&P)[16], const u32x4& CQ, float cs, float* xout, const float* mod_l, size_t t, unsigned s, int lane) {
    const int g = lane >> 3, p = lane & 7; const bool b4 = (lane >> 4) & 1, b3 = (lane >> 3) & 1;
    typedef float f32x2 __attribute__((ext_vector_type(2)));
    const int col = (int)s * 128 + 16 * p + 2 * g, b = (int)(t >> 12);
    float* xp = xout + t * DM + col;
    f32x2 xv = *(const f32x2*)xp;
    const f32x2 gt = *(const f32x2*)(mod_l + (size_t)b * NMOD + 5 * DM + col);
    int acc[16];
#pragma unroll
    for (int k = 0; k < 16; ++k) acc[k] = 0;
#pragma unroll
    for (int qd = 0; qd < 4; ++qd)
#pragma unroll
        for (int w = 0; w < 4; ++w) {
            const unsigned A = P[4 * qd][w], B = P[4 * qd + 1][w], C = P[4 * qd + 2][w], D = P[4 * qd + 3][w];
            const unsigned X = __builtin_amdgcn_perm(B, A, 0x05010400u), Y = __builtin_amdgcn_perm(B, A, 0x07030602u);
            const unsigned Z = __builtin_amdgcn_perm(D, C, 0x05010400u), W = __builtin_amdgcn_perm(D, C, 0x07030602u);
            const unsigned T0 = __builtin_amdgcn_perm(Z, X, 0x05040100u), T1 = __builtin_amdgcn_perm(Z, X, 0x07060302u);
            const unsigned T2 = __builtin_amdgcn_perm(W, Y, 0x05040100u), T3 = __builtin_amdgcn_perm(W, Y, 0x07060302u);
            acc[4 * w + 0] = __builtin_amdgcn_sdot4((int)T0, (int)CQ[qd], acc[4 * w + 0], false); acc[4 * w + 1] = __builtin_amdgcn_sdot4((int)T1, (int)CQ[qd], acc[4 * w + 1], false);
            acc[4 * w + 2] = __builtin_amdgcn_sdot4((int)T2, (int)CQ[qd], acc[4 * w + 2], false); acc[4 * w + 3] = __builtin_amdgcn_sdot4((int)T3, (int)CQ[qd], acc[4 * w + 3], false);
        }
    int r8[8], r4[4], r2[2];
#pragma unroll
    for (int q = 0; q < 8; ++q) { auto rr = __builtin_amdgcn_permlane32_swap((unsigned)acc[q], (unsigned)acc[8 + q], false, false); r8[q] = (int)rr[0] + (int)rr[1]; }
#pragma unroll
    for (int q = 0; q < 4; ++q) { int lo = r8[q], hi = r8[4 + q]; asm volatile("" : "+v"(lo), "+v"(hi)); const int keep = b4 ? hi : lo, send = b4 ? lo : hi; r4[q] = keep + __builtin_amdgcn_ds_swizzle(send, (16 << 10) | 0x1f); }
#pragma unroll
    for (int q = 0; q < 2; ++q) { int lo = r4[q], hi = r4[2 + q]; asm volatile("" : "+v"(lo), "+v"(hi)); const int keep = b3 ? hi : lo, send = b3 ? lo : hi; r2[q] = keep + __builtin_amdgcn_ds_swizzle(send, (8 << 10) | 0x1f); }
    xv.x += gt.x * ((float)r2[0] * cs); xv.y += gt.y * ((float)r2[1] * cs);
    *(f32x2*)xp = xv;
}
__device__ __forceinline__ void v_unit(const KArgs& a, int l, const float* mod_l, unsigned s, unsigned unit, int lane) {
    const int g = lane >> 3, p = lane & 7;
    const unsigned char* VS = a.ws + WS_VQ + (size_t)l * NEXP * 1024 + (size_t)s * NEXP * 128 + 16 * p;
    const int* IDX = (const int*)(a.ws + WS_IDX); const float* COEF = (const float*)(a.ws + WS_COEF);
    const size_t t0 = (size_t)unit * UNIT;
    VMeta m; v_meta(m, IDX, COEF, t0, g);
    u32x4 PA[16], PB[16], CQA, CQB; float csA, csB;
    v_stage(PA, CQA, csA, m, VS);
    v_meta(m, IDX, COEF, t0 + 1, g);
#pragma unroll 1
    for (int i = 0; i < UNIT; i += 2) {
        v_stage(PB, CQB, csB, m, VS);
        v_meta(m, IDX, COEF, t0 + (i + 2 < UNIT ? i + 2 : i), g);
        v_compute(PA, CQA, csA, a.out, mod_l, t0 + i, s, lane);
        if (i + 2 < UNIT) { v_stage(PA, CQA, csA, m, VS); v_meta(m, IDX, COEF, t0 + (i + 3 < UNIT ? i + 3 : i), g); }
        v_compute(PB, CQB, csB, a.out, mod_l, t0 + i + 1, s, lane);
    }
}
template <bool VSTEP>
__device__ __forceinline__ void peer_phase(const KArgs& a, int l, const float* mod_l, unsigned* cnt, LAS unsigned char* lds, int wv) {
        const int tid = phase_tid(wv), lane = tid & 63, wid = wv;
    LAS unsigned char* wlds = lds + wid * 1024;
    const unsigned home = xcc_id();
    unsigned ss = 0, s = home;
    unsigned nxt = take_async(cnt + 64 * s, lane);
    for (;;) {
        const unsigned cur = (unsigned)__builtin_amdgcn_readfirstlane((int)nxt);
        if (cur >= (unsigned)NUNIT) { if (++ss == 8u) break; s = (home + ss) & 7u; nxt = take_async(cnt + 64 * s, lane); continue; }
        nxt = take_async(cnt + 64 * s, lane);
        if (VSTEP) v_unit(a, l, mod_l, s, cur, lane); else u_unit(a, l, s, cur, wlds, lane);
    }
}
}

constexpr int PH_PER_LAYER = 10, NPHASES = 1 + DEPTH * PH_PER_LAYER + 1;
#ifndef PHASE_MASK
#define PHASE_MASK 0xFFFF
#endif
#define HASP(k) (((PHASE_MASK) >> (k)) & 1)
#ifndef SB_EARLY_EXIT
#define SB_EARLY_EXIT 1
#endif

#define GAS __attribute__((address_space(1)))
#define RLX_AGENT __ATOMIC_RELAXED, __HIP_MEMORY_SCOPE_AGENT
#define XB_TMO      128
#define XB_XCNT(j)  (256  + 64 * (j))
#define XB_XSUB(j)  (1280 + 64 * (j))
#define XB_XGEN(j)  (2304 + 64 * (j))
#define XB_TOP      3328
#define XB_TOPGEN   3392
#define XCD_BAR_WORDS 3456
#define XB_SPIN_CAP (1u << 18)

__device__ __forceinline__ unsigned xb_ld(unsigned* p)              { return __hip_atomic_load(p, __ATOMIC_RELAXED, __HIP_MEMORY_SCOPE_AGENT); }
__device__ __forceinline__ unsigned xb_add(unsigned* p, unsigned v) { return __hip_atomic_fetch_add(p, v, __ATOMIC_RELAXED, __HIP_MEMORY_SCOPE_AGENT); }
__device__ __forceinline__ unsigned xb_xcc_id() { return (unsigned)__builtin_amdgcn_s_getreg((3 << 11) | 20) & 0xFu; }
#define XB_SPIN(cond, bar) do { unsigned _sp = 0; while (cond) { __builtin_amdgcn_s_sleep(1); \
    if ((++_sp & 255u) == 0u) { if (xb_ld(&(bar)[XB_TMO])) break; if (_sp > XB_SPIN_CAP) { atomicAdd(&(bar)[XB_TMO], 1u); break; } } } } while (0)

struct XcdBarrier {
    unsigned* bar; unsigned x;
    volatile LAS unsigned* st;
};

__device__ __forceinline__ XcdBarrier xcd_barrier_post(unsigned* bar, volatile LAS unsigned* st, bool tid0) {
    XcdBarrier b; b.bar = bar; b.x = xb_xcc_id(); b.st = st;
    if (tid0) (void)xb_add(&bar[XB_XCNT(b.x)], 1u);
    return b;
}
__device__ __forceinline__ void xcd_barrier_complete(unsigned* bar, unsigned x, unsigned& nloc, unsigned& nx) {
    const unsigned G = gridDim.x * gridDim.y * gridDim.z;
    unsigned sum, cnt, mine, sp = 0u;
    for (;;) {
        sum = 0u; cnt = 0u; mine = 0u;
#pragma unroll
        for (unsigned j = 0; j < 16; ++j) { const unsigned c = xb_ld(&bar[XB_XCNT(j)]); sum += c; cnt += (c > 0u) ? 1u : 0u; mine = (j == x) ? c : mine; }
        if (sum == G) break;
        __builtin_amdgcn_s_sleep(1);
        if ((++sp & 255u) == 0u) { if (xb_ld(&bar[XB_TMO])) break; if (sp > XB_SPIN_CAP) { atomicAdd(&bar[XB_TMO], 1u); break; } }
    }
    nloc = mine > 0u ? mine : 1u; nx = cnt > 0u ? cnt : 1u;
}

__device__ __forceinline__ void xcd_barrier(const XcdBarrier& b, bool tid0) {
    asm volatile("s_waitcnt vmcnt(0)" ::: "memory");
    __syncthreads();
    if (tid0) {
        unsigned* bar = b.bar;
        __builtin_amdgcn_s_waitcnt(0);
        unsigned nloc = b.st[0], nx = b.st[1];
        if (nloc == 0u) { xcd_barrier_complete(bar, b.x, nloc, nx); b.st[0] = nloc; b.st[1] = nx; }
        const unsigned old = xb_add(&bar[XB_XSUB(b.x)], 1u);
        const unsigned gen = old / nloc;
        if (old + 1u == (gen + 1u) * nloc) {
            __builtin_amdgcn_fence(__ATOMIC_RELEASE, "agent");
            asm volatile("s_waitcnt vmcnt(0)" ::: "memory");
            const unsigned og = xb_add(&bar[XB_TOP], 1u);
            const unsigned tg = og / nx;
            if (og + 1u == (tg + 1u) * nx) xb_add(&bar[XB_TOPGEN], 1u);
            else XB_SPIN(xb_ld(&bar[XB_TOPGEN]) == tg, bar);
            __builtin_amdgcn_fence(__ATOMIC_ACQUIRE, "agent");
            xb_add(&bar[XB_XGEN(b.x)], 1u);
            asm volatile("s_waitcnt vmcnt(0)" ::: "memory");
        } else {
            XB_SPIN(xb_ld(&bar[XB_XGEN(b.x)]) == gen, bar);
            __builtin_amdgcn_fence(__ATOMIC_ACQUIRE, "agent");
            asm volatile("s_waitcnt vmcnt(0)" ::: "memory");
        }
    }
    __syncthreads();
}

typedef const __attribute__((address_space(4))) KArgs* KArgsP;
__device__ __forceinline__ KArgsP kargs() { KArgsP p = (KArgsP)__builtin_amdgcn_kernarg_segment_ptr(); asm volatile("" : "+s"(p)); return p; }

__device__ __forceinline__ void load_args(KArgs& a) {
#if defined(__HIP_DEVICE_COMPILE__)
    KArgsP p = kargs();
    a.x = p->x; a.c = p->c; a.pos = p->pos; a.ada_w = p->ada_w; a.ada_b = p->ada_b; a.norm1_g = p->norm1_g; a.w_in = p->w_in; a.sinks = p->sinks; a.wbr_a = p->wbr_a; a.wbr_b = p->wbr_b;
    a.w_out = p->w_out; a.norm2_g = p->norm2_g; a.wq = p->wq; a.subkeys = p->subkeys; a.pu = p->pu; a.pv = p->pv; a.final_g = p->final_g; a.out = p->out; a.ws = p->ws; a.ph_lo = p->ph_lo; a.ph_hi = p->ph_hi;
#endif
}
__global__ void __launch_bounds__(NTHREADS, 2) fwd_kernel(KArgs a_unused) {
    extern __shared__ __attribute__((aligned(16))) unsigned char lds_raw[];
    LAS unsigned char* lds = (LAS unsigned char*)lds_raw;
    cg::grid_group grid = cg::this_grid();
    const int ph_lo = kargs()->ph_lo, ph_hi = kargs()->ph_hi;
    const int wv = __builtin_amdgcn_readfirstlane((int)threadIdx.x >> 6);
#define IN(k) (ph_lo <= (k) && (k) < ph_hi)
    volatile LAS unsigned* xb_st = (volatile LAS unsigned*)(lds + LDS_BYTES - 64);
    { const bool t0_ = phase_tid(wv) == 0; if (t0_) { xb_st[0] = 0u; xb_st[1] = 0u; } __syncthreads();
      (void)xcd_barrier_post((unsigned*)(kargs()->ws + WS_CTL) + CTL_BAR, xb_st, t0_); }
#define GRID_BAR() do { XcdBarrier b_; b_.bar = (unsigned*)(kargs()->ws + WS_CTL) + CTL_BAR; b_.x = xb_xcc_id(); b_.st = xb_st; xcd_barrier(b_, phase_tid(wv) == 0); } while (0)
#ifdef PROBE_PH
    unsigned long long pr_prev = __builtin_amdgcn_s_memrealtime(), pr_acc = 0;
#define PROBE_MATCH(k) ((PROBE_PH) >= 100 ? ((k) >= 1 && (k) < NPHASES - 1 && (((k) - 1) % PH_PER_LAYER) == (PROBE_PH) - 100) : (k) == (PROBE_PH))
#define SEAM(k) do { if (IN(k) && IN((k) + 1)) { if ((k) == 0) grid.sync(); else GRID_BAR(); } { const unsigned long long now_ = __builtin_amdgcn_s_memrealtime(); if (PROBE_MATCH(k)) pr_acc += now_ - pr_prev; pr_prev = now_; } } while (0)
#else
#define SEAM(k) do { if (IN(k) && IN((k) + 1)) { if ((k) == 0) grid.sync(); else GRID_BAR(); } } while (0)
#endif
#define LOADARGS KArgs a; load_args(a); unsigned char* ws = a.ws; const int G = op_grid(); (void)G; (void)ws
#define LAYERARGS const float* mod_l = (const float*)(ws + WS_MOD) + (size_t)l * 8 * NMOD; const float* xcur = (l == 0) ? a.x : a.out; (void)mod_l; (void)xcur
    if (IN(0)) { if (HASP(0)) { LOADARGS; ph_prologue(a, lds, wv); } }
    SEAM(0);
#pragma unroll 1
    for (int l = 0; l < DEPTH; ++l) {
        const int p0 = 1 + l * PH_PER_LAYER;
        if (IN(p0 + 0)) { if (HASP(1)) { LOADARGS; LAYERARGS; ph_norm<false>(a, xcur, a.norm1_g + l * DM, mod_l, 0, 1, wv); } }
        SEAM(p0 + 0);
        if (IN(p0 + 1)) { if (HASP(2)) { LOADARGS; pg8::Gemm g{(const bf16_t*)(ws + WS_H), (const bf16_t*)(ws + WS_WIN) + (size_t)l * NPROJ * 1024, T, NPROJ, 1024};
                  pg8::StaticOrder S; S.init(T, NPROJ, G, op_bid()); EpiProj E{ws};
                  pg8::gemm_phase<EpiProj, pg8::StaticOrder, true, true>(lds, g, S, E, wv); } }
        SEAM(p0 + 1);
        if (IN(p0 + 2)) { if (HASP(3)) { LOADARGS;
                  att::swa_phase((const bf16_t*)(ws + WS_QA), (const bf16_t*)(ws + WS_KA), (const bf16_t*)(ws + WS_VA), (bf16_t*)(ws + WS_QA), a.sinks + l * 8, lds, wv);
                  __syncthreads();
                  att::sb_phase<SB_EARLY_EXIT != 0>((const bf16_t*)(ws + WS_QB), (const bf16_t*)(ws + WS_KB), (const bf16_t*)(ws + WS_VB), (bf16_t*)(ws + WS_QB), lds, wv); } }
        SEAM(p0 + 2);
        if (IN(p0 + 3)) { if (HASP(4)) { LOADARGS; pg8::StaticOrder S; S.init(T, DM, G, op_bid());
                  { pg8::Gemm g{(const bf16_t*)(ws + WS_QA), (const bf16_t*)(ws + WS_WBA) + (size_t)l * 1024 * 512, T, DM, 512};
                    EpiBranch<false> E{(const bf16_t*)(ws + WS_GA), (bf16_t*)(ws + WS_H)};
                    pg8::gemm_phase<EpiBranch<false>, pg8::StaticOrder, true, true>(lds, g, S, E, wv); }
                  __syncthreads();
                  { pg8::Gemm g{(const bf16_t*)(ws + WS_QB), (const bf16_t*)(ws + WS_WBB) + (size_t)l * 1024 * 512, T, DM, 512};
                    EpiBranch<true> E{(const bf16_t*)(ws + WS_GB), (bf16_t*)(ws + WS_H)};
                    pg8::gemm_phase<EpiBranch<true>, pg8::StaticOrder, true, true>(lds, g, S, E, wv); } } }
        SEAM(p0 + 3);
        if (IN(p0 + 4)) { if (HASP(5)) { LOADARGS; LAYERARGS; pg8::Gemm g{(const bf16_t*)(ws + WS_H), (const bf16_t*)(ws + WS_WOUT) + (size_t)l * 1024 * 1024, T, DM, 1024};
                  pg8::StaticOrder S; S.init(T, DM, G, op_bid()); EpiWout E{xcur, a.out, mod_l + 2 * DM};
                  pg8::gemm_phase<EpiWout, pg8::StaticOrder, true, true>(lds, g, S, E, wv); } }
        SEAM(p0 + 4);
        if (IN(p0 + 5)) { if (HASP(6)) { LOADARGS; LAYERARGS; ph_norm<true>(a, a.out, a.norm2_g + l * DM, mod_l, 3, 4, wv); } }
        SEAM(p0 + 5);
        if (IN(p0 + 6)) { if (HASP(7)) { LOADARGS; pg8::Gemm g{(const bf16_t*)(ws + WS_H), (const bf16_t*)(ws + WS_WQ) + (size_t)l * PQ * 1024, T, PQ, 1024};
                  pg8::StaticOrder S; S.init(T, PQ, G, op_bid()); EpiPlainBf16 E{(bf16_t*)(ws + WS_Q2), PQ};
                  pg8::gemm_phase<EpiPlainBf16, pg8::StaticOrder, true, true>(lds, g, S, E, wv); } }
        SEAM(p0 + 6);
        if (IN(p0 + 7)) { if (HASP(8)) { LOADARGS; tk::topk_phase((const bf16_t*)(ws + WS_Q2), (const bf16_t*)(ws + WS_SK) + (size_t)l * 8 * 2 * 128 * 128, (int*)(ws + WS_IDX), (float*)(ws + WS_GATE), lds, wv); } }
        SEAM(p0 + 7);
        if (IN(p0 + 8)) { if (HASP(9)) { LOADARGS; peer3::peer_phase<false>(a, l, nullptr, (unsigned*)(ws + WS_CTL) + CTL_QUEUE + (l * 2 + 0) * 8 * 64, lds, wv); } }
        SEAM(p0 + 8);
        if (IN(p0 + 9)) { if (HASP(10)) { LOADARGS; LAYERARGS; peer3::peer_phase<true>(a, l, mod_l, (unsigned*)(ws + WS_CTL) + CTL_QUEUE + (l * 2 + 1) * 8 * 64, lds, wv); } }
        SEAM(p0 + 9);
    }
    if (IN(NPHASES - 1)) { if (HASP(11)) { LOADARGS; ph_final_norm(a, wv); } }
#ifdef PROBE_PH
    { const unsigned long long now_ = __builtin_amdgcn_s_memrealtime(); if (PROBE_MATCH(NPHASES - 1)) pr_acc += now_ - pr_prev;
      if (blockIdx.x == 0 && threadIdx.x == 0) { const unsigned long long t0_ = __builtin_amdgcn_s_memrealtime(); while (__builtin_amdgcn_s_memrealtime() - t0_ < pr_acc * (PROBE_K)) __builtin_amdgcn_s_sleep(16); } }
#endif
#undef IN
#undef SEAM
}

#ifndef N_LAUNCH_SPLIT
#define N_LAUNCH_SPLIT 1
#endif
extern "C" void kernel_launch(void* const* d_in, const int* in_sizes, int n_in, void* d_out, int out_size, void* d_ws, size_t ws_size, hipStream_t stream) {
    static int grid = 0;
    if (grid == 0) {
        if (n_in != 17 || out_size != T * DM || ws_size < WS_END) { fprintf(stderr, "kernel_launch: unexpected problem (n_in %d out %d ws %zu)\n", n_in, out_size, ws_size); grid = -1; return; }
        int dev = 0, cus = 0, per_cu = 0;
        (void)hipGetDevice(&dev);
        (void)hipDeviceGetAttribute(&cus, hipDeviceAttributeMultiprocessorCount, dev);
        (void)hipFuncSetAttribute((const void*)fwd_kernel, hipFuncAttributeMaxDynamicSharedMemorySize, LDS_BYTES);
        (void)hipOccupancyMaxActiveBlocksPerMultiprocessor(&per_cu, (const void*)fwd_kernel, NTHREADS, LDS_BYTES);
        if (per_cu < 1) { fprintf(stderr, "kernel_launch: occupancy query says %d\n", per_cu); per_cu = 1; }
        grid = cus;
        fprintf(stderr, "kernel_launch: cus %d per_cu %d grid %d ws %zu\n", cus, per_cu, grid, ws_size);
    }
    if (grid < 0) return;
    if (hipMemsetAsync((char*)d_ws + WS_CTL, 0, 65536, stream) != hipSuccess) { fprintf(stderr, "kernel_launch: hipMemsetAsync of the control words failed\n"); return; }
    KArgs a{};
    a.x = (const float*)d_in[0]; a.c = (const float*)d_in[1]; a.pos = (const int*)d_in[2]; a.ada_w = (const float*)d_in[3]; a.ada_b = (const float*)d_in[4];
    a.norm1_g = (const float*)d_in[5]; a.w_in = (const float*)d_in[6]; a.sinks = (const float*)d_in[7]; a.wbr_a = (const float*)d_in[8]; a.wbr_b = (const float*)d_in[9];
    a.w_out = (const float*)d_in[10]; a.norm2_g = (const float*)d_in[11]; a.wq = (const float*)d_in[12]; a.subkeys = (const float*)d_in[13]; a.pu = (const float*)d_in[14];
    a.pv = (const float*)d_in[15]; a.final_g = (const float*)d_in[16]; a.out = (float*)d_out; a.ws = (unsigned char*)d_ws;
#if N_LAUNCH_SPLIT
    a.ph_lo = 0; a.ph_hi = NPHASES;
    { void* args[] = {&a};
      hipError_t e = hipLaunchCooperativeKernel((void*)fwd_kernel, dim3(grid), dim3(NTHREADS), args, LDS_BYTES, stream);
      if (e != hipSuccess) fprintf(stderr, "cooperative launch failed: %s (grid %d)\n", hipGetErrorString(e), grid); }
#else
    for (int ph = 0; ph < NPHASES; ++ph) {
        a.ph_lo = ph; a.ph_hi = ph + 1;
        void* args[] = {&a};
        hipError_t e = hipLaunchCooperativeKernel((void*)fwd_kernel, dim3(grid), dim3(NTHREADS), args, LDS_BYTES, stream);
        if (e != hipSuccess) { fprintf(stderr, "cooperative launch %d failed: %s (grid %d)\n", ph, hipGetErrorString(e), grid); break; }
    }
#endif
}
```

```cpp
#include <hip/hip_runtime.h>
#include <hip/hip_cooperative_groups.h>
#include <cstdio>
#include <cstdint>
namespace cg = cooperative_groups;

namespace pg8 {
#define PG8_LAS __attribute__((address_space(3)))
typedef unsigned short bf16_t;
typedef short bf16x8 __attribute__((ext_vector_type(8)));
typedef float f32x4 __attribute__((ext_vector_type(4)));
typedef unsigned u32x4 __attribute__((ext_vector_type(4)));
constexpr int BM = 256, BK = 64, HALF = 128, HTB = HALF * BK * 2  , STAGE_BYTES = 8 * HTB, NXCD = 8, WGM = 8;

__host__ __device__ __forceinline__ int lds_byte(int r, int c) { const int st = (r >> 4) * 2 + (c >> 5), rr = r & 15, cc = c & 31, ob = rr * 64 + cc * 2; return st * 1024 + (ob ^ (((ob >> 9) & 1) << 5)); }
__host__ __device__ __forceinline__ void stage_rc(int b, int& R, int& C) { const int st = b / 1024, sb = b % 1024, swz = sb ^ (((sb >> 9) & 1) << 5); R = (st >> 1) * 16 + swz / 64; C = (st & 1) * 32 + (swz % 64) / 2; }
__host__ __device__ __forceinline__ int perm32(int rho) { const int n = rho >> 4, i = rho & 15; return 8 * (i >> 2) + 4 * n + (i & 3); }

struct Unit { int pm, pn; };
struct Gemm { const bf16_t* A; const bf16_t* Bt; int M, N, K; };

struct StaticOrder {
    int nM, nN, nwg, G, c;
    __host__ __device__ void init(int M, int N, int G_, int c_) { nM = M / BM; nN = N / BM; nwg = nM * nN; G = G_; c = c_; }
    __host__ __device__ bool next(int i, Unit& u) const {
        const long L = (long)i * G + c; if (L >= nwg) return false;
        int wgid = (int)L; { const int q = nwg / NXCD, r = nwg % NXCD, xcd = wgid % NXCD, off = wgid / NXCD; wgid = (xcd < r ? xcd * (q + 1) : r * (q + 1) + (xcd - r) * q) + off; }
        const int nig = WGM * nN, gid = wgid / nig, fm = gid * WGM, gsz = (nM - fm) < WGM ? (nM - fm) : WGM;
        u.pm = fm + ((wgid % nig) % gsz); u.pn = (wgid % nig) / gsz; return true;
    }
    __device__ __forceinline__ void a_ready(const Unit&) const {}
    __device__ __forceinline__ void done(const Unit&) const {}
};


__device__ __forceinline__ unsigned cvt_pk_bf16(float lo, float hi) { unsigned r; asm volatile("v_cvt_pk_bf16_f32 %0, %1, %2" : "=v"(r) : "v"(lo), "v"(hi)); return r; }
template <class Epi, class Sched, bool ALIGN_EPI = false, bool SP2 = false>
__device__ __forceinline__ void gemm_phase(PG8_LAS unsigned char* lds, const Gemm g, const Sched& S, const Epi& E, int wv) {
    unsigned m_op = ~0u; asm volatile("" : "+s"(m_op));
    const int tid = wv * 64 + (int)__builtin_amdgcn_mbcnt_hi(m_op, __builtin_amdgcn_mbcnt_lo(m_op, 0u)), wid = wv, lane = tid & 63, wr = wid >> 2, wc = wid & 3, fr = lane & 15, fq = lane >> 4;
    const int K = g.K, nt = K / BK;
    unsigned voffA[2], voffB[2];
#pragma unroll
    for (int i = 0; i < 2; ++i) { int R, C; stage_rc(tid * 16 + i * 8192, R, C); const int Rb = Epi::PERM ? ((R & ~31) + perm32(R & 31)) : R;
        voffA[i] = (unsigned)(R * K + C) * 2u; voffB[i] = (unsigned)(Rb * K + C) * 2u; }
    const size_t kstep = (size_t)(BK * 2);
    const size_t hstep = (size_t)HALF * K * 2;
    const size_t tstep = 2 * hstep;
    const unsigned ldsw = (unsigned)wid * 1024u;
    const int aoff = lds_byte(wr * 64 + fr, fq * 8), boff = lds_byte(wc * 32 + fr, fq * 8);
#define PG8_SA(b, h) (((b) * 2 + (h)) * HTB)
#define PG8_SB(b, h) ((4 + (b) * 2 + (h)) * HTB)
#define PG8_STAGE(bufoff, gbase, voff) do { _Pragma("unroll") for (int _i = 0; _i < 2; ++_i) \
        __builtin_amdgcn_global_load_lds((const unsigned*)((const char*)(gbase) + (voff)[_i]), (PG8_LAS unsigned*)(lds + (bufoff) + ldsw + _i * 8192), 16, 0, 0); } while (0)
#define PG8_LDA(dst, b, h) do { _Pragma("unroll") for (int m = 0; m < 4; ++m) _Pragma("unroll") for (int k = 0; k < 2; ++k) dst[m][k] = *(const PG8_LAS bf16x8*)(lds + PG8_SA(b, h) + aoff + m * 2048 + k * 1024); } while (0)
#define PG8_LDB(dst, b, h) do { _Pragma("unroll") for (int n = 0; n < 2; ++n) _Pragma("unroll") for (int k = 0; k < 2; ++k) dst[n][k] = *(const PG8_LAS bf16x8*)(lds + PG8_SB(b, h) + boff + n * 2048 + k * 1024); } while (0)
#define PG8_MMA(ai, bj, At, Bt) do { __builtin_amdgcn_s_setprio(1); _Pragma("unroll") for (int m = 0; m < 4; ++m) _Pragma("unroll") for (int n = 0; n < 2; ++n) _Pragma("unroll") for (int k = 0; k < 2; ++k) \
        acc[ai][bj][m][n] = __builtin_amdgcn_mfma_f32_16x16x32_bf16(Bt[n][k], At[m][k], acc[ai][bj][m][n], 0, 0, 0); __builtin_amdgcn_s_setprio(0); } while (0)
#define PG8_WAIT_V(n) asm volatile("s_waitcnt vmcnt(" #n ")" ::: "memory")
#define PG8_WAIT_L(n) asm volatile("s_waitcnt lgkmcnt(" #n ")" ::: "memory")
#define PG8_BAR __builtin_amdgcn_s_barrier()
#define PG8_SCHED __builtin_amdgcn_sched_barrier(0)
    Unit cur, nxt; int ui = 0;
    if (!S.next(0, cur)) return;
    f32x4 acc[2][2][4][2];
#pragma unroll
    for (int a = 0; a < 2; ++a)
#pragma unroll
        for (int b = 0; b < 2; ++b)
#pragma unroll
            for (int m = 0; m < 4; ++m)
#pragma unroll
                for (int n = 0; n < 2; ++n) acc[a][b][m][n] = (f32x4){0.f, 0.f, 0.f, 0.f};
    bf16x8 At[4][2], B0[2][2], B1[2][2];
    const char* cA = (const char*)g.A + (size_t)cur.pm * tstep; const char* cB = (const char*)g.Bt + (size_t)cur.pn * tstep;
    S.a_ready(cur);
    if constexpr (SP2) {
        PG8_STAGE(PG8_SB(0, 0), cB, voffB); PG8_STAGE(PG8_SB(0, 1), cB + hstep, voffB); PG8_STAGE(PG8_SA(0, 0), cA, voffA); PG8_STAGE(PG8_SA(0, 1), cA + hstep, voffA);
        if (wr == 1) PG8_BAR;
        PG8_WAIT_V(2); PG8_BAR;
        PG8_STAGE(PG8_SB(1, 0), cB + kstep, voffB); PG8_STAGE(PG8_SA(1, 0), cA + kstep, voffA); PG8_STAGE(PG8_SB(1, 1), cB + hstep + kstep, voffB);
        PG8_WAIT_V(6); PG8_BAR;
    } else {
        PG8_STAGE(PG8_SB(0, 0), cB, voffB); PG8_STAGE(PG8_SA(0, 0), cA, voffA); PG8_STAGE(PG8_SB(0, 1), cB + hstep, voffB); PG8_STAGE(PG8_SA(0, 1), cA + hstep, voffA);
        if (wr == 1) PG8_BAR;
        PG8_WAIT_V(4); PG8_BAR;
        PG8_STAGE(PG8_SB(1, 0), cB + kstep, voffB); PG8_STAGE(PG8_SA(1, 0), cA + kstep, voffA); PG8_STAGE(PG8_SB(1, 1), cB + hstep + kstep, voffB);
        PG8_WAIT_V(6); PG8_BAR;
    }
    for (;;) {
        const bool has_next = S.next(ui + 1, nxt);
        const char* nA = has_next ? (const char*)g.A + (size_t)nxt.pm * tstep : cA; const char* nB = has_next ? (const char*)g.Bt + (size_t)nxt.pn * tstep : cB;
        for (int t = 0; t < nt; t += 2) {
            const bool last = (t == nt - 2);
            const char* a1 = cA + (size_t)(t + 1) * kstep;
            const char* a2 = last ? nA : cA + (size_t)(t + 2) * kstep; const char* b2 = last ? nB : cB + (size_t)(t + 2) * kstep;
            const char* a3 = a2 + kstep; const char* b3 = b2 + kstep;
            if (last && has_next) S.a_ready(nxt);
            if constexpr (SP2) {
            PG8_LDB(B0, 0, 0); PG8_LDB(B1, 0, 1); PG8_SCHED; PG8_LDA(At, 0, 0); PG8_STAGE(PG8_SA(1, 1), a1 + hstep, voffA);
            PG8_WAIT_V(8); PG8_WAIT_L(0); PG8_BAR; PG8_MMA(0, 0, At, B0); PG8_MMA(0, 1, At, B1); PG8_BAR; PG8_SCHED;
            PG8_LDA(At, 0, 1); PG8_STAGE(PG8_SB(0, 0), b2, voffB); PG8_STAGE(PG8_SB(0, 1), b2 + hstep, voffB); PG8_STAGE(PG8_SA(0, 0), a2, voffA);
            PG8_WAIT_V(8); PG8_WAIT_L(0); PG8_BAR; PG8_MMA(1, 0, At, B0); PG8_MMA(1, 1, At, B1); PG8_BAR; PG8_SCHED;
            PG8_LDB(B0, 1, 0); PG8_LDB(B1, 1, 1); PG8_SCHED; PG8_LDA(At, 1, 0); PG8_STAGE(PG8_SA(0, 1), a2 + hstep, voffA);
            PG8_WAIT_V(8); PG8_WAIT_L(0); PG8_BAR; PG8_MMA(0, 0, At, B0); PG8_MMA(0, 1, At, B1); PG8_BAR; PG8_SCHED;
            PG8_LDA(At, 1, 1); PG8_STAGE(PG8_SB(1, 0), b3, voffB); PG8_STAGE(PG8_SB(1, 1), b3 + hstep, voffB); PG8_STAGE(PG8_SA(1, 0), a3, voffA);
            PG8_WAIT_V(8); PG8_WAIT_L(0); PG8_BAR; PG8_MMA(1, 0, At, B0); PG8_MMA(1, 1, At, B1); PG8_BAR; PG8_SCHED;
            } else {
            PG8_LDB(B0, 0, 0); PG8_SCHED; PG8_LDA(At, 0, 0); PG8_STAGE(PG8_SA(1, 1), a1 + hstep, voffA);
            PG8_WAIT_L(8); PG8_BAR; PG8_WAIT_L(0); PG8_MMA(0, 0, At, B0); PG8_BAR; PG8_SCHED;
            PG8_LDB(B1, 0, 1); PG8_STAGE(PG8_SB(0, 0), b2, voffB);
            PG8_BAR; PG8_WAIT_L(0); PG8_MMA(0, 1, At, B1); PG8_BAR;
            PG8_LDA(At, 0, 1); PG8_STAGE(PG8_SA(0, 0), a2, voffA);
            PG8_BAR; PG8_WAIT_L(0); PG8_MMA(1, 0, At, B0); PG8_BAR; PG8_SCHED;
            PG8_STAGE(PG8_SB(0, 1), b2 + hstep, voffB);
            PG8_WAIT_V(6); PG8_BAR; PG8_MMA(1, 1, At, B1); PG8_BAR;
            PG8_LDB(B0, 1, 0); PG8_SCHED; PG8_LDA(At, 1, 0); PG8_STAGE(PG8_SA(0, 1), a2 + hstep, voffA);
            PG8_WAIT_L(8); PG8_BAR; PG8_WAIT_L(0); PG8_MMA(0, 0, At, B0); PG8_BAR; PG8_SCHED;
            PG8_LDB(B1, 1, 1); PG8_STAGE(PG8_SB(1, 0), b3, voffB);
            PG8_BAR; PG8_WAIT_L(0); PG8_MMA(0, 1, At, B1); PG8_BAR;
            PG8_LDA(At, 1, 1); PG8_STAGE(PG8_SA(1, 0), a3, voffA);
            PG8_BAR; PG8_WAIT_L(0); PG8_MMA(1, 0, At, B0); PG8_BAR; PG8_SCHED;
            PG8_STAGE(PG8_SB(1, 1), b3 + hstep, voffB);
            PG8_WAIT_V(6); PG8_BAR; PG8_MMA(1, 1, At, B1); PG8_BAR;
            }
        }
        if constexpr (ALIGN_EPI) { if (wr == 0) PG8_BAR; }
        if constexpr (!Epi::AFTER_DRAIN) { E(acc, cur, wr, wc, fr, fq); S.done(cur); }
        if (!has_next) break;
#pragma unroll
        for (int a = 0; a < 2; ++a)
#pragma unroll
            for (int b = 0; b < 2; ++b)
#pragma unroll
                for (int m = 0; m < 4; ++m)
#pragma unroll
                    for (int n = 0; n < 2; ++n) acc[a][b][m][n] = (f32x4){0.f, 0.f, 0.f, 0.f};
        cur = nxt; cA = nA; cB = nB; ++ui;
        if constexpr (ALIGN_EPI) { if (wr == 1) PG8_BAR; }
    }
    PG8_WAIT_V(0);
    if constexpr (!ALIGN_EPI) { if (wr == 0) PG8_BAR; }
    PG8_BAR;
    if constexpr (Epi::AFTER_DRAIN) { E.fused(acc, cur, wr, wc, fr, fq, lds, wid, lane); S.done(cur); }
#undef PG8_SA
#undef PG8_SB
#undef PG8_STAGE
#undef PG8_LDA
#undef PG8_LDB
#undef PG8_MMA
#undef PG8_WAIT_V
#undef PG8_WAIT_L
#undef PG8_BAR
#undef PG8_SCHED
}
}


#define LAS __attribute__((address_space(3)))

__device__ __forceinline__ int op_bid() { int b = (int)blockIdx.x; asm volatile("" : "+s"(b)); return b; }
__device__ __forceinline__ int op_grid() { int g = (int)gridDim.x; asm volatile("" : "+s"(g)); return g; }
__device__ __forceinline__ int phase_tid(int wv) { unsigned m = ~0u; asm volatile("" : "+s"(m)); return wv * 64 + (int)__builtin_amdgcn_mbcnt_hi(m, __builtin_amdgcn_mbcnt_lo(m, 0u)); }
typedef unsigned short bf16_t;
typedef float f32x4 __attribute__((ext_vector_type(4)));
typedef unsigned u32x4 __attribute__((ext_vector_type(4)));
typedef unsigned u32x2 __attribute__((ext_vector_type(2)));

constexpr int BATCH = 8, SEQ = 4096, DM = 1024, T = BATCH * SEQ, DEPTH = 2;
constexpr int NPROJ = 4352, NMOD = 6 * DM;
constexpr int NEXP = 16384, PQ = 2048;
constexpr float NORM_EPS = 1e-6f;
constexpr float LOG2E = 1.4426950408889634f;
constexpr float QSCALE = 0.125f * LOG2E;
constexpr float SB_EXIT = 160.0f;

constexpr size_t MiB = 1u << 20;
constexpr size_t WS_CTL = 0;
constexpr size_t WS_MOD = 1 * MiB;
constexpr size_t WS_ROPE = 2 * MiB;
constexpr size_t WS_WIN = 10 * MiB;
constexpr size_t WS_WBA = 27 * MiB;
constexpr size_t WS_WBB = 29 * MiB;
constexpr size_t WS_WOUT = 31 * MiB;
constexpr size_t WS_WQ = 35 * MiB;
constexpr size_t WS_SK = 43 * MiB;
constexpr size_t WS_UQ = 44 * MiB;
constexpr size_t WS_VQ = 76 * MiB;
constexpr size_t WS_USC = 108 * MiB;
constexpr size_t WS_VSC = 108 * MiB + 256 * 1024;
constexpr size_t WS_HS = 109 * MiB;
constexpr size_t WS_H = 112 * MiB;
constexpr size_t WS_QA = 176 * MiB;
constexpr size_t WS_QB = 208 * MiB;
constexpr size_t WS_KB = 240 * MiB;
constexpr size_t WS_VB = 272 * MiB;
constexpr size_t WS_KA = 304 * MiB;
constexpr size_t WS_VA = 312 * MiB;
constexpr size_t WS_GA = 320 * MiB;
constexpr size_t WS_GB = 384 * MiB;
constexpr size_t WS_END = 448 * MiB;
constexpr size_t WS_H2Q = WS_QA, WS_IDX = WS_KB, WS_GATE = WS_VB, WS_Q2 = WS_GA, WS_COEF = WS_GA;
constexpr int CTL_BAR = 4096;
constexpr int CTL_QUEUE = 1024;

constexpr int LDS_BYTES = 147456;
constexpr int NTHREADS = 512, NWAVES = 8;

struct KArgs {
    const float* x; const float* c; const int* pos; const float* ada_w; const float* ada_b; const float* norm1_g; const float* w_in; const float* sinks;
    const float* wbr_a; const float* wbr_b; const float* w_out; const float* norm2_g; const float* wq; const float* subkeys; const float* pu; const float* pv; const float* final_g;
    float* out; unsigned char* ws; int ph_lo, ph_hi;
};

__device__ __forceinline__ unsigned f2bf(float f) { unsigned u = __float_as_uint(f); return (u + 0x7fffu + ((u >> 16) & 1u)) >> 16; }
__device__ __forceinline__ unsigned pk2(float lo, float hi) { return f2bf(lo) | (f2bf(hi) << 16); }
__device__ __forceinline__ float bflo(unsigned w) { return __uint_as_float(w << 16); }
__device__ __forceinline__ float bfhi(unsigned w) { return __uint_as_float(w & 0xffff0000u); }
template <int M> __device__ __forceinline__ float swz_xor(float v) { return __int_as_float(__builtin_amdgcn_ds_swizzle(__float_as_int(v), (M << 10) | 0x1f)); }
__device__ __forceinline__ float wave_sum(float v) {
    v += swz_xor<1>(v); v += swz_xor<2>(v); v += swz_xor<4>(v); v += swz_xor<8>(v); v += swz_xor<16>(v);
    auto rr = __builtin_amdgcn_permlane32_swap(__float_as_uint(v), __float_as_uint(v), false, false);
    return __uint_as_float(rr[0]) + __uint_as_float(rr[1]);
}
__device__ __forceinline__ float wave_max(float v) {
    v = fmaxf(v, swz_xor<1>(v)); v = fmaxf(v, swz_xor<2>(v)); v = fmaxf(v, swz_xor<4>(v)); v = fmaxf(v, swz_xor<8>(v)); v = fmaxf(v, swz_xor<16>(v));
    auto rr = __builtin_amdgcn_permlane32_swap(__float_as_uint(v), __float_as_uint(v), false, false);
    return fmaxf(__uint_as_float(rr[0]), __uint_as_float(rr[1]));
}
__device__ __forceinline__ int rdlane_i(int v, int l) { return __builtin_amdgcn_readlane(v, __builtin_amdgcn_readfirstlane(l)); }
__device__ __forceinline__ float rdlane_f(float v, int l) { return __int_as_float(__builtin_amdgcn_readlane(__float_as_int(v), __builtin_amdgcn_readfirstlane(l))); }
__device__ __forceinline__ float dot8(u32x4 a, u32x4 b, float acc) {
    acc = fmaf(bflo(a.x), bflo(b.x), acc); acc = fmaf(bfhi(a.x), bfhi(b.x), acc);
    acc = fmaf(bflo(a.y), bflo(b.y), acc); acc = fmaf(bfhi(a.y), bfhi(b.y), acc);
    acc = fmaf(bflo(a.z), bflo(b.z), acc); acc = fmaf(bfhi(a.z), bfhi(b.z), acc);
    acc = fmaf(bflo(a.w), bflo(b.w), acc); acc = fmaf(bfhi(a.w), bfhi(b.w), acc);
    return acc;
}
__device__ __forceinline__ float softplus2(float z2) {
    return fmaxf(z2, 0.f) + __log2f(1.0f + exp2f(-fabsf(z2)));
}

__device__ __forceinline__ int win_pos(int n) {
    if (n >= 640) return n;
    const int hb = n & ~63, d = n & 63;
    return hb + (d < 32 ? 2 * d : 2 * (d - 32) + 1);
}
template <bool WIN>
__device__ __forceinline__ void transpose_item(const float* W, int K, int N, bf16_t* WT, LAS float* scr, int item, int lane) {
    const int nblk = N / 32, kb = item / nblk, nb = item % nblk, k0 = 64 * kb, n0 = 32 * nb;
#pragma unroll 8
    for (int i = 0; i < 32; ++i) { const int kk = 2 * i + (lane >> 5); scr[kk * 33 + (lane & 31)] = W[(size_t)(k0 + kk) * N + n0 + (lane & 31)]; }
    asm volatile("s_waitcnt lgkmcnt(0)" ::: "memory");
    const int c = lane & 7;
#pragma unroll
    for (int j = 0; j < 4; ++j) { const int n = (lane >> 3) + 8 * j; const LAS float* s = scr + (8 * c) * 33 + n;
        u32x4 o; o.x = pk2(s[0 * 33], s[1 * 33]); o.y = pk2(s[2 * 33], s[3 * 33]); o.z = pk2(s[4 * 33], s[5 * 33]); o.w = pk2(s[6 * 33], s[7 * 33]);
        const int row = WIN ? win_pos(n0 + n) : (n0 + n);
        *(u32x4*)(WT + (size_t)row * K + k0 + 8 * c) = o; }
    asm volatile("s_waitcnt lgkmcnt(0)" ::: "memory");
}
template <bool OFFSET128>
__device__ __forceinline__ void quant_row(const f32x4 (&v)[4], unsigned char* dst_row, float* scale_out, int lane) {
    float am = 0.f;
#pragma unroll
    for (int i = 0; i < 4; ++i) am = fmaxf(am, fmaxf(fmaxf(fabsf(v[i].x), fabsf(v[i].y)), fmaxf(fabsf(v[i].z), fabsf(v[i].w))));
    am = wave_max(am);
    const float inv = am > 0.f ? 127.0f / am : 0.f, sc = am > 0.f ? am / 127.0f : 1.0f;
    u32x4 o;
#pragma unroll
    for (int i = 0; i < 4; ++i) {
        int q0 = (int)rintf(v[i].x * inv), q1 = (int)rintf(v[i].y * inv), q2 = (int)rintf(v[i].z * inv), q3 = (int)rintf(v[i].w * inv);
        if (OFFSET128) { q0 += 128; q1 += 128; q2 += 128; q3 += 128; }
        o[i] = (unsigned)(q0 & 0xff) | ((unsigned)(q1 & 0xff) << 8) | ((unsigned)(q2 & 0xff) << 16) | ((unsigned)(q3 & 0xff) << 24);
    }
    *(u32x4*)(dst_row + 16 * lane) = o;
    if (lane == 0) *scale_out = sc;
}

__device__ __forceinline__ void ph_prologue(const KArgs& a, LAS unsigned char* lds, int wv) {
    const int tid = phase_tid(wv), lane = tid & 63, wave = wv, G = op_grid();
    const int gw = op_bid() * NWAVES + wave, NGW = G * NWAVES;
    unsigned char* ws = a.ws;
    {
        LAS float* sc = (LAS float*)lds;
        LAS float* red = (LAS float*)(lds + 32768);
        for (int it = op_bid(); it < DEPTH * 96; it += G) {
            for (int idx = tid; idx < 8192; idx += NTHREADS) { const int b = idx >> 10, i = idx & 1023; const float cv = a.c[b * 1024 + i]; sc[i * 8 + b] = cv / (1.0f + __expf(-cv)); }
            __syncthreads();
            const int l = it / 96, j0 = (it % 96) * 64;
            const float* wp = a.ada_w + ((size_t)l * 1024 + wave * 128) * NMOD + j0 + lane;
            float acc[8];
#pragma unroll
            for (int b = 0; b < 8; ++b) acc[b] = 0.f;
#pragma unroll 8
            for (int i = 0; i < 128; ++i) {
                const float w = wp[(size_t)i * NMOD];
                const f32x4 s0 = *(const LAS f32x4*)(sc + (wave * 128 + i) * 8), s1 = *(const LAS f32x4*)(sc + (wave * 128 + i) * 8 + 4);
                acc[0] = fmaf(s0.x, w, acc[0]); acc[1] = fmaf(s0.y, w, acc[1]); acc[2] = fmaf(s0.z, w, acc[2]); acc[3] = fmaf(s0.w, w, acc[3]);
                acc[4] = fmaf(s1.x, w, acc[4]); acc[5] = fmaf(s1.y, w, acc[5]); acc[6] = fmaf(s1.z, w, acc[6]); acc[7] = fmaf(s1.w, w, acc[7]);
            }
#pragma unroll
            for (int b = 0; b < 8; ++b) red[(wave * 8 + b) * 64 + lane] = acc[b];
            __syncthreads();
            {
                float t = 0.f;
#pragma unroll
                for (int w = 0; w < 8; ++w) t += red[(w * 8 + wave) * 64 + lane];
                ((float*)(ws + WS_MOD))[(size_t)(l * 8 + wave) * NMOD + j0 + lane] = t + a.ada_b[l * NMOD + j0 + lane];
            }
            __syncthreads();
        }
    }
    {
        LAS float* scr = (LAS float*)(lds + 32768 + wave * 8448);
        constexpr int I_IN = 16 * 136, I_BR = 8 * 32, I_OUT = 16 * 32, I_Q = 16 * 64, I_L = I_IN + 2 * I_BR + I_OUT + I_Q;
        for (int it = gw; it < DEPTH * I_L; it += NGW) {
            const int l = it / I_L; int r = it % I_L;
            if (r < I_IN) { transpose_item<true>(a.w_in + (size_t)l * 1024 * NPROJ, 1024, NPROJ, (bf16_t*)(ws + WS_WIN) + (size_t)l * NPROJ * 1024, scr, r, lane); continue; } r -= I_IN;
            if (r < I_BR) { transpose_item<false>(a.wbr_a + (size_t)l * 512 * 1024, 512, 1024, (bf16_t*)(ws + WS_WBA) + (size_t)l * 1024 * 512, scr, r, lane); continue; } r -= I_BR;
            if (r < I_BR) { transpose_item<false>(a.wbr_b + (size_t)l * 512 * 1024, 512, 1024, (bf16_t*)(ws + WS_WBB) + (size_t)l * 1024 * 512, scr, r, lane); continue; } r -= I_BR;
            if (r < I_OUT) { transpose_item<false>(a.w_out + (size_t)l * 1024 * 1024, 1024, 1024, (bf16_t*)(ws + WS_WOUT) + (size_t)l * 1024 * 1024, scr, r, lane); continue; } r -= I_OUT;
            transpose_item<false>(a.wq + (size_t)l * 1024 * PQ, 1024, PQ, (bf16_t*)(ws + WS_WQ) + (size_t)l * PQ * 1024, scr, r, lane);
        }
    }
    {
        const int gt = op_bid() * NTHREADS + tid, NGT = G * NTHREADS;
        for (int i = gt; i < DEPTH * 8 * 2 * 128 * 128 / 8; i += NGT) {
            const f32x4 v0 = *(const f32x4*)(a.subkeys + (size_t)i * 8), v1 = *(const f32x4*)(a.subkeys + (size_t)i * 8 + 4);
            u32x4 o; o.x = pk2(v0.x, v0.y); o.y = pk2(v0.z, v0.w); o.z = pk2(v1.x, v1.y); o.w = pk2(v1.z, v1.w);
            *(u32x4*)((bf16_t*)(ws + WS_SK) + (size_t)i * 8) = o;
        }
        for (int i = gt; i < T * 32; i += NGT) {
            const int t = i >> 5, f = i & 31;
            double inv = 1.0;
            for (int k = 0; k < f; ++k) inv *= 0.7498942093324559;
            const double ang = (double)a.pos[t] * inv;
            const double kq = rint(ang * 0.63661977236758134308);
            const double r = fma(-kq, 6.123233995736766036e-17, fma(-kq, 1.57079632679489655800, ang));
            const int quad = (int)((long long)kq & 3);
            const double r2 = r * r;
            double sp = -1.0 / 1307674368000.0; sp = fma(sp, r2, 1.0 / 6227020800.0); sp = fma(sp, r2, -1.0 / 39916800.0); sp = fma(sp, r2, 1.0 / 362880.0);
            sp = fma(sp, r2, -1.0 / 5040.0); sp = fma(sp, r2, 1.0 / 120.0); sp = fma(sp, r2, -1.0 / 6.0); sp = fma(sp * r2, r, r);
            double cp = 1.0 / 20922789888000.0; cp = fma(cp, r2, -1.0 / 87178291200.0); cp = fma(cp, r2, 1.0 / 479001600.0); cp = fma(cp, r2, -1.0 / 3628800.0);
            cp = fma(cp, r2, 1.0 / 40320.0); cp = fma(cp, r2, -1.0 / 720.0); cp = fma(cp, r2, 1.0 / 24.0); cp = fma(cp, r2, -0.5); cp = fma(cp, r2, 1.0);
            const double sn = (quad == 0) ? sp : (quad == 1) ? cp : (quad == 2) ? -sp : -cp;
            const double cs = (quad == 0) ? cp : (quad == 1) ? -sp : (quad == 2) ? -cp : sp;
            float* rp = (float*)(ws + WS_ROPE) + (size_t)i * 2; rp[0] = (float)cs; rp[1] = (float)sn;
        }
    }
    for (int r = gw; r < DEPTH * 2 * NEXP; r += NGW) {
        const int tbl = r / (DEPTH * NEXP), lr = r % (DEPTH * NEXP);
        const float* src = (tbl == 0 ? a.pu : a.pv) + (size_t)lr * 1024;
        f32x4 v[4];
        if (tbl == 0) {
#pragma unroll
            for (int i = 0; i < 4; ++i) v[i] = ((const f32x4*)src)[64 * i + lane];
            quant_row<false>(v, ws + WS_UQ + (size_t)lr * 1024, (float*)(ws + WS_USC) + lr, lane);
        } else {
#pragma unroll
            for (int i = 0; i < 4; ++i) v[i] = ((const f32x4*)src)[4 * lane + i];
            const int l = lr / NEXP, e = lr % NEXP;
            quant_row<false>(v, ws + WS_VQ + (size_t)l * NEXP * 1024 + ((size_t)(lane >> 3) * NEXP + e) * 128 + 16 * (lane & 7) - 16 * lane, (float*)(ws + WS_VSC) + lr, lane);
        }
    }
    if (op_bid() == 0) for (int i = tid; i < DEPTH * 2 * 8 * 64; i += NTHREADS) ((unsigned*)(ws + WS_CTL))[CTL_QUEUE + i] = 0u;
}

template <bool WITH_Q8>
__device__ __forceinline__ void ph_norm(const KArgs& a, const float* xin, const float* g, const float* mod_l, int shift_idx, int scale_idx, int wv) {
    const int tid = phase_tid(wv), lane = tid & 63, wave = wv;
    const int gw = op_bid() * NWAVES + wave, NGW = op_grid() * NWAVES;
    bf16_t* H = (bf16_t*)(a.ws + WS_H);
    for (int row = gw; row < T; row += NGW) {
        const int b = row >> 12;
        f32x4 v[4]; float ss = 0.f;
#pragma unroll
        for (int i = 0; i < 4; ++i) { v[i] = ((const f32x4*)(xin + (size_t)row * DM))[64 * i + lane]; ss += (v[i].x * v[i].x + v[i].y * v[i].y) + (v[i].z * v[i].z + v[i].w * v[i].w); }
        ss = wave_sum(ss);
        const float r = 1.0f / sqrtf(ss * (1.0f / DM) + NORM_EPS);
#pragma unroll
        for (int i = 0; i < 4; ++i) {
            const int col = 256 * i + 4 * lane;
            const f32x4 gg = *(const f32x4*)(g + col), sc = *(const f32x4*)(mod_l + (size_t)b * NMOD + scale_idx * DM + col), sh = *(const f32x4*)(mod_l + (size_t)b * NMOD + shift_idx * DM + col);
            v[i] = (v[i] * r) * gg * (sc + 1.0f) + sh;
            u32x2 o; o.x = pk2(v[i].x, v[i].y); o.y = pk2(v[i].z, v[i].w);
            *(u32x2*)(H + (size_t)row * DM + col) = o;
        }
        if (WITH_Q8) quant_row<false>(v, a.ws + WS_H2Q + (size_t)row * 1024, (float*)(a.ws + WS_HS) + row, lane);
    }
}
__device__ __forceinline__ void ph_final_norm(const KArgs& a, int wv) {
    const int tid = phase_tid(wv), lane = tid & 63, wave = wv;
    const int gw = op_bid() * NWAVES + wave, NGW = op_grid() * NWAVES;
    for (int row = gw; row < T; row += NGW) {
        f32x4 v[4]; float ss = 0.f;
#pragma unroll
        for (int i = 0; i < 4; ++i) { v[i] = ((const f32x4*)(a.out + (size_t)row * DM))[64 * i + lane]; ss += (v[i].x * v[i].x + v[i].y * v[i].y) + (v[i].z * v[i].z + v[i].w * v[i].w); }
        ss = wave_sum(ss);
        const float r = 1.0f / sqrtf(ss * (1.0f / DM) + NORM_EPS);
#pragma unroll
        for (int i = 0; i < 4; ++i) { const f32x4 gg = *(const f32x4*)(a.final_g + 256 * i + 4 * lane); ((f32x4*)(a.out + (size_t)row * DM))[64 * i + lane] = (v[i] * r) * gg; }
    }
}

struct EpiProj {
    static constexpr bool PERM = true, AFTER_DRAIN = false;
    unsigned char* ws;
    __device__ __forceinline__ void operator()(const pg8::f32x4 (&acc)[2][2][4][2], const pg8::Unit& u, int wr, int wc, int fr, int fq) const {
        const int row0 = u.pm * 256 + wr * 64 + fr;
        const float* rope = (const float*)(ws + WS_ROPE);
#pragma unroll
        for (int bj = 0; bj < 2; ++bj) {
            const int cgb = u.pn * 256 + bj * 128;
            bf16_t* base; int pitch, cl, mode;
            if (cgb < 512) { base = (bf16_t*)(ws + WS_QA); pitch = 512; cl = cgb; mode = 1; }
            else if (cgb < 640) { base = (bf16_t*)(ws + WS_KA); pitch = 128; cl = cgb - 512; mode = 2; }
            else if (cgb < 768) { base = (bf16_t*)(ws + WS_VA); pitch = 128; cl = cgb - 640; mode = 0; }
            else if (cgb < 1280) { base = (bf16_t*)(ws + WS_QB); pitch = 512; cl = cgb - 768; mode = 3; }
            else if (cgb < 1792) { base = (bf16_t*)(ws + WS_KB); pitch = 512; cl = cgb - 1280; mode = 0; }
            else if (cgb < 2304) { base = (bf16_t*)(ws + WS_VB); pitch = 512; cl = cgb - 1792; mode = 0; }
            else if (cgb < 3328) { base = (bf16_t*)(ws + WS_GA); pitch = 1024; cl = cgb - 2304; mode = 4; }
            else { base = (bf16_t*)(ws + WS_GB); pitch = 1024; cl = cgb - 3328; mode = 4; }
            const int col = cl + wc * 32 + 8 * fq;
#pragma unroll
            for (int ai = 0; ai < 2; ++ai)
#pragma unroll
                for (int m = 0; m < 4; ++m) {
                    const int row = row0 + ai * 128 + m * 16;
                    pg8::f32x4 v0 = acc[ai][bj][m][0], v1 = acc[ai][bj][m][1];
                    if (mode == 1 || mode == 2) {
                        const int i0 = (col & 63) >> 1;
                        const f32x4 c01 = *(const f32x4*)(rope + ((size_t)row * 32 + i0) * 2), c23 = *(const f32x4*)(rope + ((size_t)row * 32 + i0 + 2) * 2);
                        pg8::f32x4 w0, w1;
                        w0[0] = v0[0] * c01.x - v0[1] * c01.y; w0[1] = v0[1] * c01.x + v0[0] * c01.y;
                        w0[2] = v0[2] * c01.z - v0[3] * c01.w; w0[3] = v0[3] * c01.z + v0[2] * c01.w;
                        w1[0] = v1[0] * c23.x - v1[1] * c23.y; w1[1] = v1[1] * c23.x + v1[0] * c23.y;
                        w1[2] = v1[2] * c23.z - v1[3] * c23.w; w1[3] = v1[3] * c23.z + v1[2] * c23.w;
                        v0 = w0; v1 = w1;
                    }
                    if (mode == 1 || mode == 3) { v0 = v0 * QSCALE; v1 = v1 * QSCALE; }
                    if (mode == 4) {
#pragma unroll
                        for (int e = 0; e < 4; ++e) { v0[e] = 1.0f / (1.0f + __expf(-v0[e])); v1[e] = 1.0f / (1.0f + __expf(-v1[e])); }
                    }
                    u32x4 w; w.x = pk2(v0[0], v0[1]); w.y = pk2(v0[2], v0[3]); w.z = pk2(v1[0], v1[1]); w.w = pk2(v1[2], v1[3]);
                    *(u32x4*)(base + (size_t)row * pitch + col) = w;
                }
        }
    }
};
template <bool ADD> struct EpiBranch {
    static constexpr bool PERM = true, AFTER_DRAIN = false;
    const bf16_t* Gt; bf16_t* O;
    __device__ __forceinline__ void operator()(const pg8::f32x4 (&acc)[2][2][4][2], const pg8::Unit& u, int wr, int wc, int fr, int fq) const {
        const int row0 = u.pm * 256 + wr * 64 + fr, col0 = u.pn * 256 + wc * 32 + 8 * fq;
#pragma unroll
        for (int ai = 0; ai < 2; ++ai)
#pragma unroll
            for (int m = 0; m < 4; ++m)
#pragma unroll
                for (int bj = 0; bj < 2; ++bj) {
                    const size_t off = (size_t)(row0 + ai * 128 + m * 16) * DM + col0 + bj * 128;
                    const u32x4 gv = *(const u32x4*)(Gt + off);
                    const pg8::f32x4 v0 = acc[ai][bj][m][0], v1 = acc[ai][bj][m][1];
                    float r[8];
                    r[0] = bflo(gv.x) * v0[0]; r[1] = bfhi(gv.x) * v0[1]; r[2] = bflo(gv.y) * v0[2]; r[3] = bfhi(gv.y) * v0[3];
                    r[4] = bflo(gv.z) * v1[0]; r[5] = bfhi(gv.z) * v1[1]; r[6] = bflo(gv.w) * v1[2]; r[7] = bfhi(gv.w) * v1[3];
                    if (ADD) { const u32x4 ov = *(const u32x4*)(O + off);
                        r[0] += bflo(ov.x); r[1] += bfhi(ov.x); r[2] += bflo(ov.y); r[3] += bfhi(ov.y); r[4] += bflo(ov.z); r[5] += bfhi(ov.z); r[6] += bflo(ov.w); r[7] += bfhi(ov.w); }
                    u32x4 w; w.x = pk2(r[0], r[1]); w.y = pk2(r[2], r[3]); w.z = pk2(r[4], r[5]); w.w = pk2(r[6], r[7]);
                    *(u32x4*)(O + off) = w;
                }
    }
};
struct EpiWout {
    static constexpr bool PERM = false, AFTER_DRAIN = false;
    const float* xold; float* xnew; const float* gate;
    __device__ __forceinline__ void operator()(const pg8::f32x4 (&acc)[2][2][4][2], const pg8::Unit& u, int wr, int wc, int fr, int fq) const {
        const int row0 = u.pm * 256 + wr * 64 + fr, col0 = u.pn * 256 + wc * 32 + 4 * fq, b = u.pm >> 4;
#pragma unroll
        for (int bj = 0; bj < 2; ++bj)
#pragma unroll
            for (int n = 0; n < 2; ++n) {
                const pg8::f32x4 gv = *(const pg8::f32x4*)(gate + (size_t)b * NMOD + col0 + bj * 128 + n * 16);
#pragma unroll
                for (int ai = 0; ai < 2; ++ai)
#pragma unroll
                    for (int m = 0; m < 4; ++m) { const size_t off = (size_t)(row0 + ai * 128 + m * 16) * DM + col0 + bj * 128 + n * 16;
                        const pg8::f32x4 xo = *(const pg8::f32x4*)(xold + off);
                        *(pg8::f32x4*)(xnew + off) = xo + gv * acc[ai][bj][m][n]; }
            }
    }
};
struct EpiPlainBf16 {
    static constexpr bool PERM = true, AFTER_DRAIN = false;
    bf16_t* O; int ldc;
    __device__ __forceinline__ void operator()(const pg8::f32x4 (&acc)[2][2][4][2], const pg8::Unit& u, int wr, int wc, int fr, int fq) const {
        const int row0 = u.pm * 256 + wr * 64 + fr, col0 = u.pn * 256 + wc * 32 + 8 * fq;
#pragma unroll
        for (int ai = 0; ai < 2; ++ai)
#pragma unroll
            for (int m = 0; m < 4; ++m)
#pragma unroll
                for (int bj = 0; bj < 2; ++bj) {
                    const pg8::f32x4 v0 = acc[ai][bj][m][0], v1 = acc[ai][bj][m][1];
                    u32x4 w; w.x = pk2(v0[0], v0[1]); w.y = pk2(v0[2], v0[3]); w.z = pk2(v1[0], v1[1]); w.w = pk2(v1[2], v1[3]);
                    *(u32x4*)(O + (size_t)(row0 + ai * 128 + m * 16) * ldc + col0 + bj * 128) = w;
                }
    }
};

namespace att {
typedef short bf16x8 __attribute__((ext_vector_type(8)));
typedef short s16x4 __attribute__((ext_vector_type(4)));
typedef float f32x16 __attribute__((ext_vector_type(16)));
__device__ __forceinline__ int crow(int r, int hi) { return (r & 3) + 8 * (r >> 2) + 4 * hi; }
typedef float f32x2_t __attribute__((ext_vector_type(2))); typedef __bf16 bf16x2_t __attribute__((ext_vector_type(2)));
__device__ __forceinline__ unsigned cvtpk(float lo, float hi) { f32x2_t v = {lo, hi}; bf16x2_t b = __builtin_convertvector(v, bf16x2_t); return __builtin_bit_cast(unsigned, b); }
#define ATT_SBAR() __builtin_amdgcn_sched_barrier(0)

__device__ __forceinline__ void qkt(f32x16& p0, f32x16& p1, const LAS unsigned char* kslot, const bf16x8 (&qr)[4], int r32, int hi) {
    const LAS unsigned char* kb = kslot + hi * 1024 + r32 * 16;
    p0 = f32x16{}; p1 = f32x16{};
#pragma unroll
    for (int d0 = 0; d0 < 4; ++d0) {
        const bf16x8 b0 = *(const LAS bf16x8*)(kb + d0 * 2048);
        const bf16x8 b1 = *(const LAS bf16x8*)(kb + d0 * 2048 + 512);
        p0 = __builtin_amdgcn_mfma_f32_32x32x16_bf16(b0, qr[d0], p0, 0, 0, 0);
        p1 = __builtin_amdgcn_mfma_f32_32x32x16_bf16(b1, qr[d0], p1, 0, 0, 0);
    }
}
__device__ __forceinline__ void pv(f32x16 (&o)[2], int vb, bf16x8 pa0, bf16x8 pa1, bf16x8 pa2, bf16x8 pa3) {
#pragma unroll
    for (int d0 = 0; d0 < 2; ++d0) {
        s16x4 lo[4], hh[4];
#pragma unroll
        for (int ks = 0; ks < 4; ++ks) {
            asm volatile("ds_read_b64_tr_b16 %0,%1 offset:%c2" : "=&v"(lo[ks]) : "v"(vb), "i"(d0 * 4096 + ks * 1024) : "memory");
            asm volatile("ds_read_b64_tr_b16 %0,%1 offset:%c2" : "=&v"(hh[ks]) : "v"(vb), "i"(d0 * 4096 + ks * 1024 + 512) : "memory");
        }
        asm volatile("s_waitcnt lgkmcnt(0)" ::: "memory"); ATT_SBAR();
#define ATT_PK(k) (bf16x8){lo[k][0], lo[k][1], lo[k][2], lo[k][3], hh[k][0], hh[k][1], hh[k][2], hh[k][3]}
        o[d0] = __builtin_amdgcn_mfma_f32_32x32x16_bf16(pa0, ATT_PK(0), o[d0], 0, 0, 0);
        o[d0] = __builtin_amdgcn_mfma_f32_32x32x16_bf16(pa1, ATT_PK(1), o[d0], 0, 0, 0);
        o[d0] = __builtin_amdgcn_mfma_f32_32x32x16_bf16(pa2, ATT_PK(2), o[d0], 0, 0, 0);
        o[d0] = __builtin_amdgcn_mfma_f32_32x32x16_bf16(pa3, ATT_PK(3), o[d0], 0, 0, 0);
#undef ATT_PK
    }
}
__device__ __forceinline__ void pack_p(const f32x16& p0, const f32x16& p1, bf16x8& pa0, bf16x8& pa1, bf16x8& pa2, bf16x8& pa3) {
    u32x4 w0, w1, w2, w3;
    w0 = (u32x4){cvtpk(p0[0], p0[1]), cvtpk(p0[2], p0[3]), cvtpk(p0[4], p0[5]), cvtpk(p0[6], p0[7])};
    w1 = (u32x4){cvtpk(p0[8], p0[9]), cvtpk(p0[10], p0[11]), cvtpk(p0[12], p0[13]), cvtpk(p0[14], p0[15])};
    w2 = (u32x4){cvtpk(p1[0], p1[1]), cvtpk(p1[2], p1[3]), cvtpk(p1[4], p1[5]), cvtpk(p1[6], p1[7])};
    w3 = (u32x4){cvtpk(p1[8], p1[9]), cvtpk(p1[10], p1[11]), cvtpk(p1[12], p1[13]), cvtpk(p1[14], p1[15])};
    pa0 = __builtin_bit_cast(bf16x8, w0); pa1 = __builtin_bit_cast(bf16x8, w1); pa2 = __builtin_bit_cast(bf16x8, w2); pa3 = __builtin_bit_cast(bf16x8, w3);
}
__device__ __forceinline__ u32x4 tile_gload(const bf16_t* src, int pitch, int tid) { return *(const u32x4*)(src + (size_t)(tid >> 3) * pitch + (tid & 7) * 8); }
__device__ __forceinline__ void tile_kwrite(LAS unsigned char* kslot, u32x4 v, int tid) { *(LAS u32x4*)(kslot + (tid & 7) * 1024 + (tid >> 3) * 16) = v; }
__device__ __forceinline__ void tile_vwrite(LAS unsigned char* vslot, u32x4 v, int tid) { const int c = tid & 7; *(LAS u32x4*)(vslot + (c >> 2) * 4096 + (tid >> 3) * 64 + (c & 3) * 16) = v; }
__device__ __forceinline__ void store_o(const f32x16 (&o)[2], const float (&rs)[16], LAS unsigned char* stage, bf16_t* Ow, int pitch, int lane) {
    asm volatile("" : "+v"(lane));
    const int r32 = lane & 31, hi = lane >> 5;
    LAS bf16_t* stg = (LAS bf16_t*)stage;
#pragma unroll
    for (int r = 0; r < 16; ++r) { const int orow = crow(r, hi);
#pragma unroll
        for (int d0 = 0; d0 < 2; ++d0) stg[orow * 64 + d0 * 32 + r32] = (bf16_t)f2bf(o[d0][r] * rs[r]); }
    asm volatile("s_waitcnt lgkmcnt(0)" ::: "memory");
#pragma unroll
    for (int i = 0; i < 4; ++i) { const int row = i * 8 + (lane >> 3), ch = lane & 7; const u32x4 v = *(const LAS u32x4*)(stg + row * 64 + ch * 8); *(u32x4*)(Ow + (size_t)row * pitch + ch * 8) = v; }
    asm volatile("s_waitcnt lgkmcnt(0)" ::: "memory");
}

constexpr int SB_WLDS = 8192;
template <bool EARLY_EXIT>
__device__ __forceinline__ void sb_phase(const bf16_t* Q, const bf16_t* K, const bf16_t* V, bf16_t* O, LAS unsigned char* lds, int wv) {
    const int tid = phase_tid(wv), lane = tid & 63, r32 = lane & 31, hi = lane >> 5, wid = wv;
    LAS unsigned char* vimg = lds + wid * SB_WLDS;
    const int vb0 = (int)(unsigned)(uintptr_t)vimg + ((lane >> 4) & 1) * 32 + (lane & 3) * 8 + (4 * hi + ((lane & 15) >> 2)) * 64;
    const int vwoff = ((lane & 7) >> 2) * 4096 + (lane >> 3) * 64 + (lane & 3) * 16;
    const float m0 = hi == 0 ? 1.0f : 0.0f;
    const int gw = op_bid() * NWAVES + wid, NGW = op_grid() * NWAVES;
    for (int wu = gw; wu < BATCH * 8 * (SEQ / 32); wu += NGW) {
        const int rb = wu & 127, h = (wu >> 7) & 7, b = wu >> 10;
        const int R0 = rb * 32;
        const size_t rowbase = (size_t)b * SEQ;
        const char* Kb = (const char*)(K + rowbase * 512 + h * 64); const char* Vb = (const char*)(V + rowbase * 512 + h * 64);
        const unsigned koff = (unsigned)(r32 * 1024 + hi * 16), voff = (unsigned)((lane >> 3) * 1024 + (lane & 7) * 16);
        const bf16_t* Qw = Q + (rowbase + R0) * 512 + h * 64;
        bf16x8 qr[4];
#pragma unroll
        for (int d0 = 0; d0 < 4; ++d0) qr[d0] = *(const bf16x8*)((const char*)Qw + koff + d0 * 32);
        int kt = R0 >> 6;
        bf16x8 kf[8]; u32x4 vr[8];
#define SB_LOADK(KT) do { const char* k0_ = Kb + (size_t)(KT) * 65536; const char* k1_ = k0_ + 32768; _Pragma("unroll") for (int d0 = 0; d0 < 4; ++d0) { kf[2 * d0] = *(const bf16x8*)(k0_ + koff + d0 * 32); kf[2 * d0 + 1] = *(const bf16x8*)(k1_ + koff + d0 * 32); } } while (0)
#define SB_LOADV(KT) do { const char* v0_ = Vb + (size_t)(KT) * 65536; _Pragma("unroll") for (int i = 0; i < 8; ++i) vr[i] = *(const u32x4*)(v0_ + i * 8192 + voff); } while (0)
        SB_LOADK(kt); SB_LOADV(kt);
        f32x16 o[2]; o[0] = f32x16{}; o[1] = f32x16{};
        float carry = 0.f;
        for (;;) {
            f32x16 p0 = f32x16{}, p1 = f32x16{};
#pragma unroll
            for (int d0 = 0; d0 < 4; ++d0) { p0 = __builtin_amdgcn_mfma_f32_32x32x16_bf16(kf[2 * d0], qr[d0], p0, 0, 0, 0); p1 = __builtin_amdgcn_mfma_f32_32x32x16_bf16(kf[2 * d0 + 1], qr[d0], p1, 0, 0, 0); }
            const bool more = kt > 0;
#pragma unroll
            for (int i = 0; i < 8; ++i) *(LAS u32x4*)(vimg + vwoff + i * 512) = vr[i];
            const int D = R0 - 64 * kt;
            if (D < 64) {
                const int thr = D + r32 - 4 * hi;
#pragma unroll
                for (int r = 0; r < 16; ++r) { const int cr = (r & 3) + 8 * (r >> 2); if (cr >= thr) p0[r] = -INFINITY; if (cr + 32 >= thr) p1[r] = -INFINITY; }
            }
            float tt[8], uu[8];
#define SB_SP(x) (fmaxf(x, 0.f) + __builtin_amdgcn_logf(1.0f + __builtin_amdgcn_exp2f(-fabsf(x))))
#pragma unroll
            for (int i = 0; i < 4; ++i) {
                float s3 = SB_SP(p0[4 * i + 3]), s2 = s3 + SB_SP(p0[4 * i + 2]), s1 = s2 + SB_SP(p0[4 * i + 1]), s0 = s1 + SB_SP(p0[4 * i]);
                p0[4 * i + 3] -= s3; p0[4 * i + 2] -= s2; p0[4 * i + 1] -= s1; p0[4 * i] -= s0; tt[i] = s0;
                s3 = SB_SP(p1[4 * i + 3]); s2 = s3 + SB_SP(p1[4 * i + 2]); s1 = s2 + SB_SP(p1[4 * i + 1]); s0 = s1 + SB_SP(p1[4 * i]);
                p1[4 * i + 3] -= s3; p1[4 * i + 2] -= s2; p1[4 * i + 1] -= s1; p1[4 * i] -= s0; tt[4 + i] = s0;
                __builtin_amdgcn_sched_barrier(0);
            }
#undef SB_SP
#pragma unroll
            for (int k = 0; k < 8; ++k) { auto rr = __builtin_amdgcn_permlane32_swap(__float_as_uint(tt[k]), __float_as_uint(tt[k]), false, false); uu[k] = __uint_as_float(hi ? rr[0] : rr[1]); }
            float sw = 0.f;
#pragma unroll
            for (int k = 7; k >= 0; --k) {
                const float bs = carry - (sw + m0 * uu[k]); sw += tt[k] + uu[k];
                if (k < 4) { p0[4 * k] = __builtin_amdgcn_exp2f(p0[4 * k] + bs); p0[4 * k + 1] = __builtin_amdgcn_exp2f(p0[4 * k + 1] + bs); p0[4 * k + 2] = __builtin_amdgcn_exp2f(p0[4 * k + 2] + bs); p0[4 * k + 3] = __builtin_amdgcn_exp2f(p0[4 * k + 3] + bs); }
                else { const int i = k - 4; p1[4 * i] = __builtin_amdgcn_exp2f(p1[4 * i] + bs); p1[4 * i + 1] = __builtin_amdgcn_exp2f(p1[4 * i + 1] + bs); p1[4 * i + 2] = __builtin_amdgcn_exp2f(p1[4 * i + 2] + bs); p1[4 * i + 3] = __builtin_amdgcn_exp2f(p1[4 * i + 3] + bs); }
            }
            carry -= sw;
            bf16x8 pa0, pa1, pa2, pa3; pack_p(p0, p1, pa0, pa1, pa2, pa3);
            if (more) { SB_LOADK(kt - 1); SB_LOADV(kt - 1); }
            pv(o, vb0, pa0, pa1, pa2, pa3);
            if (!more) break;
            if (EARLY_EXIT && __all(carry < -SB_EXIT)) break;
            --kt;
        }
        float ones[16];
#pragma unroll
        for (int r = 0; r < 16; ++r) ones[r] = 1.0f;
        store_o(o, ones, vimg, O + (rowbase + R0) * 512 + h * 64, 512, phase_tid(wv) & 63);
    }
#undef SB_LOADK
#undef SB_LOADV
}

constexpr int SW_K0 = 0, SW_V0 = 24576, SW_STAGE = 49152, SW_WSF = 81920, SW_LDS_END = 81920 + 2048;
__device__ __forceinline__ void swa_phase(const bf16_t* Q, const bf16_t* K, const bf16_t* V, bf16_t* O, const float* sinks, LAS unsigned char* lds, int wv) {
        const int tid = phase_tid(wv), lane = tid & 63, r32 = lane & 31, hi = lane >> 5, wid = wv;
    const int vb0 = (int)(unsigned)(uintptr_t)(lds + SW_V0) + ((lane >> 4) & 1) * 32 + (lane & 3) * 8 + (4 * hi + ((lane & 15) >> 2)) * 64;
    LAS float* wsf = (LAS float*)(lds + SW_WSF) + wid * 64;
    const int g = wid >> 1, j = wid & 1;
    for (int unit = op_bid(); unit < BATCH * 2 * 64; unit += op_grid()) {
        const int qb = unit & 63, kvh = (unit >> 6) & 1, b = unit >> 7;
        const int q0 = qb * 64, hq = kvh * 4 + g;
        const size_t rowbase = (size_t)b * SEQ;
        const bf16_t* Kh = K + rowbase * 128 + kvh * 64; const bf16_t* Vh = V + rowbase * 128 + kvh * 64;
        const bf16_t* Qw = Q + (rowbase + q0 + j * 32) * 512 + hq * 64;
        __syncthreads();
#pragma unroll
        for (int i = 0; i < 3; ++i) { const int kt = qb - 2 + i;
            if (kt >= 0) { const u32x4 kv = tile_gload(Kh + (size_t)kt * 64 * 128, 128, tid), vv = tile_gload(Vh + (size_t)kt * 64 * 128, 128, tid);
                tile_kwrite(lds + SW_K0 + i * 8192, kv, tid); tile_vwrite(lds + SW_V0 + i * 8192, vv, tid); } }
        bf16x8 qr[4];
#pragma unroll
        for (int d0 = 0; d0 < 4; ++d0) qr[d0] = *(const bf16x8*)(Qw + (size_t)r32 * 512 + d0 * 16 + hi * 8);
        __syncthreads();
        const int qrel4 = 32 * j + r32 - 4 * hi;
        const float sink2 = sinks[hq] * LOG2E;
        float m = sink2;
#pragma unroll
        for (int i = 0; i < 3; ++i) {
            if (qb - 2 + i >= 0) {
                f32x16 p0, p1;
                qkt(p0, p1, lds + SW_K0 + i * 8192, qr, r32, hi);
#pragma unroll
                for (int r = 0; r < 16; ++r) { const int kv = (r & 3) + 8 * (r >> 2);
                    bool v0 = true, v1 = true;
                    if (i == 2) { v0 = kv <= qrel4; v1 = kv + 32 <= qrel4; }
                    if (i == 0) { v0 = kv > qrel4; v1 = kv + 32 > qrel4; }
                    m = fmaxf(m, fmaxf(v0 ? p0[r] : -INFINITY, v1 ? p1[r] : -INFINITY)); }
            }
        }
        { auto rr = __builtin_amdgcn_permlane32_swap(__float_as_uint(m), __float_as_uint(m), false, false); m = fmaxf(__uint_as_float(rr[0]), __uint_as_float(rr[1])); }
        float lsum = 0.f;
        f32x16 o[2]; o[0] = f32x16{}; o[1] = f32x16{};
#pragma unroll
        for (int i = 0; i < 3; ++i) {
            if (qb - 2 + i >= 0) {
                f32x16 p0, p1;
                qkt(p0, p1, lds + SW_K0 + i * 8192, qr, r32, hi);
#pragma unroll
                for (int r = 0; r < 16; ++r) { const int kv = (r & 3) + 8 * (r >> 2);
                    bool v0 = true, v1 = true;
                    if (i == 2) { v0 = kv <= qrel4; v1 = kv + 32 <= qrel4; }
                    if (i == 0) { v0 = kv > qrel4; v1 = kv + 32 > qrel4; }
                    p0[r] = v0 ? exp2f(p0[r] - m) : 0.f; p1[r] = v1 ? exp2f(p1[r] - m) : 0.f; lsum += p0[r] + p1[r]; }
                bf16x8 pa0, pa1, pa2, pa3; pack_p(p0, p1, pa0, pa1, pa2, pa3); pv(o, vb0 + i * 8192, pa0, pa1, pa2, pa3);
            }
        }
        { auto rr = __builtin_amdgcn_permlane32_swap(__float_as_uint(lsum), __float_as_uint(lsum), false, false); lsum = __uint_as_float(rr[0]) + __uint_as_float(rr[1]); }
        lsum += exp2f(sink2 - m);
        if (hi == 0) wsf[r32] = 1.0f / lsum;
        asm volatile("s_waitcnt lgkmcnt(0)" ::: "memory");
        float rs[16];
#pragma unroll
        for (int r = 0; r < 16; ++r) rs[r] = wsf[crow(r, hi)];
        asm volatile("s_waitcnt lgkmcnt(0)" ::: "memory");
        store_o(o, rs, lds + SW_STAGE + wid * 4096, O + (rowbase + q0 + j * 32) * 512 + hq * 64, 512, lane);
    }
}
#undef ATT_SBAR
}

namespace tk {
typedef short bf16x8 __attribute__((ext_vector_type(8)));
typedef float f32x16 __attribute__((ext_vector_type(16)));
__device__ __forceinline__ float vmax(float a, float b) { float r; asm("v_max_f32 %0, %1, %2" : "=v"(r) : "v"(a), "v"(b)); return r; }
__device__ __forceinline__ float vmin(float a, float b) { float r; asm("v_min_f32 %0, %1, %2" : "=v"(r) : "v"(a), "v"(b)); return r; }
#define TK_CE(a, b) { const float t_ = vmax(a, b); b = vmin(a, b); a = t_; }
__device__ __forceinline__ void sort16(float (&v)[16]) {
    TK_CE(v[0], v[1]) TK_CE(v[2], v[3]) TK_CE(v[0], v[2]) TK_CE(v[1], v[3]) TK_CE(v[1], v[2]) TK_CE(v[4], v[5]) TK_CE(v[6], v[7]) TK_CE(v[4], v[6])
    TK_CE(v[5], v[7]) TK_CE(v[5], v[6]) TK_CE(v[0], v[4]) TK_CE(v[2], v[6]) TK_CE(v[2], v[4]) TK_CE(v[1], v[5]) TK_CE(v[3], v[7]) TK_CE(v[3], v[5])
    TK_CE(v[1], v[2]) TK_CE(v[3], v[4]) TK_CE(v[5], v[6]) TK_CE(v[8], v[9]) TK_CE(v[10], v[11]) TK_CE(v[8], v[10]) TK_CE(v[9], v[11]) TK_CE(v[9], v[10])
    TK_CE(v[12], v[13]) TK_CE(v[14], v[15]) TK_CE(v[12], v[14]) TK_CE(v[13], v[15]) TK_CE(v[13], v[14]) TK_CE(v[8], v[12]) TK_CE(v[10], v[14]) TK_CE(v[10], v[12])
    TK_CE(v[9], v[13]) TK_CE(v[11], v[15]) TK_CE(v[11], v[13]) TK_CE(v[9], v[10]) TK_CE(v[11], v[12]) TK_CE(v[13], v[14]) TK_CE(v[0], v[8]) TK_CE(v[4], v[12])
    TK_CE(v[4], v[8]) TK_CE(v[2], v[10]) TK_CE(v[6], v[14]) TK_CE(v[6], v[10]) TK_CE(v[2], v[4]) TK_CE(v[6], v[8]) TK_CE(v[10], v[12]) TK_CE(v[1], v[9])
    TK_CE(v[5], v[13]) TK_CE(v[5], v[9]) TK_CE(v[3], v[11]) TK_CE(v[7], v[15]) TK_CE(v[7], v[11]) TK_CE(v[3], v[5]) TK_CE(v[7], v[9]) TK_CE(v[11], v[13])
    TK_CE(v[1], v[2]) TK_CE(v[3], v[4]) TK_CE(v[5], v[6]) TK_CE(v[7], v[8]) TK_CE(v[9], v[10]) TK_CE(v[11], v[12]) TK_CE(v[13], v[14])
}
__device__ __forceinline__ void bmerge16(float (&v)[16]) {
    TK_CE(v[0], v[8]) TK_CE(v[1], v[9]) TK_CE(v[2], v[10]) TK_CE(v[3], v[11]) TK_CE(v[4], v[12]) TK_CE(v[5], v[13]) TK_CE(v[6], v[14]) TK_CE(v[7], v[15])
    TK_CE(v[0], v[4]) TK_CE(v[1], v[5]) TK_CE(v[2], v[6]) TK_CE(v[3], v[7]) TK_CE(v[8], v[12]) TK_CE(v[9], v[13]) TK_CE(v[10], v[14]) TK_CE(v[11], v[15])
    TK_CE(v[0], v[2]) TK_CE(v[1], v[3]) TK_CE(v[4], v[6]) TK_CE(v[5], v[7]) TK_CE(v[8], v[10]) TK_CE(v[9], v[11]) TK_CE(v[12], v[14]) TK_CE(v[13], v[15])
    TK_CE(v[0], v[1]) TK_CE(v[2], v[3]) TK_CE(v[4], v[5]) TK_CE(v[6], v[7]) TK_CE(v[8], v[9]) TK_CE(v[10], v[11]) TK_CE(v[12], v[13]) TK_CE(v[14], v[15])
}

__device__ __forceinline__ void merge_top16(float (&a)[16], const float (&b)[16]) {
#pragma unroll
    for (int i = 0; i < 16; ++i) a[i] = vmax(a[i], b[15 - i]);
    bmerge16(a);
}
__device__ __forceinline__ float partner_f(float v, int hi) { auto rr = __builtin_amdgcn_permlane32_swap(__float_as_uint(v), __float_as_uint(v), false, false); return __uint_as_float(hi ? rr[0] : rr[1]); }
__device__ __forceinline__ void merge_partner(float (&a)[16], int hi) {
    float pp[16];
#pragma unroll
    for (int i = 0; i < 16; ++i) pp[i] = partner_f(a[i], hi);
    merge_top16(a, pp);
}
__device__ __forceinline__ void take_block(float (&v)[16], const f32x16& acc, int blk, unsigned hi4) {
#pragma unroll
    for (int r = 0; r < 16; ++r) { const unsigned code = 127u - (unsigned)(32 * blk + (r & 3) + 8 * (r >> 2)); v[r] = __uint_as_float(((__float_as_uint(acc[r]) & 0xFFFFFF80u) | code) ^ hi4); }
    sort16(v);
}
constexpr int TK_SK = 0, TK_IDX = 65536, TK_LDS_END = 65536 + 8192;
constexpr float TK_NEG = -3.4028234663852886e38f;
template <int P>
__device__ __forceinline__ void half_top16(float (&L)[16], const bf16_t* qrow, LAS unsigned char* lds, LAS unsigned char* idxslot, int r32, int hi) {
    bf16x8 qf[8];
#pragma unroll
    for (int ks = 0; ks < 8; ++ks) qf[ks] = *(const bf16x8*)(qrow + P * 128 + 16 * ks + 8 * hi);
    f32x16 acc[4];
#pragma unroll
    for (int blk = 0; blk < 4; ++blk) acc[blk] = f32x16{};
    const LAS unsigned char* ab = lds + TK_SK + P * 32768 + hi * 2048 + r32 * 16;
#pragma unroll
    for (int ks = 0; ks < 8; ++ks)
#pragma unroll
        for (int blk = 0; blk < 4; ++blk) {
            const bf16x8 af = *(const LAS bf16x8*)(ab + ks * 4096 + blk * 512);
            acc[blk] = __builtin_amdgcn_mfma_f32_32x32x16_bf16(af, qf[ks], acc[blk], 0, 0, 0);
        }
    const unsigned hi4 = (unsigned)hi << 2;
    float M[16];
    take_block(L, acc[0], 0, hi4); take_block(M, acc[1], 1, hi4); merge_top16(L, M);
    { float N[16]; take_block(M, acc[2], 2, hi4); take_block(N, acc[3], 3, hi4); merge_top16(M, N); }
    merge_top16(L, M);
    merge_partner(L, hi);
    if (hi == 0) {
        u32x4 w;
#pragma unroll
        for (int q = 0; q < 4; ++q) w[q] = (__float_as_uint(L[4 * q]) & 127u) | ((__float_as_uint(L[4 * q + 1]) & 127u) << 8) | ((__float_as_uint(L[4 * q + 2]) & 127u) << 16) | ((__float_as_uint(L[4 * q + 3]) & 127u) << 24);
        *(LAS u32x4*)(idxslot + P * 16) = w;
    }
}
__device__ __forceinline__ float cand(float x, float y, unsigned code, unsigned hi8) { return __uint_as_float((__float_as_uint(x + y) & 0xFFFFFE00u) | code | hi8); }

__device__ __forceinline__ void topk_phase(const bf16_t* Q2, const bf16_t* SKl, int* IDX, float* GATE, LAS unsigned char* lds, int wv) {
        const int tid = phase_tid(wv), lane = tid & 63, r32 = lane & 31, hi = lane >> 5, wid = wv;
    LAS unsigned char* idxslot = lds + TK_IDX + wid * 1024 + r32 * 32;
    int cur_h = -1;
    for (int unit = op_bid(); unit < 8 * (T / 256); unit += op_grid()) {
        const int h = unit & 7, tb = unit >> 3;
        if (h != cur_h) {
            __syncthreads();
#pragma unroll
            for (int i = 0; i < 8; ++i) { const int id = tid + 512 * i, c = id & 15, n = (id >> 4) & 127, p = id >> 11;
                const u32x4 v = *(const u32x4*)(SKl + ((size_t)(h * 2 + p) * 128 + n) * 128 + c * 8);
                *(LAS u32x4*)(lds + TK_SK + p * 32768 + c * 2048 + n * 16) = v; }
            __syncthreads();
            cur_h = h;
        }
        const size_t token = (size_t)tb * 256 + wid * 32 + r32;
        const bf16_t* qrow = Q2 + token * PQ + h * 256;
        float a[16], b[16];
        half_top16<0>(a, qrow, lds, idxslot, r32, hi);
        half_top16<1>(b, qrow, lds, idxslot, r32, hi);
        float x[16], y[16];
#pragma unroll
        for (int i = 0; i < 16; ++i) { float av = a[i], bv = b[i]; asm volatile("" : "+v"(av), "+v"(bv)); x[i] = hi ? bv : av; y[i] = hi ? av : bv; }
        const unsigned hi8 = (unsigned)hi << 8;
        float A[16], B[16];
#pragma unroll
        for (int j = 1; j < 16; ++j) A[j - 1] = cand(x[0], y[j], (unsigned)j, hi8);
        A[15] = TK_NEG;
#pragma unroll
        for (int j = 2; j < 8; ++j) B[j - 2] = cand(x[1], y[j], (unsigned)(16 + j), hi8);
        B[6] = cand(x[2], y[3], 2u * 16u + 3u, hi8); B[7] = cand(x[2], y[4], 2u * 16u + 4u, hi8);
#pragma unroll
        for (int i = 0; i < 4; ++i) { const float d = cand(x[i], y[i], (unsigned)(17 * i), hi8); B[8 + i] = hi ? TK_NEG : d; }
        B[12] = TK_NEG; B[13] = TK_NEG; B[14] = TK_NEG; B[15] = TK_NEG;
        sort16(B);
        merge_top16(A, B);
        merge_partner(A, hi);
        const float smax = A[0];
        float ex[8]; int eidx[8]; float lsum = 0.f;
        asm volatile("s_waitcnt lgkmcnt(0)" ::: "memory");
#pragma unroll
        for (int k = 0; k < 8; ++k) {
            float s_lo = A[k], s_hi = A[8 + k]; asm volatile("" : "+v"(s_lo), "+v"(s_hi)); const float s = hi ? s_hi : s_lo;
            ex[k] = __expf(s - smax); lsum += ex[k];
            const unsigned code = __float_as_uint(s) & 0x1FFu, src = code >> 8, ci = (code >> 4) & 15u, cj = code & 15u;
            const unsigned ai = src ? cj : ci, bi = src ? ci : cj;
            const unsigned ca = idxslot[ai], cb = idxslot[16 + bi];
            eidx[k] = (int)(((ca ^ 127u) << 7) | (cb ^ 127u));
        }
        const float tot = lsum + partner_f(lsum, hi);
        const float inv = 1.0f / tot;
        int* ip = IDX + token * 128 + h * 16 + 8 * hi; float* gp = GATE + token * 128 + h * 16 + 8 * hi;
        *(u32x4*)ip = (u32x4){(unsigned)eidx[0], (unsigned)eidx[1], (unsigned)eidx[2], (unsigned)eidx[3]};
        *(u32x4*)(ip + 4) = (u32x4){(unsigned)eidx[4], (unsigned)eidx[5], (unsigned)eidx[6], (unsigned)eidx[7]};
        *(f32x4*)gp = (f32x4){ex[0] * inv, ex[1] * inv, ex[2] * inv, ex[3] * inv};
        *(f32x4*)(gp + 4) = (f32x4){ex[4] * inv, ex[5] * inv, ex[6] * inv, ex[7] * inv};
        asm volatile("s_waitcnt lgkmcnt(0)" ::: "memory");
    }
}
}

namespace peer3 {
__device__ __forceinline__ unsigned xcc_id() { return (unsigned)__builtin_amdgcn_s_getreg((3 << 11) | 20) & 7u; }
constexpr int UNIT = 16, NUNIT = T / UNIT;
template <int CTRL> __device__ __forceinline__ int dpp_i(int v) { return __builtin_amdgcn_update_dpp(0, v, CTRL, 0xF, 0xF, true); }
__device__ __forceinline__ int rowsum16(int v) { v += dpp_i<0xB1>(v); v += dpp_i<0x4E>(v); v += dpp_i<0x141>(v); v += dpp_i<0x140>(v); return v; }
__device__ __forceinline__ float gelu_as(float v) {
    const float av = fabsf(v), t = __builtin_amdgcn_rcpf(fmaf(av, 0.2316418882f, 1.0f));
    float q = fmaf(t, 0.5307027145f, -0.7265760135f); q = fmaf(q, t, 0.7107068705f); q = fmaf(q, t, -0.142248368f); q = fmaf(q, t, 0.127414796f); q = q * t;
    const float e = __builtin_amdgcn_exp2f(v * v * -0.72134752044f), m = v * (q * e);
    return v < 0.f ? m : v - m;
}
__device__ __forceinline__ unsigned take_async(unsigned* p, int lane) { unsigned v = 0u; if (lane == 0) v = __hip_atomic_fetch_add(p, 1u, __ATOMIC_RELAXED, __HIP_MEMORY_SCOPE_AGENT); return v; }

constexpr int UST = 6;
__device__ __forceinline__ void u_unit(const KArgs& a, int l, unsigned s, unsigned unit, LAS unsigned char* wlds, int lane) {
    const unsigned char* UQ = a.ws + WS_UQ + (size_t)l * NEXP * 1024;
    const float* USC = (const float*)(a.ws + WS_USC) + l * NEXP; const float* VSC = (const float*)(a.ws + WS_VSC) + l * NEXP;
    const int* IDX = (const int*)(a.ws + WS_IDX); const float* GATE = (const float*)(a.ws + WS_GATE);
    const unsigned char* HQ = a.ws + WS_H2Q; const float* HS = (const float*)(a.ws + WS_HS);
    float* COEF = (float*)(a.ws + WS_COEF);
    LAS int* lst = (LAS int*)wlds; LAS float* res = (LAS float*)(wlds + 512);
    const int q = lane >> 4, r = lane & 15;
    const size_t t0 = (size_t)unit * UNIT;
    int idx0 = IDX[t0 * 128 + lane], idx1 = IDX[t0 * 128 + 64 + lane];
    float g0 = GATE[t0 * 128 + lane], g1 = GATE[t0 * 128 + 64 + lane], sh = HS[t0];
    u32x4 hv[4];
#pragma unroll
    for (int k = 0; k < 4; ++k) hv[k] = *(const u32x4*)(HQ + t0 * 1024 + 256 * k + 16 * r);
#pragma unroll 1
    for (int i = 0; i < UNIT; ++i) {
        const size_t t = t0 + i, tn = t0 + (i + 1 < UNIT ? i + 1 : i);
        const bool in0 = (unsigned)(idx0 >> 11) == s, in1 = (unsigned)(idx1 >> 11) == s;
        float us0 = 0.f, us1 = 0.f, vs0 = 0.f, vs1 = 0.f;
        if (in0) { us0 = USC[idx0]; vs0 = VSC[idx0]; }
        if (in1) { us1 = USC[idx1]; vs1 = VSC[idx1]; }
        const int nidx0 = IDX[tn * 128 + lane], nidx1 = IDX[tn * 128 + 64 + lane];
        const float ng0 = GATE[tn * 128 + lane], ng1 = GATE[tn * 128 + 64 + lane], nsh = HS[tn];
        const unsigned long long m0 = __ballot(in0), m1 = __ballot(in1);
        const int c0 = __builtin_popcountll(m0), n = c0 + __builtin_popcountll(m1);
        const int rank0 = (int)__builtin_amdgcn_mbcnt_hi((unsigned)(m0 >> 32), __builtin_amdgcn_mbcnt_lo((unsigned)m0, 0u));
        const int rank1 = c0 + (int)__builtin_amdgcn_mbcnt_hi((unsigned)(m1 >> 32), __builtin_amdgcn_mbcnt_lo((unsigned)m1, 0u));
        if (in0) lst[rank0] = idx0;
        if (in1) lst[rank1] = idx1;
#pragma unroll 1
        for (int base = 0; base < n; base += 4 * UST) {
            const int nst = (n - base + 3) >> 2;
            u32x4 uv[UST][4];
#pragma unroll
            for (int st = 0; st < UST; ++st) {
                if (st < nst) {
                    int slot = base + 4 * st + q; slot = slot < n ? slot : n - 1;
                    const unsigned char* rp = UQ + (size_t)lst[slot] * 1024 + 16 * r;
#pragma unroll
                    for (int k = 0; k < 4; ++k) uv[st][k] = *(const u32x4*)(rp + 256 * k);
                }
            }
#pragma unroll
            for (int st = 0; st < UST; ++st) {
                if (st < nst) {
                    int s0_ = 0, s1_ = 0, s2_ = 0, s3_ = 0;
#pragma unroll
                    for (int k = 0; k < 4; ++k) {
                        s0_ = __builtin_amdgcn_sdot4((int)uv[st][k].x, (int)hv[k].x, s0_, false); s1_ = __builtin_amdgcn_sdot4((int)uv[st][k].y, (int)hv[k].y, s1_, false);
                        s2_ = __builtin_amdgcn_sdot4((int)uv[st][k].z, (int)hv[k].z, s2_, false); s3_ = __builtin_amdgcn_sdot4((int)uv[st][k].w, (int)hv[k].w, s3_, false);
                    }
                    const int tot = rowsum16((s0_ + s1_) + (s2_ + s3_));
                    if (r == 0) res[base + 4 * st + q] = (float)tot;
                }
            }
        }
        const float d0 = in0 ? res[rank0] : 0.f, d1 = in1 ? res[rank1] : 0.f;
        u32x4 nhv[4];
#pragma unroll
        for (int k = 0; k < 4; ++k) nhv[k] = *(const u32x4*)(HQ + tn * 1024 + 256 * k + 16 * r);
        if (in0) COEF[t * 128 + lane] = gelu_as(d0 * us0 * sh) * g0 * vs0;
        if (in1) COEF[t * 128 + 64 + lane] = gelu_as(d1 * us1 * sh) * g1 * vs1;
        idx0 = nidx0; idx1 = nidx1; g0 = ng0; g1 = ng1; sh = nsh;
#pragma unroll
        for (int k = 0; k < 4; ++k) hv[k] = nhv[k];
    }
}
struct VMeta { u32x4 iv[4]; f32x4 cv[4]; };
__device__ __forceinline__ void v_meta(VMeta& m, const int* IDX, const float* COEF, size_t t, int g) {
#pragma unroll
    for (int q = 0; q < 4; ++q) { m.iv[q] = *(const u32x4*)(IDX + t * 128 + 16 * g + 4 * q); m.cv[q] = *(const f32x4*)(COEF + t * 128 + 16 * g + 4 * q); }
}
__device__ __forceinline__ void v_stage(u32x4 (&P)[16], u32x4& CQ, float& cs, const VMeta& m, const unsigned char* VS) {
    float cm = 0.f;
#pragma unroll
    for (int j = 0; j < 16; ++j) cm = fmaxf(cm, fabsf(m.cv[j >> 2][j & 3]));
    cm = fmaxf(cm, swz_xor<8>(cm)); cm = fmaxf(cm, swz_xor<16>(cm));
    { auto rr = __builtin_amdgcn_permlane32_swap(__float_as_uint(cm), __float_as_uint(cm), false, false); cm = fmaxf(__uint_as_float(rr[0]), __uint_as_float(rr[1])); }
    const float inv = cm > 0.f ? 127.0f / cm : 0.f; cs = cm * (1.0f / 127.0f);
#pragma unroll
    for (int qd = 0; qd < 4; ++qd) {
        const int c0 = (int)rintf(m.cv[qd][0] * inv), c1 = (int)rintf(m.cv[qd][1] * inv), c2 = (int)rintf(m.cv[qd][2] * inv), c3 = (int)rintf(m.cv[qd][3] * inv);
        CQ[qd] = (unsigned)(c0 & 0xff) | ((unsigned)(c1 & 0xff) << 8) | ((unsigned)(c2 & 0xff) << 16) | ((unsigned)(c3 & 0xff) << 24);
    }
#pragma unroll
    for (int j = 0; j < 16; ++j) P[j] = *(const u32x4*)(VS + (size_t)m.iv[j >> 2][j & 3] * 128);
}
__device__ __forceinline__ void v_compute(const u32x4 (&P)[16], const u32x4& CQ, float cs, float* xout, const float* mod_l, size_t t, unsigned s, int lane) {
    const int g = lane >> 3, p = lane & 7; const bool b4 = (lane >> 4) & 1, b3 = (lane >> 3) & 1;
    typedef float f32x2 __attribute__((ext_vector_type(2)));
    const int col = (int)s * 128 + 16 * p + 2 * g, b = (int)(t >> 12);
    float* xp = xout + t * DM + col;
    f32x2 xv = *(const f32x2*)xp;
    const f32x2 gt = *(const f32x2*)(mod_l + (size_t)b * NMOD + 5 * DM + col);
    int acc[16];
#pragma unroll
    for (int k = 0; k < 16; ++k) acc[k] = 0;
#pragma unroll
    for (int qd = 0; qd < 4; ++qd)
#pragma unroll
        for (int w = 0; w < 4; ++w) {
            const unsigned A = P[4 * qd][w], B = P[4 * qd + 1][w], C = P[4 * qd + 2][w], D = P[4 * qd + 3][w];
            const unsigned X = __builtin_amdgcn_perm(B, A, 0x05010400u), Y = __builtin_amdgcn_perm(B, A, 0x07030602u);
            const unsigned Z = __builtin_amdgcn_perm(D, C, 0x05010400u), W = __builtin_amdgcn_perm(D, C, 0x07030602u);
            const unsigned T0 = __builtin_amdgcn_perm(Z, X, 0x05040100u), T1 = __builtin_amdgcn_perm(Z, X, 0x07060302u);
            const unsigned T2 = __builtin_amdgcn_perm(W, Y, 0x05040100u), T3 = __builtin_amdgcn_perm(W, Y, 0x07060302u);
            acc[4 * w + 0] = __builtin_amdgcn_sdot4((int)T0, (int)CQ[qd], acc[4 * w + 0], false); acc[4 * w + 1] = __builtin_amdgcn_sdot4((int)T1, (int)CQ[qd], acc[4 * w + 1], false);
            acc[4 * w + 2] = __builtin_amdgcn_sdot4((int)T2, (int)CQ[qd], acc[4 * w + 2], false); acc[4 * w + 3] = __builtin_amdgcn_sdot4((int)T3, (int)CQ[qd], acc[4 * w + 3], false);
        }
    int r8[8], r4[4], r2[2];
#pragma unroll
    for (int q = 0; q < 8; ++q) { auto rr = __builtin_amdgcn_permlane32_swap((unsigned)acc[q], (unsigned)acc[8 + q], false, false); r8[q] = (int)rr[0] + (int)rr[1]; }
#pragma unroll
    for (int q = 0; q < 4; ++q) { int lo = r8[q], hi = r8[4 + q]; asm volatile("" : "+v"(lo), "+v"(hi)); const int keep = b4 ? hi : lo, send = b4 ? lo : hi; r4[q] = keep + __builtin_amdgcn_ds_swizzle(send, (16 << 10) | 0x1f); }
#pragma unroll
    for (int q = 0; q < 2; ++q) { int lo = r4[q], hi = r4[2 + q]; asm volatile("" : "+v"(lo), "+v"(hi)); const int keep = b3 ? hi : lo, send = b3 ? lo : hi; r2[q] = keep + __builtin_amdgcn_ds_swizzle(send, (8 << 10) | 0x1f); }
    xv.x += gt.x * ((float)r2[0] * cs); xv.y += gt.y * ((float)r2[1] * cs);
    *(f32x2*)xp = xv;
}
__device__ __forceinline__ void v_unit(const KArgs& a, int l, const float* mod_l, unsigned s, unsigned unit, int lane) {
    const int g = lane >> 3, p = lane & 7;
    const unsigned char* VS = a.ws + WS_VQ + (size_t)l * NEXP * 1024 + (size_t)s * NEXP * 128 + 16 * p;
    const int* IDX = (const int*)(a.ws + WS_IDX); const float* COEF = (const float*)(a.ws + WS_COEF);
    const size_t t0 = (size_t)unit * UNIT;
    VMeta m; v_meta(m, IDX, COEF, t0, g);
    u32x4 PA[16], PB[16], CQA, CQB; float csA, csB;
    v_stage(PA, CQA, csA, m, VS);
    v_meta(m, IDX, COEF, t0 + 1, g);
#pragma unroll 1
    for (int i = 0; i < UNIT; i += 2) {
        v_stage(PB, CQB, csB, m, VS);
        v_meta(m, IDX, COEF, t0 + (i + 2 < UNIT ? i + 2 : i), g);
        v_compute(PA, CQA, csA, a.out, mod_l, t0 + i, s, lane);
        if (i + 2 < UNIT) { v_stage(PA, CQA, csA, m, VS); v_meta(m, IDX, COEF, t0 + (i + 3 < UNIT ? i + 3 : i), g); }
        v_compute(PB, CQB, csB, a.out, mod_l, t0 + i + 1, s, lane);
    }
}
template <bool VSTEP>
__device__ __forceinline__ void peer_phase(const KArgs& a, int l, const float* mod_l, unsigned* cnt, LAS unsigned char* lds, int wv) {
        const int tid = phase_tid(wv), lane = tid & 63, wid = wv;
    LAS unsigned char* wlds = lds + wid * 1024;
    const unsigned home = xcc_id();
    unsigned ss = 0, s = home;
    unsigned nxt = take_async(cnt + 64 * s, lane);
    for (;;) {
        const unsigned cur = (unsigned)__builtin_amdgcn_readfirstlane((int)nxt);
        if (cur >= (unsigned)NUNIT) { if (++ss == 8u) break; s = (home + ss) & 7u; nxt = take_async(cnt + 64 * s, lane); continue; }
        nxt = take_async(cnt + 64 * s, lane);
        if (VSTEP) v_unit(a, l, mod_l, s, cur, lane); else u_unit(a, l, s, cur, wlds, lane);
    }
}
}

constexpr int PH_PER_LAYER = 10, NPHASES = 1 + DEPTH * PH_PER_LAYER + 1;
#ifndef PHASE_MASK
#define PHASE_MASK 0xFFFF
#endif
#define HASP(k) (((PHASE_MASK) >> (k)) & 1)
#ifndef SB_EARLY_EXIT
#define SB_EARLY_EXIT 1
#endif

#define GAS __attribute__((address_space(1)))
#define RLX_AGENT __ATOMIC_RELAXED, __HIP_MEMORY_SCOPE_AGENT
#define XB_TMO      128
#define XB_XCNT(j)  (256  + 64 * (j))
#define XB_XSUB(j)  (1280 + 64 * (j))
#define XB_XGEN(j)  (2304 + 64 * (j))
#define XB_TOP      3328
#define XB_TOPGEN   3392
#define XCD_BAR_WORDS 3456
#define XB_SPIN_CAP (1u << 18)

__device__ __forceinline__ unsigned xb_ld(unsigned* p)              { return __hip_atomic_load(p, __ATOMIC_RELAXED, __HIP_MEMORY_SCOPE_AGENT); }
__device__ __forceinline__ unsigned xb_add(unsigned* p, unsigned v) { return __hip_atomic_fetch_add(p, v, __ATOMIC_RELAXED, __HIP_MEMORY_SCOPE_AGENT); }
__device__ __forceinline__ unsigned xb_xcc_id() { return (unsigned)__builtin_amdgcn_s_getreg((3 << 11) | 20) & 0xFu; }
#define XB_SPIN(cond, bar) do { unsigned _sp = 0; while (cond) { __builtin_amdgcn_s_sleep(1); \
    if ((++_sp & 255u) == 0u) { if (xb_ld(&(bar)[XB_TMO])) break; if (_sp > XB_SPIN_CAP) { atomicAdd(&(bar)[XB_TMO], 1u); break; } } } } while (0)

struct XcdBarrier {
    unsigned* bar; unsigned x;
    volatile LAS unsigned* st;
};

__device__ __forceinline__ XcdBarrier xcd_barrier_post(unsigned* bar, volatile LAS unsigned* st, bool tid0) {
    XcdBarrier b; b.bar = bar; b.x = xb_xcc_id(); b.st = st;
    if (tid0) (void)xb_add(&bar[XB_XCNT(b.x)], 1u);
    return b;
}
__device__ __forceinline__ void xcd_barrier_complete(unsigned* bar, unsigned x, unsigned& nloc, unsigned& nx) {
    const unsigned G = gridDim.x * gridDim.y * gridDim.z;
    unsigned sum, cnt, mine, sp = 0u;
    for (;;) {
        sum = 0u; cnt = 0u; mine = 0u;
#pragma unroll
        for (unsigned j = 0; j < 16; ++j) { const unsigned c = xb_ld(&bar[XB_XCNT(j)]); sum += c; cnt += (c > 0u) ? 1u : 0u; mine = (j == x) ? c : mine; }
        if (sum == G) break;
        __builtin_amdgcn_s_sleep(1);
        if ((++sp & 255u) == 0u) { if (xb_ld(&bar[XB_TMO])) break; if (sp > XB_SPIN_CAP) { atomicAdd(&bar[XB_TMO], 1u); break; } }
    }
    nloc = mine > 0u ? mine : 1u; nx = cnt > 0u ? cnt : 1u;
}

__device__ __forceinline__ void xcd_barrier(const XcdBarrier& b, bool tid0) {
    asm volatile("s_waitcnt vmcnt(0)" ::: "memory");
    __syncthreads();
    if (tid0) {
        unsigned* bar = b.bar;
        __builtin_amdgcn_s_waitcnt(0);
        unsigned nloc = b.st[0], nx = b.st[1];
        if (nloc == 0u) { xcd_barrier_complete(bar, b.x, nloc, nx); b.st[0] = nloc; b.st[1] = nx; }
        const unsigned old = xb_add(&bar[XB_XSUB(b.x)], 1u);
        const unsigned gen = old / nloc;
        if (old + 1u == (gen + 1u) * nloc) {
            __builtin_amdgcn_fence(__ATOMIC_RELEASE, "agent");
            asm volatile("s_waitcnt vmcnt(0)" ::: "memory");
            const unsigned og = xb_add(&bar[XB_TOP], 1u);
            const unsigned tg = og / nx;
            if (og + 1u == (tg + 1u) * nx) xb_add(&bar[XB_TOPGEN], 1u);
            else XB_SPIN(xb_ld(&bar[XB_TOPGEN]) == tg, bar);
            __builtin_amdgcn_fence(__ATOMIC_ACQUIRE, "agent");
            xb_add(&bar[XB_XGEN(b.x)], 1u);
            asm volatile("s_waitcnt vmcnt(0)" ::: "memory");
        } else {
            XB_SPIN(xb_ld(&bar[XB_XGEN(b.x)]) == gen, bar);
            __builtin_amdgcn_fence(__ATOMIC_ACQUIRE, "agent");
            asm volatile("s_waitcnt vmcnt(0)" ::: "memory");
        }
    }
    __syncthreads();
}

typedef const __attribute__((address_space(4))) KArgs* KArgsP;
__device__ __forceinline__ KArgsP kargs() { KArgsP p = (KArgsP)__builtin_amdgcn_kernarg_segment_ptr(); asm volatile("" : "+s"(p)); return p; }

__device__ __forceinline__ void load_args(KArgs& a) {
#if defined(__HIP_DEVICE_COMPILE__)
    KArgsP p = kargs();
    a.x = p->x; a.c = p->c; a.pos = p->pos; a.ada_w = p->ada_w; a.ada_b = p->ada_b; a.norm1_g = p->norm1_g; a.w_in = p->w_in; a.sinks = p->sinks; a.wbr_a = p->wbr_a; a.wbr_b = p->wbr_b;
    a.w_out = p->w_out; a.norm2_g = p->norm2_g; a.wq = p->wq; a.subkeys = p->subkeys; a.pu = p->pu; a.pv = p->pv; a.final_g = p->final_g; a.out = p->out; a.ws = p->ws; a.ph_lo = p->ph_lo; a.ph_hi = p->ph_hi;
#endif
}
__global__ void __launch_bounds__(NTHREADS, 2) fwd_kernel(KArgs a_unused) {
    extern __shared__ __attribute__((aligned(16))) unsigned char lds_raw[];
    LAS unsigned char* lds = (LAS unsigned char*)lds_raw;
    cg::grid_group grid = cg::this_grid();
    const int ph_lo = kargs()->ph_lo, ph_hi = kargs()->ph_hi;
    const int wv = __builtin_amdgcn_readfirstlane((int)threadIdx.x >> 6);
#define IN(k) (ph_lo <= (k) && (k) < ph_hi)
    volatile LAS unsigned* xb_st = (volatile LAS unsigned*)(lds + LDS_BYTES - 64);
    { const bool t0_ = phase_tid(wv) == 0; if (t0_) { xb_st[0] = 0u; xb_st[1] = 0u; } __syncthreads();
      (void)xcd_barrier_post((unsigned*)(kargs()->ws + WS_CTL) + CTL_BAR, xb_st, t0_); }
#define GRID_BAR() do { XcdBarrier b_; b_.bar = (unsigned*)(kargs()->ws + WS_CTL) + CTL_BAR; b_.x = xb_xcc_id(); b_.st = xb_st; xcd_barrier(b_, phase_tid(wv) == 0); } while (0)
#ifdef PROBE_PH
    unsigned long long pr_prev = __builtin_amdgcn_s_memrealtime(), pr_acc = 0;
#define PROBE_MATCH(k) ((PROBE_PH) >= 100 ? ((k) >= 1 && (k) < NPHASES - 1 && (((k) - 1) % PH_PER_LAYER) == (PROBE_PH) - 100) : (k) == (PROBE_PH))
#define SEAM(k) do { if (IN(k) && IN((k) + 1)) { if ((k) == 0) grid.sync(); else GRID_BAR(); } { const unsigned long long now_ = __builtin_amdgcn_s_memrealtime(); if (PROBE_MATCH(k)) pr_acc += now_ - pr_prev; pr_prev = now_; } } while (0)
#else
#define SEAM(k) do { if (IN(k) && IN((k) + 1)) { if ((k) == 0) grid.sync(); else GRID_BAR(); } } while (0)
#endif
#define LOADARGS KArgs a; load_args(a); unsigned char* ws = a.ws; const int G = op_grid(); (void)G; (void)ws
#define LAYERARGS const float* mod_l = (const float*)(ws + WS_MOD) + (size_t)l * 8 * NMOD; const float* xcur = (l == 0) ? a.x : a.out; (void)mod_l; (void)xcur
    if (IN(0)) { if (HASP(0)) { LOADARGS; ph_prologue(a, lds, wv); } }
    SEAM(0);
#pragma unroll 1
    for (int l = 0; l < DEPTH; ++l) {
        const int p0 = 1 + l * PH_PER_LAYER;
        if (IN(p0 + 0)) { if (HASP(1)) { LOADARGS; LAYERARGS; ph_norm<false>(a, xcur, a.norm1_g + l * DM, mod_l, 0, 1, wv); } }
        SEAM(p0 + 0);
        if (IN(p0 + 1)) { if (HASP(2)) { LOADARGS; pg8::Gemm g{(const bf16_t*)(ws + WS_H), (const bf16_t*)(ws + WS_WIN) + (size_t)l * NPROJ * 1024, T, NPROJ, 1024};
                  pg8::StaticOrder S; S.init(T, NPROJ, G, op_bid()); EpiProj E{ws};
                  pg8::gemm_phase<EpiProj, pg8::StaticOrder, true, true>(lds, g, S, E, wv); } }
        SEAM(p0 + 1);
        if (IN(p0 + 2)) { if (HASP(3)) { LOADARGS;
                  att::swa_phase((const bf16_t*)(ws + WS_QA), (const bf16_t*)(ws + WS_KA), (const bf16_t*)(ws + WS_VA), (bf16_t*)(ws + WS_QA), a.sinks + l * 8, lds, wv);
                  __syncthreads();
                  att::sb_phase<SB_EARLY_EXIT != 0>((const bf16_t*)(ws + WS_QB), (const bf16_t*)(ws + WS_KB), (const bf16_t*)(ws + WS_VB), (bf16_t*)(ws + WS_QB), lds, wv); } }
        SEAM(p0 + 2);
        if (IN(p0 + 3)) { if (HASP(4)) { LOADARGS; pg8::StaticOrder S; S.init(T, DM, G, op_bid());
                  { pg8::Gemm g{(const bf16_t*)(ws + WS_QA), (const bf16_t*)(ws + WS_WBA) + (size_t)l * 1024 * 512, T, DM, 512};
                    EpiBranch<false> E{(const bf16_t*)(ws + WS_GA), (bf16_t*)(ws + WS_H)};
                    pg8::gemm_phase<EpiBranch<false>, pg8::StaticOrder, true, true>(lds, g, S, E, wv); }
                  __syncthreads();
                  { pg8::Gemm g{(const bf16_t*)(ws + WS_QB), (const bf16_t*)(ws + WS_WBB) + (size_t)l * 1024 * 512, T, DM, 512};
                    EpiBranch<true> E{(const bf16_t*)(ws + WS_GB), (bf16_t*)(ws + WS_H)};
                    pg8::gemm_phase<EpiBranch<true>, pg8::StaticOrder, true, true>(lds, g, S, E, wv); } } }
        SEAM(p0 + 3);
        if (IN(p0 + 4)) { if (HASP(5)) { LOADARGS; LAYERARGS; pg8::Gemm g{(const bf16_t*)(ws + WS_H), (const bf16_t*)(ws + WS_WOUT) + (size_t)l * 1024 * 1024, T, DM, 1024};
                  pg8::StaticOrder S; S.init(T, DM, G, op_bid()); EpiWout E{xcur, a.out, mod_l + 2 * DM};
                  pg8::gemm_phase<EpiWout, pg8::StaticOrder, true, true>(lds, g, S, E, wv); } }
        SEAM(p0 + 4);
        if (IN(p0 + 5)) { if (HASP(6)) { LOADARGS; LAYERARGS; ph_norm<true>(a, a.out, a.norm2_g + l * DM, mod_l, 3, 4, wv); } }
        SEAM(p0 + 5);
        if (IN(p0 + 6)) { if (HASP(7)) { LOADARGS; pg8::Gemm g{(const bf16_t*)(ws + WS_H), (const bf16_t*)(ws + WS_WQ) + (size_t)l * PQ * 1024, T, PQ, 1024};
                  pg8::StaticOrder S; S.init(T, PQ, G, op_bid()); EpiPlainBf16 E{(bf16_t*)(ws + WS_Q2), PQ};
                  pg8::gemm_phase<EpiPlainBf16, pg8::StaticOrder, true, true>(lds, g, S, E, wv); } }
        SEAM(p0 + 6);
        if (IN(p0 + 7)) { if (HASP(8)) { LOADARGS; tk::topk_phase((const bf16_t*)(ws + WS_Q2), (const bf16_t*)(ws + WS_SK) + (size_t)l * 8 * 2 * 128 * 128, (int*)(ws + WS_IDX), (float*)(ws + WS_GATE), lds, wv); } }
        SEAM(p0 + 7);
        if (IN(p0 + 8)) { if (HASP(9)) { LOADARGS; peer3::peer_phase<false>(a, l, nullptr, (unsigned*)(ws + WS_CTL) + CTL_QUEUE + (l * 2 + 0) * 8 * 64, lds, wv); } }
        SEAM(p0 + 8);
        if (IN(p0 + 9)) { if (HASP(10)) { LOADARGS; LAYERARGS; peer3::peer_phase<true>(a, l, mod_l, (unsigned*)(ws + WS_CTL) + CTL_QUEUE + (l * 2 + 1) * 8 * 64, lds, wv); } }
        SEAM(p0 + 9);
    }
    if (IN(NPHASES - 1)) { if (HASP(11)) { LOADARGS; ph_final_norm(a, wv); } }
#ifdef PROBE_PH
    { const unsigned long long now_ = __builtin_amdgcn_s_memrealtime(); if (PROBE_MATCH(NPHASES - 1)) pr_acc += now_ - pr_prev;
      if (blockIdx.x == 0 && threadIdx.x == 0) { const unsigned long long t0_ = __builtin_amdgcn_s_memrealtime(); while (__builtin_amdgcn_s_memrealtime() - t0_ < pr_acc * (PROBE_K)) __builtin_amdgcn_s_sleep(16); } }
#endif
#undef IN
#undef SEAM
}

#ifndef N_LAUNCH_SPLIT
#define N_LAUNCH_SPLIT 1
#endif
extern "C" void kernel_launch(void* const* d_in, const int* in_sizes, int n_in, void* d_out, int out_size, void* d_ws, size_t ws_size, hipStream_t stream) {
    static int grid = 0;
    if (grid == 0) {
        if (n_in != 17 || out_size != T * DM || ws_size < WS_END) { fprintf(stderr, "kernel_launch: unexpected problem (n_in %d out %d ws %zu)\n", n_in, out_size, ws_size); grid = -1; return; }
        int dev = 0, cus = 0, per_cu = 0;
        (void)hipGetDevice(&dev);
        (void)hipDeviceGetAttribute(&cus, hipDeviceAttributeMultiprocessorCount, dev);
        (void)hipFuncSetAttribute((const void*)fwd_kernel, hipFuncAttributeMaxDynamicSharedMemorySize, LDS_BYTES);
        (void)hipOccupancyMaxActiveBlocksPerMultiprocessor(&per_cu, (const void*)fwd_kernel, NTHREADS, LDS_BYTES);
        if (per_cu < 1) { fprintf(stderr, "kernel_launch: occupancy query says %d\n", per_cu); per_cu = 1; }
        grid = cus;
        fprintf(stderr, "kernel_launch: cus %d per_cu %d grid %d ws %zu\n", cus, per_cu, grid, ws_size);
    }
    if (grid < 0) return;
    if (hipMemsetAsync((char*)d_ws + WS_CTL, 0, 65536, stream) != hipSuccess) { fprintf(stderr, "kernel_launch: hipMemsetAsync of the control words failed\n"); return; }
    KArgs a{};
    a.x = (const float*)d_in[0]; a.c = (const float*)d_in[1]; a.pos = (const int*)d_in[2]; a.ada_w = (const float*)d_in[3]; a.ada_b = (const float*)d_in[4];
    a.norm1_g = (const float*)d_in[5]; a.w_in = (const float*)d_in[6]; a.sinks = (const float*)d_in[7]; a.wbr_a = (const float*)d_in[8]; a.wbr_b = (const float*)d_in[9];
    a.w_out = (const float*)d_in[10]; a.norm2_g = (const float*)d_in[11]; a.wq = (const float*)d_in[12]; a.subkeys = (const float*)d_in[13]; a.pu = (const float*)d_in[14];
    a.pv = (const float*)d_in[15]; a.final_g = (const float*)d_in[16]; a.out = (float*)d_out; a.ws = (unsigned char*)d_ws;
#if N_LAUNCH_SPLIT
    a.ph_lo = 0; a.ph_hi = NPHASES;
    { void* args[] = {&a};
      hipError_t e = hipLaunchCooperativeKernel((void*)fwd_kernel, dim3(grid), dim3(NTHREADS), args, LDS_BYTES, stream);
      if (e != hipSuccess) fprintf(stderr, "cooperative launch failed: %s (grid %d)\n", hipGetErrorString(e), grid); }
#else
    for (int ph = 0; ph < NPHASES; ++ph) {
        a.ph_lo = ph; a.ph_hi = ph + 1;
        void* args[] = {&a};
        hipError_t e = hipLaunchCooperativeKernel((void*)fwd_kernel, dim3(grid), dim3(NTHREADS), args, LDS_BYTES, stream);
        if (e != hipSuccess) { fprintf(stderr, "cooperative launch %d failed: %s (grid %d)\n", ph, hipGetErrorString(e), grid); break; }
    }
#endif
}
```

```cpp
#include <hip/hip_runtime.h>
#include <hip/hip_cooperative_groups.h>
#include <cstdio>
#include <cstdint>
namespace cg = cooperative_groups;

namespace pg8 {
#define PG8_LAS __attribute__((address_space(3)))
typedef unsigned short bf16_t;
typedef short bf16x8 __attribute__((ext_vector_type(8)));
typedef float f32x4 __attribute__((ext_vector_type(4)));
typedef unsigned u32x4 __attribute__((ext_vector_type(4)));
constexpr int BM = 256, BK = 64, HALF = 128, HTB = HALF * BK * 2  , STAGE_BYTES = 8 * HTB, NXCD = 8, WGM = 8;

__host__ __device__ __forceinline__ int lds_byte(int r, int c) { const int st = (r >> 4) * 2 + (c >> 5), rr = r & 15, cc = c & 31, ob = rr * 64 + cc * 2; return st * 1024 + (ob ^ (((ob >> 9) & 1) << 5)); }
__host__ __device__ __forceinline__ void stage_rc(int b, int& R, int& C) { const int st = b / 1024, sb = b % 1024, swz = sb ^ (((sb >> 9) & 1) << 5); R = (st >> 1) * 16 + swz / 64; C = (st & 1) * 32 + (swz % 64) / 2; }
__host__ __device__ __forceinline__ int perm32(int rho) { const int n = rho >> 4, i = rho & 15; return 8 * (i >> 2) + 4 * n + (i & 3); }

struct Unit { int pm, pn; };
struct Gemm { const bf16_t* A; const bf16_t* Bt; int M, N, K; };

struct StaticOrder {
    int nM, nN, nwg, G, c;
    __host__ __device__ void init(int M, int N, int G_, int c_) { nM = M / BM; nN = N / BM; nwg = nM * nN; G = G_; c = c_; }
    __host__ __device__ bool next(int i, Unit& u) const {
        const long L = (long)i * G + c; if (L >= nwg) return false;
        int wgid = (int)L; { const int q = nwg / NXCD, r = nwg % NXCD, xcd = wgid % NXCD, off = wgid / NXCD; wgid = (xcd < r ? xcd * (q + 1) : r * (q + 1) + (xcd - r) * q) + off; }
        const int nig = WGM * nN, gid = wgid / nig, fm = gid * WGM, gsz = (nM - fm) < WGM ? (nM - fm) : WGM;
        u.pm = fm + ((wgid % nig) % gsz); u.pn = (wgid % nig) / gsz; return true;
    }
    __device__ __forceinline__ void a_ready(const Unit&) const {}
    __device__ __forceinline__ void done(const Unit&) const {}
};


__device__ __forceinline__ unsigned cvt_pk_bf16(float lo, float hi) { unsigned r; asm volatile("v_cvt_pk_bf16_f32 %0, %1, %2" : "=v"(r) : "v"(lo), "v"(hi)); return r; }
template <class Epi, class Sched, bool ALIGN_EPI = false, bool SP2 = false>
__device__ __forceinline__ void gemm_phase(PG8_LAS unsigned char* lds, const Gemm g, const Sched& S, const Epi& E, int wv) {
    unsigned m_op = ~0u; asm volatile("" : "+s"(m_op));
    const int tid = wv * 64 + (int)__builtin_amdgcn_mbcnt_hi(m_op, __builtin_amdgcn_mbcnt_lo(m_op, 0u)), wid = wv, lane = tid & 63, wr = wid >> 2, wc = wid & 3, fr = lane & 15, fq = lane >> 4;
    const int K = g.K, nt = K / BK;
    unsigned voffA[2], voffB[2];
#pragma unroll
    for (int i = 0; i < 2; ++i) { int R, C; stage_rc(tid * 16 + i * 8192, R, C); const int Rb = Epi::PERM ? ((R & ~31) + perm32(R & 31)) : R;
        voffA[i] = (unsigned)(R * K + C) * 2u; voffB[i] = (unsigned)(Rb * K + C) * 2u; }
    const size_t kstep = (size_t)(BK * 2);
    const size_t hstep = (size_t)HALF * K * 2;
    const size_t tstep = 2 * hstep;
    const unsigned ldsw = (unsigned)wid * 1024u;
    const int aoff = lds_byte(wr * 64 + fr, fq * 8), boff = lds_byte(wc * 32 + fr, fq * 8);
#define PG8_SA(b, h) (((b) * 2 + (h)) * HTB)
#define PG8_SB(b, h) ((4 + (b) * 2 + (h)) * HTB)
#define PG8_STAGE(bufoff, gbase, voff) do { _Pragma("unroll") for (int _i = 0; _i < 2; ++_i) \
        __builtin_amdgcn_global_load_lds((const unsigned*)((const char*)(gbase) + (voff)[_i]), (PG8_LAS unsigned*)(lds + (bufoff) + ldsw + _i * 8192), 16, 0, 0); } while (0)
#define PG8_LDA(dst, b, h) do { _Pragma("unroll") for (int m = 0; m < 4; ++m) _Pragma("unroll") for (int k = 0; k < 2; ++k) dst[m][k] = *(const PG8_LAS bf16x8*)(lds + PG8_SA(b, h) + aoff + m * 2048 + k * 1024); } while (0)
#define PG8_LDB(dst, b, h) do { _Pragma("unroll") for (int n = 0; n < 2; ++n) _Pragma("unroll") for (int k = 0; k < 2; ++k) dst[n][k] = *(const PG8_LAS bf16x8*)(lds + PG8_SB(b, h) + boff + n * 2048 + k * 1024); } while (0)
#define PG8_MMA(ai, bj, At, Bt) do { __builtin_amdgcn_s_setprio(1); _Pragma("unroll") for (int m = 0; m < 4; ++m) _Pragma("unroll") for (int n = 0; n < 2; ++n) _Pragma("unroll") for (int k = 0; k < 2; ++k) \
        acc[ai][bj][m][n] = __builtin_amdgcn_mfma_f32_16x16x32_bf16(Bt[n][k], At[m][k], acc[ai][bj][m][n], 0, 0, 0); __builtin_amdgcn_s_setprio(0); } while (0)
#define PG8_WAIT_V(n) asm volatile("s_waitcnt vmcnt(" #n ")" ::: "memory")
#define PG8_WAIT_L(n) asm volatile("s_waitcnt lgkmcnt(" #n ")" ::: "memory")
#define PG8_BAR __builtin_amdgcn_s_barrier()
#define PG8_SCHED __builtin_amdgcn_sched_barrier(0)
    Unit cur, nxt; int ui = 0;
    if (!S.next(0, cur)) return;
    f32x4 acc[2][2][4][2];
#pragma unroll
    for (int a = 0; a < 2; ++a)
#pragma unroll
        for (int b = 0; b < 2; ++b)
#pragma unroll
            for (int m = 0; m < 4; ++m)
#pragma unroll
                for (int n = 0; n < 2; ++n) acc[a][b][m][n] = (f32x4){0.f, 0.f, 0.f, 0.f};
    bf16x8 At[4][2], B0[2][2], B1[2][2];
    const char* cA = (const char*)g.A + (size_t)cur.pm * tstep; const char* cB = (const char*)g.Bt + (size_t)cur.pn * tstep;
    S.a_ready(cur);
    if constexpr (SP2) {
        PG8_STAGE(PG8_SB(0, 0), cB, voffB); PG8_STAGE(PG8_SB(0, 1), cB + hstep, voffB); PG8_STAGE(PG8_SA(0, 0), cA, voffA); PG8_STAGE(PG8_SA(0, 1), cA + hstep, voffA);
        if (wr == 1) PG8_BAR;
        PG8_WAIT_V(2); PG8_BAR;
        PG8_STAGE(PG8_SB(1, 0), cB + kstep, voffB); PG8_STAGE(PG8_SA(1, 0), cA + kstep, voffA); PG8_STAGE(PG8_SB(1, 1), cB + hstep + kstep, voffB);
        PG8_WAIT_V(6); PG8_BAR;
    } else {
        PG8_STAGE(PG8_SB(0, 0), cB, voffB); PG8_STAGE(PG8_SA(0, 0), cA, voffA); PG8_STAGE(PG8_SB(0, 1), cB + hstep, voffB); PG8_STAGE(PG8_SA(0, 1), cA + hstep, voffA);
        if (wr == 1) PG8_BAR;
        PG8_WAIT_V(4); PG8_BAR;
        PG8_STAGE(PG8_SB(1, 0), cB + kstep, voffB); PG8_STAGE(PG8_SA(1, 0), cA + kstep, voffA); PG8_STAGE(PG8_SB(1, 1), cB + hstep + kstep, voffB);
        PG8_WAIT_V(6); PG8_BAR;
    }
    for (;;) {
        const bool has_next = S.next(ui + 1, nxt);
        const char* nA = has_next ? (const char*)g.A + (size_t)nxt.pm * tstep : cA; const char* nB = has_next ? (const char*)g.Bt + (size_t)nxt.pn * tstep : cB;
        for (int t = 0; t < nt; t += 2) {
            const bool last = (t == nt - 2);
            const char* a1 = cA + (size_t)(t + 1) * kstep;
            const char* a2 = last ? nA : cA + (size_t)(t + 2) * kstep; const char* b2 = last ? nB : cB + (size_t)(t + 2) * kstep;
            const char* a3 = a2 + kstep; const char* b3 = b2 + kstep;
            if (last && has_next) S.a_ready(nxt);
            if constexpr (SP2) {
            PG8_LDB(B0, 0, 0); PG8_LDB(B1, 0, 1); PG8_SCHED; PG8_LDA(At, 0, 0); PG8_STAGE(PG8_SA(1, 1), a1 + hstep, voffA);
            PG8_WAIT_V(8); PG8_WAIT_L(0); PG8_BAR; PG8_MMA(0, 0, At, B0); PG8_MMA(0, 1, At, B1); PG8_BAR; PG8_SCHED;
            PG8_LDA(At, 0, 1); PG8_STAGE(PG8_SB(0, 0), b2, voffB); PG8_STAGE(PG8_SB(0, 1), b2 + hstep, voffB); PG8_STAGE(PG8_SA(0, 0), a2, voffA);
            PG8_WAIT_V(8); PG8_WAIT_L(0); PG8_BAR; PG8_MMA(1, 0, At, B0); PG8_MMA(1, 1, At, B1); PG8_BAR; PG8_SCHED;
            PG8_LDB(B0, 1, 0); PG8_LDB(B1, 1, 1); PG8_SCHED; PG8_LDA(At, 1, 0); PG8_STAGE(PG8_SA(0, 1), a2 + hstep, voffA);
            PG8_WAIT_V(8); PG8_WAIT_L(0); PG8_BAR; PG8_MMA(0, 0, At, B0); PG8_MMA(0, 1, At, B1); PG8_BAR; PG8_SCHED;
            PG8_LDA(At, 1, 1); PG8_STAGE(PG8_SB(1, 0), b3, voffB); PG8_STAGE(PG8_SB(1, 1), b3 + hstep, voffB); PG8_STAGE(PG8_SA(1, 0), a3, voffA);
            PG8_WAIT_V(8); PG8_WAIT_L(0); PG8_BAR; PG8_MMA(1, 0, At, B0); PG8_MMA(1, 1, At, B1); PG8_BAR; PG8_SCHED;
            } else {
            PG8_LDB(B0, 0, 0); PG8_SCHED; PG8_LDA(At, 0, 0); PG8_STAGE(PG8_SA(1, 1), a1 + hstep, voffA);
            PG8_WAIT_L(8); PG8_BAR; PG8_WAIT_L(0); PG8_MMA(0, 0, At, B0); PG8_BAR; PG8_SCHED;
            PG8_LDB(B1, 0, 1); PG8_STAGE(PG8_SB(0, 0), b2, voffB);
            PG8_BAR; PG8_WAIT_L(0); PG8_MMA(0, 1, At, B1); PG8_BAR;
            PG8_LDA(At, 0, 1); PG8_STAGE(PG8_SA(0, 0), a2, voffA);
            PG8_BAR; PG8_WAIT_L(0); PG8_MMA(1, 0, At, B0); PG8_BAR; PG8_SCHED;
            PG8_STAGE(PG8_SB(0, 1), b2 + hstep, voffB);
            PG8_WAIT_V(6); PG8_BAR; PG8_MMA(1, 1, At, B1); PG8_BAR;
            PG8_LDB(B0, 1, 0); PG8_SCHED; PG8_LDA(At, 1, 0); PG8_STAGE(PG8_SA(0, 1), a2 + hstep, voffA);
            PG8_WAIT_L(8); PG8_BAR; PG8_WAIT_L(0); PG8_MMA(0, 0, At, B0); PG8_BAR; PG8_SCHED;
            PG8_LDB(B1, 1, 1); PG8_STAGE(PG8_SB(1, 0), b3, voffB);
            PG8_BAR; PG8_WAIT_L(0); PG8_MMA(0, 1, At, B1); PG8_BAR;
            PG8_LDA(At, 1, 1); PG8_STAGE(PG8_SA(1, 0), a3, voffA);
            PG8_BAR; PG8_WAIT_L(0); PG8_MMA(1, 0, At, B0); PG8_BAR; PG8_SCHED;
            PG8_STAGE(PG8_SB(1, 1), b3 + hstep, voffB);
            PG8_WAIT_V(6); PG8_BAR; PG8_MMA(1, 1, At, B1); PG8_BAR;
            }
        }
        if constexpr (ALIGN_EPI) { if (wr == 0) PG8_BAR; }
        if constexpr (!Epi::AFTER_DRAIN) { E(acc, cur, wr, wc, fr, fq); S.done(cur); }
        if (!has_next) break;
#pragma unroll
        for (int a = 0; a < 2; ++a)
#pragma unroll
            for (int b = 0; b < 2; ++b)
#pragma unroll
                for (int m = 0; m < 4; ++m)
#pragma unroll
                    for (int n = 0; n < 2; ++n) acc[a][b][m][n] = (f32x4){0.f, 0.f, 0.f, 0.f};
        cur = nxt; cA = nA; cB = nB; ++ui;
        if constexpr (ALIGN_EPI) { if (wr == 1) PG8_BAR; }
    }
    PG8_WAIT_V(0);
    if constexpr (!ALIGN_EPI) { if (wr == 0) PG8_BAR; }
    PG8_BAR;
    if constexpr (Epi::AFTER_DRAIN) { E.fused(acc, cur, wr, wc, fr, fq, lds, wid, lane); S.done(cur); }
#undef PG8_SA
#undef PG8_SB
#undef PG8_STAGE
#undef PG8_LDA
#undef PG8_LDB
#undef PG8_MMA
#undef PG8_WAIT_V
#undef PG8_WAIT_L
#undef PG8_BAR
#undef PG8_SCHED
}
}


#define LAS __attribute__((address_space(3)))

__device__ __forceinline__ int op_bid() { int b = (int)blockIdx.x; asm volatile("" : "+s"(b)); return b; }
__device__ __forceinline__ int op_grid() { int g = (int)gridDim.x; asm volatile("" : "+s"(g)); return g; }
__device__ __forceinline__ int phase_tid(int wv) { unsigned m = ~0u; asm volatile("" : "+s"(m)); return wv * 64 + (int)__builtin_amdgcn_mbcnt_hi(m, __builtin_amdgcn_mbcnt_lo(m, 0u)); }
typedef unsigned short bf16_t;
typedef float f32x4 __attribute__((ext_vector_type(4)));
typedef unsigned u32x4 __attribute__((ext_vector_type(4)));
typedef unsigned u32x2 __attribute__((ext_vector_type(2)));

constexpr int BATCH = 8, SEQ = 4096, DM = 1024, T = BATCH * SEQ, DEPTH = 2;
constexpr int NPROJ = 4352, NMOD = 6 * DM;
constexpr int NEXP = 16384, PQ = 2048;
constexpr float NORM_EPS = 1e-6f;
constexpr float LOG2E = 1.4426950408889634f;
constexpr float QSCALE = 0.125f * LOG2E;
constexpr float SB_EXIT = 160.0f;

constexpr size_t MiB = 1u << 20;
constexpr size_t WS_CTL = 0;
constexpr size_t WS_MOD = 1 * MiB;
constexpr size_t WS_ROPE = 2 * MiB;
constexpr size_t WS_WIN = 10 * MiB;
constexpr size_t WS_WBA = 27 * MiB;
constexpr size_t WS_WBB = 29 * MiB;
constexpr size_t WS_WOUT = 31 * MiB;
constexpr size_t WS_WQ = 35 * MiB;
constexpr size_t WS_SK = 43 * MiB;
constexpr size_t WS_UQ = 44 * MiB;
constexpr size_t WS_VQ = 76 * MiB;
constexpr size_t WS_USC = 108 * MiB;
constexpr size_t WS_VSC = 108 * MiB + 256 * 1024;
constexpr size_t WS_HS = 109 * MiB;
constexpr size_t WS_H = 112 * MiB;
constexpr size_t WS_QA = 176 * MiB;
constexpr size_t WS_QB = 208 * MiB;
constexpr size_t WS_KB = 240 * MiB;
constexpr size_t WS_VB = 272 * MiB;
constexpr size_t WS_KA = 304 * MiB;
constexpr size_t WS_VA = 312 * MiB;
constexpr size_t WS_GA = 320 * MiB;
constexpr size_t WS_GB = 384 * MiB;
constexpr size_t WS_END = 448 * MiB;
constexpr size_t WS_H2Q = WS_QA, WS_IDX = WS_KB, WS_GATE = WS_VB, WS_Q2 = WS_GA, WS_COEF = WS_GA;
constexpr int CTL_BAR = 4096;
constexpr int CTL_QUEUE = 1024;

constexpr int LDS_BYTES = 147456;
constexpr int NTHREADS = 512, NWAVES = 8;

struct KArgs {
    const float* x; const float* c; const int* pos; const float* ada_w; const float* ada_b; const float* norm1_g; const float* w_in; const float* sinks;
    const float* wbr_a; const float* wbr_b; const float* w_out; const float* norm2_g; const float* wq; const float* subkeys; const float* pu; const float* pv; const float* final_g;
    float* out; unsigned char* ws; int ph_lo, ph_hi;
};

__device__ __forceinline__ unsigned f2bf(float f) { unsigned u = __float_as_uint(f); return (u + 0x7fffu + ((u >> 16) & 1u)) >> 16; }
__device__ __forceinline__ unsigned pk2(float lo, float hi) { return f2bf(lo) | (f2bf(hi) << 16); }
__device__ __forceinline__ float bflo(unsigned w) { return __uint_as_float(w << 16); }
__device__ __forceinline__ float bfhi(unsigned w) { return __uint_as_float(w & 0xffff0000u); }
template <int M> __device__ __forceinline__ float swz_xor(float v) { return __int_as_float(__builtin_amdgcn_ds_swizzle(__float_as_int(v), (M << 10) | 0x1f)); }
__device__ __forceinline__ float wave_sum(float v) {
    v += swz_xor<1>(v); v += swz_xor<2>(v); v += swz_xor<4>(v); v += swz_xor<8>(v); v += swz_xor<16>(v);
    auto rr = __builtin_amdgcn_permlane32_swap(__float_as_uint(v), __float_as_uint(v), false, false);
    return __uint_as_float(rr[0]) + __uint_as_float(rr[1]);
}
__device__ __forceinline__ float wave_max(float v) {
    v = fmaxf(v, swz_xor<1>(v)); v = fmaxf(v, swz_xor<2>(v)); v = fmaxf(v, swz_xor<4>(v)); v = fmaxf(v, swz_xor<8>(v)); v = fmaxf(v, swz_xor<16>(v));
    auto rr = __builtin_amdgcn_permlane32_swap(__float_as_uint(v), __float_as_uint(v), false, false);
    return fmaxf(__uint_as_float(rr[0]), __uint_as_float(rr[1]));
}
__device__ __forceinline__ int rdlane_i(int v, int l) { return __builtin_amdgcn_readlane(v, __builtin_amdgcn_readfirstlane(l)); }
__device__ __forceinline__ float rdlane_f(float v, int l) { return __int_as_float(__builtin_amdgcn_readlane(__float_as_int(v), __builtin_amdgcn_readfirstlane(l))); }
__device__ __forceinline__ float dot8(u32x4 a, u32x4 b, float acc) {
    acc = fmaf(bflo(a.x), bflo(b.x), acc); acc = fmaf(bfhi(a.x), bfhi(b.x), acc);
    acc = fmaf(bflo(a.y), bflo(b.y), acc); acc = fmaf(bfhi(a.y), bfhi(b.y), acc);
    acc = fmaf(bflo(a.z), bflo(b.z), acc); acc = fmaf(bfhi(a.z), bfhi(b.z), acc);
    acc = fmaf(bflo(a.w), bflo(b.w), acc); acc = fmaf(bfhi(a.w), bfhi(b.w), acc);
    return acc;
}
__device__ __forceinline__ float softplus2(float z2) {
    return fmaxf(z2, 0.f) + __log2f(1.0f + exp2f(-fabsf(z2)));
}

__device__ __forceinline__ int win_pos(int n) {
    if (n >= 640) return n;
    const int hb = n & ~63, d = n & 63;
    return hb + (d < 32 ? 2 * d : 2 * (d - 32) + 1);
}
template <bool WIN>
__device__ __forceinline__ void transpose_item(const float* W, int K, int N, bf16_t* WT, LAS float* scr, int item, int lane) {
    const int nblk = N / 32, kb = item / nblk, nb = item % nblk, k0 = 64 * kb, n0 = 32 * nb;
#pragma unroll 8
    for (int i = 0; i < 32; ++i) { const int kk = 2 * i + (lane >> 5); scr[kk * 33 + (lane & 31)] = W[(size_t)(k0 + kk) * N + n0 + (lane & 31)]; }
    asm volatile("s_waitcnt lgkmcnt(0)" ::: "memory");
    const int c = lane & 7;
#pragma unroll
    for (int j = 0; j < 4; ++j) { const int n = (lane >> 3) + 8 * j; const LAS float* s = scr + (8 * c) * 33 + n;
        u32x4 o; o.x = pk2(s[0 * 33], s[1 * 33]); o.y = pk2(s[2 * 33], s[3 * 33]); o.z = pk2(s[4 * 33], s[5 * 33]); o.w = pk2(s[6 * 33], s[7 * 33]);
        const int row = WIN ? win_pos(n0 + n) : (n0 + n);
        *(u32x4*)(WT + (size_t)row * K + k0 + 8 * c) = o; }
    asm volatile("s_waitcnt lgkmcnt(0)" ::: "memory");
}
template <bool OFFSET128>
__device__ __forceinline__ void quant_row(const f32x4 (&v)[4], unsigned char* dst_row, float* scale_out, int lane) {
    float am = 0.f;
#pragma unroll
    for (int i = 0; i < 4; ++i) am = fmaxf(am, fmaxf(fmaxf(fabsf(v[i].x), fabsf(v[i].y)), fmaxf(fabsf(v[i].z), fabsf(v[i].w))));
    am = wave_max(am);
    const float inv = am > 0.f ? 127.0f / am : 0.f, sc = am > 0.f ? am / 127.0f : 1.0f;
    u32x4 o;
#pragma unroll
    for (int i = 0; i < 4; ++i) {
        int q0 = (int)rintf(v[i].x * inv), q1 = (int)rintf(v[i].y * inv), q2 = (int)rintf(v[i].z * inv), q3 = (int)rintf(v[i].w * inv);
        if (OFFSET128) { q0 += 128; q1 += 128; q2 += 128; q3 += 128; }
        o[i] = (unsigned)(q0 & 0xff) | ((unsigned)(q1 & 0xff) << 8) | ((unsigned)(q2 & 0xff) << 16) | ((unsigned)(q3 & 0xff) << 24);
    }
    *(u32x4*)(dst_row + 16 * lane) = o;
    if (lane == 0) *scale_out = sc;
}

__device__ __forceinline__ void ph_prologue(const KArgs& a, LAS unsigned char* lds, int wv) {
    const int tid = phase_tid(wv), lane = tid & 63, wave = wv, G = op_grid();
    const int gw = op_bid() * NWAVES + wave, NGW = G * NWAVES;
    unsigned char* ws = a.ws;
    {
        LAS float* sc = (LAS float*)lds;
        LAS float* red = (LAS float*)(lds + 32768);
        for (int it = op_bid(); it < DEPTH * 96; it += G) {
            for (int idx = tid; idx < 8192; idx += NTHREADS) { const int b = idx >> 10, i = idx & 1023; const float cv = a.c[b * 1024 + i]; sc[i * 8 + b] = cv / (1.0f + __expf(-cv)); }
            __syncthreads();
            const int l = it / 96, j0 = (it % 96) * 64;
            const float* wp = a.ada_w + ((size_t)l * 1024 + wave * 128) * NMOD + j0 + lane;
            float acc[8];
#pragma unroll
            for (int b = 0; b < 8; ++b) acc[b] = 0.f;
#pragma unroll 8
            for (int i = 0; i < 128; ++i) {
                const float w = wp[(size_t)i * NMOD];
                const f32x4 s0 = *(const LAS f32x4*)(sc + (wave * 128 + i) * 8), s1 = *(const LAS f32x4*)(sc + (wave * 128 + i) * 8 + 4);
                acc[0] = fmaf(s0.x, w, acc[0]); acc[1] = fmaf(s0.y, w, acc[1]); acc[2] = fmaf(s0.z, w, acc[2]); acc[3] = fmaf(s0.w, w, acc[3]);
                acc[4] = fmaf(s1.x, w, acc[4]); acc[5] = fmaf(s1.y, w, acc[5]); acc[6] = fmaf(s1.z, w, acc[6]); acc[7] = fmaf(s1.w, w, acc[7]);
            }
#pragma unroll
            for (int b = 0; b < 8; ++b) red[(wave * 8 + b) * 64 + lane] = acc[b];
            __syncthreads();
            {
                float t = 0.f;
#pragma unroll
                for (int w = 0; w < 8; ++w) t += red[(w * 8 + wave) * 64 + lane];
                ((float*)(ws + WS_MOD))[(size_t)(l * 8 + wave) * NMOD + j0 + lane] = t + a.ada_b[l * NMOD + j0 + lane];
            }
            __syncthreads();
        }
    }
    {
        LAS float* scr = (LAS float*)(lds + 32768 + wave * 8448);
        constexpr int I_IN = 16 * 136, I_BR = 8 * 32, I_OUT = 16 * 32, I_Q = 16 * 64, I_L = I_IN + 2 * I_BR + I_OUT + I_Q;
        for (int it = gw; it < DEPTH * I_L; it += NGW) {
            const int l = it / I_L; int r = it % I_L;
            if (r < I_IN) { transpose_item<true>(a.w_in + (size_t)l * 1024 * NPROJ, 1024, NPROJ, (bf16_t*)(ws + WS_WIN) + (size_t)l * NPROJ * 1024, scr, r, lane); continue; } r -= I_IN;
            if (r < I_BR) { transpose_item<false>(a.wbr_a + (size_t)l * 512 * 1024, 512, 1024, (bf16_t*)(ws + WS_WBA) + (size_t)l * 1024 * 512, scr, r, lane); continue; } r -= I_BR;
            if (r < I_BR) { transpose_item<false>(a.wbr_b + (size_t)l * 512 * 1024, 512, 1024, (bf16_t*)(ws + WS_WBB) + (size_t)l * 1024 * 512, scr, r, lane); continue; } r -= I_BR;
            if (r < I_OUT) { transpose_item<false>(a.w_out + (size_t)l * 1024 * 1024, 1024, 1024, (bf16_t*)(ws + WS_WOUT) + (size_t)l * 1024 * 1024, scr, r, lane); continue; } r -= I_OUT;
            transpose_item<false>(a.wq + (size_t)l * 1024 * PQ, 1024, PQ, (bf16_t*)(ws + WS_WQ) + (size_t)l * PQ * 1024, scr, r, lane);
        }
    }
    {
        const int gt = op_bid() * NTHREADS + tid, NGT = G * NTHREADS;
        for (int i = gt; i < DEPTH * 8 * 2 * 128 * 128 / 8; i += NGT) {
            const f32x4 v0 = *(const f32x4*)(a.subkeys + (size_t)i * 8), v1 = *(const f32x4*)(a.subkeys + (size_t)i * 8 + 4);
            u32x4 o; o.x = pk2(v0.x, v0.y); o.y = pk2(v0.z, v0.w); o.z = pk2(v1.x, v1.y); o.w = pk2(v1.z, v1.w);
            *(u32x4*)((bf16_t*)(ws + WS_SK) + (size_t)i * 8) = o;
        }
        for (int i = gt; i < T * 32; i += NGT) {
            const int t = i >> 5, f = i & 31;
            double inv = 1.0;
            for (int k = 0; k < f; ++k) inv *= 0.7498942093324559;
            const double ang = (double)a.pos[t] * inv;
            const double kq = rint(ang * 0.63661977236758134308);
            const double r = fma(-kq, 6.123233995736766036e-17, fma(-kq, 1.57079632679489655800, ang));
            const int quad = (int)((long long)kq & 3);
            const double r2 = r * r;
            double sp = -1.0 / 1307674368000.0; sp = fma(sp, r2, 1.0 / 6227020800.0); sp = fma(sp, r2, -1.0 / 39916800.0); sp = fma(sp, r2, 1.0 / 362880.0);
            sp = fma(sp, r2, -1.0 / 5040.0); sp = fma(sp, r2, 1.0 / 120.0); sp = fma(sp, r2, -1.0 / 6.0); sp = fma(sp * r2, r, r);
            double cp = 1.0 / 20922789888000.0; cp = fma(cp, r2, -1.0 / 87178291200.0); cp = fma(cp, r2, 1.0 / 479001600.0); cp = fma(cp, r2, -1.0 / 3628800.0);
            cp = fma(cp, r2, 1.0 / 40320.0); cp = fma(cp, r2, -1.0 / 720.0); cp = fma(cp, r2, 1.0 / 24.0); cp = fma(cp, r2, -0.5); cp = fma(cp, r2, 1.0);
            const double sn = (quad == 0) ? sp : (quad == 1) ? cp : (quad == 2) ? -sp : -cp;
            const double cs = (quad == 0) ? cp : (quad == 1) ? -sp : (quad == 2) ? -cp : sp;
            float* rp = (float*)(ws + WS_ROPE) + (size_t)i * 2; rp[0] = (float)cs; rp[1] = (float)sn;
        }
    }
    for (int r = gw; r < DEPTH * 2 * NEXP; r += NGW) {
        const int tbl = r / (DEPTH * NEXP), lr = r % (DEPTH * NEXP);
        const float* src = (tbl == 0 ? a.pu : a.pv) + (size_t)lr * 1024;
        f32x4 v[4];
        if (tbl == 0) {
#pragma unroll
            for (int i = 0; i < 4; ++i) v[i] = ((const f32x4*)src)[64 * i + lane];
            quant_row<false>(v, ws + WS_UQ + (size_t)lr * 1024, (float*)(ws + WS_USC) + lr, lane);
        } else {
#pragma unroll
            for (int i = 0; i < 4; ++i) v[i] = ((const f32x4*)src)[4 * lane + i];
            const int l = lr / NEXP, e = lr % NEXP;
            quant_row<false>(v, ws + WS_VQ + (size_t)l * NEXP * 1024 + ((size_t)(lane >> 3) * NEXP + e) * 128 + 16 * (lane & 7) - 16 * lane, (float*)(ws + WS_VSC) + lr, lane);
        }
    }
    if (op_bid() == 0) for (int i = tid; i < DEPTH * 2 * 8 * 64; i += NTHREADS) ((unsigned*)(ws + WS_CTL))[CTL_QUEUE + i] = 0u;
}

template <bool WITH_Q8>
__device__ __forceinline__ void ph_norm(const KArgs& a, const float* xin, const float* g, const float* mod_l, int shift_idx, int scale_idx, int wv) {
    const int tid = phase_tid(wv), lane = tid & 63, wave = wv;
    const int gw = op_bid() * NWAVES + wave, NGW = op_grid() * NWAVES;
    bf16_t* H = (bf16_t*)(a.ws + WS_H);
    for (int row = gw; row < T; row += NGW) {
        const int b = row >> 12;
        f32x4 v[4]; float ss = 0.f;
#pragma unroll
        for (int i = 0; i < 4; ++i) { v[i] = ((const f32x4*)(xin + (size_t)row * DM))[64 * i + lane]; ss += (v[i].x * v[i].x + v[i].y * v[i].y) + (v[i].z * v[i].z + v[i].w * v[i].w); }
        ss = wave_sum(ss);
        const float r = 1.0f / sqrtf(ss * (1.0f / DM) + NORM_EPS);
#pragma unroll
        for (int i = 0; i < 4; ++i) {
            const int col = 256 * i + 4 * lane;
            const f32x4 gg = *(const f32x4*)(g + col), sc = *(const f32x4*)(mod_l + (size_t)b * NMOD + scale_idx * DM + col), sh = *(const f32x4*)(mod_l + (size_t)b * NMOD + shift_idx * DM + col);
            v[i] = (v[i] * r) * gg * (sc + 1.0f) + sh;
            u32x2 o; o.x = pk2(v[i].x, v[i].y); o.y = pk2(v[i].z, v[i].w);
            *(u32x2*)(H + (size_t)row * DM + col) = o;
        }
        if (WITH_Q8) quant_row<false>(v, a.ws + WS_H2Q + (size_t)row * 1024, (float*)(a.ws + WS_HS) + row, lane);
    }
}
__device__ __forceinline__ void ph_final_norm(const KArgs& a, int wv) {
    const int tid = phase_tid(wv), lane = tid & 63, wave = wv;
    const int gw = op_bid() * NWAVES + wave, NGW = op_grid() * NWAVES;
    for (int row = gw; row < T; row += NGW) {
        f32x4 v[4]; float ss = 0.f;
#pragma unroll
        for (int i = 0; i < 4; ++i) { v[i] = ((const f32x4*)(a.out + (size_t)row * DM))[64 * i + lane]; ss += (v[i].x * v[i].x + v[i].y * v[i].y) + (v[i].z * v[i].z + v[i].w * v[i].w); }
        ss = wave_sum(ss);
        const float r = 1.0f / sqrtf(ss * (1.0f / DM) + NORM_EPS);
#pragma unroll
        for (int i = 0; i < 4; ++i) { const f32x4 gg = *(const f32x4*)(a.final_g + 256 * i + 4 * lane); ((f32x4*)(a.out + (size_t)row * DM))[64 * i + lane] = (v[i] * r) * gg; }
    }
}

struct EpiProj {
    static constexpr bool PERM = true, AFTER_DRAIN = false;
    unsigned char* ws;
    __device__ __forceinline__ void operator()(const pg8::f32x4 (&acc)[2][2][4][2], const pg8::Unit& u, int wr, int wc, int fr, int fq) const {
        const int row0 = u.pm * 256 + wr * 64 + fr;
        const float* rope = (const float*)(ws + WS_ROPE);
#pragma unroll
        for (int bj = 0; bj < 2; ++bj) {
            const int cgb = u.pn * 256 + bj * 128;
            bf16_t* base; int pitch, cl, mode;
            if (cgb < 512) { base = (bf16_t*)(ws + WS_QA); pitch = 512; cl = cgb; mode = 1; }
            else if (cgb < 640) { base = (bf16_t*)(ws + WS_KA); pitch = 128; cl = cgb - 512; mode = 2; }
            else if (cgb < 768) { base = (bf16_t*)(ws + WS_VA); pitch = 128; cl = cgb - 640; mode = 0; }
            else if (cgb < 1280) { base = (bf16_t*)(ws + WS_QB); pitch = 512; cl = cgb - 768; mode = 3; }
            else if (cgb < 1792) { base = (bf16_t*)(ws + WS_KB); pitch = 512; cl = cgb - 1280; mode = 0; }
            else if (cgb < 2304) { base = (bf16_t*)(ws + WS_VB); pitch = 512; cl = cgb - 1792; mode = 0; }
            else if (cgb < 3328) { base = (bf16_t*)(ws + WS_GA); pitch = 1024; cl = cgb - 2304; mode = 4; }
            else { base = (bf16_t*)(ws + WS_GB); pitch = 1024; cl = cgb - 3328; mode = 4; }
            const int col = cl + wc * 32 + 8 * fq;
#pragma unroll
            for (int ai = 0; ai < 2; ++ai)
#pragma unroll
                for (int m = 0; m < 4; ++m) {
                    const int row = row0 + ai * 128 + m * 16;
                    pg8::f32x4 v0 = acc[ai][bj][m][0], v1 = acc[ai][bj][m][1];
                    if (mode == 1 || mode == 2) {
                        const int i0 = (col & 63) >> 1;
                        const f32x4 c01 = *(const f32x4*)(rope + ((size_t)row * 32 + i0) * 2), c23 = *(const f32x4*)(rope + ((size_t)row * 32 + i0 + 2) * 2);
                        pg8::f32x4 w0, w1;
                        w0[0] = v0[0] * c01.x - v0[1] * c01.y; w0[1] = v0[1] * c01.x + v0[0] * c01.y;
                        w0[2] = v0[2] * c01.z - v0[3] * c01.w; w0[3] = v0[3] * c01.z + v0[2] * c01.w;
                        w1[0] = v1[0] * c23.x - v1[1] * c23.y; w1[1] = v1[1] * c23.x + v1[0] * c23.y;
                        w1[2] = v1[2] * c23.z - v1[3] * c23.w; w1[3] = v1[3] * c23.z + v1[2] * c23.w;
                        v0 = w0; v1 = w1;
                    }
                    if (mode == 1 || mode == 3) { v0 = v0 * QSCALE; v1 = v1 * QSCALE; }
                    if (mode == 4) {
#pragma unroll
                        for (int e = 0; e < 4; ++e) { v0[e] = 1.0f / (1.0f + __expf(-v0[e])); v1[e] = 1.0f / (1.0f + __expf(-v1[e])); }
                    }
                    u32x4 w; w.x = pk2(v0[0], v0[1]); w.y = pk2(v0[2], v0[3]); w.z = pk2(v1[0], v1[1]); w.w = pk2(v1[2], v1[3]);
                    *(u32x4*)(base + (size_t)row * pitch + col) = w;
                }
        }
    }
};
template <bool ADD> struct EpiBranch {
    static constexpr bool PERM = true, AFTER_DRAIN = false;
    const bf16_t* Gt; bf16_t* O;
    __device__ __forceinline__ void operator()(const pg8::f32x4 (&acc)[2][2][4][2], const pg8::Unit& u, int wr, int wc, int fr, int fq) const {
        const int row0 = u.pm * 256 + wr * 64 + fr, col0 = u.pn * 256 + wc * 32 + 8 * fq;
#pragma unroll
        for (int ai = 0; ai < 2; ++ai)
#pragma unroll
            for (int m = 0; m < 4; ++m)
#pragma unroll
                for (int bj = 0; bj < 2; ++bj) {
                    const size_t off = (size_t)(row0 + ai * 128 + m * 16) * DM + col0 + bj * 128;
                    const u32x4 gv = *(const u32x4*)(Gt + off);
                    const pg8::f32x4 v0 = acc[ai][bj][m][0], v1 = acc[ai][bj][m][1];
                    float r[8];
                    r[0] = bflo(gv.x) * v0[0]; r[1] = bfhi(gv.x) * v0[1]; r[2] = bflo(gv.y) * v0[2]; r[3] = bfhi(gv.y) * v0[3];
                    r[4] = bflo(gv.z) * v1[0]; r[5] = bfhi(gv.z) * v1[1]; r[6] = bflo(gv.w) * v1[2]; r[7] = bfhi(gv.w) * v1[3];
                    if (ADD) { const u32x4 ov = *(const u32x4*)(O + off);
                        r[0] += bflo(ov.x); r[1] += bfhi(ov.x); r[2] += bflo(ov.y); r[3] += bfhi(ov.y); r[4] += bflo(ov.z); r[5] += bfhi(ov.z); r[6] += bflo(ov.w); r[7] += bfhi(ov.w); }
                    u32x4 w; w.x = pk2(r[0], r[1]); w.y = pk2(r[2], r[3]); w.z = pk2(r[4], r[5]); w.w = pk2(r[6], r[7]);
                    *(u32x4*)(O + off) = w;
                }
    }
};
struct EpiWout {
    static constexpr bool PERM = false, AFTER_DRAIN = false;
    const float* xold; float* xnew; const float* gate;
    __device__ __forceinline__ void operator()(const pg8::f32x4 (&acc)[2][2][4][2], const pg8::Unit& u, int wr, int wc, int fr, int fq) const {
        const int row0 = u.pm * 256 + wr * 64 + fr, col0 = u.pn * 256 + wc * 32 + 4 * fq, b = u.pm >> 4;
#pragma unroll
        for (int bj = 0; bj < 2; ++bj)
#pragma unroll
            for (int n = 0; n < 2; ++n) {
                const pg8::f32x4 gv = *(const pg8::f32x4*)(gate + (size_t)b * NMOD + col0 + bj * 128 + n * 16);
#pragma unroll
                for (int ai = 0; ai < 2; ++ai)
#pragma unroll
                    for (int m = 0; m < 4; ++m) { const size_t off = (size_t)(row0 + ai * 128 + m * 16) * DM + col0 + bj * 128 + n * 16;
                        const pg8::f32x4 xo = *(const pg8::f32x4*)(xold + off);
                        *(pg8::f32x4*)(xnew + off) = xo + gv * acc[ai][bj][m][n]; }
            }
    }
};
struct EpiPlainBf16 {
    static constexpr bool PERM = true, AFTER_DRAIN = false;
    bf16_t* O; int ldc;
    __device__ __forceinline__ void operator()(const pg8::f32x4 (&acc)[2][2][4][2], const pg8::Unit& u, int wr, int wc, int fr, int fq) const {
        const int row0 = u.pm * 256 + wr * 64 + fr, col0 = u.pn * 256 + wc * 32 + 8 * fq;
#pragma unroll
        for (int ai = 0; ai < 2; ++ai)
#pragma unroll
            for (int m = 0; m < 4; ++m)
#pragma unroll
                for (int bj = 0; bj < 2; ++bj) {
                    const pg8::f32x4 v0 = acc[ai][bj][m][0], v1 = acc[ai][bj][m][1];
                    u32x4 w; w.x = pk2(v0[0], v0[1]); w.y = pk2(v0[2], v0[3]); w.z = pk2(v1[0], v1[1]); w.w = pk2(v1[2], v1[3]);
                    *(u32x4*)(O + (size_t)(row0 + ai * 128 + m * 16) * ldc + col0 + bj * 128) = w;
                }
    }
};

namespace att {
typedef short bf16x8 __attribute__((ext_vector_type(8)));
typedef short s16x4 __attribute__((ext_vector_type(4)));
typedef float f32x16 __attribute__((ext_vector_type(16)));
__device__ __forceinline__ int crow(int r, int hi) { return (r & 3) + 8 * (r >> 2) + 4 * hi; }
typedef float f32x2_t __attribute__((ext_vector_type(2))); typedef __bf16 bf16x2_t __attribute__((ext_vector_type(2)));
__device__ __forceinline__ unsigned cvtpk(float lo, float hi) { f32x2_t v = {lo, hi}; bf16x2_t b = __builtin_convertvector(v, bf16x2_t); return __builtin_bit_cast(unsigned, b); }
#define ATT_SBAR() __builtin_amdgcn_sched_barrier(0)

__device__ __forceinline__ void qkt(f32x16& p0, f32x16& p1, const LAS unsigned char* kslot, const bf16x8 (&qr)[4], int r32, int hi) {
    const LAS unsigned char* kb = kslot + hi * 1024 + r32 * 16;
    p0 = f32x16{}; p1 = f32x16{};
#pragma unroll
    for (int d0 = 0; d0 < 4; ++d0) {
        const bf16x8 b0 = *(const LAS bf16x8*)(kb + d0 * 2048);
        const bf16x8 b1 = *(const LAS bf16x8*)(kb + d0 * 2048 + 512);
        p0 = __builtin_amdgcn_mfma_f32_32x32x16_bf16(b0, qr[d0], p0, 0, 0, 0);
        p1 = __builtin_amdgcn_mfma_f32_32x32x16_bf16(b1, qr[d0], p1, 0, 0, 0);
    }
}
__device__ __forceinline__ void pv(f32x16 (&o)[2], int vb, bf16x8 pa0, bf16x8 pa1, bf16x8 pa2, bf16x8 pa3) {
#pragma unroll
    for (int d0 = 0; d0 < 2; ++d0) {
        s16x4 lo[4], hh[4];
#pragma unroll
        for (int ks = 0; ks < 4; ++ks) {
            asm volatile("ds_read_b64_tr_b16 %0,%1 offset:%c2" : "=&v"(lo[ks]) : "v"(vb), "i"(d0 * 4096 + ks * 1024) : "memory");
            asm volatile("ds_read_b64_tr_b16 %0,%1 offset:%c2" : "=&v"(hh[ks]) : "v"(vb), "i"(d0 * 4096 + ks * 1024 + 512) : "memory");
        }
        asm volatile("s_waitcnt lgkmcnt(0)" ::: "memory"); ATT_SBAR();
#define ATT_PK(k) (bf16x8){lo[k][0], lo[k][1], lo[k][2], lo[k][3], hh[k][0], hh[k][1], hh[k][2], hh[k][3]}
        o[d0] = __builtin_amdgcn_mfma_f32_32x32x16_bf16(pa0, ATT_PK(0), o[d0], 0, 0, 0);
        o[d0] = __builtin_amdgcn_mfma_f32_32x32x16_bf16(pa1, ATT_PK(1), o[d0], 0, 0, 0);
        o[d0] = __builtin_amdgcn_mfma_f32_32x32x16_bf16(pa2, ATT_PK(2), o[d0], 0, 0, 0);
        o[d0] = __builtin_amdgcn_mfma_f32_32x32x16_bf16(pa3, ATT_PK(3), o[d0], 0, 0, 0);
#undef ATT_PK
    }
}
__device__ __forceinline__ void pack_p(const f32x16& p0, const f32x16& p1, bf16x8& pa0, bf16x8& pa1, bf16x8& pa2, bf16x8& pa3) {
    u32x4 w0, w1, w2, w3;
    w0 = (u32x4){cvtpk(p0[0], p0[1]), cvtpk(p0[2], p0[3]), cvtpk(p0[4], p0[5]), cvtpk(p0[6], p0[7])};
    w1 = (u32x4){cvtpk(p0[8], p0[9]), cvtpk(p0[10], p0[11]), cvtpk(p0[12], p0[13]), cvtpk(p0[14], p0[15])};
    w2 = (u32x4){cvtpk(p1[0], p1[1]), cvtpk(p1[2], p1[3]), cvtpk(p1[4], p1[5]), cvtpk(p1[6], p1[7])};
    w3 = (u32x4){cvtpk(p1[8], p1[9]), cvtpk(p1[10], p1[11]), cvtpk(p1[12], p1[13]), cvtpk(p1[14], p1[15])};
    pa0 = __builtin_bit_cast(bf16x8, w0); pa1 = __builtin_bit_cast(bf16x8, w1); pa2 = __builtin_bit_cast(bf16x8, w2); pa3 = __builtin_bit_cast(bf16x8, w3);
}
__device__ __forceinline__ u32x4 tile_gload(const bf16_t* src, int pitch, int tid) { return *(const u32x4*)(src + (size_t)(tid >> 3) * pitch + (tid & 7) * 8); }
__device__ __forceinline__ void tile_kwrite(LAS unsigned char* kslot, u32x4 v, int tid) { *(LAS u32x4*)(kslot + (tid & 7) * 1024 + (tid >> 3) * 16) = v; }
__device__ __forceinline__ void tile_vwrite(LAS unsigned char* vslot, u32x4 v, int tid) { const int c = tid & 7; *(LAS u32x4*)(vslot + (c >> 2) * 4096 + (tid >> 3) * 64 + (c & 3) * 16) = v; }
__device__ __forceinline__ void store_o(const f32x16 (&o)[2], const float (&rs)[16], LAS unsigned char* stage, bf16_t* Ow, int pitch, int lane) {
    asm volatile("" : "+v"(lane));
    const int r32 = lane & 31, hi = lane >> 5;
    LAS bf16_t* stg = (LAS bf16_t*)stage;
#pragma unroll
    for (int r = 0; r < 16; ++r) { const int orow = crow(r, hi);
#pragma unroll
        for (int d0 = 0; d0 < 2; ++d0) stg[orow * 64 + d0 * 32 + r32] = (bf16_t)f2bf(o[d0][r] * rs[r]); }
    asm volatile("s_waitcnt lgkmcnt(0)" ::: "memory");
#pragma unroll
    for (int i = 0; i < 4; ++i) { const int row = i * 8 + (lane >> 3), ch = lane & 7; const u32x4 v = *(const LAS u32x4*)(stg + row * 64 + ch * 8); *(u32x4*)(Ow + (size_t)row * pitch + ch * 8) = v; }
    asm volatile("s_waitcnt lgkmcnt(0)" ::: "memory");
}

constexpr int SB_WLDS = 8192;
template <bool EARLY_EXIT>
__device__ __forceinline__ void sb_phase(const bf16_t* Q, const bf16_t* K, const bf16_t* V, bf16_t* O, LAS unsigned char* lds, int wv) {
    const int tid = phase_tid(wv), lane = tid & 63, r32 = lane & 31, hi = lane >> 5, wid = wv;
    LAS unsigned char* vimg = lds + wid * SB_WLDS;
    const int vb0 = (int)(unsigned)(uintptr_t)vimg + ((lane >> 4) & 1) * 32 + (lane & 3) * 8 + (4 * hi + ((lane & 15) >> 2)) * 64;
    const int vwoff = ((lane & 7) >> 2) * 4096 + (lane >> 3) * 64 + (lane & 3) * 16;
    const float m0 = hi == 0 ? 1.0f : 0.0f;
    const int G_ = op_grid(), bid_ = op_bid(), vbid = (G_ % 8 == 0) ? (bid_ % 8) * (G_ / 8) + bid_ / 8 : bid_;
    const int gw = vbid * NWAVES + wid, NGW = G_ * NWAVES;
    for (int wu = gw; wu < BATCH * 8 * (SEQ / 32); wu += NGW) {
        const int rb = wu & 127, h = (wu >> 7) & 7, b = wu >> 10;
        const int R0 = rb * 32;
        const size_t rowbase = (size_t)b * SEQ;
        const char* Kb = (const char*)(K + rowbase * 512 + h * 64); const char* Vb = (const char*)(V + rowbase * 512 + h * 64);
        const unsigned koff = (unsigned)(r32 * 1024 + hi * 16), voff = (unsigned)((lane >> 3) * 1024 + (lane & 7) * 16);
        const bf16_t* Qw = Q + (rowbase + R0) * 512 + h * 64;
        bf16x8 qr[4];
#pragma unroll
        for (int d0 = 0; d0 < 4; ++d0) qr[d0] = *(const bf16x8*)((const char*)Qw + koff + d0 * 32);
        int kt = R0 >> 6;
        bf16x8 kf[8]; u32x4 vr[8];
#define SB_LOADK(KT) do { const char* k0_ = Kb + (size_t)(KT) * 65536; const char* k1_ = k0_ + 32768; _Pragma("unroll") for (int d0 = 0; d0 < 4; ++d0) { kf[2 * d0] = *(const bf16x8*)(k0_ + koff + d0 * 32); kf[2 * d0 + 1] = *(const bf16x8*)(k1_ + koff + d0 * 32); } } while (0)
#define SB_LOADV(KT) do { const char* v0_ = Vb + (size_t)(KT) * 65536; _Pragma("unroll") for (int i = 0; i < 8; ++i) vr[i] = *(const u32x4*)(v0_ + i * 8192 + voff); } while (0)
        SB_LOADK(kt); SB_LOADV(kt);
        f32x16 o[2]; o[0] = f32x16{}; o[1] = f32x16{};
        float carry = 0.f;
        for (;;) {
            f32x16 p0 = f32x16{}, p1 = f32x16{};
#pragma unroll
            for (int d0 = 0; d0 < 4; ++d0) { p0 = __builtin_amdgcn_mfma_f32_32x32x16_bf16(kf[2 * d0], qr[d0], p0, 0, 0, 0); p1 = __builtin_amdgcn_mfma_f32_32x32x16_bf16(kf[2 * d0 + 1], qr[d0], p1, 0, 0, 0); }
            const bool more = kt > 0;
#pragma unroll
            for (int i = 0; i < 8; ++i) *(LAS u32x4*)(vimg + vwoff + i * 512) = vr[i];
            if (more) { SB_LOADK(kt - 1); SB_LOADV(kt - 1); }
            const int D = R0 - 64 * kt;
            if (D < 64) {
                const int thr = D + r32 - 4 * hi;
#pragma unroll
                for (int r = 0; r < 16; ++r) { const int cr = (r & 3) + 8 * (r >> 2); if (cr >= thr) p0[r] = -INFINITY; if (cr + 32 >= thr) p1[r] = -INFINITY; }
            }
            float tt[8], uu[8];
#define SB_SP(x) (fmaxf(x, 0.f) + __builtin_amdgcn_logf(1.0f + __builtin_amdgcn_exp2f(-fabsf(x))))
#pragma unroll
            for (int i = 0; i < 4; ++i) {
                float s3 = SB_SP(p0[4 * i + 3]), s2 = s3 + SB_SP(p0[4 * i + 2]), s1 = s2 + SB_SP(p0[4 * i + 1]), s0 = s1 + SB_SP(p0[4 * i]);
                p0[4 * i + 3] -= s3; p0[4 * i + 2] -= s2; p0[4 * i + 1] -= s1; p0[4 * i] -= s0; tt[i] = s0;
                s3 = SB_SP(p1[4 * i + 3]); s2 = s3 + SB_SP(p1[4 * i + 2]); s1 = s2 + SB_SP(p1[4 * i + 1]); s0 = s1 + SB_SP(p1[4 * i]);
                p1[4 * i + 3] -= s3; p1[4 * i + 2] -= s2; p1[4 * i + 1] -= s1; p1[4 * i] -= s0; tt[4 + i] = s0;
                __builtin_amdgcn_sched_barrier(0);
            }
#undef SB_SP
#pragma unroll
            for (int k = 0; k < 8; ++k) { auto rr = __builtin_amdgcn_permlane32_swap(__float_as_uint(tt[k]), __float_as_uint(tt[k]), false, false); uu[k] = __uint_as_float(hi ? rr[0] : rr[1]); }
            float sw = 0.f;
#pragma unroll
            for (int k = 7; k >= 0; --k) {
                const float bs = carry - (sw + m0 * uu[k]); sw += tt[k] + uu[k];
                if (k < 4) { p0[4 * k] = __builtin_amdgcn_exp2f(p0[4 * k] + bs); p0[4 * k + 1] = __builtin_amdgcn_exp2f(p0[4 * k + 1] + bs); p0[4 * k + 2] = __builtin_amdgcn_exp2f(p0[4 * k + 2] + bs); p0[4 * k + 3] = __builtin_amdgcn_exp2f(p0[4 * k + 3] + bs); }
                else { const int i = k - 4; p1[4 * i] = __builtin_amdgcn_exp2f(p1[4 * i] + bs); p1[4 * i + 1] = __builtin_amdgcn_exp2f(p1[4 * i + 1] + bs); p1[4 * i + 2] = __builtin_amdgcn_exp2f(p1[4 * i + 2] + bs); p1[4 * i + 3] = __builtin_amdgcn_exp2f(p1[4 * i + 3] + bs); }
            }
            carry -= sw;
            bf16x8 pa0, pa1, pa2, pa3; pack_p(p0, p1, pa0, pa1, pa2, pa3);
            pv(o, vb0, pa0, pa1, pa2, pa3);
            if (!more) break;
            if (EARLY_EXIT && __all(carry < -SB_EXIT)) break;
            --kt;
        }
        float ones[16];
#pragma unroll
        for (int r = 0; r < 16; ++r) ones[r] = 1.0f;
        store_o(o, ones, vimg, O + (rowbase + R0) * 512 + h * 64, 512, phase_tid(wv) & 63);
    }
#undef SB_LOADK
#undef SB_LOADV
}

__device__ __forceinline__ void swa_phase(const bf16_t* Q, const bf16_t* K, const bf16_t* V, bf16_t* O, const float* sinks, LAS unsigned char* lds, int wv) {
    const int tid = phase_tid(wv), lane = tid & 63, r32 = lane & 31, hi = lane >> 5, wid = wv;
    LAS unsigned char* vimg = lds + wid * SB_WLDS;
    const int vb0 = (int)(unsigned)(uintptr_t)vimg + ((lane >> 4) & 1) * 32 + (lane & 3) * 8 + (4 * hi + ((lane & 15) >> 2)) * 64;
    const int vwoff = ((lane & 7) >> 2) * 4096 + (lane >> 3) * 64 + (lane & 3) * 16;
    const int G_ = op_grid(), bid_ = op_bid(), vbid = (G_ % 8 == 0) ? (bid_ % 8) * (G_ / 8) + bid_ / 8 : bid_;
    const int gw = vbid * NWAVES + wid, NGW = G_ * NWAVES;
    for (int wu = gw; wu < BATCH * 8 * (SEQ / 32); wu += NGW) {
        const int rb = wu & 127, hq = (wu >> 7) & 7, b = wu >> 10, kvh = hq >> 2;
        const int R0 = rb * 32, a = R0 >> 6;
        const size_t rowbase = (size_t)b * SEQ;
        const char* Kb = (const char*)(K + rowbase * 128 + kvh * 64); const char* Vb = (const char*)(V + rowbase * 128 + kvh * 64);
        const unsigned koff = (unsigned)(r32 * 256 + hi * 16), voff = (unsigned)((lane >> 3) * 256 + (lane & 7) * 16);
        const bf16_t* Qw = Q + (rowbase + R0) * 512 + hq * 64;
        bf16x8 qr[4];
#pragma unroll
        for (int d0 = 0; d0 < 4; ++d0) qr[d0] = *(const bf16x8*)((const char*)Qw + (unsigned)(r32 * 1024 + hi * 16) + d0 * 32);
        const float sink2 = sinks[hq] * LOG2E;
        bf16x8 kf[8];
#define SW_LOADK(KT) do { const char* k0_ = Kb + (size_t)(KT) * 16384; const char* k1_ = k0_ + 8192; _Pragma("unroll") for (int d0 = 0; d0 < 4; ++d0) { kf[2 * d0] = *(const bf16x8*)(k0_ + koff + d0 * 32); kf[2 * d0 + 1] = *(const bf16x8*)(k1_ + koff + d0 * 32); } } while (0)
#define SW_QKT(P0, P1) do { P0 = f32x16{}; P1 = f32x16{}; _Pragma("unroll") for (int d0 = 0; d0 < 4; ++d0) { P0 = __builtin_amdgcn_mfma_f32_32x32x16_bf16(kf[2 * d0], qr[d0], P0, 0, 0, 0); P1 = __builtin_amdgcn_mfma_f32_32x32x16_bf16(kf[2 * d0 + 1], qr[d0], P1, 0, 0, 0); } } while (0)
        const int kt_lo = a >= 2 ? a - 2 : 0;
        float m = sink2;
        SW_LOADK(kt_lo);
        for (int kt = kt_lo; kt <= a; ++kt) {
            f32x16 p0, p1; SW_QKT(p0, p1);
            if (kt < a) SW_LOADK(kt + 1);
            const int thr = R0 - 64 * kt + r32 - 4 * hi;
#pragma unroll
            for (int r = 0; r < 16; ++r) { const int cr = (r & 3) + 8 * (r >> 2);
                const bool v0 = cr <= thr && cr > thr - 128, v1 = cr + 32 <= thr && cr + 32 > thr - 128;
                m = fmaxf(m, fmaxf(v0 ? p0[r] : -INFINITY, v1 ? p1[r] : -INFINITY)); }
        }
        { auto rr = __builtin_amdgcn_permlane32_swap(__float_as_uint(m), __float_as_uint(m), false, false); m = fmaxf(__uint_as_float(rr[0]), __uint_as_float(rr[1])); }
        float lsum = 0.f;
        f32x16 o[2]; o[0] = f32x16{}; o[1] = f32x16{};
        SW_LOADK(kt_lo);
        for (int kt = kt_lo; kt <= a; ++kt) {
            u32x4 vr[8];
            { const char* v0_ = Vb + (size_t)kt * 16384;
#pragma unroll
              for (int i = 0; i < 8; ++i) vr[i] = *(const u32x4*)(v0_ + i * 2048 + voff); }
            f32x16 p0, p1; SW_QKT(p0, p1);
            if (kt < a) SW_LOADK(kt + 1);
            const int thr = R0 - 64 * kt + r32 - 4 * hi;
#pragma unroll
            for (int r = 0; r < 16; ++r) { const int cr = (r & 3) + 8 * (r >> 2);
                const bool v0 = cr <= thr && cr > thr - 128, v1 = cr + 32 <= thr && cr + 32 > thr - 128;
                p0[r] = v0 ? __builtin_amdgcn_exp2f(p0[r] - m) : 0.f; p1[r] = v1 ? __builtin_amdgcn_exp2f(p1[r] - m) : 0.f; lsum += p0[r] + p1[r]; }
#pragma unroll
            for (int i = 0; i < 8; ++i) *(LAS u32x4*)(vimg + vwoff + i * 512) = vr[i];
            bf16x8 pa0, pa1, pa2, pa3; pack_p(p0, p1, pa0, pa1, pa2, pa3); pv(o, vb0, pa0, pa1, pa2, pa3);
        }
#undef SW_LOADK
#undef SW_QKT
        { auto rr = __builtin_amdgcn_permlane32_swap(__float_as_uint(lsum), __float_as_uint(lsum), false, false); lsum = __uint_as_float(rr[0]) + __uint_as_float(rr[1]); }
        lsum += __builtin_amdgcn_exp2f(sink2 - m);
        LAS float* wsf = (LAS float*)vimg;
        asm volatile("s_waitcnt lgkmcnt(0)" ::: "memory");
        if (hi == 0) wsf[r32] = 1.0f / lsum;
        asm volatile("s_waitcnt lgkmcnt(0)" ::: "memory");
        float rs[16];
#pragma unroll
        for (int r = 0; r < 16; ++r) rs[r] = wsf[crow(r, hi)];
        asm volatile("s_waitcnt lgkmcnt(0)" ::: "memory");
        store_o(o, rs, vimg, O + (rowbase + R0) * 512 + hq * 64, 512, phase_tid(wv) & 63);
    }
}
}

namespace tk {
typedef short bf16x8 __attribute__((ext_vector_type(8)));
typedef float f32x16 __attribute__((ext_vector_type(16)));
__device__ __forceinline__ float vmax(float a, float b) { float r; asm("v_max_f32 %0, %1, %2" : "=v"(r) : "v"(a), "v"(b)); return r; }
__device__ __forceinline__ float vmin(float a, float b) { float r; asm("v_min_f32 %0, %1, %2" : "=v"(r) : "v"(a), "v"(b)); return r; }
#define TK_CE(a, b) { const float t_ = vmax(a, b); b = vmin(a, b); a = t_; }
__device__ __forceinline__ void sort16(float (&v)[16]) {
    TK_CE(v[0], v[1]) TK_CE(v[2], v[3]) TK_CE(v[0], v[2]) TK_CE(v[1], v[3]) TK_CE(v[1], v[2]) TK_CE(v[4], v[5]) TK_CE(v[6], v[7]) TK_CE(v[4], v[6])
    TK_CE(v[5], v[7]) TK_CE(v[5], v[6]) TK_CE(v[0], v[4]) TK_CE(v[2], v[6]) TK_CE(v[2], v[4]) TK_CE(v[1], v[5]) TK_CE(v[3], v[7]) TK_CE(v[3], v[5])
    TK_CE(v[1], v[2]) TK_CE(v[3], v[4]) TK_CE(v[5], v[6]) TK_CE(v[8], v[9]) TK_CE(v[10], v[11]) TK_CE(v[8], v[10]) TK_CE(v[9], v[11]) TK_CE(v[9], v[10])
    TK_CE(v[12], v[13]) TK_CE(v[14], v[15]) TK_CE(v[12], v[14]) TK_CE(v[13], v[15]) TK_CE(v[13], v[14]) TK_CE(v[8], v[12]) TK_CE(v[10], v[14]) TK_CE(v[10], v[12])
    TK_CE(v[9], v[13]) TK_CE(v[11], v[15]) TK_CE(v[11], v[13]) TK_CE(v[9], v[10]) TK_CE(v[11], v[12]) TK_CE(v[13], v[14]) TK_CE(v[0], v[8]) TK_CE(v[4], v[12])
    TK_CE(v[4], v[8]) TK_CE(v[2], v[10]) TK_CE(v[6], v[14]) TK_CE(v[6], v[10]) TK_CE(v[2], v[4]) TK_CE(v[6], v[8]) TK_CE(v[10], v[12]) TK_CE(v[1], v[9])
    TK_CE(v[5], v[13]) TK_CE(v[5], v[9]) TK_CE(v[3], v[11]) TK_CE(v[7], v[15]) TK_CE(v[7], v[11]) TK_CE(v[3], v[5]) TK_CE(v[7], v[9]) TK_CE(v[11], v[13])
    TK_CE(v[1], v[2]) TK_CE(v[3], v[4]) TK_CE(v[5], v[6]) TK_CE(v[7], v[8]) TK_CE(v[9], v[10]) TK_CE(v[11], v[12]) TK_CE(v[13], v[14])
}
__device__ __forceinline__ void bmerge16(float (&v)[16]) {
    TK_CE(v[0], v[8]) TK_CE(v[1], v[9]) TK_CE(v[2], v[10]) TK_CE(v[3], v[11]) TK_CE(v[4], v[12]) TK_CE(v[5], v[13]) TK_CE(v[6], v[14]) TK_CE(v[7], v[15])
    TK_CE(v[0], v[4]) TK_CE(v[1], v[5]) TK_CE(v[2], v[6]) TK_CE(v[3], v[7]) TK_CE(v[8], v[12]) TK_CE(v[9], v[13]) TK_CE(v[10], v[14]) TK_CE(v[11], v[15])
    TK_CE(v[0], v[2]) TK_CE(v[1], v[3]) TK_CE(v[4], v[6]) TK_CE(v[5], v[7]) TK_CE(v[8], v[10]) TK_CE(v[9], v[11]) TK_CE(v[12], v[14]) TK_CE(v[13], v[15])
    TK_CE(v[0], v[1]) TK_CE(v[2], v[3]) TK_CE(v[4], v[5]) TK_CE(v[6], v[7]) TK_CE(v[8], v[9]) TK_CE(v[10], v[11]) TK_CE(v[12], v[13]) TK_CE(v[14], v[15])
}

__device__ __forceinline__ void merge_top16(float (&a)[16], const float (&b)[16]) {
#pragma unroll
    for (int i = 0; i < 16; ++i) a[i] = vmax(a[i], b[15 - i]);
    bmerge16(a);
}
__device__ __forceinline__ float partner_f(float v, int hi) { auto rr = __builtin_amdgcn_permlane32_swap(__float_as_uint(v), __float_as_uint(v), false, false); return __uint_as_float(hi ? rr[0] : rr[1]); }
__device__ __forceinline__ void merge_partner(float (&a)[16], int hi) {
    float pp[16];
#pragma unroll
    for (int i = 0; i < 16; ++i) pp[i] = partner_f(a[i], hi);
    merge_top16(a, pp);
}
__device__ __forceinline__ void take_block(float (&v)[16], const f32x16& acc, int blk, unsigned hi4) {
#pragma unroll
    for (int r = 0; r < 16; ++r) { const unsigned code = 127u - (unsigned)(32 * blk + (r & 3) + 8 * (r >> 2)); v[r] = __uint_as_float(((__float_as_uint(acc[r]) & 0xFFFFFF80u) | code) ^ hi4); }
    sort16(v);
}
constexpr int TK_SK = 0, TK_IDX = 65536, TK_LDS_END = 65536 + 8192;
constexpr float TK_NEG = -3.4028234663852886e38f;
template <int P>
__device__ __forceinline__ void half_top16(float (&L)[16], const bf16_t* qrow, LAS unsigned char* lds, LAS unsigned char* idxslot, int r32, int hi) {
    bf16x8 qf[8];
#pragma unroll
    for (int ks = 0; ks < 8; ++ks) qf[ks] = *(const bf16x8*)(qrow + P * 128 + 16 * ks + 8 * hi);
    f32x16 acc[4];
#pragma unroll
    for (int blk = 0; blk < 4; ++blk) acc[blk] = f32x16{};
    const LAS unsigned char* ab = lds + TK_SK + P * 32768 + hi * 2048 + r32 * 16;
#pragma unroll
    for (int ks = 0; ks < 8; ++ks)
#pragma unroll
        for (int blk = 0; blk < 4; ++blk) {
            const bf16x8 af = *(const LAS bf16x8*)(ab + ks * 4096 + blk * 512);
            acc[blk] = __builtin_amdgcn_mfma_f32_32x32x16_bf16(af, qf[ks], acc[blk], 0, 0, 0);
        }
    const unsigned hi4 = (unsigned)hi << 2;
    float M[16];
    take_block(L, acc[0], 0, hi4); take_block(M, acc[1], 1, hi4); merge_top16(L, M);
    { float N[16]; take_block(M, acc[2], 2, hi4); take_block(N, acc[3], 3, hi4); merge_top16(M, N); }
    merge_top16(L, M);
    merge_partner(L, hi);
    if (hi == 0) {
        u32x4 w;
#pragma unroll
        for (int q = 0; q < 4; ++q) w[q] = (__float_as_uint(L[4 * q]) & 127u) | ((__float_as_uint(L[4 * q + 1]) & 127u) << 8) | ((__float_as_uint(L[4 * q + 2]) & 127u) << 16) | ((__float_as_uint(L[4 * q + 3]) & 127u) << 24);
        *(LAS u32x4*)(idxslot + P * 16) = w;
    }
}
__device__ __forceinline__ float cand(float x, float y, unsigned code, unsigned hi8) { return __uint_as_float((__float_as_uint(x + y) & 0xFFFFFE00u) | code | hi8); }

__device__ __forceinline__ void topk_phase(const bf16_t* Q2, const bf16_t* SKl, int* IDX, float* GATE, LAS unsigned char* lds, int wv) {
        const int tid = phase_tid(wv), lane = tid & 63, r32 = lane & 31, hi = lane >> 5, wid = wv;
    LAS unsigned char* idxslot = lds + TK_IDX + wid * 1024 + r32 * 32;
    int cur_h = -1;
    for (int unit = op_bid(); unit < 8 * (T / 256); unit += op_grid()) {
        const int h = unit & 7, tb = unit >> 3;
        if (h != cur_h) {
            __syncthreads();
#pragma unroll
            for (int i = 0; i < 8; ++i) { const int id = tid + 512 * i, c = id & 15, n = (id >> 4) & 127, p = id >> 11;
                const u32x4 v = *(const u32x4*)(SKl + ((size_t)(h * 2 + p) * 128 + n) * 128 + c * 8);
                *(LAS u32x4*)(lds + TK_SK + p * 32768 + c * 2048 + n * 16) = v; }
            __syncthreads();
            cur_h = h;
        }
        const size_t token = (size_t)tb * 256 + wid * 32 + r32;
        const bf16_t* qrow = Q2 + token * PQ + h * 256;
        float a[16], b[16];
        half_top16<0>(a, qrow, lds, idxslot, r32, hi);
        half_top16<1>(b, qrow, lds, idxslot, r32, hi);
        float x[16], y[16];
#pragma unroll
        for (int i = 0; i < 16; ++i) { float av = a[i], bv = b[i]; asm volatile("" : "+v"(av), "+v"(bv)); x[i] = hi ? bv : av; y[i] = hi ? av : bv; }
        const unsigned hi8 = (unsigned)hi << 8;
        float A[16], B[16];
#pragma unroll
        for (int j = 1; j < 16; ++j) A[j - 1] = cand(x[0], y[j], (unsigned)j, hi8);
        A[15] = TK_NEG;
#pragma unroll
        for (int j = 2; j < 8; ++j) B[j - 2] = cand(x[1], y[j], (unsigned)(16 + j), hi8);
        B[6] = cand(x[2], y[3], 2u * 16u + 3u, hi8); B[7] = cand(x[2], y[4], 2u * 16u + 4u, hi8);
#pragma unroll
        for (int i = 0; i < 4; ++i) { const float d = cand(x[i], y[i], (unsigned)(17 * i), hi8); B[8 + i] = hi ? TK_NEG : d; }
        B[12] = TK_NEG; B[13] = TK_NEG; B[14] = TK_NEG; B[15] = TK_NEG;
        sort16(B);
        merge_top16(A, B);
        merge_partner(A, hi);
        const float smax = A[0];
        float ex[8]; int eidx[8]; float lsum = 0.f;
        asm volatile("s_waitcnt lgkmcnt(0)" ::: "memory");
#pragma unroll
        for (int k = 0; k < 8; ++k) {
            float s_lo = A[k], s_hi = A[8 + k]; asm volatile("" : "+v"(s_lo), "+v"(s_hi)); const float s = hi ? s_hi : s_lo;
            ex[k] = __expf(s - smax); lsum += ex[k];
            const unsigned code = __float_as_uint(s) & 0x1FFu, src = code >> 8, ci = (code >> 4) & 15u, cj = code & 15u;
            const unsigned ai = src ? cj : ci, bi = src ? ci : cj;
            const unsigned ca = idxslot[ai], cb = idxslot[16 + bi];
            eidx[k] = (int)(((ca ^ 127u) << 7) | (cb ^ 127u));
        }
        const float tot = lsum + partner_f(lsum, hi);
        const float inv = 1.0f / tot;
        int* ip = IDX + token * 128 + h * 16 + 8 * hi; float* gp = GATE + token * 128 + h * 16 + 8 * hi;
        *(u32x4*)ip = (u32x4){(unsigned)eidx[0], (unsigned)eidx[1], (unsigned)eidx[2], (unsigned)eidx[3]};
        *(u32x4*)(ip + 4) = (u32x4){(unsigned)eidx[4], (unsigned)eidx[5], (unsigned)eidx[6], (unsigned)eidx[7]};
        *(f32x4*)gp = (f32x4){ex[0] * inv, ex[1] * inv, ex[2] * inv, ex[3] * inv};
        *(f32x4*)(gp + 4) = (f32x4){ex[4] * inv, ex[5] * inv, ex[6] * inv, ex[7] * inv};
        asm volatile("s_waitcnt lgkmcnt(0)" ::: "memory");
    }
}
}

namespace peer3 {
__device__ __forceinline__ unsigned xcc_id() { return (unsigned)__builtin_amdgcn_s_getreg((3 << 11) | 20) & 7u; }
constexpr int UNIT = 16, NUNIT = T / UNIT;
template <int CTRL> __device__ __forceinline__ int dpp_i(int v) { return __builtin_amdgcn_update_dpp(0, v, CTRL, 0xF, 0xF, true); }
__device__ __forceinline__ int rowsum16(int v) { v += dpp_i<0xB1>(v); v += dpp_i<0x4E>(v); v += dpp_i<0x141>(v); v += dpp_i<0x140>(v); return v; }
__device__ __forceinline__ float gelu_as(float v) {
    const float av = fabsf(v), t = __builtin_amdgcn_rcpf(fmaf(av, 0.2316418882f, 1.0f));
    float q = fmaf(t, 0.5307027145f, -0.7265760135f); q = fmaf(q, t, 0.7107068705f); q = fmaf(q, t, -0.142248368f); q = fmaf(q, t, 0.127414796f); q = q * t;
    const float e = __builtin_amdgcn_exp2f(v * v * -0.72134752044f), m = v * (q * e);
    return v < 0.f ? m : v - m;
}
__device__ __forceinline__ unsigned take_async(unsigned* p, int lane) { unsigned v = 0u; if (lane == 0) v = __hip_atomic_fetch_add(p, 1u, __ATOMIC_RELAXED, __HIP_MEMORY_SCOPE_AGENT); return v; }

constexpr int UST = 6;
__device__ __forceinline__ void u_unit(const KArgs& a, int l, unsigned s, unsigned unit, LAS unsigned char* wlds, int lane) {
    const unsigned char* UQ = a.ws + WS_UQ + (size_t)l * NEXP * 1024;
    const float* USC = (const float*)(a.ws + WS_USC) + l * NEXP; const float* VSC = (const float*)(a.ws + WS_VSC) + l * NEXP;
    const int* IDX = (const int*)(a.ws + WS_IDX); const float* GATE = (const float*)(a.ws + WS_GATE);
    const unsigned char* HQ = a.ws + WS_H2Q; const float* HS = (const float*)(a.ws + WS_HS);
    float* COEF = (float*)(a.ws + WS_COEF);
    LAS int* lst = (LAS int*)wlds; LAS float* res = (LAS float*)(wlds + 512);
    const int q = lane >> 4, r = lane & 15;
    const size_t t0 = (size_t)unit * UNIT;
    int idx0 = IDX[t0 * 128 + lane], idx1 = IDX[t0 * 128 + 64 + lane];
    float g0 = GATE[t0 * 128 + lane], g1 = GATE[t0 * 128 + 64 + lane], sh = HS[t0];
    u32x4 hv[4];
#pragma unroll
    for (int k = 0; k < 4; ++k) hv[k] = *(const u32x4*)(HQ + t0 * 1024 + 256 * k + 16 * r);
#pragma unroll 1
    for (int i = 0; i < UNIT; ++i) {
        const size_t t = t0 + i, tn = t0 + (i + 1 < UNIT ? i + 1 : i);
        const bool in0 = (unsigned)(idx0 >> 11) == s, in1 = (unsigned)(idx1 >> 11) == s;
        float us0 = 0.f, us1 = 0.f, vs0 = 0.f, vs1 = 0.f;
        if (in0) { us0 = USC[idx0]; vs0 = VSC[idx0]; }
        if (in1) { us1 = USC[idx1]; vs1 = VSC[idx1]; }
        const int nidx0 = IDX[tn * 128 + lane], nidx1 = IDX[tn * 128 + 64 + lane];
        const float ng0 = GATE[tn * 128 + lane], ng1 = GATE[tn * 128 + 64 + lane], nsh = HS[tn];
        const unsigned long long m0 = __ballot(in0), m1 = __ballot(in1);
        const int c0 = __builtin_popcountll(m0), n = c0 + __builtin_popcountll(m1);
        const int rank0 = (int)__builtin_amdgcn_mbcnt_hi((unsigned)(m0 >> 32), __builtin_amdgcn_mbcnt_lo((unsigned)m0, 0u));
        const int rank1 = c0 + (int)__builtin_amdgcn_mbcnt_hi((unsigned)(m1 >> 32), __builtin_amdgcn_mbcnt_lo((unsigned)m1, 0u));
        if (in0) lst[rank0] = idx0;
        if (in1) lst[rank1] = idx1;
#pragma unroll 1
        for (int base = 0; base < n; base += 4 * UST) {
            const int nst = (n - base + 3) >> 2;
            u32x4 uv[UST][4];
#pragma unroll
            for (int st = 0; st < UST; ++st) {
                if (st < nst) {
                    int slot = base + 4 * st + q; slot = slot < n ? slot : n - 1;
                    const unsigned char* rp = UQ + (size_t)lst[slot] * 1024 + 16 * r;
#pragma unroll
                    for (int k = 0; k < 4; ++k) uv[st][k] = *(const u32x4*)(rp + 256 * k);
                }
            }
#pragma unroll
            for (int st = 0; st < UST; ++st) {
                if (st < nst) {
                    int s0_ = 0, s1_ = 0, s2_ = 0, s3_ = 0;
#pragma unroll
                    for (int k = 0; k < 4; ++k) {
                        s0_ = __builtin_amdgcn_sdot4((int)uv[st][k].x, (int)hv[k].x, s0_, false); s1_ = __builtin_amdgcn_sdot4((int)uv[st][k].y, (int)hv[k].y, s1_, false);
                        s2_ = __builtin_amdgcn_sdot4((int)uv[st][k].z, (int)hv[k].z, s2_, false); s3_ = __builtin_amdgcn_sdot4((int)uv[st][k].w, (int)hv[k].w, s3_, false);
                    }
                    const int tot = rowsum16((s0_ + s1_) + (s2_ + s3_));
                    if (r == 0) res[base + 4 * st + q] = (float)tot;
                }
            }
        }
        const float d0 = in0 ? res[rank0] : 0.f, d1 = in1 ? res[rank1] : 0.f;
        u32x4 nhv[4];
#pragma unroll
        for (int k = 0; k < 4; ++k) nhv[k] = *(const u32x4*)(HQ + tn * 1024 + 256 * k + 16 * r);
        if (in0) COEF[t * 128 + lane] = gelu_as(d0 * us0 * sh) * g0 * vs0;
        if (in1) COEF[t * 128 + 64 + lane] = gelu_as(d1 * us1 * sh) * g1 * vs1;
        idx0 = nidx0; idx1 = nidx1; g0 = ng0; g1 = ng1; sh = nsh;
#pragma unroll
        for (int k = 0; k < 4; ++k) hv[k] = nhv[k];
    }
}
struct VMeta { u32x4 iv[4]; f32x4 cv[4]; };
__device__ __forceinline__ void v_meta(VMeta& m, const int* IDX, const float* COEF, size_t t, int g) {
#pragma unroll
    for (int q = 0; q < 4; ++q) { m.iv[q] = *(const u32x4*)(IDX + t * 128 + 16 * g + 4 * q); m.cv[q] = *(const f32x4*)(COEF + t * 128 + 16 * g + 4 * q); }
}
__device__ __forceinline__ void v_stage(u32x4 (&P)[16], u32x4& CQ, float& cs, const VMeta& m, const unsigned char* VS) {
    float cm = 0.f;
#pragma unroll
    for (int j = 0; j < 16; ++j) cm = fmaxf(cm, fabsf(m.cv[j >> 2][j & 3]));
    cm = fmaxf(cm, swz_xor<8>(cm)); cm = fmaxf(cm, swz_xor<16>(cm));
    { auto rr = __builtin_amdgcn_permlane32_swap(__float_as_uint(cm), __float_as_uint(cm), false, false); cm = fmaxf(__uint_as_float(rr[0]), __uint_as_float(rr[1])); }
    const float inv = cm > 0.f ? 127.0f / cm : 0.f; cs = cm * (1.0f / 127.0f);
#pragma unroll
    for (int qd = 0; qd < 4; ++qd) {
        const int c0 = (int)rintf(m.cv[qd][0] * inv), c1 = (int)rintf(m.cv[qd][1] * inv), c2 = (int)rintf(m.cv[qd][2] * inv), c3 = (int)rintf(m.cv[qd][3] * inv);
        CQ[qd] = (unsigned)(c0 & 0xff) | ((unsigned)(c1 & 0xff) << 8) | ((unsigned)(c2 & 0xff) << 16) | ((unsigned)(c3 & 0xff) << 24);
    }
#pragma unroll
    for (int j = 0; j < 16; ++j) P[j] = *(const u32x4*)(VS + (size_t)m.iv[j >> 2][j & 3] * 128);
}
__device__ __forceinline__ void v_compute(const u32x4 (&P)[16], const u32x4& CQ, float cs, float* xout, const float* mod_l, size_t t, unsigned s, int lane) {
    const int g = lane >> 3, p = lane & 7; const bool b4 = (lane >> 4) & 1, b3 = (lane >> 3) & 1;
    typedef float f32x2 __attribute__((ext_vector_type(2)));
    const int col = (int)s * 128 + 16 * p + 2 * g, b = (int)(t >> 12);
    float* xp = xout + t * DM + col;
    f32x2 xv = *(const f32x2*)xp;
    const f32x2 gt = *(const f32x2*)(mod_l + (size_t)b * NMOD + 5 * DM + col);
    int acc[16];
#pragma unroll
    for (int k = 0; k < 16; ++k) acc[k] = 0;
#pragma unroll
    for (int qd = 0; qd < 4; ++qd)
#pragma unroll
        for (int w = 0; w < 4; ++w) {
            const unsigned A = P[4 * qd][w], B = P[4 * qd + 1][w], C = P[4 * qd + 2][w], D = P[4 * qd + 3][w];
            const unsigned X = __builtin_amdgcn_perm(B, A, 0x05010400u), Y = __builtin_amdgcn_perm(B, A, 0x07030602u);
            const unsigned Z = __builtin_amdgcn_perm(D, C, 0x05010400u), W = __builtin_amdgcn_perm(D, C, 0x07030602u);
            const unsigned T0 = __builtin_amdgcn_perm(Z, X, 0x05040100u), T1 = __builtin_amdgcn_perm(Z, X, 0x07060302u);
            const unsigned T2 = __builtin_amdgcn_perm(W, Y, 0x05040100u), T3 = __builtin_amdgcn_perm(W, Y, 0x07060302u);
            acc[4 * w + 0] = __builtin_amdgcn_sdot4((int)T0, (int)CQ[qd], acc[4 * w + 0], false); acc[4 * w + 1] = __builtin_amdgcn_sdot4((int)T1, (int)CQ[qd], acc[4 * w + 1], false);
            acc[4 * w + 2] = __builtin_amdgcn_sdot4((int)T2, (int)CQ[qd], acc[4 * w + 2], false); acc[4 * w + 3] = __builtin_amdgcn_sdot4((int)T3, (int)CQ[qd], acc[4 * w + 3], false);
        }
    int r8[8], r4[4], r2[2];
#pragma unroll
    for (int q = 0; q < 8; ++q) { auto rr = __builtin_amdgcn_permlane32_swap((unsigned)acc[q], (unsigned)acc[8 + q], false, false); r8[q] = (int)rr[0] + (int)rr[1]; }
#pragma unroll
    for (int q = 0; q < 4; ++q) { int lo = r8[q], hi = r8[4 + q]; asm volatile("" : "+v"(lo), "+v"(hi)); const int keep = b4 ? hi : lo, send = b4 ? lo : hi; r4[q] = keep + __builtin_amdgcn_ds_swizzle(send, (16 << 10) | 0x1f); }
#pragma unroll
    for (int q = 0; q < 2; ++q) { int lo = r4[q], hi = r4[2 + q]; asm volatile("" : "+v"(lo), "+v"(hi)); const int keep = b3 ? hi : lo, send = b3 ? lo : hi; r2[q] = keep + __builtin_amdgcn_ds_swizzle(send, (8 << 10) | 0x1f); }
    xv.x += gt.x * ((float)r2[0] * cs); xv.y += gt.y * ((float)r2[1] * cs);
    *(f32x2*)xp = xv;
}
__device__ __forceinline__ void v_unit(const KArgs& a, int l, const float* mod_l, unsigned s, unsigned unit, int lane) {
    const int g = lane >> 3, p = lane & 7;
    const unsigned char* VS = a.ws + WS_VQ + (size_t)l * NEXP * 1024 + (size_t)s * NEXP * 128 + 16 * p;
    const int* IDX = (const int*)(a.ws + WS_IDX); const float* COEF = (const float*)(a.ws + WS_COEF);
    const size_t t0 = (size_t)unit * UNIT;
    VMeta m; v_meta(m, IDX, COEF, t0, g);
    u32x4 PA[16], PB[16], CQA, CQB; float csA, csB;
    v_stage(PA, CQA, csA, m, VS);
    v_meta(m, IDX, COEF, t0 + 1, g);
#pragma unroll 1
    for (int i = 0; i < UNIT; i += 2) {
        v_stage(PB, CQB, csB, m, VS);
        v_meta(m, IDX, COEF, t0 + (i + 2 < UNIT ? i + 2 : i), g);
        v_compute(PA, CQA, csA, a.out, mod_l, t0 + i, s, lane);
        if (i + 2 < UNIT) { v_stage(PA, CQA, csA, m, VS); v_meta(m, IDX, COEF, t0 + (i + 3 < UNIT ? i + 3 : i), g); }
        v_compute(PB, CQB, csB, a.out, mod_l, t0 + i + 1, s, lane);
    }
}
template <bool VSTEP>
__device__ __forceinline__ void peer_phase(const KArgs& a, int l, const float* mod_l, unsigned* cnt, LAS unsigned char* lds, int wv) {
        const int tid = phase_tid(wv), lane = tid & 63, wid = wv;
    LAS unsigned char* wlds = lds + wid * 1024;
    const unsigned home = xcc_id();
    unsigned ss = 0, s = home;
    unsigned nxt = take_async(cnt + 64 * s, lane);
    for (;;) {
        const unsigned cur = (unsigned)__builtin_amdgcn_readfirstlane((int)nxt);
        if (cur >= (unsigned)NUNIT) { if (++ss == 8u) break; s = (home + ss) & 7u; nxt = take_async(cnt + 64 * s, lane); continue; }
        nxt = take_async(cnt + 64 * s, lane);
        if (VSTEP) v_unit(a, l, mod_l, s, cur, lane); else u_unit(a, l, s, cur, wlds, lane);
    }
}
}

constexpr int PH_PER_LAYER = 10, NPHASES = 1 + DEPTH * PH_PER_LAYER + 1;
#ifndef PHASE_MASK
#define PHASE_MASK 0xFFFF
#endif
#define HASP(k) (((PHASE_MASK) >> (k)) & 1)
#ifndef SB_EARLY_EXIT
#define SB_EARLY_EXIT 1
#endif

#define GAS __attribute__((address_space(1)))
#define RLX_AGENT __ATOMIC_RELAXED, __HIP_MEMORY_SCOPE_AGENT
#define XB_TMO      128
#define XB_XCNT(j)  (256  + 64 * (j))
#define XB_XSUB(j)  (1280 + 64 * (j))
#define XB_XGEN(j)  (2304 + 64 * (j))
#define XB_TOP      3328
#define XB_TOPGEN   3392
#define XCD_BAR_WORDS 3456
#define XB_SPIN_CAP (1u << 18)

__device__ __forceinline__ unsigned xb_ld(unsigned* p)              { return __hip_atomic_load(p, __ATOMIC_RELAXED, __HIP_MEMORY_SCOPE_AGENT); }
__device__ __forceinline__ unsigned xb_add(unsigned* p, unsigned v) { return __hip_atomic_fetch_add(p, v, __ATOMIC_RELAXED, __HIP_MEMORY_SCOPE_AGENT); }
__device__ __forceinline__ unsigned xb_xcc_id() { return (unsigned)__builtin_amdgcn_s_getreg((3 << 11) | 20) & 0xFu; }
#define XB_SPIN(cond, bar) do { unsigned _sp = 0; while (cond) { __builtin_amdgcn_s_sleep(1); \
    if ((++_sp & 255u) == 0u) { if (xb_ld(&(bar)[XB_TMO])) break; if (_sp > XB_SPIN_CAP) { atomicAdd(&(bar)[XB_TMO], 1u); break; } } } } while (0)

struct XcdBarrier {
    unsigned* bar; unsigned x;
    volatile LAS unsigned* st;
};

__device__ __forceinline__ XcdBarrier xcd_barrier_post(unsigned* bar, volatile LAS unsigned* st, bool tid0) {
    XcdBarrier b; b.bar = bar; b.x = xb_xcc_id(); b.st = st;
    if (tid0) (void)xb_add(&bar[XB_XCNT(b.x)], 1u);
    return b;
}
__device__ __forceinline__ void xcd_barrier_complete(unsigned* bar, unsigned x, unsigned& nloc, unsigned& nx) {
    const unsigned G = gridDim.x * gridDim.y * gridDim.z;
    unsigned sum, cnt, mine, sp = 0u;
    for (;;) {
        sum = 0u; cnt = 0u; mine = 0u;
#pragma unroll
        for (unsigned j = 0; j < 16; ++j) { const unsigned c = xb_ld(&bar[XB_XCNT(j)]); sum += c; cnt += (c > 0u) ? 1u : 0u; mine = (j == x) ? c : mine; }
        if (sum == G) break;
        __builtin_amdgcn_s_sleep(1);
        if ((++sp & 255u) == 0u) { if (xb_ld(&bar[XB_TMO])) break; if (sp > XB_SPIN_CAP) { atomicAdd(&bar[XB_TMO], 1u); break; } }
    }
    nloc = mine > 0u ? mine : 1u; nx = cnt > 0u ? cnt : 1u;
}

__device__ __forceinline__ void xcd_barrier(const XcdBarrier& b, bool tid0) {
    asm volatile("s_waitcnt vmcnt(0)" ::: "memory");
    __syncthreads();
    if (tid0) {
        unsigned* bar = b.bar;
        __builtin_amdgcn_s_waitcnt(0);
        unsigned nloc = b.st[0], nx = b.st[1];
        if (nloc == 0u) { xcd_barrier_complete(bar, b.x, nloc, nx); b.st[0] = nloc; b.st[1] = nx; }
        const unsigned old = xb_add(&bar[XB_XSUB(b.x)], 1u);
        const unsigned gen = old / nloc;
        if (old + 1u == (gen + 1u) * nloc) {
            __builtin_amdgcn_fence(__ATOMIC_RELEASE, "agent");
            asm volatile("s_waitcnt vmcnt(0)" ::: "memory");
            const unsigned og = xb_add(&bar[XB_TOP], 1u);
            const unsigned tg = og / nx;
            if (og + 1u == (tg + 1u) * nx) xb_add(&bar[XB_TOPGEN], 1u);
            else XB_SPIN(xb_ld(&bar[XB_TOPGEN]) == tg, bar);
            __builtin_amdgcn_fence(__ATOMIC_ACQUIRE, "agent");
            xb_add(&bar[XB_XGEN(b.x)], 1u);
            asm volatile("s_waitcnt vmcnt(0)" ::: "memory");
        } else {
            XB_SPIN(xb_ld(&bar[XB_XGEN(b.x)]) == gen, bar);
            __builtin_amdgcn_fence(__ATOMIC_ACQUIRE, "agent");
            asm volatile("s_waitcnt vmcnt(0)" ::: "memory");
        }
    }
    __syncthreads();
}

typedef const __attribute__((address_space(4))) KArgs* KArgsP;
__device__ __forceinline__ KArgsP kargs() { KArgsP p = (KArgsP)__builtin_amdgcn_kernarg_segment_ptr(); asm volatile("" : "+s"(p)); return p; }

__device__ __forceinline__ void load_args(KArgs& a) {
#if defined(__HIP_DEVICE_COMPILE__)
    KArgsP p = kargs();
    a.x = p->x; a.c = p->c; a.pos = p->pos; a.ada_w = p->ada_w; a.ada_b = p->ada_b; a.norm1_g = p->norm1_g; a.w_in = p->w_in; a.sinks = p->sinks; a.wbr_a = p->wbr_a; a.wbr_b = p->wbr_b;
    a.w_out = p->w_out; a.norm2_g = p->norm2_g; a.wq = p->wq; a.subkeys = p->subkeys; a.pu = p->pu; a.pv = p->pv; a.final_g = p->final_g; a.out = p->out; a.ws = p->ws; a.ph_lo = p->ph_lo; a.ph_hi = p->ph_hi;
#endif
}
__global__ void __launch_bounds__(NTHREADS, 2) fwd_kernel(KArgs a_unused) {
    extern __shared__ __attribute__((aligned(16))) unsigned char lds_raw[];
    LAS unsigned char* lds = (LAS unsigned char*)lds_raw;
    cg::grid_group grid = cg::this_grid();
    const int ph_lo = kargs()->ph_lo, ph_hi = kargs()->ph_hi;
    const int wv = __builtin_amdgcn_readfirstlane((int)threadIdx.x >> 6);
#define IN(k) (ph_lo <= (k) && (k) < ph_hi)
    volatile LAS unsigned* xb_st = (volatile LAS unsigned*)(lds + LDS_BYTES - 64);
    { const bool t0_ = phase_tid(wv) == 0; if (t0_) { xb_st[0] = 0u; xb_st[1] = 0u; } __syncthreads();
      (void)xcd_barrier_post((unsigned*)(kargs()->ws + WS_CTL) + CTL_BAR, xb_st, t0_); }
#define GRID_BAR() do { XcdBarrier b_; b_.bar = (unsigned*)(kargs()->ws + WS_CTL) + CTL_BAR; b_.x = xb_xcc_id(); b_.st = xb_st; xcd_barrier(b_, phase_tid(wv) == 0); } while (0)
#ifdef PROBE_PH
    volatile LAS unsigned long long* pr_mem = (volatile LAS unsigned long long*)(lds + LDS_BYTES - 32);
    if (blockIdx.x == 0 && threadIdx.x == 0) { pr_mem[0] = __builtin_amdgcn_s_memrealtime(); pr_mem[1] = 0; }
#define PROBE_MATCH(k) ((PROBE_PH) >= 100 ? ((k) >= 1 && (k) < NPHASES - 1 && (((k) - 1) % PH_PER_LAYER) == (PROBE_PH) - 100) : (k) == (PROBE_PH))
#define PROBE_STAMP(k) do { if (blockIdx.x == 0 && threadIdx.x == 0) { const unsigned long long now_ = __builtin_amdgcn_s_memrealtime(); if (PROBE_MATCH(k)) pr_mem[1] = pr_mem[1] + (now_ - pr_mem[0]); pr_mem[0] = now_; } } while (0)
#define SEAM(k) do { if (IN(k) && IN((k) + 1)) { if ((k) == 0) grid.sync(); else GRID_BAR(); } PROBE_STAMP(k); } while (0)
#else
#define SEAM(k) do { if (IN(k) && IN((k) + 1)) { if ((k) == 0) grid.sync(); else GRID_BAR(); } } while (0)
#endif
#define LOADARGS KArgs a; load_args(a); unsigned char* ws = a.ws; const int G = op_grid(); (void)G; (void)ws
#define LAYERARGS const float* mod_l = (const float*)(ws + WS_MOD) + (size_t)l * 8 * NMOD; const float* xcur = (l == 0) ? a.x : a.out; (void)mod_l; (void)xcur
    if (IN(0)) { if (HASP(0)) { LOADARGS; ph_prologue(a, lds, wv); } }
    SEAM(0);
#pragma unroll 1
    for (int l = 0; l < DEPTH; ++l) {
        const int p0 = 1 + l * PH_PER_LAYER;
        if (IN(p0 + 0)) { if (HASP(1)) { LOADARGS; LAYERARGS; ph_norm<false>(a, xcur, a.norm1_g + l * DM, mod_l, 0, 1, wv); } }
        SEAM(p0 + 0);
        if (IN(p0 + 1)) { if (HASP(2)) { LOADARGS; pg8::Gemm g{(const bf16_t*)(ws + WS_H), (const bf16_t*)(ws + WS_WIN) + (size_t)l * NPROJ * 1024, T, NPROJ, 1024};
                  pg8::StaticOrder S; S.init(T, NPROJ, G, op_bid()); EpiProj E{ws};
                  pg8::gemm_phase<EpiProj, pg8::StaticOrder, true, true>(lds, g, S, E, wv); } }
        SEAM(p0 + 1);
        if (IN(p0 + 2)) { if (HASP(3)) { LOADARGS;
                  att::swa_phase((const bf16_t*)(ws + WS_QA), (const bf16_t*)(ws + WS_KA), (const bf16_t*)(ws + WS_VA), (bf16_t*)(ws + WS_QA), a.sinks + l * 8, lds, wv);
                  __syncthreads();
                  att::sb_phase<SB_EARLY_EXIT != 0>((const bf16_t*)(ws + WS_QB), (const bf16_t*)(ws + WS_KB), (const bf16_t*)(ws + WS_VB), (bf16_t*)(ws + WS_QB), lds, wv); } }
        SEAM(p0 + 2);
        if (IN(p0 + 3)) { if (HASP(4)) { LOADARGS; pg8::StaticOrder S; S.init(T, DM, G, op_bid());
                  { pg8::Gemm g{(const bf16_t*)(ws + WS_QA), (const bf16_t*)(ws + WS_WBA) + (size_t)l * 1024 * 512, T, DM, 512};
                    EpiBranch<false> E{(const bf16_t*)(ws + WS_GA), (bf16_t*)(ws + WS_H)};
                    pg8::gemm_phase<EpiBranch<false>, pg8::StaticOrder, true, true>(lds, g, S, E, wv); }
                  __syncthreads();
                  { pg8::Gemm g{(const bf16_t*)(ws + WS_QB), (const bf16_t*)(ws + WS_WBB) + (size_t)l * 1024 * 512, T, DM, 512};
                    EpiBranch<true> E{(const bf16_t*)(ws + WS_GB), (bf16_t*)(ws + WS_H)};
                    pg8::gemm_phase<EpiBranch<true>, pg8::StaticOrder, true, true>(lds, g, S, E, wv); } } }
        SEAM(p0 + 3);
        if (IN(p0 + 4)) { if (HASP(5)) { LOADARGS; LAYERARGS; pg8::Gemm g{(const bf16_t*)(ws + WS_H), (const bf16_t*)(ws + WS_WOUT) + (size_t)l * 1024 * 1024, T, DM, 1024};
                  pg8::StaticOrder S; S.init(T, DM, G, op_bid()); EpiWout E{xcur, a.out, mod_l + 2 * DM};
                  pg8::gemm_phase<EpiWout, pg8::StaticOrder, true, true>(lds, g, S, E, wv); } }
        SEAM(p0 + 4);
        if (IN(p0 + 5)) { if (HASP(6)) { LOADARGS; LAYERARGS; ph_norm<true>(a, a.out, a.norm2_g + l * DM, mod_l, 3, 4, wv); } }
        SEAM(p0 + 5);
        if (IN(p0 + 6)) { if (HASP(7)) { LOADARGS; pg8::Gemm g{(const bf16_t*)(ws + WS_H), (const bf16_t*)(ws + WS_WQ) + (size_t)l * PQ * 1024, T, PQ, 1024};
                  pg8::StaticOrder S; S.init(T, PQ, G, op_bid()); EpiPlainBf16 E{(bf16_t*)(ws + WS_Q2), PQ};
                  pg8::gemm_phase<EpiPlainBf16, pg8::StaticOrder, true, true>(lds, g, S, E, wv); } }
        SEAM(p0 + 6);
        if (IN(p0 + 7)) { if (HASP(8)) { LOADARGS; tk::topk_phase((const bf16_t*)(ws + WS_Q2), (const bf16_t*)(ws + WS_SK) + (size_t)l * 8 * 2 * 128 * 128, (int*)(ws + WS_IDX), (float*)(ws + WS_GATE), lds, wv); } }
        SEAM(p0 + 7);
        if (IN(p0 + 8)) { if (HASP(9)) { LOADARGS; peer3::peer_phase<false>(a, l, nullptr, (unsigned*)(ws + WS_CTL) + CTL_QUEUE + (l * 2 + 0) * 8 * 64, lds, wv); } }
        SEAM(p0 + 8);
        if (IN(p0 + 9)) { if (HASP(10)) { LOADARGS; LAYERARGS; peer3::peer_phase<true>(a, l, mod_l, (unsigned*)(ws + WS_CTL) + CTL_QUEUE + (l * 2 + 1) * 8 * 64, lds, wv); } }
        SEAM(p0 + 9);
    }
    if (IN(NPHASES - 1)) { if (HASP(11)) { LOADARGS; ph_final_norm(a, wv); } }
#ifdef PROBE_PH
    PROBE_STAMP(NPHASES - 1);
    if (blockIdx.x == 0 && threadIdx.x == 0) { const unsigned long long t0_ = __builtin_amdgcn_s_memrealtime(), dl_ = pr_mem[1] * (PROBE_K); while (__builtin_amdgcn_s_memrealtime() - t0_ < dl_) __builtin_amdgcn_s_sleep(16); }
#endif
#undef IN
#undef SEAM
}

#ifndef N_LAUNCH_SPLIT
#define N_LAUNCH_SPLIT 1
#endif
extern "C" void kernel_launch(void* const* d_in, const int* in_sizes, int n_in, void* d_out, int out_size, void* d_ws, size_t ws_size, hipStream_t stream) {
    static int grid = 0;
    if (grid == 0) {
        if (n_in != 17 || out_size != T * DM || ws_size < WS_END) { fprintf(stderr, "kernel_launch: unexpected problem (n_in %d out %d ws %zu)\n", n_in, out_size, ws_size); grid = -1; return; }
        int dev = 0, cus = 0, per_cu = 0;
        (void)hipGetDevice(&dev);
        (void)hipDeviceGetAttribute(&cus, hipDeviceAttributeMultiprocessorCount, dev);
        (void)hipFuncSetAttribute((const void*)fwd_kernel, hipFuncAttributeMaxDynamicSharedMemorySize, LDS_BYTES);
        (void)hipOccupancyMaxActiveBlocksPerMultiprocessor(&per_cu, (const void*)fwd_kernel, NTHREADS, LDS_BYTES);
        if (per_cu < 1) { fprintf(stderr, "kernel_launch: occupancy query says %d\n", per_cu); per_cu = 1; }
        grid = cus;
        fprintf(stderr, "kernel_launch: cus %d per_cu %d grid %d ws %zu\n", cus, per_cu, grid, ws_size);
    }
    if (grid < 0) return;
    if (hipMemsetAsync((char*)d_ws + WS_CTL, 0, 65536, stream) != hipSuccess) { fprintf(stderr, "kernel_launch: hipMemsetAsync of the control words failed\n"); return; }
    KArgs a{};
    a.x = (const float*)d_in[0]; a.c = (const float*)d_in[1]; a.pos = (const int*)d_in[2]; a.ada_w = (const float*)d_in[3]; a.ada_b = (const float*)d_in[4];
    a.norm1_g = (const float*)d_in[5]; a.w_in = (const float*)d_in[6]; a.sinks = (const float*)d_in[7]; a.wbr_a = (const float*)d_in[8]; a.wbr_b = (const float*)d_in[9];
    a.w_out = (const float*)d_in[10]; a.norm2_g = (const float*)d_in[11]; a.wq = (const float*)d_in[12]; a.subkeys = (const float*)d_in[13]; a.pu = (const float*)d_in[14];
    a.pv = (const float*)d_in[15]; a.final_g = (const float*)d_in[16]; a.out = (float*)d_out; a.ws = (unsigned char*)d_ws;
#if N_LAUNCH_SPLIT
    a.ph_lo = 0; a.ph_hi = NPHASES;
    { void* args[] = {&a};
      hipError_t e = hipLaunchCooperativeKernel((void*)fwd_kernel, dim3(grid), dim3(NTHREADS), args, LDS_BYTES, stream);
      if (e != hipSuccess) fprintf(stderr, "cooperative launch failed: %s (grid %d)\n", hipGetErrorString(e), grid); }
#else
    for (int ph = 0; ph < NPHASES; ++ph) {
        a.ph_lo = ph; a.ph_hi = ph + 1;
        void* args[] = {&a};
        hipError_t e = hipLaunchCooperativeKernel((void*)fwd_kernel, dim3(grid), dim3(NTHREADS), args, LDS_BYTES, stream);
        if (e != hipSuccess) { fprintf(stderr, "cooperative launch %d failed: %s (grid %d)\n", ph, hipGetErrorString(e), grid); break; }
    }
#endif
}
```

```cpp
#include <hip/hip_runtime.h>
#include <hip/hip_cooperative_groups.h>
#include <cstdio>
#include <cstdint>
namespace cg = cooperative_groups;

namespace pg8 {
#define PG8_LAS __attribute__((address_space(3)))
typedef unsigned short bf16_t;
typedef short bf16x8 __attribute__((ext_vector_type(8)));
typedef float f32x4 __attribute__((ext_vector_type(4)));
typedef unsigned u32x4 __attribute__((ext_vector_type(4)));
constexpr int BM = 256, BK = 64, HALF = 128, HTB = HALF * BK * 2  , STAGE_BYTES = 8 * HTB, NXCD = 8, WGM = 8;

__host__ __device__ __forceinline__ int lds_byte(int r, int c) { const int st = (r >> 4) * 2 + (c >> 5), rr = r & 15, cc = c & 31, ob = rr * 64 + cc * 2; return st * 1024 + (ob ^ (((ob >> 9) & 1) << 5)); }
__host__ __device__ __forceinline__ void stage_rc(int b, int& R, int& C) { const int st = b / 1024, sb = b % 1024, swz = sb ^ (((sb >> 9) & 1) << 5); R = (st >> 1) * 16 + swz / 64; C = (st & 1) * 32 + (swz % 64) / 2; }
__host__ __device__ __forceinline__ int perm32(int rho) { const int n = rho >> 4, i = rho & 15; return 8 * (i >> 2) + 4 * n + (i & 3); }

struct Unit { int pm, pn; };
struct Gemm { const bf16_t* A; const bf16_t* Bt; int M, N, K; };

struct StaticOrder {
    int nM, nN, nwg, G, c;
    __host__ __device__ void init(int M, int N, int G_, int c_) { nM = M / BM; nN = N / BM; nwg = nM * nN; G = G_; c = c_; }
    __host__ __device__ bool next(int i, Unit& u) const {
        const long L = (long)i * G + c; if (L >= nwg) return false;
        int wgid = (int)L; { const int q = nwg / NXCD, r = nwg % NXCD, xcd = wgid % NXCD, off = wgid / NXCD; wgid = (xcd < r ? xcd * (q + 1) : r * (q + 1) + (xcd - r) * q) + off; }
        const int nig = WGM * nN, gid = wgid / nig, fm = gid * WGM, gsz = (nM - fm) < WGM ? (nM - fm) : WGM;
        u.pm = fm + ((wgid % nig) % gsz); u.pn = (wgid % nig) / gsz; return true;
    }
    __device__ __forceinline__ void a_ready(const Unit&) const {}
    __device__ __forceinline__ void done(const Unit&) const {}
};


__device__ __forceinline__ unsigned cvt_pk_bf16(float lo, float hi) { unsigned r; asm volatile("v_cvt_pk_bf16_f32 %0, %1, %2" : "=v"(r) : "v"(lo), "v"(hi)); return r; }
template <class Epi, class Sched, bool ALIGN_EPI = false, bool SP2 = false>
__device__ __forceinline__ void gemm_phase(PG8_LAS unsigned char* lds, const Gemm g, const Sched& S, const Epi& E, int wv) {
    unsigned m_op = ~0u; asm volatile("" : "+s"(m_op));
    const int tid = wv * 64 + (int)__builtin_amdgcn_mbcnt_hi(m_op, __builtin_amdgcn_mbcnt_lo(m_op, 0u)), wid = wv, lane = tid & 63, wr = wid >> 2, wc = wid & 3, fr = lane & 15, fq = lane >> 4;
    const int K = g.K, nt = K / BK;
    unsigned voffA[2], voffB[2];
#pragma unroll
    for (int i = 0; i < 2; ++i) { int R, C; stage_rc(tid * 16 + i * 8192, R, C); const int Rb = Epi::PERM ? ((R & ~31) + perm32(R & 31)) : R;
        voffA[i] = (unsigned)(R * K + C) * 2u; voffB[i] = (unsigned)(Rb * K + C) * 2u; }
    const size_t kstep = (size_t)(BK * 2);
    const size_t hstep = (size_t)HALF * K * 2;
    const size_t tstep = 2 * hstep;
    const unsigned ldsw = (unsigned)wid * 1024u;
    const int aoff = lds_byte(wr * 64 + fr, fq * 8), boff = lds_byte(wc * 32 + fr, fq * 8);
#define PG8_SA(b, h) (((b) * 2 + (h)) * HTB)
#define PG8_SB(b, h) ((4 + (b) * 2 + (h)) * HTB)
#define PG8_STAGE(bufoff, gbase, voff) do { _Pragma("unroll") for (int _i = 0; _i < 2; ++_i) \
        __builtin_amdgcn_global_load_lds((const unsigned*)((const char*)(gbase) + (voff)[_i]), (PG8_LAS unsigned*)(lds + (bufoff) + ldsw + _i * 8192), 16, 0, 0); } while (0)
#define PG8_LDA(dst, b, h) do { _Pragma("unroll") for (int m = 0; m < 4; ++m) _Pragma("unroll") for (int k = 0; k < 2; ++k) dst[m][k] = *(const PG8_LAS bf16x8*)(lds + PG8_SA(b, h) + aoff + m * 2048 + k * 1024); } while (0)
#define PG8_LDB(dst, b, h) do { _Pragma("unroll") for (int n = 0; n < 2; ++n) _Pragma("unroll") for (int k = 0; k < 2; ++k) dst[n][k] = *(const PG8_LAS bf16x8*)(lds + PG8_SB(b, h) + boff + n * 2048 + k * 1024); } while (0)
#define PG8_MMA(ai, bj, At, Bt) do { __builtin_amdgcn_s_setprio(1); _Pragma("unroll") for (int m = 0; m < 4; ++m) _Pragma("unroll") for (int n = 0; n < 2; ++n) _Pragma("unroll") for (int k = 0; k < 2; ++k) \
        acc[ai][bj][m][n] = __builtin_amdgcn_mfma_f32_16x16x32_bf16(Bt[n][k], At[m][k], acc[ai][bj][m][n], 0, 0, 0); __builtin_amdgcn_s_setprio(0); } while (0)
#define PG8_WAIT_V(n) asm volatile("s_waitcnt vmcnt(" #n ")" ::: "memory")
#define PG8_WAIT_L(n) asm volatile("s_waitcnt lgkmcnt(" #n ")" ::: "memory")
#define PG8_BAR __builtin_amdgcn_s_barrier()
#define PG8_SCHED __builtin_amdgcn_sched_barrier(0)
    Unit cur, nxt; int ui = 0;
    if (!S.next(0, cur)) return;
    f32x4 acc[2][2][4][2];
#pragma unroll
    for (int a = 0; a < 2; ++a)
#pragma unroll
        for (int b = 0; b < 2; ++b)
#pragma unroll
            for (int m = 0; m < 4; ++m)
#pragma unroll
                for (int n = 0; n < 2; ++n) acc[a][b][m][n] = (f32x4){0.f, 0.f, 0.f, 0.f};
    bf16x8 At[4][2], B0[2][2], B1[2][2];
    const char* cA = (const char*)g.A + (size_t)cur.pm * tstep; const char* cB = (const char*)g.Bt + (size_t)cur.pn * tstep;
    S.a_ready(cur);
    if constexpr (SP2) {
        PG8_STAGE(PG8_SB(0, 0), cB, voffB); PG8_STAGE(PG8_SB(0, 1), cB + hstep, voffB); PG8_STAGE(PG8_SA(0, 0), cA, voffA); PG8_STAGE(PG8_SA(0, 1), cA + hstep, voffA);
        if (wr == 1) PG8_BAR;
        PG8_WAIT_V(2); PG8_BAR;
        PG8_STAGE(PG8_SB(1, 0), cB + kstep, voffB); PG8_STAGE(PG8_SA(1, 0), cA + kstep, voffA); PG8_STAGE(PG8_SB(1, 1), cB + hstep + kstep, voffB);
        PG8_WAIT_V(6); PG8_BAR;
    } else {
        PG8_STAGE(PG8_SB(0, 0), cB, voffB); PG8_STAGE(PG8_SA(0, 0), cA, voffA); PG8_STAGE(PG8_SB(0, 1), cB + hstep, voffB); PG8_STAGE(PG8_SA(0, 1), cA + hstep, voffA);
        if (wr == 1) PG8_BAR;
        PG8_WAIT_V(4); PG8_BAR;
        PG8_STAGE(PG8_SB(1, 0), cB + kstep, voffB); PG8_STAGE(PG8_SA(1, 0), cA + kstep, voffA); PG8_STAGE(PG8_SB(1, 1), cB + hstep + kstep, voffB);
        PG8_WAIT_V(6); PG8_BAR;
    }
    for (;;) {
        const bool has_next = S.next(ui + 1, nxt);
        const char* nA = has_next ? (const char*)g.A + (size_t)nxt.pm * tstep : cA; const char* nB = has_next ? (const char*)g.Bt + (size_t)nxt.pn * tstep : cB;
        for (int t = 0; t < nt; t += 2) {
            const bool last = (t == nt - 2);
            const char* a1 = cA + (size_t)(t + 1) * kstep;
            const char* a2 = last ? nA : cA + (size_t)(t + 2) * kstep; const char* b2 = last ? nB : cB + (size_t)(t + 2) * kstep;
            const char* a3 = a2 + kstep; const char* b3 = b2 + kstep;
            if (last && has_next) S.a_ready(nxt);
            if constexpr (SP2) {
            PG8_LDB(B0, 0, 0); PG8_LDB(B1, 0, 1); PG8_SCHED; PG8_LDA(At, 0, 0); PG8_STAGE(PG8_SA(1, 1), a1 + hstep, voffA);
            PG8_WAIT_V(8); PG8_WAIT_L(0); PG8_BAR; PG8_MMA(0, 0, At, B0); PG8_MMA(0, 1, At, B1); PG8_BAR; PG8_SCHED;
            PG8_LDA(At, 0, 1); PG8_STAGE(PG8_SB(0, 0), b2, voffB); PG8_STAGE(PG8_SB(0, 1), b2 + hstep, voffB); PG8_STAGE(PG8_SA(0, 0), a2, voffA);
            PG8_WAIT_V(8); PG8_WAIT_L(0); PG8_BAR; PG8_MMA(1, 0, At, B0); PG8_MMA(1, 1, At, B1); PG8_BAR; PG8_SCHED;
            PG8_LDB(B0, 1, 0); PG8_LDB(B1, 1, 1); PG8_SCHED; PG8_LDA(At, 1, 0); PG8_STAGE(PG8_SA(0, 1), a2 + hstep, voffA);
            PG8_WAIT_V(8); PG8_WAIT_L(0); PG8_BAR; PG8_MMA(0, 0, At, B0); PG8_MMA(0, 1, At, B1); PG8_BAR; PG8_SCHED;
            PG8_LDA(At, 1, 1); PG8_STAGE(PG8_SB(1, 0), b3, voffB); PG8_STAGE(PG8_SB(1, 1), b3 + hstep, voffB); PG8_STAGE(PG8_SA(1, 0), a3, voffA);
            PG8_WAIT_V(8); PG8_WAIT_L(0); PG8_BAR; PG8_MMA(1, 0, At, B0); PG8_MMA(1, 1, At, B1); PG8_BAR; PG8_SCHED;
            } else {
            PG8_LDB(B0, 0, 0); PG8_SCHED; PG8_LDA(At, 0, 0); PG8_STAGE(PG8_SA(1, 1), a1 + hstep, voffA);
            PG8_WAIT_L(8); PG8_BAR; PG8_WAIT_L(0); PG8_MMA(0, 0, At, B0); PG8_BAR; PG8_SCHED;
            PG8_LDB(B1, 0, 1); PG8_STAGE(PG8_SB(0, 0), b2, voffB);
            PG8_BAR; PG8_WAIT_L(0); PG8_MMA(0, 1, At, B1); PG8_BAR;
            PG8_LDA(At, 0, 1); PG8_STAGE(PG8_SA(0, 0), a2, voffA);
            PG8_BAR; PG8_WAIT_L(0); PG8_MMA(1, 0, At, B0); PG8_BAR; PG8_SCHED;
            PG8_STAGE(PG8_SB(0, 1), b2 + hstep, voffB);
            PG8_WAIT_V(6); PG8_BAR; PG8_MMA(1, 1, At, B1); PG8_BAR;
            PG8_LDB(B0, 1, 0); PG8_SCHED; PG8_LDA(At, 1, 0); PG8_STAGE(PG8_SA(0, 1), a2 + hstep, voffA);
            PG8_WAIT_L(8); PG8_BAR; PG8_WAIT_L(0); PG8_MMA(0, 0, At, B0); PG8_BAR; PG8_SCHED;
            PG8_LDB(B1, 1, 1); PG8_STAGE(PG8_SB(1, 0), b3, voffB);
            PG8_BAR; PG8_WAIT_L(0); PG8_MMA(0, 1, At, B1); PG8_BAR;
            PG8_LDA(At, 1, 1); PG8_STAGE(PG8_SA(1, 0), a3, voffA);
            PG8_BAR; PG8_WAIT_L(0); PG8_MMA(1, 0, At, B0); PG8_BAR; PG8_SCHED;
            PG8_STAGE(PG8_SB(1, 1), b3 + hstep, voffB);
            PG8_WAIT_V(6); PG8_BAR; PG8_MMA(1, 1, At, B1); PG8_BAR;
            }
        }
        if constexpr (ALIGN_EPI) { if (wr == 0) PG8_BAR; }
        if constexpr (!Epi::AFTER_DRAIN) { E(acc, cur, wr, wc, fr, fq); S.done(cur); }
        if (!has_next) break;
#pragma unroll
        for (int a = 0; a < 2; ++a)
#pragma unroll
            for (int b = 0; b < 2; ++b)
#pragma unroll
                for (int m = 0; m < 4; ++m)
#pragma unroll
                    for (int n = 0; n < 2; ++n) acc[a][b][m][n] = (f32x4){0.f, 0.f, 0.f, 0.f};
        cur = nxt; cA = nA; cB = nB; ++ui;
        if constexpr (ALIGN_EPI) { if (wr == 1) PG8_BAR; }
    }
    PG8_WAIT_V(0);
    if constexpr (!ALIGN_EPI) { if (wr == 0) PG8_BAR; }
    PG8_BAR;
    if constexpr (Epi::AFTER_DRAIN) { E.fused(acc, cur, wr, wc, fr, fq, lds, wid, lane); S.done(cur); }
#undef PG8_SA
#undef PG8_SB
#undef PG8_STAGE
#undef PG8_LDA
#undef PG8_LDB
#undef PG8_MMA
#undef PG8_WAIT_V
#undef PG8_WAIT_L
#undef PG8_BAR
#undef PG8_SCHED
}
}


#define LAS __attribute__((address_space(3)))

__device__ __forceinline__ int op_bid() { int b = (int)blockIdx.x; asm volatile("" : "+s"(b)); return b; }
__device__ __forceinline__ int op_grid() { int g = (int)gridDim.x; asm volatile("" : "+s"(g)); return g; }
__device__ __forceinline__ int phase_tid(int wv) { unsigned m = ~0u; asm volatile("" : "+s"(m)); return wv * 64 + (int)__builtin_amdgcn_mbcnt_hi(m, __builtin_amdgcn_mbcnt_lo(m, 0u)); }
typedef unsigned short bf16_t;
typedef float f32x4 __attribute__((ext_vector_type(4)));
typedef unsigned u32x4 __attribute__((ext_vector_type(4)));
typedef unsigned u32x2 __attribute__((ext_vector_type(2)));

constexpr int BATCH = 8, SEQ = 4096, DM = 1024, T = BATCH * SEQ, DEPTH = 2;
constexpr int NPROJ = 4352, NMOD = 6 * DM;
constexpr int NEXP = 16384, PQ = 2048;
constexpr float NORM_EPS = 1e-6f;
constexpr float LOG2E = 1.4426950408889634f;
constexpr float QSCALE = 0.125f * LOG2E;
constexpr float SB_EXIT = 160.0f;

constexpr size_t MiB = 1u << 20;
constexpr size_t WS_CTL = 0;
constexpr size_t WS_MOD = 1 * MiB;
constexpr size_t WS_ROPE = 2 * MiB;
constexpr size_t WS_WIN = 10 * MiB;
constexpr size_t WS_WBA = 27 * MiB;
constexpr size_t WS_WBB = 29 * MiB;
constexpr size_t WS_WOUT = 31 * MiB;
constexpr size_t WS_WQ = 35 * MiB;
constexpr size_t WS_SK = 43 * MiB;
constexpr size_t WS_UQ = 44 * MiB;
constexpr size_t WS_VQ = 76 * MiB;
constexpr size_t WS_USC = 108 * MiB;
constexpr size_t WS_VSC = 108 * MiB + 256 * 1024;
constexpr size_t WS_HS = 109 * MiB;
constexpr size_t WS_H = 112 * MiB;
constexpr size_t WS_QA = 176 * MiB;
constexpr size_t WS_QB = 208 * MiB;
constexpr size_t WS_KB = 240 * MiB;
constexpr size_t WS_VB = 272 * MiB;
constexpr size_t WS_KA = 304 * MiB;
constexpr size_t WS_VA = 312 * MiB;
constexpr size_t WS_GA = 320 * MiB;
constexpr size_t WS_GB = 384 * MiB;
constexpr size_t WS_END = 448 * MiB;
constexpr size_t WS_H2Q = WS_QA, WS_IDX = WS_KB, WS_GATE = WS_VB, WS_Q2 = WS_GA, WS_COEF = WS_GA;
constexpr int CTL_BAR = 4096;
constexpr int CTL_ATTQ = 8192;
constexpr int CTL_QUEUE = 1024;

constexpr int LDS_BYTES = 147456;
constexpr int NTHREADS = 512, NWAVES = 8;

struct KArgs {
    const float* x; const float* c; const int* pos; const float* ada_w; const float* ada_b; const float* norm1_g; const float* w_in; const float* sinks;
    const float* wbr_a; const float* wbr_b; const float* w_out; const float* norm2_g; const float* wq; const float* subkeys; const float* pu; const float* pv; const float* final_g;
    float* out; unsigned char* ws; int ph_lo, ph_hi;
};

__device__ __forceinline__ unsigned f2bf(float f) { unsigned u = __float_as_uint(f); return (u + 0x7fffu + ((u >> 16) & 1u)) >> 16; }
__device__ __forceinline__ unsigned pk2(float lo, float hi) { return f2bf(lo) | (f2bf(hi) << 16); }
__device__ __forceinline__ float bflo(unsigned w) { return __uint_as_float(w << 16); }
__device__ __forceinline__ float bfhi(unsigned w) { return __uint_as_float(w & 0xffff0000u); }
template <int M> __device__ __forceinline__ float swz_xor(float v) { return __int_as_float(__builtin_amdgcn_ds_swizzle(__float_as_int(v), (M << 10) | 0x1f)); }
__device__ __forceinline__ float wave_sum(float v) {
    v += swz_xor<1>(v); v += swz_xor<2>(v); v += swz_xor<4>(v); v += swz_xor<8>(v); v += swz_xor<16>(v);
    auto rr = __builtin_amdgcn_permlane32_swap(__float_as_uint(v), __float_as_uint(v), false, false);
    return __uint_as_float(rr[0]) + __uint_as_float(rr[1]);
}
__device__ __forceinline__ float wave_max(float v) {
    v = fmaxf(v, swz_xor<1>(v)); v = fmaxf(v, swz_xor<2>(v)); v = fmaxf(v, swz_xor<4>(v)); v = fmaxf(v, swz_xor<8>(v)); v = fmaxf(v, swz_xor<16>(v));
    auto rr = __builtin_amdgcn_permlane32_swap(__float_as_uint(v), __float_as_uint(v), false, false);
    return fmaxf(__uint_as_float(rr[0]), __uint_as_float(rr[1]));
}
__device__ __forceinline__ int rdlane_i(int v, int l) { return __builtin_amdgcn_readlane(v, __builtin_amdgcn_readfirstlane(l)); }
__device__ __forceinline__ float rdlane_f(float v, int l) { return __int_as_float(__builtin_amdgcn_readlane(__float_as_int(v), __builtin_amdgcn_readfirstlane(l))); }
__device__ __forceinline__ float dot8(u32x4 a, u32x4 b, float acc) {
    acc = fmaf(bflo(a.x), bflo(b.x), acc); acc = fmaf(bfhi(a.x), bfhi(b.x), acc);
    acc = fmaf(bflo(a.y), bflo(b.y), acc); acc = fmaf(bfhi(a.y), bfhi(b.y), acc);
    acc = fmaf(bflo(a.z), bflo(b.z), acc); acc = fmaf(bfhi(a.z), bfhi(b.z), acc);
    acc = fmaf(bflo(a.w), bflo(b.w), acc); acc = fmaf(bfhi(a.w), bfhi(b.w), acc);
    return acc;
}
__device__ __forceinline__ float softplus2(float z2) {
    return fmaxf(z2, 0.f) + __log2f(1.0f + exp2f(-fabsf(z2)));
}

__device__ __forceinline__ int win_pos(int n) {
    if (n >= 640) return n;
    const int hb = n & ~63, d = n & 63;
    return hb + (d < 32 ? 2 * d : 2 * (d - 32) + 1);
}
template <bool WIN>
__device__ __forceinline__ void transpose_item(const float* W, int K, int N, bf16_t* WT, LAS float* scr, int item, int lane) {
    const int nblk = N / 32, kb = item / nblk, nb = item % nblk, k0 = 64 * kb, n0 = 32 * nb;
#pragma unroll 8
    for (int i = 0; i < 32; ++i) { const int kk = 2 * i + (lane >> 5); scr[kk * 33 + (lane & 31)] = W[(size_t)(k0 + kk) * N + n0 + (lane & 31)]; }
    asm volatile("s_waitcnt lgkmcnt(0)" ::: "memory");
    const int c = lane & 7;
#pragma unroll
    for (int j = 0; j < 4; ++j) { const int n = (lane >> 3) + 8 * j; const LAS float* s = scr + (8 * c) * 33 + n;
        u32x4 o; o.x = pk2(s[0 * 33], s[1 * 33]); o.y = pk2(s[2 * 33], s[3 * 33]); o.z = pk2(s[4 * 33], s[5 * 33]); o.w = pk2(s[6 * 33], s[7 * 33]);
        const int row = WIN ? win_pos(n0 + n) : (n0 + n);
        *(u32x4*)(WT + (size_t)row * K + k0 + 8 * c) = o; }
    asm volatile("s_waitcnt lgkmcnt(0)" ::: "memory");
}
template <bool OFFSET128>
__device__ __forceinline__ void quant_row(const f32x4 (&v)[4], unsigned char* dst_row, float* scale_out, int lane) {
    float am = 0.f;
#pragma unroll
    for (int i = 0; i < 4; ++i) am = fmaxf(am, fmaxf(fmaxf(fabsf(v[i].x), fabsf(v[i].y)), fmaxf(fabsf(v[i].z), fabsf(v[i].w))));
    am = wave_max(am);
    const float inv = am > 0.f ? 127.0f / am : 0.f, sc = am > 0.f ? am / 127.0f : 1.0f;
    u32x4 o;
#pragma unroll
    for (int i = 0; i < 4; ++i) {
        int q0 = (int)rintf(v[i].x * inv), q1 = (int)rintf(v[i].y * inv), q2 = (int)rintf(v[i].z * inv), q3 = (int)rintf(v[i].w * inv);
        if (OFFSET128) { q0 += 128; q1 += 128; q2 += 128; q3 += 128; }
        o[i] = (unsigned)(q0 & 0xff) | ((unsigned)(q1 & 0xff) << 8) | ((unsigned)(q2 & 0xff) << 16) | ((unsigned)(q3 & 0xff) << 24);
    }
    *(u32x4*)(dst_row + 16 * lane) = o;
    if (lane == 0) *scale_out = sc;
}

__device__ __forceinline__ void ph_prologue(const KArgs& a, LAS unsigned char* lds, int wv) {
    const int tid = phase_tid(wv), lane = tid & 63, wave = wv, G = op_grid();
    const int gw = op_bid() * NWAVES + wave, NGW = G * NWAVES;
    unsigned char* ws = a.ws;
    {
        LAS float* sc = (LAS float*)lds;
        LAS float* red = (LAS float*)(lds + 32768);
        for (int it = op_bid(); it < DEPTH * 96; it += G) {
            for (int idx = tid; idx < 8192; idx += NTHREADS) { const int b = idx >> 10, i = idx & 1023; const float cv = a.c[b * 1024 + i]; sc[i * 8 + b] = cv / (1.0f + __expf(-cv)); }
            __syncthreads();
            const int l = it / 96, j0 = (it % 96) * 64;
            const float* wp = a.ada_w + ((size_t)l * 1024 + wave * 128) * NMOD + j0 + lane;
            float acc[8];
#pragma unroll
            for (int b = 0; b < 8; ++b) acc[b] = 0.f;
#pragma unroll 8
            for (int i = 0; i < 128; ++i) {
                const float w = wp[(size_t)i * NMOD];
                const f32x4 s0 = *(const LAS f32x4*)(sc + (wave * 128 + i) * 8), s1 = *(const LAS f32x4*)(sc + (wave * 128 + i) * 8 + 4);
                acc[0] = fmaf(s0.x, w, acc[0]); acc[1] = fmaf(s0.y, w, acc[1]); acc[2] = fmaf(s0.z, w, acc[2]); acc[3] = fmaf(s0.w, w, acc[3]);
                acc[4] = fmaf(s1.x, w, acc[4]); acc[5] = fmaf(s1.y, w, acc[5]); acc[6] = fmaf(s1.z, w, acc[6]); acc[7] = fmaf(s1.w, w, acc[7]);
            }
#pragma unroll
            for (int b = 0; b < 8; ++b) red[(wave * 8 + b) * 64 + lane] = acc[b];
            __syncthreads();
            {
                float t = 0.f;
#pragma unroll
                for (int w = 0; w < 8; ++w) t += red[(w * 8 + wave) * 64 + lane];
                ((float*)(ws + WS_MOD))[(size_t)(l * 8 + wave) * NMOD + j0 + lane] = t + a.ada_b[l * NMOD + j0 + lane];
            }
            __syncthreads();
        }
    }
    {
        LAS float* scr = (LAS float*)(lds + 32768 + wave * 8448);
        constexpr int I_IN = 16 * 136, I_BR = 8 * 32, I_OUT = 16 * 32, I_Q = 16 * 64, I_L = I_IN + 2 * I_BR + I_OUT + I_Q;
        for (int it = gw; it < DEPTH * I_L; it += NGW) {
            const int l = it / I_L; int r = it % I_L;
            if (r < I_IN) { transpose_item<true>(a.w_in + (size_t)l * 1024 * NPROJ, 1024, NPROJ, (bf16_t*)(ws + WS_WIN) + (size_t)l * NPROJ * 1024, scr, r, lane); continue; } r -= I_IN;
            if (r < I_BR) { transpose_item<false>(a.wbr_a + (size_t)l * 512 * 1024, 512, 1024, (bf16_t*)(ws + WS_WBA) + (size_t)l * 1024 * 512, scr, r, lane); continue; } r -= I_BR;
            if (r < I_BR) { transpose_item<false>(a.wbr_b + (size_t)l * 512 * 1024, 512, 1024, (bf16_t*)(ws + WS_WBB) + (size_t)l * 1024 * 512, scr, r, lane); continue; } r -= I_BR;
            if (r < I_OUT) { transpose_item<false>(a.w_out + (size_t)l * 1024 * 1024, 1024, 1024, (bf16_t*)(ws + WS_WOUT) + (size_t)l * 1024 * 1024, scr, r, lane); continue; } r -= I_OUT;
            transpose_item<false>(a.wq + (size_t)l * 1024 * PQ, 1024, PQ, (bf16_t*)(ws + WS_WQ) + (size_t)l * PQ * 1024, scr, r, lane);
        }
    }
    {
        const int gt = op_bid() * NTHREADS + tid, NGT = G * NTHREADS;
        for (int i = gt; i < DEPTH * 8 * 2 * 128 * 128 / 8; i += NGT) {
            const f32x4 v0 = *(const f32x4*)(a.subkeys + (size_t)i * 8), v1 = *(const f32x4*)(a.subkeys + (size_t)i * 8 + 4);
            u32x4 o; o.x = pk2(v0.x, v0.y); o.y = pk2(v0.z, v0.w); o.z = pk2(v1.x, v1.y); o.w = pk2(v1.z, v1.w);
            *(u32x4*)((bf16_t*)(ws + WS_SK) + (size_t)i * 8) = o;
        }
        for (int i = gt; i < T * 32; i += NGT) {
            const int t = i >> 5, f = i & 31;
            double inv = 1.0;
            for (int k = 0; k < f; ++k) inv *= 0.7498942093324559;
            const double ang = (double)a.pos[t] * inv;
            const double kq = rint(ang * 0.63661977236758134308);
            const double r = fma(-kq, 6.123233995736766036e-17, fma(-kq, 1.57079632679489655800, ang));
            const int quad = (int)((long long)kq & 3);
            const double r2 = r * r;
            double sp = -1.0 / 1307674368000.0; sp = fma(sp, r2, 1.0 / 6227020800.0); sp = fma(sp, r2, -1.0 / 39916800.0); sp = fma(sp, r2, 1.0 / 362880.0);
            sp = fma(sp, r2, -1.0 / 5040.0); sp = fma(sp, r2, 1.0 / 120.0); sp = fma(sp, r2, -1.0 / 6.0); sp = fma(sp * r2, r, r);
            double cp = 1.0 / 20922789888000.0; cp = fma(cp, r2, -1.0 / 87178291200.0); cp = fma(cp, r2, 1.0 / 479001600.0); cp = fma(cp, r2, -1.0 / 3628800.0);
            cp = fma(cp, r2, 1.0 / 40320.0); cp = fma(cp, r2, -1.0 / 720.0); cp = fma(cp, r2, 1.0 / 24.0); cp = fma(cp, r2, -0.5); cp = fma(cp, r2, 1.0);
            const double sn = (quad == 0) ? sp : (quad == 1) ? cp : (quad == 2) ? -sp : -cp;
            const double cs = (quad == 0) ? cp : (quad == 1) ? -sp : (quad == 2) ? -cp : sp;
            float* rp = (float*)(ws + WS_ROPE) + (size_t)i * 2; rp[0] = (float)cs; rp[1] = (float)sn;
        }
    }
    for (int r = gw; r < DEPTH * 2 * NEXP; r += NGW) {
        const int tbl = r / (DEPTH * NEXP), lr = r % (DEPTH * NEXP);
        const float* src = (tbl == 0 ? a.pu : a.pv) + (size_t)lr * 1024;
        f32x4 v[4];
        if (tbl == 0) {
#pragma unroll
            for (int i = 0; i < 4; ++i) v[i] = ((const f32x4*)src)[64 * i + lane];
            quant_row<false>(v, ws + WS_UQ + (size_t)lr * 1024, (float*)(ws + WS_USC) + lr, lane);
        } else {
#pragma unroll
            for (int i = 0; i < 4; ++i) v[i] = ((const f32x4*)src)[4 * lane + i];
            const int l = lr / NEXP, e = lr % NEXP;
            quant_row<false>(v, ws + WS_VQ + (size_t)l * NEXP * 1024 + ((size_t)(lane >> 3) * NEXP + e) * 128 + 16 * (lane & 7) - 16 * lane, (float*)(ws + WS_VSC) + lr, lane);
        }
    }
    if (op_bid() == 0) for (int i = tid; i < DEPTH * 2 * 8 * 64; i += NTHREADS) ((unsigned*)(ws + WS_CTL))[CTL_QUEUE + i] = 0u;
}

template <bool WITH_Q8>
__device__ __forceinline__ void ph_norm(const KArgs& a, const float* xin, const float* g, const float* mod_l, int shift_idx, int scale_idx, int wv) {
    const int tid = phase_tid(wv), lane = tid & 63, wave = wv;
    const int gw = op_bid() * NWAVES + wave, NGW = op_grid() * NWAVES;
    bf16_t* H = (bf16_t*)(a.ws + WS_H);
    for (int row = gw; row < T; row += NGW) {
        const int b = row >> 12;
        f32x4 v[4]; float ss = 0.f;
#pragma unroll
        for (int i = 0; i < 4; ++i) { v[i] = ((const f32x4*)(xin + (size_t)row * DM))[64 * i + lane]; ss += (v[i].x * v[i].x + v[i].y * v[i].y) + (v[i].z * v[i].z + v[i].w * v[i].w); }
        ss = wave_sum(ss);
        const float r = 1.0f / sqrtf(ss * (1.0f / DM) + NORM_EPS);
#pragma unroll
        for (int i = 0; i < 4; ++i) {
            const int col = 256 * i + 4 * lane;
            const f32x4 gg = *(const f32x4*)(g + col), sc = *(const f32x4*)(mod_l + (size_t)b * NMOD + scale_idx * DM + col), sh = *(const f32x4*)(mod_l + (size_t)b * NMOD + shift_idx * DM + col);
            v[i] = (v[i] * r) * gg * (sc + 1.0f) + sh;
            u32x2 o; o.x = pk2(v[i].x, v[i].y); o.y = pk2(v[i].z, v[i].w);
            *(u32x2*)(H + (size_t)row * DM + col) = o;
        }
        if (WITH_Q8) quant_row<false>(v, a.ws + WS_H2Q + (size_t)row * 1024, (float*)(a.ws + WS_HS) + row, lane);
    }
}
__device__ __forceinline__ void ph_final_norm(const KArgs& a, int wv) {
    const int tid = phase_tid(wv), lane = tid & 63, wave = wv;
    const int gw = op_bid() * NWAVES + wave, NGW = op_grid() * NWAVES;
    for (int row = gw; row < T; row += NGW) {
        f32x4 v[4]; float ss = 0.f;
#pragma unroll
        for (int i = 0; i < 4; ++i) { v[i] = ((const f32x4*)(a.out + (size_t)row * DM))[64 * i + lane]; ss += (v[i].x * v[i].x + v[i].y * v[i].y) + (v[i].z * v[i].z + v[i].w * v[i].w); }
        ss = wave_sum(ss);
        const float r = 1.0f / sqrtf(ss * (1.0f / DM) + NORM_EPS);
#pragma unroll
        for (int i = 0; i < 4; ++i) { const f32x4 gg = *(const f32x4*)(a.final_g + 256 * i + 4 * lane); ((f32x4*)(a.out + (size_t)row * DM))[64 * i + lane] = (v[i] * r) * gg; }
    }
}

struct EpiProj {
    static constexpr bool PERM = true, AFTER_DRAIN = false;
    unsigned char* ws;
    __device__ __forceinline__ void operator()(const pg8::f32x4 (&acc)[2][2][4][2], const pg8::Unit& u, int wr, int wc, int fr, int fq) const {
        const int row0 = u.pm * 256 + wr * 64 + fr;
        const float* rope = (const float*)(ws + WS_ROPE);
#pragma unroll
        for (int bj = 0; bj < 2; ++bj) {
            const int cgb = u.pn * 256 + bj * 128;
            bf16_t* base; int pitch, cl, mode;
            if (cgb < 512) { base = (bf16_t*)(ws + WS_QA); pitch = 512; cl = cgb; mode = 1; }
            else if (cgb < 640) { base = (bf16_t*)(ws + WS_KA); pitch = 128; cl = cgb - 512; mode = 2; }
            else if (cgb < 768) { base = (bf16_t*)(ws + WS_VA); pitch = 128; cl = cgb - 640; mode = 0; }
            else if (cgb < 1280) { base = (bf16_t*)(ws + WS_QB); pitch = 512; cl = cgb - 768; mode = 3; }
            else if (cgb < 1792) { base = (bf16_t*)(ws + WS_KB); pitch = 512; cl = cgb - 1280; mode = 0; }
            else if (cgb < 2304) { base = (bf16_t*)(ws + WS_VB); pitch = 512; cl = cgb - 1792; mode = 0; }
            else if (cgb < 3328) { base = (bf16_t*)(ws + WS_GA); pitch = 1024; cl = cgb - 2304; mode = 4; }
            else { base = (bf16_t*)(ws + WS_GB); pitch = 1024; cl = cgb - 3328; mode = 4; }
            const int col = cl + wc * 32 + 8 * fq;
#pragma unroll
            for (int ai = 0; ai < 2; ++ai)
#pragma unroll
                for (int m = 0; m < 4; ++m) {
                    const int row = row0 + ai * 128 + m * 16;
                    pg8::f32x4 v0 = acc[ai][bj][m][0], v1 = acc[ai][bj][m][1];
                    if (mode == 1 || mode == 2) {
                        const int i0 = (col & 63) >> 1;
                        const f32x4 c01 = *(const f32x4*)(rope + ((size_t)row * 32 + i0) * 2), c23 = *(const f32x4*)(rope + ((size_t)row * 32 + i0 + 2) * 2);
                        pg8::f32x4 w0, w1;
                        w0[0] = v0[0] * c01.x - v0[1] * c01.y; w0[1] = v0[1] * c01.x + v0[0] * c01.y;
                        w0[2] = v0[2] * c01.z - v0[3] * c01.w; w0[3] = v0[3] * c01.z + v0[2] * c01.w;
                        w1[0] = v1[0] * c23.x - v1[1] * c23.y; w1[1] = v1[1] * c23.x + v1[0] * c23.y;
                        w1[2] = v1[2] * c23.z - v1[3] * c23.w; w1[3] = v1[3] * c23.z + v1[2] * c23.w;
                        v0 = w0; v1 = w1;
                    }
                    if (mode == 1 || mode == 3) { v0 = v0 * QSCALE; v1 = v1 * QSCALE; }
                    if (mode == 4) {
#pragma unroll
                        for (int e = 0; e < 4; ++e) { v0[e] = 1.0f / (1.0f + __expf(-v0[e])); v1[e] = 1.0f / (1.0f + __expf(-v1[e])); }
                    }
                    u32x4 w; w.x = pk2(v0[0], v0[1]); w.y = pk2(v0[2], v0[3]); w.z = pk2(v1[0], v1[1]); w.w = pk2(v1[2], v1[3]);
                    *(u32x4*)(base + (size_t)row * pitch + col) = w;
                }
        }
    }
};
template <bool ADD> struct EpiBranch {
    static constexpr bool PERM = true, AFTER_DRAIN = false;
    const bf16_t* Gt; bf16_t* O;
    __device__ __forceinline__ void operator()(const pg8::f32x4 (&acc)[2][2][4][2], const pg8::Unit& u, int wr, int wc, int fr, int fq) const {
        const int row0 = u.pm * 256 + wr * 64 + fr, col0 = u.pn * 256 + wc * 32 + 8 * fq;
#pragma unroll
        for (int ai = 0; ai < 2; ++ai)
#pragma unroll
            for (int m = 0; m < 4; ++m)
#pragma unroll
                for (int bj = 0; bj < 2; ++bj) {
                    const size_t off = (size_t)(row0 + ai * 128 + m * 16) * DM + col0 + bj * 128;
                    const u32x4 gv = *(const u32x4*)(Gt + off);
                    const pg8::f32x4 v0 = acc[ai][bj][m][0], v1 = acc[ai][bj][m][1];
                    float r[8];
                    r[0] = bflo(gv.x) * v0[0]; r[1] = bfhi(gv.x) * v0[1]; r[2] = bflo(gv.y) * v0[2]; r[3] = bfhi(gv.y) * v0[3];
                    r[4] = bflo(gv.z) * v1[0]; r[5] = bfhi(gv.z) * v1[1]; r[6] = bflo(gv.w) * v1[2]; r[7] = bfhi(gv.w) * v1[3];
                    if (ADD) { const u32x4 ov = *(const u32x4*)(O + off);
                        r[0] += bflo(ov.x); r[1] += bfhi(ov.x); r[2] += bflo(ov.y); r[3] += bfhi(ov.y); r[4] += bflo(ov.z); r[5] += bfhi(ov.z); r[6] += bflo(ov.w); r[7] += bfhi(ov.w); }
                    u32x4 w; w.x = pk2(r[0], r[1]); w.y = pk2(r[2], r[3]); w.z = pk2(r[4], r[5]); w.w = pk2(r[6], r[7]);
                    *(u32x4*)(O + off) = w;
                }
    }
};
struct EpiWout {
    static constexpr bool PERM = false, AFTER_DRAIN = false;
    const float* xold; float* xnew; const float* gate;
    __device__ __forceinline__ void operator()(const pg8::f32x4 (&acc)[2][2][4][2], const pg8::Unit& u, int wr, int wc, int fr, int fq) const {
        const int row0 = u.pm * 256 + wr * 64 + fr, col0 = u.pn * 256 + wc * 32 + 4 * fq, b = u.pm >> 4;
#pragma unroll
        for (int bj = 0; bj < 2; ++bj)
#pragma unroll
            for (int n = 0; n < 2; ++n) {
                const pg8::f32x4 gv = *(const pg8::f32x4*)(gate + (size_t)b * NMOD + col0 + bj * 128 + n * 16);
#pragma unroll
                for (int ai = 0; ai < 2; ++ai)
#pragma unroll
                    for (int m = 0; m < 4; ++m) { const size_t off = (size_t)(row0 + ai * 128 + m * 16) * DM + col0 + bj * 128 + n * 16;
                        const pg8::f32x4 xo = *(const pg8::f32x4*)(xold + off);
                        *(pg8::f32x4*)(xnew + off) = xo + gv * acc[ai][bj][m][n]; }
            }
    }
};
struct EpiPlainBf16 {
    static constexpr bool PERM = true, AFTER_DRAIN = false;
    bf16_t* O; int ldc;
    __device__ __forceinline__ void operator()(const pg8::f32x4 (&acc)[2][2][4][2], const pg8::Unit& u, int wr, int wc, int fr, int fq) const {
        const int row0 = u.pm * 256 + wr * 64 + fr, col0 = u.pn * 256 + wc * 32 + 8 * fq;
#pragma unroll
        for (int ai = 0; ai < 2; ++ai)
#pragma unroll
            for (int m = 0; m < 4; ++m)
#pragma unroll
                for (int bj = 0; bj < 2; ++bj) {
                    const pg8::f32x4 v0 = acc[ai][bj][m][0], v1 = acc[ai][bj][m][1];
                    u32x4 w; w.x = pk2(v0[0], v0[1]); w.y = pk2(v0[2], v0[3]); w.z = pk2(v1[0], v1[1]); w.w = pk2(v1[2], v1[3]);
                    *(u32x4*)(O + (size_t)(row0 + ai * 128 + m * 16) * ldc + col0 + bj * 128) = w;
                }
    }
};

namespace att {
typedef short bf16x8 __attribute__((ext_vector_type(8)));
typedef short s16x4 __attribute__((ext_vector_type(4)));
typedef float f32x16 __attribute__((ext_vector_type(16)));
__device__ __forceinline__ int crow(int r, int hi) { return (r & 3) + 8 * (r >> 2) + 4 * hi; }
typedef float f32x2_t __attribute__((ext_vector_type(2))); typedef __bf16 bf16x2_t __attribute__((ext_vector_type(2)));
__device__ __forceinline__ unsigned cvtpk(float lo, float hi) { f32x2_t v = {lo, hi}; bf16x2_t b = __builtin_convertvector(v, bf16x2_t); return __builtin_bit_cast(unsigned, b); }
#define ATT_SBAR() __builtin_amdgcn_sched_barrier(0)

__device__ __forceinline__ void qkt(f32x16& p0, f32x16& p1, const LAS unsigned char* kslot, const bf16x8 (&qr)[4], int r32, int hi) {
    const LAS unsigned char* kb = kslot + hi * 1024 + r32 * 16;
    p0 = f32x16{}; p1 = f32x16{};
#pragma unroll
    for (int d0 = 0; d0 < 4; ++d0) {
        const bf16x8 b0 = *(const LAS bf16x8*)(kb + d0 * 2048);
        const bf16x8 b1 = *(const LAS bf16x8*)(kb + d0 * 2048 + 512);
        p0 = __builtin_amdgcn_mfma_f32_32x32x16_bf16(b0, qr[d0], p0, 0, 0, 0);
        p1 = __builtin_amdgcn_mfma_f32_32x32x16_bf16(b1, qr[d0], p1, 0, 0, 0);
    }
}
__device__ __forceinline__ void pv(f32x16 (&o)[2], int vb, bf16x8 pa0, bf16x8 pa1, bf16x8 pa2, bf16x8 pa3) {
#pragma unroll
    for (int d0 = 0; d0 < 2; ++d0) {
        s16x4 lo[4], hh[4];
#pragma unroll
        for (int ks = 0; ks < 4; ++ks) {
            asm volatile("ds_read_b64_tr_b16 %0,%1 offset:%c2" : "=&v"(lo[ks]) : "v"(vb), "i"(d0 * 4096 + ks * 1024) : "memory");
            asm volatile("ds_read_b64_tr_b16 %0,%1 offset:%c2" : "=&v"(hh[ks]) : "v"(vb), "i"(d0 * 4096 + ks * 1024 + 512) : "memory");
        }
        asm volatile("s_waitcnt lgkmcnt(0)" ::: "memory"); ATT_SBAR();
#define ATT_PK(k) (bf16x8){lo[k][0], lo[k][1], lo[k][2], lo[k][3], hh[k][0], hh[k][1], hh[k][2], hh[k][3]}
        o[d0] = __builtin_amdgcn_mfma_f32_32x32x16_bf16(pa0, ATT_PK(0), o[d0], 0, 0, 0);
        o[d0] = __builtin_amdgcn_mfma_f32_32x32x16_bf16(pa1, ATT_PK(1), o[d0], 0, 0, 0);
        o[d0] = __builtin_amdgcn_mfma_f32_32x32x16_bf16(pa2, ATT_PK(2), o[d0], 0, 0, 0);
        o[d0] = __builtin_amdgcn_mfma_f32_32x32x16_bf16(pa3, ATT_PK(3), o[d0], 0, 0, 0);
#undef ATT_PK
    }
}
__device__ __forceinline__ void pack_p(const f32x16& p0, const f32x16& p1, bf16x8& pa0, bf16x8& pa1, bf16x8& pa2, bf16x8& pa3) {
    u32x4 w0, w1, w2, w3;
    w0 = (u32x4){cvtpk(p0[0], p0[1]), cvtpk(p0[2], p0[3]), cvtpk(p0[4], p0[5]), cvtpk(p0[6], p0[7])};
    w1 = (u32x4){cvtpk(p0[8], p0[9]), cvtpk(p0[10], p0[11]), cvtpk(p0[12], p0[13]), cvtpk(p0[14], p0[15])};
    w2 = (u32x4){cvtpk(p1[0], p1[1]), cvtpk(p1[2], p1[3]), cvtpk(p1[4], p1[5]), cvtpk(p1[6], p1[7])};
    w3 = (u32x4){cvtpk(p1[8], p1[9]), cvtpk(p1[10], p1[11]), cvtpk(p1[12], p1[13]), cvtpk(p1[14], p1[15])};
    pa0 = __builtin_bit_cast(bf16x8, w0); pa1 = __builtin_bit_cast(bf16x8, w1); pa2 = __builtin_bit_cast(bf16x8, w2); pa3 = __builtin_bit_cast(bf16x8, w3);
}
__device__ __forceinline__ u32x4 tile_gload(const bf16_t* src, int pitch, int tid) { return *(const u32x4*)(src + (size_t)(tid >> 3) * pitch + (tid & 7) * 8); }
__device__ __forceinline__ void tile_kwrite(LAS unsigned char* kslot, u32x4 v, int tid) { *(LAS u32x4*)(kslot + (tid & 7) * 1024 + (tid >> 3) * 16) = v; }
__device__ __forceinline__ void tile_vwrite(LAS unsigned char* vslot, u32x4 v, int tid) { const int c = tid & 7; *(LAS u32x4*)(vslot + (c >> 2) * 4096 + (tid >> 3) * 64 + (c & 3) * 16) = v; }
__device__ __forceinline__ void store_o(const f32x16 (&o)[2], const float (&rs)[16], LAS unsigned char* stage, bf16_t* Ow, int pitch, int lane) {
    asm volatile("" : "+v"(lane));
    const int r32 = lane & 31, hi = lane >> 5;
    LAS bf16_t* stg = (LAS bf16_t*)stage;
#pragma unroll
    for (int r = 0; r < 16; ++r) { const int orow = crow(r, hi);
#pragma unroll
        for (int d0 = 0; d0 < 2; ++d0) stg[orow * 64 + d0 * 32 + r32] = (bf16_t)f2bf(o[d0][r] * rs[r]); }
    asm volatile("s_waitcnt lgkmcnt(0)" ::: "memory");
#pragma unroll
    for (int i = 0; i < 4; ++i) { const int row = i * 8 + (lane >> 3), ch = lane & 7; const u32x4 v = *(const LAS u32x4*)(stg + row * 64 + ch * 8); *(u32x4*)(Ow + (size_t)row * pitch + ch * 8) = v; }
    asm volatile("s_waitcnt lgkmcnt(0)" ::: "memory");
}

constexpr int SB_WLDS = 8192;
template <bool EARLY_EXIT>
__device__ __forceinline__ void sb_unit(const bf16_t* Q, const bf16_t* K, const bf16_t* V, bf16_t* O, LAS unsigned char* vimg, int b, int h, int rb, int lane, int wv) {
    const int r32 = lane & 31, hi = lane >> 5;
    const int vb0 = (int)(unsigned)(uintptr_t)vimg + ((lane >> 4) & 1) * 32 + (lane & 3) * 8 + (4 * hi + ((lane & 15) >> 2)) * 64;
    const int vwoff = ((lane & 7) >> 2) * 4096 + (lane >> 3) * 64 + (lane & 3) * 16;
    const float m0 = hi == 0 ? 1.0f : 0.0f;
    {
        const int R0 = rb * 32;
        const size_t rowbase = (size_t)b * SEQ;
        const char* Kb = (const char*)(K + rowbase * 512 + h * 64); const char* Vb = (const char*)(V + rowbase * 512 + h * 64);
        const unsigned koff = (unsigned)(r32 * 1024 + hi * 16), voff = (unsigned)((lane >> 3) * 1024 + (lane & 7) * 16);
        const bf16_t* Qw = Q + (rowbase + R0) * 512 + h * 64;
        bf16x8 qr[4];
#pragma unroll
        for (int d0 = 0; d0 < 4; ++d0) qr[d0] = *(const bf16x8*)((const char*)Qw + koff + d0 * 32);
        int kt = R0 >> 6;
        bf16x8 kf[8]; u32x4 vr[8];
#define SB_LOADK(KT) do { const char* k0_ = Kb + (size_t)(KT) * 65536; const char* k1_ = k0_ + 32768; _Pragma("unroll") for (int d0 = 0; d0 < 4; ++d0) { kf[2 * d0] = *(const bf16x8*)(k0_ + koff + d0 * 32); kf[2 * d0 + 1] = *(const bf16x8*)(k1_ + koff + d0 * 32); } } while (0)
#define SB_LOADV(KT) do { const char* v0_ = Vb + (size_t)(KT) * 65536; _Pragma("unroll") for (int i = 0; i < 8; ++i) vr[i] = *(const u32x4*)(v0_ + i * 8192 + voff); } while (0)
        SB_LOADK(kt); SB_LOADV(kt);
        f32x16 o[2]; o[0] = f32x16{}; o[1] = f32x16{};
        float carry = 0.f;
        for (;;) {
            f32x16 p0 = f32x16{}, p1 = f32x16{};
#pragma unroll
            for (int d0 = 0; d0 < 4; ++d0) { p0 = __builtin_amdgcn_mfma_f32_32x32x16_bf16(kf[2 * d0], qr[d0], p0, 0, 0, 0); p1 = __builtin_amdgcn_mfma_f32_32x32x16_bf16(kf[2 * d0 + 1], qr[d0], p1, 0, 0, 0); }
            const bool more = kt > 0;
#pragma unroll
            for (int i = 0; i < 8; ++i) *(LAS u32x4*)(vimg + vwoff + i * 512) = vr[i];
            if (more) { SB_LOADK(kt - 1); SB_LOADV(kt - 1); }
            const int D = R0 - 64 * kt;
            if (D < 64) {
                const int thr = D + r32 - 4 * hi;
#pragma unroll
                for (int r = 0; r < 16; ++r) { const int cr = (r & 3) + 8 * (r >> 2); if (cr >= thr) p0[r] = -INFINITY; if (cr + 32 >= thr) p1[r] = -INFINITY; }
            }
            float tt[8], uu[8];
#define SB_SP(x) (fmaxf(x, 0.f) + __builtin_amdgcn_logf(1.0f + __builtin_amdgcn_exp2f(-fabsf(x))))
#pragma unroll
            for (int i = 0; i < 4; ++i) {
                float s3 = SB_SP(p0[4 * i + 3]), s2 = s3 + SB_SP(p0[4 * i + 2]), s1 = s2 + SB_SP(p0[4 * i + 1]), s0 = s1 + SB_SP(p0[4 * i]);
                p0[4 * i + 3] -= s3; p0[4 * i + 2] -= s2; p0[4 * i + 1] -= s1; p0[4 * i] -= s0; tt[i] = s0;
                s3 = SB_SP(p1[4 * i + 3]); s2 = s3 + SB_SP(p1[4 * i + 2]); s1 = s2 + SB_SP(p1[4 * i + 1]); s0 = s1 + SB_SP(p1[4 * i]);
                p1[4 * i + 3] -= s3; p1[4 * i + 2] -= s2; p1[4 * i + 1] -= s1; p1[4 * i] -= s0; tt[4 + i] = s0;
                __builtin_amdgcn_sched_barrier(0);
            }
#undef SB_SP
#pragma unroll
            for (int k = 0; k < 8; ++k) { auto rr = __builtin_amdgcn_permlane32_swap(__float_as_uint(tt[k]), __float_as_uint(tt[k]), false, false); uu[k] = __uint_as_float(hi ? rr[0] : rr[1]); }
            float sw = 0.f;
#pragma unroll
            for (int k = 7; k >= 0; --k) {
                const float bs = carry - (sw + m0 * uu[k]); sw += tt[k] + uu[k];
                if (k < 4) { p0[4 * k] = __builtin_amdgcn_exp2f(p0[4 * k] + bs); p0[4 * k + 1] = __builtin_amdgcn_exp2f(p0[4 * k + 1] + bs); p0[4 * k + 2] = __builtin_amdgcn_exp2f(p0[4 * k + 2] + bs); p0[4 * k + 3] = __builtin_amdgcn_exp2f(p0[4 * k + 3] + bs); }
                else { const int i = k - 4; p1[4 * i] = __builtin_amdgcn_exp2f(p1[4 * i] + bs); p1[4 * i + 1] = __builtin_amdgcn_exp2f(p1[4 * i + 1] + bs); p1[4 * i + 2] = __builtin_amdgcn_exp2f(p1[4 * i + 2] + bs); p1[4 * i + 3] = __builtin_amdgcn_exp2f(p1[4 * i + 3] + bs); }
            }
            carry -= sw;
            bf16x8 pa0, pa1, pa2, pa3; pack_p(p0, p1, pa0, pa1, pa2, pa3);
            pv(o, vb0, pa0, pa1, pa2, pa3);
            if (!more) break;
            if (EARLY_EXIT && __all(carry < -SB_EXIT)) break;
            --kt;
        }
        float ones[16];
#pragma unroll
        for (int r = 0; r < 16; ++r) ones[r] = 1.0f;
        store_o(o, ones, vimg, O + (rowbase + R0) * 512 + h * 64, 512, phase_tid(wv) & 63);
    }
#undef SB_LOADK
#undef SB_LOADV
}

__device__ __forceinline__ void swa_unit(const bf16_t* Q, const bf16_t* K, const bf16_t* V, bf16_t* O, const float* sinks, LAS unsigned char* vimg, int b, int hq, int rb, int lane, int wv) {
    const int r32 = lane & 31, hi = lane >> 5, kvh = hq >> 2;
    const int vb0 = (int)(unsigned)(uintptr_t)vimg + ((lane >> 4) & 1) * 32 + (lane & 3) * 8 + (4 * hi + ((lane & 15) >> 2)) * 64;
    const int vwoff = ((lane & 7) >> 2) * 4096 + (lane >> 3) * 64 + (lane & 3) * 16;
    {
        const int R0 = rb * 32, a = R0 >> 6;
        const size_t rowbase = (size_t)b * SEQ;
        const char* Kb = (const char*)(K + rowbase * 128 + kvh * 64); const char* Vb = (const char*)(V + rowbase * 128 + kvh * 64);
        const unsigned koff = (unsigned)(r32 * 256 + hi * 16), voff = (unsigned)((lane >> 3) * 256 + (lane & 7) * 16);
        const bf16_t* Qw = Q + (rowbase + R0) * 512 + hq * 64;
        bf16x8 qr[4];
#pragma unroll
        for (int d0 = 0; d0 < 4; ++d0) qr[d0] = *(const bf16x8*)((const char*)Qw + (unsigned)(r32 * 1024 + hi * 16) + d0 * 32);
        const float sink2 = sinks[hq] * LOG2E;
        bf16x8 kf[8];
#define SW_LOADK(KT) do { const char* k0_ = Kb + (size_t)(KT) * 16384; const char* k1_ = k0_ + 8192; _Pragma("unroll") for (int d0 = 0; d0 < 4; ++d0) { kf[2 * d0] = *(const bf16x8*)(k0_ + koff + d0 * 32); kf[2 * d0 + 1] = *(const bf16x8*)(k1_ + koff + d0 * 32); } } while (0)
#define SW_QKT(P0, P1) do { P0 = f32x16{}; P1 = f32x16{}; _Pragma("unroll") for (int d0 = 0; d0 < 4; ++d0) { P0 = __builtin_amdgcn_mfma_f32_32x32x16_bf16(kf[2 * d0], qr[d0], P0, 0, 0, 0); P1 = __builtin_amdgcn_mfma_f32_32x32x16_bf16(kf[2 * d0 + 1], qr[d0], P1, 0, 0, 0); } } while (0)
        const int kt_lo = a >= 2 ? a - 2 : 0;
        float m = sink2;
        SW_LOADK(kt_lo);
        for (int kt = kt_lo; kt <= a; ++kt) {
            f32x16 p0, p1; SW_QKT(p0, p1);
            if (kt < a) SW_LOADK(kt + 1);
            const int thr = R0 - 64 * kt + r32 - 4 * hi;
#pragma unroll
            for (int r = 0; r < 16; ++r) { const int cr = (r & 3) + 8 * (r >> 2);
                const bool v0 = cr <= thr && cr > thr - 128, v1 = cr + 32 <= thr && cr + 32 > thr - 128;
                m = fmaxf(m, fmaxf(v0 ? p0[r] : -INFINITY, v1 ? p1[r] : -INFINITY)); }
        }
        { auto rr = __builtin_amdgcn_permlane32_swap(__float_as_uint(m), __float_as_uint(m), false, false); m = fmaxf(__uint_as_float(rr[0]), __uint_as_float(rr[1])); }
        float lsum = 0.f;
        f32x16 o[2]; o[0] = f32x16{}; o[1] = f32x16{};
        SW_LOADK(kt_lo);
        for (int kt = kt_lo; kt <= a; ++kt) {
            u32x4 vr[8];
            { const char* v0_ = Vb + (size_t)kt * 16384;
#pragma unroll
              for (int i = 0; i < 8; ++i) vr[i] = *(const u32x4*)(v0_ + i * 2048 + voff); }
            f32x16 p0, p1; SW_QKT(p0, p1);
            if (kt < a) SW_LOADK(kt + 1);
            const int thr = R0 - 64 * kt + r32 - 4 * hi;
#pragma unroll
            for (int r = 0; r < 16; ++r) { const int cr = (r & 3) + 8 * (r >> 2);
                const bool v0 = cr <= thr && cr > thr - 128, v1 = cr + 32 <= thr && cr + 32 > thr - 128;
                p0[r] = v0 ? __builtin_amdgcn_exp2f(p0[r] - m) : 0.f; p1[r] = v1 ? __builtin_amdgcn_exp2f(p1[r] - m) : 0.f; lsum += p0[r] + p1[r]; }
#pragma unroll
            for (int i = 0; i < 8; ++i) *(LAS u32x4*)(vimg + vwoff + i * 512) = vr[i];
            bf16x8 pa0, pa1, pa2, pa3; pack_p(p0, p1, pa0, pa1, pa2, pa3); pv(o, vb0, pa0, pa1, pa2, pa3);
        }
#undef SW_LOADK
#undef SW_QKT
        { auto rr = __builtin_amdgcn_permlane32_swap(__float_as_uint(lsum), __float_as_uint(lsum), false, false); lsum = __uint_as_float(rr[0]) + __uint_as_float(rr[1]); }
        lsum += __builtin_amdgcn_exp2f(sink2 - m);
        LAS float* wsf = (LAS float*)vimg;
        asm volatile("s_waitcnt lgkmcnt(0)" ::: "memory");
        if (hi == 0) wsf[r32] = 1.0f / lsum;
        asm volatile("s_waitcnt lgkmcnt(0)" ::: "memory");
        float rs[16];
#pragma unroll
        for (int r = 0; r < 16; ++r) rs[r] = wsf[crow(r, hi)];
        asm volatile("s_waitcnt lgkmcnt(0)" ::: "memory");
        store_o(o, rs, vimg, O + (rowbase + R0) * 512 + hq * 64, 512, phase_tid(wv) & 63);
    }
}
template <bool EARLY_EXIT>
__device__ __forceinline__ void attn_phase(const unsigned char* ws, const float* sinks, unsigned* cnt, LAS unsigned char* lds, int wv) {
    const int tid = phase_tid(wv), lane = tid & 63, wid = wv;
    LAS unsigned char* vimg = lds + wid * SB_WLDS;
    const unsigned home = (unsigned)op_bid() & 7u;
    unsigned ss = 0, x = home;
    unsigned nxt = 0u; if (lane == 0) nxt = __hip_atomic_fetch_add(cnt + 64 * x, 1u, __ATOMIC_RELAXED, __HIP_MEMORY_SCOPE_AGENT);
    for (;;) {
        const unsigned cur = (unsigned)__builtin_amdgcn_readfirstlane((int)nxt);
        if (cur >= 2048u) { if (++ss == 8u) break; x = (home + ss) & 7u; nxt = 0u; if (lane == 0) nxt = __hip_atomic_fetch_add(cnt + 64 * x, 1u, __ATOMIC_RELAXED, __HIP_MEMORY_SCOPE_AGENT); continue; }
        nxt = 0u; if (lane == 0) nxt = __hip_atomic_fetch_add(cnt + 64 * x, 1u, __ATOMIC_RELAXED, __HIP_MEMORY_SCOPE_AGENT);
        const int b = (int)(cur >> 7) & 7, rb = (int)(cur & 127u);
        if (cur < 1024u) sb_unit<EARLY_EXIT>((const bf16_t*)(ws + WS_QB), (const bf16_t*)(ws + WS_KB), (const bf16_t*)(ws + WS_VB), (bf16_t*)(ws + WS_QB), vimg, b, (int)x, rb, lane, wv);
        else swa_unit((const bf16_t*)(ws + WS_QA), (const bf16_t*)(ws + WS_KA), (const bf16_t*)(ws + WS_VA), (bf16_t*)(ws + WS_QA), sinks, vimg, b, (int)x, rb, lane, wv);
    }
}
}

namespace tk {
typedef short bf16x8 __attribute__((ext_vector_type(8)));
typedef float f32x16 __attribute__((ext_vector_type(16)));
__device__ __forceinline__ float vmax(float a, float b) { float r; asm("v_max_f32 %0, %1, %2" : "=v"(r) : "v"(a), "v"(b)); return r; }
__device__ __forceinline__ float vmin(float a, float b) { float r; asm("v_min_f32 %0, %1, %2" : "=v"(r) : "v"(a), "v"(b)); return r; }
#define TK_CE(a, b) { const float t_ = vmax(a, b); b = vmin(a, b); a = t_; }
__device__ __forceinline__ void sort16(float (&v)[16]) {
    TK_CE(v[0], v[1]) TK_CE(v[2], v[3]) TK_CE(v[0], v[2]) TK_CE(v[1], v[3]) TK_CE(v[1], v[2]) TK_CE(v[4], v[5]) TK_CE(v[6], v[7]) TK_CE(v[4], v[6])
    TK_CE(v[5], v[7]) TK_CE(v[5], v[6]) TK_CE(v[0], v[4]) TK_CE(v[2], v[6]) TK_CE(v[2], v[4]) TK_CE(v[1], v[5]) TK_CE(v[3], v[7]) TK_CE(v[3], v[5])
    TK_CE(v[1], v[2]) TK_CE(v[3], v[4]) TK_CE(v[5], v[6]) TK_CE(v[8], v[9]) TK_CE(v[10], v[11]) TK_CE(v[8], v[10]) TK_CE(v[9], v[11]) TK_CE(v[9], v[10])
    TK_CE(v[12], v[13]) TK_CE(v[14], v[15]) TK_CE(v[12], v[14]) TK_CE(v[13], v[15]) TK_CE(v[13], v[14]) TK_CE(v[8], v[12]) TK_CE(v[10], v[14]) TK_CE(v[10], v[12])
    TK_CE(v[9], v[13]) TK_CE(v[11], v[15]) TK_CE(v[11], v[13]) TK_CE(v[9], v[10]) TK_CE(v[11], v[12]) TK_CE(v[13], v[14]) TK_CE(v[0], v[8]) TK_CE(v[4], v[12])
    TK_CE(v[4], v[8]) TK_CE(v[2], v[10]) TK_CE(v[6], v[14]) TK_CE(v[6], v[10]) TK_CE(v[2], v[4]) TK_CE(v[6], v[8]) TK_CE(v[10], v[12]) TK_CE(v[1], v[9])
    TK_CE(v[5], v[13]) TK_CE(v[5], v[9]) TK_CE(v[3], v[11]) TK_CE(v[7], v[15]) TK_CE(v[7], v[11]) TK_CE(v[3], v[5]) TK_CE(v[7], v[9]) TK_CE(v[11], v[13])
    TK_CE(v[1], v[2]) TK_CE(v[3], v[4]) TK_CE(v[5], v[6]) TK_CE(v[7], v[8]) TK_CE(v[9], v[10]) TK_CE(v[11], v[12]) TK_CE(v[13], v[14])
}
__device__ __forceinline__ void bmerge16(float (&v)[16]) {
    TK_CE(v[0], v[8]) TK_CE(v[1], v[9]) TK_CE(v[2], v[10]) TK_CE(v[3], v[11]) TK_CE(v[4], v[12]) TK_CE(v[5], v[13]) TK_CE(v[6], v[14]) TK_CE(v[7], v[15])
    TK_CE(v[0], v[4]) TK_CE(v[1], v[5]) TK_CE(v[2], v[6]) TK_CE(v[3], v[7]) TK_CE(v[8], v[12]) TK_CE(v[9], v[13]) TK_CE(v[10], v[14]) TK_CE(v[11], v[15])
    TK_CE(v[0], v[2]) TK_CE(v[1], v[3]) TK_CE(v[4], v[6]) TK_CE(v[5], v[7]) TK_CE(v[8], v[10]) TK_CE(v[9], v[11]) TK_CE(v[12], v[14]) TK_CE(v[13], v[15])
    TK_CE(v[0], v[1]) TK_CE(v[2], v[3]) TK_CE(v[4], v[5]) TK_CE(v[6], v[7]) TK_CE(v[8], v[9]) TK_CE(v[10], v[11]) TK_CE(v[12], v[13]) TK_CE(v[14], v[15])
}

__device__ __forceinline__ void merge_top16(float (&a)[16], const float (&b)[16]) {
#pragma unroll
    for (int i = 0; i < 16; ++i) a[i] = vmax(a[i], b[15 - i]);
    bmerge16(a);
}
__device__ __forceinline__ float partner_f(float v, int hi) { auto rr = __builtin_amdgcn_permlane32_swap(__float_as_uint(v), __float_as_uint(v), false, false); return __uint_as_float(hi ? rr[0] : rr[1]); }
__device__ __forceinline__ void merge_partner(float (&a)[16], int hi) {
    float pp[16];
#pragma unroll
    for (int i = 0; i < 16; ++i) pp[i] = partner_f(a[i], hi);
    merge_top16(a, pp);
}
__device__ __forceinline__ void take_block(float (&v)[16], const f32x16& acc, int blk, unsigned hi4) {
#pragma unroll
    for (int r = 0; r < 16; ++r) { const unsigned code = 127u - (unsigned)(32 * blk + (r & 3) + 8 * (r >> 2)); v[r] = __uint_as_float(((__float_as_uint(acc[r]) & 0xFFFFFF80u) | code) ^ hi4); }
    sort16(v);
}
constexpr int TK_SK = 0, TK_IDX = 65536, TK_LDS_END = 65536 + 8192;
constexpr float TK_NEG = -3.4028234663852886e38f;
template <int P>
__device__ __forceinline__ void half_top16(float (&L)[16], const bf16_t* qrow, LAS unsigned char* lds, LAS unsigned char* idxslot, int r32, int hi) {
    bf16x8 qf[8];
#pragma unroll
    for (int ks = 0; ks < 8; ++ks) qf[ks] = *(const bf16x8*)(qrow + P * 128 + 16 * ks + 8 * hi);
    f32x16 acc[4];
#pragma unroll
    for (int blk = 0; blk < 4; ++blk) acc[blk] = f32x16{};
    const LAS unsigned char* ab = lds + TK_SK + P * 32768 + hi * 2048 + r32 * 16;
#pragma unroll
    for (int ks = 0; ks < 8; ++ks)
#pragma unroll
        for (int blk = 0; blk < 4; ++blk) {
            const bf16x8 af = *(const LAS bf16x8*)(ab + ks * 4096 + blk * 512);
            acc[blk] = __builtin_amdgcn_mfma_f32_32x32x16_bf16(af, qf[ks], acc[blk], 0, 0, 0);
        }
    const unsigned hi4 = (unsigned)hi << 2;
    float M[16];
    take_block(L, acc[0], 0, hi4); take_block(M, acc[1], 1, hi4); merge_top16(L, M);
    { float N[16]; take_block(M, acc[2], 2, hi4); take_block(N, acc[3], 3, hi4); merge_top16(M, N); }
    merge_top16(L, M);
    merge_partner(L, hi);
    if (hi == 0) {
        u32x4 w;
#pragma unroll
        for (int q = 0; q < 4; ++q) w[q] = (__float_as_uint(L[4 * q]) & 127u) | ((__float_as_uint(L[4 * q + 1]) & 127u) << 8) | ((__float_as_uint(L[4 * q + 2]) & 127u) << 16) | ((__float_as_uint(L[4 * q + 3]) & 127u) << 24);
        *(LAS u32x4*)(idxslot + P * 16) = w;
    }
}
__device__ __forceinline__ float cand(float x, float y, unsigned code, unsigned hi8) { return __uint_as_float((__float_as_uint(x + y) & 0xFFFFFE00u) | code | hi8); }

__device__ __forceinline__ void topk_phase(const bf16_t* Q2, const bf16_t* SKl, int* IDX, float* GATE, LAS unsigned char* lds, int wv) {
        const int tid = phase_tid(wv), lane = tid & 63, r32 = lane & 31, hi = lane >> 5, wid = wv;
    LAS unsigned char* idxslot = lds + TK_IDX + wid * 1024 + r32 * 32;
    int cur_h = -1;
    for (int unit = op_bid(); unit < 8 * (T / 256); unit += op_grid()) {
        const int h = unit & 7, tb = unit >> 3;
        if (h != cur_h) {
            __syncthreads();
#pragma unroll
            for (int i = 0; i < 8; ++i) { const int id = tid + 512 * i, c = id & 15, n = (id >> 4) & 127, p = id >> 11;
                const u32x4 v = *(const u32x4*)(SKl + ((size_t)(h * 2 + p) * 128 + n) * 128 + c * 8);
                *(LAS u32x4*)(lds + TK_SK + p * 32768 + c * 2048 + n * 16) = v; }
            __syncthreads();
            cur_h = h;
        }
        const size_t token = (size_t)tb * 256 + wid * 32 + r32;
        const bf16_t* qrow = Q2 + token * PQ + h * 256;
        float a[16], b[16];
        half_top16<0>(a, qrow, lds, idxslot, r32, hi);
        half_top16<1>(b, qrow, lds, idxslot, r32, hi);
        float x[16], y[16];
#pragma unroll
        for (int i = 0; i < 16; ++i) { float av = a[i], bv = b[i]; asm volatile("" : "+v"(av), "+v"(bv)); x[i] = hi ? bv : av; y[i] = hi ? av : bv; }
        const unsigned hi8 = (unsigned)hi << 8;
        float A[16], B[16];
#pragma unroll
        for (int j = 1; j < 16; ++j) A[j - 1] = cand(x[0], y[j], (unsigned)j, hi8);
        A[15] = TK_NEG;
#pragma unroll
        for (int j = 2; j < 8; ++j) B[j - 2] = cand(x[1], y[j], (unsigned)(16 + j), hi8);
        B[6] = cand(x[2], y[3], 2u * 16u + 3u, hi8); B[7] = cand(x[2], y[4], 2u * 16u + 4u, hi8);
#pragma unroll
        for (int i = 0; i < 4; ++i) { const float d = cand(x[i], y[i], (unsigned)(17 * i), hi8); B[8 + i] = hi ? TK_NEG : d; }
        B[12] = TK_NEG; B[13] = TK_NEG; B[14] = TK_NEG; B[15] = TK_NEG;
        sort16(B);
        merge_top16(A, B);
        merge_partner(A, hi);
        const float smax = A[0];
        float ex[8]; int eidx[8]; float lsum = 0.f;
        asm volatile("s_waitcnt lgkmcnt(0)" ::: "memory");
#pragma unroll
        for (int k = 0; k < 8; ++k) {
            float s_lo = A[k], s_hi = A[8 + k]; asm volatile("" : "+v"(s_lo), "+v"(s_hi)); const float s = hi ? s_hi : s_lo;
            ex[k] = __expf(s - smax); lsum += ex[k];
            const unsigned code = __float_as_uint(s) & 0x1FFu, src = code >> 8, ci = (code >> 4) & 15u, cj = code & 15u;
            const unsigned ai = src ? cj : ci, bi = src ? ci : cj;
            const unsigned ca = idxslot[ai], cb = idxslot[16 + bi];
            eidx[k] = (int)(((ca ^ 127u) << 7) | (cb ^ 127u));
        }
        const float tot = lsum + partner_f(lsum, hi);
        const float inv = 1.0f / tot;
        int* ip = IDX + token * 128 + h * 16 + 8 * hi; float* gp = GATE + token * 128 + h * 16 + 8 * hi;
        *(u32x4*)ip = (u32x4){(unsigned)eidx[0], (unsigned)eidx[1], (unsigned)eidx[2], (unsigned)eidx[3]};
        *(u32x4*)(ip + 4) = (u32x4){(unsigned)eidx[4], (unsigned)eidx[5], (unsigned)eidx[6], (unsigned)eidx[7]};
        *(f32x4*)gp = (f32x4){ex[0] * inv, ex[1] * inv, ex[2] * inv, ex[3] * inv};
        *(f32x4*)(gp + 4) = (f32x4){ex[4] * inv, ex[5] * inv, ex[6] * inv, ex[7] * inv};
        asm volatile("s_waitcnt lgkmcnt(0)" ::: "memory");
    }
}
}

namespace peer3 {
__device__ __forceinline__ unsigned xcc_id() { return (unsigned)__builtin_amdgcn_s_getreg((3 << 11) | 20) & 7u; }
constexpr int UNIT = 16, NUNIT = T / UNIT;
template <int CTRL> __device__ __forceinline__ int dpp_i(int v) { return __builtin_amdgcn_update_dpp(0, v, CTRL, 0xF, 0xF, true); }
__device__ __forceinline__ int rowsum16(int v) { v += dpp_i<0xB1>(v); v += dpp_i<0x4E>(v); v += dpp_i<0x141>(v); v += dpp_i<0x140>(v); return v; }
__device__ __forceinline__ float gelu_as(float v) {
    const float av = fabsf(v), t = __builtin_amdgcn_rcpf(fmaf(av, 0.2316418882f, 1.0f));
    float q = fmaf(t, 0.5307027145f, -0.7265760135f); q = fmaf(q, t, 0.7107068705f); q = fmaf(q, t, -0.142248368f); q = fmaf(q, t, 0.127414796f); q = q * t;
    const float e = __builtin_amdgcn_exp2f(v * v * -0.72134752044f), m = v * (q * e);
    return v < 0.f ? m : v - m;
}
__device__ __forceinline__ unsigned take_async(unsigned* p, int lane) { unsigned v = 0u; if (lane == 0) v = __hip_atomic_fetch_add(p, 1u, __ATOMIC_RELAXED, __HIP_MEMORY_SCOPE_AGENT); return v; }

constexpr int UST = 6;
__device__ __forceinline__ void u_unit(const KArgs& a, int l, unsigned s, unsigned unit, LAS unsigned char* wlds, int lane) {
    const unsigned char* UQ = a.ws + WS_UQ + (size_t)l * NEXP * 1024;
    const float* USC = (const float*)(a.ws + WS_USC) + l * NEXP; const float* VSC = (const float*)(a.ws + WS_VSC) + l * NEXP;
    const int* IDX = (const int*)(a.ws + WS_IDX); const float* GATE = (const float*)(a.ws + WS_GATE);
    const unsigned char* HQ = a.ws + WS_H2Q; const float* HS = (const float*)(a.ws + WS_HS);
    float* COEF = (float*)(a.ws + WS_COEF);
    LAS int* lst = (LAS int*)wlds; LAS float* res = (LAS float*)(wlds + 512);
    const int q = lane >> 4, r = lane & 15;
    const size_t t0 = (size_t)unit * UNIT;
    int idx0 = IDX[t0 * 128 + lane], idx1 = IDX[t0 * 128 + 64 + lane];
    float g0 = GATE[t0 * 128 + lane], g1 = GATE[t0 * 128 + 64 + lane], sh = HS[t0];
    u32x4 hv[4];
#pragma unroll
    for (int k = 0; k < 4; ++k) hv[k] = *(const u32x4*)(HQ + t0 * 1024 + 256 * k + 16 * r);
#pragma unroll 1
    for (int i = 0; i < UNIT; ++i) {
        const size_t t = t0 + i, tn = t0 + (i + 1 < UNIT ? i + 1 : i);
        const bool in0 = (unsigned)(idx0 >> 11) == s, in1 = (unsigned)(idx1 >> 11) == s;
        float us0 = 0.f, us1 = 0.f, vs0 = 0.f, vs1 = 0.f;
        if (in0) { us0 = USC[idx0]; vs0 = VSC[idx0]; }
        if (in1) { us1 = USC[idx1]; vs1 = VSC[idx1]; }
        const int nidx0 = IDX[tn * 128 + lane], nidx1 = IDX[tn * 128 + 64 + lane];
        const float ng0 = GATE[tn * 128 + lane], ng1 = GATE[tn * 128 + 64 + lane], nsh = HS[tn];
        const unsigned long long m0 = __ballot(in0), m1 = __ballot(in1);
        const int c0 = __builtin_popcountll(m0), n = c0 + __builtin_popcountll(m1);
        const int rank0 = (int)__builtin_amdgcn_mbcnt_hi((unsigned)(m0 >> 32), __builtin_amdgcn_mbcnt_lo((unsigned)m0, 0u));
        const int rank1 = c0 + (int)__builtin_amdgcn_mbcnt_hi((unsigned)(m1 >> 32), __builtin_amdgcn_mbcnt_lo((unsigned)m1, 0u));
        if (in0) lst[rank0] = idx0;
        if (in1) lst[rank1] = idx1;
#pragma unroll 1
        for (int base = 0; base < n; base += 4 * UST) {
            const int nst = (n - base + 3) >> 2;
            u32x4 uv[UST][4];
#pragma unroll
            for (int st = 0; st < UST; ++st) {
                if (st < nst) {
                    int slot = base + 4 * st + q; slot = slot < n ? slot : n - 1;
                    const unsigned char* rp = UQ + (size_t)lst[slot] * 1024 + 16 * r;
#pragma unroll
                    for (int k = 0; k < 4; ++k) uv[st][k] = *(const u32x4*)(rp + 256 * k);
                }
            }
#pragma unroll
            for (int st = 0; st < UST; ++st) {
                if (st < nst) {
                    int s0_ = 0, s1_ = 0, s2_ = 0, s3_ = 0;
#pragma unroll
                    for (int k = 0; k < 4; ++k) {
                        s0_ = __builtin_amdgcn_sdot4((int)uv[st][k].x, (int)hv[k].x, s0_, false); s1_ = __builtin_amdgcn_sdot4((int)uv[st][k].y, (int)hv[k].y, s1_, false);
                        s2_ = __builtin_amdgcn_sdot4((int)uv[st][k].z, (int)hv[k].z, s2_, false); s3_ = __builtin_amdgcn_sdot4((int)uv[st][k].w, (int)hv[k].w, s3_, false);
                    }
                    const int tot = rowsum16((s0_ + s1_) + (s2_ + s3_));
                    if (r == 0) res[base + 4 * st + q] = (float)tot;
                }
            }
        }
        const float d0 = in0 ? res[rank0] : 0.f, d1 = in1 ? res[rank1] : 0.f;
        u32x4 nhv[4];
#pragma unroll
        for (int k = 0; k < 4; ++k) nhv[k] = *(const u32x4*)(HQ + tn * 1024 + 256 * k + 16 * r);
        if (in0) COEF[t * 128 + lane] = gelu_as(d0 * us0 * sh) * g0 * vs0;
        if (in1) COEF[t * 128 + 64 + lane] = gelu_as(d1 * us1 * sh) * g1 * vs1;
        idx0 = nidx0; idx1 = nidx1; g0 = ng0; g1 = ng1; sh = nsh;
#pragma unroll
        for (int k = 0; k < 4; ++k) hv[k] = nhv[k];
    }
}
struct VMeta { u32x4 iv[4]; f32x4 cv[4]; };
__device__ __forceinline__ void v_meta(VMeta& m, const int* IDX, const float* COEF, size_t t, int g) {
#pragma unroll
    for (int q = 0; q < 4; ++q) { m.iv[q] = *(const u32x4*)(IDX + t * 128 + 16 * g + 4 * q); m.cv[q] = *(const f32x4*)(COEF + t * 128 + 16 * g + 4 * q); }
}
__device__ __forceinline__ void v_stage(u32x4 (&P)[16], u32x4& CQ, float& cs, const VMeta& m, const unsigned char* VS) {
    float cm = 0.f;
#pragma unroll
    for (int j = 0; j < 16; ++j) cm = fmaxf(cm, fabsf(m.cv[j >> 2][j & 3]));
    cm = fmaxf(cm, swz_xor<8>(cm)); cm = fmaxf(cm, swz_xor<16>(cm));
    { auto rr = __builtin_amdgcn_permlane32_swap(__float_as_uint(cm), __float_as_uint(cm), false, false); cm = fmaxf(__uint_as_float(rr[0]), __uint_as_float(rr[1])); }
    const float inv = cm > 0.f ? 127.0f / cm : 0.f; cs = cm * (1.0f / 127.0f);
#pragma unroll
    for (int qd = 0; qd < 4; ++qd) {
        const int c0 = (int)rintf(m.cv[qd][0] * inv), c1 = (int)rintf(m.cv[qd][1] * inv), c2 = (int)rintf(m.cv[qd][2] * inv), c3 = (int)rintf(m.cv[qd][3] * inv);
        CQ[qd] = (unsigned)(c0 & 0xff) | ((unsigned)(c1 & 0xff) << 8) | ((unsigned)(c2 & 0xff) << 16) | ((unsigned)(c3 & 0xff) << 24);
    }
#pragma unroll
    for (int j = 0; j < 16; ++j) P[j] = *(const u32x4*)(VS + (size_t)m.iv[j >> 2][j & 3] * 128);
}
__device__ __forceinline__ void v_compute(const u32x4 (&P)[16], const u32x4& CQ, float cs, float* xout, const float* mod_l, size_t t, unsigned s, int lane) {
    const int g = lane >> 3, p = lane & 7; const bool b4 = (lane >> 4) & 1, b3 = (lane >> 3) & 1;
    typedef float f32x2 __attribute__((ext_vector_type(2)));
    const int col = (int)s * 128 + 16 * p + 2 * g, b = (int)(t >> 12);
    float* xp = xout + t * DM + col;
    f32x2 xv = *(const f32x2*)xp;
    const f32x2 gt = *(const f32x2*)(mod_l + (size_t)b * NMOD + 5 * DM + col);
    int acc[16];
#pragma unroll
    for (int k = 0; k < 16; ++k) acc[k] = 0;
#pragma unroll
    for (int qd = 0; qd < 4; ++qd)
#pragma unroll
        for (int w = 0; w < 4; ++w) {
            const unsigned A = P[4 * qd][w], B = P[4 * qd + 1][w], C = P[4 * qd + 2][w], D = P[4 * qd + 3][w];
            const unsigned X = __builtin_amdgcn_perm(B, A, 0x05010400u), Y = __builtin_amdgcn_perm(B, A, 0x07030602u);
            const unsigned Z = __builtin_amdgcn_perm(D, C, 0x05010400u), W = __builtin_amdgcn_perm(D, C, 0x07030602u);
            const unsigned T0 = __builtin_amdgcn_perm(Z, X, 0x05040100u), T1 = __builtin_amdgcn_perm(Z, X, 0x07060302u);
            const unsigned T2 = __builtin_amdgcn_perm(W, Y, 0x05040100u), T3 = __builtin_amdgcn_perm(W, Y, 0x07060302u);
            acc[4 * w + 0] = __builtin_amdgcn_sdot4((int)T0, (int)CQ[qd], acc[4 * w + 0], false); acc[4 * w + 1] = __builtin_amdgcn_sdot4((int)T1, (int)CQ[qd], acc[4 * w + 1], false);
            acc[4 * w + 2] = __builtin_amdgcn_sdot4((int)T2, (int)CQ[qd], acc[4 * w + 2], false); acc[4 * w + 3] = __builtin_amdgcn_sdot4((int)T3, (int)CQ[qd], acc[4 * w + 3], false);
        }
    int r8[8], r4[4], r2[2];
#pragma unroll
    for (int q = 0; q < 8; ++q) { auto rr = __builtin_amdgcn_permlane32_swap((unsigned)acc[q], (unsigned)acc[8 + q], false, false); r8[q] = (int)rr[0] + (int)rr[1]; }
#pragma unroll
    for (int q = 0; q < 4; ++q) { int lo = r8[q], hi = r8[4 + q]; asm volatile("" : "+v"(lo), "+v"(hi)); const int keep = b4 ? hi : lo, send = b4 ? lo : hi; r4[q] = keep + __builtin_amdgcn_ds_swizzle(send, (16 << 10) | 0x1f); }
#pragma unroll
    for (int q = 0; q < 2; ++q) { int lo = r4[q], hi = r4[2 + q]; asm volatile("" : "+v"(lo), "+v"(hi)); const int keep = b3 ? hi : lo, send = b3 ? lo : hi; r2[q] = keep + __builtin_amdgcn_ds_swizzle(send, (8 << 10) | 0x1f); }
    xv.x += gt.x * ((float)r2[0] * cs); xv.y += gt.y * ((float)r2[1] * cs);
    *(f32x2*)xp = xv;
}
__device__ __forceinline__ void v_unit(const KArgs& a, int l, const float* mod_l, unsigned s, unsigned unit, int lane) {
    const int g = lane >> 3, p = lane & 7;
    const unsigned char* VS = a.ws + WS_VQ + (size_t)l * NEXP * 1024 + (size_t)s * NEXP * 128 + 16 * p;
    const int* IDX = (const int*)(a.ws + WS_IDX); const float* COEF = (const float*)(a.ws + WS_COEF);
    const size_t t0 = (size_t)unit * UNIT;
    VMeta m; v_meta(m, IDX, COEF, t0, g);
    u32x4 PA[16], PB[16], CQA, CQB; float csA, csB;
    v_stage(PA, CQA, csA, m, VS);
    v_meta(m, IDX, COEF, t0 + 1, g);
#pragma unroll 1
    for (int i = 0; i < UNIT; i += 2) {
        v_stage(PB, CQB, csB, m, VS);
        v_meta(m, IDX, COEF, t0 + (i + 2 < UNIT ? i + 2 : i), g);
        v_compute(PA, CQA, csA, a.out, mod_l, t0 + i, s, lane);
        if (i + 2 < UNIT) { v_stage(PA, CQA, csA, m, VS); v_meta(m, IDX, COEF, t0 + (i + 3 < UNIT ? i + 3 : i), g); }
        v_compute(PB, CQB, csB, a.out, mod_l, t0 + i + 1, s, lane);
    }
}
template <bool VSTEP>
__device__ __forceinline__ void peer_phase(const KArgs& a, int l, const float* mod_l, unsigned* cnt, LAS unsigned char* lds, int wv) {
        const int tid = phase_tid(wv), lane = tid & 63, wid = wv;
    LAS unsigned char* wlds = lds + wid * 1024;
    const unsigned home = xcc_id();
    unsigned ss = 0, s = home;
    unsigned nxt = take_async(cnt + 64 * s, lane);
    for (;;) {
        const unsigned cur = (unsigned)__builtin_amdgcn_readfirstlane((int)nxt);
        if (cur >= (unsigned)NUNIT) { if (++ss == 8u) break; s = (home + ss) & 7u; nxt = take_async(cnt + 64 * s, lane); continue; }
        nxt = take_async(cnt + 64 * s, lane);
        if (VSTEP) v_unit(a, l, mod_l, s, cur, lane); else u_unit(a, l, s, cur, wlds, lane);
    }
}
}

constexpr int PH_PER_LAYER = 10, NPHASES = 1 + DEPTH * PH_PER_LAYER + 1;
#ifndef PHASE_MASK
#define PHASE_MASK 0xFFFF
#endif
#define HASP(k) (((PHASE_MASK) >> (k)) & 1)
#ifndef SB_EARLY_EXIT
#define SB_EARLY_EXIT 1
#endif

#define GAS __attribute__((address_space(1)))
#define RLX_AGENT __ATOMIC_RELAXED, __HIP_MEMORY_SCOPE_AGENT
#define XB_TMO      128
#define XB_XCNT(j)  (256  + 64 * (j))
#define XB_XSUB(j)  (1280 + 64 * (j))
#define XB_XGEN(j)  (2304 + 64 * (j))
#define XB_TOP      3328
#define XB_TOPGEN   3392
#define XCD_BAR_WORDS 3456
#define XB_SPIN_CAP (1u << 18)

__device__ __forceinline__ unsigned xb_ld(unsigned* p)              { return __hip_atomic_load(p, __ATOMIC_RELAXED, __HIP_MEMORY_SCOPE_AGENT); }
__device__ __forceinline__ unsigned xb_add(unsigned* p, unsigned v) { return __hip_atomic_fetch_add(p, v, __ATOMIC_RELAXED, __HIP_MEMORY_SCOPE_AGENT); }
__device__ __forceinline__ unsigned xb_xcc_id() { return (unsigned)__builtin_amdgcn_s_getreg((3 << 11) | 20) & 0xFu; }
#define XB_SPIN(cond, bar) do { unsigned _sp = 0; while (cond) { __builtin_amdgcn_s_sleep(1); \
    if ((++_sp & 255u) == 0u) { if (xb_ld(&(bar)[XB_TMO])) break; if (_sp > XB_SPIN_CAP) { atomicAdd(&(bar)[XB_TMO], 1u); break; } } } } while (0)

struct XcdBarrier {
    unsigned* bar; unsigned x;
    volatile LAS unsigned* st;
};

__device__ __forceinline__ XcdBarrier xcd_barrier_post(unsigned* bar, volatile LAS unsigned* st, bool tid0) {
    XcdBarrier b; b.bar = bar; b.x = xb_xcc_id(); b.st = st;
    if (tid0) (void)xb_add(&bar[XB_XCNT(b.x)], 1u);
    return b;
}
__device__ __forceinline__ void xcd_barrier_complete(unsigned* bar, unsigned x, unsigned& nloc, unsigned& nx) {
    const unsigned G = gridDim.x * gridDim.y * gridDim.z;
    unsigned sum, cnt, mine, sp = 0u;
    for (;;) {
        sum = 0u; cnt = 0u; mine = 0u;
#pragma unroll
        for (unsigned j = 0; j < 16; ++j) { const unsigned c = xb_ld(&bar[XB_XCNT(j)]); sum += c; cnt += (c > 0u) ? 1u : 0u; mine = (j == x) ? c : mine; }
        if (sum == G) break;
        __builtin_amdgcn_s_sleep(1);
        if ((++sp & 255u) == 0u) { if (xb_ld(&bar[XB_TMO])) break; if (sp > XB_SPIN_CAP) { atomicAdd(&bar[XB_TMO], 1u); break; } }
    }
    nloc = mine > 0u ? mine : 1u; nx = cnt > 0u ? cnt : 1u;
}

__device__ __forceinline__ void xcd_barrier(const XcdBarrier& b, bool tid0) {
    asm volatile("s_waitcnt vmcnt(0)" ::: "memory");
    __syncthreads();
    if (tid0) {
        unsigned* bar = b.bar;
        __builtin_amdgcn_s_waitcnt(0);
        unsigned nloc = b.st[0], nx = b.st[1];
        if (nloc == 0u) { xcd_barrier_complete(bar, b.x, nloc, nx); b.st[0] = nloc; b.st[1] = nx; }
        const unsigned old = xb_add(&bar[XB_XSUB(b.x)], 1u);
        const unsigned gen = old / nloc;
        if (old + 1u == (gen + 1u) * nloc) {
            __builtin_amdgcn_fence(__ATOMIC_RELEASE, "agent");
            asm volatile("s_waitcnt vmcnt(0)" ::: "memory");
            const unsigned og = xb_add(&bar[XB_TOP], 1u);
            const unsigned tg = og / nx;
            if (og + 1u == (tg + 1u) * nx) xb_add(&bar[XB_TOPGEN], 1u);
            else XB_SPIN(xb_ld(&bar[XB_TOPGEN]) == tg, bar);
            __builtin_amdgcn_fence(__ATOMIC_ACQUIRE, "agent");
            xb_add(&bar[XB_XGEN(b.x)], 1u);
            asm volatile("s_waitcnt vmcnt(0)" ::: "memory");
        } else {
            XB_SPIN(xb_ld(&bar[XB_XGEN(b.x)]) == gen, bar);
            __builtin_amdgcn_fence(__ATOMIC_ACQUIRE, "agent");
            asm volatile("s_waitcnt vmcnt(0)" ::: "memory");
        }
    }
    __syncthreads();
}

typedef const __attribute__((address_space(4))) KArgs* KArgsP;
__device__ __forceinline__ KArgsP kargs() { KArgsP p = (KArgsP)__builtin_amdgcn_kernarg_segment_ptr(); asm volatile("" : "+s"(p)); return p; }

__device__ __forceinline__ void load_args(KArgs& a) {
#if defined(__HIP_DEVICE_COMPILE__)
    KArgsP p = kargs();
    a.x = p->x; a.c = p->c; a.pos = p->pos; a.ada_w = p->ada_w; a.ada_b = p->ada_b; a.norm1_g = p->norm1_g; a.w_in = p->w_in; a.sinks = p->sinks; a.wbr_a = p->wbr_a; a.wbr_b = p->wbr_b;
    a.w_out = p->w_out; a.norm2_g = p->norm2_g; a.wq = p->wq; a.subkeys = p->subkeys; a.pu = p->pu; a.pv = p->pv; a.final_g = p->final_g; a.out = p->out; a.ws = p->ws; a.ph_lo = p->ph_lo; a.ph_hi = p->ph_hi;
#endif
}
__global__ void __launch_bounds__(NTHREADS, 2) fwd_kernel(KArgs a_unused) {
    extern __shared__ __attribute__((aligned(16))) unsigned char lds_raw[];
    LAS unsigned char* lds = (LAS unsigned char*)lds_raw;
    cg::grid_group grid = cg::this_grid();
    const int ph_lo = kargs()->ph_lo, ph_hi = kargs()->ph_hi;
    const int wv = __builtin_amdgcn_readfirstlane((int)threadIdx.x >> 6);
#define IN(k) (ph_lo <= (k) && (k) < ph_hi)
    volatile LAS unsigned* xb_st = (volatile LAS unsigned*)(lds + LDS_BYTES - 64);
    { const bool t0_ = phase_tid(wv) == 0; if (t0_) { xb_st[0] = 0u; xb_st[1] = 0u; } __syncthreads();
      (void)xcd_barrier_post((unsigned*)(kargs()->ws + WS_CTL) + CTL_BAR, xb_st, t0_); }
#define GRID_BAR() do { XcdBarrier b_; b_.bar = (unsigned*)(kargs()->ws + WS_CTL) + CTL_BAR; b_.x = xb_xcc_id(); b_.st = xb_st; xcd_barrier(b_, phase_tid(wv) == 0); } while (0)
#ifdef PROBE_PH
    volatile LAS unsigned long long* pr_mem = (volatile LAS unsigned long long*)(lds + LDS_BYTES - 32);
    if (blockIdx.x == 0 && threadIdx.x == 0) { pr_mem[0] = __builtin_amdgcn_s_memrealtime(); pr_mem[1] = 0; }
#define PROBE_MATCH(k) ((PROBE_PH) >= 100 ? ((k) >= 1 && (k) < NPHASES - 1 && (((k) - 1) % PH_PER_LAYER) == (PROBE_PH) - 100) : (k) == (PROBE_PH))
#define PROBE_STAMP(k) do { if (blockIdx.x == 0 && threadIdx.x == 0) { const unsigned long long now_ = __builtin_amdgcn_s_memrealtime(); if (PROBE_MATCH(k)) pr_mem[1] = pr_mem[1] + (now_ - pr_mem[0]); pr_mem[0] = now_; } } while (0)
#define SEAM(k) do { if (IN(k) && IN((k) + 1)) { if ((k) == 0) grid.sync(); else GRID_BAR(); } PROBE_STAMP(k); } while (0)
#else
#define SEAM(k) do { if (IN(k) && IN((k) + 1)) { if ((k) == 0) grid.sync(); else GRID_BAR(); } } while (0)
#endif
#define LOADARGS KArgs a; load_args(a); unsigned char* ws = a.ws; const int G = op_grid(); (void)G; (void)ws
#define LAYERARGS const float* mod_l = (const float*)(ws + WS_MOD) + (size_t)l * 8 * NMOD; const float* xcur = (l == 0) ? a.x : a.out; (void)mod_l; (void)xcur
    if (IN(0)) { if (HASP(0)) { LOADARGS; ph_prologue(a, lds, wv); } }
    SEAM(0);
#pragma unroll 1
    for (int l = 0; l < DEPTH; ++l) {
        const int p0 = 1 + l * PH_PER_LAYER;
        if (IN(p0 + 0)) { if (HASP(1)) { LOADARGS; LAYERARGS; ph_norm<false>(a, xcur, a.norm1_g + l * DM, mod_l, 0, 1, wv); } }
        SEAM(p0 + 0);
        if (IN(p0 + 1)) { if (HASP(2)) { LOADARGS; pg8::Gemm g{(const bf16_t*)(ws + WS_H), (const bf16_t*)(ws + WS_WIN) + (size_t)l * NPROJ * 1024, T, NPROJ, 1024};
                  pg8::StaticOrder S; S.init(T, NPROJ, G, op_bid()); EpiProj E{ws};
                  pg8::gemm_phase<EpiProj, pg8::StaticOrder, true, true>(lds, g, S, E, wv); } }
        SEAM(p0 + 1);
        if (IN(p0 + 2)) { if (HASP(3)) { LOADARGS;
                  att::attn_phase<SB_EARLY_EXIT != 0>(ws, a.sinks + l * 8, (unsigned*)(ws + WS_CTL) + CTL_ATTQ + l * 8 * 64, lds, wv); } }
        SEAM(p0 + 2);
        if (IN(p0 + 3)) { if (HASP(4)) { LOADARGS; pg8::StaticOrder S; S.init(T, DM, G, op_bid());
                  { pg8::Gemm g{(const bf16_t*)(ws + WS_QA), (const bf16_t*)(ws + WS_WBA) + (size_t)l * 1024 * 512, T, DM, 512};
                    EpiBranch<false> E{(const bf16_t*)(ws + WS_GA), (bf16_t*)(ws + WS_H)};
                    pg8::gemm_phase<EpiBranch<false>, pg8::StaticOrder, true, true>(lds, g, S, E, wv); }
                  __syncthreads();
                  { pg8::Gemm g{(const bf16_t*)(ws + WS_QB), (const bf16_t*)(ws + WS_WBB) + (size_t)l * 1024 * 512, T, DM, 512};
                    EpiBranch<true> E{(const bf16_t*)(ws + WS_GB), (bf16_t*)(ws + WS_H)};
                    pg8::gemm_phase<EpiBranch<true>, pg8::StaticOrder, true, true>(lds, g, S, E, wv); } } }
        SEAM(p0 + 3);
        if (IN(p0 + 4)) { if (HASP(5)) { LOADARGS; LAYERARGS; pg8::Gemm g{(const bf16_t*)(ws + WS_H), (const bf16_t*)(ws + WS_WOUT) + (size_t)l * 1024 * 1024, T, DM, 1024};
                  pg8::StaticOrder S; S.init(T, DM, G, op_bid()); EpiWout E{xcur, a.out, mod_l + 2 * DM};
                  pg8::gemm_phase<EpiWout, pg8::StaticOrder, true, true>(lds, g, S, E, wv); } }
        SEAM(p0 + 4);
        if (IN(p0 + 5)) { if (HASP(6)) { LOADARGS; LAYERARGS; ph_norm<true>(a, a.out, a.norm2_g + l * DM, mod_l, 3, 4, wv); } }
        SEAM(p0 + 5);
        if (IN(p0 + 6)) { if (HASP(7)) { LOADARGS; pg8::Gemm g{(const bf16_t*)(ws + WS_H), (const bf16_t*)(ws + WS_WQ) + (size_t)l * PQ * 1024, T, PQ, 1024};
                  pg8::StaticOrder S; S.init(T, PQ, G, op_bid()); EpiPlainBf16 E{(bf16_t*)(ws + WS_Q2), PQ};
                  pg8::gemm_phase<EpiPlainBf16, pg8::StaticOrder, true, true>(lds, g, S, E, wv); } }
        SEAM(p0 + 6);
        if (IN(p0 + 7)) { if (HASP(8)) { LOADARGS; tk::topk_phase((const bf16_t*)(ws + WS_Q2), (const bf16_t*)(ws + WS_SK) + (size_t)l * 8 * 2 * 128 * 128, (int*)(ws + WS_IDX), (float*)(ws + WS_GATE), lds, wv); } }
        SEAM(p0 + 7);
        if (IN(p0 + 8)) { if (HASP(9)) { LOADARGS; peer3::peer_phase<false>(a, l, nullptr, (unsigned*)(ws + WS_CTL) + CTL_QUEUE + (l * 2 + 0) * 8 * 64, lds, wv); } }
        SEAM(p0 + 8);
        if (IN(p0 + 9)) { if (HASP(10)) { LOADARGS; LAYERARGS; peer3::peer_phase<true>(a, l, mod_l, (unsigned*)(ws + WS_CTL) + CTL_QUEUE + (l * 2 + 1) * 8 * 64, lds, wv); } }
        SEAM(p0 + 9);
    }
    if (IN(NPHASES - 1)) { if (HASP(11)) { LOADARGS; ph_final_norm(a, wv); } }
#ifdef PROBE_PH
    PROBE_STAMP(NPHASES - 1);
    if (blockIdx.x == 0 && threadIdx.x == 0) { const unsigned long long t0_ = __builtin_amdgcn_s_memrealtime(), dl_ = pr_mem[1] * (PROBE_K); while (__builtin_amdgcn_s_memrealtime() - t0_ < dl_) __builtin_amdgcn_s_sleep(16); }
#endif
#undef IN
#undef SEAM
}

#ifndef N_LAUNCH_SPLIT
#define N_LAUNCH_SPLIT 1
#endif
extern "C" void kernel_launch(void* const* d_in, const int* in_sizes, int n_in, void* d_out, int out_size, void* d_ws, size_t ws_size, hipStream_t stream) {
    static int grid = 0;
    if (grid == 0) {
        if (n_in != 17 || out_size != T * DM || ws_size < WS_END) { fprintf(stderr, "kernel_launch: unexpected problem (n_in %d out %d ws %zu)\n", n_in, out_size, ws_size); grid = -1; return; }
        int dev = 0, cus = 0, per_cu = 0;
        (void)hipGetDevice(&dev);
        (void)hipDeviceGetAttribute(&cus, hipDeviceAttributeMultiprocessorCount, dev);
        (void)hipFuncSetAttribute((const void*)fwd_kernel, hipFuncAttributeMaxDynamicSharedMemorySize, LDS_BYTES);
        (void)hipOccupancyMaxActiveBlocksPerMultiprocessor(&per_cu, (const void*)fwd_kernel, NTHREADS, LDS_BYTES);
        if (per_cu < 1) { fprintf(stderr, "kernel_launch: occupancy query says %d\n", per_cu); per_cu = 1; }
        grid = cus;
        fprintf(stderr, "kernel_launch: cus %d per_cu %d grid %d ws %zu\n", cus, per_cu, grid, ws_size);
    }
    if (grid < 0) return;
    if (hipMemsetAsync((char*)d_ws + WS_CTL, 0, 65536, stream) != hipSuccess) { fprintf(stderr, "kernel_launch: hipMemsetAsync of the control words failed\n"); return; }
    KArgs a{};
    a.x = (const float*)d_in[0]; a.c = (const float*)d_in[1]; a.pos = (const int*)d_in[2]; a.ada_w = (const float*)d_in[3]; a.ada_b = (const float*)d_in[4];
    a.norm1_g = (const float*)d_in[5]; a.w_in = (const float*)d_in[6]; a.sinks = (const float*)d_in[7]; a.wbr_a = (const float*)d_in[8]; a.wbr_b = (const float*)d_in[9];
    a.w_out = (const float*)d_in[10]; a.norm2_g = (const float*)d_in[11]; a.wq = (const float*)d_in[12]; a.subkeys = (const float*)d_in[13]; a.pu = (const float*)d_in[14];
    a.pv = (const float*)d_in[15]; a.final_g = (const float*)d_in[16]; a.out = (float*)d_out; a.ws = (unsigned char*)d_ws;
#if N_LAUNCH_SPLIT
    a.ph_lo = 0; a.ph_hi = NPHASES;
    { void* args[] = {&a};
      hipError_t e = hipLaunchCooperativeKernel((void*)fwd_kernel, dim3(grid), dim3(NTHREADS), args, LDS_BYTES, stream);
      if (e != hipSuccess) fprintf(stderr, "cooperative launch failed: %s (grid %d)\n", hipGetErrorString(e), grid); }
#else
    for (int ph = 0; ph < NPHASES; ++ph) {
        a.ph_lo = ph; a.ph_hi = ph + 1;
        void* args[] = {&a};
        hipError_t e = hipLaunchCooperativeKernel((void*)fwd_kernel, dim3(grid), dim3(NTHREADS), args, LDS_BYTES, stream);
        if (e != hipSuccess) { fprintf(stderr, "cooperative launch %d failed: %s (grid %d)\n", ph, hipGetErrorString(e), grid); break; }
    }
#endif
}
```

```cpp
#include <hip/hip_runtime.h>
#include <hip/hip_cooperative_groups.h>
#include <cstdio>
#include <cstdint>
namespace cg = cooperative_groups;

#ifdef SUBPROBE
#define SP_MEM ((volatile __attribute__((address_space(3))) unsigned long long*)((__attribute__((address_space(3))) unsigned char*)0 + 147456 - 32))
#define SUBPROBE_T(id) do { __builtin_amdgcn_sched_barrier(0); if (blockIdx.x == SUBPROBE_BLK && threadIdx.x == 0) { const unsigned long long now_ = __builtin_amdgcn_s_memtime(); if ((id) == SUBPROBE) SP_MEM[1] = SP_MEM[1] + (now_ - SP_MEM[0]); SP_MEM[0] = now_; } __builtin_amdgcn_sched_barrier(0); } while (0)
#else
#define SUBPROBE_T(id) do {} while (0)
#endif
namespace pg8 {
#define PG8_LAS __attribute__((address_space(3)))
typedef unsigned short bf16_t;
typedef short bf16x8 __attribute__((ext_vector_type(8)));
typedef float f32x4 __attribute__((ext_vector_type(4)));
typedef unsigned u32x4 __attribute__((ext_vector_type(4)));
constexpr int BM = 256, BK = 64, HALF = 128, HTB = HALF * BK * 2  , STAGE_BYTES = 8 * HTB, NXCD = 8, WGM = 8;

__host__ __device__ __forceinline__ int lds_byte(int r, int c) { const int st = (r >> 4) * 2 + (c >> 5), rr = r & 15, cc = c & 31, ob = rr * 64 + cc * 2; return st * 1024 + (ob ^ (((ob >> 9) & 1) << 5)); }
__host__ __device__ __forceinline__ void stage_rc(int b, int& R, int& C) { const int st = b / 1024, sb = b % 1024, swz = sb ^ (((sb >> 9) & 1) << 5); R = (st >> 1) * 16 + swz / 64; C = (st & 1) * 32 + (swz % 64) / 2; }
__host__ __device__ __forceinline__ int perm32(int rho) { const int n = rho >> 4, i = rho & 15; return 8 * (i >> 2) + 4 * n + (i & 3); }

struct Unit { int pm, pn; };
struct Gemm { const bf16_t* A; const bf16_t* Bt; int M, N, K; };

struct StaticOrder {
    int nM, nN, nwg, G, c;
    __host__ __device__ void init(int M, int N, int G_, int c_) { nM = M / BM; nN = N / BM; nwg = nM * nN; G = G_; c = c_; }
    __host__ __device__ bool next(int i, Unit& u) const {
        const long L = (long)i * G + c; if (L >= nwg) return false;
        int wgid = (int)L; { const int q = nwg / NXCD, r = nwg % NXCD, xcd = wgid % NXCD, off = wgid / NXCD; wgid = (xcd < r ? xcd * (q + 1) : r * (q + 1) + (xcd - r) * q) + off; }
        const int nig = WGM * nN, gid = wgid / nig, fm = gid * WGM, gsz = (nM - fm) < WGM ? (nM - fm) : WGM;
        u.pm = fm + ((wgid % nig) % gsz); u.pn = (wgid % nig) / gsz; return true;
    }
    __device__ __forceinline__ void a_ready(const Unit&) const {}
    __device__ __forceinline__ void done(const Unit&) const {}
};


__device__ __forceinline__ unsigned cvt_pk_bf16(float lo, float hi) { unsigned r; asm volatile("v_cvt_pk_bf16_f32 %0, %1, %2" : "=v"(r) : "v"(lo), "v"(hi)); return r; }
template <class Epi, class Sched, bool ALIGN_EPI = false, bool SP2 = false>
__device__ __forceinline__ void gemm_phase(PG8_LAS unsigned char* lds, const Gemm g, const Sched& S, const Epi& E, int wv) {
    unsigned m_op = ~0u; asm volatile("" : "+s"(m_op));
    const int tid = wv * 64 + (int)__builtin_amdgcn_mbcnt_hi(m_op, __builtin_amdgcn_mbcnt_lo(m_op, 0u)), wid = wv, lane = tid & 63, wr = wid >> 2, wc = wid & 3, fr = lane & 15, fq = lane >> 4;
    const int K = g.K, nt = K / BK;
    unsigned voffA[2], voffB[2];
#pragma unroll
    for (int i = 0; i < 2; ++i) { int R, C; stage_rc(tid * 16 + i * 8192, R, C); const int Rb = Epi::PERM ? ((R & ~31) + perm32(R & 31)) : R;
        voffA[i] = (unsigned)(R * K + C) * 2u; voffB[i] = (unsigned)(Rb * K + C) * 2u; }
    const size_t kstep = (size_t)(BK * 2);
    const size_t hstep = (size_t)HALF * K * 2;
    const size_t tstep = 2 * hstep;
    const unsigned ldsw = (unsigned)wid * 1024u;
    const int aoff = lds_byte(wr * 64 + fr, fq * 8), boff = lds_byte(wc * 32 + fr, fq * 8);
#define PG8_SA(b, h) (((b) * 2 + (h)) * HTB)
#define PG8_SB(b, h) ((4 + (b) * 2 + (h)) * HTB)
#define PG8_STAGE(bufoff, gbase, voff) do { _Pragma("unroll") for (int _i = 0; _i < 2; ++_i) \
        __builtin_amdgcn_global_load_lds((const unsigned*)((const char*)(gbase) + (voff)[_i]), (PG8_LAS unsigned*)(lds + (bufoff) + ldsw + _i * 8192), 16, 0, 0); } while (0)
#define PG8_LDA(dst, b, h) do { _Pragma("unroll") for (int m = 0; m < 4; ++m) _Pragma("unroll") for (int k = 0; k < 2; ++k) dst[m][k] = *(const PG8_LAS bf16x8*)(lds + PG8_SA(b, h) + aoff + m * 2048 + k * 1024); } while (0)
#define PG8_LDB(dst, b, h) do { _Pragma("unroll") for (int n = 0; n < 2; ++n) _Pragma("unroll") for (int k = 0; k < 2; ++k) dst[n][k] = *(const PG8_LAS bf16x8*)(lds + PG8_SB(b, h) + boff + n * 2048 + k * 1024); } while (0)
#define PG8_MMA(ai, bj, At, Bt) do { __builtin_amdgcn_s_setprio(1); _Pragma("unroll") for (int m = 0; m < 4; ++m) _Pragma("unroll") for (int n = 0; n < 2; ++n) _Pragma("unroll") for (int k = 0; k < 2; ++k) \
        acc[ai][bj][m][n] = __builtin_amdgcn_mfma_f32_16x16x32_bf16(Bt[n][k], At[m][k], acc[ai][bj][m][n], 0, 0, 0); __builtin_amdgcn_s_setprio(0); } while (0)
#define PG8_WAIT_V(n) asm volatile("s_waitcnt vmcnt(" #n ")" ::: "memory")
#define PG8_WAIT_L(n) asm volatile("s_waitcnt lgkmcnt(" #n ")" ::: "memory")
#define PG8_BAR __builtin_amdgcn_s_barrier()
#define PG8_SCHED __builtin_amdgcn_sched_barrier(0)
    Unit cur, nxt; int ui = 0;
    if (!S.next(0, cur)) return;
    f32x4 acc[2][2][4][2];
#pragma unroll
    for (int a = 0; a < 2; ++a)
#pragma unroll
        for (int b = 0; b < 2; ++b)
#pragma unroll
            for (int m = 0; m < 4; ++m)
#pragma unroll
                for (int n = 0; n < 2; ++n) acc[a][b][m][n] = (f32x4){0.f, 0.f, 0.f, 0.f};
    bf16x8 At[4][2], B0[2][2], B1[2][2];
    const char* cA = (const char*)g.A + (size_t)cur.pm * tstep; const char* cB = (const char*)g.Bt + (size_t)cur.pn * tstep;
    S.a_ready(cur);
    if constexpr (SP2) {
        PG8_STAGE(PG8_SB(0, 0), cB, voffB); PG8_STAGE(PG8_SB(0, 1), cB + hstep, voffB); PG8_STAGE(PG8_SA(0, 0), cA, voffA); PG8_STAGE(PG8_SA(0, 1), cA + hstep, voffA);
        if (wr == 1) PG8_BAR;
        PG8_WAIT_V(2); PG8_BAR;
        PG8_STAGE(PG8_SB(1, 0), cB + kstep, voffB); PG8_STAGE(PG8_SA(1, 0), cA + kstep, voffA); PG8_STAGE(PG8_SB(1, 1), cB + hstep + kstep, voffB);
        PG8_WAIT_V(6); PG8_BAR;
    } else {
        PG8_STAGE(PG8_SB(0, 0), cB, voffB); PG8_STAGE(PG8_SA(0, 0), cA, voffA); PG8_STAGE(PG8_SB(0, 1), cB + hstep, voffB); PG8_STAGE(PG8_SA(0, 1), cA + hstep, voffA);
        if (wr == 1) PG8_BAR;
        PG8_WAIT_V(4); PG8_BAR;
        PG8_STAGE(PG8_SB(1, 0), cB + kstep, voffB); PG8_STAGE(PG8_SA(1, 0), cA + kstep, voffA); PG8_STAGE(PG8_SB(1, 1), cB + hstep + kstep, voffB);
        PG8_WAIT_V(6); PG8_BAR;
    }
    for (;;) {
        const bool has_next = S.next(ui + 1, nxt);
        const char* nA = has_next ? (const char*)g.A + (size_t)nxt.pm * tstep : cA; const char* nB = has_next ? (const char*)g.Bt + (size_t)nxt.pn * tstep : cB;
        for (int t = 0; t < nt; t += 2) {
            const bool last = (t == nt - 2);
            const char* a1 = cA + (size_t)(t + 1) * kstep;
            const char* a2 = last ? nA : cA + (size_t)(t + 2) * kstep; const char* b2 = last ? nB : cB + (size_t)(t + 2) * kstep;
            const char* a3 = a2 + kstep; const char* b3 = b2 + kstep;
            if (last && has_next) S.a_ready(nxt);
            if constexpr (SP2) {
            PG8_LDB(B0, 0, 0); PG8_LDB(B1, 0, 1); PG8_SCHED; PG8_LDA(At, 0, 0); PG8_STAGE(PG8_SA(1, 1), a1 + hstep, voffA);
            PG8_WAIT_V(8); PG8_WAIT_L(0); PG8_BAR; PG8_MMA(0, 0, At, B0); PG8_MMA(0, 1, At, B1); PG8_BAR; PG8_SCHED;
            PG8_LDA(At, 0, 1); PG8_STAGE(PG8_SB(0, 0), b2, voffB); PG8_STAGE(PG8_SB(0, 1), b2 + hstep, voffB); PG8_STAGE(PG8_SA(0, 0), a2, voffA);
            PG8_WAIT_V(8); PG8_WAIT_L(0); PG8_BAR; PG8_MMA(1, 0, At, B0); PG8_MMA(1, 1, At, B1); PG8_BAR; PG8_SCHED;
            PG8_LDB(B0, 1, 0); PG8_LDB(B1, 1, 1); PG8_SCHED; PG8_LDA(At, 1, 0); PG8_STAGE(PG8_SA(0, 1), a2 + hstep, voffA);
            PG8_WAIT_V(8); PG8_WAIT_L(0); PG8_BAR; PG8_MMA(0, 0, At, B0); PG8_MMA(0, 1, At, B1); PG8_BAR; PG8_SCHED;
            PG8_LDA(At, 1, 1); PG8_STAGE(PG8_SB(1, 0), b3, voffB); PG8_STAGE(PG8_SB(1, 1), b3 + hstep, voffB); PG8_STAGE(PG8_SA(1, 0), a3, voffA);
            PG8_WAIT_V(8); PG8_WAIT_L(0); PG8_BAR; PG8_MMA(1, 0, At, B0); PG8_MMA(1, 1, At, B1); PG8_BAR; PG8_SCHED;
            } else {
            PG8_LDB(B0, 0, 0); PG8_SCHED; PG8_LDA(At, 0, 0); PG8_STAGE(PG8_SA(1, 1), a1 + hstep, voffA);
            PG8_WAIT_L(8); PG8_BAR; PG8_WAIT_L(0); PG8_MMA(0, 0, At, B0); PG8_BAR; PG8_SCHED;
            PG8_LDB(B1, 0, 1); PG8_STAGE(PG8_SB(0, 0), b2, voffB);
            PG8_BAR; PG8_WAIT_L(0); PG8_MMA(0, 1, At, B1); PG8_BAR;
            PG8_LDA(At, 0, 1); PG8_STAGE(PG8_SA(0, 0), a2, voffA);
            PG8_BAR; PG8_WAIT_L(0); PG8_MMA(1, 0, At, B0); PG8_BAR; PG8_SCHED;
            PG8_STAGE(PG8_SB(0, 1), b2 + hstep, voffB);
            PG8_WAIT_V(6); PG8_BAR; PG8_MMA(1, 1, At, B1); PG8_BAR;
            PG8_LDB(B0, 1, 0); PG8_SCHED; PG8_LDA(At, 1, 0); PG8_STAGE(PG8_SA(0, 1), a2 + hstep, voffA);
            PG8_WAIT_L(8); PG8_BAR; PG8_WAIT_L(0); PG8_MMA(0, 0, At, B0); PG8_BAR; PG8_SCHED;
            PG8_LDB(B1, 1, 1); PG8_STAGE(PG8_SB(1, 0), b3, voffB);
            PG8_BAR; PG8_WAIT_L(0); PG8_MMA(0, 1, At, B1); PG8_BAR;
            PG8_LDA(At, 1, 1); PG8_STAGE(PG8_SA(1, 0), a3, voffA);
            PG8_BAR; PG8_WAIT_L(0); PG8_MMA(1, 0, At, B0); PG8_BAR; PG8_SCHED;
            PG8_STAGE(PG8_SB(1, 1), b3 + hstep, voffB);
            PG8_WAIT_V(6); PG8_BAR; PG8_MMA(1, 1, At, B1); PG8_BAR;
            }
        }
        if constexpr (ALIGN_EPI) { if (wr == 0) PG8_BAR; }
        if constexpr (!Epi::AFTER_DRAIN) { E(acc, cur, wr, wc, fr, fq); S.done(cur); }
        if (!has_next) break;
#pragma unroll
        for (int a = 0; a < 2; ++a)
#pragma unroll
            for (int b = 0; b < 2; ++b)
#pragma unroll
                for (int m = 0; m < 4; ++m)
#pragma unroll
                    for (int n = 0; n < 2; ++n) acc[a][b][m][n] = (f32x4){0.f, 0.f, 0.f, 0.f};
        cur = nxt; cA = nA; cB = nB; ++ui;
        if constexpr (ALIGN_EPI) { if (wr == 1) PG8_BAR; }
    }
    PG8_WAIT_V(0);
    if constexpr (!ALIGN_EPI) { if (wr == 0) PG8_BAR; }
    PG8_BAR;
    if constexpr (Epi::AFTER_DRAIN) { E.fused(acc, cur, wr, wc, fr, fq, lds, wid, lane); S.done(cur); }
#undef PG8_SA
#undef PG8_SB
#undef PG8_STAGE
#undef PG8_LDA
#undef PG8_LDB
#undef PG8_MMA
#undef PG8_WAIT_V
#undef PG8_WAIT_L
#undef PG8_BAR
#undef PG8_SCHED
}

typedef int i32x4 __attribute__((ext_vector_type(4)));
template <class Epi, class Sched, bool ALIGN_EPI = false, bool SP2 = false>
__device__ __forceinline__ void gemm_phase_i8(PG8_LAS unsigned char* lds, const Gemm g, const Sched& S, const Epi& E, int wv) {
    unsigned m_op = ~0u; asm volatile("" : "+s"(m_op));
    const int tid = wv * 64 + (int)__builtin_amdgcn_mbcnt_hi(m_op, __builtin_amdgcn_mbcnt_lo(m_op, 0u)), wid = wv, lane = tid & 63, wr = wid >> 2, wc = wid & 3, fr = lane & 15, fq = lane >> 4;
    const int K = g.K, nt = K / BK;
    unsigned voffA[2], voffB[2];
#pragma unroll
    for (int i = 0; i < 2; ++i) { int R, C; stage_rc(tid * 16 + i * 8192, R, C); const int Rb = Epi::PERM ? ((R & ~31) + perm32(R & 31)) : R;
        voffA[i] = (unsigned)(R * K + C) * 2u; voffB[i] = (unsigned)(Rb * K + C) * 2u; }
    const size_t kstep = (size_t)(BK * 2);
    const size_t hstep = (size_t)HALF * K * 2;
    const size_t tstep = 2 * hstep;
    const unsigned ldsw = (unsigned)wid * 1024u;
    const int aoff = lds_byte(wr * 64 + fr, fq * 8), boff = lds_byte(wc * 32 + fr, fq * 8);
#define PG8_SA(b, h) (((b) * 2 + (h)) * HTB)
#define PG8_SB(b, h) ((4 + (b) * 2 + (h)) * HTB)
#define PG8_STAGE(bufoff, gbase, voff) do { _Pragma("unroll") for (int _i = 0; _i < 2; ++_i) \
        __builtin_amdgcn_global_load_lds((const unsigned*)((const char*)(gbase) + (voff)[_i]), (PG8_LAS unsigned*)(lds + (bufoff) + ldsw + _i * 8192), 16, 0, 0); } while (0)
#define PG8_LDA(dst, b, h) do { _Pragma("unroll") for (int m = 0; m < 4; ++m) _Pragma("unroll") for (int k = 0; k < 2; ++k) dst[m][k] = *(const PG8_LAS bf16x8*)(lds + PG8_SA(b, h) + aoff + m * 2048 + k * 1024); } while (0)
#define PG8_LDB(dst, b, h) do { _Pragma("unroll") for (int n = 0; n < 2; ++n) _Pragma("unroll") for (int k = 0; k < 2; ++k) dst[n][k] = *(const PG8_LAS bf16x8*)(lds + PG8_SB(b, h) + boff + n * 2048 + k * 1024); } while (0)
#define PG8_MMA(ai, bj, At, Bt) do { __builtin_amdgcn_s_setprio(1); _Pragma("unroll") for (int m = 0; m < 4; ++m) _Pragma("unroll") for (int n = 0; n < 2; ++n) _Pragma("unroll") for (int k = 0; k < 2; ++k) \
        acc[ai][bj][m][n] = __builtin_amdgcn_mfma_i32_16x16x64_i8(__builtin_bit_cast(i32x4, Bt[n][k]), __builtin_bit_cast(i32x4, At[m][k]), acc[ai][bj][m][n], 0, 0, 0); __builtin_amdgcn_s_setprio(0); } while (0)
#define PG8_WAIT_V(n) asm volatile("s_waitcnt vmcnt(" #n ")" ::: "memory")
#define PG8_WAIT_L(n) asm volatile("s_waitcnt lgkmcnt(" #n ")" ::: "memory")
#define PG8_BAR __builtin_amdgcn_s_barrier()
#define PG8_SCHED __builtin_amdgcn_sched_barrier(0)
    Unit cur, nxt; int ui = 0;
    if (!S.next(0, cur)) return;
    i32x4 acc[2][2][4][2];
#pragma unroll
    for (int a = 0; a < 2; ++a)
#pragma unroll
        for (int b = 0; b < 2; ++b)
#pragma unroll
            for (int m = 0; m < 4; ++m)
#pragma unroll
                for (int n = 0; n < 2; ++n) acc[a][b][m][n] = (i32x4){0, 0, 0, 0};
    bf16x8 At[4][2], B0[2][2], B1[2][2];
    const char* cA = (const char*)g.A + (size_t)cur.pm * tstep; const char* cB = (const char*)g.Bt + (size_t)cur.pn * tstep;
    S.a_ready(cur);
    if constexpr (SP2) {
        PG8_STAGE(PG8_SB(0, 0), cB, voffB); PG8_STAGE(PG8_SB(0, 1), cB + hstep, voffB); PG8_STAGE(PG8_SA(0, 0), cA, voffA); PG8_STAGE(PG8_SA(0, 1), cA + hstep, voffA);
        if (wr == 1) PG8_BAR;
        PG8_WAIT_V(2); PG8_BAR;
        PG8_STAGE(PG8_SB(1, 0), cB + kstep, voffB); PG8_STAGE(PG8_SA(1, 0), cA + kstep, voffA); PG8_STAGE(PG8_SB(1, 1), cB + hstep + kstep, voffB);
        PG8_WAIT_V(6); PG8_BAR;
    } else {
        PG8_STAGE(PG8_SB(0, 0), cB, voffB); PG8_STAGE(PG8_SA(0, 0), cA, voffA); PG8_STAGE(PG8_SB(0, 1), cB + hstep, voffB); PG8_STAGE(PG8_SA(0, 1), cA + hstep, voffA);
        if (wr == 1) PG8_BAR;
        PG8_WAIT_V(4); PG8_BAR;
        PG8_STAGE(PG8_SB(1, 0), cB + kstep, voffB); PG8_STAGE(PG8_SA(1, 0), cA + kstep, voffA); PG8_STAGE(PG8_SB(1, 1), cB + hstep + kstep, voffB);
        PG8_WAIT_V(6); PG8_BAR;
    }
    for (;;) {
        const bool has_next = S.next(ui + 1, nxt);
        const char* nA = has_next ? (const char*)g.A + (size_t)nxt.pm * tstep : cA; const char* nB = has_next ? (const char*)g.Bt + (size_t)nxt.pn * tstep : cB;
        for (int t = 0; t < nt; t += 2) {
            const bool last = (t == nt - 2);
            const char* a1 = cA + (size_t)(t + 1) * kstep;
            const char* a2 = last ? nA : cA + (size_t)(t + 2) * kstep; const char* b2 = last ? nB : cB + (size_t)(t + 2) * kstep;
            const char* a3 = a2 + kstep; const char* b3 = b2 + kstep;
            if (last && has_next) S.a_ready(nxt);
            if constexpr (SP2) {
            PG8_LDB(B0, 0, 0); PG8_LDB(B1, 0, 1); PG8_SCHED; PG8_LDA(At, 0, 0); PG8_STAGE(PG8_SA(1, 1), a1 + hstep, voffA);
            PG8_WAIT_V(8); PG8_WAIT_L(0); PG8_BAR; PG8_MMA(0, 0, At, B0); PG8_MMA(0, 1, At, B1); PG8_BAR; PG8_SCHED;
            PG8_LDA(At, 0, 1); PG8_STAGE(PG8_SB(0, 0), b2, voffB); PG8_STAGE(PG8_SB(0, 1), b2 + hstep, voffB); PG8_STAGE(PG8_SA(0, 0), a2, voffA);
            PG8_WAIT_V(8); PG8_WAIT_L(0); PG8_BAR; PG8_MMA(1, 0, At, B0); PG8_MMA(1, 1, At, B1); PG8_BAR; PG8_SCHED;
            PG8_LDB(B0, 1, 0); PG8_LDB(B1, 1, 1); PG8_SCHED; PG8_LDA(At, 1, 0); PG8_STAGE(PG8_SA(0, 1), a2 + hstep, voffA);
            PG8_WAIT_V(8); PG8_WAIT_L(0); PG8_BAR; PG8_MMA(0, 0, At, B0); PG8_MMA(0, 1, At, B1); PG8_BAR; PG8_SCHED;
            PG8_LDA(At, 1, 1); PG8_STAGE(PG8_SB(1, 0), b3, voffB); PG8_STAGE(PG8_SB(1, 1), b3 + hstep, voffB); PG8_STAGE(PG8_SA(1, 0), a3, voffA);
            PG8_WAIT_V(8); PG8_WAIT_L(0); PG8_BAR; PG8_MMA(1, 0, At, B0); PG8_MMA(1, 1, At, B1); PG8_BAR; PG8_SCHED;
            } else {
            PG8_LDB(B0, 0, 0); PG8_SCHED; PG8_LDA(At, 0, 0); PG8_STAGE(PG8_SA(1, 1), a1 + hstep, voffA);
            PG8_WAIT_L(8); PG8_BAR; PG8_WAIT_L(0); PG8_MMA(0, 0, At, B0); PG8_BAR; PG8_SCHED;
            PG8_LDB(B1, 0, 1); PG8_STAGE(PG8_SB(0, 0), b2, voffB);
            PG8_BAR; PG8_WAIT_L(0); PG8_MMA(0, 1, At, B1); PG8_BAR;
            PG8_LDA(At, 0, 1); PG8_STAGE(PG8_SA(0, 0), a2, voffA);
            PG8_BAR; PG8_WAIT_L(0); PG8_MMA(1, 0, At, B0); PG8_BAR; PG8_SCHED;
            PG8_STAGE(PG8_SB(0, 1), b2 + hstep, voffB);
            PG8_WAIT_V(6); PG8_BAR; PG8_MMA(1, 1, At, B1); PG8_BAR;
            PG8_LDB(B0, 1, 0); PG8_SCHED; PG8_LDA(At, 1, 0); PG8_STAGE(PG8_SA(0, 1), a2 + hstep, voffA);
            PG8_WAIT_L(8); PG8_BAR; PG8_WAIT_L(0); PG8_MMA(0, 0, At, B0); PG8_BAR; PG8_SCHED;
            PG8_LDB(B1, 1, 1); PG8_STAGE(PG8_SB(1, 0), b3, voffB);
            PG8_BAR; PG8_WAIT_L(0); PG8_MMA(0, 1, At, B1); PG8_BAR;
            PG8_LDA(At, 1, 1); PG8_STAGE(PG8_SA(1, 0), a3, voffA);
            PG8_BAR; PG8_WAIT_L(0); PG8_MMA(1, 0, At, B0); PG8_BAR; PG8_SCHED;
            PG8_STAGE(PG8_SB(1, 1), b3 + hstep, voffB);
            PG8_WAIT_V(6); PG8_BAR; PG8_MMA(1, 1, At, B1); PG8_BAR;
            }
        }
        if constexpr (ALIGN_EPI) { if (wr == 0) PG8_BAR; }
        if constexpr (!Epi::AFTER_DRAIN) { E(acc, cur, wr, wc, fr, fq); S.done(cur); }
        if (!has_next) break;
#pragma unroll
        for (int a = 0; a < 2; ++a)
#pragma unroll
            for (int b = 0; b < 2; ++b)
#pragma unroll
                for (int m = 0; m < 4; ++m)
#pragma unroll
                    for (int n = 0; n < 2; ++n) acc[a][b][m][n] = (i32x4){0, 0, 0, 0};
        cur = nxt; cA = nA; cB = nB; ++ui;
        if constexpr (ALIGN_EPI) { if (wr == 1) PG8_BAR; }
    }
    PG8_WAIT_V(0);
    if constexpr (!ALIGN_EPI) { if (wr == 0) PG8_BAR; }
    PG8_BAR;
    if constexpr (Epi::AFTER_DRAIN) { E.fused(acc, cur, wr, wc, fr, fq, lds, wid, lane); S.done(cur); }
#undef PG8_SA
#undef PG8_SB
#undef PG8_STAGE
#undef PG8_LDA
#undef PG8_LDB
#undef PG8_MMA
#undef PG8_WAIT_V
#undef PG8_WAIT_L
#undef PG8_BAR
#undef PG8_SCHED
}
}


#define LAS __attribute__((address_space(3)))

__device__ __forceinline__ int op_bid() { int b = (int)blockIdx.x; asm volatile("" : "+s"(b)); return b; }
__device__ __forceinline__ int op_grid() { int g = (int)gridDim.x; asm volatile("" : "+s"(g)); return g; }
__device__ __forceinline__ int phase_tid(int wv) { unsigned m = ~0u; asm volatile("" : "+s"(m)); return wv * 64 + (int)__builtin_amdgcn_mbcnt_hi(m, __builtin_amdgcn_mbcnt_lo(m, 0u)); }
typedef unsigned short bf16_t;
typedef float f32x4 __attribute__((ext_vector_type(4)));
typedef unsigned u32x4 __attribute__((ext_vector_type(4)));
typedef unsigned u32x2 __attribute__((ext_vector_type(2)));

constexpr int BATCH = 8, SEQ = 4096, DM = 1024, T = BATCH * SEQ, DEPTH = 2;
constexpr int NPROJ = 4352, NMOD = 6 * DM;
constexpr int NEXP = 16384, PQ = 2048;
constexpr float NORM_EPS = 1e-6f;
constexpr float LOG2E = 1.4426950408889634f;
constexpr float QSCALE = 0.125f * LOG2E;
constexpr float SB_EXIT = 160.0f;

constexpr size_t MiB = 1u << 20;
constexpr size_t WS_CTL = 0;
constexpr size_t WS_MOD = 1 * MiB;
constexpr size_t WS_ROPE = 2 * MiB;
constexpr size_t WS_WIN = 10 * MiB;
constexpr size_t WS_WBA = 27 * MiB;
constexpr size_t WS_WBB = 29 * MiB;
constexpr size_t WS_WOUT = 31 * MiB;
constexpr size_t WS_WQ = 35 * MiB;
constexpr size_t WS_SK = 43 * MiB;
constexpr size_t WS_UQ = 44 * MiB;
constexpr size_t WS_VQ = 76 * MiB;
constexpr size_t WS_USC = 108 * MiB;
constexpr size_t WS_HS = 109 * MiB;
constexpr size_t WS_H = 112 * MiB;
constexpr size_t WS_QA = 176 * MiB;
constexpr size_t WS_QB = 208 * MiB;
constexpr size_t WS_KB = 240 * MiB;
constexpr size_t WS_VB = 272 * MiB;
constexpr size_t WS_KA = 304 * MiB;
constexpr size_t WS_VA = 312 * MiB;
constexpr size_t WS_GA = 320 * MiB;
constexpr size_t WS_GB = 384 * MiB;
constexpr size_t WS_XB = 448 * MiB;
constexpr size_t WS_END = 512 * MiB;
constexpr size_t WS_H2Q = WS_QA, WS_UM = WS_VB, WS_Q2 = WS_GA, WS_COEF = WS_GA;
constexpr size_t WS_IDX_UNUSED = WS_KB;
constexpr int CTL_BAR = 4096;
constexpr size_t WS_IDX16 = WS_KB + 16 * MiB;
constexpr size_t WS_CSIN = WS_MOD + 512 * 1024;
constexpr size_t WS_CSQ = WS_CSIN + 64 * 1024;
constexpr size_t WS_HS1 = WS_HS + 768 * 1024;
constexpr int CTL_ATTQ = 8192;
constexpr int CTL_QUEUE = 1024;

constexpr int LDS_BYTES = 147456;
constexpr int NTHREADS = 512, NWAVES = 8;

struct KArgs {
    const float* x; const float* c; const int* pos; const float* ada_w; const float* ada_b; const float* norm1_g; const float* w_in; const float* sinks;
    const float* wbr_a; const float* wbr_b; const float* w_out; const float* norm2_g; const float* wq; const float* subkeys; const float* pu; const float* pv; const float* final_g;
    float* out; unsigned char* ws; int ph_lo, ph_hi;
};

__device__ __forceinline__ unsigned f2bf(float f) { unsigned u = __float_as_uint(f); return (u + 0x7fffu + ((u >> 16) & 1u)) >> 16; }
__device__ __forceinline__ unsigned pk2(float lo, float hi) { unsigned r; asm("v_cvt_pk_bf16_f32 %0, %1, %2" : "=v"(r) : "v"(lo), "v"(hi)); return r; }
__device__ __forceinline__ float bflo(unsigned w) { return __uint_as_float(w << 16); }
__device__ __forceinline__ float bfhi(unsigned w) { return __uint_as_float(w & 0xffff0000u); }
template <int M> __device__ __forceinline__ float swz_xor(float v) { return __int_as_float(__builtin_amdgcn_ds_swizzle(__float_as_int(v), (M << 10) | 0x1f)); }
__device__ __forceinline__ float wave_sum(float v) {
    v += swz_xor<1>(v); v += swz_xor<2>(v); v += swz_xor<4>(v); v += swz_xor<8>(v); v += swz_xor<16>(v);
    auto rr = __builtin_amdgcn_permlane32_swap(__float_as_uint(v), __float_as_uint(v), false, false);
    return __uint_as_float(rr[0]) + __uint_as_float(rr[1]);
}
__device__ __forceinline__ float wave_max(float v) {
    v = fmaxf(v, swz_xor<1>(v)); v = fmaxf(v, swz_xor<2>(v)); v = fmaxf(v, swz_xor<4>(v)); v = fmaxf(v, swz_xor<8>(v)); v = fmaxf(v, swz_xor<16>(v));
    auto rr = __builtin_amdgcn_permlane32_swap(__float_as_uint(v), __float_as_uint(v), false, false);
    return fmaxf(__uint_as_float(rr[0]), __uint_as_float(rr[1]));
}
template <int CTRL> __device__ __forceinline__ float dpp_f(float v) { return __int_as_float(__builtin_amdgcn_update_dpp(0, __float_as_int(v), CTRL, 0xF, 0xF, true)); }
__device__ __forceinline__ float wave_sum_dpp(float v) {
    v += dpp_f<0xB1>(v); v += dpp_f<0x4E>(v); v += dpp_f<0x141>(v); v += dpp_f<0x140>(v);
    { auto rr = __builtin_amdgcn_permlane16_swap(__float_as_uint(v), __float_as_uint(v), false, false); v = __uint_as_float(rr[0]) + __uint_as_float(rr[1]); }
    { auto rr = __builtin_amdgcn_permlane32_swap(__float_as_uint(v), __float_as_uint(v), false, false); v = __uint_as_float(rr[0]) + __uint_as_float(rr[1]); }
    return v;
}
__device__ __forceinline__ float wave_max_dpp(float v) {
    v = fmaxf(v, dpp_f<0xB1>(v)); v = fmaxf(v, dpp_f<0x4E>(v)); v = fmaxf(v, dpp_f<0x141>(v)); v = fmaxf(v, dpp_f<0x140>(v));
    { auto rr = __builtin_amdgcn_permlane16_swap(__float_as_uint(v), __float_as_uint(v), false, false); v = fmaxf(__uint_as_float(rr[0]), __uint_as_float(rr[1])); }
    { auto rr = __builtin_amdgcn_permlane32_swap(__float_as_uint(v), __float_as_uint(v), false, false); v = fmaxf(__uint_as_float(rr[0]), __uint_as_float(rr[1])); }
    return v;
}
__device__ __forceinline__ int rdlane_i(int v, int l) { return __builtin_amdgcn_readlane(v, __builtin_amdgcn_readfirstlane(l)); }
__device__ __forceinline__ float rdlane_f(float v, int l) { return __int_as_float(__builtin_amdgcn_readlane(__float_as_int(v), __builtin_amdgcn_readfirstlane(l))); }
__device__ __forceinline__ float dot8(u32x4 a, u32x4 b, float acc) {
    acc = fmaf(bflo(a.x), bflo(b.x), acc); acc = fmaf(bfhi(a.x), bfhi(b.x), acc);
    acc = fmaf(bflo(a.y), bflo(b.y), acc); acc = fmaf(bfhi(a.y), bfhi(b.y), acc);
    acc = fmaf(bflo(a.z), bflo(b.z), acc); acc = fmaf(bfhi(a.z), bfhi(b.z), acc);
    acc = fmaf(bflo(a.w), bflo(b.w), acc); acc = fmaf(bfhi(a.w), bfhi(b.w), acc);
    return acc;
}
__device__ __forceinline__ float softplus2(float z2) {
    return fmaxf(z2, 0.f) + __log2f(1.0f + exp2f(-fabsf(z2)));
}

__device__ __forceinline__ int win_pos(int n) {
    if (n >= 640) return n;
    const int hb = n & ~63, d = n & 63;
    return hb + (d < 32 ? 2 * d : 2 * (d - 32) + 1);
}
template <bool WIN>
__device__ __forceinline__ void transpose_item(const float* W, int K, int N, bf16_t* WT, LAS float* scr, int item, int lane) {
    const int nblk = N / 32, kb = item / nblk, nb = item % nblk, k0 = 64 * kb, n0 = 32 * nb;
    {
        float tv[32];
#pragma unroll
        for (int i = 0; i < 32; ++i) { const int kk = 2 * i + (lane >> 5); tv[i] = W[(size_t)(k0 + kk) * N + n0 + (lane & 31)]; }
#pragma unroll
        for (int i = 0; i < 32; ++i) { const int kk = 2 * i + (lane >> 5); scr[kk * 33 + (lane & 31)] = tv[i]; }
    }
    asm volatile("s_waitcnt lgkmcnt(0)" ::: "memory");
    const int c = lane & 7;
#pragma unroll
    for (int j = 0; j < 4; ++j) { const int n = (lane >> 3) + 8 * j; const LAS float* s = scr + (8 * c) * 33 + n;
        u32x4 o; o.x = pk2(s[0 * 33], s[1 * 33]); o.y = pk2(s[2 * 33], s[3 * 33]); o.z = pk2(s[4 * 33], s[5 * 33]); o.w = pk2(s[6 * 33], s[7 * 33]);
        const int row = WIN ? win_pos(n0 + n) : (n0 + n);
        *(u32x4*)(WT + (size_t)row * K + k0 + 8 * c) = o; }
    asm volatile("s_waitcnt lgkmcnt(0)" ::: "memory");
}
template <bool OFFSET128>
__device__ __forceinline__ void quant_row(const f32x4 (&v)[4], unsigned char* dst_row, float* scale_out, int lane) {
    float am = 0.f;
#pragma unroll
    for (int i = 0; i < 4; ++i) am = fmaxf(am, fmaxf(fmaxf(fabsf(v[i].x), fabsf(v[i].y)), fmaxf(fabsf(v[i].z), fabsf(v[i].w))));
    am = wave_max_dpp(am);
    const float inv = am > 0.f ? 127.0f / am : 0.f, sc = am > 0.f ? am / 127.0f : 1.0f;
    u32x4 o;
#pragma unroll
    for (int i = 0; i < 4; ++i) {
        int q0 = (int)rintf(v[i].x * inv), q1 = (int)rintf(v[i].y * inv), q2 = (int)rintf(v[i].z * inv), q3 = (int)rintf(v[i].w * inv);
        if (OFFSET128) { q0 += 128; q1 += 128; q2 += 128; q3 += 128; }
        o[i] = (unsigned)(q0 & 0xff) | ((unsigned)(q1 & 0xff) << 8) | ((unsigned)(q2 & 0xff) << 16) | ((unsigned)(q3 & 0xff) << 24);
    }
    *(u32x4*)(dst_row + 16 * lane) = o;
    if (lane == 0) *scale_out = sc;
}

__device__ __forceinline__ void quant_row_nat(const f32x4 (&v)[4], unsigned char* dst_row, float* scale_out, int lane) {
    float am = 0.f;
#pragma unroll
    for (int i = 0; i < 4; ++i) am = fmaxf(am, fmaxf(fmaxf(fabsf(v[i].x), fabsf(v[i].y)), fmaxf(fabsf(v[i].z), fabsf(v[i].w))));
    am = wave_max_dpp(am);
    const float inv = am > 0.f ? 127.0f / am : 0.f, sc = am > 0.f ? am / 127.0f : 1.0f;
#pragma unroll
    for (int i = 0; i < 4; ++i) {
        const int q0 = (int)rintf(v[i].x * inv), q1 = (int)rintf(v[i].y * inv), q2 = (int)rintf(v[i].z * inv), q3 = (int)rintf(v[i].w * inv);
        *(unsigned*)(dst_row + 256 * i + 4 * lane) = (unsigned)(q0 & 0xff) | ((unsigned)(q1 & 0xff) << 8) | ((unsigned)(q2 & 0xff) << 16) | ((unsigned)(q3 & 0xff) << 24);
    }
    if (lane == 0) *scale_out = sc;
}
template <bool WIN>
__device__ __forceinline__ void transpose_item_i8(const float* W, int K, int N, unsigned char* WT, const float* cscale, LAS float* scr, int item, int lane) {
    const int nblk = N / 32, kb = item / nblk, nb = item % nblk, k0 = 64 * kb, n0 = 32 * nb;
    {
        float tv[32];
#pragma unroll
        for (int i = 0; i < 32; ++i) { const int kk = 2 * i + (lane >> 5); tv[i] = W[(size_t)(k0 + kk) * N + n0 + (lane & 31)]; }
#pragma unroll
        for (int i = 0; i < 32; ++i) { const int kk = 2 * i + (lane >> 5); scr[kk * 33 + (lane & 31)] = tv[i]; }
    }
    asm volatile("s_waitcnt lgkmcnt(0)" ::: "memory");
    const int c = lane & 3;
#pragma unroll
    for (int j = 0; j < 2; ++j) { const int n = (lane >> 2) + 16 * j; const LAS float* sp = scr + (16 * c) * 33 + n;
        const int row = WIN ? win_pos(n0 + n) : (n0 + n);
        const float cs = cscale[row], inv = cs > 0.f ? 1.0f / cs : 0.f;
        u32x4 o;
#pragma unroll
        for (int w = 0; w < 4; ++w) { const int q0 = (int)rintf(sp[(4 * w) * 33] * inv), q1 = (int)rintf(sp[(4 * w + 1) * 33] * inv), q2 = (int)rintf(sp[(4 * w + 2) * 33] * inv), q3 = (int)rintf(sp[(4 * w + 3) * 33] * inv);
            o[w] = (unsigned)(q0 & 0xff) | ((unsigned)(q1 & 0xff) << 8) | ((unsigned)(q2 & 0xff) << 16) | ((unsigned)(q3 & 0xff) << 24); }
        *(u32x4*)(WT + (size_t)row * K + k0 + 16 * c) = o; }
    asm volatile("s_waitcnt lgkmcnt(0)" ::: "memory");
}
__device__ __forceinline__ void peer_tables_layer(const KArgs& a, int l, int part, int nparts, int lane) {
    unsigned char* ws = a.ws;
    for (int r0 = l * NEXP + part * 4; r0 < (l + 1) * NEXP; r0 += nparts * 4) {
        f32x4 v[4][4];
#pragma unroll
        for (int j = 0; j < 4; ++j)
#pragma unroll
            for (int i = 0; i < 4; ++i) v[j][i] = ((const f32x4*)(a.pu + (size_t)(r0 + j) * 1024))[64 * i + lane];
#pragma unroll
        for (int j = 0; j < 4; ++j) quant_row_nat(v[j], ws + WS_UQ + (size_t)(r0 + j) * 1024, (float*)(ws + WS_USC) + 2 * (r0 + j), lane);
    }
    for (int r0 = l * NEXP + part * 4; r0 < (l + 1) * NEXP; r0 += nparts * 4) {
        f32x4 v[4][4];
#pragma unroll
        for (int j = 0; j < 4; ++j)
#pragma unroll
            for (int i = 0; i < 4; ++i) v[j][i] = ((const f32x4*)(a.pv + (size_t)(r0 + j) * 1024))[4 * lane + i];
#pragma unroll
        for (int j = 0; j < 4; ++j) { const int lr = r0 + j, e = lr - l * NEXP;
            quant_row<false>(v[j], ws + WS_VQ + (size_t)l * NEXP * 1024 + ((size_t)(lane >> 3) * NEXP + e) * 128 + 16 * (lane & 7) - 16 * lane, (float*)(ws + WS_USC) + 2 * lr + 1, lane); }
    }
}
__device__ __forceinline__ void ph_prologue(const KArgs& a, LAS unsigned char* lds, int wv) {
    const int tid = phase_tid(wv), lane = tid & 63, wave = wv, G = op_grid();
    const int gw = op_bid() * NWAVES + wave, NGW = G * NWAVES;
    unsigned char* ws = a.ws;
    {
        LAS float* sc = (LAS float*)lds;
        LAS float* red = (LAS float*)(lds + 32768);
        for (int it = op_bid(); it < DEPTH * 96; it += G) {
            for (int idx = tid; idx < 8192; idx += NTHREADS) { const int b = idx >> 10, i = idx & 1023; const float cv = a.c[b * 1024 + i]; sc[i * 8 + b] = cv / (1.0f + __expf(-cv)); }
            __syncthreads();
            const int l = it / 96, j0 = (it % 96) * 64;
            const float* wp = a.ada_w + ((size_t)l * 1024 + wave * 128) * NMOD + j0 + lane;
            float acc[8];
#pragma unroll
            for (int b = 0; b < 8; ++b) acc[b] = 0.f;
#pragma unroll 1
            for (int i0 = 0; i0 < 128; i0 += 32) {
                float wv_[32];
#pragma unroll
                for (int i = 0; i < 32; ++i) wv_[i] = wp[(size_t)(i0 + i) * NMOD];
#pragma unroll
                for (int ii = 0; ii < 32; ++ii) { const int i = i0 + ii; const float w = wv_[ii];
                const f32x4 s0 = *(const LAS f32x4*)(sc + (wave * 128 + i) * 8), s1 = *(const LAS f32x4*)(sc + (wave * 128 + i) * 8 + 4);
                acc[0] = fmaf(s0.x, w, acc[0]); acc[1] = fmaf(s0.y, w, acc[1]); acc[2] = fmaf(s0.z, w, acc[2]); acc[3] = fmaf(s0.w, w, acc[3]);
                acc[4] = fmaf(s1.x, w, acc[4]); acc[5] = fmaf(s1.y, w, acc[5]); acc[6] = fmaf(s1.z, w, acc[6]); acc[7] = fmaf(s1.w, w, acc[7]);
                }
            }
#pragma unroll
            for (int b = 0; b < 8; ++b) red[(wave * 8 + b) * 64 + lane] = acc[b];
            __syncthreads();
            {
                float t = 0.f;
#pragma unroll
                for (int w = 0; w < 8; ++w) t += red[(w * 8 + wave) * 64 + lane];
                ((float*)(ws + WS_MOD))[(size_t)(l * 8 + wave) * NMOD + j0 + lane] = t + a.ada_b[l * NMOD + j0 + lane];
            }
            __syncthreads();
        }
    }
    {
        LAS float* red = (LAS float*)(lds + 32768);
        for (int it = op_bid(); it < DEPTH * 100; it += G) {
            const int l = it / 100, rr = it % 100; const bool isq = rr >= 68;
            const int N = isq ? PQ : NPROJ, j0 = (isq ? rr - 68 : rr) * 64;
            const float* wp = (isq ? a.wq + (size_t)l * 1024 * PQ : a.w_in + (size_t)l * 1024 * NPROJ) + (size_t)(wave * 128) * N + j0 + lane;
            float m = 0.f;
#pragma unroll 1
            for (int i0 = 0; i0 < 128; i0 += 64) {
                float wv_[64];
#pragma unroll
                for (int i = 0; i < 64; ++i) wv_[i] = wp[(size_t)(i0 + i) * N];
#pragma unroll
                for (int i = 0; i < 64; ++i) m = fmaxf(m, fabsf(wv_[i]));
            }
            red[wave * 64 + lane] = m;
            __syncthreads();
            if (wave == 0) {
#pragma unroll
                for (int w = 1; w < 8; ++w) m = fmaxf(m, red[w * 64 + lane]);
                float* cs = isq ? (float*)(ws + WS_CSQ) + l * PQ : (float*)(ws + WS_CSIN) + l * NPROJ;
                cs[isq ? j0 + lane : win_pos(j0 + lane)] = m * (1.0f / 127.0f);
            }
            __syncthreads();
        }
    }
    {
        LAS float* scr = (LAS float*)(lds + 32768 + wave * 8448);
        constexpr int I_BR = 8 * 32, I_OUT = 16 * 32, I_L = 2 * I_BR + I_OUT;
        for (int it = gw; it < DEPTH * I_L; it += NGW) {
            const int l = it / I_L; int r = it % I_L;
            if (r < I_BR) { transpose_item<false>(a.wbr_a + (size_t)l * 512 * 1024, 512, 1024, (bf16_t*)(ws + WS_WBA) + (size_t)l * 1024 * 512, scr, r, lane); continue; } r -= I_BR;
            if (r < I_BR) { transpose_item<false>(a.wbr_b + (size_t)l * 512 * 1024, 512, 1024, (bf16_t*)(ws + WS_WBB) + (size_t)l * 1024 * 512, scr, r, lane); continue; } r -= I_BR;
            transpose_item<false>(a.w_out + (size_t)l * 1024 * 1024, 1024, 1024, (bf16_t*)(ws + WS_WOUT) + (size_t)l * 1024 * 1024, scr, r, lane);
        }
    }
    {
        const int gt = op_bid() * NTHREADS + tid, NGT = G * NTHREADS;
        for (int i = gt; i < DEPTH * 8 * 2 * 128 * 128 / 8; i += NGT) {
            const f32x4 v0 = *(const f32x4*)(a.subkeys + (size_t)i * 8), v1 = *(const f32x4*)(a.subkeys + (size_t)i * 8 + 4);
            u32x4 o; o.x = pk2(v0.x, v0.y); o.y = pk2(v0.z, v0.w); o.z = pk2(v1.x, v1.y); o.w = pk2(v1.z, v1.w);
            *(u32x4*)((bf16_t*)(ws + WS_SK) + (size_t)i * 8) = o;
        }
        for (int i = gt; i < T * 32; i += NGT) {
            const int t = i >> 5, f = i & 31;
            double inv = 1.0;
            for (int k = 0; k < f; ++k) inv *= 0.7498942093324559;
            const double ang = (double)a.pos[t] * inv;
            const double kq = rint(ang * 0.63661977236758134308);
            const double r = fma(-kq, 6.123233995736766036e-17, fma(-kq, 1.57079632679489655800, ang));
            const int quad = (int)((long long)kq & 3);
            const double r2 = r * r;
            double sp = -1.0 / 1307674368000.0; sp = fma(sp, r2, 1.0 / 6227020800.0); sp = fma(sp, r2, -1.0 / 39916800.0); sp = fma(sp, r2, 1.0 / 362880.0);
            sp = fma(sp, r2, -1.0 / 5040.0); sp = fma(sp, r2, 1.0 / 120.0); sp = fma(sp, r2, -1.0 / 6.0); sp = fma(sp * r2, r, r);
            double cp = 1.0 / 20922789888000.0; cp = fma(cp, r2, -1.0 / 87178291200.0); cp = fma(cp, r2, 1.0 / 479001600.0); cp = fma(cp, r2, -1.0 / 3628800.0);
            cp = fma(cp, r2, 1.0 / 40320.0); cp = fma(cp, r2, -1.0 / 720.0); cp = fma(cp, r2, 1.0 / 24.0); cp = fma(cp, r2, -0.5); cp = fma(cp, r2, 1.0);
            const double sn = (quad == 0) ? sp : (quad == 1) ? cp : (quad == 2) ? -sp : -cp;
            const double cs = (quad == 0) ? cp : (quad == 1) ? -sp : (quad == 2) ? -cp : sp;
            float* rp = (float*)(ws + WS_ROPE) + (size_t)i * 2; rp[0] = (float)cs; rp[1] = (float)sn;
        }
    }
    if (op_bid() == 0) for (int i = tid; i < DEPTH * 2 * 8 * 64; i += NTHREADS) ((unsigned*)(ws + WS_CTL))[CTL_QUEUE + i] = 0u;
}

__device__ __forceinline__ void ph_prologue_b(const KArgs& a, LAS unsigned char* lds, int wv) {
    const int tid = phase_tid(wv), lane = tid & 63, wave = wv;
    const int gw = op_bid() * NWAVES + wave, NGW = op_grid() * NWAVES;
    unsigned char* ws = a.ws;
    LAS float* scr = (LAS float*)(lds + wave * 8448);
    constexpr int I_IN = 16 * 136, I_Q = 16 * 64, I_L = I_IN + I_Q;
    for (int it = gw; it < DEPTH * I_L; it += NGW) {
        const int l = it / I_L, r = it % I_L;
        if (r < I_IN) transpose_item_i8<true>(a.w_in + (size_t)l * 1024 * NPROJ, 1024, NPROJ, ws + WS_WIN + (size_t)l * NPROJ * 1024, (const float*)(ws + WS_CSIN) + l * NPROJ, scr, r, lane);
        else transpose_item_i8<false>(a.wq + (size_t)l * 1024 * PQ, 1024, PQ, ws + WS_WQ + (size_t)l * PQ * 1024, (const float*)(ws + WS_CSQ) + l * PQ, scr, r - I_IN, lane);
    }
}

template <bool XF32>
__device__ __forceinline__ void ph_norm(const KArgs& a, const void* xin, const float* g, const float* mod_l, int shift_idx, int scale_idx, unsigned char* dst, float* dscale, int wv) {
    const int tid = phase_tid(wv), lane = tid & 63, wave = wv;
    const int gw = op_bid() * NWAVES + wave, NGW = op_grid() * NWAVES;
    constexpr int RU = 16, RG = 4;
    for (int unit = gw; unit < T / RU; unit += NGW) {
        const int row0 = unit * RU, b = row0 >> 12;
        f32x4 gs[4], sh[4];
#pragma unroll
        for (int i = 0; i < 4; ++i) {
            const int col = 256 * i + 4 * lane;
            const f32x4 gg = *(const f32x4*)(g + col), sc = *(const f32x4*)(mod_l + (size_t)b * NMOD + scale_idx * DM + col);
            sh[i] = *(const f32x4*)(mod_l + (size_t)b * NMOD + shift_idx * DM + col); gs[i] = gg * (sc + 1.0f);
        }
#pragma unroll 1
        for (int r0 = 0; r0 < RU; r0 += RG) {
            f32x4 v[RG][4];
            if (XF32) {
#pragma unroll
                for (int j = 0; j < RG; ++j)
#pragma unroll
                    for (int i = 0; i < 4; ++i) v[j][i] = ((const f32x4*)((const float*)xin + (size_t)(row0 + r0 + j) * DM))[64 * i + lane];
            } else {
                u32x2 xv[RG][4];
#pragma unroll
                for (int j = 0; j < RG; ++j)
#pragma unroll
                    for (int i = 0; i < 4; ++i) xv[j][i] = ((const u32x2*)((const bf16_t*)xin + (size_t)(row0 + r0 + j) * DM))[64 * i + lane];
#pragma unroll
                for (int j = 0; j < RG; ++j)
#pragma unroll
                    for (int i = 0; i < 4; ++i) v[j][i] = (f32x4){bflo(xv[j][i].x), bfhi(xv[j][i].x), bflo(xv[j][i].y), bfhi(xv[j][i].y)};
            }
            float ss[RG];
#pragma unroll
            for (int j = 0; j < RG; ++j) { ss[j] = 0.f;
#pragma unroll
                for (int i = 0; i < 4; ++i) ss[j] += (v[j][i].x * v[j][i].x + v[j][i].y * v[j][i].y) + (v[j][i].z * v[j][i].z + v[j][i].w * v[j][i].w); }
#pragma unroll
            for (int j = 0; j < RG; ++j) ss[j] = wave_sum_dpp(ss[j]);
#pragma unroll
            for (int j = 0; j < RG; ++j) { const float r = 1.0f / sqrtf(ss[j] * (1.0f / DM) + NORM_EPS);
#pragma unroll
                for (int i = 0; i < 4; ++i) v[j][i] = (v[j][i] * r) * gs[i] + sh[i]; }
#pragma unroll
            for (int j = 0; j < RG; ++j) quant_row_nat(v[j], dst + (size_t)(row0 + r0 + j) * 1024, dscale + row0 + r0 + j, lane);
        }
    }
}
__device__ __forceinline__ void ph_final_norm(const KArgs& a, int wv) {
    const int tid = phase_tid(wv), lane = tid & 63, wave = wv;
    const int gw = op_bid() * NWAVES + wave, NGW = op_grid() * NWAVES;
    for (int row = gw; row < T; row += NGW) {
        f32x4 v[4]; float ss = 0.f;
#pragma unroll
        for (int i = 0; i < 4; ++i) { const u32x2 xv = ((const u32x2*)((const bf16_t*)(a.ws + WS_XB) + (size_t)row * DM))[64 * i + lane]; v[i] = (f32x4){bflo(xv.x), bfhi(xv.x), bflo(xv.y), bfhi(xv.y)};
            ss += (v[i].x * v[i].x + v[i].y * v[i].y) + (v[i].z * v[i].z + v[i].w * v[i].w); }
        ss = wave_sum(ss);
        const float r = 1.0f / sqrtf(ss * (1.0f / DM) + NORM_EPS);
#pragma unroll
        for (int i = 0; i < 4; ++i) { const f32x4 gg = *(const f32x4*)(a.final_g + 256 * i + 4 * lane); ((f32x4*)(a.out + (size_t)row * DM))[64 * i + lane] = (v[i] * r) * gg; }
    }
}

struct EpiProj {
    static constexpr bool PERM = true, AFTER_DRAIN = false;
    unsigned char* ws;
    __device__ __forceinline__ void operator()(const pg8::f32x4 (&acc)[2][2][4][2], const pg8::Unit& u, int wr, int wc, int fr, int fq) const {
        const int row0 = u.pm * 256 + wr * 64 + fr;
        const float* rope = (const float*)(ws + WS_ROPE);
#pragma unroll
        for (int bj = 0; bj < 2; ++bj) {
            const int cgb = u.pn * 256 + bj * 128;
            bf16_t* base; int pitch, cl, mode;
            if (cgb < 512) { base = (bf16_t*)(ws + WS_QA); pitch = 512; cl = cgb; mode = 1; }
            else if (cgb < 640) { base = (bf16_t*)(ws + WS_KA); pitch = 128; cl = cgb - 512; mode = 2; }
            else if (cgb < 768) { base = (bf16_t*)(ws + WS_VA); pitch = 128; cl = cgb - 640; mode = 0; }
            else if (cgb < 1280) { base = (bf16_t*)(ws + WS_QB); pitch = 512; cl = cgb - 768; mode = 3; }
            else if (cgb < 1792) { base = (bf16_t*)(ws + WS_KB); pitch = 512; cl = cgb - 1280; mode = 0; }
            else if (cgb < 2304) { base = (bf16_t*)(ws + WS_VB); pitch = 512; cl = cgb - 1792; mode = 0; }
            else if (cgb < 3328) { base = (bf16_t*)(ws + WS_GA); pitch = 1024; cl = cgb - 2304; mode = 4; }
            else { base = (bf16_t*)(ws + WS_GB); pitch = 1024; cl = cgb - 3328; mode = 4; }
            const int col = cl + wc * 32 + 8 * fq;
#pragma unroll
            for (int ai = 0; ai < 2; ++ai)
#pragma unroll
                for (int m = 0; m < 4; ++m) {
                    const int row = row0 + ai * 128 + m * 16;
                    pg8::f32x4 v0 = acc[ai][bj][m][0], v1 = acc[ai][bj][m][1];
                    if (mode == 1 || mode == 2) {
                        const int i0 = (col & 63) >> 1;
                        const f32x4 c01 = *(const f32x4*)(rope + ((size_t)row * 32 + i0) * 2), c23 = *(const f32x4*)(rope + ((size_t)row * 32 + i0 + 2) * 2);
                        pg8::f32x4 w0, w1;
                        w0[0] = v0[0] * c01.x - v0[1] * c01.y; w0[1] = v0[1] * c01.x + v0[0] * c01.y;
                        w0[2] = v0[2] * c01.z - v0[3] * c01.w; w0[3] = v0[3] * c01.z + v0[2] * c01.w;
                        w1[0] = v1[0] * c23.x - v1[1] * c23.y; w1[1] = v1[1] * c23.x + v1[0] * c23.y;
                        w1[2] = v1[2] * c23.z - v1[3] * c23.w; w1[3] = v1[3] * c23.z + v1[2] * c23.w;
                        v0 = w0; v1 = w1;
                    }
                    if (mode == 1 || mode == 3) { v0 = v0 * QSCALE; v1 = v1 * QSCALE; }
                    if (mode == 4) {
#pragma unroll
                        for (int e = 0; e < 4; ++e) { v0[e] = 1.0f / (1.0f + __expf(-v0[e])); v1[e] = 1.0f / (1.0f + __expf(-v1[e])); }
                    }
                    u32x4 w; w.x = pk2(v0[0], v0[1]); w.y = pk2(v0[2], v0[3]); w.z = pk2(v1[0], v1[1]); w.w = pk2(v1[2], v1[3]);
                    *(u32x4*)(base + (size_t)row * pitch + col) = w;
                }
        }
    }
};
template <class EpiF> struct EpiI8 {
    static constexpr bool PERM = true, AFTER_DRAIN = false;
    static_assert(EpiF::PERM, "EpiI8 wraps PERM = true epilogues");
    EpiF F; const float* rowscale; const float* colscale;
    __device__ __forceinline__ void operator()(const pg8::i32x4 (&acc)[2][2][4][2], const pg8::Unit& u, int wr, int wc, int fr, int fq) const {
        const int row0 = u.pm * 256 + wr * 64 + fr, col0 = u.pn * 256 + wc * 32 + 8 * fq;
        pg8::f32x4 f[2][2][4][2], cs[2][2];
#pragma unroll
        for (int bj = 0; bj < 2; ++bj)
#pragma unroll
            for (int n = 0; n < 2; ++n) cs[bj][n] = *(const pg8::f32x4*)(colscale + col0 + bj * 128 + 4 * n);
#pragma unroll
        for (int ai = 0; ai < 2; ++ai)
#pragma unroll
            for (int m = 0; m < 4; ++m) { const float hs = rowscale[row0 + ai * 128 + m * 16];
#pragma unroll
                for (int bj = 0; bj < 2; ++bj)
#pragma unroll
                    for (int n = 0; n < 2; ++n) f[ai][bj][m][n] = __builtin_convertvector(acc[ai][bj][m][n], pg8::f32x4) * cs[bj][n] * hs; }
        F(f, u, wr, wc, fr, fq);
    }
};
template <bool ADD> struct EpiBranch {
    static constexpr bool PERM = true, AFTER_DRAIN = false;
    const bf16_t* Gt; bf16_t* O;
    __device__ __forceinline__ void operator()(const pg8::f32x4 (&acc)[2][2][4][2], const pg8::Unit& u, int wr, int wc, int fr, int fq) const {
        const int row0 = u.pm * 256 + wr * 64 + fr, col0 = u.pn * 256 + wc * 32 + 8 * fq;
#pragma unroll
        for (int ai = 0; ai < 2; ++ai) {
            u32x4 gv[4][2], ov[4][2];
#pragma unroll
            for (int m = 0; m < 4; ++m)
#pragma unroll
                for (int bj = 0; bj < 2; ++bj) {
                    const size_t off = (size_t)(row0 + ai * 128 + m * 16) * DM + col0 + bj * 128;
                    gv[m][bj] = *(const u32x4*)(Gt + off);
                    if (ADD) ov[m][bj] = *(const u32x4*)(O + off);
                }
#pragma unroll
            for (int m = 0; m < 4; ++m)
#pragma unroll
                for (int bj = 0; bj < 2; ++bj) {
                    const size_t off = (size_t)(row0 + ai * 128 + m * 16) * DM + col0 + bj * 128;
                    const u32x4 g4 = gv[m][bj];
                    const pg8::f32x4 v0 = acc[ai][bj][m][0], v1 = acc[ai][bj][m][1];
                    float r[8];
                    r[0] = bflo(g4.x) * v0[0]; r[1] = bfhi(g4.x) * v0[1]; r[2] = bflo(g4.y) * v0[2]; r[3] = bfhi(g4.y) * v0[3];
                    r[4] = bflo(g4.z) * v1[0]; r[5] = bfhi(g4.z) * v1[1]; r[6] = bflo(g4.w) * v1[2]; r[7] = bfhi(g4.w) * v1[3];
                    if (ADD) { const u32x4 o4 = ov[m][bj];
                        r[0] += bflo(o4.x); r[1] += bfhi(o4.x); r[2] += bflo(o4.y); r[3] += bfhi(o4.y); r[4] += bflo(o4.z); r[5] += bfhi(o4.z); r[6] += bflo(o4.w); r[7] += bfhi(o4.w); }
                    u32x4 w; w.x = pk2(r[0], r[1]); w.y = pk2(r[2], r[3]); w.z = pk2(r[4], r[5]); w.w = pk2(r[6], r[7]);
                    *(u32x4*)(O + off) = w;
                }
        }
    }
};
template <bool XF32> struct EpiWout {
    static constexpr bool PERM = true, AFTER_DRAIN = false;
    const void* xold; bf16_t* xnew; const float* gate;
    __device__ __forceinline__ void operator()(const pg8::f32x4 (&acc)[2][2][4][2], const pg8::Unit& u, int wr, int wc, int fr, int fq) const {
        const int row0 = u.pm * 256 + wr * 64 + fr, col0 = u.pn * 256 + wc * 32 + 8 * fq, b = u.pm >> 4;
        pg8::f32x4 gt[2][2];
#pragma unroll
        for (int bj = 0; bj < 2; ++bj) { gt[bj][0] = *(const pg8::f32x4*)(gate + (size_t)b * NMOD + col0 + bj * 128); gt[bj][1] = *(const pg8::f32x4*)(gate + (size_t)b * NMOD + col0 + bj * 128 + 4); }
#pragma unroll
        for (int ai = 0; ai < 2; ++ai) {
            pg8::f32x4 xf[XF32 ? 4 : 1][2][2]; u32x4 xb[XF32 ? 1 : 4][2];
#pragma unroll
            for (int m = 0; m < 4; ++m)
#pragma unroll
                for (int bj = 0; bj < 2; ++bj) { const size_t off = (size_t)(row0 + ai * 128 + m * 16) * DM + col0 + bj * 128;
                    if constexpr (XF32) { xf[m][bj][0] = *(const pg8::f32x4*)((const float*)xold + off); xf[m][bj][1] = *(const pg8::f32x4*)((const float*)xold + off + 4); }
                    else xb[m][bj] = *(const u32x4*)((const bf16_t*)xold + off); }
#pragma unroll
            for (int m = 0; m < 4; ++m)
#pragma unroll
                for (int bj = 0; bj < 2; ++bj) { const size_t off = (size_t)(row0 + ai * 128 + m * 16) * DM + col0 + bj * 128;
                    pg8::f32x4 x0, x1;
                    if constexpr (XF32) { x0 = xf[m][bj][0]; x1 = xf[m][bj][1]; }
                    else { const u32x4 xv = xb[m][bj]; x0 = (pg8::f32x4){bflo(xv.x), bfhi(xv.x), bflo(xv.y), bfhi(xv.y)}; x1 = (pg8::f32x4){bflo(xv.z), bfhi(xv.z), bflo(xv.w), bfhi(xv.w)}; }
                    x0 = x0 + gt[bj][0] * acc[ai][bj][m][0]; x1 = x1 + gt[bj][1] * acc[ai][bj][m][1];
                    u32x4 w; w.x = pk2(x0[0], x0[1]); w.y = pk2(x0[2], x0[3]); w.z = pk2(x1[0], x1[1]); w.w = pk2(x1[2], x1[3]);
                    *(u32x4*)(xnew + off) = w; }
        }
    }
};
struct EpiPlainBf16 {
    static constexpr bool PERM = true, AFTER_DRAIN = false;
    bf16_t* O; int ldc;
    __device__ __forceinline__ void operator()(const pg8::f32x4 (&acc)[2][2][4][2], const pg8::Unit& u, int wr, int wc, int fr, int fq) const {
        const int row0 = u.pm * 256 + wr * 64 + fr, col0 = u.pn * 256 + wc * 32 + 8 * fq;
#pragma unroll
        for (int ai = 0; ai < 2; ++ai)
#pragma unroll
            for (int m = 0; m < 4; ++m)
#pragma unroll
                for (int bj = 0; bj < 2; ++bj) {
                    const pg8::f32x4 v0 = acc[ai][bj][m][0], v1 = acc[ai][bj][m][1];
                    u32x4 w; w.x = pk2(v0[0], v0[1]); w.y = pk2(v0[2], v0[3]); w.z = pk2(v1[0], v1[1]); w.w = pk2(v1[2], v1[3]);
                    *(u32x4*)(O + (size_t)(row0 + ai * 128 + m * 16) * ldc + col0 + bj * 128) = w;
                }
    }
};

namespace att {
typedef short bf16x8 __attribute__((ext_vector_type(8)));
typedef short s16x4 __attribute__((ext_vector_type(4)));
typedef float f32x16 __attribute__((ext_vector_type(16)));
__device__ __forceinline__ int crow(int r, int hi) { return (r & 3) + 8 * (r >> 2) + 4 * hi; }
typedef float f32x2_t __attribute__((ext_vector_type(2))); typedef __bf16 bf16x2_t __attribute__((ext_vector_type(2)));
__device__ __forceinline__ unsigned cvtpk(float lo, float hi) { f32x2_t v = {lo, hi}; bf16x2_t b = __builtin_convertvector(v, bf16x2_t); return __builtin_bit_cast(unsigned, b); }
#define ATT_SBAR() __builtin_amdgcn_sched_barrier(0)

__device__ __forceinline__ void qkt(f32x16& p0, f32x16& p1, const LAS unsigned char* kslot, const bf16x8 (&qr)[4], int r32, int hi) {
    const LAS unsigned char* kb = kslot + hi * 1024 + r32 * 16;
    p0 = f32x16{}; p1 = f32x16{};
#pragma unroll
    for (int d0 = 0; d0 < 4; ++d0) {
        const bf16x8 b0 = *(const LAS bf16x8*)(kb + d0 * 2048);
        const bf16x8 b1 = *(const LAS bf16x8*)(kb + d0 * 2048 + 512);
        p0 = __builtin_amdgcn_mfma_f32_32x32x16_bf16(b0, qr[d0], p0, 0, 0, 0);
        p1 = __builtin_amdgcn_mfma_f32_32x32x16_bf16(b1, qr[d0], p1, 0, 0, 0);
    }
}
__device__ __forceinline__ void pv(f32x16 (&o)[2], int vb, bf16x8 pa0, bf16x8 pa1, bf16x8 pa2, bf16x8 pa3) {
#pragma unroll
    for (int d0 = 0; d0 < 2; ++d0) {
        s16x4 lo[4], hh[4];
#pragma unroll
        for (int ks = 0; ks < 4; ++ks) {
            asm volatile("ds_read_b64_tr_b16 %0,%1 offset:%c2" : "=&v"(lo[ks]) : "v"(vb), "i"(d0 * 4096 + ks * 1024) : "memory");
            asm volatile("ds_read_b64_tr_b16 %0,%1 offset:%c2" : "=&v"(hh[ks]) : "v"(vb), "i"(d0 * 4096 + ks * 1024 + 512) : "memory");
        }
        asm volatile("s_waitcnt lgkmcnt(0)" ::: "memory"); ATT_SBAR();
#define ATT_PK(k) (bf16x8){lo[k][0], lo[k][1], lo[k][2], lo[k][3], hh[k][0], hh[k][1], hh[k][2], hh[k][3]}
        o[d0] = __builtin_amdgcn_mfma_f32_32x32x16_bf16(pa0, ATT_PK(0), o[d0], 0, 0, 0);
        o[d0] = __builtin_amdgcn_mfma_f32_32x32x16_bf16(pa1, ATT_PK(1), o[d0], 0, 0, 0);
        o[d0] = __builtin_amdgcn_mfma_f32_32x32x16_bf16(pa2, ATT_PK(2), o[d0], 0, 0, 0);
        o[d0] = __builtin_amdgcn_mfma_f32_32x32x16_bf16(pa3, ATT_PK(3), o[d0], 0, 0, 0);
#undef ATT_PK
    }
}
__device__ __forceinline__ void pack_p(const f32x16& p0, const f32x16& p1, bf16x8& pa0, bf16x8& pa1, bf16x8& pa2, bf16x8& pa3) {
    u32x4 w0, w1, w2, w3;
    w0 = (u32x4){cvtpk(p0[0], p0[1]), cvtpk(p0[2], p0[3]), cvtpk(p0[4], p0[5]), cvtpk(p0[6], p0[7])};
    w1 = (u32x4){cvtpk(p0[8], p0[9]), cvtpk(p0[10], p0[11]), cvtpk(p0[12], p0[13]), cvtpk(p0[14], p0[15])};
    w2 = (u32x4){cvtpk(p1[0], p1[1]), cvtpk(p1[2], p1[3]), cvtpk(p1[4], p1[5]), cvtpk(p1[6], p1[7])};
    w3 = (u32x4){cvtpk(p1[8], p1[9]), cvtpk(p1[10], p1[11]), cvtpk(p1[12], p1[13]), cvtpk(p1[14], p1[15])};
    pa0 = __builtin_bit_cast(bf16x8, w0); pa1 = __builtin_bit_cast(bf16x8, w1); pa2 = __builtin_bit_cast(bf16x8, w2); pa3 = __builtin_bit_cast(bf16x8, w3);
}
__device__ __forceinline__ u32x4 tile_gload(const bf16_t* src, int pitch, int tid) { return *(const u32x4*)(src + (size_t)(tid >> 3) * pitch + (tid & 7) * 8); }
__device__ __forceinline__ void tile_kwrite(LAS unsigned char* kslot, u32x4 v, int tid) { *(LAS u32x4*)(kslot + (tid & 7) * 1024 + (tid >> 3) * 16) = v; }
__device__ __forceinline__ void tile_vwrite(LAS unsigned char* vslot, u32x4 v, int tid) { const int c = tid & 7; *(LAS u32x4*)(vslot + (c >> 2) * 4096 + (tid >> 3) * 64 + (c & 3) * 16) = v; }
__device__ __forceinline__ void store_o(const f32x16 (&o)[2], const float (&rs)[16], LAS unsigned char* stage, bf16_t* Ow, int pitch, int lane) {
    asm volatile("" : "+v"(lane));
    const int r32 = lane & 31, hi = lane >> 5;
    LAS bf16_t* stg = (LAS bf16_t*)stage;
#pragma unroll
    for (int r = 0; r < 16; ++r) { const int orow = crow(r, hi);
#pragma unroll
        for (int d0 = 0; d0 < 2; ++d0) stg[orow * 64 + d0 * 32 + r32] = (bf16_t)f2bf(o[d0][r] * rs[r]); }
    asm volatile("s_waitcnt lgkmcnt(0)" ::: "memory");
#pragma unroll
    for (int i = 0; i < 4; ++i) { const int row = i * 8 + (lane >> 3), ch = lane & 7; const u32x4 v = *(const LAS u32x4*)(stg + row * 64 + ch * 8); *(u32x4*)(Ow + (size_t)row * pitch + ch * 8) = v; }
    asm volatile("s_waitcnt lgkmcnt(0)" ::: "memory");
}

constexpr int SB_WLDS = 16384;
template <bool EARLY_EXIT>
__device__ __forceinline__ void sb_unit(const bf16_t* Q, const bf16_t* K, const bf16_t* V, bf16_t* O, LAS unsigned char* vimg, int b, int h, int rb, int lane, int wv) {
    const int r32 = lane & 31, hi = lane >> 5;
    const int vb0 = (int)(unsigned)(uintptr_t)vimg + ((lane >> 4) & 1) * 32 + (lane & 3) * 8 + (4 * hi + ((lane & 15) >> 2)) * 64;
    const int vwoff = ((lane & 7) >> 2) * 4096 + (lane >> 3) * 64 + (lane & 3) * 16;
    const float m0 = hi == 0 ? 1.0f : 0.0f;
    {
        const int R0 = rb * 32;
        const size_t rowbase = (size_t)b * SEQ;
        const char* Kb = (const char*)(K + rowbase * 512 + h * 64); const char* Vb = (const char*)(V + rowbase * 512 + h * 64);
        const unsigned koff = (unsigned)(r32 * 1024 + hi * 16), voff = (unsigned)((lane >> 3) * 1024 + (lane & 7) * 16);
        const bf16_t* Qw = Q + (rowbase + R0) * 512 + h * 64;
        bf16x8 qr[4];
#pragma unroll
        for (int d0 = 0; d0 < 4; ++d0) qr[d0] = *(const bf16x8*)((const char*)Qw + koff + d0 * 32);
        int kt = R0 >> 6;
        u32x4 kr[8], vr[8];
        LAS unsigned char* kimg = vimg + 8192;
        const int kwoff = (lane >> 3) * 128 + (((lane & 7) ^ ((lane >> 4) & 7)) << 4);
        const int krd = r32 * 128, kx = (r32 >> 1) & 7;
#define SB_LOADK(KT) do { const char* k0_ = Kb + (size_t)(KT) * 65536; _Pragma("unroll") for (int i = 0; i < 8; ++i) kr[i] = *(const u32x4*)(k0_ + i * 8192 + voff); } while (0)
#define SB_LOADV(KT) do { const char* v0_ = Vb + (size_t)(KT) * 65536; _Pragma("unroll") for (int i = 0; i < 8; ++i) vr[i] = *(const u32x4*)(v0_ + i * 8192 + voff); } while (0)
        SB_LOADK(kt); SB_LOADV(kt);
        f32x16 o[2]; o[0] = f32x16{}; o[1] = f32x16{};
        float carry = 0.f;
        for (;;) {
#pragma unroll
            for (int i = 0; i < 8; ++i) *(LAS u32x4*)(kimg + (kwoff ^ ((i & 1) << 6)) + i * 1024) = kr[i];
            f32x16 p0 = f32x16{}, p1 = f32x16{};
#pragma unroll
            for (int d0 = 0; d0 < 4; ++d0) {
                const int co = ((2 * d0 + hi) ^ kx) << 4;
                const bf16x8 k0f = *(const LAS bf16x8*)(kimg + krd + co), k1f = *(const LAS bf16x8*)(kimg + krd + co + 4096);
                p0 = __builtin_amdgcn_mfma_f32_32x32x16_bf16(k0f, qr[d0], p0, 0, 0, 0); p1 = __builtin_amdgcn_mfma_f32_32x32x16_bf16(k1f, qr[d0], p1, 0, 0, 0);
            }
            const bool more = kt > 0;
#pragma unroll
            for (int i = 0; i < 8; ++i) *(LAS u32x4*)(vimg + vwoff + i * 512) = vr[i];
            if (more) { SB_LOADK(kt - 1); SB_LOADV(kt - 1); }
            const int D = R0 - 64 * kt;
            if (D < 64) {
                const int thr = D + r32 - 4 * hi;
#pragma unroll
                for (int r = 0; r < 16; ++r) { const int cr = (r & 3) + 8 * (r >> 2); if (cr >= thr) p0[r] = -INFINITY; if (cr + 32 >= thr) p1[r] = -INFINITY; }
            }
            float tt[8], uu[8];
#define SB_SP(x) (fmaxf(x, 0.f) + __builtin_amdgcn_logf(1.0f + __builtin_amdgcn_exp2f(-fabsf(x))))
#pragma unroll
            for (int i = 0; i < 4; ++i) {
                float s3 = SB_SP(p0[4 * i + 3]), s2 = s3 + SB_SP(p0[4 * i + 2]), s1 = s2 + SB_SP(p0[4 * i + 1]), s0 = s1 + SB_SP(p0[4 * i]);
                p0[4 * i + 3] -= s3; p0[4 * i + 2] -= s2; p0[4 * i + 1] -= s1; p0[4 * i] -= s0; tt[i] = s0;
                s3 = SB_SP(p1[4 * i + 3]); s2 = s3 + SB_SP(p1[4 * i + 2]); s1 = s2 + SB_SP(p1[4 * i + 1]); s0 = s1 + SB_SP(p1[4 * i]);
                p1[4 * i + 3] -= s3; p1[4 * i + 2] -= s2; p1[4 * i + 1] -= s1; p1[4 * i] -= s0; tt[4 + i] = s0;
                __builtin_amdgcn_sched_barrier(0);
            }
#undef SB_SP
#pragma unroll
            for (int k = 0; k < 8; ++k) { auto rr = __builtin_amdgcn_permlane32_swap(__float_as_uint(tt[k]), __float_as_uint(tt[k]), false, false); uu[k] = __uint_as_float(hi ? rr[0] : rr[1]); }
            float sw = 0.f;
#pragma unroll
            for (int k = 7; k >= 0; --k) {
                const float bs = carry - (sw + m0 * uu[k]); sw += tt[k] + uu[k];
                if (k < 4) { p0[4 * k] = __builtin_amdgcn_exp2f(p0[4 * k] + bs); p0[4 * k + 1] = __builtin_amdgcn_exp2f(p0[4 * k + 1] + bs); p0[4 * k + 2] = __builtin_amdgcn_exp2f(p0[4 * k + 2] + bs); p0[4 * k + 3] = __builtin_amdgcn_exp2f(p0[4 * k + 3] + bs); }
                else { const int i = k - 4; p1[4 * i] = __builtin_amdgcn_exp2f(p1[4 * i] + bs); p1[4 * i + 1] = __builtin_amdgcn_exp2f(p1[4 * i + 1] + bs); p1[4 * i + 2] = __builtin_amdgcn_exp2f(p1[4 * i + 2] + bs); p1[4 * i + 3] = __builtin_amdgcn_exp2f(p1[4 * i + 3] + bs); }
            }
            carry -= sw;
            bf16x8 pa0, pa1, pa2, pa3; pack_p(p0, p1, pa0, pa1, pa2, pa3);
            pv(o, vb0, pa0, pa1, pa2, pa3);
            if (!more) break;
            if (EARLY_EXIT && __all(carry < -SB_EXIT)) break;
            --kt;
        }
        float ones[16];
#pragma unroll
        for (int r = 0; r < 16; ++r) ones[r] = 1.0f;
        store_o(o, ones, vimg, O + (rowbase + R0) * 512 + h * 64, 512, phase_tid(wv) & 63);
    }
#undef SB_LOADK
#undef SB_LOADV
}

__device__ __forceinline__ void swa_unit(const bf16_t* Q, const bf16_t* K, const bf16_t* V, bf16_t* O, const float* sinks, LAS unsigned char* vimg, int b, int hq, int rb, int lane, int wv) {
    const int r32 = lane & 31, hi = lane >> 5, kvh = hq >> 2;
    const int vb0 = (int)(unsigned)(uintptr_t)vimg + ((lane >> 4) & 1) * 32 + (lane & 3) * 8 + (4 * hi + ((lane & 15) >> 2)) * 64;
    const int vwoff = ((lane & 7) >> 2) * 4096 + (lane >> 3) * 64 + (lane & 3) * 16;
    {
        const int R0 = rb * 32, a = R0 >> 6;
        const size_t rowbase = (size_t)b * SEQ;
        const char* Kb = (const char*)(K + rowbase * 128 + kvh * 64); const char* Vb = (const char*)(V + rowbase * 128 + kvh * 64);
        const unsigned koff = (unsigned)(r32 * 256 + hi * 16), voff = (unsigned)((lane >> 3) * 256 + (lane & 7) * 16);
        const bf16_t* Qw = Q + (rowbase + R0) * 512 + hq * 64;
        bf16x8 qr[4];
#pragma unroll
        for (int d0 = 0; d0 < 4; ++d0) qr[d0] = *(const bf16x8*)((const char*)Qw + (unsigned)(r32 * 1024 + hi * 16) + d0 * 32);
        const float sink2 = sinks[hq] * LOG2E;
        u32x4 kr[8];
        LAS unsigned char* kimg = vimg + 8192;
        const int kwoff = (lane >> 3) * 128 + (((lane & 7) ^ ((lane >> 4) & 7)) << 4);
        const int krd = r32 * 128, kx = (r32 >> 1) & 7;
#define SW_LOADK(KT) do { const char* k0_ = Kb + (size_t)(KT) * 16384; _Pragma("unroll") for (int i = 0; i < 8; ++i) kr[i] = *(const u32x4*)(k0_ + i * 2048 + voff); } while (0)
#define SW_QKT(P0, P1) do { _Pragma("unroll") for (int i = 0; i < 8; ++i) *(LAS u32x4*)(kimg + (kwoff ^ ((i & 1) << 6)) + i * 1024) = kr[i]; \
        P0 = f32x16{}; P1 = f32x16{}; _Pragma("unroll") for (int d0 = 0; d0 < 4; ++d0) { const int co = ((2 * d0 + hi) ^ kx) << 4; \
            const bf16x8 k0f = *(const LAS bf16x8*)(kimg + krd + co), k1f = *(const LAS bf16x8*)(kimg + krd + co + 4096); \
            P0 = __builtin_amdgcn_mfma_f32_32x32x16_bf16(k0f, qr[d0], P0, 0, 0, 0); P1 = __builtin_amdgcn_mfma_f32_32x32x16_bf16(k1f, qr[d0], P1, 0, 0, 0); } } while (0)
        const int kt_lo = a >= 2 ? a - 2 : 0;
        float m = sink2;
        SW_LOADK(kt_lo);
        for (int kt = kt_lo; kt <= a; ++kt) {
            f32x16 p0, p1; SW_QKT(p0, p1);
            if (kt < a) SW_LOADK(kt + 1);
            const int thr = R0 - 64 * kt + r32 - 4 * hi;
#pragma unroll
            for (int r = 0; r < 16; ++r) { const int cr = (r & 3) + 8 * (r >> 2);
                const bool v0 = cr <= thr && cr > thr - 128, v1 = cr + 32 <= thr && cr + 32 > thr - 128;
                m = fmaxf(m, fmaxf(v0 ? p0[r] : -INFINITY, v1 ? p1[r] : -INFINITY)); }
        }
        { auto rr = __builtin_amdgcn_permlane32_swap(__float_as_uint(m), __float_as_uint(m), false, false); m = fmaxf(__uint_as_float(rr[0]), __uint_as_float(rr[1])); }
        float lsum = 0.f;
        f32x16 o[2]; o[0] = f32x16{}; o[1] = f32x16{};
        SW_LOADK(kt_lo);
        for (int kt = kt_lo; kt <= a; ++kt) {
            u32x4 vr[8];
            { const char* v0_ = Vb + (size_t)kt * 16384;
#pragma unroll
              for (int i = 0; i < 8; ++i) vr[i] = *(const u32x4*)(v0_ + i * 2048 + voff); }
            f32x16 p0, p1; SW_QKT(p0, p1);
            if (kt < a) SW_LOADK(kt + 1);
            const int thr = R0 - 64 * kt + r32 - 4 * hi;
#pragma unroll
            for (int r = 0; r < 16; ++r) { const int cr = (r & 3) + 8 * (r >> 2);
                const bool v0 = cr <= thr && cr > thr - 128, v1 = cr + 32 <= thr && cr + 32 > thr - 128;
                p0[r] = v0 ? __builtin_amdgcn_exp2f(p0[r] - m) : 0.f; p1[r] = v1 ? __builtin_amdgcn_exp2f(p1[r] - m) : 0.f; lsum += p0[r] + p1[r]; }
#pragma unroll
            for (int i = 0; i < 8; ++i) *(LAS u32x4*)(vimg + vwoff + i * 512) = vr[i];
            bf16x8 pa0, pa1, pa2, pa3; pack_p(p0, p1, pa0, pa1, pa2, pa3); pv(o, vb0, pa0, pa1, pa2, pa3);
        }
#undef SW_LOADK
#undef SW_QKT
        { auto rr = __builtin_amdgcn_permlane32_swap(__float_as_uint(lsum), __float_as_uint(lsum), false, false); lsum = __uint_as_float(rr[0]) + __uint_as_float(rr[1]); }
        lsum += __builtin_amdgcn_exp2f(sink2 - m);
        LAS float* wsf = (LAS float*)vimg;
        asm volatile("s_waitcnt lgkmcnt(0)" ::: "memory");
        if (hi == 0) wsf[r32] = 1.0f / lsum;
        asm volatile("s_waitcnt lgkmcnt(0)" ::: "memory");
        float rs[16];
#pragma unroll
        for (int r = 0; r < 16; ++r) rs[r] = wsf[crow(r, hi)];
        asm volatile("s_waitcnt lgkmcnt(0)" ::: "memory");
        store_o(o, rs, vimg, O + (rowbase + R0) * 512 + hq * 64, 512, phase_tid(wv) & 63);
    }
}
template <bool EARLY_EXIT>
__device__ __forceinline__ void attn_phase(const unsigned char* ws, const float* sinks, unsigned* cnt, LAS unsigned char* lds, int wv) {
    const int tid = phase_tid(wv), lane = tid & 63, wid = wv;
    LAS unsigned char* vimg = lds + wid * SB_WLDS;
    const unsigned home = (unsigned)op_bid() & 7u;
    unsigned ss = 0, x = home;
    unsigned nxt = 0u; if (lane == 0) nxt = __hip_atomic_fetch_add(cnt + 64 * x, 1u, __ATOMIC_RELAXED, __HIP_MEMORY_SCOPE_AGENT);
    for (;;) {
        const unsigned cur = (unsigned)__builtin_amdgcn_readfirstlane((int)nxt);
        if (cur >= 2048u) { if (++ss == 8u) break; x = (home + ss) & 7u; nxt = 0u; if (lane == 0) nxt = __hip_atomic_fetch_add(cnt + 64 * x, 1u, __ATOMIC_RELAXED, __HIP_MEMORY_SCOPE_AGENT); continue; }
        nxt = 0u; if (lane == 0) nxt = __hip_atomic_fetch_add(cnt + 64 * x, 1u, __ATOMIC_RELAXED, __HIP_MEMORY_SCOPE_AGENT);
        const int b = (int)(cur >> 7) & 7, rb = (int)(cur & 127u);
        if (cur < 1024u) sb_unit<EARLY_EXIT>((const bf16_t*)(ws + WS_QB), (const bf16_t*)(ws + WS_KB), (const bf16_t*)(ws + WS_VB), (bf16_t*)(ws + WS_QB), vimg, b, (int)x, rb, lane, wv);
        else swa_unit((const bf16_t*)(ws + WS_QA), (const bf16_t*)(ws + WS_KA), (const bf16_t*)(ws + WS_VA), (bf16_t*)(ws + WS_QA), sinks, vimg, b, (int)x, rb, lane, wv);
    }
}
}

namespace tk {
typedef short bf16x8 __attribute__((ext_vector_type(8)));
typedef float f32x16 __attribute__((ext_vector_type(16)));
__device__ __forceinline__ float vmax(float a, float b) { float r; asm("v_max_f32 %0, %1, %2" : "=v"(r) : "v"(a), "v"(b)); return r; }
__device__ __forceinline__ float vmin(float a, float b) { float r; asm("v_min_f32 %0, %1, %2" : "=v"(r) : "v"(a), "v"(b)); return r; }
#define TK_CE(a, b) { const float t_ = vmax(a, b); b = vmin(a, b); a = t_; }
__device__ __forceinline__ void sort16(float (&v)[16]) {
    TK_CE(v[0], v[1]) TK_CE(v[2], v[3]) TK_CE(v[0], v[2]) TK_CE(v[1], v[3]) TK_CE(v[1], v[2]) TK_CE(v[4], v[5]) TK_CE(v[6], v[7]) TK_CE(v[4], v[6])
    TK_CE(v[5], v[7]) TK_CE(v[5], v[6]) TK_CE(v[0], v[4]) TK_CE(v[2], v[6]) TK_CE(v[2], v[4]) TK_CE(v[1], v[5]) TK_CE(v[3], v[7]) TK_CE(v[3], v[5])
    TK_CE(v[1], v[2]) TK_CE(v[3], v[4]) TK_CE(v[5], v[6]) TK_CE(v[8], v[9]) TK_CE(v[10], v[11]) TK_CE(v[8], v[10]) TK_CE(v[9], v[11]) TK_CE(v[9], v[10])
    TK_CE(v[12], v[13]) TK_CE(v[14], v[15]) TK_CE(v[12], v[14]) TK_CE(v[13], v[15]) TK_CE(v[13], v[14]) TK_CE(v[8], v[12]) TK_CE(v[10], v[14]) TK_CE(v[10], v[12])
    TK_CE(v[9], v[13]) TK_CE(v[11], v[15]) TK_CE(v[11], v[13]) TK_CE(v[9], v[10]) TK_CE(v[11], v[12]) TK_CE(v[13], v[14]) TK_CE(v[0], v[8]) TK_CE(v[4], v[12])
    TK_CE(v[4], v[8]) TK_CE(v[2], v[10]) TK_CE(v[6], v[14]) TK_CE(v[6], v[10]) TK_CE(v[2], v[4]) TK_CE(v[6], v[8]) TK_CE(v[10], v[12]) TK_CE(v[1], v[9])
    TK_CE(v[5], v[13]) TK_CE(v[5], v[9]) TK_CE(v[3], v[11]) TK_CE(v[7], v[15]) TK_CE(v[7], v[11]) TK_CE(v[3], v[5]) TK_CE(v[7], v[9]) TK_CE(v[11], v[13])
    TK_CE(v[1], v[2]) TK_CE(v[3], v[4]) TK_CE(v[5], v[6]) TK_CE(v[7], v[8]) TK_CE(v[9], v[10]) TK_CE(v[11], v[12]) TK_CE(v[13], v[14])
}
__device__ __forceinline__ void bmerge16(float (&v)[16]) {
    TK_CE(v[0], v[8]) TK_CE(v[1], v[9]) TK_CE(v[2], v[10]) TK_CE(v[3], v[11]) TK_CE(v[4], v[12]) TK_CE(v[5], v[13]) TK_CE(v[6], v[14]) TK_CE(v[7], v[15])
    TK_CE(v[0], v[4]) TK_CE(v[1], v[5]) TK_CE(v[2], v[6]) TK_CE(v[3], v[7]) TK_CE(v[8], v[12]) TK_CE(v[9], v[13]) TK_CE(v[10], v[14]) TK_CE(v[11], v[15])
    TK_CE(v[0], v[2]) TK_CE(v[1], v[3]) TK_CE(v[4], v[6]) TK_CE(v[5], v[7]) TK_CE(v[8], v[10]) TK_CE(v[9], v[11]) TK_CE(v[12], v[14]) TK_CE(v[13], v[15])
    TK_CE(v[0], v[1]) TK_CE(v[2], v[3]) TK_CE(v[4], v[5]) TK_CE(v[6], v[7]) TK_CE(v[8], v[9]) TK_CE(v[10], v[11]) TK_CE(v[12], v[13]) TK_CE(v[14], v[15])
}

__device__ __forceinline__ void merge_top16(float (&a)[16], const float (&b)[16]) {
#pragma unroll
    for (int i = 0; i < 16; ++i) a[i] = vmax(a[i], b[15 - i]);
    bmerge16(a);
}
__device__ __forceinline__ float partner_f(float v, int hi) { auto rr = __builtin_amdgcn_permlane32_swap(__float_as_uint(v), __float_as_uint(v), false, false); return __uint_as_float(hi ? rr[0] : rr[1]); }
__device__ __forceinline__ void merge_partner(float (&a)[16], int hi) {
    float pp[16];
#pragma unroll
    for (int i = 0; i < 16; ++i) pp[i] = partner_f(a[i], hi);
    merge_top16(a, pp);
}
__device__ __forceinline__ void take_block(float (&v)[16], const f32x16& acc, int blk, unsigned hi4) {
#pragma unroll
    for (int r = 0; r < 16; ++r) { const unsigned code = 127u - (unsigned)(32 * blk + (r & 3) + 8 * (r >> 2)); v[r] = __uint_as_float(((__float_as_uint(acc[r]) & 0xFFFFFF80u) | code) ^ hi4); }
    sort16(v);
}
constexpr int TK_SK = 0, TK_IDX = 65536, TK_LDS_END = 65536 + 8192;
constexpr float TK_NEG = -3.4028234663852886e38f;
template <int P>
__device__ __forceinline__ void half_top16(float (&L)[16], const bf16_t* qrow, LAS unsigned char* lds, LAS unsigned char* idxslot, int r32, int hi) {
    bf16x8 qf[8];
#pragma unroll
    for (int ks = 0; ks < 8; ++ks) qf[ks] = *(const bf16x8*)(qrow + P * 128 + 16 * ks + 8 * hi);
    f32x16 acc[4];
#pragma unroll
    for (int blk = 0; blk < 4; ++blk) acc[blk] = f32x16{};
    const LAS unsigned char* ab = lds + TK_SK + P * 32768 + hi * 2048 + r32 * 16;
#pragma unroll
    for (int ks = 0; ks < 8; ++ks)
#pragma unroll
        for (int blk = 0; blk < 4; ++blk) {
            const bf16x8 af = *(const LAS bf16x8*)(ab + ks * 4096 + blk * 512);
            acc[blk] = __builtin_amdgcn_mfma_f32_32x32x16_bf16(af, qf[ks], acc[blk], 0, 0, 0);
        }
    const unsigned hi4 = (unsigned)hi << 2;
    float M[16];
    take_block(L, acc[0], 0, hi4); take_block(M, acc[1], 1, hi4); merge_top16(L, M);
    { float N[16]; take_block(M, acc[2], 2, hi4); take_block(N, acc[3], 3, hi4); merge_top16(M, N); }
    merge_top16(L, M);
    merge_partner(L, hi);
    if (hi == 0) {
        u32x4 w;
#pragma unroll
        for (int q = 0; q < 4; ++q) w[q] = (__float_as_uint(L[4 * q]) & 127u) | ((__float_as_uint(L[4 * q + 1]) & 127u) << 8) | ((__float_as_uint(L[4 * q + 2]) & 127u) << 16) | ((__float_as_uint(L[4 * q + 3]) & 127u) << 24);
        *(LAS u32x4*)(idxslot + P * 16) = w;
    }
}
__device__ __forceinline__ float cand(float x, float y, unsigned code, unsigned hi8) { return __uint_as_float((__float_as_uint(x + y) & 0xFFFFFE00u) | code | hi8); }

__device__ __forceinline__ void topk_phase(const bf16_t* Q2, const bf16_t* SKl, u32x4* UM, unsigned short* IDX16, const float* HS, LAS unsigned char* lds, int wv) {
        const int tid = phase_tid(wv), lane = tid & 63, r32 = lane & 31, hi = lane >> 5, wid = wv;
    LAS unsigned char* idxslot = lds + TK_IDX + wid * 1024 + r32 * 32;
    int cur_h = -1;
    for (int unit = op_bid(); unit < 8 * (T / 256); unit += op_grid()) {
        const int h = unit & 7, tb = unit >> 3;
        if (h != cur_h) {
            __syncthreads();
#pragma unroll
            for (int i = 0; i < 8; ++i) { const int id = tid + 512 * i, c = id & 15, n = (id >> 4) & 127, p = id >> 11;
                const u32x4 v = *(const u32x4*)(SKl + ((size_t)(h * 2 + p) * 128 + n) * 128 + c * 8);
                *(LAS u32x4*)(lds + TK_SK + p * 32768 + c * 2048 + n * 16) = v; }
            __syncthreads();
            cur_h = h;
        }
        const size_t token = (size_t)tb * 256 + wid * 32 + r32;
        const bf16_t* qrow = Q2 + token * PQ + h * 256;
        float a[16], b[16];
        half_top16<0>(a, qrow, lds, idxslot, r32, hi);
        half_top16<1>(b, qrow, lds, idxslot, r32, hi);
        float x[16], y[16];
#pragma unroll
        for (int i = 0; i < 16; ++i) { float av = a[i], bv = b[i]; asm volatile("" : "+v"(av), "+v"(bv)); x[i] = hi ? bv : av; y[i] = hi ? av : bv; }
        const unsigned hi8 = (unsigned)hi << 8;
        float A[16], B[16];
#pragma unroll
        for (int j = 1; j < 16; ++j) A[j - 1] = cand(x[0], y[j], (unsigned)j, hi8);
        A[15] = TK_NEG;
#pragma unroll
        for (int j = 2; j < 8; ++j) B[j - 2] = cand(x[1], y[j], (unsigned)(16 + j), hi8);
        B[6] = cand(x[2], y[3], 2u * 16u + 3u, hi8); B[7] = cand(x[2], y[4], 2u * 16u + 4u, hi8);
#pragma unroll
        for (int i = 0; i < 4; ++i) { const float d = cand(x[i], y[i], (unsigned)(17 * i), hi8); B[8 + i] = hi ? TK_NEG : d; }
        B[12] = TK_NEG; B[13] = TK_NEG; B[14] = TK_NEG; B[15] = TK_NEG;
        sort16(B);
        merge_top16(A, B);
        merge_partner(A, hi);
        const float smax = A[0];
        float ex[8]; int eidx[8]; float lsum = 0.f;
        asm volatile("s_waitcnt lgkmcnt(0)" ::: "memory");
#pragma unroll
        for (int k = 0; k < 8; ++k) {
            float s_lo = A[k], s_hi = A[8 + k]; asm volatile("" : "+v"(s_lo), "+v"(s_hi)); const float s = hi ? s_hi : s_lo;
            ex[k] = __expf(s - smax); lsum += ex[k];
            const unsigned code = __float_as_uint(s) & 0x1FFu, src = code >> 8, ci = (code >> 4) & 15u, cj = code & 15u;
            const unsigned ai = src ? cj : ci, bi = src ? ci : cj;
            const unsigned ca = idxslot[ai], cb = idxslot[16 + bi];
            eidx[k] = (int)(((ca ^ 127u) << 7) | (cb ^ 127u));
        }
        const float tot = lsum + partner_f(lsum, hi);
        const float inv = 1.0f / tot;
        *(u32x4*)(IDX16 + token * 128 + h * 16 + 8 * hi) = (u32x4){(unsigned)eidx[0] | ((unsigned)eidx[1] << 16), (unsigned)eidx[2] | ((unsigned)eidx[3] << 16), (unsigned)eidx[4] | ((unsigned)eidx[5] << 16), (unsigned)eidx[6] | ((unsigned)eidx[7] << 16)};
        {
            const unsigned shb = __float_as_uint(HS[token]);
            u32x4* up = UM + token * 64 + h * 8 + 4 * hi;
#pragma unroll
            for (int j = 0; j < 4; ++j) up[j] = (u32x4){(unsigned)eidx[2 * j] | ((unsigned)f2bf(ex[2 * j] * inv) << 16), (unsigned)eidx[2 * j + 1] | ((unsigned)f2bf(ex[2 * j + 1] * inv) << 16), shb, 0u};
        }
        asm volatile("s_waitcnt lgkmcnt(0)" ::: "memory");
    }
}
}

namespace peer3 {
__device__ __forceinline__ unsigned xcc_id() { return (unsigned)__builtin_amdgcn_s_getreg((3 << 11) | 20) & 7u; }
#ifndef PUNIT
#define PUNIT 16
#endif
constexpr int UNIT = PUNIT, NUNIT = T / UNIT;
template <int CTRL> __device__ __forceinline__ int dpp_i(int v) { return __builtin_amdgcn_update_dpp(0, v, CTRL, 0xF, 0xF, true); }
__device__ __forceinline__ int rowsum16(int v) { v += dpp_i<0xB1>(v); v += dpp_i<0x4E>(v); v += dpp_i<0x141>(v); v += dpp_i<0x140>(v); return v; }
__device__ __forceinline__ float gelu_as(float v) {
    const float av = fabsf(v), t = __builtin_amdgcn_rcpf(fmaf(av, 0.2316418882f, 1.0f));
    float q = fmaf(t, 0.5307027145f, -0.7265760135f); q = fmaf(q, t, 0.7107068705f); q = fmaf(q, t, -0.142248368f); q = fmaf(q, t, 0.127414796f); q = q * t;
    const float e = __builtin_amdgcn_exp2f(v * v * -0.72134752044f), m = v * (q * e);
    return v < 0.f ? m : v - m;
}
__device__ __forceinline__ unsigned take_async(unsigned* p, int lane) { unsigned v = 0u; if (lane == 0) v = __hip_atomic_fetch_add(p, 1u, __ATOMIC_RELAXED, __HIP_MEMORY_SCOPE_AGENT); return v; }

constexpr int UST = 4;
typedef float f32x2_t __attribute__((ext_vector_type(2)));
struct UTok { unsigned um0, um1; float sh; int n; unsigned mine; f32x2_t sc; };
struct UPtr { const unsigned char* UQ; const f32x2_t* SC; const u32x4* UM; const unsigned char* HQ; bf16_t* COEF; };
__device__ __forceinline__ void u_meta(UTok& T, const UPtr& P, size_t t, int lane) { const u32x4 m = P.UM[t * 64 + lane]; T.um0 = m.x; T.um1 = m.y; T.sh = __uint_as_float(m.z); }
__device__ __forceinline__ void u_hrow(u32x4 (&hv)[4], const UPtr& P, size_t t, int lane) {
#pragma unroll
    for (int k = 0; k < 4; ++k) hv[k] = *(const u32x4*)(P.HQ + t * 1024 + 256 * k + 16 * (lane & 15));
}
template <int EXP = 0>
__device__ __forceinline__ void u_issue(u32x4 (&uv)[UST][4], const UPtr& P, LAS unsigned* lst, int base, int n, int lane) {
    const int q = lane >> 4, r = lane & 15, nst = (n - base + 3) >> 2;
#pragma unroll
    for (int st = 0; st < UST; ++st) {
        if (st < nst) {
            int slot = base + 4 * st + q; slot = slot < n ? slot : n - 1;
            const unsigned char* rp = P.UQ + (size_t)(lst[slot] & ((EXP & 1) ? 0x383fu : 0x3fffu)) * 1024 + 16 * r;
#pragma unroll
            for (int k = 0; k < 4; ++k) uv[st][k] = *(const u32x4*)(rp + 256 * k);
        }
    }
}
__device__ __forceinline__ void u_dots(const u32x4 (&uv)[UST][4], const u32x4 (&hv)[4], LAS float* res, int base, int n, int lane) {
    const int q = lane >> 4, r = lane & 15, nst = (n - base + 3) >> 2;
#pragma unroll
    for (int st = 0; st < UST; ++st) {
        if (st < nst) {
            int s0_ = 0, s1_ = 0, s2_ = 0, s3_ = 0;
#pragma unroll
            for (int k = 0; k < 4; ++k) {
                s0_ = __builtin_amdgcn_sdot4((int)uv[st][k].x, (int)hv[k].x, s0_, false); s1_ = __builtin_amdgcn_sdot4((int)uv[st][k].y, (int)hv[k].y, s1_, false);
                s2_ = __builtin_amdgcn_sdot4((int)uv[st][k].z, (int)hv[k].z, s2_, false); s3_ = __builtin_amdgcn_sdot4((int)uv[st][k].w, (int)hv[k].w, s3_, false);
            }
            const int tot = rowsum16((s0_ + s1_) + (s2_ + s3_));
            if (r == 0) res[base + 4 * st + q] = (float)tot;
        }
    }
}
template <int EXP = 0>
__device__ __forceinline__ void u_front(UTok& T, u32x4 (&uv)[UST][4], const UPtr& P, unsigned s, LAS unsigned* lst, LAS unsigned* glst, int lane) {
    const unsigned idx0 = T.um0 & 0xffffu, idx1 = T.um1 & 0xffffu;
    const bool in0 = (idx0 >> 11) == s, in1 = (idx1 >> 11) == s;
    const unsigned long long m0 = __ballot(in0), m1 = __ballot(in1);
    const int c0 = __builtin_popcountll(m0); T.n = c0 + __builtin_popcountll(m1);
    const int rank0 = (int)__builtin_amdgcn_mbcnt_hi((unsigned)(m0 >> 32), __builtin_amdgcn_mbcnt_lo((unsigned)m0, 0u));
    const int rank1 = c0 + (int)__builtin_amdgcn_mbcnt_hi((unsigned)(m1 >> 32), __builtin_amdgcn_mbcnt_lo((unsigned)m1, 0u));
    if (in0) { lst[rank0] = idx0 | ((unsigned)(2 * lane) << 16); glst[rank0] = T.um0 & 0xffff0000u; }
    if (in1) { lst[rank1] = idx1 | ((unsigned)(2 * lane + 1) << 16); glst[rank1] = T.um1 & 0xffff0000u; }
    T.mine = lst[lane];
    T.sc = (f32x2_t){0.f, 0.f};
    if (lane < T.n) T.sc = P.SC[(EXP & 2) ? (T.mine & 0x383fu) : (T.mine & 0x3fffu)];
    u_issue<EXP>(uv, P, lst, 0, T.n, lane);
}
template <int EXP = 0>
__device__ __forceinline__ void u_back(const UTok& T, u32x4 (&uv)[UST][4], const u32x4 (&hv)[4], const UPtr& P, LAS unsigned* lst, LAS unsigned* glst, LAS float* res, size_t t, int lane) {
    u_dots(uv, hv, res, 0, T.n, lane);
#pragma unroll 1
    for (int base = 4 * UST; base < T.n; base += 4 * UST) { u_issue<EXP>(uv, P, lst, base, T.n, lane); u_dots(uv, hv, res, base, T.n, lane); }
    if (lane < T.n) {
        const float d = res[lane], g = __uint_as_float(glst[lane]);
        P.COEF[t * 128 + (T.mine >> 16)] = (bf16_t)f2bf(gelu_as(d * T.sc.x * T.sh) * g * T.sc.y);
    }
    if (T.n > 64 && lane + 64 < T.n) {
        const unsigned m2 = lst[lane + 64]; const float d = res[lane + 64], g = __uint_as_float(glst[lane + 64]);
        const f32x2_t sc = P.SC[(EXP & 2) ? (m2 & 0x383fu) : (m2 & 0x3fffu)];
        P.COEF[t * 128 + (m2 >> 16)] = (bf16_t)f2bf(gelu_as(d * sc.x * T.sh) * g * sc.y);
    }
}
template <int EXP = 0>
__device__ __forceinline__ void u_unit(const KArgs& a, int l, unsigned s, unsigned unit, LAS unsigned char* wlds, int lane) {
    UPtr P;
    P.UQ = a.ws + WS_UQ + (size_t)l * NEXP * 1024; P.SC = (const f32x2_t*)(a.ws + WS_USC) + l * NEXP;
    P.UM = (const u32x4*)(a.ws + WS_UM); P.HQ = a.ws + WS_H2Q; P.COEF = (bf16_t*)(a.ws + (EXP ? WS_GB : WS_COEF));
    LAS unsigned* lstA = (LAS unsigned*)wlds; LAS unsigned* glstA = (LAS unsigned*)(wlds + 512); LAS float* resA = (LAS float*)(wlds + 1024);
    LAS unsigned* lstB = (LAS unsigned*)(wlds + 1536); LAS unsigned* glstB = (LAS unsigned*)(wlds + 2048); LAS float* resB = (LAS float*)(wlds + 2560);
    const size_t t0 = (size_t)unit * UNIT;
    UTok TA, TB, TN; u32x4 uvA[UST][4], uvB[UST][4], hvA[4], hvB[4];
    u_meta(TA, P, t0, lane); u_hrow(hvA, P, t0, lane);
    u_front<EXP>(TA, uvA, P, s, lstA, glstA, lane);
    u_meta(TB, P, t0 + 1, lane); u_hrow(hvB, P, t0 + 1, lane);
#pragma unroll 1
    for (int i = 0; i < UNIT; i += 2) {
        const size_t t = t0 + i, t2 = t0 + (i + 2 < UNIT ? i + 2 : i), t3 = t0 + (i + 3 < UNIT ? i + 3 : i + 1);
        u_front<EXP>(TB, uvB, P, s, lstB, glstB, lane);
        u_meta(TN, P, t2, lane);
        u_back<EXP>(TA, uvA, hvA, P, lstA, glstA, resA, t, lane);
        u_hrow(hvA, P, t2, lane);
        TA.um0 = TN.um0; TA.um1 = TN.um1; TA.sh = TN.sh;
        if (i + 2 < UNIT) u_front<EXP>(TA, uvA, P, s, lstA, glstA, lane);
        u_meta(TN, P, t3, lane);
        u_back<EXP>(TB, uvB, hvB, P, lstB, glstB, resB, t + 1, lane);
        u_hrow(hvB, P, t3, lane);
        TB.um0 = TN.um0; TB.um1 = TN.um1; TB.sh = TN.sh;
    }
}
struct VMeta { u32x4 iv[2]; u32x4 cv[2]; };
__device__ __forceinline__ void v_meta(VMeta& m, const unsigned short* IDX16, const bf16_t* COEF, size_t t, int g) {
#pragma unroll
    for (int q = 0; q < 2; ++q) { m.iv[q] = *(const u32x4*)(IDX16 + t * 128 + 16 * g + 8 * q); m.cv[q] = *(const u32x4*)(COEF + t * 128 + 16 * g + 8 * q); }
}
__device__ __forceinline__ float v_coef(const VMeta& m, int j) { const unsigned w = m.cv[j >> 3][(j >> 1) & 3]; return (j & 1) ? bfhi(w) : bflo(w); }
__device__ __forceinline__ unsigned v_idx(const VMeta& m, int j) { const unsigned w = m.iv[j >> 3][(j >> 1) & 3]; return (j & 1) ? (w >> 16) : (w & 0xffffu); }
struct VX { unsigned xw; float g0, g1; };
template <int EXP = 0>
__device__ __forceinline__ void v_stage(u32x4 (&P)[16], u32x4& CQ, float& cs, VX& X, const VMeta& m, const unsigned char* VS, const bf16_t* __restrict__ xin, const float* mod_l, size_t t, unsigned s, int lane) {
    {
        const int col = (int)s * 128 + 16 * (lane & 7) + 2 * (lane >> 3), b = (int)(t >> 12);
        X.xw = *(const unsigned*)(xin + t * DM + col);
        typedef float f32x2 __attribute__((ext_vector_type(2)));
        const f32x2 gt = *(const f32x2*)(mod_l + (size_t)b * NMOD + 5 * DM + col); X.g0 = gt.x; X.g1 = gt.y;
    }
    typedef unsigned short u16x2_t __attribute__((ext_vector_type(2)));
    u16x2_t mx = __builtin_bit_cast(u16x2_t, m.cv[0][0] & 0x7fff7fffu);
#pragma unroll
    for (int d = 1; d < 8; ++d) mx = __builtin_elementwise_max(mx, __builtin_bit_cast(u16x2_t, m.cv[d >> 2][d & 3] & 0x7fff7fffu));
    const unsigned mu = __builtin_bit_cast(unsigned, mx);
    unsigned cu = (mu > (mu << 16) ? mu : (mu << 16)) & 0xffff0000u;
    { const unsigned o = (unsigned)__builtin_amdgcn_update_dpp(0, (int)cu, 0x128, 0xF, 0xF, true); cu = cu > o ? cu : o; }
    { auto rr = __builtin_amdgcn_permlane16_swap(cu, cu, false, false); cu = rr[0] > rr[1] ? rr[0] : rr[1]; }
    { auto rr = __builtin_amdgcn_permlane32_swap(cu, cu, false, false); cu = rr[0] > rr[1] ? rr[0] : rr[1]; }
    float cm = __uint_as_float(cu);
    cm = fmaxf(cm, 1e-30f);
    const unsigned ib = __float_as_uint(127.0f * __builtin_amdgcn_rcpf(cm)) & 0xffff0000u, blo = ib >> 16;
    cs = __builtin_amdgcn_rcpf(__uint_as_float(ib));
    const float magic = 12582912.0f;
#pragma unroll
    for (int qd = 0; qd < 4; ++qd) {
        const unsigned w0 = m.cv[qd >> 1][(2 * qd) & 3], w1 = m.cv[qd >> 1][(2 * qd + 1) & 3];
        unsigned f0, f1, f2, f3;
        asm("v_dot2_f32_bf16 %0, %4, %6, %8\n\tv_dot2_f32_bf16 %1, %4, %7, %8\n\tv_dot2_f32_bf16 %2, %5, %6, %8\n\tv_dot2_f32_bf16 %3, %5, %7, %8\n\ts_nop 1"
            : "=&v"(f0), "=&v"(f1), "=&v"(f2), "=&v"(f3) : "v"(w0), "v"(w1), "v"(blo), "v"(ib), "s"(magic));
        CQ[qd] = __builtin_amdgcn_perm(__builtin_amdgcn_perm(f3, f2, 0x0c0c0400u), __builtin_amdgcn_perm(f1, f0, 0x0c0c0400u), 0x05040100u);
    }
    const unsigned lane16 = 16u * (unsigned)(lane & 7), c128 = 128u;
#pragma unroll
    for (int j = 0; j < 16; ++j) {
        const unsigned w = m.iv[j >> 3][(j >> 1) & 3]; unsigned off;
        if (EXP & 1) off = (v_idx(m, j) & 63u) * 128u + lane16;
        else if (j & 1) asm("v_mad_u32_u16 %0, %1, %2, %3 op_sel:[1,0,0,0]" : "=v"(off) : "v"(w), "s"(c128), "v"(lane16));
        else asm("v_mad_u32_u16 %0, %1, %2, %3" : "=v"(off) : "v"(w), "s"(c128), "v"(lane16));
        P[j] = *(const u32x4*)(VS + (size_t)off);
    }
}
template <int EXP = 0>
__device__ __forceinline__ void v_compute(const u32x4 (&P)[16], const u32x4& CQ, float cs, const VX& X, bf16_t* __restrict__ xout, size_t t, unsigned s, int lane) {
    const int g = lane >> 3, p = lane & 7; const bool b4 = (lane >> 4) & 1, b3 = (lane >> 3) & 1;
    typedef float f32x2 __attribute__((ext_vector_type(2)));
    const int col = (int)s * 128 + 16 * p + 2 * g;
    unsigned* xp = (unsigned*)(xout + t * DM + col);
    f32x2 xv = {bflo(X.xw), bfhi(X.xw)};
    const f32x2 gt = {X.g0, X.g1};
    int acc[16];
#pragma unroll
    for (int k = 0; k < 16; ++k) acc[k] = 0;
    if (EXP & 2) {
#pragma unroll
        for (int j = 0; j < 16; ++j) acc[j] = (int)(P[j].x + P[j].y + P[j].z + P[j].w + CQ[j & 3]);
    } else
#pragma unroll
    for (int qd = 0; qd < 4; ++qd)
#pragma unroll
        for (int w = 0; w < 4; ++w) {
            const unsigned A = P[4 * qd][w], B = P[4 * qd + 1][w], C = P[4 * qd + 2][w], D = P[4 * qd + 3][w];
            const unsigned X = __builtin_amdgcn_perm(B, A, 0x05010400u), Y = __builtin_amdgcn_perm(B, A, 0x07030602u);
            const unsigned Z = __builtin_amdgcn_perm(D, C, 0x05010400u), W = __builtin_amdgcn_perm(D, C, 0x07030602u);
            const unsigned T0 = __builtin_amdgcn_perm(Z, X, 0x05040100u), T1 = __builtin_amdgcn_perm(Z, X, 0x07060302u);
            const unsigned T2 = __builtin_amdgcn_perm(W, Y, 0x05040100u), T3 = __builtin_amdgcn_perm(W, Y, 0x07060302u);
            acc[4 * w + 0] = __builtin_amdgcn_sdot4((int)T0, (int)CQ[qd], acc[4 * w + 0], false); acc[4 * w + 1] = __builtin_amdgcn_sdot4((int)T1, (int)CQ[qd], acc[4 * w + 1], false);
            acc[4 * w + 2] = __builtin_amdgcn_sdot4((int)T2, (int)CQ[qd], acc[4 * w + 2], false); acc[4 * w + 3] = __builtin_amdgcn_sdot4((int)T3, (int)CQ[qd], acc[4 * w + 3], false);
        }
    int r8[8], r4[4], r2[2];
#pragma unroll
    for (int q = 0; q < 8; ++q) { auto rr = __builtin_amdgcn_permlane32_swap((unsigned)acc[q], (unsigned)acc[8 + q], false, false); r8[q] = (int)rr[0] + (int)rr[1]; }
#pragma unroll
    for (int q = 0; q < 4; ++q) { auto rr = __builtin_amdgcn_permlane16_swap((unsigned)r8[q], (unsigned)r8[4 + q], false, false); r4[q] = (int)rr[0] + (int)rr[1]; }
#pragma unroll
    for (int q = 0; q < 2; ++q) { const int u = r4[q] + dpp_i<0x128>(r4[q]), v = r4[2 + q] + dpp_i<0x128>(r4[2 + q]); r2[q] = b3 ? v : u; }
    xv.x += gt.x * ((float)r2[0] * cs); xv.y += gt.y * ((float)r2[1] * cs);
    *xp = pk2(xv.x, xv.y);
}
template <int EXP = 0>
__device__ __forceinline__ void v_unit_(const KArgs& a, int l, const float* mod_l, unsigned s, unsigned unit, int lane, const bf16_t* __restrict__ xr, bf16_t* __restrict__ xw) {
    const int g = lane >> 3, p = lane & 7;
    const unsigned char* VS = a.ws + WS_VQ + (size_t)l * NEXP * 1024 + (size_t)s * NEXP * 128;
    const unsigned short* IDX16 = (const unsigned short*)(a.ws + WS_IDX16); const bf16_t* COEF = (const bf16_t*)(a.ws + WS_COEF);
    const size_t t0 = (size_t)unit * UNIT;
    VMeta mA, mB; v_meta(mA, IDX16, COEF, t0, g); v_meta(mB, IDX16, COEF, t0 + 1, g);
    u32x4 PA[16], PB[16], CQA, CQB; float csA, csB; VX XA, XB;
#define VSB() __builtin_amdgcn_sched_barrier(0)
    VSB(); v_stage<EXP>(PA, CQA, csA, XA, mA, VS, xr, mod_l, t0, s, lane); VSB();
    v_meta(mA, IDX16, COEF, t0 + 2, g); VSB();
#pragma unroll 1
    for (int i = 0; i < UNIT; i += 2) {
        SUBPROBE_T(0);
        v_stage<EXP>(PB, CQB, csB, XB, mB, VS, xr, mod_l, t0 + i + 1, s, lane); VSB();
        SUBPROBE_T(1);
        v_meta(mB, IDX16, COEF, t0 + (i + 3 < UNIT ? i + 3 : i + 1), g); VSB();
        SUBPROBE_T(2);
        v_compute<EXP>(PA, CQA, csA, XA, xw, t0 + i, s, lane); VSB();
        SUBPROBE_T(3);
        v_stage<EXP>(PA, CQA, csA, XA, mA, VS, xr, mod_l, t0 + (i + 2 < UNIT ? i + 2 : i), s, lane); VSB();
        v_meta(mA, IDX16, COEF, t0 + (i + 4 < UNIT ? i + 4 : i + 2 < UNIT ? i + 2 : i), g); VSB();
        v_compute<EXP>(PB, CQB, csB, XB, xw, t0 + i + 1, s, lane); VSB();
    }
#undef VSB
}
__device__ __forceinline__ void v_unit(const KArgs& a, int l, const float* mod_l, unsigned s, unsigned unit, int lane) { v_unit_<0>(a, l, mod_l, s, unit, lane, (const bf16_t*)(a.ws + WS_XB), (bf16_t*)(a.ws + WS_XB)); }
#ifdef VEXP
__device__ __forceinline__ void v_unit_exp(const KArgs& a, int l, const float* mod_l, unsigned s, unsigned unit, int lane) { v_unit_<VEXP>(a, l, mod_l, s, unit, lane, (const bf16_t*)(a.ws + WS_XB), (bf16_t*)(a.ws + WS_GB)); }
#endif
template <bool VSTEP, bool VX_ = false>
__device__ __forceinline__ void peer_phase(const KArgs& a, int l, const float* mod_l, unsigned* cnt, LAS unsigned char* lds, int wv) {
        const int tid = phase_tid(wv), lane = tid & 63, wid = wv;
    LAS unsigned char* wlds = lds + wid * 3072;
#ifdef VWAVES
    if (VSTEP && wid >= VWAVES) return;
#endif
#ifdef UWAVES
    if (!VSTEP && wid >= UWAVES) return;
#endif
    const unsigned home = xcc_id();
    unsigned ss = 0, s = home;
    unsigned nxt = take_async(cnt + 64 * s, lane);
    for (;;) {
        const unsigned cur = (unsigned)__builtin_amdgcn_readfirstlane((int)nxt);
        if (cur >= (unsigned)NUNIT) { if (++ss == 8u) break; s = (home + ss) & 7u; nxt = take_async(cnt + 64 * s, lane); continue; }
        nxt = take_async(cnt + 64 * s, lane);
#ifdef VEXP
        if (VX_) { v_unit_exp(a, l, mod_l, s, cur, lane); continue; }
#endif
#ifdef UEXP
        if (VX_) { u_unit<UEXP>(a, l, s, cur, wlds, lane); continue; }
#endif
        if (VSTEP) v_unit(a, l, mod_l, s, cur, lane); else u_unit<0>(a, l, s, cur, wlds, lane);
    }
}
}

#ifndef PEERQ_WAVES
#define PEERQ_WAVES 2
#endif
constexpr int PH_PER_LAYER = 10, NPHASES = 2 + DEPTH * PH_PER_LAYER + 1;
#ifndef PHASE_MASK
#define PHASE_MASK 0xFFFF
#endif
#define HASP(k) (((PHASE_MASK) >> (k)) & 1)
#ifndef SB_EARLY_EXIT
#define SB_EARLY_EXIT 1
#endif

#define GAS __attribute__((address_space(1)))
#define RLX_AGENT __ATOMIC_RELAXED, __HIP_MEMORY_SCOPE_AGENT
#define XB_TMO      128
#define XB_XCNT(j)  (256  + 64 * (j))
#define XB_XSUB(j)  (1280 + 64 * (j))
#define XB_XGEN(j)  (2304 + 64 * (j))
#define XB_TOP      3328
#define XB_TOPGEN   3392
#define XCD_BAR_WORDS 3456
#define XB_SPIN_CAP (1u << 18)

__device__ __forceinline__ unsigned xb_ld(unsigned* p)              { return __hip_atomic_load(p, __ATOMIC_RELAXED, __HIP_MEMORY_SCOPE_AGENT); }
__device__ __forceinline__ unsigned xb_add(unsigned* p, unsigned v) { return __hip_atomic_fetch_add(p, v, __ATOMIC_RELAXED, __HIP_MEMORY_SCOPE_AGENT); }
__device__ __forceinline__ unsigned xb_xcc_id() { return (unsigned)__builtin_amdgcn_s_getreg((3 << 11) | 20) & 0xFu; }
#define XB_SPIN(cond, bar) do { unsigned _sp = 0; while (cond) { __builtin_amdgcn_s_sleep(1); \
    if ((++_sp & 255u) == 0u) { if (xb_ld(&(bar)[XB_TMO])) break; if (_sp > XB_SPIN_CAP) { atomicAdd(&(bar)[XB_TMO], 1u); break; } } } } while (0)

struct XcdBarrier {
    unsigned* bar; unsigned x;
    volatile LAS unsigned* st;
};

__device__ __forceinline__ XcdBarrier xcd_barrier_post(unsigned* bar, volatile LAS unsigned* st, bool tid0) {
    XcdBarrier b; b.bar = bar; b.x = xb_xcc_id(); b.st = st;
    if (tid0) (void)xb_add(&bar[XB_XCNT(b.x)], 1u);
    return b;
}
__device__ __forceinline__ void xcd_barrier_complete(unsigned* bar, unsigned x, unsigned& nloc, unsigned& nx) {
    const unsigned G = gridDim.x * gridDim.y * gridDim.z;
    unsigned sum, cnt, mine, sp = 0u;
    for (;;) {
        sum = 0u; cnt = 0u; mine = 0u;
#pragma unroll
        for (unsigned j = 0; j < 16; ++j) { const unsigned c = xb_ld(&bar[XB_XCNT(j)]); sum += c; cnt += (c > 0u) ? 1u : 0u; mine = (j == x) ? c : mine; }
        if (sum == G) break;
        __builtin_amdgcn_s_sleep(1);
        if ((++sp & 255u) == 0u) { if (xb_ld(&bar[XB_TMO])) break; if (sp > XB_SPIN_CAP) { atomicAdd(&bar[XB_TMO], 1u); break; } }
    }
    nloc = mine > 0u ? mine : 1u; nx = cnt > 0u ? cnt : 1u;
}

__device__ __forceinline__ void xcd_barrier(const XcdBarrier& b, bool tid0) {
    asm volatile("s_waitcnt vmcnt(0)" ::: "memory");
    __syncthreads();
    if (tid0) {
        unsigned* bar = b.bar;
        __builtin_amdgcn_s_waitcnt(0);
        unsigned nloc = b.st[0], nx = b.st[1];
        if (nloc == 0u) { xcd_barrier_complete(bar, b.x, nloc, nx); b.st[0] = nloc; b.st[1] = nx; }
        const unsigned old = xb_add(&bar[XB_XSUB(b.x)], 1u);
        const unsigned gen = old / nloc;
        if (old + 1u == (gen + 1u) * nloc) {
            __builtin_amdgcn_fence(__ATOMIC_RELEASE, "agent");
            asm volatile("s_waitcnt vmcnt(0)" ::: "memory");
            const unsigned og = xb_add(&bar[XB_TOP], 1u);
            const unsigned tg = og / nx;
            if (og + 1u == (tg + 1u) * nx) xb_add(&bar[XB_TOPGEN], 1u);
            else XB_SPIN(xb_ld(&bar[XB_TOPGEN]) == tg, bar);
            __builtin_amdgcn_fence(__ATOMIC_ACQUIRE, "agent");
            xb_add(&bar[XB_XGEN(b.x)], 1u);
            asm volatile("s_waitcnt vmcnt(0)" ::: "memory");
        } else {
            XB_SPIN(xb_ld(&bar[XB_XGEN(b.x)]) == gen, bar);
            __builtin_amdgcn_fence(__ATOMIC_ACQUIRE, "agent");
            asm volatile("s_waitcnt vmcnt(0)" ::: "memory");
        }
    }
    __syncthreads();
}

typedef const __attribute__((address_space(4))) KArgs* KArgsP;
__device__ __forceinline__ KArgsP kargs() { KArgsP p = (KArgsP)__builtin_amdgcn_kernarg_segment_ptr(); asm volatile("" : "+s"(p)); return p; }

__device__ __forceinline__ void load_args(KArgs& a) {
#if defined(__HIP_DEVICE_COMPILE__)
    KArgsP p = kargs();
    a.x = p->x; a.c = p->c; a.pos = p->pos; a.ada_w = p->ada_w; a.ada_b = p->ada_b; a.norm1_g = p->norm1_g; a.w_in = p->w_in; a.sinks = p->sinks; a.wbr_a = p->wbr_a; a.wbr_b = p->wbr_b;
    a.w_out = p->w_out; a.norm2_g = p->norm2_g; a.wq = p->wq; a.subkeys = p->subkeys; a.pu = p->pu; a.pv = p->pv; a.final_g = p->final_g; a.out = p->out; a.ws = p->ws; a.ph_lo = p->ph_lo; a.ph_hi = p->ph_hi;
#endif
}
__global__ void __launch_bounds__(NTHREADS, 2) fwd_kernel(KArgs a_unused) {
    extern __shared__ __attribute__((aligned(16))) unsigned char lds_raw[];
    LAS unsigned char* lds = (LAS unsigned char*)lds_raw;
    cg::grid_group grid = cg::this_grid();
    const int ph_lo = kargs()->ph_lo, ph_hi = kargs()->ph_hi;
    const int wv = __builtin_amdgcn_readfirstlane((int)threadIdx.x >> 6);
#define IN(k) (ph_lo <= (k) && (k) < ph_hi)
#ifdef SUBPROBE
    if (blockIdx.x == SUBPROBE_BLK && threadIdx.x == 0) { SP_MEM[1] = 0; SP_MEM[0] = __builtin_amdgcn_s_memtime(); }
#endif
    volatile LAS unsigned* xb_st = (volatile LAS unsigned*)(lds + LDS_BYTES - 64);
    { const bool t0_ = phase_tid(wv) == 0; if (t0_) { xb_st[0] = 0u; xb_st[1] = 0u; } __syncthreads();
      (void)xcd_barrier_post((unsigned*)(kargs()->ws + WS_CTL) + CTL_BAR, xb_st, t0_); }
#define GRID_BAR() do { XcdBarrier b_; b_.bar = (unsigned*)(kargs()->ws + WS_CTL) + CTL_BAR; b_.x = xb_xcc_id(); b_.st = xb_st; xcd_barrier(b_, phase_tid(wv) == 0); } while (0)
#ifdef PROBE_PH
    volatile LAS unsigned long long* pr_mem = (volatile LAS unsigned long long*)(lds + LDS_BYTES - 32);
    if (blockIdx.x == 0 && threadIdx.x == 0) { pr_mem[0] = __builtin_amdgcn_s_memrealtime(); pr_mem[1] = 0; }
#define PROBE_MATCH(k) ((PROBE_PH) >= 100 ? ((k) >= 2 && (k) < NPHASES - 1 && (((k) - 2) % PH_PER_LAYER) == (PROBE_PH) - 100) : (k) == (PROBE_PH))
#define PROBE_STAMP(k) do { if (blockIdx.x == 0 && threadIdx.x == 0) { const unsigned long long now_ = __builtin_amdgcn_s_memrealtime(); if (PROBE_MATCH(k)) pr_mem[1] = pr_mem[1] + (now_ - pr_mem[0]); pr_mem[0] = now_; } } while (0)
#define SEAM(k) do { if (IN(k) && IN((k) + 1)) { if ((k) == 0) grid.sync(); else GRID_BAR(); } PROBE_STAMP(k); } while (0)
#else
#define SEAM(k) do { if (IN(k) && IN((k) + 1)) { if ((k) == 0) grid.sync(); else GRID_BAR(); } } while (0)
#endif
#define LOADARGS KArgs a; load_args(a); unsigned char* ws = a.ws; const int G = op_grid(); (void)G; (void)ws
#define LAYERARGS const float* mod_l = (const float*)(ws + WS_MOD) + (size_t)l * 8 * NMOD; const float* xcur = (l == 0) ? a.x : a.out; (void)mod_l; (void)xcur
    if (IN(0)) { if (HASP(0)) { LOADARGS; ph_prologue(a, lds, wv); } }
    SEAM(0);
    if (IN(1)) { if (HASP(0)) { LOADARGS; ph_prologue_b(a, lds, wv); } }
    SEAM(1);
#pragma unroll 1
    for (int l = 0; l < DEPTH; ++l) {
        const int p0 = 2 + l * PH_PER_LAYER;
        if (IN(p0 + 0)) { if (HASP(1)) { LOADARGS; LAYERARGS; if (l == 0) ph_norm<true>(a, a.x, a.norm1_g + l * DM, mod_l, 0, 1, ws + WS_H, (float*)(ws + WS_HS1), wv); else ph_norm<false>(a, ws + WS_XB, a.norm1_g + l * DM, mod_l, 0, 1, ws + WS_H, (float*)(ws + WS_HS1), wv); } }
        SEAM(p0 + 0);
        if (IN(p0 + 1)) { if (HASP(2)) { LOADARGS; pg8::Gemm g{(const bf16_t*)(ws + WS_H), (const bf16_t*)(ws + WS_WIN) + (size_t)l * NPROJ * 512, T, NPROJ, 512};
                  pg8::StaticOrder S; S.init(T, NPROJ, G, op_bid()); EpiI8<EpiProj> E{EpiProj{ws}, (const float*)(ws + WS_HS1), (const float*)(ws + WS_CSIN) + l * NPROJ};
                  pg8::gemm_phase_i8<EpiI8<EpiProj>, pg8::StaticOrder, true, true>(lds, g, S, E, wv); } }
        SEAM(p0 + 1);
        if (IN(p0 + 2)) { if (HASP(3)) { LOADARGS;
                  if (wv >= NWAVES - PEERQ_WAVES) peer_tables_layer(a, l, op_bid() * PEERQ_WAVES + (wv - (NWAVES - PEERQ_WAVES)), G * PEERQ_WAVES, phase_tid(wv) & 63);
                  att::attn_phase<SB_EARLY_EXIT != 0>(ws, a.sinks + l * 8, (unsigned*)(ws + WS_CTL) + CTL_ATTQ + l * 8 * 64, lds, wv); } }
        SEAM(p0 + 2);
        if (IN(p0 + 3)) { if (HASP(4)) { LOADARGS; pg8::StaticOrder S; S.init(T, DM, G, op_bid());
                  { pg8::Gemm g{(const bf16_t*)(ws + WS_QA), (const bf16_t*)(ws + WS_WBA) + (size_t)l * 1024 * 512, T, DM, 512};
                    EpiBranch<false> E{(const bf16_t*)(ws + WS_GA), (bf16_t*)(ws + WS_H)};
                    pg8::gemm_phase<EpiBranch<false>, pg8::StaticOrder, true, true>(lds, g, S, E, wv); }
                  __syncthreads();
                  { pg8::Gemm g{(const bf16_t*)(ws + WS_QB), (const bf16_t*)(ws + WS_WBB) + (size_t)l * 1024 * 512, T, DM, 512};
                    EpiBranch<true> E{(const bf16_t*)(ws + WS_GB), (bf16_t*)(ws + WS_H)};
                    pg8::gemm_phase<EpiBranch<true>, pg8::StaticOrder, true, true>(lds, g, S, E, wv); } } }
        SEAM(p0 + 3);
        if (IN(p0 + 4)) { if (HASP(5)) { LOADARGS; LAYERARGS; pg8::Gemm g{(const bf16_t*)(ws + WS_H), (const bf16_t*)(ws + WS_WOUT) + (size_t)l * 1024 * 1024, T, DM, 1024};
                  pg8::StaticOrder S; S.init(T, DM, G, op_bid());
                  if (l == 0) { EpiWout<true> E{a.x, (bf16_t*)(ws + WS_XB), mod_l + 2 * DM}; pg8::gemm_phase<EpiWout<true>, pg8::StaticOrder, true, true>(lds, g, S, E, wv); }
                  else { EpiWout<false> E{ws + WS_XB, (bf16_t*)(ws + WS_XB), mod_l + 2 * DM}; pg8::gemm_phase<EpiWout<false>, pg8::StaticOrder, true, true>(lds, g, S, E, wv); } } }
        SEAM(p0 + 4);
        if (IN(p0 + 5)) { if (HASP(6)) { LOADARGS; LAYERARGS; ph_norm<false>(a, ws + WS_XB, a.norm2_g + l * DM, mod_l, 3, 4, ws + WS_H2Q, (float*)(ws + WS_HS), wv); } }
        SEAM(p0 + 5);
        if (IN(p0 + 6)) { if (HASP(7)) { LOADARGS; pg8::Gemm g{(const bf16_t*)(ws + WS_H2Q), (const bf16_t*)(ws + WS_WQ) + (size_t)l * PQ * 512, T, PQ, 512};
                  pg8::StaticOrder S; S.init(T, PQ, G, op_bid()); EpiI8<EpiPlainBf16> E{EpiPlainBf16{(bf16_t*)(ws + WS_Q2), PQ}, (const float*)(ws + WS_HS), (const float*)(ws + WS_CSQ) + l * PQ};
                  pg8::gemm_phase_i8<EpiI8<EpiPlainBf16>, pg8::StaticOrder, true, true>(lds, g, S, E, wv); } }
        SEAM(p0 + 6);
        if (IN(p0 + 7)) { if (HASP(8)) { LOADARGS; tk::topk_phase((const bf16_t*)(ws + WS_Q2), (const bf16_t*)(ws + WS_SK) + (size_t)l * 8 * 2 * 128 * 128, (u32x4*)(ws + WS_UM), (unsigned short*)(ws + WS_IDX16), (const float*)(ws + WS_HS), lds, wv); } }
        SEAM(p0 + 7);
        if (IN(p0 + 8)) { if (HASP(9)) { LOADARGS; peer3::peer_phase<false>(a, l, nullptr, (unsigned*)(ws + WS_CTL) + CTL_QUEUE + (l * 2 + 0) * 8 * 64, lds, wv); } }
        SEAM(p0 + 8);
        if (IN(p0 + 9)) { if (HASP(10)) { LOADARGS; LAYERARGS; peer3::peer_phase<true>(a, l, mod_l, (unsigned*)(ws + WS_CTL) + CTL_QUEUE + (l * 2 + 1) * 8 * 64, lds, wv); } }
        SEAM(p0 + 9);
#ifdef UEXP
        if (IN(p0 + 9)) { { LOADARGS; LAYERARGS; peer3::peer_phase<false, true>(a, l, mod_l, (unsigned*)(ws + WS_CTL) + CTL_QUEUE + (4 + l) * 8 * 64, lds, wv); } GRID_BAR(); }
#endif
#ifdef VEXP
        if (IN(p0 + 9)) { { LOADARGS; LAYERARGS; peer3::peer_phase<true, true>(a, l, mod_l, (unsigned*)(ws + WS_CTL) + CTL_QUEUE + (4 + l) * 8 * 64, lds, wv); } GRID_BAR(); }
#endif
    }
    if (IN(NPHASES - 1)) { if (HASP(11)) { LOADARGS; ph_final_norm(a, wv); } }
#ifdef PROBE_PH
    PROBE_STAMP(NPHASES - 1);
    if (blockIdx.x == 0 && threadIdx.x == 0) { const unsigned long long t0_ = __builtin_amdgcn_s_memrealtime(), dl_ = pr_mem[1] * (PROBE_K); while (__builtin_amdgcn_s_memrealtime() - t0_ < dl_) __builtin_amdgcn_s_sleep(16); }
#endif
#ifdef SUBPROBE
    if (blockIdx.x == SUBPROBE_BLK && threadIdx.x == 0) { const unsigned long long t0_ = __builtin_amdgcn_s_memtime(), dl_ = SP_MEM[1] * (SUBPROBE_K); while (__builtin_amdgcn_s_memtime() - t0_ < dl_) __builtin_amdgcn_s_sleep(16); }
#endif
#undef IN
#undef SEAM
}

#ifndef N_LAUNCH_SPLIT
#define N_LAUNCH_SPLIT 1
#endif
extern "C" void kernel_launch(void* const* d_in, const int* in_sizes, int n_in, void* d_out, int out_size, void* d_ws, size_t ws_size, hipStream_t stream) {
    static int grid = 0;
    if (grid == 0) {
        if (n_in != 17 || out_size != T * DM || ws_size < WS_END) { fprintf(stderr, "kernel_launch: unexpected problem (n_in %d out %d ws %zu)\n", n_in, out_size, ws_size); grid = -1; return; }
        int dev = 0, cus = 0, per_cu = 0;
        (void)hipGetDevice(&dev);
        (void)hipDeviceGetAttribute(&cus, hipDeviceAttributeMultiprocessorCount, dev);
        (void)hipFuncSetAttribute((const void*)fwd_kernel, hipFuncAttributeMaxDynamicSharedMemorySize, LDS_BYTES);
        (void)hipOccupancyMaxActiveBlocksPerMultiprocessor(&per_cu, (const void*)fwd_kernel, NTHREADS, LDS_BYTES);
        if (per_cu < 1) { fprintf(stderr, "kernel_launch: occupancy query says %d\n", per_cu); per_cu = 1; }
        grid = cus;
        fprintf(stderr, "kernel_launch: cus %d per_cu %d grid %d ws %zu\n", cus, per_cu, grid, ws_size);
    }
    if (grid < 0) return;
    if (hipMemsetAsync((char*)d_ws + WS_CTL, 0, 65536, stream) != hipSuccess) { fprintf(stderr, "kernel_launch: hipMemsetAsync of the control words failed\n"); return; }
    KArgs a{};
    a.x = (const float*)d_in[0]; a.c = (const float*)d_in[1]; a.pos = (const int*)d_in[2]; a.ada_w = (const float*)d_in[3]; a.ada_b = (const float*)d_in[4];
    a.norm1_g = (const float*)d_in[5]; a.w_in = (const float*)d_in[6]; a.sinks = (const float*)d_in[7]; a.wbr_a = (const float*)d_in[8]; a.wbr_b = (const float*)d_in[9];
    a.w_out = (const float*)d_in[10]; a.norm2_g = (const float*)d_in[11]; a.wq = (const float*)d_in[12]; a.subkeys = (const float*)d_in[13]; a.pu = (const float*)d_in[14];
    a.pv = (const float*)d_in[15]; a.final_g = (const float*)d_in[16]; a.out = (float*)d_out; a.ws = (unsigned char*)d_ws;
#if N_LAUNCH_SPLIT
    a.ph_lo = 0; a.ph_hi = NPHASES;
    { void* args[] = {&a};
      hipError_t e = hipLaunchCooperativeKernel((void*)fwd_kernel, dim3(grid), dim3(NTHREADS), args, LDS_BYTES, stream);
      if (e != hipSuccess) fprintf(stderr, "cooperative launch failed: %s (grid %d)\n", hipGetErrorString(e), grid); }
#else
    for (int ph = 0; ph < NPHASES; ++ph) {
        a.ph_lo = ph; a.ph_hi = ph + 1;
        void* args[] = {&a};
        hipError_t e = hipLaunchCooperativeKernel((void*)fwd_kernel, dim3(grid), dim3(NTHREADS), args, LDS_BYTES, stream);
        if (e != hipSuccess) { fprintf(stderr, "cooperative launch %d failed: %s (grid %d)\n", ph, hipGetErrorString(e), grid); break; }
    }
#endif
}
```

```cpp
#include <hip/hip_runtime.h>
#include <hip/hip_cooperative_groups.h>
#include <cstdio>
#include <cstdint>
namespace cg = cooperative_groups;

#ifdef SUBPROBE
#define SP_MEM ((volatile __attribute__((address_space(3))) unsigned long long*)((__attribute__((address_space(3))) unsigned char*)0 + 147456 - 32))
#define SUBPROBE_T(id) do { __builtin_amdgcn_sched_barrier(0); if (blockIdx.x == SUBPROBE_BLK && threadIdx.x == 0) { const unsigned long long now_ = __builtin_amdgcn_s_memtime(); if ((id) == SUBPROBE) SP_MEM[1] = SP_MEM[1] + (now_ - SP_MEM[0]); SP_MEM[0] = now_; } __builtin_amdgcn_sched_barrier(0); } while (0)
#else
#define SUBPROBE_T(id) do {} while (0)
#endif
namespace pg8 {
#define PG8_LAS __attribute__((address_space(3)))
typedef unsigned short bf16_t;
typedef short bf16x8 __attribute__((ext_vector_type(8)));
typedef float f32x4 __attribute__((ext_vector_type(4)));
typedef unsigned u32x4 __attribute__((ext_vector_type(4)));
constexpr int BM = 256, BK = 64, HALF = 128, HTB = HALF * BK * 2  , STAGE_BYTES = 8 * HTB, NXCD = 8, WGM = 8;

__host__ __device__ __forceinline__ int lds_byte(int r, int c) { const int st = (r >> 4) * 2 + (c >> 5), rr = r & 15, cc = c & 31, ob = rr * 64 + cc * 2; return st * 1024 + (ob ^ (((ob >> 9) & 1) << 5)); }
__host__ __device__ __forceinline__ void stage_rc(int b, int& R, int& C) { const int st = b / 1024, sb = b % 1024, swz = sb ^ (((sb >> 9) & 1) << 5); R = (st >> 1) * 16 + swz / 64; C = (st & 1) * 32 + (swz % 64) / 2; }
__host__ __device__ __forceinline__ int perm32(int rho) { const int n = rho >> 4, i = rho & 15; return 8 * (i >> 2) + 4 * n + (i & 3); }

struct Unit { int pm, pn; };
struct Gemm { const bf16_t* A; const bf16_t* Bt; int M, N, K; };

struct StaticOrder {
    int nM, nN, nwg, G, c;
    __host__ __device__ void init(int M, int N, int G_, int c_) { nM = M / BM; nN = N / BM; nwg = nM * nN; G = G_; c = c_; }
    __host__ __device__ bool next(int i, Unit& u) const {
        const long L = (long)i * G + c; if (L >= nwg) return false;
        int wgid = (int)L; { const int q = nwg / NXCD, r = nwg % NXCD, xcd = wgid % NXCD, off = wgid / NXCD; wgid = (xcd < r ? xcd * (q + 1) : r * (q + 1) + (xcd - r) * q) + off; }
        const int nig = WGM * nN, gid = wgid / nig, fm = gid * WGM, gsz = (nM - fm) < WGM ? (nM - fm) : WGM;
        u.pm = fm + ((wgid % nig) % gsz); u.pn = (wgid % nig) / gsz; return true;
    }
    __device__ __forceinline__ void a_ready(const Unit&) const {}
    __device__ __forceinline__ void done(const Unit&) const {}
};


__device__ __forceinline__ unsigned cvt_pk_bf16(float lo, float hi) { unsigned r; asm volatile("v_cvt_pk_bf16_f32 %0, %1, %2" : "=v"(r) : "v"(lo), "v"(hi)); return r; }
template <class Epi, class Sched, bool ALIGN_EPI = false, bool SP2 = false>
__device__ __forceinline__ void gemm_phase(PG8_LAS unsigned char* lds, const Gemm g, const Sched& S, const Epi& E, int wv) {
    unsigned m_op = ~0u; asm volatile("" : "+s"(m_op));
    const int tid = wv * 64 + (int)__builtin_amdgcn_mbcnt_hi(m_op, __builtin_amdgcn_mbcnt_lo(m_op, 0u)), wid = wv, lane = tid & 63, wr = wid >> 2, wc = wid & 3, fr = lane & 15, fq = lane >> 4;
    const int K = g.K, nt = K / BK;
    unsigned voffA[2], voffB[2];
#pragma unroll
    for (int i = 0; i < 2; ++i) { int R, C; stage_rc(tid * 16 + i * 8192, R, C); const int Rb = Epi::PERM ? ((R & ~31) + perm32(R & 31)) : R;
        voffA[i] = (unsigned)(R * K + C) * 2u; voffB[i] = (unsigned)(Rb * K + C) * 2u; }
    const size_t kstep = (size_t)(BK * 2);
    const size_t hstep = (size_t)HALF * K * 2;
    const size_t tstep = 2 * hstep;
    const unsigned ldsw = (unsigned)wid * 1024u;
    const int aoff = lds_byte(wr * 64 + fr, fq * 8), boff = lds_byte(wc * 32 + fr, fq * 8);
#define PG8_SA(b, h) (((b) * 2 + (h)) * HTB)
#define PG8_SB(b, h) ((4 + (b) * 2 + (h)) * HTB)
#define PG8_STAGE(bufoff, gbase, voff) do { _Pragma("unroll") for (int _i = 0; _i < 2; ++_i) \
        __builtin_amdgcn_global_load_lds((const unsigned*)((const char*)(gbase) + (voff)[_i]), (PG8_LAS unsigned*)(lds + (bufoff) + ldsw + _i * 8192), 16, 0, 0); } while (0)
#define PG8_LDA(dst, b, h) do { _Pragma("unroll") for (int m = 0; m < 4; ++m) _Pragma("unroll") for (int k = 0; k < 2; ++k) dst[m][k] = *(const PG8_LAS bf16x8*)(lds + PG8_SA(b, h) + aoff + m * 2048 + k * 1024); } while (0)
#define PG8_LDB(dst, b, h) do { _Pragma("unroll") for (int n = 0; n < 2; ++n) _Pragma("unroll") for (int k = 0; k < 2; ++k) dst[n][k] = *(const PG8_LAS bf16x8*)(lds + PG8_SB(b, h) + boff + n * 2048 + k * 1024); } while (0)
#define PG8_MMA(ai, bj, At, Bt) do { __builtin_amdgcn_s_setprio(1); _Pragma("unroll") for (int m = 0; m < 4; ++m) _Pragma("unroll") for (int n = 0; n < 2; ++n) _Pragma("unroll") for (int k = 0; k < 2; ++k) \
        acc[ai][bj][m][n] = __builtin_amdgcn_mfma_f32_16x16x32_bf16(Bt[n][k], At[m][k], acc[ai][bj][m][n], 0, 0, 0); __builtin_amdgcn_s_setprio(0); } while (0)
#define PG8_WAIT_V(n) asm volatile("s_waitcnt vmcnt(" #n ")" ::: "memory")
#define PG8_WAIT_L(n) asm volatile("s_waitcnt lgkmcnt(" #n ")" ::: "memory")
#define PG8_BAR __builtin_amdgcn_s_barrier()
#define PG8_SCHED __builtin_amdgcn_sched_barrier(0)
    Unit cur, nxt; int ui = 0;
    if (!S.next(0, cur)) return;
    f32x4 acc[2][2][4][2];
#pragma unroll
    for (int a = 0; a < 2; ++a)
#pragma unroll
        for (int b = 0; b < 2; ++b)
#pragma unroll
            for (int m = 0; m < 4; ++m)
#pragma unroll
                for (int n = 0; n < 2; ++n) acc[a][b][m][n] = (f32x4){0.f, 0.f, 0.f, 0.f};
    bf16x8 At[4][2], B0[2][2], B1[2][2];
    const char* cA = (const char*)g.A + (size_t)cur.pm * tstep; const char* cB = (const char*)g.Bt + (size_t)cur.pn * tstep;
    S.a_ready(cur);
    if constexpr (SP2) {
        PG8_STAGE(PG8_SB(0, 0), cB, voffB); PG8_STAGE(PG8_SB(0, 1), cB + hstep, voffB); PG8_STAGE(PG8_SA(0, 0), cA, voffA); PG8_STAGE(PG8_SA(0, 1), cA + hstep, voffA);
        if (wr == 1) PG8_BAR;
        PG8_WAIT_V(2); PG8_BAR;
        PG8_STAGE(PG8_SB(1, 0), cB + kstep, voffB); PG8_STAGE(PG8_SA(1, 0), cA + kstep, voffA); PG8_STAGE(PG8_SB(1, 1), cB + hstep + kstep, voffB);
        PG8_WAIT_V(6); PG8_BAR;
    } else {
        PG8_STAGE(PG8_SB(0, 0), cB, voffB); PG8_STAGE(PG8_SA(0, 0), cA, voffA); PG8_STAGE(PG8_SB(0, 1), cB + hstep, voffB); PG8_STAGE(PG8_SA(0, 1), cA + hstep, voffA);
        if (wr == 1) PG8_BAR;
        PG8_WAIT_V(4); PG8_BAR;
        PG8_STAGE(PG8_SB(1, 0), cB + kstep, voffB); PG8_STAGE(PG8_SA(1, 0), cA + kstep, voffA); PG8_STAGE(PG8_SB(1, 1), cB + hstep + kstep, voffB);
        PG8_WAIT_V(6); PG8_BAR;
    }
    for (;;) {
        const bool has_next = S.next(ui + 1, nxt);
        const char* nA = has_next ? (const char*)g.A + (size_t)nxt.pm * tstep : cA; const char* nB = has_next ? (const char*)g.Bt + (size_t)nxt.pn * tstep : cB;
        for (int t = 0; t < nt; t += 2) {
            const bool last = (t == nt - 2);
            const char* a1 = cA + (size_t)(t + 1) * kstep;
            const char* a2 = last ? nA : cA + (size_t)(t + 2) * kstep; const char* b2 = last ? nB : cB + (size_t)(t + 2) * kstep;
            const char* a3 = a2 + kstep; const char* b3 = b2 + kstep;
            if (last && has_next) S.a_ready(nxt);
            if constexpr (SP2) {
            PG8_LDB(B0, 0, 0); PG8_LDB(B1, 0, 1); PG8_SCHED; PG8_LDA(At, 0, 0); PG8_STAGE(PG8_SA(1, 1), a1 + hstep, voffA);
            PG8_WAIT_V(8); PG8_WAIT_L(0); PG8_BAR; PG8_MMA(0, 0, At, B0); PG8_MMA(0, 1, At, B1); PG8_BAR; PG8_SCHED;
            PG8_LDA(At, 0, 1); PG8_STAGE(PG8_SB(0, 0), b2, voffB); PG8_STAGE(PG8_SB(0, 1), b2 + hstep, voffB); PG8_STAGE(PG8_SA(0, 0), a2, voffA);
            PG8_WAIT_V(8); PG8_WAIT_L(0); PG8_BAR; PG8_MMA(1, 0, At, B0); PG8_MMA(1, 1, At, B1); PG8_BAR; PG8_SCHED;
            PG8_LDB(B0, 1, 0); PG8_LDB(B1, 1, 1); PG8_SCHED; PG8_LDA(At, 1, 0); PG8_STAGE(PG8_SA(0, 1), a2 + hstep, voffA);
            PG8_WAIT_V(8); PG8_WAIT_L(0); PG8_BAR; PG8_MMA(0, 0, At, B0); PG8_MMA(0, 1, At, B1); PG8_BAR; PG8_SCHED;
            PG8_LDA(At, 1, 1); PG8_STAGE(PG8_SB(1, 0), b3, voffB); PG8_STAGE(PG8_SB(1, 1), b3 + hstep, voffB); PG8_STAGE(PG8_SA(1, 0), a3, voffA);
            PG8_WAIT_V(8); PG8_WAIT_L(0); PG8_BAR; PG8_MMA(1, 0, At, B0); PG8_MMA(1, 1, At, B1); PG8_BAR; PG8_SCHED;
            } else {
            PG8_LDB(B0, 0, 0); PG8_SCHED; PG8_LDA(At, 0, 0); PG8_STAGE(PG8_SA(1, 1), a1 + hstep, voffA);
            PG8_WAIT_L(8); PG8_BAR; PG8_WAIT_L(0); PG8_MMA(0, 0, At, B0); PG8_BAR; PG8_SCHED;
            PG8_LDB(B1, 0, 1); PG8_STAGE(PG8_SB(0, 0), b2, voffB);
            PG8_BAR; PG8_WAIT_L(0); PG8_MMA(0, 1, At, B1); PG8_BAR;
            PG8_LDA(At, 0, 1); PG8_STAGE(PG8_SA(0, 0), a2, voffA);
            PG8_BAR; PG8_WAIT_L(0); PG8_MMA(1, 0, At, B0); PG8_BAR; PG8_SCHED;
            PG8_STAGE(PG8_SB(0, 1), b2 + hstep, voffB);
            PG8_WAIT_V(6); PG8_BAR; PG8_MMA(1, 1, At, B1); PG8_BAR;
            PG8_LDB(B0, 1, 0); PG8_SCHED; PG8_LDA(At, 1, 0); PG8_STAGE(PG8_SA(0, 1), a2 + hstep, voffA);
            PG8_WAIT_L(8); PG8_BAR; PG8_WAIT_L(0); PG8_MMA(0, 0, At, B0); PG8_BAR; PG8_SCHED;
            PG8_LDB(B1, 1, 1); PG8_STAGE(PG8_SB(1, 0), b3, voffB);
            PG8_BAR; PG8_WAIT_L(0); PG8_MMA(0, 1, At, B1); PG8_BAR;
            PG8_LDA(At, 1, 1); PG8_STAGE(PG8_SA(1, 0), a3, voffA);
            PG8_BAR; PG8_WAIT_L(0); PG8_MMA(1, 0, At, B0); PG8_BAR; PG8_SCHED;
            PG8_STAGE(PG8_SB(1, 1), b3 + hstep, voffB);
            PG8_WAIT_V(6); PG8_BAR; PG8_MMA(1, 1, At, B1); PG8_BAR;
            }
        }
        if constexpr (ALIGN_EPI) { if (wr == 0) PG8_BAR; }
        if constexpr (!Epi::AFTER_DRAIN) { E(acc, cur, wr, wc, fr, fq); S.done(cur); }
        if (!has_next) break;
#pragma unroll
        for (int a = 0; a < 2; ++a)
#pragma unroll
            for (int b = 0; b < 2; ++b)
#pragma unroll
                for (int m = 0; m < 4; ++m)
#pragma unroll
                    for (int n = 0; n < 2; ++n) acc[a][b][m][n] = (f32x4){0.f, 0.f, 0.f, 0.f};
        cur = nxt; cA = nA; cB = nB; ++ui;
        if constexpr (ALIGN_EPI) { if (wr == 1) PG8_BAR; }
    }
    PG8_WAIT_V(0);
    if constexpr (!ALIGN_EPI) { if (wr == 0) PG8_BAR; }
    PG8_BAR;
    if constexpr (Epi::AFTER_DRAIN) { E.fused(acc, cur, wr, wc, fr, fq, lds, wid, lane); S.done(cur); }
#undef PG8_SA
#undef PG8_SB
#undef PG8_STAGE
#undef PG8_LDA
#undef PG8_LDB
#undef PG8_MMA
#undef PG8_WAIT_V
#undef PG8_WAIT_L
#undef PG8_BAR
#undef PG8_SCHED
}

typedef int i32x4 __attribute__((ext_vector_type(4)));
template <class Epi, class Sched, bool ALIGN_EPI = false, bool SP2 = false>
__device__ __forceinline__ void gemm_phase_i8(PG8_LAS unsigned char* lds, const Gemm g, const Sched& S, const Epi& E, int wv) {
    unsigned m_op = ~0u; asm volatile("" : "+s"(m_op));
    const int tid = wv * 64 + (int)__builtin_amdgcn_mbcnt_hi(m_op, __builtin_amdgcn_mbcnt_lo(m_op, 0u)), wid = wv, lane = tid & 63, wr = wid >> 2, wc = wid & 3, fr = lane & 15, fq = lane >> 4;
    const int K = g.K, nt = K / BK;
    unsigned voffA[2], voffB[2];
#pragma unroll
    for (int i = 0; i < 2; ++i) { int R, C; stage_rc(tid * 16 + i * 8192, R, C); const int Rb = Epi::PERM ? ((R & ~31) + perm32(R & 31)) : R;
        voffA[i] = (unsigned)(R * K + C) * 2u; voffB[i] = (unsigned)(Rb * K + C) * 2u; }
    const size_t kstep = (size_t)(BK * 2);
    const size_t hstep = (size_t)HALF * K * 2;
    const size_t tstep = 2 * hstep;
    const unsigned ldsw = (unsigned)wid * 1024u;
    const int aoff = lds_byte(wr * 64 + fr, fq * 8), boff = lds_byte(wc * 32 + fr, fq * 8);
#define PG8_SA(b, h) (((b) * 2 + (h)) * HTB)
#define PG8_SB(b, h) ((4 + (b) * 2 + (h)) * HTB)
#define PG8_STAGE(bufoff, gbase, voff) do { _Pragma("unroll") for (int _i = 0; _i < 2; ++_i) \
        __builtin_amdgcn_global_load_lds((const unsigned*)((const char*)(gbase) + (voff)[_i]), (PG8_LAS unsigned*)(lds + (bufoff) + ldsw + _i * 8192), 16, 0, 0); } while (0)
#define PG8_LDA(dst, b, h) do { _Pragma("unroll") for (int m = 0; m < 4; ++m) _Pragma("unroll") for (int k = 0; k < 2; ++k) dst[m][k] = *(const PG8_LAS bf16x8*)(lds + PG8_SA(b, h) + aoff + m * 2048 + k * 1024); } while (0)
#define PG8_LDB(dst, b, h) do { _Pragma("unroll") for (int n = 0; n < 2; ++n) _Pragma("unroll") for (int k = 0; k < 2; ++k) dst[n][k] = *(const PG8_LAS bf16x8*)(lds + PG8_SB(b, h) + boff + n * 2048 + k * 1024); } while (0)
#define PG8_MMA(ai, bj, At, Bt) do { __builtin_amdgcn_s_setprio(1); _Pragma("unroll") for (int m = 0; m < 4; ++m) _Pragma("unroll") for (int n = 0; n < 2; ++n) _Pragma("unroll") for (int k = 0; k < 2; ++k) \
        acc[ai][bj][m][n] = __builtin_amdgcn_mfma_i32_16x16x64_i8(__builtin_bit_cast(i32x4, Bt[n][k]), __builtin_bit_cast(i32x4, At[m][k]), acc[ai][bj][m][n], 0, 0, 0); __builtin_amdgcn_s_setprio(0); } while (0)
#define PG8_WAIT_V(n) asm volatile("s_waitcnt vmcnt(" #n ")" ::: "memory")
#define PG8_WAIT_L(n) asm volatile("s_waitcnt lgkmcnt(" #n ")" ::: "memory")
#define PG8_BAR __builtin_amdgcn_s_barrier()
#define PG8_SCHED __builtin_amdgcn_sched_barrier(0)
    Unit cur, nxt; int ui = 0;
    if (!S.next(0, cur)) return;
    i32x4 acc[2][2][4][2];
#pragma unroll
    for (int a = 0; a < 2; ++a)
#pragma unroll
        for (int b = 0; b < 2; ++b)
#pragma unroll
            for (int m = 0; m < 4; ++m)
#pragma unroll
                for (int n = 0; n < 2; ++n) acc[a][b][m][n] = (i32x4){0, 0, 0, 0};
    bf16x8 At[4][2], B0[2][2], B1[2][2];
    const char* cA = (const char*)g.A + (size_t)cur.pm * tstep; const char* cB = (const char*)g.Bt + (size_t)cur.pn * tstep;
    S.a_ready(cur);
    if constexpr (SP2) {
        PG8_STAGE(PG8_SB(0, 0), cB, voffB); PG8_STAGE(PG8_SB(0, 1), cB + hstep, voffB); PG8_STAGE(PG8_SA(0, 0), cA, voffA); PG8_STAGE(PG8_SA(0, 1), cA + hstep, voffA);
        if (wr == 1) PG8_BAR;
        PG8_WAIT_V(2); PG8_BAR;
        PG8_STAGE(PG8_SB(1, 0), cB + kstep, voffB); PG8_STAGE(PG8_SA(1, 0), cA + kstep, voffA); PG8_STAGE(PG8_SB(1, 1), cB + hstep + kstep, voffB);
        PG8_WAIT_V(6); PG8_BAR;
    } else {
        PG8_STAGE(PG8_SB(0, 0), cB, voffB); PG8_STAGE(PG8_SA(0, 0), cA, voffA); PG8_STAGE(PG8_SB(0, 1), cB + hstep, voffB); PG8_STAGE(PG8_SA(0, 1), cA + hstep, voffA);
        if (wr == 1) PG8_BAR;
        PG8_WAIT_V(4); PG8_BAR;
        PG8_STAGE(PG8_SB(1, 0), cB + kstep, voffB); PG8_STAGE(PG8_SA(1, 0), cA + kstep, voffA); PG8_STAGE(PG8_SB(1, 1), cB + hstep + kstep, voffB);
        PG8_WAIT_V(6); PG8_BAR;
    }
    for (;;) {
        const bool has_next = S.next(ui + 1, nxt);
        const char* nA = has_next ? (const char*)g.A + (size_t)nxt.pm * tstep : cA; const char* nB = has_next ? (const char*)g.Bt + (size_t)nxt.pn * tstep : cB;
        for (int t = 0; t < nt; t += 2) {
            const bool last = (t == nt - 2);
            const char* a1 = cA + (size_t)(t + 1) * kstep;
            const char* a2 = last ? nA : cA + (size_t)(t + 2) * kstep; const char* b2 = last ? nB : cB + (size_t)(t + 2) * kstep;
            const char* a3 = a2 + kstep; const char* b3 = b2 + kstep;
            if (last && has_next) S.a_ready(nxt);
            if constexpr (SP2) {
            PG8_LDB(B0, 0, 0); PG8_LDB(B1, 0, 1); PG8_SCHED; PG8_LDA(At, 0, 0); PG8_STAGE(PG8_SA(1, 1), a1 + hstep, voffA);
            PG8_WAIT_V(8); PG8_WAIT_L(0); PG8_BAR; PG8_MMA(0, 0, At, B0); PG8_MMA(0, 1, At, B1); PG8_BAR; PG8_SCHED;
            PG8_LDA(At, 0, 1); PG8_STAGE(PG8_SB(0, 0), b2, voffB); PG8_STAGE(PG8_SB(0, 1), b2 + hstep, voffB); PG8_STAGE(PG8_SA(0, 0), a2, voffA);
            PG8_WAIT_V(8); PG8_WAIT_L(0); PG8_BAR; PG8_MMA(1, 0, At, B0); PG8_MMA(1, 1, At, B1); PG8_BAR; PG8_SCHED;
            PG8_LDB(B0, 1, 0); PG8_LDB(B1, 1, 1); PG8_SCHED; PG8_LDA(At, 1, 0); PG8_STAGE(PG8_SA(0, 1), a2 + hstep, voffA);
            PG8_WAIT_V(8); PG8_WAIT_L(0); PG8_BAR; PG8_MMA(0, 0, At, B0); PG8_MMA(0, 1, At, B1); PG8_BAR; PG8_SCHED;
            PG8_LDA(At, 1, 1); PG8_STAGE(PG8_SB(1, 0), b3, voffB); PG8_STAGE(PG8_SB(1, 1), b3 + hstep, voffB); PG8_STAGE(PG8_SA(1, 0), a3, voffA);
            PG8_WAIT_V(8); PG8_WAIT_L(0); PG8_BAR; PG8_MMA(1, 0, At, B0); PG8_MMA(1, 1, At, B1); PG8_BAR; PG8_SCHED;
            } else {
            PG8_LDB(B0, 0, 0); PG8_SCHED; PG8_LDA(At, 0, 0); PG8_STAGE(PG8_SA(1, 1), a1 + hstep, voffA);
            PG8_WAIT_L(8); PG8_BAR; PG8_WAIT_L(0); PG8_MMA(0, 0, At, B0); PG8_BAR; PG8_SCHED;
            PG8_LDB(B1, 0, 1); PG8_STAGE(PG8_SB(0, 0), b2, voffB);
            PG8_BAR; PG8_WAIT_L(0); PG8_MMA(0, 1, At, B1); PG8_BAR;
            PG8_LDA(At, 0, 1); PG8_STAGE(PG8_SA(0, 0), a2, voffA);
            PG8_BAR; PG8_WAIT_L(0); PG8_MMA(1, 0, At, B0); PG8_BAR; PG8_SCHED;
            PG8_STAGE(PG8_SB(0, 1), b2 + hstep, voffB);
            PG8_WAIT_V(6); PG8_BAR; PG8_MMA(1, 1, At, B1); PG8_BAR;
            PG8_LDB(B0, 1, 0); PG8_SCHED; PG8_LDA(At, 1, 0); PG8_STAGE(PG8_SA(0, 1), a2 + hstep, voffA);
            PG8_WAIT_L(8); PG8_BAR; PG8_WAIT_L(0); PG8_MMA(0, 0, At, B0); PG8_BAR; PG8_SCHED;
            PG8_LDB(B1, 1, 1); PG8_STAGE(PG8_SB(1, 0), b3, voffB);
            PG8_BAR; PG8_WAIT_L(0); PG8_MMA(0, 1, At, B1); PG8_BAR;
            PG8_LDA(At, 1, 1); PG8_STAGE(PG8_SA(1, 0), a3, voffA);
            PG8_BAR; PG8_WAIT_L(0); PG8_MMA(1, 0, At, B0); PG8_BAR; PG8_SCHED;
            PG8_STAGE(PG8_SB(1, 1), b3 + hstep, voffB);
            PG8_WAIT_V(6); PG8_BAR; PG8_MMA(1, 1, At, B1); PG8_BAR;
            }
        }
        if constexpr (ALIGN_EPI) { if (wr == 0) PG8_BAR; }
        if constexpr (!Epi::AFTER_DRAIN) { E(acc, cur, wr, wc, fr, fq); S.done(cur); }
        if (!has_next) break;
#pragma unroll
        for (int a = 0; a < 2; ++a)
#pragma unroll
            for (int b = 0; b < 2; ++b)
#pragma unroll
                for (int m = 0; m < 4; ++m)
#pragma unroll
                    for (int n = 0; n < 2; ++n) acc[a][b][m][n] = (i32x4){0, 0, 0, 0};
        cur = nxt; cA = nA; cB = nB; ++ui;
        if constexpr (ALIGN_EPI) { if (wr == 1) PG8_BAR; }
    }
    PG8_WAIT_V(0);
    if constexpr (!ALIGN_EPI) { if (wr == 0) PG8_BAR; }
    PG8_BAR;
    if constexpr (Epi::AFTER_DRAIN) { E.fused(acc, cur, wr, wc, fr, fq, lds, wid, lane); S.done(cur); }
#undef PG8_SA
#undef PG8_SB
#undef PG8_STAGE
#undef PG8_LDA
#undef PG8_LDB
#undef PG8_MMA
#undef PG8_WAIT_V
#undef PG8_WAIT_L
#undef PG8_BAR
#undef PG8_SCHED
}
}


#define LAS __attribute__((address_space(3)))

__device__ __forceinline__ int op_bid() { int b = (int)blockIdx.x; asm volatile("" : "+s"(b)); return b; }
__device__ __forceinline__ int op_grid() { int g = (int)gridDim.x; asm volatile("" : "+s"(g)); return g; }
__device__ __forceinline__ int phase_tid(int wv) { unsigned m = ~0u; asm volatile("" : "+s"(m)); return wv * 64 + (int)__builtin_amdgcn_mbcnt_hi(m, __builtin_amdgcn_mbcnt_lo(m, 0u)); }
typedef unsigned short bf16_t;
typedef float f32x4 __attribute__((ext_vector_type(4)));
typedef unsigned u32x4 __attribute__((ext_vector_type(4)));
typedef unsigned u32x2 __attribute__((ext_vector_type(2)));

constexpr int BATCH = 8, SEQ = 4096, DM = 1024, T = BATCH * SEQ, DEPTH = 2;
constexpr int NPROJ = 4352, NMOD = 6 * DM;
constexpr int NEXP = 16384, PQ = 2048;
constexpr float NORM_EPS = 1e-6f;
constexpr float LOG2E = 1.4426950408889634f;
constexpr float QSCALE = 0.125f * LOG2E;
constexpr float SB_EXIT = 160.0f;

constexpr size_t MiB = 1u << 20;
constexpr size_t WS_CTL = 0;
constexpr size_t WS_MOD = 1 * MiB;
constexpr size_t WS_ROPE = 2 * MiB;
constexpr size_t WS_WIN = 10 * MiB;
constexpr size_t WS_WBA = 27 * MiB;
constexpr size_t WS_WBB = 29 * MiB;
constexpr size_t WS_WOUT = 31 * MiB;
constexpr size_t WS_WQ = 35 * MiB;
constexpr size_t WS_SK = 43 * MiB;
constexpr size_t WS_UQ = 44 * MiB;
constexpr size_t WS_VQ = 76 * MiB;
constexpr size_t WS_USC = 108 * MiB;
constexpr size_t WS_HS = 109 * MiB;
constexpr size_t WS_H = 112 * MiB;
constexpr size_t WS_QA = 176 * MiB;
constexpr size_t WS_QB = 208 * MiB;
constexpr size_t WS_KB = 240 * MiB;
constexpr size_t WS_VB = 272 * MiB;
constexpr size_t WS_KA = 304 * MiB;
constexpr size_t WS_VA = 312 * MiB;
constexpr size_t WS_GA = 320 * MiB;
constexpr size_t WS_GB = 384 * MiB;
constexpr size_t WS_XB = 448 * MiB;
constexpr size_t WS_END = 512 * MiB;
constexpr size_t WS_H2Q = WS_QA, WS_UM = WS_VB, WS_Q2 = WS_GA, WS_COEF = WS_GA;
constexpr size_t WS_IDX_UNUSED = WS_KB;
constexpr int CTL_BAR = 4096;
constexpr size_t WS_IDX16 = WS_KB + 16 * MiB;
constexpr size_t WS_CSIN = WS_MOD + 512 * 1024;
constexpr size_t WS_CSQ = WS_CSIN + 64 * 1024;
constexpr size_t WS_CMAXIN = WS_CTL + 65536;
constexpr size_t WS_CMAXQ = WS_CTL + 102400;
constexpr size_t WS_MODP = WS_GB;
constexpr size_t WS_ZERO_BYTES = 736 * 1024;
constexpr size_t WS_HS1 = WS_HS + 768 * 1024;
constexpr int CTL_ATTQ = 8192;
constexpr int CTL_QUEUE = 1024;

constexpr int LDS_BYTES = 147456;
constexpr int NTHREADS = 512, NWAVES = 8;

struct KArgs {
    const float* x; const float* c; const int* pos; const float* ada_w; const float* ada_b; const float* norm1_g; const float* w_in; const float* sinks;
    const float* wbr_a; const float* wbr_b; const float* w_out; const float* norm2_g; const float* wq; const float* subkeys; const float* pu; const float* pv; const float* final_g;
    float* out; unsigned char* ws; int ph_lo, ph_hi;
};

__device__ __forceinline__ unsigned f2bf(float f) { unsigned r; asm("v_cvt_pk_bf16_f32 %0, %1, 0" : "=v"(r) : "v"(f)); return r; }
__device__ __forceinline__ unsigned pk2(float lo, float hi) { unsigned r; asm("v_cvt_pk_bf16_f32 %0, %1, %2" : "=v"(r) : "v"(lo), "v"(hi)); return r; }
__device__ __forceinline__ float bflo(unsigned w) { return __uint_as_float(w << 16); }
__device__ __forceinline__ float bfhi(unsigned w) { return __uint_as_float(w & 0xffff0000u); }
__device__ __forceinline__ unsigned peer_pos(unsigned i, unsigned j) { return (((i + j) & 7u) << 11) | (i << 4) | (j >> 3); }
template <int M> __device__ __forceinline__ float swz_xor(float v) { return __int_as_float(__builtin_amdgcn_ds_swizzle(__float_as_int(v), (M << 10) | 0x1f)); }
__device__ __forceinline__ float wave_sum(float v) {
    v += swz_xor<1>(v); v += swz_xor<2>(v); v += swz_xor<4>(v); v += swz_xor<8>(v); v += swz_xor<16>(v);
    auto rr = __builtin_amdgcn_permlane32_swap(__float_as_uint(v), __float_as_uint(v), false, false);
    return __uint_as_float(rr[0]) + __uint_as_float(rr[1]);
}
__device__ __forceinline__ float wave_max(float v) {
    v = fmaxf(v, swz_xor<1>(v)); v = fmaxf(v, swz_xor<2>(v)); v = fmaxf(v, swz_xor<4>(v)); v = fmaxf(v, swz_xor<8>(v)); v = fmaxf(v, swz_xor<16>(v));
    auto rr = __builtin_amdgcn_permlane32_swap(__float_as_uint(v), __float_as_uint(v), false, false);
    return fmaxf(__uint_as_float(rr[0]), __uint_as_float(rr[1]));
}
template <int CTRL> __device__ __forceinline__ float dpp_f(float v) { return __int_as_float(__builtin_amdgcn_update_dpp(0, __float_as_int(v), CTRL, 0xF, 0xF, true)); }
__device__ __forceinline__ float wave_sum_dpp(float v) {
    v += dpp_f<0xB1>(v); v += dpp_f<0x4E>(v); v += dpp_f<0x141>(v); v += dpp_f<0x140>(v);
    { auto rr = __builtin_amdgcn_permlane16_swap(__float_as_uint(v), __float_as_uint(v), false, false); v = __uint_as_float(rr[0]) + __uint_as_float(rr[1]); }
    { auto rr = __builtin_amdgcn_permlane32_swap(__float_as_uint(v), __float_as_uint(v), false, false); v = __uint_as_float(rr[0]) + __uint_as_float(rr[1]); }
    return v;
}
__device__ __forceinline__ float wave_max_dpp(float v) {
    v = fmaxf(v, dpp_f<0xB1>(v)); v = fmaxf(v, dpp_f<0x4E>(v)); v = fmaxf(v, dpp_f<0x141>(v)); v = fmaxf(v, dpp_f<0x140>(v));
    { auto rr = __builtin_amdgcn_permlane16_swap(__float_as_uint(v), __float_as_uint(v), false, false); v = fmaxf(__uint_as_float(rr[0]), __uint_as_float(rr[1])); }
    { auto rr = __builtin_amdgcn_permlane32_swap(__float_as_uint(v), __float_as_uint(v), false, false); v = fmaxf(__uint_as_float(rr[0]), __uint_as_float(rr[1])); }
    return v;
}
__device__ __forceinline__ int rdlane_i(int v, int l) { return __builtin_amdgcn_readlane(v, __builtin_amdgcn_readfirstlane(l)); }
__device__ __forceinline__ float rdlane_f(float v, int l) { return __int_as_float(__builtin_amdgcn_readlane(__float_as_int(v), __builtin_amdgcn_readfirstlane(l))); }
__device__ __forceinline__ float dot8(u32x4 a, u32x4 b, float acc) {
    acc = fmaf(bflo(a.x), bflo(b.x), acc); acc = fmaf(bfhi(a.x), bfhi(b.x), acc);
    acc = fmaf(bflo(a.y), bflo(b.y), acc); acc = fmaf(bfhi(a.y), bfhi(b.y), acc);
    acc = fmaf(bflo(a.z), bflo(b.z), acc); acc = fmaf(bfhi(a.z), bfhi(b.z), acc);
    acc = fmaf(bflo(a.w), bflo(b.w), acc); acc = fmaf(bfhi(a.w), bfhi(b.w), acc);
    return acc;
}
__device__ __forceinline__ float softplus2(float z2) {
    return fmaxf(z2, 0.f) + __log2f(1.0f + exp2f(-fabsf(z2)));
}

__device__ __forceinline__ int win_pos(int n) {
    if (n >= 640) return n;
    const int hb = n & ~63, d = n & 63;
    return hb + (d < 32 ? 2 * d : 2 * (d - 32) + 1);
}
template <bool WIN>
__device__ __forceinline__ void transpose_item(const float* W, int K, int N, bf16_t* WT, LAS float* scr, int item, int lane) {
    const int nblk = N / 32, kb = item / nblk, nb = item % nblk, k0 = 64 * kb, n0 = 32 * nb;
    {
        float tv[32];
#pragma unroll
        for (int i = 0; i < 32; ++i) { const int kk = 2 * i + (lane >> 5); tv[i] = W[(size_t)(k0 + kk) * N + n0 + (lane & 31)]; }
#pragma unroll
        for (int i = 0; i < 32; ++i) { const int kk = 2 * i + (lane >> 5); scr[kk * 33 + (lane & 31)] = tv[i]; }
    }
    asm volatile("s_waitcnt lgkmcnt(0)" ::: "memory");
    const int c = lane & 7;
#pragma unroll
    for (int j = 0; j < 4; ++j) { const int n = (lane >> 3) + 8 * j; const LAS float* s = scr + (8 * c) * 33 + n;
        u32x4 o; o.x = pk2(s[0 * 33], s[1 * 33]); o.y = pk2(s[2 * 33], s[3 * 33]); o.z = pk2(s[4 * 33], s[5 * 33]); o.w = pk2(s[6 * 33], s[7 * 33]);
        const int row = WIN ? win_pos(n0 + n) : (n0 + n);
        *(u32x4*)(WT + (size_t)row * K + k0 + 8 * c) = o; }
    asm volatile("s_waitcnt lgkmcnt(0)" ::: "memory");
}
template <bool OFFSET128>
__device__ __forceinline__ void quant_row(const f32x4 (&v)[4], unsigned char* dst_row, float* scale_out, int lane) {
    float am = 0.f;
#pragma unroll
    for (int i = 0; i < 4; ++i) am = fmaxf(am, fmaxf(fmaxf(fabsf(v[i].x), fabsf(v[i].y)), fmaxf(fabsf(v[i].z), fabsf(v[i].w))));
    am = wave_max_dpp(am);
    const float inv = am > 0.f ? 127.0f / am : 0.f, sc = am > 0.f ? am / 127.0f : 1.0f;
    u32x4 o;
#pragma unroll
    for (int i = 0; i < 4; ++i) {
        int q0 = (int)rintf(v[i].x * inv), q1 = (int)rintf(v[i].y * inv), q2 = (int)rintf(v[i].z * inv), q3 = (int)rintf(v[i].w * inv);
        if (OFFSET128) { q0 += 128; q1 += 128; q2 += 128; q3 += 128; }
        o[i] = (unsigned)(q0 & 0xff) | ((unsigned)(q1 & 0xff) << 8) | ((unsigned)(q2 & 0xff) << 16) | ((unsigned)(q3 & 0xff) << 24);
    }
    *(u32x4*)(dst_row + 16 * lane) = o;
    if (lane == 0) *scale_out = sc;
}

__device__ __forceinline__ void quant_row_nat(const f32x4 (&v)[4], unsigned char* dst_row, float* scale_out, int lane) {
    float am = 0.f;
#pragma unroll
    for (int i = 0; i < 4; ++i) am = fmaxf(am, fmaxf(fmaxf(fabsf(v[i].x), fabsf(v[i].y)), fmaxf(fabsf(v[i].z), fabsf(v[i].w))));
    am = wave_max_dpp(am);
    const float inv = am > 0.f ? 127.0f / am : 0.f, sc = am > 0.f ? am / 127.0f : 1.0f;
#pragma unroll
    for (int i = 0; i < 4; ++i) {
        const int q0 = (int)rintf(v[i].x * inv), q1 = (int)rintf(v[i].y * inv), q2 = (int)rintf(v[i].z * inv), q3 = (int)rintf(v[i].w * inv);
        *(unsigned*)(dst_row + 256 * i + 4 * lane) = (unsigned)(q0 & 0xff) | ((unsigned)(q1 & 0xff) << 8) | ((unsigned)(q2 & 0xff) << 16) | ((unsigned)(q3 & 0xff) << 24);
    }
    if (lane == 0) *scale_out = sc;
}
template <bool WIN>
__device__ __forceinline__ void transpose_item_i8(const float* W, int K, int N, unsigned char* WT, const float* cscale, LAS float* scr, int item, int lane) {
    const int nblk = N / 32, kb = item / nblk, nb = item % nblk, k0 = 64 * kb, n0 = 32 * nb;
    {
        float tv[32];
#pragma unroll
        for (int i = 0; i < 32; ++i) { const int kk = 2 * i + (lane >> 5); tv[i] = W[(size_t)(k0 + kk) * N + n0 + (lane & 31)]; }
#pragma unroll
        for (int i = 0; i < 32; ++i) { const int kk = 2 * i + (lane >> 5); scr[kk * 33 + (lane & 31)] = tv[i]; }
    }
    asm volatile("s_waitcnt lgkmcnt(0)" ::: "memory");
    const int c = lane & 3;
#pragma unroll
    for (int j = 0; j < 2; ++j) { const int n = (lane >> 2) + 16 * j; const LAS float* sp = scr + (16 * c) * 33 + n;
        const int row = WIN ? win_pos(n0 + n) : (n0 + n);
        const float mx = cscale[row], inv = mx > 0.f ? 127.0f / mx : 0.f;
        u32x4 o;
#pragma unroll
        for (int w = 0; w < 4; ++w) { const int q0 = (int)rintf(sp[(4 * w) * 33] * inv), q1 = (int)rintf(sp[(4 * w + 1) * 33] * inv), q2 = (int)rintf(sp[(4 * w + 2) * 33] * inv), q3 = (int)rintf(sp[(4 * w + 3) * 33] * inv);
            o[w] = (unsigned)(q0 & 0xff) | ((unsigned)(q1 & 0xff) << 8) | ((unsigned)(q2 & 0xff) << 16) | ((unsigned)(q3 & 0xff) << 24); }
        *(u32x4*)(WT + (size_t)row * K + k0 + 16 * c) = o; }
    asm volatile("s_waitcnt lgkmcnt(0)" ::: "memory");
}
__device__ __forceinline__ void peer_tables_layer(const KArgs& a, int l, int part, int nparts, int lane) {
    unsigned char* ws = a.ws;
    const int rend = (l + 1) * NEXP, rstep = nparts * 4;
#define PT_LOADU(buf, r0_) do { _Pragma("unroll") for (int j = 0; j < 4; ++j) _Pragma("unroll") for (int i = 0; i < 4; ++i) buf[j][i] = ((const f32x4*)(a.pu + (size_t)((r0_) + j) * 1024))[64 * i + lane]; } while (0)
#define PT_QUANTU(buf, r0_) do { _Pragma("unroll") for (int j = 0; j < 4; ++j) { const unsigned e = (unsigned)((r0_) + j - l * NEXP), pr = (unsigned)(l * NEXP) + peer_pos(e >> 7, e & 127u); \
            quant_row_nat(buf[j], ws + WS_UQ + (size_t)pr * 1024, (float*)(ws + WS_USC) + 2 * pr, lane); } } while (0)
#define PT_LOADV(buf, r0_) do { _Pragma("unroll") for (int j = 0; j < 4; ++j) _Pragma("unroll") for (int i = 0; i < 4; ++i) buf[j][i] = ((const f32x4*)(a.pv + (size_t)((r0_) + j) * 1024))[4 * lane + i]; } while (0)
#define PT_QUANTV(buf, r0_) do { _Pragma("unroll") for (int j = 0; j < 4; ++j) { const unsigned e0 = (unsigned)((r0_) + j - l * NEXP), e = peer_pos(e0 >> 7, e0 & 127u); const int lr = l * NEXP + (int)e; \
            quant_row<false>(buf[j], ws + WS_VQ + (size_t)l * NEXP * 1024 + ((size_t)(lane >> 3) * NEXP + e) * 128 + 16 * (lane & 7) - 16 * lane, (float*)(ws + WS_USC) + 2 * lr + 1, lane); } } while (0)
    {
        f32x4 va[4][4], vb[4][4];
        int r = l * NEXP + part * 4;
        if (r < rend) PT_LOADU(va, r);
#pragma unroll 1
        for (; r < rend; r += 2 * rstep) {
            const int r2 = r + rstep, r3 = r2 + rstep;
            if (r2 < rend) PT_LOADU(vb, r2);
            __builtin_amdgcn_sched_barrier(0);
            PT_QUANTU(va, r);
            __builtin_amdgcn_sched_barrier(0);
            if (r3 < rend) PT_LOADU(va, r3);
            __builtin_amdgcn_sched_barrier(0);
            if (r2 < rend) PT_QUANTU(vb, r2);
            __builtin_amdgcn_sched_barrier(0);
        }
    }
    {
        f32x4 va[4][4], vb[4][4];
        int r = l * NEXP + part * 4;
        if (r < rend) PT_LOADV(va, r);
#pragma unroll 1
        for (; r < rend; r += 2 * rstep) {
            const int r2 = r + rstep, r3 = r2 + rstep;
            if (r2 < rend) PT_LOADV(vb, r2);
            __builtin_amdgcn_sched_barrier(0);
            PT_QUANTV(va, r);
            __builtin_amdgcn_sched_barrier(0);
            if (r3 < rend) PT_LOADV(va, r3);
            __builtin_amdgcn_sched_barrier(0);
            if (r2 < rend) PT_QUANTV(vb, r2);
            __builtin_amdgcn_sched_barrier(0);
        }
    }
#undef PT_LOADU
#undef PT_QUANTU
#undef PT_LOADV
#undef PT_QUANTV
}
__device__ __forceinline__ void ph_prologue(const KArgs& a, LAS unsigned char* lds, int wv) {
    const int tid = phase_tid(wv), lane = tid & 63, wave = wv, G = op_grid();
    const int gw = op_bid() * NWAVES + wave, NGW = G * NWAVES;
    unsigned char* ws = a.ws;
    {
        LAS float* sc = (LAS float*)lds;
        LAS float* red = (LAS float*)(lds + 4096);
        constexpr int N_MOD = DEPTH * 8 * 24, N_AMX = DEPTH * 8 * 25;
        for (int it = op_bid(); it < N_MOD + N_AMX; it += G) {
            if (it < N_MOD) {
                const int l = it / 192, r = it % 192, kb = r / 24, j0 = (r % 24) * 256, k0 = kb * 128;
                const float* wp = a.ada_w + ((size_t)l * 1024 + k0 + wave * 16) * NMOD + j0 + 4 * lane;
                f32x4 wv_[16];
#pragma unroll
                for (int i = 0; i < 16; ++i) wv_[i] = *(const f32x4*)(wp + (size_t)i * NMOD);
                __builtin_amdgcn_sched_barrier(0);
                {   const int b0 = tid >> 7, kk = tid & 127;
                    const float c0 = a.c[b0 * 1024 + k0 + kk], c1 = a.c[(b0 + 4) * 1024 + k0 + kk];
                    sc[kk * 8 + b0] = c0 * __builtin_amdgcn_rcpf(1.0f + __builtin_amdgcn_exp2f(c0 * -1.44269504089f));
                    sc[kk * 8 + b0 + 4] = c1 * __builtin_amdgcn_rcpf(1.0f + __builtin_amdgcn_exp2f(c1 * -1.44269504089f)); }
                __syncthreads();
                f32x4 acc[8];
#pragma unroll
                for (int b = 0; b < 8; ++b) acc[b] = (f32x4){0.f, 0.f, 0.f, 0.f};
#pragma unroll
                for (int i = 0; i < 16; ++i) {
                    const f32x4 s0 = *(const LAS f32x4*)(sc + (wave * 16 + i) * 8), s1 = *(const LAS f32x4*)(sc + (wave * 16 + i) * 8 + 4);
                    acc[0] += wv_[i] * s0.x; acc[1] += wv_[i] * s0.y; acc[2] += wv_[i] * s0.z; acc[3] += wv_[i] * s0.w;
                    acc[4] += wv_[i] * s1.x; acc[5] += wv_[i] * s1.y; acc[6] += wv_[i] * s1.z; acc[7] += wv_[i] * s1.w;
                }
#pragma unroll
                for (int b = 0; b < 8; ++b) *(LAS f32x4*)(red + (wave * 8 + b) * 256 + 4 * lane) = acc[b];
                __syncthreads();
                {
                    f32x4 t = {0.f, 0.f, 0.f, 0.f};
#pragma unroll
                    for (int w = 0; w < 8; ++w) t += *(const LAS f32x4*)(red + (w * 8 + wave) * 256 + 4 * lane);
                    if (kb == 0) t += *(const f32x4*)(a.ada_b + l * NMOD + j0 + 4 * lane);
                    *(f32x4*)((float*)(ws + WS_MODP) + (size_t)kb * (DEPTH * 8 * NMOD) + (size_t)(l * 8 + wave) * NMOD + j0 + 4 * lane) = t;
                }
                __syncthreads();
            } else {
                const int ia = it - N_MOD, l = ia / 200, r = ia % 200, kb = r / 25, cb = r % 25; const bool isq = cb >= 17;
                const int N = isq ? PQ : NPROJ, j0 = (isq ? cb - 17 : cb) * 256, k0 = kb * 128;
                const float* wp = (isq ? a.wq + (size_t)l * 1024 * PQ : a.w_in + (size_t)l * 1024 * NPROJ) + (size_t)(k0 + wave * 16) * N + j0 + 4 * lane;
                f32x4 wv_[16];
#pragma unroll
                for (int i = 0; i < 16; ++i) wv_[i] = *(const f32x4*)(wp + (size_t)i * N);
                __builtin_amdgcn_sched_barrier(0);
                f32x4 m = {0.f, 0.f, 0.f, 0.f};
#pragma unroll
                for (int i = 0; i < 16; ++i) { m.x = fmaxf(m.x, fabsf(wv_[i].x)); m.y = fmaxf(m.y, fabsf(wv_[i].y)); m.z = fmaxf(m.z, fabsf(wv_[i].z)); m.w = fmaxf(m.w, fabsf(wv_[i].w)); }
                *(LAS f32x4*)(red + wave * 256 + 4 * lane) = m;
                __syncthreads();
                if (wave == 0) {
#pragma unroll
                    for (int w = 1; w < 8; ++w) { const f32x4 o = *(const LAS f32x4*)(red + w * 256 + 4 * lane); m.x = fmaxf(m.x, o.x); m.y = fmaxf(m.y, o.y); m.z = fmaxf(m.z, o.z); m.w = fmaxf(m.w, o.w); }
                    unsigned* cm = isq ? (unsigned*)(ws + WS_CMAXQ) + l * PQ : (unsigned*)(ws + WS_CMAXIN) + l * NPROJ;
                    const int ja = j0 + 4 * lane;
                    atomicMax(cm + (isq ? ja : win_pos(ja)), __float_as_uint(m.x)); atomicMax(cm + (isq ? ja + 1 : win_pos(ja + 1)), __float_as_uint(m.y));
                    atomicMax(cm + (isq ? ja + 2 : win_pos(ja + 2)), __float_as_uint(m.z)); atomicMax(cm + (isq ? ja + 3 : win_pos(ja + 3)), __float_as_uint(m.w));
                }
                __syncthreads();
            }
        }
    }
    {
        LAS float* scr = (LAS float*)(lds + 32768 + wave * 8448);
        constexpr int I_BR = 8 * 32, I_OUT = 16 * 32, I_L = 2 * I_BR + I_OUT;
        for (int it = gw; it < DEPTH * I_L; it += NGW) {
            const int l = it / I_L; int r = it % I_L;
            if (r < I_BR) { transpose_item<false>(a.wbr_a + (size_t)l * 512 * 1024, 512, 1024, (bf16_t*)(ws + WS_WBA) + (size_t)l * 1024 * 512, scr, r, lane); continue; } r -= I_BR;
            if (r < I_BR) { transpose_item<false>(a.wbr_b + (size_t)l * 512 * 1024, 512, 1024, (bf16_t*)(ws + WS_WBB) + (size_t)l * 1024 * 512, scr, r, lane); continue; } r -= I_BR;
            transpose_item<false>(a.w_out + (size_t)l * 1024 * 1024, 1024, 1024, (bf16_t*)(ws + WS_WOUT) + (size_t)l * 1024 * 1024, scr, r, lane);
        }
    }
    {
        const int gt = op_bid() * NTHREADS + tid, NGT = G * NTHREADS;
        for (int i = gt; i < DEPTH * 8 * 2 * 128 * 128 / 8; i += NGT) {
            const f32x4 v0 = *(const f32x4*)(a.subkeys + (size_t)i * 8), v1 = *(const f32x4*)(a.subkeys + (size_t)i * 8 + 4);
            u32x4 o; o.x = pk2(v0.x, v0.y); o.y = pk2(v0.z, v0.w); o.z = pk2(v1.x, v1.y); o.w = pk2(v1.z, v1.w);
            *(u32x4*)((bf16_t*)(ws + WS_SK) + (size_t)i * 8) = o;
        }
        for (int i = gt; i < T * 32; i += NGT) {
            const int t = i >> 5, f = i & 31;
            double inv = 1.0;
            for (int k = 0; k < f; ++k) inv *= 0.7498942093324559;
            const double ang = (double)a.pos[t] * inv;
            const double kq = rint(ang * 0.63661977236758134308);
            const double r = fma(-kq, 6.123233995736766036e-17, fma(-kq, 1.57079632679489655800, ang));
            const int quad = (int)((long long)kq & 3);
            const double r2 = r * r;
            double sp = -1.0 / 1307674368000.0; sp = fma(sp, r2, 1.0 / 6227020800.0); sp = fma(sp, r2, -1.0 / 39916800.0); sp = fma(sp, r2, 1.0 / 362880.0);
            sp = fma(sp, r2, -1.0 / 5040.0); sp = fma(sp, r2, 1.0 / 120.0); sp = fma(sp, r2, -1.0 / 6.0); sp = fma(sp * r2, r, r);
            double cp = 1.0 / 20922789888000.0; cp = fma(cp, r2, -1.0 / 87178291200.0); cp = fma(cp, r2, 1.0 / 479001600.0); cp = fma(cp, r2, -1.0 / 3628800.0);
            cp = fma(cp, r2, 1.0 / 40320.0); cp = fma(cp, r2, -1.0 / 720.0); cp = fma(cp, r2, 1.0 / 24.0); cp = fma(cp, r2, -0.5); cp = fma(cp, r2, 1.0);
            const double sn = (quad == 0) ? sp : (quad == 1) ? cp : (quad == 2) ? -sp : -cp;
            const double cs = (quad == 0) ? cp : (quad == 1) ? -sp : (quad == 2) ? -cp : sp;
            float* rp = (float*)(ws + WS_ROPE) + (size_t)i * 2; rp[0] = (float)cs; rp[1] = (float)sn;
        }
    }
    if (op_bid() == 0) for (int i = tid; i < DEPTH * 2 * 8 * 64; i += NTHREADS) ((unsigned*)(ws + WS_CTL))[CTL_QUEUE + i] = 0u;
}

__device__ __forceinline__ void ph_prologue_b(const KArgs& a, LAS unsigned char* lds, int wv) {
    const int tid = phase_tid(wv), lane = tid & 63, wave = wv;
    const int gw = op_bid() * NWAVES + wave, NGW = op_grid() * NWAVES;
    unsigned char* ws = a.ws;
    LAS float* scr = (LAS float*)(lds + wave * 8448);
    constexpr int I_IN = 16 * 136, I_Q = 16 * 64, I_L = I_IN + I_Q;
    for (int i = (gw * 64 + lane) * 4; i < DEPTH * 8 * NMOD; i += NGW * 64 * 4) {
        f32x4 t = *(const f32x4*)((const float*)(ws + WS_MODP) + i);
#pragma unroll
        for (int kb = 1; kb < 8; ++kb) t += *(const f32x4*)((const float*)(ws + WS_MODP) + (size_t)kb * (DEPTH * 8 * NMOD) + i);
        *(f32x4*)((float*)(ws + WS_MOD) + i) = t;
    }
    for (int i = gw * 64 + lane; i < DEPTH * NPROJ; i += NGW * 64) ((float*)(ws + WS_CSIN))[i] = __uint_as_float(((const unsigned*)(ws + WS_CMAXIN))[i]) * (1.0f / 127.0f);
    for (int i = gw * 64 + lane; i < DEPTH * PQ; i += NGW * 64) ((float*)(ws + WS_CSQ))[i] = __uint_as_float(((const unsigned*)(ws + WS_CMAXQ))[i]) * (1.0f / 127.0f);
    for (int it = gw; it < DEPTH * I_L; it += NGW) {
        const int l = it / I_L, r = it % I_L;
        if (r < I_IN) transpose_item_i8<true>(a.w_in + (size_t)l * 1024 * NPROJ, 1024, NPROJ, ws + WS_WIN + (size_t)l * NPROJ * 1024, (const float*)(ws + WS_CMAXIN) + l * NPROJ, scr, r, lane);
        else transpose_item_i8<false>(a.wq + (size_t)l * 1024 * PQ, 1024, PQ, ws + WS_WQ + (size_t)l * PQ * 1024, (const float*)(ws + WS_CMAXQ) + l * PQ, scr, r - I_IN, lane);
    }
}

template <bool XF32>
__device__ __forceinline__ void ph_norm(const KArgs& a, const void* xin, const float* g, const float* mod_l, int shift_idx, int scale_idx, unsigned char* dst, float* dscale, int wv) {
    const int tid = phase_tid(wv), lane = tid & 63, wave = wv;
    const int gw = op_bid() * NWAVES + wave, NGW = op_grid() * NWAVES;
    constexpr int RU = 16, RG = 4;
    for (int unit = gw; unit < T / RU; unit += NGW) {
        const int row0 = unit * RU, b = row0 >> 12;
        f32x4 gs[4], sh[4];
#pragma unroll
        for (int i = 0; i < 4; ++i) {
            const int col = 256 * i + 4 * lane;
            const f32x4 gg = *(const f32x4*)(g + col), sc = *(const f32x4*)(mod_l + (size_t)b * NMOD + scale_idx * DM + col);
            sh[i] = *(const f32x4*)(mod_l + (size_t)b * NMOD + shift_idx * DM + col); gs[i] = gg * (sc + 1.0f);
        }
#pragma unroll 1
        for (int r0 = 0; r0 < RU; r0 += RG) {
            f32x4 v[RG][4];
            if (XF32) {
#pragma unroll
                for (int j = 0; j < RG; ++j)
#pragma unroll
                    for (int i = 0; i < 4; ++i) v[j][i] = ((const f32x4*)((const float*)xin + (size_t)(row0 + r0 + j) * DM))[64 * i + lane];
            } else {
                u32x2 xv[RG][4];
#pragma unroll
                for (int j = 0; j < RG; ++j)
#pragma unroll
                    for (int i = 0; i < 4; ++i) xv[j][i] = ((const u32x2*)((const bf16_t*)xin + (size_t)(row0 + r0 + j) * DM))[64 * i + lane];
#pragma unroll
                for (int j = 0; j < RG; ++j)
#pragma unroll
                    for (int i = 0; i < 4; ++i) v[j][i] = (f32x4){bflo(xv[j][i].x), bfhi(xv[j][i].x), bflo(xv[j][i].y), bfhi(xv[j][i].y)};
            }
            float ss[RG];
#pragma unroll
            for (int j = 0; j < RG; ++j) { ss[j] = 0.f;
#pragma unroll
                for (int i = 0; i < 4; ++i) ss[j] += (v[j][i].x * v[j][i].x + v[j][i].y * v[j][i].y) + (v[j][i].z * v[j][i].z + v[j][i].w * v[j][i].w); }
#pragma unroll
            for (int j = 0; j < RG; ++j) ss[j] = wave_sum_dpp(ss[j]);
#pragma unroll
            for (int j = 0; j < RG; ++j) { const float r = 1.0f / sqrtf(ss[j] * (1.0f / DM) + NORM_EPS);
#pragma unroll
                for (int i = 0; i < 4; ++i) v[j][i] = (v[j][i] * r) * gs[i] + sh[i]; }
#pragma unroll
            for (int j = 0; j < RG; ++j) quant_row_nat(v[j], dst + (size_t)(row0 + r0 + j) * 1024, dscale + row0 + r0 + j, lane);
        }
    }
}
__device__ __forceinline__ void ph_final_norm(const KArgs& a, int wv) {
    const int tid = phase_tid(wv), lane = tid & 63, wave = wv;
    const int gw = op_bid() * NWAVES + wave, NGW = op_grid() * NWAVES;
    for (int row = gw; row < T; row += NGW) {
        f32x4 v[4]; float ss = 0.f;
#pragma unroll
        for (int i = 0; i < 4; ++i) { const u32x2 xv = ((const u32x2*)((const bf16_t*)(a.ws + WS_XB) + (size_t)row * DM))[64 * i + lane]; v[i] = (f32x4){bflo(xv.x), bfhi(xv.x), bflo(xv.y), bfhi(xv.y)};
            ss += (v[i].x * v[i].x + v[i].y * v[i].y) + (v[i].z * v[i].z + v[i].w * v[i].w); }
        ss = wave_sum(ss);
        const float r = 1.0f / sqrtf(ss * (1.0f / DM) + NORM_EPS);
#pragma unroll
        for (int i = 0; i < 4; ++i) { const f32x4 gg = *(const f32x4*)(a.final_g + 256 * i + 4 * lane); ((f32x4*)(a.out + (size_t)row * DM))[64 * i + lane] = (v[i] * r) * gg; }
    }
}

struct EpiProj {
    static constexpr bool PERM = true, AFTER_DRAIN = false;
    unsigned char* ws;
    __device__ __forceinline__ void operator()(const pg8::f32x4 (&acc)[2][2][4][2], const pg8::Unit& u, int wr, int wc, int fr, int fq) const {
        const int row0 = u.pm * 256 + wr * 64 + fr;
        const float* rope = (const float*)(ws + WS_ROPE);
#pragma unroll
        for (int bj = 0; bj < 2; ++bj) {
            const int cgb = u.pn * 256 + bj * 128;
            bf16_t* base; int pitch, cl, mode;
            if (cgb < 512) { base = (bf16_t*)(ws + WS_QA); pitch = 512; cl = cgb; mode = 1; }
            else if (cgb < 640) { base = (bf16_t*)(ws + WS_KA); pitch = 128; cl = cgb - 512; mode = 2; }
            else if (cgb < 768) { base = (bf16_t*)(ws + WS_VA); pitch = 128; cl = cgb - 640; mode = 0; }
            else if (cgb < 1280) { base = (bf16_t*)(ws + WS_QB); pitch = 512; cl = cgb - 768; mode = 3; }
            else if (cgb < 1792) { base = (bf16_t*)(ws + WS_KB); pitch = 512; cl = cgb - 1280; mode = 0; }
            else if (cgb < 2304) { base = (bf16_t*)(ws + WS_VB); pitch = 512; cl = cgb - 1792; mode = 0; }
            else if (cgb < 3328) { base = (bf16_t*)(ws + WS_GA); pitch = 1024; cl = cgb - 2304; mode = 4; }
            else { base = (bf16_t*)(ws + WS_GB); pitch = 1024; cl = cgb - 3328; mode = 4; }
            const int col = cl + wc * 32 + 8 * fq;
#pragma unroll
            for (int ai = 0; ai < 2; ++ai) {
                f32x4 rc[4][2];
                if (mode == 1 || mode == 2) {
                    const int i0 = (col & 63) >> 1;
#pragma unroll
                    for (int m = 0; m < 4; ++m) { const int row = row0 + ai * 128 + m * 16;
                        rc[m][0] = *(const f32x4*)(rope + ((size_t)row * 32 + i0) * 2); rc[m][1] = *(const f32x4*)(rope + ((size_t)row * 32 + i0 + 2) * 2); }
                }
#pragma unroll
                for (int m = 0; m < 4; ++m) {
                    const int row = row0 + ai * 128 + m * 16;
                    pg8::f32x4 v0 = acc[ai][bj][m][0], v1 = acc[ai][bj][m][1];
                    if (mode == 1 || mode == 2) {
                        const f32x4 c01 = rc[m][0], c23 = rc[m][1];
                        pg8::f32x4 w0, w1;
                        w0[0] = v0[0] * c01.x - v0[1] * c01.y; w0[1] = v0[1] * c01.x + v0[0] * c01.y;
                        w0[2] = v0[2] * c01.z - v0[3] * c01.w; w0[3] = v0[3] * c01.z + v0[2] * c01.w;
                        w1[0] = v1[0] * c23.x - v1[1] * c23.y; w1[1] = v1[1] * c23.x + v1[0] * c23.y;
                        w1[2] = v1[2] * c23.z - v1[3] * c23.w; w1[3] = v1[3] * c23.z + v1[2] * c23.w;
                        v0 = w0; v1 = w1;
                    }
                    if (mode == 1 || mode == 3) { v0 = v0 * QSCALE; v1 = v1 * QSCALE; }
                    if (mode == 4) {
#pragma unroll
                        for (int e = 0; e < 4; ++e) { v0[e] = __builtin_amdgcn_rcpf(1.0f + __builtin_amdgcn_exp2f(v0[e] * -1.44269504089f)); v1[e] = __builtin_amdgcn_rcpf(1.0f + __builtin_amdgcn_exp2f(v1[e] * -1.44269504089f)); }
                    }
                    u32x4 w; w.x = pk2(v0[0], v0[1]); w.y = pk2(v0[2], v0[3]); w.z = pk2(v1[0], v1[1]); w.w = pk2(v1[2], v1[3]);
                    *(u32x4*)(base + (size_t)row * pitch + col) = w;
                }
            }
        }
    }
};
template <class EpiF> struct EpiI8 {
    static constexpr bool PERM = true, AFTER_DRAIN = false;
    static_assert(EpiF::PERM, "EpiI8 wraps PERM = true epilogues");
    EpiF F; const float* rowscale; const float* colscale;
    __device__ __forceinline__ void operator()(const pg8::i32x4 (&acc)[2][2][4][2], const pg8::Unit& u, int wr, int wc, int fr, int fq) const {
        const int row0 = u.pm * 256 + wr * 64 + fr, col0 = u.pn * 256 + wc * 32 + 8 * fq;
        pg8::f32x4 f[2][2][4][2], cs[2][2];
#pragma unroll
        for (int bj = 0; bj < 2; ++bj)
#pragma unroll
            for (int n = 0; n < 2; ++n) cs[bj][n] = *(const pg8::f32x4*)(colscale + col0 + bj * 128 + 4 * n);
#pragma unroll
        for (int ai = 0; ai < 2; ++ai)
#pragma unroll
            for (int m = 0; m < 4; ++m) { const float hs = rowscale[row0 + ai * 128 + m * 16];
#pragma unroll
                for (int bj = 0; bj < 2; ++bj)
#pragma unroll
                    for (int n = 0; n < 2; ++n) f[ai][bj][m][n] = __builtin_convertvector(acc[ai][bj][m][n], pg8::f32x4) * cs[bj][n] * hs; }
        F(f, u, wr, wc, fr, fq);
    }
};
template <bool ADD> struct EpiBranch {
    static constexpr bool PERM = true, AFTER_DRAIN = false;
    const bf16_t* Gt; bf16_t* O;
    __device__ __forceinline__ void operator()(const pg8::f32x4 (&acc)[2][2][4][2], const pg8::Unit& u, int wr, int wc, int fr, int fq) const {
        const int row0 = u.pm * 256 + wr * 64 + fr, col0 = u.pn * 256 + wc * 32 + 8 * fq;
#pragma unroll
        for (int ai = 0; ai < 2; ++ai) {
            u32x4 gv[4][2], ov[4][2];
#pragma unroll
            for (int m = 0; m < 4; ++m)
#pragma unroll
                for (int bj = 0; bj < 2; ++bj) {
                    const size_t off = (size_t)(row0 + ai * 128 + m * 16) * DM + col0 + bj * 128;
                    gv[m][bj] = *(const u32x4*)(Gt + off);
                    if (ADD) ov[m][bj] = *(const u32x4*)(O + off);
                }
#pragma unroll
            for (int m = 0; m < 4; ++m)
#pragma unroll
                for (int bj = 0; bj < 2; ++bj) {
                    const size_t off = (size_t)(row0 + ai * 128 + m * 16) * DM + col0 + bj * 128;
                    const u32x4 g4 = gv[m][bj];
                    const pg8::f32x4 v0 = acc[ai][bj][m][0], v1 = acc[ai][bj][m][1];
                    float r[8];
                    r[0] = bflo(g4.x) * v0[0]; r[1] = bfhi(g4.x) * v0[1]; r[2] = bflo(g4.y) * v0[2]; r[3] = bfhi(g4.y) * v0[3];
                    r[4] = bflo(g4.z) * v1[0]; r[5] = bfhi(g4.z) * v1[1]; r[6] = bflo(g4.w) * v1[2]; r[7] = bfhi(g4.w) * v1[3];
                    if (ADD) { const u32x4 o4 = ov[m][bj];
                        r[0] += bflo(o4.x); r[1] += bfhi(o4.x); r[2] += bflo(o4.y); r[3] += bfhi(o4.y); r[4] += bflo(o4.z); r[5] += bfhi(o4.z); r[6] += bflo(o4.w); r[7] += bfhi(o4.w); }
                    u32x4 w; w.x = pk2(r[0], r[1]); w.y = pk2(r[2], r[3]); w.z = pk2(r[4], r[5]); w.w = pk2(r[6], r[7]);
                    *(u32x4*)(O + off) = w;
                }
        }
    }
};
template <bool XF32> struct EpiWout {
    static constexpr bool PERM = true, AFTER_DRAIN = false;
    const void* xold; bf16_t* xnew; const float* gate;
    __device__ __forceinline__ void operator()(const pg8::f32x4 (&acc)[2][2][4][2], const pg8::Unit& u, int wr, int wc, int fr, int fq) const {
        const int row0 = u.pm * 256 + wr * 64 + fr, col0 = u.pn * 256 + wc * 32 + 8 * fq, b = u.pm >> 4;
        pg8::f32x4 gt[2][2];
#pragma unroll
        for (int bj = 0; bj < 2; ++bj) { gt[bj][0] = *(const pg8::f32x4*)(gate + (size_t)b * NMOD + col0 + bj * 128); gt[bj][1] = *(const pg8::f32x4*)(gate + (size_t)b * NMOD + col0 + bj * 128 + 4); }
#pragma unroll
        for (int ai = 0; ai < 2; ++ai) {
            pg8::f32x4 xf[XF32 ? 4 : 1][2][2]; u32x4 xb[XF32 ? 1 : 4][2];
#pragma unroll
            for (int m = 0; m < 4; ++m)
#pragma unroll
                for (int bj = 0; bj < 2; ++bj) { const size_t off = (size_t)(row0 + ai * 128 + m * 16) * DM + col0 + bj * 128;
                    if constexpr (XF32) { xf[m][bj][0] = *(const pg8::f32x4*)((const float*)xold + off); xf[m][bj][1] = *(const pg8::f32x4*)((const float*)xold + off + 4); }
                    else xb[m][bj] = *(const u32x4*)((const bf16_t*)xold + off); }
#pragma unroll
            for (int m = 0; m < 4; ++m)
#pragma unroll
                for (int bj = 0; bj < 2; ++bj) { const size_t off = (size_t)(row0 + ai * 128 + m * 16) * DM + col0 + bj * 128;
                    pg8::f32x4 x0, x1;
                    if constexpr (XF32) { x0 = xf[m][bj][0]; x1 = xf[m][bj][1]; }
                    else { const u32x4 xv = xb[m][bj]; x0 = (pg8::f32x4){bflo(xv.x), bfhi(xv.x), bflo(xv.y), bfhi(xv.y)}; x1 = (pg8::f32x4){bflo(xv.z), bfhi(xv.z), bflo(xv.w), bfhi(xv.w)}; }
                    x0 = x0 + gt[bj][0] * acc[ai][bj][m][0]; x1 = x1 + gt[bj][1] * acc[ai][bj][m][1];
                    u32x4 w; w.x = pk2(x0[0], x0[1]); w.y = pk2(x0[2], x0[3]); w.z = pk2(x1[0], x1[1]); w.w = pk2(x1[2], x1[3]);
                    *(u32x4*)(xnew + off) = w; }
        }
    }
};
struct EpiPlainBf16 {
    static constexpr bool PERM = true, AFTER_DRAIN = false;
    bf16_t* O; int ldc;
    __device__ __forceinline__ void operator()(const pg8::f32x4 (&acc)[2][2][4][2], const pg8::Unit& u, int wr, int wc, int fr, int fq) const {
        const int row0 = u.pm * 256 + wr * 64 + fr, col0 = u.pn * 256 + wc * 32 + 8 * fq;
#pragma unroll
        for (int ai = 0; ai < 2; ++ai)
#pragma unroll
            for (int m = 0; m < 4; ++m)
#pragma unroll
                for (int bj = 0; bj < 2; ++bj) {
                    const pg8::f32x4 v0 = acc[ai][bj][m][0], v1 = acc[ai][bj][m][1];
                    u32x4 w; w.x = pk2(v0[0], v0[1]); w.y = pk2(v0[2], v0[3]); w.z = pk2(v1[0], v1[1]); w.w = pk2(v1[2], v1[3]);
                    *(u32x4*)(O + (size_t)(row0 + ai * 128 + m * 16) * ldc + col0 + bj * 128) = w;
                }
    }
};

#ifndef ATT_STEAL_MIN
#define ATT_STEAL_MIN 0
#endif
namespace att {
typedef short bf16x8 __attribute__((ext_vector_type(8)));
typedef short s16x4 __attribute__((ext_vector_type(4)));
typedef float f32x16 __attribute__((ext_vector_type(16)));
__device__ __forceinline__ int crow(int r, int hi) { return (r & 3) + 8 * (r >> 2) + 4 * hi; }
typedef float f32x2_t __attribute__((ext_vector_type(2))); typedef __bf16 bf16x2_t __attribute__((ext_vector_type(2)));
__device__ __forceinline__ unsigned cvtpk(float lo, float hi) { f32x2_t v = {lo, hi}; bf16x2_t b = __builtin_convertvector(v, bf16x2_t); return __builtin_bit_cast(unsigned, b); }
#define ATT_SBAR() __builtin_amdgcn_sched_barrier(0)

__device__ __forceinline__ void qkt(f32x16& p0, f32x16& p1, const LAS unsigned char* kslot, const bf16x8 (&qr)[4], int r32, int hi) {
    const LAS unsigned char* kb = kslot + hi * 1024 + r32 * 16;
    p0 = f32x16{}; p1 = f32x16{};
#pragma unroll
    for (int d0 = 0; d0 < 4; ++d0) {
        const bf16x8 b0 = *(const LAS bf16x8*)(kb + d0 * 2048);
        const bf16x8 b1 = *(const LAS bf16x8*)(kb + d0 * 2048 + 512);
        p0 = __builtin_amdgcn_mfma_f32_32x32x16_bf16(b0, qr[d0], p0, 0, 0, 0);
        p1 = __builtin_amdgcn_mfma_f32_32x32x16_bf16(b1, qr[d0], p1, 0, 0, 0);
    }
}
__device__ __forceinline__ void pv(f32x16 (&o)[2], int vb, bf16x8 pa0, bf16x8 pa1, bf16x8 pa2, bf16x8 pa3) {
#pragma unroll
    for (int d0 = 0; d0 < 2; ++d0) {
        s16x4 lo[4], hh[4];
#pragma unroll
        for (int ks = 0; ks < 4; ++ks) {
            asm volatile("ds_read_b64_tr_b16 %0,%1 offset:%c2" : "=&v"(lo[ks]) : "v"(vb), "i"(d0 * 4096 + ks * 1024) : "memory");
            asm volatile("ds_read_b64_tr_b16 %0,%1 offset:%c2" : "=&v"(hh[ks]) : "v"(vb), "i"(d0 * 4096 + ks * 1024 + 512) : "memory");
        }
        asm volatile("s_waitcnt lgkmcnt(0)" ::: "memory"); ATT_SBAR();
#define ATT_PK(k) (bf16x8){lo[k][0], lo[k][1], lo[k][2], lo[k][3], hh[k][0], hh[k][1], hh[k][2], hh[k][3]}
        o[d0] = __builtin_amdgcn_mfma_f32_32x32x16_bf16(pa0, ATT_PK(0), o[d0], 0, 0, 0);
        o[d0] = __builtin_amdgcn_mfma_f32_32x32x16_bf16(pa1, ATT_PK(1), o[d0], 0, 0, 0);
        o[d0] = __builtin_amdgcn_mfma_f32_32x32x16_bf16(pa2, ATT_PK(2), o[d0], 0, 0, 0);
        o[d0] = __builtin_amdgcn_mfma_f32_32x32x16_bf16(pa3, ATT_PK(3), o[d0], 0, 0, 0);
#undef ATT_PK
    }
}
__device__ __forceinline__ void pack_p(const f32x16& p0, const f32x16& p1, bf16x8& pa0, bf16x8& pa1, bf16x8& pa2, bf16x8& pa3) {
    u32x4 w0, w1, w2, w3;
    w0 = (u32x4){cvtpk(p0[0], p0[1]), cvtpk(p0[2], p0[3]), cvtpk(p0[4], p0[5]), cvtpk(p0[6], p0[7])};
    w1 = (u32x4){cvtpk(p0[8], p0[9]), cvtpk(p0[10], p0[11]), cvtpk(p0[12], p0[13]), cvtpk(p0[14], p0[15])};
    w2 = (u32x4){cvtpk(p1[0], p1[1]), cvtpk(p1[2], p1[3]), cvtpk(p1[4], p1[5]), cvtpk(p1[6], p1[7])};
    w3 = (u32x4){cvtpk(p1[8], p1[9]), cvtpk(p1[10], p1[11]), cvtpk(p1[12], p1[13]), cvtpk(p1[14], p1[15])};
    pa0 = __builtin_bit_cast(bf16x8, w0); pa1 = __builtin_bit_cast(bf16x8, w1); pa2 = __builtin_bit_cast(bf16x8, w2); pa3 = __builtin_bit_cast(bf16x8, w3);
}
__device__ __forceinline__ u32x4 tile_gload(const bf16_t* src, int pitch, int tid) { return *(const u32x4*)(src + (size_t)(tid >> 3) * pitch + (tid & 7) * 8); }
__device__ __forceinline__ void tile_kwrite(LAS unsigned char* kslot, u32x4 v, int tid) { *(LAS u32x4*)(kslot + (tid & 7) * 1024 + (tid >> 3) * 16) = v; }
__device__ __forceinline__ void tile_vwrite(LAS unsigned char* vslot, u32x4 v, int tid) { const int c = tid & 7; *(LAS u32x4*)(vslot + (c >> 2) * 4096 + (tid >> 3) * 64 + (c & 3) * 16) = v; }
__device__ __forceinline__ void store_o(const f32x16 (&o)[2], const float (&rs)[16], LAS unsigned char* stage, bf16_t* Ow, int pitch, int lane) {
    asm volatile("" : "+v"(lane));
    const int r32 = lane & 31, hi = lane >> 5;
    LAS bf16_t* stg = (LAS bf16_t*)stage;
#pragma unroll
    for (int r = 0; r < 16; ++r) { const int orow = crow(r, hi);
#pragma unroll
        for (int d0 = 0; d0 < 2; ++d0) stg[orow * 64 + d0 * 32 + r32] = (bf16_t)f2bf(o[d0][r] * rs[r]); }
    asm volatile("s_waitcnt lgkmcnt(0)" ::: "memory");
#pragma unroll
    for (int i = 0; i < 4; ++i) { const int row = i * 8 + (lane >> 3), ch = lane & 7; const u32x4 v = *(const LAS u32x4*)(stg + row * 64 + ch * 8); *(u32x4*)(Ow + (size_t)row * pitch + ch * 8) = v; }
    asm volatile("s_waitcnt lgkmcnt(0)" ::: "memory");
}

constexpr int SB_WLDS = 16384;
template <bool EARLY_EXIT>
__device__ __forceinline__ void sb_unit(const bf16_t* Q, const bf16_t* K, const bf16_t* V, bf16_t* O, LAS unsigned char* vimg, int b, int h, int rb, int lane, int wv) {
    const int r32 = lane & 31, hi = lane >> 5;
    const int vb0 = (int)(unsigned)(uintptr_t)vimg + ((lane >> 4) & 1) * 32 + (lane & 3) * 8 + (4 * hi + ((lane & 15) >> 2)) * 64;
    const int vwoff = ((lane & 7) >> 2) * 4096 + (lane >> 3) * 64 + (lane & 3) * 16;
    const float m0 = hi == 0 ? 1.0f : 0.0f;
    {
        const int R0 = rb * 32;
        const size_t rowbase = (size_t)b * SEQ;
        const char* Kb = (const char*)(K + rowbase * 512 + h * 64); const char* Vb = (const char*)(V + rowbase * 512 + h * 64);
        const unsigned koff = (unsigned)(r32 * 1024 + hi * 16), voff = (unsigned)((lane >> 3) * 1024 + (lane & 7) * 16);
        const bf16_t* Qw = Q + (rowbase + R0) * 512 + h * 64;
        bf16x8 qr[4];
#pragma unroll
        for (int d0 = 0; d0 < 4; ++d0) qr[d0] = *(const bf16x8*)((const char*)Qw + koff + d0 * 32);
        int kt = R0 >> 6;
        u32x4 kr[8], vr[8];
        LAS unsigned char* kimg = vimg + 8192;
        const int kwoff = (lane >> 3) * 128 + (((lane & 7) ^ ((lane >> 4) & 7)) << 4);
        const int krd = r32 * 128, kx = (r32 >> 1) & 7;
#define SB_LOADK(KT) do { const char* k0_ = Kb + (size_t)(KT) * 65536; _Pragma("unroll") for (int i = 0; i < 8; ++i) kr[i] = *(const u32x4*)(k0_ + i * 8192 + voff); } while (0)
#define SB_LOADV(KT) do { const char* v0_ = Vb + (size_t)(KT) * 65536; _Pragma("unroll") for (int i = 0; i < 8; ++i) vr[i] = *(const u32x4*)(v0_ + i * 8192 + voff); } while (0)
        SB_LOADK(kt); SB_LOADV(kt);
        f32x16 o[2]; o[0] = f32x16{}; o[1] = f32x16{};
        float carry = 0.f;
        for (;;) {
#pragma unroll
            for (int i = 0; i < 8; ++i) *(LAS u32x4*)(kimg + (kwoff ^ ((i & 1) << 6)) + i * 1024) = kr[i];
            f32x16 p0 = f32x16{}, p1 = f32x16{};
#pragma unroll
            for (int d0 = 0; d0 < 4; ++d0) {
                const int co = ((2 * d0 + hi) ^ kx) << 4;
                const bf16x8 k0f = *(const LAS bf16x8*)(kimg + krd + co), k1f = *(const LAS bf16x8*)(kimg + krd + co + 4096);
                p0 = __builtin_amdgcn_mfma_f32_32x32x16_bf16(k0f, qr[d0], p0, 0, 0, 0); p1 = __builtin_amdgcn_mfma_f32_32x32x16_bf16(k1f, qr[d0], p1, 0, 0, 0);
            }
            const bool more = kt > 0;
#pragma unroll
            for (int i = 0; i < 8; ++i) *(LAS u32x4*)(vimg + vwoff + i * 512) = vr[i];
            if (more) { SB_LOADK(kt - 1); SB_LOADV(kt - 1); }
            const int D = R0 - 64 * kt;
            const bool halfmasked = (D == 0);
            if (D < 64) {
                const int thr = D + r32 - 4 * hi;
#pragma unroll
                for (int r = 0; r < 16; ++r) { const int cr = (r & 3) + 8 * (r >> 2); if (cr >= thr) p0[r] = -INFINITY; if (cr + 32 >= thr) p1[r] = -INFINITY; }
            }
            float tt[8], uu[8];
#define SB_SP(x) (fmaxf(x, 0.f) + __builtin_amdgcn_logf(1.0f + __builtin_amdgcn_exp2f(-fabsf(x))))
#pragma unroll
            for (int i = 0; i < 4; ++i) {
                float s3 = SB_SP(p0[4 * i + 3]), s2 = s3 + SB_SP(p0[4 * i + 2]), s1 = s2 + SB_SP(p0[4 * i + 1]), s0 = s1 + SB_SP(p0[4 * i]);
                p0[4 * i + 3] -= s3; p0[4 * i + 2] -= s2; p0[4 * i + 1] -= s1; p0[4 * i] -= s0; tt[i] = s0;
                if (!halfmasked) {
                s3 = SB_SP(p1[4 * i + 3]); s2 = s3 + SB_SP(p1[4 * i + 2]); s1 = s2 + SB_SP(p1[4 * i + 1]); s0 = s1 + SB_SP(p1[4 * i]);
                p1[4 * i + 3] -= s3; p1[4 * i + 2] -= s2; p1[4 * i + 1] -= s1; p1[4 * i] -= s0; tt[4 + i] = s0;
                } else tt[4 + i] = 0.f;
                __builtin_amdgcn_sched_barrier(0);
            }
#undef SB_SP
#pragma unroll
            for (int k = 0; k < 8; ++k) { auto rr = __builtin_amdgcn_permlane32_swap(__float_as_uint(tt[k]), __float_as_uint(tt[k]), false, false); uu[k] = __uint_as_float(hi ? rr[0] : rr[1]); }
            float sw = 0.f;
#pragma unroll
            for (int k = 7; k >= 0; --k) {
                const float bs = carry - (sw + m0 * uu[k]); sw += tt[k] + uu[k];
                if (k < 4) { p0[4 * k] = __builtin_amdgcn_exp2f(p0[4 * k] + bs); p0[4 * k + 1] = __builtin_amdgcn_exp2f(p0[4 * k + 1] + bs); p0[4 * k + 2] = __builtin_amdgcn_exp2f(p0[4 * k + 2] + bs); p0[4 * k + 3] = __builtin_amdgcn_exp2f(p0[4 * k + 3] + bs); }
                else if (halfmasked) { const int i = k - 4; p1[4 * i] = 0.f; p1[4 * i + 1] = 0.f; p1[4 * i + 2] = 0.f; p1[4 * i + 3] = 0.f; }
                else { const int i = k - 4; p1[4 * i] = __builtin_amdgcn_exp2f(p1[4 * i] + bs); p1[4 * i + 1] = __builtin_amdgcn_exp2f(p1[4 * i + 1] + bs); p1[4 * i + 2] = __builtin_amdgcn_exp2f(p1[4 * i + 2] + bs); p1[4 * i + 3] = __builtin_amdgcn_exp2f(p1[4 * i + 3] + bs); }
            }
            carry -= sw;
            bf16x8 pa0, pa1, pa2, pa3; pack_p(p0, p1, pa0, pa1, pa2, pa3);
            pv(o, vb0, pa0, pa1, pa2, pa3);
            if (!more) break;
            if (EARLY_EXIT && __all(carry < -SB_EXIT)) break;
            --kt;
        }
        float ones[16];
#pragma unroll
        for (int r = 0; r < 16; ++r) ones[r] = 1.0f;
        store_o(o, ones, vimg, O + (rowbase + R0) * 512 + h * 64, 512, phase_tid(wv) & 63);
    }
#undef SB_LOADK
#undef SB_LOADV
}

__device__ __forceinline__ void swa_unit(const bf16_t* Q, const bf16_t* K, const bf16_t* V, bf16_t* O, const float* sinks, LAS unsigned char* vimg, int b, int hq, int rb, int lane, int wv) {
    const int r32 = lane & 31, hi = lane >> 5, kvh = hq >> 2;
    const int vb0 = (int)(unsigned)(uintptr_t)vimg + ((lane >> 4) & 1) * 32 + (lane & 3) * 8 + (4 * hi + ((lane & 15) >> 2)) * 64;
    const int vwoff = ((lane & 7) >> 2) * 4096 + (lane >> 3) * 64 + (lane & 3) * 16;
    {
        const int R0 = rb * 32, a = R0 >> 6;
        const size_t rowbase = (size_t)b * SEQ;
        const char* Kb = (const char*)(K + rowbase * 128 + kvh * 64); const char* Vb = (const char*)(V + rowbase * 128 + kvh * 64);
        const unsigned koff = (unsigned)(r32 * 256 + hi * 16), voff = (unsigned)((lane >> 3) * 256 + (lane & 7) * 16);
        const bf16_t* Qw = Q + (rowbase + R0) * 512 + hq * 64;
        bf16x8 qr[4];
#pragma unroll
        for (int d0 = 0; d0 < 4; ++d0) qr[d0] = *(const bf16x8*)((const char*)Qw + (unsigned)(r32 * 1024 + hi * 16) + d0 * 32);
        const float sink2 = sinks[hq] * LOG2E;
        u32x4 kr[8];
        LAS unsigned char* kimg = vimg + 8192;
        const int kwoff = (lane >> 3) * 128 + (((lane & 7) ^ ((lane >> 4) & 7)) << 4);
        const int krd = r32 * 128, kx = (r32 >> 1) & 7;
#define SW_LOADK(KT) do { const char* k0_ = Kb + (size_t)(KT) * 16384; _Pragma("unroll") for (int i = 0; i < 8; ++i) kr[i] = *(const u32x4*)(k0_ + i * 2048 + voff); } while (0)
#define SW_QKT(P0, P1) do { _Pragma("unroll") for (int i = 0; i < 8; ++i) *(LAS u32x4*)(kimg + (kwoff ^ ((i & 1) << 6)) + i * 1024) = kr[i]; \
        P0 = f32x16{}; P1 = f32x16{}; _Pragma("unroll") for (int d0 = 0; d0 < 4; ++d0) { const int co = ((2 * d0 + hi) ^ kx) << 4; \
            const bf16x8 k0f = *(const LAS bf16x8*)(kimg + krd + co), k1f = *(const LAS bf16x8*)(kimg + krd + co + 4096); \
            P0 = __builtin_amdgcn_mfma_f32_32x32x16_bf16(k0f, qr[d0], P0, 0, 0, 0); P1 = __builtin_amdgcn_mfma_f32_32x32x16_bf16(k1f, qr[d0], P1, 0, 0, 0); } } while (0)
        const int kt_lo = a >= 2 ? a - 2 : 0;
        constexpr float SW_THR = 8.0f;
        float m = sink2, lsum = 0.f;
        f32x16 o[2]; o[0] = f32x16{}; o[1] = f32x16{};
        LAS float* axf = (LAS float*)(vimg - wv * SB_WLDS + 8 * SB_WLDS + wv * 128);
        SW_LOADK(kt_lo);
        for (int kt = kt_lo; kt <= a; ++kt) {
            u32x4 vr[8];
            { const char* v0_ = Vb + (size_t)kt * 16384;
#pragma unroll
              for (int i = 0; i < 8; ++i) vr[i] = *(const u32x4*)(v0_ + i * 2048 + voff); }
            f32x16 p0, p1; SW_QKT(p0, p1);
            if (kt < a) SW_LOADK(kt + 1);
            const int thr = R0 - 64 * kt + r32 - 4 * hi;
            if (kt == a) {
#pragma unroll
                for (int r = 0; r < 16; ++r) { const int cr = (r & 3) + 8 * (r >> 2); if (!(cr <= thr)) p0[r] = -INFINITY; if (!(cr + 32 <= thr)) p1[r] = -INFINITY; }
            } else if (kt == a - 2) {
#pragma unroll
                for (int r = 0; r < 16; ++r) { const int cr = (r & 3) + 8 * (r >> 2); if (!(cr > thr - 128)) p0[r] = -INFINITY; if (!(cr + 32 > thr - 128)) p1[r] = -INFINITY; }
            }
            float mt = -INFINITY;
#pragma unroll
            for (int r = 0; r < 16; ++r) mt = fmaxf(mt, fmaxf(p0[r], p1[r]));
            { auto rr = __builtin_amdgcn_permlane32_swap(__float_as_uint(mt), __float_as_uint(mt), false, false); mt = fmaxf(__uint_as_float(rr[0]), __uint_as_float(rr[1])); }
            if (__any(mt > m + SW_THR)) {
                const float mn = fmaxf(m, mt), alpha = __builtin_amdgcn_exp2f(m - mn);
                m = mn; lsum *= alpha;
                asm volatile("s_waitcnt lgkmcnt(0)" ::: "memory");
                if (hi == 0) axf[r32] = alpha;
                asm volatile("s_waitcnt lgkmcnt(0)" ::: "memory");
#pragma unroll
                for (int r = 0; r < 16; ++r) { const float ar = axf[crow(r, hi)]; o[0][r] *= ar; o[1][r] *= ar; }
                asm volatile("s_waitcnt lgkmcnt(0)" ::: "memory");
            }
            if (kt == a && (R0 & 63) == 0) {
#pragma unroll
                for (int r = 0; r < 16; ++r) { p0[r] = __builtin_amdgcn_exp2f(p0[r] - m); p1[r] = 0.f; lsum += p0[r]; }
            } else {
#pragma unroll
                for (int r = 0; r < 16; ++r) { p0[r] = __builtin_amdgcn_exp2f(p0[r] - m); p1[r] = __builtin_amdgcn_exp2f(p1[r] - m); lsum += p0[r] + p1[r]; }
            }
#pragma unroll
            for (int i = 0; i < 8; ++i) *(LAS u32x4*)(vimg + vwoff + i * 512) = vr[i];
            bf16x8 pa0, pa1, pa2, pa3; pack_p(p0, p1, pa0, pa1, pa2, pa3); pv(o, vb0, pa0, pa1, pa2, pa3);
        }
#undef SW_LOADK
#undef SW_QKT
        { auto rr = __builtin_amdgcn_permlane32_swap(__float_as_uint(lsum), __float_as_uint(lsum), false, false); lsum = __uint_as_float(rr[0]) + __uint_as_float(rr[1]); }
        lsum += __builtin_amdgcn_exp2f(sink2 - m);
        LAS float* wsf = (LAS float*)vimg;
        asm volatile("s_waitcnt lgkmcnt(0)" ::: "memory");
        if (hi == 0) wsf[r32] = 1.0f / lsum;
        asm volatile("s_waitcnt lgkmcnt(0)" ::: "memory");
        float rs[16];
#pragma unroll
        for (int r = 0; r < 16; ++r) rs[r] = wsf[crow(r, hi)];
        asm volatile("s_waitcnt lgkmcnt(0)" ::: "memory");
        store_o(o, rs, vimg, O + (rowbase + R0) * 512 + hq * 64, 512, phase_tid(wv) & 63);
    }
}
template <bool EARLY_EXIT>
__device__ __forceinline__ void attn_phase(const unsigned char* ws, const float* sinks, unsigned* cnt, LAS unsigned char* lds, int wv) {
    const int tid = phase_tid(wv), lane = tid & 63, wid = wv;
    LAS unsigned char* vimg = lds + wid * SB_WLDS;
    const unsigned home = (unsigned)op_bid() & 7u;
    unsigned ss = 0, x = home;
    unsigned nxt = 0u; if (lane == 0) nxt = __hip_atomic_fetch_add(cnt + 64 * x, 1u, __ATOMIC_RELAXED, __HIP_MEMORY_SCOPE_AGENT);
    for (;;) {
        const unsigned cur = (unsigned)__builtin_amdgcn_readfirstlane((int)nxt);
        if (cur >= 2048u) {
            bool found_ = false;
            for (++ss; ss < 8u; ++ss) { const unsigned q_ = (home + ss) & 7u;
                const unsigned c_ = __hip_atomic_load(cnt + 64 * q_, __ATOMIC_RELAXED, __HIP_MEMORY_SCOPE_AGENT);
                if (c_ < 2048u && ((unsigned)op_grid() <= q_ || 2048u - c_ > (unsigned)ATT_STEAL_MIN)) { x = q_; found_ = true; break; } }
            if (!found_) break;
            --ss;
            nxt = 0u; if (lane == 0) nxt = __hip_atomic_fetch_add(cnt + 64 * x, 1u, __ATOMIC_RELAXED, __HIP_MEMORY_SCOPE_AGENT); continue; }
        nxt = 0u; if (lane == 0) nxt = __hip_atomic_fetch_add(cnt + 64 * x, 1u, __ATOMIC_RELAXED, __HIP_MEMORY_SCOPE_AGENT);
        const int b = (int)(cur >> 7) & 7, rb = (int)(cur & 127u);
        if (cur < 1024u) sb_unit<EARLY_EXIT>((const bf16_t*)(ws + WS_QB), (const bf16_t*)(ws + WS_KB), (const bf16_t*)(ws + WS_VB), (bf16_t*)(ws + WS_QB), vimg, b, (int)x, rb, lane, wv);
        else swa_unit((const bf16_t*)(ws + WS_QA), (const bf16_t*)(ws + WS_KA), (const bf16_t*)(ws + WS_VA), (bf16_t*)(ws + WS_QA), sinks, vimg, b, (int)x, rb, lane, wv);
    }
}
}

namespace tk {
typedef short bf16x8 __attribute__((ext_vector_type(8)));
typedef float f32x16 __attribute__((ext_vector_type(16)));
__device__ __forceinline__ float vmax(float a, float b) { float r; asm("v_max_f32 %0, %1, %2" : "=v"(r) : "v"(a), "v"(b)); return r; }
__device__ __forceinline__ float vmin(float a, float b) { float r; asm("v_min_f32 %0, %1, %2" : "=v"(r) : "v"(a), "v"(b)); return r; }
#define TK_CE(a, b) { const float t_ = vmax(a, b); b = vmin(a, b); a = t_; }
__device__ __forceinline__ void sort16(float (&v)[16]) {
    TK_CE(v[0], v[1]) TK_CE(v[2], v[3]) TK_CE(v[0], v[2]) TK_CE(v[1], v[3]) TK_CE(v[1], v[2]) TK_CE(v[4], v[5]) TK_CE(v[6], v[7]) TK_CE(v[4], v[6])
    TK_CE(v[5], v[7]) TK_CE(v[5], v[6]) TK_CE(v[0], v[4]) TK_CE(v[2], v[6]) TK_CE(v[2], v[4]) TK_CE(v[1], v[5]) TK_CE(v[3], v[7]) TK_CE(v[3], v[5])
    TK_CE(v[1], v[2]) TK_CE(v[3], v[4]) TK_CE(v[5], v[6]) TK_CE(v[8], v[9]) TK_CE(v[10], v[11]) TK_CE(v[8], v[10]) TK_CE(v[9], v[11]) TK_CE(v[9], v[10])
    TK_CE(v[12], v[13]) TK_CE(v[14], v[15]) TK_CE(v[12], v[14]) TK_CE(v[13], v[15]) TK_CE(v[13], v[14]) TK_CE(v[8], v[12]) TK_CE(v[10], v[14]) TK_CE(v[10], v[12])
    TK_CE(v[9], v[13]) TK_CE(v[11], v[15]) TK_CE(v[11], v[13]) TK_CE(v[9], v[10]) TK_CE(v[11], v[12]) TK_CE(v[13], v[14]) TK_CE(v[0], v[8]) TK_CE(v[4], v[12])
    TK_CE(v[4], v[8]) TK_CE(v[2], v[10]) TK_CE(v[6], v[14]) TK_CE(v[6], v[10]) TK_CE(v[2], v[4]) TK_CE(v[6], v[8]) TK_CE(v[10], v[12]) TK_CE(v[1], v[9])
    TK_CE(v[5], v[13]) TK_CE(v[5], v[9]) TK_CE(v[3], v[11]) TK_CE(v[7], v[15]) TK_CE(v[7], v[11]) TK_CE(v[3], v[5]) TK_CE(v[7], v[9]) TK_CE(v[11], v[13])
    TK_CE(v[1], v[2]) TK_CE(v[3], v[4]) TK_CE(v[5], v[6]) TK_CE(v[7], v[8]) TK_CE(v[9], v[10]) TK_CE(v[11], v[12]) TK_CE(v[13], v[14])
}
__device__ __forceinline__ void bmerge16(float (&v)[16]) {
    TK_CE(v[0], v[8]) TK_CE(v[1], v[9]) TK_CE(v[2], v[10]) TK_CE(v[3], v[11]) TK_CE(v[4], v[12]) TK_CE(v[5], v[13]) TK_CE(v[6], v[14]) TK_CE(v[7], v[15])
    TK_CE(v[0], v[4]) TK_CE(v[1], v[5]) TK_CE(v[2], v[6]) TK_CE(v[3], v[7]) TK_CE(v[8], v[12]) TK_CE(v[9], v[13]) TK_CE(v[10], v[14]) TK_CE(v[11], v[15])
    TK_CE(v[0], v[2]) TK_CE(v[1], v[3]) TK_CE(v[4], v[6]) TK_CE(v[5], v[7]) TK_CE(v[8], v[10]) TK_CE(v[9], v[11]) TK_CE(v[12], v[14]) TK_CE(v[13], v[15])
    TK_CE(v[0], v[1]) TK_CE(v[2], v[3]) TK_CE(v[4], v[5]) TK_CE(v[6], v[7]) TK_CE(v[8], v[9]) TK_CE(v[10], v[11]) TK_CE(v[12], v[13]) TK_CE(v[14], v[15])
}

__device__ __forceinline__ void merge_top16(float (&a)[16], const float (&b)[16]) {
#pragma unroll
    for (int i = 0; i < 16; ++i) a[i] = vmax(a[i], b[15 - i]);
    bmerge16(a);
}
__device__ __forceinline__ float partner_f(float v, int hi) { auto rr = __builtin_amdgcn_permlane32_swap(__float_as_uint(v), __float_as_uint(v), false, false); return __uint_as_float(hi ? rr[0] : rr[1]); }
__device__ __forceinline__ void merge_partner(float (&a)[16], int hi) {
    float pp[16];
#pragma unroll
    for (int i = 0; i < 16; ++i) pp[i] = partner_f(a[i], hi);
    merge_top16(a, pp);
}
__device__ __forceinline__ void take_block(float (&v)[16], const f32x16& acc, int blk, unsigned hi4) {
#pragma unroll
    for (int r = 0; r < 16; ++r) { const unsigned code = 127u - (unsigned)(32 * blk + (r & 3) + 8 * (r >> 2)); v[r] = __uint_as_float(((__float_as_uint(acc[r]) & 0xFFFFFF80u) | code) ^ hi4); }
    sort16(v);
}
constexpr int TK_SK = 0, TK_IDX = 65536, TK_LDS_END = 65536 + 8192;
constexpr float TK_NEG = -3.4028234663852886e38f;
template <int P>
__device__ __forceinline__ void half_top16(float (&L)[16], const bf16_t* qrow, LAS unsigned char* lds, LAS unsigned char* idxslot, int r32, int hi) {
    bf16x8 qf[8];
#pragma unroll
    for (int ks = 0; ks < 8; ++ks) qf[ks] = *(const bf16x8*)(qrow + P * 128 + 16 * ks + 8 * hi);
    f32x16 acc[4];
#pragma unroll
    for (int blk = 0; blk < 4; ++blk) acc[blk] = f32x16{};
    const LAS unsigned char* ab = lds + TK_SK + P * 32768 + hi * 2048 + r32 * 16;
#pragma unroll
    for (int ks = 0; ks < 8; ++ks)
#pragma unroll
        for (int blk = 0; blk < 4; ++blk) {
            const bf16x8 af = *(const LAS bf16x8*)(ab + ks * 4096 + blk * 512);
            acc[blk] = __builtin_amdgcn_mfma_f32_32x32x16_bf16(af, qf[ks], acc[blk], 0, 0, 0);
        }
    const unsigned hi4 = (unsigned)hi << 2;
    float M[16];
    take_block(L, acc[0], 0, hi4); take_block(M, acc[1], 1, hi4); merge_top16(L, M);
    { float N[16]; take_block(M, acc[2], 2, hi4); take_block(N, acc[3], 3, hi4); merge_top16(M, N); }
    merge_top16(L, M);
    merge_partner(L, hi);
    if (hi == 0) {
        u32x4 w;
#pragma unroll
        for (int q = 0; q < 4; ++q) w[q] = (__float_as_uint(L[4 * q]) & 127u) | ((__float_as_uint(L[4 * q + 1]) & 127u) << 8) | ((__float_as_uint(L[4 * q + 2]) & 127u) << 16) | ((__float_as_uint(L[4 * q + 3]) & 127u) << 24);
        *(LAS u32x4*)(idxslot + P * 16) = w;
    }
}
__device__ __forceinline__ float cand(float x, float y, unsigned code, unsigned hi8) { return __uint_as_float((__float_as_uint(x + y) & 0xFFFFFE00u) | code | hi8); }

__device__ __forceinline__ void topk_phase(const bf16_t* Q2, const bf16_t* SKl, u32x4* UM, unsigned short* IDX16, const float* HS, LAS unsigned char* lds, int wv) {
        const int tid = phase_tid(wv), lane = tid & 63, r32 = lane & 31, hi = lane >> 5, wid = wv;
    LAS unsigned char* idxslot = lds + TK_IDX + wid * 1024 + r32 * 32;
    int cur_h = -1;
    for (int unit = op_bid(); unit < 8 * (T / 256); unit += op_grid()) {
        const int h = unit & 7, tb = unit >> 3;
        if (h != cur_h) {
            __syncthreads();
#pragma unroll
            for (int i = 0; i < 8; ++i) { const int id = tid + 512 * i, c = id & 15, n = (id >> 4) & 127, p = id >> 11;
                const u32x4 v = *(const u32x4*)(SKl + ((size_t)(h * 2 + p) * 128 + n) * 128 + c * 8);
                *(LAS u32x4*)(lds + TK_SK + p * 32768 + c * 2048 + n * 16) = v; }
            __syncthreads();
            cur_h = h;
        }
        const size_t token = (size_t)tb * 256 + wid * 32 + r32;
        const bf16_t* qrow = Q2 + token * PQ + h * 256;
        float a[16], b[16];
        half_top16<0>(a, qrow, lds, idxslot, r32, hi);
        half_top16<1>(b, qrow, lds, idxslot, r32, hi);
        float x[16], y[16];
#pragma unroll
        for (int i = 0; i < 16; ++i) { float av = a[i], bv = b[i]; asm volatile("" : "+v"(av), "+v"(bv)); x[i] = hi ? bv : av; y[i] = hi ? av : bv; }
        const unsigned hi8 = (unsigned)hi << 8;
        float A[16], B[16];
#pragma unroll
        for (int j = 1; j < 16; ++j) A[j - 1] = cand(x[0], y[j], (unsigned)j, hi8);
        A[15] = TK_NEG;
#pragma unroll
        for (int j = 2; j < 8; ++j) B[j - 2] = cand(x[1], y[j], (unsigned)(16 + j), hi8);
        B[6] = cand(x[2], y[3], 2u * 16u + 3u, hi8); B[7] = cand(x[2], y[4], 2u * 16u + 4u, hi8);
#pragma unroll
        for (int i = 0; i < 4; ++i) { const float d = cand(x[i], y[i], (unsigned)(17 * i), hi8); B[8 + i] = hi ? TK_NEG : d; }
        B[12] = TK_NEG; B[13] = TK_NEG; B[14] = TK_NEG; B[15] = TK_NEG;
        sort16(B);
        merge_top16(A, B);
        merge_partner(A, hi);
        const float smax = A[0];
        float ex[8]; int eidx[8]; float lsum = 0.f;
        asm volatile("s_waitcnt lgkmcnt(0)" ::: "memory");
#pragma unroll
        for (int k = 0; k < 8; ++k) {
            float s_lo = A[k], s_hi = A[8 + k]; asm volatile("" : "+v"(s_lo), "+v"(s_hi)); const float s = hi ? s_hi : s_lo;
            ex[k] = __expf(s - smax); lsum += ex[k];
            const unsigned code = __float_as_uint(s) & 0x1FFu, src = code >> 8, ci = (code >> 4) & 15u, cj = code & 15u;
            const unsigned ai = src ? cj : ci, bi = src ? ci : cj;
            const unsigned ca = idxslot[ai], cb = idxslot[16 + bi];
            eidx[k] = (int)peer_pos(ca ^ 127u, cb ^ 127u);
        }
        const float tot = lsum + partner_f(lsum, hi);
        const float inv = 1.0f / tot;
        *(u32x4*)(IDX16 + token * 128 + h * 16 + 8 * hi) = (u32x4){(unsigned)eidx[0] | ((unsigned)eidx[1] << 16), (unsigned)eidx[2] | ((unsigned)eidx[3] << 16), (unsigned)eidx[4] | ((unsigned)eidx[5] << 16), (unsigned)eidx[6] | ((unsigned)eidx[7] << 16)};
        {
            const unsigned shb = __float_as_uint(HS[token]);
            u32x4* up = UM + token * 64 + h * 8 + 4 * hi;
#pragma unroll
            for (int j = 0; j < 4; ++j) up[j] = (u32x4){(unsigned)eidx[2 * j] | ((unsigned)f2bf(ex[2 * j] * inv) << 16), (unsigned)eidx[2 * j + 1] | ((unsigned)f2bf(ex[2 * j + 1] * inv) << 16), shb, 0u};
        }
        asm volatile("s_waitcnt lgkmcnt(0)" ::: "memory");
    }
}
}

namespace peer3 {
__device__ __forceinline__ unsigned xcc_id() { return (unsigned)__builtin_amdgcn_s_getreg((3 << 11) | 20) & 7u; }
#ifndef PUNIT
#define PUNIT 16
#endif
constexpr int UNIT = PUNIT, NUNIT = T / UNIT;
template <int CTRL> __device__ __forceinline__ int dpp_i(int v) { return __builtin_amdgcn_update_dpp(0, v, CTRL, 0xF, 0xF, true); }
__device__ __forceinline__ int rowsum16(int v) { v += dpp_i<0xB1>(v); v += dpp_i<0x4E>(v); v += dpp_i<0x141>(v); v += dpp_i<0x140>(v); return v; }
__device__ __forceinline__ float gelu_as(float v) {
    const float av = fabsf(v), t = __builtin_amdgcn_rcpf(fmaf(av, 0.2316418882f, 1.0f));
    float q = fmaf(t, 0.5307027145f, -0.7265760135f); q = fmaf(q, t, 0.7107068705f); q = fmaf(q, t, -0.142248368f); q = fmaf(q, t, 0.127414796f); q = q * t;
    const float e = __builtin_amdgcn_exp2f(v * v * -0.72134752044f), m = v * (q * e);
    return v < 0.f ? m : v - m;
}
__device__ __forceinline__ unsigned take_async(unsigned* p, int lane) { unsigned v = 0u; if (lane == 0) v = __hip_atomic_fetch_add(p, 1u, __ATOMIC_RELAXED, __HIP_MEMORY_SCOPE_AGENT); return v; }

constexpr int UST = 4;
typedef float f32x2_t __attribute__((ext_vector_type(2)));
struct UTok { unsigned um0, um1; float sh; int n; unsigned mine; f32x2_t sc; };
struct UPtr { const unsigned char* UQ; const f32x2_t* SC; const u32x4* UM; const unsigned char* HQ; bf16_t* COEF; };
__device__ __forceinline__ void u_meta(UTok& T, const UPtr& P, size_t t, int lane) { const u32x4 m = P.UM[t * 64 + lane]; T.um0 = m.x; T.um1 = m.y; T.sh = __uint_as_float(m.z); }
__device__ __forceinline__ void u_hrow(u32x4 (&hv)[4], const UPtr& P, size_t t, int lane) {
#pragma unroll
    for (int k = 0; k < 4; ++k) hv[k] = *(const u32x4*)(P.HQ + t * 1024 + 256 * k + 16 * (lane & 15));
}
template <int EXP = 0>
__device__ __forceinline__ void u_issue(u32x4 (&uv)[UST][4], const UPtr& P, LAS unsigned* lst, int base, int n, int lane) {
    const int q = lane >> 4, r = lane & 15, nst = (n - base + 3) >> 2;
    unsigned e[UST];
#pragma unroll
    for (int st = 0; st < UST; ++st) {
        int slot = base + 4 * st + q; slot = slot < n ? slot : n - 1; slot = slot > 0 ? slot : 0;
        e[st] = lst[slot];
    }
#pragma unroll
    for (int st = 0; st < UST; ++st) {
        if (st < nst) {
            const unsigned char* rp = P.UQ + (size_t)(e[st] & ((EXP & 1) ? 0x383fu : 0x3fffu)) * 1024 + 16 * r;
#pragma unroll
            for (int k = 0; k < 4; ++k) uv[st][k] = *(const u32x4*)(rp + 256 * k);
        }
    }
}
__device__ __forceinline__ void u_dots(const u32x4 (&uv)[UST][4], const u32x4 (&hv)[4], LAS float* res, int base, int n, int lane) {
    const int q = lane >> 4, r = lane & 15, nst = (n - base + 3) >> 2;
    int part[UST];
#pragma unroll
    for (int st = 0; st < UST; ++st) {
        part[st] = 0;
        if (st < nst) {
            int s0_ = 0, s1_ = 0, s2_ = 0, s3_ = 0;
#pragma unroll
            for (int k = 0; k < 4; ++k) {
                s0_ = __builtin_amdgcn_sdot4((int)uv[st][k].x, (int)hv[k].x, s0_, false); s1_ = __builtin_amdgcn_sdot4((int)uv[st][k].y, (int)hv[k].y, s1_, false);
                s2_ = __builtin_amdgcn_sdot4((int)uv[st][k].z, (int)hv[k].z, s2_, false); s3_ = __builtin_amdgcn_sdot4((int)uv[st][k].w, (int)hv[k].w, s3_, false);
            }
            part[st] = (s0_ + s1_) + (s2_ + s3_);
        }
    }
    const bool b0 = (r & 1) != 0, b1 = (r & 2) != 0;
    int p0 = part[0], p1 = part[1], p2 = part[2], p3 = part[3]; asm volatile("" : "+v"(p0), "+v"(p1), "+v"(p2), "+v"(p3));
    const int x01 = (b0 ? p1 : p0) + dpp_i<0xB1>(b0 ? p0 : p1), x23 = (b0 ? p3 : p2) + dpp_i<0xB1>(b0 ? p2 : p3);
    int y = (b1 ? x23 : x01) + dpp_i<0x4E>(b1 ? x01 : x23);
    y += dpp_i<0x124>(y); y += dpp_i<0x128>(y);
    if (r < 4 && r < nst) res[base + 4 * r + q] = (float)y;
}
template <int EXP = 0>
__device__ __forceinline__ void u_front(UTok& T, u32x4 (&uv)[UST][4], const UPtr& P, unsigned s, LAS unsigned* lst, LAS unsigned* glst, int lane) {
    const unsigned idx0 = T.um0 & 0xffffu, idx1 = T.um1 & 0xffffu;
    const bool in0 = (idx0 >> 11) == s, in1 = (idx1 >> 11) == s;
    const unsigned long long m0 = __ballot(in0), m1 = __ballot(in1);
    const int c0 = __builtin_popcountll(m0); T.n = c0 + __builtin_popcountll(m1);
    const int rank0 = (int)__builtin_amdgcn_mbcnt_hi((unsigned)(m0 >> 32), __builtin_amdgcn_mbcnt_lo((unsigned)m0, 0u));
    const int rank1 = c0 + (int)__builtin_amdgcn_mbcnt_hi((unsigned)(m1 >> 32), __builtin_amdgcn_mbcnt_lo((unsigned)m1, 0u));
    if (in0) { lst[rank0] = idx0 | ((unsigned)(2 * lane) << 16); glst[rank0] = T.um0 & 0xffff0000u; }
    if (in1) { lst[rank1] = idx1 | ((unsigned)(2 * lane + 1) << 16); glst[rank1] = T.um1 & 0xffff0000u; }
    T.mine = lst[lane];
    T.sc = (f32x2_t){0.f, 0.f};
    if (lane < T.n) T.sc = P.SC[(EXP & 2) ? (T.mine & 0x383fu) : (T.mine & 0x3fffu)];
    u_issue<EXP>(uv, P, lst, 0, T.n, lane);
}
template <int EXP = 0>
__device__ __forceinline__ void u_back(const UTok& T, u32x4 (&uv)[UST][4], const u32x4 (&hv)[4], const UPtr& P, LAS unsigned* lst, LAS unsigned* glst, LAS float* res, size_t t, int lane) {
    u_dots(uv, hv, res, 0, T.n, lane);
#pragma unroll 1
    for (int base = 4 * UST; base < T.n; base += 4 * UST) { u_issue<EXP>(uv, P, lst, base, T.n, lane); u_dots(uv, hv, res, base, T.n, lane); }
    if (lane < T.n) {
        const float d = res[lane], g = __uint_as_float(glst[lane]);
        P.COEF[t * 128 + (T.mine >> 16)] = (bf16_t)f2bf(gelu_as(d * T.sc.x * T.sh) * g * T.sc.y);
    }
    if (T.n > 64 && lane + 64 < T.n) {
        const unsigned m2 = lst[lane + 64]; const float d = res[lane + 64], g = __uint_as_float(glst[lane + 64]);
        const f32x2_t sc = P.SC[(EXP & 2) ? (m2 & 0x383fu) : (m2 & 0x3fffu)];
        P.COEF[t * 128 + (m2 >> 16)] = (bf16_t)f2bf(gelu_as(d * sc.x * T.sh) * g * sc.y);
    }
}
template <int EXP = 0>
__device__ __forceinline__ void u_unit(const KArgs& a, int l, unsigned s, unsigned unit, LAS unsigned char* wlds, int lane, size_t t0 = ~(size_t)0, int ulen = UNIT) {
    UPtr P;
    P.UQ = a.ws + WS_UQ + (size_t)l * NEXP * 1024; P.SC = (const f32x2_t*)(a.ws + WS_USC) + l * NEXP;
    P.UM = (const u32x4*)(a.ws + WS_UM); P.HQ = a.ws + WS_H2Q; P.COEF = (bf16_t*)(a.ws + (EXP ? WS_GB : WS_COEF));
    LAS unsigned* lstA = (LAS unsigned*)wlds; LAS unsigned* glstA = (LAS unsigned*)(wlds + 512); LAS float* resA = (LAS float*)(wlds + 1024);
    LAS unsigned* lstB = (LAS unsigned*)(wlds + 1536); LAS unsigned* glstB = (LAS unsigned*)(wlds + 2048); LAS float* resB = (LAS float*)(wlds + 2560);
    if (t0 == ~(size_t)0) t0 = (size_t)unit * UNIT;
    UTok TA, TB, TN; u32x4 uvA[UST][4], uvB[UST][4], hvA[4], hvB[4];
    u_meta(TA, P, t0, lane); u_hrow(hvA, P, t0, lane);
    u_front<EXP>(TA, uvA, P, s, lstA, glstA, lane);
    u_meta(TB, P, t0 + 1, lane); u_hrow(hvB, P, t0 + 1, lane);
#pragma unroll 1
    for (int i = 0; i < ulen; i += 2) {
        const size_t t = t0 + i, t2 = t0 + (i + 2 < ulen ? i + 2 : i), t3 = t0 + (i + 3 < ulen ? i + 3 : i + 1);
        u_front<EXP>(TB, uvB, P, s, lstB, glstB, lane);
        u_meta(TN, P, t2, lane);
        u_back<EXP>(TA, uvA, hvA, P, lstA, glstA, resA, t, lane);
        u_hrow(hvA, P, t2, lane);
        TA.um0 = TN.um0; TA.um1 = TN.um1; TA.sh = TN.sh;
        if (i + 2 < ulen) u_front<EXP>(TA, uvA, P, s, lstA, glstA, lane);
        u_meta(TN, P, t3, lane);
        u_back<EXP>(TB, uvB, hvB, P, lstB, glstB, resB, t + 1, lane);
        u_hrow(hvB, P, t3, lane);
        TB.um0 = TN.um0; TB.um1 = TN.um1; TB.sh = TN.sh;
    }
}
struct VMeta { u32x4 iv[2]; u32x4 cv[2]; };
__device__ __forceinline__ void v_meta(VMeta& m, const unsigned short* IDX16, const bf16_t* COEF, size_t t, int g) {
#pragma unroll
    for (int q = 0; q < 2; ++q) { m.iv[q] = *(const u32x4*)(IDX16 + t * 128 + 16 * g + 8 * q); m.cv[q] = *(const u32x4*)(COEF + t * 128 + 16 * g + 8 * q); }
}
__device__ __forceinline__ float v_coef(const VMeta& m, int j) { const unsigned w = m.cv[j >> 3][(j >> 1) & 3]; return (j & 1) ? bfhi(w) : bflo(w); }
__device__ __forceinline__ unsigned v_idx(const VMeta& m, int j) { const unsigned w = m.iv[j >> 3][(j >> 1) & 3]; return (j & 1) ? (w >> 16) : (w & 0xffffu); }
struct VX { unsigned xw; float g0, g1; };
template <int EXP = 0>
__device__ __forceinline__ void v_stage(u32x4 (&P)[16], u32x4& CQ, float& cs, VX& X, const VMeta& m, const unsigned char* VS, const bf16_t* __restrict__ xin, const float* mod_l, size_t t, unsigned s, int lane) {
    {
        const int col = (int)s * 128 + 16 * (lane & 7) + 2 * (lane >> 3);
        X.xw = *(const unsigned*)(xin + t * DM + col);
    }
    typedef unsigned short u16x2_t __attribute__((ext_vector_type(2)));
    u16x2_t mx = __builtin_bit_cast(u16x2_t, m.cv[0][0] & 0x7fff7fffu);
#pragma unroll
    for (int d = 1; d < 8; ++d) mx = __builtin_elementwise_max(mx, __builtin_bit_cast(u16x2_t, m.cv[d >> 2][d & 3] & 0x7fff7fffu));
    const unsigned mu = __builtin_bit_cast(unsigned, mx);
    unsigned cu = (mu > (mu << 16) ? mu : (mu << 16)) & 0xffff0000u;
    { const unsigned o = (unsigned)__builtin_amdgcn_update_dpp(0, (int)cu, 0x128, 0xF, 0xF, true); cu = cu > o ? cu : o; }
    { auto rr = __builtin_amdgcn_permlane16_swap(cu, cu, false, false); cu = rr[0] > rr[1] ? rr[0] : rr[1]; }
    { auto rr = __builtin_amdgcn_permlane32_swap(cu, cu, false, false); cu = rr[0] > rr[1] ? rr[0] : rr[1]; }
    float cm = __uint_as_float(cu);
    cm = fmaxf(cm, 1e-30f);
    const unsigned ib = __float_as_uint(127.0f * __builtin_amdgcn_rcpf(cm)) & 0xffff0000u, blo = ib >> 16;
    cs = __builtin_amdgcn_rcpf(__uint_as_float(ib));
    const float magic = 12582912.0f;
#pragma unroll
    for (int qd = 0; qd < 4; ++qd) {
        const unsigned w0 = m.cv[qd >> 1][(2 * qd) & 3], w1 = m.cv[qd >> 1][(2 * qd + 1) & 3];
        unsigned f0, f1, f2, f3;
        asm("v_dot2_f32_bf16 %0, %4, %6, %8\n\tv_dot2_f32_bf16 %1, %4, %7, %8\n\tv_dot2_f32_bf16 %2, %5, %6, %8\n\tv_dot2_f32_bf16 %3, %5, %7, %8\n\ts_nop 1"
            : "=&v"(f0), "=&v"(f1), "=&v"(f2), "=&v"(f3) : "v"(w0), "v"(w1), "v"(blo), "v"(ib), "s"(magic));
        CQ[qd] = __builtin_amdgcn_perm(__builtin_amdgcn_perm(f3, f2, 0x0c0c0400u), __builtin_amdgcn_perm(f1, f0, 0x0c0c0400u), 0x05040100u);
    }
    const unsigned lane16 = 16u * (unsigned)(lane & 7), c128 = 128u;
#pragma unroll
    for (int j = 0; j < 16; ++j) {
        const unsigned w = m.iv[j >> 3][(j >> 1) & 3]; unsigned off;
        if (EXP & 1) off = (v_idx(m, j) & 63u) * 128u + lane16;
        else if (j & 1) asm("v_mad_u32_u16 %0, %1, %2, %3 op_sel:[1,0,0,0]" : "=v"(off) : "v"(w), "s"(c128), "v"(lane16));
        else asm("v_mad_u32_u16 %0, %1, %2, %3" : "=v"(off) : "v"(w), "s"(c128), "v"(lane16));
        P[j] = *(const u32x4*)(VS + (size_t)off);
    }
}
template <int EXP = 0>
__device__ __forceinline__ void v_compute(const u32x4 (&P)[16], const u32x4& CQ, float cs, const VX& X, bf16_t* __restrict__ xout, size_t t, unsigned s, int lane) {
    const int g = lane >> 3, p = lane & 7; const bool b4 = (lane >> 4) & 1, b3 = (lane >> 3) & 1;
    typedef float f32x2 __attribute__((ext_vector_type(2)));
    const int col = (int)s * 128 + 16 * p + 2 * g;
    unsigned* xp = (unsigned*)(xout + t * DM + col);
    f32x2 xv = {bflo(X.xw), bfhi(X.xw)};
    const f32x2 gt = {X.g0, X.g1};
    int acc[16];
#pragma unroll
    for (int k = 0; k < 16; ++k) acc[k] = 0;
    if (EXP & 2) {
#pragma unroll
        for (int j = 0; j < 16; ++j) acc[j] = (int)(P[j].x + P[j].y + P[j].z + P[j].w + CQ[j & 3]);
    } else
#pragma unroll
    for (int qd = 0; qd < 4; ++qd)
#pragma unroll
        for (int w = 0; w < 4; ++w) {
            const unsigned A = P[4 * qd][w], B = P[4 * qd + 1][w], C = P[4 * qd + 2][w], D = P[4 * qd + 3][w];
            const unsigned X = __builtin_amdgcn_perm(B, A, 0x05010400u), Y = __builtin_amdgcn_perm(B, A, 0x07030602u);
            const unsigned Z = __builtin_amdgcn_perm(D, C, 0x05010400u), W = __builtin_amdgcn_perm(D, C, 0x07030602u);
            const unsigned T0 = __builtin_amdgcn_perm(Z, X, 0x05040100u), T1 = __builtin_amdgcn_perm(Z, X, 0x07060302u);
            const unsigned T2 = __builtin_amdgcn_perm(W, Y, 0x05040100u), T3 = __builtin_amdgcn_perm(W, Y, 0x07060302u);
            acc[4 * w + 0] = __builtin_amdgcn_sdot4((int)T0, (int)CQ[qd], acc[4 * w + 0], false); acc[4 * w + 1] = __builtin_amdgcn_sdot4((int)T1, (int)CQ[qd], acc[4 * w + 1], false);
            acc[4 * w + 2] = __builtin_amdgcn_sdot4((int)T2, (int)CQ[qd], acc[4 * w + 2], false); acc[4 * w + 3] = __builtin_amdgcn_sdot4((int)T3, (int)CQ[qd], acc[4 * w + 3], false);
        }
    int r8[8], r4[4], r2[2];
#pragma unroll
    for (int q = 0; q < 8; ++q) { auto rr = __builtin_amdgcn_permlane32_swap((unsigned)acc[q], (unsigned)acc[8 + q], false, false); r8[q] = (int)rr[0] + (int)rr[1]; }
#pragma unroll
    for (int q = 0; q < 4; ++q) { auto rr = __builtin_amdgcn_permlane16_swap((unsigned)r8[q], (unsigned)r8[4 + q], false, false); r4[q] = (int)rr[0] + (int)rr[1]; }
#pragma unroll
    for (int q = 0; q < 2; ++q) { const int u = r4[q] + dpp_i<0x128>(r4[q]), v = r4[2 + q] + dpp_i<0x128>(r4[2 + q]); r2[q] = b3 ? v : u; }
    xv.x += gt.x * ((float)r2[0] * cs); xv.y += gt.y * ((float)r2[1] * cs);
    *xp = pk2(xv.x, xv.y);
}
struct VRaw { unsigned iw, cw; };
__device__ __forceinline__ void v_raw(VRaw& r, const unsigned short* IDX16, const bf16_t* COEF, size_t t, int lane) { r.iw = ((const unsigned*)(IDX16 + t * 128))[lane]; r.cw = ((const unsigned*)(COEF + t * 128))[lane]; }
__device__ __forceinline__ void v_meta_lds(VMeta& m, const VRaw& r, LAS unsigned char* buf, int lane, int g) {
    ((LAS unsigned*)buf)[lane] = r.iw; ((LAS unsigned*)buf)[64 + lane] = r.cw;
#pragma unroll
    for (int q = 0; q < 2; ++q) { m.iv[q] = *(const LAS u32x4*)(buf + 32 * g + 16 * q); m.cv[q] = *(const LAS u32x4*)(buf + 256 + 32 * g + 16 * q); }
}
template <int EXP = 0>
__device__ __forceinline__ void v_unit_(const KArgs& a, int l, const float* mod_l, unsigned s, unsigned unit, int lane, const bf16_t* __restrict__ xr, bf16_t* __restrict__ xw, LAS unsigned char* wlds, size_t t0 = ~(size_t)0, int ulen = UNIT) {
    const int g = lane >> 3;
    const unsigned char* VS = a.ws + WS_VQ + (size_t)l * NEXP * 1024 + (size_t)s * NEXP * 128;
    const unsigned short* IDX16 = (const unsigned short*)(a.ws + WS_IDX16); const bf16_t* COEF = (const bf16_t*)(a.ws + WS_COEF);
    if (t0 == ~(size_t)0) t0 = (size_t)unit * UNIT;
    LAS unsigned char* bufA = wlds; LAS unsigned char* bufB = wlds + 512;
    VMeta mA, mB; VRaw rA, rB;
    u32x4 PA[16], PB[16], CQA, CQB; float csA, csB; VX XA, XB;
    {
        typedef float f32x2 __attribute__((ext_vector_type(2)));
        const int col = (int)s * 128 + 16 * (lane & 7) + 2 * (lane >> 3);
        const f32x2 gt = *(const f32x2*)(mod_l + (size_t)(t0 >> 12) * NMOD + 5 * DM + col);
        XA.g0 = gt.x; XA.g1 = gt.y; XB.g0 = gt.x; XB.g1 = gt.y;
    }
#define VSB() __builtin_amdgcn_sched_barrier(0)
    v_raw(rA, IDX16, COEF, t0, lane); v_raw(rB, IDX16, COEF, t0 + 1, lane); VSB();
    v_meta_lds(mA, rA, bufA, lane, g); v_meta_lds(mB, rB, bufB, lane, g); VSB();
    v_raw(rA, IDX16, COEF, t0 + 2, lane); VSB();
    v_stage<EXP>(PA, CQA, csA, XA, mA, VS, xr, mod_l, t0, s, lane); VSB();
#pragma unroll 1
    for (int i = 0; i < ulen; i += 2) {
        v_stage<EXP>(PB, CQB, csB, XB, mB, VS, xr, mod_l, t0 + i + 1, s, lane); VSB();
        v_raw(rB, IDX16, COEF, t0 + (i + 3 < ulen ? i + 3 : i + 1), lane); VSB();
        v_meta_lds(mA, rA, bufA, lane, g); VSB();
        v_compute<EXP>(PA, CQA, csA, XA, xw, t0 + i, s, lane); VSB();
        v_stage<EXP>(PA, CQA, csA, XA, mA, VS, xr, mod_l, t0 + (i + 2 < ulen ? i + 2 : i), s, lane); VSB();
        v_raw(rA, IDX16, COEF, t0 + (i + 4 < ulen ? i + 4 : i + 2 < ulen ? i + 2 : i), lane); VSB();
        v_meta_lds(mB, rB, bufB, lane, g); VSB();
        v_compute<EXP>(PB, CQB, csB, XB, xw, t0 + i + 1, s, lane); VSB();
    }
#undef VSB
}
__device__ __forceinline__ void v_unit(const KArgs& a, int l, const float* mod_l, unsigned s, unsigned unit, int lane, LAS unsigned char* wlds) { v_unit_<0>(a, l, mod_l, s, unit, lane, (const bf16_t*)(a.ws + WS_XB), (bf16_t*)(a.ws + WS_XB), wlds); }
#ifdef VEXP
__device__ __forceinline__ void v_unit_exp(const KArgs& a, int l, const float* mod_l, unsigned s, unsigned unit, int lane) { v_unit_<VEXP>(a, l, mod_l, s, unit, lane, (const bf16_t*)(a.ws + WS_XB), (bf16_t*)(a.ws + WS_GB), (LAS unsigned char*)0); }
#endif
#ifndef U_BIG_FRAC8
#define U_BIG_FRAC8 6
#endif
constexpr int U_BIG = (T / 16) * U_BIG_FRAC8 / 8, U_TICKETS = U_BIG + (T - U_BIG * 16) / 4;
#ifndef STEAL_MIN_V
#define STEAL_MIN_V 256
#endif
#ifndef STEAL_MIN_U
#define STEAL_MIN_U 512
#endif
template <bool VSTEP, bool VX_ = false>
__device__ __forceinline__ void peer_phase(const KArgs& a, int l, const float* mod_l, unsigned* cnt, LAS unsigned char* lds, int wv) {
        const int tid = phase_tid(wv), lane = tid & 63, wid = wv;
    LAS unsigned char* wlds = lds + wid * 3072;
#ifdef VWAVES
    if (VSTEP && wid >= VWAVES) return;
#endif
#ifdef UWAVES
    if (!VSTEP && wid >= UWAVES) return;
#endif
    const unsigned home = xcc_id();
    unsigned ss = 0, s = home;
    unsigned nxt = take_async(cnt + 64 * s, lane);
    for (;;) {
        const unsigned cur = (unsigned)__builtin_amdgcn_readfirstlane((int)nxt);
        if (cur >= (unsigned)(VSTEP ? NUNIT : U_TICKETS)) {
            const unsigned lim_ = (unsigned)(VSTEP ? NUNIT : U_TICKETS), thr_ = (unsigned)(VSTEP ? STEAL_MIN_V : STEAL_MIN_U);
            const unsigned* xc_ = (const unsigned*)(a.ws + WS_CTL) + CTL_BAR;
            bool found_ = false;
            for (++ss; ss < 8u; ++ss) { const unsigned q_ = (home + ss) & 7u;
                const unsigned c_ = __hip_atomic_load(cnt + 64 * q_, __ATOMIC_RELAXED, __HIP_MEMORY_SCOPE_AGENT), pop_ = __hip_atomic_load(xc_ + (256 + 64 * q_), __ATOMIC_RELAXED, __HIP_MEMORY_SCOPE_AGENT);
                if (c_ < lim_ && (pop_ == 0u || lim_ - c_ > thr_)) { s = q_; found_ = true; break; } }
            if (!found_) break;
            --ss;
            nxt = take_async(cnt + 64 * s, lane); continue; }
        nxt = take_async(cnt + 64 * s, lane);
#ifdef VEXP
        if (VX_) { v_unit_exp(a, l, mod_l, s, cur, lane); continue; }
#endif
#ifdef UEXP
        if (VX_) { u_unit<UEXP>(a, l, s, cur, wlds, lane); continue; }
#endif
        if (VSTEP) v_unit(a, l, mod_l, s, cur, lane, wlds);
        else {
            if (cur < (unsigned)U_BIG) u_unit<0>(a, l, s, cur, wlds, lane, (size_t)cur * 16, 16);
            else u_unit<0>(a, l, s, cur, wlds, lane, (size_t)U_BIG * 16 + (size_t)(cur - U_BIG) * 4, 4);
        }
    }
}
}

#ifndef PEERQ_WAVES
#define PEERQ_WAVES 1
#endif
constexpr int PH_PER_LAYER = 10, NPHASES = 2 + DEPTH * PH_PER_LAYER + 1;
#ifndef PHASE_MASK
#define PHASE_MASK 0xFFFF
#endif
#define HASP(k) (((PHASE_MASK) >> (k)) & 1)
#ifndef SB_EARLY_EXIT
#define SB_EARLY_EXIT 1
#endif

#define GAS __attribute__((address_space(1)))
#define RLX_AGENT __ATOMIC_RELAXED, __HIP_MEMORY_SCOPE_AGENT
#define XB_TMO      128
#define XB_XCNT(j)  (256  + 64 * (j))
#define XB_XSUB(j)  (1280 + 64 * (j))
#define XB_XGEN(j)  (2304 + 64 * (j))
#define XB_TOP      3328
#define XB_TOPGEN   3392
#define XCD_BAR_WORDS 3456
#define XB_SPIN_CAP (1u << 18)

__device__ __forceinline__ unsigned xb_ld(unsigned* p)              { return __hip_atomic_load(p, __ATOMIC_RELAXED, __HIP_MEMORY_SCOPE_AGENT); }
__device__ __forceinline__ unsigned xb_add(unsigned* p, unsigned v) { return __hip_atomic_fetch_add(p, v, __ATOMIC_RELAXED, __HIP_MEMORY_SCOPE_AGENT); }
__device__ __forceinline__ unsigned xb_xcc_id() { return (unsigned)__builtin_amdgcn_s_getreg((3 << 11) | 20) & 0xFu; }
#define XB_SPIN(cond, bar) do { unsigned _sp = 0; while (cond) { __builtin_amdgcn_s_sleep(1); \
    if ((++_sp & 255u) == 0u) { if (xb_ld(&(bar)[XB_TMO])) break; if (_sp > XB_SPIN_CAP) { atomicAdd(&(bar)[XB_TMO], 1u); break; } } } } while (0)

struct XcdBarrier {
    unsigned* bar; unsigned x;
    volatile LAS unsigned* st;
};

__device__ __forceinline__ XcdBarrier xcd_barrier_post(unsigned* bar, volatile LAS unsigned* st, bool tid0) {
    XcdBarrier b; b.bar = bar; b.x = xb_xcc_id(); b.st = st;
    if (tid0) (void)xb_add(&bar[XB_XCNT(b.x)], 1u);
    return b;
}
__device__ __forceinline__ void xcd_barrier_complete(unsigned* bar, unsigned x, unsigned& nloc, unsigned& nx) {
    const unsigned G = gridDim.x * gridDim.y * gridDim.z;
    unsigned sum, cnt, mine, sp = 0u;
    for (;;) {
        sum = 0u; cnt = 0u; mine = 0u;
#pragma unroll
        for (unsigned j = 0; j < 16; ++j) { const unsigned c = xb_ld(&bar[XB_XCNT(j)]); sum += c; cnt += (c > 0u) ? 1u : 0u; mine = (j == x) ? c : mine; }
        if (sum == G) break;
        __builtin_amdgcn_s_sleep(1);
        if ((++sp & 255u) == 0u) { if (xb_ld(&bar[XB_TMO])) break; if (sp > XB_SPIN_CAP) { atomicAdd(&bar[XB_TMO], 1u); break; } }
    }
    nloc = mine > 0u ? mine : 1u; nx = cnt > 0u ? cnt : 1u;
}

__device__ __forceinline__ void xcd_barrier(const XcdBarrier& b, bool tid0) {
    asm volatile("s_waitcnt vmcnt(0)" ::: "memory");
    __syncthreads();
    if (tid0) {
        unsigned* bar = b.bar;
        __builtin_amdgcn_s_waitcnt(0);
        unsigned nloc = b.st[0], nx = b.st[1];
        if (nloc == 0u) { xcd_barrier_complete(bar, b.x, nloc, nx); b.st[0] = nloc; b.st[1] = nx; }
        const unsigned old = xb_add(&bar[XB_XSUB(b.x)], 1u);
        const unsigned gen = old / nloc;
        if (old + 1u == (gen + 1u) * nloc) {
            __builtin_amdgcn_fence(__ATOMIC_RELEASE, "agent");
            asm volatile("s_waitcnt vmcnt(0)" ::: "memory");
            const unsigned og = xb_add(&bar[XB_TOP], 1u);
            const unsigned tg = og / nx;
            if (og + 1u == (tg + 1u) * nx) xb_add(&bar[XB_TOPGEN], 1u);
            else XB_SPIN(xb_ld(&bar[XB_TOPGEN]) == tg, bar);
            __builtin_amdgcn_fence(__ATOMIC_ACQUIRE, "agent");
            asm volatile("s_waitcnt vmcnt(0)" ::: "memory");
        } else {
            XB_SPIN(xb_ld(&bar[XB_TOPGEN]) == gen, bar);
            __builtin_amdgcn_fence(__ATOMIC_ACQUIRE, "agent");
            asm volatile("s_waitcnt vmcnt(0)" ::: "memory");
        }
    }
    __syncthreads();
}

typedef const __attribute__((address_space(4))) KArgs* KArgsP;
__device__ __forceinline__ KArgsP kargs() { KArgsP p = (KArgsP)__builtin_amdgcn_kernarg_segment_ptr(); asm volatile("" : "+s"(p)); return p; }

__device__ __forceinline__ void load_args(KArgs& a) {
#if defined(__HIP_DEVICE_COMPILE__)
    KArgsP p = kargs();
    a.x = p->x; a.c = p->c; a.pos = p->pos; a.ada_w = p->ada_w; a.ada_b = p->ada_b; a.norm1_g = p->norm1_g; a.w_in = p->w_in; a.sinks = p->sinks; a.wbr_a = p->wbr_a; a.wbr_b = p->wbr_b;
    a.w_out = p->w_out; a.norm2_g = p->norm2_g; a.wq = p->wq; a.subkeys = p->subkeys; a.pu = p->pu; a.pv = p->pv; a.final_g = p->final_g; a.out = p->out; a.ws = p->ws; a.ph_lo = p->ph_lo; a.ph_hi = p->ph_hi;
#endif
}
__global__ void __launch_bounds__(NTHREADS, 2) fwd_kernel(KArgs a_unused) {
    extern __shared__ __attribute__((aligned(16))) unsigned char lds_raw[];
    LAS unsigned char* lds = (LAS unsigned char*)lds_raw;
    cg::grid_group grid = cg::this_grid();
    const int ph_lo = kargs()->ph_lo, ph_hi = kargs()->ph_hi;
    const int wv = __builtin_amdgcn_readfirstlane((int)threadIdx.x >> 6);
#define IN(k) (ph_lo <= (k) && (k) < ph_hi)
#ifdef SUBPROBE
    if (blockIdx.x == SUBPROBE_BLK && threadIdx.x == 0) { SP_MEM[1] = 0; SP_MEM[0] = __builtin_amdgcn_s_memtime(); }
#endif
    volatile LAS unsigned* xb_st = (volatile LAS unsigned*)(lds + LDS_BYTES - 64);
    { const bool t0_ = phase_tid(wv) == 0; if (t0_) { xb_st[0] = 0u; xb_st[1] = 0u; } __syncthreads();
      (void)xcd_barrier_post((unsigned*)(kargs()->ws + WS_CTL) + CTL_BAR, xb_st, t0_); }
#define GRID_BAR() do { XcdBarrier b_; b_.bar = (unsigned*)(kargs()->ws + WS_CTL) + CTL_BAR; b_.x = xb_xcc_id(); b_.st = xb_st; xcd_barrier(b_, phase_tid(wv) == 0); } while (0)
#ifdef PROBE_PH
    volatile LAS unsigned long long* pr_mem = (volatile LAS unsigned long long*)(lds + LDS_BYTES - 32);
    if (blockIdx.x == 0 && threadIdx.x == 0) { pr_mem[0] = __builtin_amdgcn_s_memrealtime(); pr_mem[1] = 0; }
#define PROBE_MATCH(k) ((PROBE_PH) >= 100 ? ((k) >= 2 && (k) < NPHASES - 1 && (((k) - 2) % PH_PER_LAYER) == (PROBE_PH) - 100) : (k) == (PROBE_PH))
#define PROBE_STAMP(k) do { if (blockIdx.x == 0 && threadIdx.x == 0) { const unsigned long long now_ = __builtin_amdgcn_s_memrealtime(); if (PROBE_MATCH(k)) pr_mem[1] = pr_mem[1] + (now_ - pr_mem[0]); pr_mem[0] = now_; } } while (0)
#define SEAM(k) do { if (IN(k) && IN((k) + 1)) { GRID_BAR(); } PROBE_STAMP(k); } while (0)
#else
#define SEAM(k) do { if (IN(k) && IN((k) + 1)) { GRID_BAR(); } } while (0)
#endif
#define LOADARGS KArgs a; load_args(a); unsigned char* ws = a.ws; const int G = op_grid(); (void)G; (void)ws
#define LAYERARGS const float* mod_l = (const float*)(ws + WS_MOD) + (size_t)l * 8 * NMOD; const float* xcur = (l == 0) ? a.x : a.out; (void)mod_l; (void)xcur
    if (IN(0)) grid.sync();
    if (IN(0)) { if (HASP(0)) { LOADARGS; ph_prologue(a, lds, wv); } }
    SEAM(0);
    if (IN(1)) { if (HASP(0)) { LOADARGS; ph_prologue_b(a, lds, wv); } }
    SEAM(1);
#pragma unroll 1
    for (int l = 0; l < DEPTH; ++l) {
        const int p0 = 2 + l * PH_PER_LAYER;
        if (IN(p0 + 0)) { if (HASP(1)) { LOADARGS; LAYERARGS; if (l == 0) ph_norm<true>(a, a.x, a.norm1_g + l * DM, mod_l, 0, 1, ws + WS_H, (float*)(ws + WS_HS1), wv); else ph_norm<false>(a, ws + WS_XB, a.norm1_g + l * DM, mod_l, 0, 1, ws + WS_H, (float*)(ws + WS_HS1), wv); } }
        SEAM(p0 + 0);
        if (IN(p0 + 1)) { if (HASP(2)) { LOADARGS; pg8::Gemm g{(const bf16_t*)(ws + WS_H), (const bf16_t*)(ws + WS_WIN) + (size_t)l * NPROJ * 512, T, NPROJ, 512};
                  pg8::StaticOrder S; S.init(T, NPROJ, G, op_bid()); EpiI8<EpiProj> E{EpiProj{ws}, (const float*)(ws + WS_HS1), (const float*)(ws + WS_CSIN) + l * NPROJ};
                  pg8::gemm_phase_i8<EpiI8<EpiProj>, pg8::StaticOrder, true, true>(lds, g, S, E, wv); } }
        SEAM(p0 + 1);
        if (IN(p0 + 2)) { if (HASP(3)) { LOADARGS;
                  if (wv >= NWAVES - PEERQ_WAVES) peer_tables_layer(a, l, op_bid() * PEERQ_WAVES + (wv - (NWAVES - PEERQ_WAVES)), G * PEERQ_WAVES, phase_tid(wv) & 63);
                  att::attn_phase<SB_EARLY_EXIT != 0>(ws, a.sinks + l * 8, (unsigned*)(ws + WS_CTL) + CTL_ATTQ + l * 8 * 64, lds, wv); } }
        SEAM(p0 + 2);
        if (IN(p0 + 3)) { if (HASP(4)) { LOADARGS; pg8::StaticOrder S; S.init(T, DM, G, op_bid());
                  { pg8::Gemm g{(const bf16_t*)(ws + WS_QA), (const bf16_t*)(ws + WS_WBA) + (size_t)l * 1024 * 512, T, DM, 512};
                    EpiBranch<false> E{(const bf16_t*)(ws + WS_GA), (bf16_t*)(ws + WS_H)};
                    pg8::gemm_phase<EpiBranch<false>, pg8::StaticOrder, true, true>(lds, g, S, E, wv); }
                  __syncthreads();
                  { pg8::Gemm g{(const bf16_t*)(ws + WS_QB), (const bf16_t*)(ws + WS_WBB) + (size_t)l * 1024 * 512, T, DM, 512};
                    EpiBranch<true> E{(const bf16_t*)(ws + WS_GB), (bf16_t*)(ws + WS_H)};
                    pg8::gemm_phase<EpiBranch<true>, pg8::StaticOrder, true, true>(lds, g, S, E, wv); } } }
        SEAM(p0 + 3);
        if (IN(p0 + 4)) { if (HASP(5)) { LOADARGS; LAYERARGS; pg8::Gemm g{(const bf16_t*)(ws + WS_H), (const bf16_t*)(ws + WS_WOUT) + (size_t)l * 1024 * 1024, T, DM, 1024};
                  pg8::StaticOrder S; S.init(T, DM, G, op_bid());
                  if (l == 0) { EpiWout<true> E{a.x, (bf16_t*)(ws + WS_XB), mod_l + 2 * DM}; pg8::gemm_phase<EpiWout<true>, pg8::StaticOrder, true, true>(lds, g, S, E, wv); }
                  else { EpiWout<false> E{ws + WS_XB, (bf16_t*)(ws + WS_XB), mod_l + 2 * DM}; pg8::gemm_phase<EpiWout<false>, pg8::StaticOrder, true, true>(lds, g, S, E, wv); } } }
        SEAM(p0 + 4);
        if (IN(p0 + 5)) { if (HASP(6)) { LOADARGS; LAYERARGS; ph_norm<false>(a, ws + WS_XB, a.norm2_g + l * DM, mod_l, 3, 4, ws + WS_H2Q, (float*)(ws + WS_HS), wv); } }
        SEAM(p0 + 5);
        if (IN(p0 + 6)) { if (HASP(7)) { LOADARGS; pg8::Gemm g{(const bf16_t*)(ws + WS_H2Q), (const bf16_t*)(ws + WS_WQ) + (size_t)l * PQ * 512, T, PQ, 512};
                  pg8::StaticOrder S; S.init(T, PQ, G, op_bid()); EpiI8<EpiPlainBf16> E{EpiPlainBf16{(bf16_t*)(ws + WS_Q2), PQ}, (const float*)(ws + WS_HS), (const float*)(ws + WS_CSQ) + l * PQ};
                  pg8::gemm_phase_i8<EpiI8<EpiPlainBf16>, pg8::StaticOrder, true, true>(lds, g, S, E, wv); } }
        SEAM(p0 + 6);
        if (IN(p0 + 7)) { if (HASP(8)) { LOADARGS; tk::topk_phase((const bf16_t*)(ws + WS_Q2), (const bf16_t*)(ws + WS_SK) + (size_t)l * 8 * 2 * 128 * 128, (u32x4*)(ws + WS_UM), (unsigned short*)(ws + WS_IDX16), (const float*)(ws + WS_HS), lds, wv); } }
        SEAM(p0 + 7);
        if (IN(p0 + 8)) { if (HASP(9)) { LOADARGS; peer3::peer_phase<false>(a, l, nullptr, (unsigned*)(ws + WS_CTL) + CTL_QUEUE + (l * 2 + 0) * 8 * 64, lds, wv); } }
        SEAM(p0 + 8);
        if (IN(p0 + 9)) { if (HASP(10)) { LOADARGS; LAYERARGS; peer3::peer_phase<true>(a, l, mod_l, (unsigned*)(ws + WS_CTL) + CTL_QUEUE + (l * 2 + 1) * 8 * 64, lds, wv); } }
        SEAM(p0 + 9);
#ifdef UEXP
        if (IN(p0 + 9)) { { LOADARGS; LAYERARGS; peer3::peer_phase<false, true>(a, l, mod_l, (unsigned*)(ws + WS_CTL) + CTL_QUEUE + (4 + l) * 8 * 64, lds, wv); } GRID_BAR(); }
#endif
#ifdef VEXP
        if (IN(p0 + 9)) { { LOADARGS; LAYERARGS; peer3::peer_phase<true, true>(a, l, mod_l, (unsigned*)(ws + WS_CTL) + CTL_QUEUE + (4 + l) * 8 * 64, lds, wv); } GRID_BAR(); }
#endif
    }
    if (IN(NPHASES - 1)) { if (HASP(11)) { LOADARGS; ph_final_norm(a, wv); } }
#ifdef PROBE_PH
    PROBE_STAMP(NPHASES - 1);
    if (blockIdx.x == 0 && threadIdx.x == 0) { const unsigned long long t0_ = __builtin_amdgcn_s_memrealtime(), dl_ = pr_mem[1] * (PROBE_K); while (__builtin_amdgcn_s_memrealtime() - t0_ < dl_) __builtin_amdgcn_s_sleep(16); }
#endif
#ifdef SUBPROBE
    if (blockIdx.x == SUBPROBE_BLK && threadIdx.x == 0) { const unsigned long long t0_ = __builtin_amdgcn_s_memtime(), dl_ = SP_MEM[1] * (SUBPROBE_K); while (__builtin_amdgcn_s_memtime() - t0_ < dl_) __builtin_amdgcn_s_sleep(16); }
#endif
#undef IN
#undef SEAM
}

#ifndef N_LAUNCH_SPLIT
#define N_LAUNCH_SPLIT 1
#endif
extern "C" void kernel_launch(void* const* d_in, const int* in_sizes, int n_in, void* d_out, int out_size, void* d_ws, size_t ws_size, hipStream_t stream) {
    static int grid = 0;
    if (grid == 0) {
        if (n_in != 17 || out_size != T * DM || ws_size < WS_END) { fprintf(stderr, "kernel_launch: unexpected problem (n_in %d out %d ws %zu)\n", n_in, out_size, ws_size); grid = -1; return; }
        int dev = 0, cus = 0, per_cu = 0;
        (void)hipGetDevice(&dev);
        (void)hipDeviceGetAttribute(&cus, hipDeviceAttributeMultiprocessorCount, dev);
        (void)hipFuncSetAttribute((const void*)fwd_kernel, hipFuncAttributeMaxDynamicSharedMemorySize, LDS_BYTES);
        (void)hipOccupancyMaxActiveBlocksPerMultiprocessor(&per_cu, (const void*)fwd_kernel, NTHREADS, LDS_BYTES);
        if (per_cu < 1) { fprintf(stderr, "kernel_launch: occupancy query says %d\n", per_cu); per_cu = 1; }
        grid = cus;
        fprintf(stderr, "kernel_launch: cus %d per_cu %d grid %d ws %zu\n", cus, per_cu, grid, ws_size);
    }
    if (grid < 0) return;
    if (hipMemsetAsync((char*)d_ws + WS_CTL, 0, 131072, stream) != hipSuccess) { fprintf(stderr, "kernel_launch: hipMemsetAsync of the control words failed\n"); return; }
    KArgs a{};
    a.x = (const float*)d_in[0]; a.c = (const float*)d_in[1]; a.pos = (const int*)d_in[2]; a.ada_w = (const float*)d_in[3]; a.ada_b = (const float*)d_in[4];
    a.norm1_g = (const float*)d_in[5]; a.w_in = (const float*)d_in[6]; a.sinks = (const float*)d_in[7]; a.wbr_a = (const float*)d_in[8]; a.wbr_b = (const float*)d_in[9];
    a.w_out = (const float*)d_in[10]; a.norm2_g = (const float*)d_in[11]; a.wq = (const float*)d_in[12]; a.subkeys = (const float*)d_in[13]; a.pu = (const float*)d_in[14];
    a.pv = (const float*)d_in[15]; a.final_g = (const float*)d_in[16]; a.out = (float*)d_out; a.ws = (unsigned char*)d_ws;
#if N_LAUNCH_SPLIT
    a.ph_lo = 0; a.ph_hi = NPHASES;
    { void* args[] = {&a};
      hipError_t e = hipLaunchCooperativeKernel((void*)fwd_kernel, dim3(grid), dim3(NTHREADS), args, LDS_BYTES, stream);
      if (e != hipSuccess) fprintf(stderr, "cooperative launch failed: %s (grid %d)\n", hipGetErrorString(e), grid); }
#else
    for (int ph = 0; ph < NPHASES; ++ph) {
        a.ph_lo = ph; a.ph_hi = ph + 1;
        void* args[] = {&a};
        hipError_t e = hipLaunchCooperativeKernel((void*)fwd_kernel, dim3(grid), dim3(NTHREADS), args, LDS_BYTES, stream);
        if (e != hipSuccess) { fprintf(stderr, "cooperative launch %d failed: %s (grid %d)\n", ph, hipGetErrorString(e), grid); break; }
    }
#endif
}
```
